# Optimizing an MI355X kernel written in HIP

```python
import jax, jax.numpy as jnp
from jax import lax
import numpy as np


D_MODEL = 1024
BATCH = 16
SEQ = 2048
DEPTH = 2

D_MIX = D_MODEL
HG_WIDTH = D_MIX // 2
HG_HEADS = 4
HG_DK = HG_WIDTH // HG_HEADS
HG_DV = HG_WIDTH // HG_HEADS
HG_CHUNK = 16
AT_WIDTH = D_MIX - HG_WIDTH
AT_HEADS = 8
AT_DH = AT_WIDTH // AT_HEADS
MOBA_BLOCK = 256
MOBA_TOPK = 3
MOBA_QCHUNK = 16
IN_SPLITS = (HG_WIDTH, HG_WIDTH, HG_WIDTH, HG_WIDTH, AT_WIDTH, AT_WIDTH, AT_WIDTH, AT_WIDTH)
IN_COLS = sum(IN_SPLITS)
NORM_EPS = 1e-6
MASK_VALUE = -1e30
LB_MAX = 1.0 - 1e-6

kernel_name = "hymba_style_hgrn2_moba_block"


def _rms_norm(x, w):
    xf = x.astype(jnp.float32)
    y = xf * lax.rsqrt(jnp.mean(xf * xf, axis=-1, keepdims=True) + NORM_EPS)
    return (y * w.astype(jnp.float32)).astype(x.dtype)


def _alibi_slopes(n_heads):
    return jnp.asarray([2.0 ** (-8.0 * (h + 1) / n_heads) for h in range(n_heads)], dtype=jnp.float32)


def _hgrn_lower_bounds(lb_logits):
    p = jax.nn.softmax(lb_logits.astype(jnp.float32), axis=0)
    return jnp.clip(jnp.cumsum(p, axis=0) - p[0:1], 0.0, LB_MAX)


def _hgrn2(q, f_logit, i, lb):
    B, T, _ = q.shape
    C = HG_CHUNK
    N = T // C

    def heads(z):
        return z.astype(jnp.float32).reshape(B, N, C, HG_HEADS, -1).transpose(0, 3, 1, 2, 4)

    q = jax.nn.silu(heads(q))
    lbh = lb.astype(jnp.float32).reshape(HG_HEADS, 1, 1, HG_DK)
    f = lbh + (1.0 - lbh) * jax.nn.sigmoid(heads(f_logit))
    log_f = jnp.logaddexp(jnp.log(lbh), jnp.log1p(-lbh) + jax.nn.log_sigmoid(heads(f_logit)))
    k = 1.0 - f
    i = heads(i)
    b = jnp.cumsum(log_f, axis=3)
    b_last = b[:, :, :, C - 1:]
    causal = jnp.tril(jnp.ones((C, C), dtype=bool))[:, :, None]
    pair = b[:, :, :, :, None, :] - b[:, :, :, None, :, :]
    decay_ts = jnp.exp(jnp.where(causal, pair, -jnp.inf))
    scores = jnp.einsum("bhncd,bhnsd,bhncsd->bhncs", q, k, decay_ts)
    o_intra = jnp.einsum("bhncs,bhnse->bhnce", scores, i)
    q_in = q * jnp.exp(b)
    k_st = k * jnp.exp(b_last - b)
    decay = jnp.exp(b_last[:, :, :, 0])

    def step(S, xs):
        qn, kn, in_, dn = xs
        o = jnp.einsum("bhcd,bhde->bhce", qn, S)
        S = dn[..., None] * S + jnp.einsum("bhcd,bhce->bhde", kn, in_)
        return S, o

    S0 = jnp.zeros((B, HG_HEADS, HG_DK, HG_DV), jnp.float32)
    mv = lambda z: jnp.moveaxis(z, 2, 0)
    _, o_inter = lax.scan(step, S0, (mv(q_in), mv(k_st), mv(i), mv(decay)))
    o = o_intra + jnp.moveaxis(o_inter, 0, 2)
    return o.transpose(0, 2, 3, 1, 4).reshape(B, T, HG_HEADS, HG_DV)


def _moba(q, k, v, q_gain, k_gain):
    B, T, _ = q.shape
    heads = lambda z: z.reshape(B, T, AT_HEADS, AT_DH).transpose(0, 2, 1, 3)
    q = _rms_norm(heads(q), q_gain).astype(jnp.float32)
    k = _rms_norm(heads(k), k_gain).astype(jnp.float32)
    v = heads(v).astype(jnp.float32)

    nb = -(-T // MOBA_BLOCK)
    t_pad = nb * MOBA_BLOCK
    pad = ((0, 0), (0, 0), (0, t_pad - T), (0, 0))
    k_pad = jnp.pad(k, pad)
    v_pad = jnp.pad(v, pad)
    kb = k_pad.reshape(B, AT_HEADS, nb, MOBA_BLOCK, AT_DH)
    vb = v_pad.reshape(B, AT_HEADS, nb, MOBA_BLOCK, AT_DH)

    k_mean = jnp.mean(kb, axis=3)
    cur_blk = jnp.arange(T) // MOBA_BLOCK
    past = jnp.arange(nb)[None, :] < cur_blk[:, None]
    gate = jnp.where(past, jnp.einsum("bhtd,bhnd->bhtn", q, k_mean), MASK_VALUE)
    n_sel = min(MOBA_TOPK, nb)
    _, sel = lax.top_k(gate, n_sel)
    valid = sel < cur_blk[:, None]

    nq = T // MOBA_QCHUNK
    chunk = lambda z: jnp.moveaxis(z.reshape(B, AT_HEADS, nq, MOBA_QCHUNK, *z.shape[3:]), 2, 0)
    t0s = jnp.arange(nq, dtype=jnp.int32) * MOBA_QCHUNK
    slopes = _alibi_slopes(AT_HEADS)[None, :, None, None]
    bi = jnp.arange(B)[:, None, None, None]
    hi = jnp.arange(AT_HEADS)[None, :, None, None]
    offs = jnp.arange(MOBA_BLOCK)
    scale = AT_DH ** -0.5

    def attend(xs):
        qc, selc, validc, t0 = xs
        t = t0 + jnp.arange(MOBA_QCHUNK)
        blk0 = (t0 // MOBA_BLOCK) * MOBA_BLOCK
        k_own = lax.dynamic_slice_in_dim(k_pad, blk0, MOBA_BLOCK, axis=2)
        v_own = lax.dynamic_slice_in_dim(v_pad, blk0, MOBA_BLOCK, axis=2)
        dist_own = (t[:, None] - (blk0 + offs)[None, :]).astype(jnp.float32)
        s_own = jnp.einsum("bhqd,bhsd->bhqs", qc, k_own) * scale - slopes * dist_own
        s_own = jnp.where(dist_own >= 0, s_own, MASK_VALUE)
        k_sel = kb[bi, hi, selc]
        v_sel = vb[bi, hi, selc]
        dist_sel = (t[:, None, None] - (selc[..., None] * MOBA_BLOCK + offs)).astype(jnp.float32)
        s_sel = jnp.einsum("bhqd,bhqjsd->bhqjs", qc, k_sel) * scale - slopes[..., None] * dist_sel
        s_sel = jnp.where(validc[..., None], s_sel, MASK_VALUE)
        s_all = jnp.concatenate(
            [s_own, s_sel.reshape(B, AT_HEADS, MOBA_QCHUNK, n_sel * MOBA_BLOCK)], axis=-1)
        p = jax.nn.softmax(s_all, axis=-1)
        p_own = p[..., :MOBA_BLOCK]
        p_sel = p[..., MOBA_BLOCK:].reshape(B, AT_HEADS, MOBA_QCHUNK, n_sel, MOBA_BLOCK)
        return (jnp.einsum("bhqs,bhsd->bhqd", p_own, v_own)
                + jnp.einsum("bhqjs,bhqjsd->bhqd", p_sel, v_sel))

    out = lax.map(attend, (chunk(q), chunk(sel), chunk(valid), t0s))
    out = jnp.moveaxis(out, 0, 2).reshape(B, AT_HEADS, T, AT_DH)
    return out.transpose(0, 2, 1, 3).reshape(B, T, AT_WIDTH)


def setup_inputs(seed: int = 0) -> dict:
    key = jax.random.key(seed)
    ks = jax.random.split(key, 8)
    x = jax.random.normal(ks[0], (BATCH, SEQ, D_MODEL), jnp.float32)
    norm_w = 1.0 + 0.02 * jax.random.normal(ks[1], (DEPTH, D_MODEL), jnp.float32)
    w_in = jax.random.normal(ks[2], (DEPTH, D_MODEL, IN_COLS), jnp.float32) * D_MODEL ** -0.5
    hg_lb_logits = 0.5 * jax.random.normal(ks[3], (DEPTH, HG_WIDTH), jnp.float32)
    hg_norm_w = 1.0 + 0.02 * jax.random.normal(ks[4], (DEPTH, HG_DV), jnp.float32)
    q_norm_w = 1.0 + 0.02 * jax.random.normal(ks[5], (DEPTH, AT_DH), jnp.float32)
    k_norm_w = 1.0 + 0.02 * jax.random.normal(ks[6], (DEPTH, AT_DH), jnp.float32)
    w_out = jax.random.normal(ks[7], (DEPTH, D_MIX, D_MODEL), jnp.float32) * D_MIX ** -0.5
    return {"x": x, "norm_w": norm_w, "w_in": w_in, "hg_lb_logits": hg_lb_logits,
            "hg_norm_w": hg_norm_w, "q_norm_w": q_norm_w, "k_norm_w": k_norm_w, "w_out": w_out}


def reference(x, norm_w, w_in, hg_lb_logits, hg_norm_w, q_norm_w, k_norm_w, w_out):
    B, T, _ = x.shape
    lower_bounds = _hgrn_lower_bounds(hg_lb_logits)
    split_points = [int(s) for s in np.cumsum(IN_SPLITS)[:-1]]
    for l in range(DEPTH):
        h = _rms_norm(x, norm_w[l])
        proj = jnp.einsum("btd,dc->btc", h, w_in[l])
        hq, hf, hi, hg, aq, ak, av, ag = jnp.split(proj, split_points, axis=-1)
        o_h = _rms_norm(_hgrn2(hq, hf, hi, lower_bounds[l]), hg_norm_w[l]).reshape(B, T, HG_WIDTH)
        o_h = o_h * jax.nn.silu(hg.astype(jnp.float32))
        o_a = _moba(aq, ak, av, q_norm_w[l], k_norm_w[l]) * jax.nn.silu(ag.astype(jnp.float32))
        mixed = jnp.concatenate([o_h, o_a], axis=-1).astype(x.dtype)
        x = x + jnp.einsum("btc,cd->btd", mixed, w_out[l])
    return x
```

```cpp
#include <hip/hip_runtime.h>
#include <cstdio>
#include <cstdint>
namespace pg8 {
#define PG8_LAS __attribute__((address_space(3)))
typedef unsigned short bf16_t;
typedef short bf16x8 __attribute__((ext_vector_type(8)));
typedef float f32x4 __attribute__((ext_vector_type(4)));
typedef unsigned u32x4 __attribute__((ext_vector_type(4)));
typedef unsigned u32x2 __attribute__((ext_vector_type(2)));
constexpr int BM = 256, BK = 64, HALF = 128, HTB = HALF * BK * 2  , STAGE_BYTES = 8 * HTB, NXCD = 8, WGM = 8;

__host__ __device__ __forceinline__ int lds_byte(int r, int c) { const int st = (r >> 4) * 2 + (c >> 5), rr = r & 15, cc = c & 31, ob = rr * 64 + cc * 2; return st * 1024 + (ob ^ (((ob >> 9) & 1) << 5)); }
__host__ __device__ __forceinline__ void stage_rc(int b, int& R, int& C) { const int st = b / 1024, sb = b % 1024, swz = sb ^ (((sb >> 9) & 1) << 5); R = (st >> 1) * 16 + swz / 64; C = (st & 1) * 32 + (swz % 64) / 2; }
__host__ __device__ __forceinline__ int perm32(int rho) { const int n = rho >> 4, i = rho & 15; return 8 * (i >> 2) + 4 * n + (i & 3); }

struct Unit { int pm, pn; };
struct Gemm { const bf16_t* A; const bf16_t* Bt; int M, N, K; };

struct StaticOrder {
    int nM, nN, nwg, G, c;
    __host__ __device__ void init(int M, int N, int G_, int c_) { nM = M / BM; nN = N / BM; nwg = nM * nN; G = G_; c = c_; }
    __host__ __device__ bool next(int i, Unit& u) const {
        const long L = (long)i * G + c; if (L >= nwg) return false;
        int wgid = (int)L; { const int q = nwg / NXCD, r = nwg % NXCD, xcd = wgid % NXCD, off = wgid / NXCD; wgid = (xcd < r ? xcd * (q + 1) : r * (q + 1) + (xcd - r) * q) + off; }
        const int nig = WGM * nN, gid = wgid / nig, fm = gid * WGM, gsz = (nM - fm) < WGM ? (nM - fm) : WGM;
        u.pm = fm + ((wgid % nig) % gsz); u.pn = (wgid % nig) / gsz; return true;
    }
    __device__ __forceinline__ void a_ready(const Unit&) const {}
    __device__ __forceinline__ void done(const Unit&) const {}
};

__device__ __forceinline__ unsigned cvt_pk_bf16(float lo, float hi) { unsigned r; asm volatile("v_cvt_pk_bf16_f32 %0, %1, %2" : "=v"(r) : "v"(lo), "v"(hi)); return r; }


struct EpiProj {
    static constexpr bool PERM = true, AFTER_DRAIN = false;
    bf16_t* O; int ldc; const float* rowss;
    __device__ __forceinline__ void operator()(const f32x4 (&acc)[2][2][4][2], const Unit& u, int wr, int wc, int fr, int fq) const {
        const int row0 = u.pm * BM + wr * 64 + fr; const int col0 = u.pn * BM + wc * 32 + 8 * fq;
#pragma unroll
        for (int ai = 0; ai < 2; ++ai)
#pragma unroll
            for (int m = 0; m < 4; ++m) {
                const int row = row0 + ai * HALF + m * 16;
                const f32x4* rp = (const f32x4*)(rowss + (size_t)row * 16);
                const f32x4 a = rp[0], b = rp[1], c = rp[2], d = rp[3];
                const float ss = ((a[0] + a[1]) + (a[2] + a[3])) + ((b[0] + b[1]) + (b[2] + b[3])) + ((c[0] + c[1]) + (c[2] + c[3])) + ((d[0] + d[1]) + (d[2] + d[3]));
                const float rs = 1.0f / sqrtf(ss * (1.0f / 1024.0f) + 1e-6f);
                bf16_t* rowp = O + (size_t)row * ldc + col0;
#pragma unroll
                for (int bj = 0; bj < 2; ++bj) { const f32x4 v0 = acc[ai][bj][m][0] * rs, v1 = acc[ai][bj][m][1] * rs;
                    u32x4 w; w.x = cvt_pk_bf16(v0[0], v0[1]); w.y = cvt_pk_bf16(v0[2], v0[3]); w.z = cvt_pk_bf16(v1[0], v1[1]); w.w = cvt_pk_bf16(v1[2], v1[3]);
                    *(u32x4*)(rowp + bj * HALF) = w; }
            }
    }
};
struct EpiOut {
    static constexpr bool PERM = false, AFTER_DRAIN = false;
    const float* xres; float* out; bf16_t* xb; float* rowss;
    __device__ __forceinline__ void operator()(const f32x4 (&acc)[2][2][4][2], const Unit& u, int wr, int wc, int fr, int fq) const {
        const int col0 = u.pn * BM + wc * 32 + 4 * fq;
#pragma unroll
        for (int ai = 0; ai < 2; ++ai)
#pragma unroll
            for (int m = 0; m < 4; ++m) {
                const int row = u.pm * BM + ai * HALF + wr * 64 + m * 16 + fr; float ss = 0.f;
#pragma unroll
                for (int bj = 0; bj < 2; ++bj)
#pragma unroll
                    for (int n = 0; n < 2; ++n) { const size_t off = (size_t)row * 1024 + col0 + bj * HALF + n * 16;
                        const f32x4 v = *(const f32x4*)(xres + off) + acc[ai][bj][m][n];
                        *(f32x4*)(out + off) = v; u32x2 w; w.x = cvt_pk_bf16(v[0], v[1]); w.y = cvt_pk_bf16(v[2], v[3]); *(u32x2*)(xb + off) = w;
                        ss += (v[0] * v[0] + v[1] * v[1]) + (v[2] * v[2] + v[3] * v[3]); }
                ss += __shfl_xor(ss, 16); ss += __shfl_xor(ss, 32);
                if (fq == 0) rowss[(size_t)row * 16 + u.pn * 4 + wc] = ss;
            }
    }
};

template <class Epi, class Sched, bool ALIGN_EPI = false, bool SP2 = false>
__device__ __forceinline__ void gemm_phase(PG8_LAS unsigned char* lds, const Gemm g, const Sched& S, const Epi& E) {
    int tid = threadIdx.x; asm volatile("" : "+v"(tid));
    const int wid = __builtin_amdgcn_readfirstlane(tid >> 6), lane = tid & 63, wr = wid >> 2, wc = wid & 3, fr = lane & 15, fq = lane >> 4;
    const int K = g.K, nt = K / BK;
    unsigned voffA[2], voffB[2];
#pragma unroll
    for (int i = 0; i < 2; ++i) { int R, C; stage_rc(tid * 16 + i * 8192, R, C); const int Rb = Epi::PERM ? ((R & ~31) + perm32(R & 31)) : R;
        voffA[i] = (unsigned)(R * K + C) * 2u; voffB[i] = (unsigned)(Rb * K + C) * 2u; }
    const size_t kstep = (size_t)(BK * 2);
    const size_t hstep = (size_t)HALF * K * 2;
    const size_t tstep = 2 * hstep;
    const unsigned ldsw = (unsigned)wid * 1024u;
    const int aoff = lds_byte(wr * 64 + fr, fq * 8), boff = lds_byte(wc * 32 + fr, fq * 8);
#define PG8_SA(b, h) (((b) * 2 + (h)) * HTB)
#define PG8_SB(b, h) ((4 + (b) * 2 + (h)) * HTB)
#define PG8_STAGE(bufoff, gbase, voff) do { _Pragma("unroll") for (int _i = 0; _i < 2; ++_i) \
        __builtin_amdgcn_global_load_lds((const unsigned*)((const char*)(gbase) + (voff)[_i]), (PG8_LAS unsigned*)(lds + (bufoff) + ldsw + _i * 8192), 16, 0, 0); } while (0)
#define PG8_LDA(dst, b, h) do { _Pragma("unroll") for (int m = 0; m < 4; ++m) _Pragma("unroll") for (int k = 0; k < 2; ++k) dst[m][k] = *(const PG8_LAS bf16x8*)(lds + PG8_SA(b, h) + aoff + m * 2048 + k * 1024); } while (0)
#define PG8_LDB(dst, b, h) do { _Pragma("unroll") for (int n = 0; n < 2; ++n) _Pragma("unroll") for (int k = 0; k < 2; ++k) dst[n][k] = *(const PG8_LAS bf16x8*)(lds + PG8_SB(b, h) + boff + n * 2048 + k * 1024); } while (0)
#define PG8_MMA(ai, bj, At, Bt) do { __builtin_amdgcn_s_setprio(1); _Pragma("unroll") for (int m = 0; m < 4; ++m) _Pragma("unroll") for (int n = 0; n < 2; ++n) _Pragma("unroll") for (int k = 0; k < 2; ++k) \
        acc[ai][bj][m][n] = __builtin_amdgcn_mfma_f32_16x16x32_bf16(Bt[n][k], At[m][k], acc[ai][bj][m][n], 0, 0, 0); __builtin_amdgcn_s_setprio(0); } while (0)
#define PG8_WAIT_V(n) asm volatile("s_waitcnt vmcnt(" #n ")" ::: "memory")
#define PG8_WAIT_L(n) asm volatile("s_waitcnt lgkmcnt(" #n ")" ::: "memory")
#define PG8_BAR __builtin_amdgcn_s_barrier()
#define PG8_SCHED __builtin_amdgcn_sched_barrier(0)
    Unit cur, nxt; int ui = 0;
    if (!S.next(0, cur)) return;
    f32x4 acc[2][2][4][2];
#pragma unroll
    for (int a = 0; a < 2; ++a)
#pragma unroll
        for (int b = 0; b < 2; ++b)
#pragma unroll
            for (int m = 0; m < 4; ++m)
#pragma unroll
                for (int n = 0; n < 2; ++n) acc[a][b][m][n] = (f32x4){0.f, 0.f, 0.f, 0.f};
    bf16x8 At[4][2], B0[2][2], B1[2][2];
    const char* cA = (const char*)g.A + (size_t)cur.pm * tstep; const char* cB = (const char*)g.Bt + (size_t)cur.pn * tstep;
    S.a_ready(cur);
    if constexpr (SP2) {
        PG8_STAGE(PG8_SB(0, 0), cB, voffB); PG8_STAGE(PG8_SB(0, 1), cB + hstep, voffB); PG8_STAGE(PG8_SA(0, 0), cA, voffA); PG8_STAGE(PG8_SA(0, 1), cA + hstep, voffA);
        if (wr == 1) PG8_BAR;
        PG8_WAIT_V(2); PG8_BAR;
        PG8_STAGE(PG8_SB(1, 0), cB + kstep, voffB); PG8_STAGE(PG8_SA(1, 0), cA + kstep, voffA); PG8_STAGE(PG8_SB(1, 1), cB + hstep + kstep, voffB);
        PG8_WAIT_V(6); PG8_BAR;
    } else {
        PG8_STAGE(PG8_SB(0, 0), cB, voffB); PG8_STAGE(PG8_SA(0, 0), cA, voffA); PG8_STAGE(PG8_SB(0, 1), cB + hstep, voffB); PG8_STAGE(PG8_SA(0, 1), cA + hstep, voffA);
        if (wr == 1) PG8_BAR;
        PG8_WAIT_V(4); PG8_BAR;
        PG8_STAGE(PG8_SB(1, 0), cB + kstep, voffB); PG8_STAGE(PG8_SA(1, 0), cA + kstep, voffA); PG8_STAGE(PG8_SB(1, 1), cB + hstep + kstep, voffB);
        PG8_WAIT_V(6); PG8_BAR;
    }
    for (;;) {
        const bool has_next = S.next(ui + 1, nxt);
        const char* nA = has_next ? (const char*)g.A + (size_t)nxt.pm * tstep : cA; const char* nB = has_next ? (const char*)g.Bt + (size_t)nxt.pn * tstep : cB;
        for (int t = 0; t < nt; t += 2) {
            const bool last = (t == nt - 2);
            const char* a1 = cA + (size_t)(t + 1) * kstep;
            const char* a2 = last ? nA : cA + (size_t)(t + 2) * kstep; const char* b2 = last ? nB : cB + (size_t)(t + 2) * kstep;
            const char* a3 = a2 + kstep; const char* b3 = b2 + kstep;
            if (last && has_next) S.a_ready(nxt);
            if constexpr (SP2) {
            PG8_LDB(B0, 0, 0); PG8_LDB(B1, 0, 1); PG8_SCHED; PG8_LDA(At, 0, 0); PG8_STAGE(PG8_SA(1, 1), a1 + hstep, voffA);
            PG8_WAIT_V(8); PG8_WAIT_L(0); PG8_BAR; PG8_MMA(0, 0, At, B0); PG8_MMA(0, 1, At, B1); PG8_BAR; PG8_SCHED;
            PG8_LDA(At, 0, 1); PG8_STAGE(PG8_SB(0, 0), b2, voffB); PG8_STAGE(PG8_SB(0, 1), b2 + hstep, voffB); PG8_STAGE(PG8_SA(0, 0), a2, voffA);
            PG8_WAIT_V(8); PG8_WAIT_L(0); PG8_BAR; PG8_MMA(1, 0, At, B0); PG8_MMA(1, 1, At, B1); PG8_BAR; PG8_SCHED;
            PG8_LDB(B0, 1, 0); PG8_LDB(B1, 1, 1); PG8_SCHED; PG8_LDA(At, 1, 0); PG8_STAGE(PG8_SA(0, 1), a2 + hstep, voffA);
            PG8_WAIT_V(8); PG8_WAIT_L(0); PG8_BAR; PG8_MMA(0, 0, At, B0); PG8_MMA(0, 1, At, B1); PG8_BAR; PG8_SCHED;
            PG8_LDA(At, 1, 1); PG8_STAGE(PG8_SB(1, 0), b3, voffB); PG8_STAGE(PG8_SB(1, 1), b3 + hstep, voffB); PG8_STAGE(PG8_SA(1, 0), a3, voffA);
            PG8_WAIT_V(8); PG8_WAIT_L(0); PG8_BAR; PG8_MMA(1, 0, At, B0); PG8_MMA(1, 1, At, B1); PG8_BAR; PG8_SCHED;
            } else {
            PG8_LDB(B0, 0, 0); PG8_SCHED; PG8_LDA(At, 0, 0); PG8_STAGE(PG8_SA(1, 1), a1 + hstep, voffA);
            PG8_WAIT_L(8); PG8_BAR; PG8_WAIT_L(0); PG8_MMA(0, 0, At, B0); PG8_BAR; PG8_SCHED;
            PG8_LDB(B1, 0, 1); PG8_STAGE(PG8_SB(0, 0), b2, voffB);
            PG8_BAR; PG8_WAIT_L(0); PG8_MMA(0, 1, At, B1); PG8_BAR;
            PG8_LDA(At, 0, 1); PG8_STAGE(PG8_SA(0, 0), a2, voffA);
            PG8_BAR; PG8_WAIT_L(0); PG8_MMA(1, 0, At, B0); PG8_BAR; PG8_SCHED;
            PG8_STAGE(PG8_SB(0, 1), b2 + hstep, voffB);
            PG8_WAIT_V(6); PG8_BAR; PG8_MMA(1, 1, At, B1); PG8_BAR;
            PG8_LDB(B0, 1, 0); PG8_SCHED; PG8_LDA(At, 1, 0); PG8_STAGE(PG8_SA(0, 1), a2 + hstep, voffA);
            PG8_WAIT_L(8); PG8_BAR; PG8_WAIT_L(0); PG8_MMA(0, 0, At, B0); PG8_BAR; PG8_SCHED;
            PG8_LDB(B1, 1, 1); PG8_STAGE(PG8_SB(1, 0), b3, voffB);
            PG8_BAR; PG8_WAIT_L(0); PG8_MMA(0, 1, At, B1); PG8_BAR;
            PG8_LDA(At, 1, 1); PG8_STAGE(PG8_SA(1, 0), a3, voffA);
            PG8_BAR; PG8_WAIT_L(0); PG8_MMA(1, 0, At, B0); PG8_BAR; PG8_SCHED;
            PG8_STAGE(PG8_SB(1, 1), b3 + hstep, voffB);
            PG8_WAIT_V(6); PG8_BAR; PG8_MMA(1, 1, At, B1); PG8_BAR;
            }
        }
        if constexpr (ALIGN_EPI) { if (wr == 0) PG8_BAR; }
        if constexpr (!Epi::AFTER_DRAIN) { E(acc, cur, wr, wc, fr, fq); S.done(cur); }
        if (!has_next) break;
#pragma unroll
        for (int a = 0; a < 2; ++a)
#pragma unroll
            for (int b = 0; b < 2; ++b)
#pragma unroll
                for (int m = 0; m < 4; ++m)
#pragma unroll
                    for (int n = 0; n < 2; ++n) acc[a][b][m][n] = (f32x4){0.f, 0.f, 0.f, 0.f};
        cur = nxt; cA = nA; cB = nB; ++ui;
        if constexpr (ALIGN_EPI) { if (wr == 1) PG8_BAR; }
    }
    PG8_WAIT_V(0);
    if constexpr (!ALIGN_EPI) { if (wr == 0) PG8_BAR; }
    PG8_BAR;
    if constexpr (Epi::AFTER_DRAIN) { E.fused(acc, cur, wr, wc, fr, fq, lds, wid, lane); S.done(cur); }
#undef PG8_SA
#undef PG8_SB
#undef PG8_STAGE
#undef PG8_LDA
#undef PG8_LDB
#undef PG8_MMA
#undef PG8_WAIT_V
#undef PG8_WAIT_L
#undef PG8_BAR
#undef PG8_SCHED
}
}


constexpr int NWAVES = 8;
#ifndef MK_N_LAUNCHES
#define MK_N_LAUNCHES 9
#endif
constexpr int N_PHASES = 9;
constexpr int N_LAUNCHES = MK_N_LAUNCHES;

constexpr int BATCH = 16, SEQ = 2048, DM = 1024, DEPTH = 2, MTOK = BATCH * SEQ, NIN = 4096;
constexpr int C_HQ = 0, C_HF = 512, C_HI = 1024, C_HG = 1536, C_AQ = 2048, C_AK = 2560, C_AV = 3072, C_AG = 3584;
constexpr float NORM_EPS = 1e-6f;

constexpr size_t MiB = 1u << 20;
constexpr size_t WS_CTL = 0, CTL_ZERO_BYTES = 1 * MiB;
constexpr size_t WS_WIN = 2 * MiB;
constexpr size_t WS_WOUT = 18 * MiB;
constexpr size_t WS_LB = 22 * MiB;
constexpr size_t WS_KMEAN = 22 * MiB + 65536;
constexpr size_t WS_ROWSS = 24 * MiB;
constexpr size_t WS_XB = 32 * MiB;
constexpr size_t WS_MIXED = 96 * MiB;
constexpr size_t WS_PROJ = 160 * MiB;
constexpr size_t WS_END = 416 * MiB;
constexpr int CW_BAR = 4096;

constexpr int RING_OFF = 0, RING_BYTES = 131072;
constexpr int EXTRA_OFF = RING_BYTES, EXTRA_BYTES = 16384;
constexpr int LDSCTL_OFF = EXTRA_OFF + EXTRA_BYTES, MISC_OFF = LDSCTL_OFF + 320;
constexpr int LDS_BYTES = LDSCTL_OFF + 1024;

#define GAS __attribute__((address_space(1)))
#define LAS __attribute__((address_space(3)))
typedef unsigned short bf16;
typedef unsigned v4u __attribute__((ext_vector_type(4)));
typedef float f32x4 __attribute__((ext_vector_type(4)));
typedef GAS unsigned gu32;
#define RLX_AGENT __ATOMIC_RELAXED, __HIP_MEMORY_SCOPE_AGENT
#define LDS_WAIT() asm volatile("s_waitcnt lgkmcnt(0)" ::: "memory")
#define VM_WAIT() asm volatile("s_waitcnt vmcnt(0)" ::: "memory")
__device__ __forceinline__ unsigned f2bf(float f) { unsigned u = __builtin_bit_cast(unsigned, f); return (u + 0x7fffu + ((u >> 16) & 1u)) >> 16; }
__device__ __forceinline__ unsigned pk2(float lo, float hi) { return f2bf(lo) | (f2bf(hi) << 16); }
__device__ __forceinline__ float bf2f(unsigned short b) { return __builtin_bit_cast(float, (unsigned)b << 16); }
__device__ __forceinline__ float bflo(unsigned w) { return __builtin_bit_cast(float, w << 16); }
__device__ __forceinline__ float bfhi(unsigned w) { return __builtin_bit_cast(float, w & 0xffff0000u); }
__device__ __forceinline__ float silu_f(float z) { return z / (1.0f + __expf(-z)); }
__device__ __forceinline__ float sigmoid_f(float z) { return 1.0f / (1.0f + __expf(-z)); }

#define XB_TMO      128
#define XB_XCNT(j)  (256  + 64 * (j))
#define XB_XSUB(j)  (1280 + 64 * (j))
#define XB_XGEN(j)  (2304 + 64 * (j))
#define XB_TOP      3328
#define XB_TOPGEN   3392
#define XCD_BAR_WORDS 3456
#define XB_SPIN_CAP (1u << 18)

__device__ __forceinline__ unsigned xb_ld(unsigned* p)              { return __hip_atomic_load(p, __ATOMIC_RELAXED, __HIP_MEMORY_SCOPE_AGENT); }
__device__ __forceinline__ unsigned xb_add(unsigned* p, unsigned v) { return __hip_atomic_fetch_add(p, v, __ATOMIC_RELAXED, __HIP_MEMORY_SCOPE_AGENT); }
__device__ __forceinline__ unsigned xb_xcc_id() { return (unsigned)__builtin_amdgcn_s_getreg((3 << 11) | 20) & 0xFu; }
#define XB_SPIN(cond, bar) do { unsigned _sp = 0; while (cond) { __builtin_amdgcn_s_sleep(1); \
    if ((++_sp & 255u) == 0u) { if (xb_ld(&(bar)[XB_TMO])) break; if (_sp > XB_SPIN_CAP) { atomicAdd(&(bar)[XB_TMO], 1u); break; } } } } while (0)

struct XcdBarrier {
    unsigned* bar; unsigned x;
    volatile LAS unsigned* st;
};

__device__ __forceinline__ XcdBarrier xcd_barrier_post(unsigned* bar, volatile LAS unsigned* st) {
    XcdBarrier b; b.bar = bar; b.x = xb_xcc_id(); b.st = st;
    if (threadIdx.x == 0) (void)xb_add(&bar[XB_XCNT(b.x)], 1u);
    return b;
}
__device__ __forceinline__ void xcd_barrier_complete(unsigned* bar, unsigned x, unsigned& nloc, unsigned& nx) {
    const unsigned G = gridDim.x * gridDim.y * gridDim.z;
    unsigned sum, cnt, mine, sp = 0u;
    for (;;) {
        sum = 0u; cnt = 0u; mine = 0u;
#pragma unroll
        for (unsigned j = 0; j < 16; ++j) { const unsigned c = xb_ld(&bar[XB_XCNT(j)]); sum += c; cnt += (c > 0u) ? 1u : 0u; mine = (j == x) ? c : mine; }
        if (sum == G) break;
        __builtin_amdgcn_s_sleep(1);
        if ((++sp & 255u) == 0u) { if (xb_ld(&bar[XB_TMO])) break; if (sp > XB_SPIN_CAP) { atomicAdd(&bar[XB_TMO], 1u); break; } }
    }
    nloc = mine > 0u ? mine : 1u; nx = cnt > 0u ? cnt : 1u;
}

__device__ __forceinline__ void xcd_barrier(const XcdBarrier& b) {
    asm volatile("s_waitcnt vmcnt(0)" ::: "memory");
    __syncthreads();
    if (threadIdx.x == 0) {
        unsigned* bar = b.bar;
        __builtin_amdgcn_s_waitcnt(0);
        unsigned nloc = b.st[0], nx = b.st[1];
        if (nloc == 0u) { xcd_barrier_complete(bar, b.x, nloc, nx); b.st[0] = nloc; b.st[1] = nx; }
        const unsigned old = xb_add(&bar[XB_XSUB(b.x)], 1u);
        const unsigned gen = old / nloc;
        if (old + 1u == (gen + 1u) * nloc) {
            __builtin_amdgcn_fence(__ATOMIC_RELEASE, "agent");
            asm volatile("s_waitcnt vmcnt(0)" ::: "memory");
            const unsigned og = xb_add(&bar[XB_TOP], 1u);
            const unsigned tg = og / nx;
            if (og + 1u == (tg + 1u) * nx) xb_add(&bar[XB_TOPGEN], 1u);
            else XB_SPIN(xb_ld(&bar[XB_TOPGEN]) == tg, bar);
            __builtin_amdgcn_fence(__ATOMIC_ACQUIRE, "agent");
            xb_add(&bar[XB_XGEN(b.x)], 1u);
            asm volatile("s_waitcnt vmcnt(0)" ::: "memory");
        } else {
            XB_SPIN(xb_ld(&bar[XB_XGEN(b.x)]) == gen, bar);
            __builtin_amdgcn_fence(__ATOMIC_ACQUIRE, "agent");
            asm volatile("s_waitcnt vmcnt(0)" ::: "memory");
        }
    }
    __syncthreads();
}


struct Frame {
    LAS unsigned char* lds;
    volatile LAS unsigned* MISC;
    gu32* ctl;
    int vcu, G;
    const float* x; float* out;
    const float *norm_w, *w_in, *lb_logits, *hg_norm_w, *q_norm_w, *k_norm_w, *w_out;
    bf16 *WIN, *WOUT, *XB, *MIXED, *PROJ;
    float *LB, *KMEAN, *ROWSS;
};

__device__ __forceinline__ float wave_sum(float v) {
#pragma unroll
    for (int o = 1; o < 64; o <<= 1) v += __shfl_xor(v, o);
    return v;
}
__device__ __forceinline__ void p0_transpose_item(const float* W, int K, int N, bf16* WT, const float* kscale, LAS float* scr, int item, int lane) {
    const int nblk = N / 32, kb = item / nblk, nb = item % nblk, k0 = 64 * kb, n0 = 32 * nb;
#pragma unroll 8
    for (int i = 0; i < 32; ++i) { const int kk = 2 * i + (lane >> 5); const float s = kscale ? kscale[k0 + kk] : 1.0f; scr[kk * 33 + (lane & 31)] = W[(size_t)(k0 + kk) * N + n0 + (lane & 31)] * s; }
    LDS_WAIT(); asm volatile("" ::: "memory");
    const int c = lane & 7;
#pragma unroll
    for (int j = 0; j < 4; ++j) { const int n = (lane >> 3) + 8 * j; const LAS float* s = scr + (8 * c) * 33 + n;
        v4u o; o.x = pk2(s[0 * 33], s[1 * 33]); o.y = pk2(s[2 * 33], s[3 * 33]); o.z = pk2(s[4 * 33], s[5 * 33]); o.w = pk2(s[6 * 33], s[7 * 33]);
        *(GAS v4u*)(WT + (size_t)(n0 + n) * K + k0 + 8 * c) = o; }
    LDS_WAIT(); asm volatile("" ::: "memory");
}
#define PHASE_IDS() int t_ = threadIdx.x; asm volatile("" : "+v"(t_)); const int tid = t_, lane = tid & 63, wave = __builtin_amdgcn_readfirstlane(tid >> 6); (void)lane; (void)wave
__device__ __forceinline__ void p0_prologue(Frame& F) {
    PHASE_IDS();
    LAS float* scr = (LAS float*)(F.lds + RING_OFF + wave * 16384);
    const int gw = F.vcu * NWAVES + wave, NGW = F.G * NWAVES;
    constexpr int I_IN = (DM / 64) * (NIN / 32), I_OUT = (DM / 64) * (DM / 32);
    constexpr int NITEMS = DEPTH * (I_IN + I_OUT);
    for (int it = gw; it < NITEMS; it += NGW) {
        int r = it;
        if (r < DEPTH * I_IN) { const int l = r / I_IN; r -= l * I_IN;
            p0_transpose_item(F.w_in + (size_t)l * DM * NIN, DM, NIN, F.WIN + (size_t)l * NIN * DM, F.norm_w + l * DM, scr, r, lane); continue; }
        r -= DEPTH * I_IN; { const int l = r / I_OUT; r -= l * I_OUT;
            p0_transpose_item(F.w_out + (size_t)l * DM * DM, DM, DM, F.WOUT + (size_t)l * DM * DM, nullptr, scr, r, lane); }
    }
    for (int m = gw; m < MTOK; m += NGW) {
        const GAS f32x4* xr = (const GAS f32x4*)(F.x + (size_t)m * DM) + lane;
        f32x4 v[4]; float s = 0.f;
#pragma unroll
        for (int j = 0; j < 4; ++j) { v[j] = xr[64 * j]; s += (v[j].x * v[j].x + v[j].y * v[j].y) + (v[j].z * v[j].z + v[j].w * v[j].w); }
        s = wave_sum(s);
        GAS unsigned long long* o8 = (GAS unsigned long long*)(F.XB + (size_t)m * DM) + lane;
#pragma unroll
        for (int j = 0; j < 4; ++j) o8[64 * j] = (unsigned long long)pk2(v[j].x, v[j].y) | ((unsigned long long)pk2(v[j].z, v[j].w) << 32);
        if (lane < 16) F.ROWSS[(size_t)m * 16 + lane] = (lane == 0) ? s : 0.f;
    }
    if (blockIdx.x == 0) { const int c = tid; const float a0 = F.lb_logits[c], a1 = F.lb_logits[512 + c]; const float mx = fmaxf(a0, a1);
        const float e0 = expf(a0 - mx), e1 = expf(a1 - mx); const float p0 = e0 / (e0 + e1), p1 = e1 / (e0 + e1);
        F.LB[c] = 0.f; F.LB[512 + c] = fminf(fmaxf((p0 + p1) - p0, 0.f), 1.0f - 1e-6f); }
}

__device__ __forceinline__ void kmean_phase(Frame& F, int l) {
    PHASE_IDS();
    LAS float* rs = (LAS float*)(F.lds + RING_OFF);
    const int t = tid;
    for (int it = F.vcu; it < 128; it += F.G) {
        const size_t row0 = (size_t)it * 256;
        const int sub = t & 7;
        for (int pp = t >> 3; pp < 2048; pp += 64) { const int row = pp >> 3, h = pp & 7;
            const v4u w = *(const GAS v4u*)(F.PROJ + (row0 + row) * NIN + C_AK + h * 64 + sub * 8);
            float ss = 0.f;
#pragma unroll
            for (int e = 0; e < 4; ++e) { const float a = bflo(w[e]), b = bfhi(w[e]); ss += a * a + b * b; }
            ss += __shfl_xor(ss, 1); ss += __shfl_xor(ss, 2); ss += __shfl_xor(ss, 4);
            if (sub == 0) rs[row * 8 + h] = 1.0f / sqrtf(ss * (1.0f / 64.0f) + NORM_EPS); }
        __syncthreads();
        { const int c = t; float sum = 0.f; const GAS bf16* kp = (const GAS bf16*)(F.PROJ + row0 * NIN + C_AK + c);
            for (int row = 0; row < 256; ++row) sum += bf2f(kp[(size_t)row * NIN]) * rs[row * 8 + (c >> 6)];
            F.KMEAN[(size_t)it * 512 + c] = sum * F.k_norm_w[l * 64 + (c & 63)] * (1.0f / 256.0f); }
        __syncthreads();
    }
}

__device__ __forceinline__ void hgrn_naive_phase(Frame& F, int l) {
    LAS float* qs = (LAS float*)(F.lds + RING_OFF);
    LAS float* fs = qs + 2048; LAS float* ks = fs + 2048; LAS float* is = ks + 2048; LAS float* gs = is + 2048;
    LAS float* op = gs + 2048;
    PHASE_IDS();
    const int t = tid, dv = t & 127, dq = t >> 7;
    for (int it = F.vcu; it < 64; it += F.G) {
        const int b = it >> 2, h = it & 3;
        float S[32];
#pragma unroll
        for (int r = 0; r < 32; ++r) S[r] = 0.f;
        for (int g = 0; g < 128; ++g) {
#pragma unroll
            for (int j = 0; j < 4; ++j) { const int idx = t + 512 * j, tt = idx >> 7, d = idx & 127;
                const GAS bf16* base = (const GAS bf16*)(F.PROJ + ((size_t)b * SEQ + g * 16 + tt) * NIN + h * 128 + d);
                const float zq = bf2f(base[C_HQ]), zf = bf2f(base[C_HF]), zi = bf2f(base[C_HI]), zg = bf2f(base[C_HG]);
                const float lbv = F.LB[l * 512 + h * 128 + d]; const float f = lbv + (1.0f - lbv) * sigmoid_f(zf);
                qs[idx] = silu_f(zq); fs[idx] = f; ks[idx] = 1.0f - f; is[idx] = zi; gs[idx] = silu_f(zg); }
            __syncthreads();
            for (int tt = 0; tt < 16; ++tt) { const float iv = is[tt * 128 + dv]; float part = 0.f;
                const LAS float* fp = fs + tt * 128 + 32 * dq; const LAS float* kp = ks + tt * 128 + 32 * dq; const LAS float* qp = qs + tt * 128 + 32 * dq;
#pragma unroll
                for (int r = 0; r < 32; ++r) { S[r] = fp[r] * S[r] + kp[r] * iv; part += S[r] * qp[r]; }
                op[(tt * 4 + dq) * 128 + dv] = part; }
            __syncthreads();
#pragma unroll
            for (int e = 0; e < 2; ++e) { const int tt = 2 * wave + e; float o0 = 0.f, o1 = 0.f;
#pragma unroll
                for (int q4 = 0; q4 < 4; ++q4) { o0 += op[(tt * 4 + q4) * 128 + lane]; o1 += op[(tt * 4 + q4) * 128 + lane + 64]; }
                const float ss = wave_sum(o0 * o0 + o1 * o1); const float rstd = 1.0f / sqrtf(ss * (1.0f / 128.0f) + NORM_EPS);
                GAS bf16* mo = (GAS bf16*)(F.MIXED + ((size_t)b * SEQ + g * 16 + tt) * DM + h * 128);
                mo[lane] = (bf16)f2bf(o0 * rstd * F.hg_norm_w[l * 128 + lane] * gs[tt * 128 + lane]);
                mo[lane + 64] = (bf16)f2bf(o1 * rstd * F.hg_norm_w[l * 128 + lane + 64] * gs[tt * 128 + lane + 64]); }
            __syncthreads();
        }
    }
}

__device__ __forceinline__ void moba_naive_phase(Frame& F, int l) {
    LAS float* Ks = (LAS float*)(F.lds + RING_OFF);
    LAS float* Vs = Ks + 16384;
    LAS float* km = (LAS float*)(F.lds + EXTRA_OFF);
    PHASE_IDS();
    const int t = tid, tql = t & 255, half = t >> 8, wq = (t & 255) >> 6;
    for (int it = F.vcu; it < 1024; it += F.G) {
        const int rnd = it >> 8, v = it & 255;
        const int hf2 = v >> 7, bh = v & 127;
        const int qb = (rnd == 0) ? (hf2 ? 6 : 7) : (rnd == 1) ? (hf2 ? 1 : 0) : (rnd == 2) ? (hf2 ? 4 : 5) : (hf2 ? 3 : 2);
        const int b = bh >> 3, h = bh & 7; const size_t rowbase = (size_t)b * SEQ; const int tq = qb * 256 + tql;
        const float slope = exp2f(-(float)(h + 1));
        float q[64];
        { const GAS v4u* qp = (const GAS v4u*)(F.PROJ + (rowbase + tq) * NIN + C_AQ + h * 64); float ss = 0.f;
#pragma unroll
            for (int c = 0; c < 8; ++c) { const v4u w = qp[c];
#pragma unroll
                for (int e = 0; e < 4; ++e) { q[c * 8 + 2 * e] = bflo(w[e]); q[c * 8 + 2 * e + 1] = bfhi(w[e]); ss += q[c * 8 + 2 * e] * q[c * 8 + 2 * e] + q[c * 8 + 2 * e + 1] * q[c * 8 + 2 * e + 1]; } }
            const float rstd = 1.0f / sqrtf(ss * (1.0f / 64.0f) + NORM_EPS) * 0.125f;
#pragma unroll
            for (int d = 0; d < 64; ++d) q[d] *= rstd * F.q_norm_w[l * 64 + d]; }
        if (t < qb * 64) km[t] = F.KMEAN[((size_t)b * 8 + (t >> 6)) * 512 + h * 64 + (t & 63)];
        __syncthreads();
        unsigned selmask = 0;
        { float gt[7];
#pragma unroll
            for (int j = 0; j < 7; ++j) { float s = 0.f; if (j < qb) {
#pragma unroll
                    for (int d = 0; d < 64; ++d) s += q[d] * km[j * 64 + d]; } gt[j] = s; }
#pragma unroll
            for (int j = 0; j < 7; ++j) { int rank = 0;
#pragma unroll
                for (int i = 0; i < 7; ++i) if (i != j && i < qb) rank += (gt[i] > gt[j] || (gt[i] == gt[j] && i < j)) ? 1 : 0;
                if (j < qb && rank < 3) selmask |= 1u << j; } }
        float mrun = -1e30f, lrun = 0.f; float acc[64];
#pragma unroll
        for (int d = 0; d < 64; ++d) acc[d] = 0.f;
        for (int j = 0; j <= qb; ++j) {
            __syncthreads();
            { const int sub = t & 7;
                for (int r = t >> 3; r < 256; r += 64) {
                    const size_t grow = (rowbase + j * 256 + r) * NIN + h * 64 + sub * 8;
                    const v4u kw = *(const GAS v4u*)(F.PROJ + grow + C_AK); const v4u vw = *(const GAS v4u*)(F.PROJ + grow + C_AV);
                    float kf[8], vf[8]; float ss = 0.f;
#pragma unroll
                    for (int e = 0; e < 4; ++e) { kf[2 * e] = bflo(kw[e]); kf[2 * e + 1] = bfhi(kw[e]); vf[2 * e] = bflo(vw[e]); vf[2 * e + 1] = bfhi(vw[e]); ss += kf[2 * e] * kf[2 * e] + kf[2 * e + 1] * kf[2 * e + 1]; }
                    ss += __shfl_xor(ss, 1); ss += __shfl_xor(ss, 2); ss += __shfl_xor(ss, 4);
                    const float rstd = 1.0f / sqrtf(ss * (1.0f / 64.0f) + NORM_EPS);
#pragma unroll
                    for (int e = 0; e < 8; ++e) { Ks[r * 64 + sub * 8 + e] = kf[e] * rstd * F.k_norm_w[l * 64 + sub * 8 + e]; Vs[r * 64 + sub * 8 + e] = vf[e]; } } }
            __syncthreads();
            const bool own = (j == qb); const bool act = own || ((selmask >> j) & 1u);
            const int k0 = half * 128; int k1 = k0 + 128; if (own) { const int lim = 64 * wq + 64; k1 = k1 < lim ? k1 : lim; }
            for (int kk = k0; kk < k1; ++kk) {
                const LAS f32x4* kr = (const LAS f32x4*)(Ks + kk * 64); float s = 0.f;
#pragma unroll
                for (int d4 = 0; d4 < 16; ++d4) { const f32x4 kv = kr[d4]; s += (q[4 * d4] * kv.x + q[4 * d4 + 1] * kv.y) + (q[4 * d4 + 2] * kv.z + q[4 * d4 + 3] * kv.w); }
                const int tk = j * 256 + kk; s -= slope * (float)(tq - tk);
                const bool valid = act && (!own || kk <= tql);
                if (valid) { const float mn = fmaxf(mrun, s); const float corr = __expf(mrun - mn), p = __expf(s - mn);
                    lrun = lrun * corr + p; mrun = mn;
                    const LAS f32x4* vr = (const LAS f32x4*)(Vs + kk * 64);
#pragma unroll
                    for (int d4 = 0; d4 < 16; ++d4) { const f32x4 vv = vr[d4];
                        acc[4 * d4] = acc[4 * d4] * corr + p * vv.x; acc[4 * d4 + 1] = acc[4 * d4 + 1] * corr + p * vv.y;
                        acc[4 * d4 + 2] = acc[4 * d4 + 2] * corr + p * vv.z; acc[4 * d4 + 3] = acc[4 * d4 + 3] * corr + p * vv.w; } }
            }
        }
        __syncthreads();
        LAS float* mg = Ks;
        if (half == 1) { mg[tql * 66] = mrun; mg[tql * 66 + 1] = lrun;
#pragma unroll
            for (int d = 0; d < 64; ++d) mg[tql * 66 + 2 + d] = acc[d]; }
        __syncthreads();
        if (half == 0) { const float m1 = mg[tql * 66], l1 = mg[tql * 66 + 1]; const float M2 = fmaxf(mrun, m1);
            const float c0 = __expf(mrun - M2), c1 = __expf(m1 - M2); const float inv = 1.0f / (lrun * c0 + l1 * c1);
            const GAS v4u* gp = (const GAS v4u*)(F.PROJ + (rowbase + tq) * NIN + C_AG + h * 64);
            GAS v4u* op = (GAS v4u*)(F.MIXED + (rowbase + tq) * DM + 512 + h * 64);
#pragma unroll
            for (int c = 0; c < 8; ++c) { const v4u gw = gp[c]; v4u ow;
#pragma unroll
                for (int e = 0; e < 4; ++e) { const int d = c * 8 + 2 * e;
                    const float o0 = (acc[d] * c0 + mg[tql * 66 + 2 + d] * c1) * inv * silu_f(bflo(gw[e]));
                    const float o1 = (acc[d + 1] * c0 + mg[tql * 66 + 3 + d] * c1) * inv * silu_f(bfhi(gw[e]));
                    ow[e] = pk2(o0, o1); }
                op[c] = ow; } }
        __syncthreads();
    }
}

struct Args { const float* in[8]; float* out; unsigned char* ws; int ph_lo, ph_hi, li, pad; };
__global__ void __launch_bounds__(NWAVES * 64, 2) fwd(Args args) {
    extern __shared__ __attribute__((aligned(16))) unsigned char lds[];
    Frame F;
    F.lds = (LAS unsigned char*)lds;
    F.MISC = (volatile LAS unsigned*)(F.lds + MISC_OFF);
    F.G = gridDim.x; { const int bx = blockIdx.x; F.vcu = (F.G % 8 == 0) ? (bx % 8) * (F.G / 8) + bx / 8 : bx; }
    unsigned char* ws = args.ws;
    F.ctl = (gu32*)(ws + WS_CTL);
    F.x = args.in[0]; F.norm_w = args.in[1]; F.w_in = args.in[2]; F.lb_logits = args.in[3]; F.hg_norm_w = args.in[4]; F.q_norm_w = args.in[5]; F.k_norm_w = args.in[6]; F.w_out = args.in[7];
    F.out = args.out;
    F.WIN = (bf16*)(ws + WS_WIN); F.WOUT = (bf16*)(ws + WS_WOUT); F.XB = (bf16*)(ws + WS_XB); F.MIXED = (bf16*)(ws + WS_MIXED); F.PROJ = (bf16*)(ws + WS_PROJ);
    F.LB = (float*)(ws + WS_LB); F.KMEAN = (float*)(ws + WS_KMEAN); F.ROWSS = (float*)(ws + WS_ROWSS);
    for (int u = threadIdx.x; u < (LDS_BYTES - LDSCTL_OFF) / 4; u += NWAVES * 64) ((LAS unsigned*)(F.lds + LDSCTL_OFF))[u] = 0u;
    __syncthreads();
    XcdBarrier bar; bar.bar = (unsigned*)(F.ctl + CW_BAR); bar.x = 0; bar.st = nullptr;
    if (N_LAUNCHES == 1) bar = xcd_barrier_post((unsigned*)(F.ctl + CW_BAR), F.MISC + 8);
#define GRID_BAR() do { if (N_LAUNCHES == 1) xcd_barrier(bar); } while (0)
    const int lo = args.ph_lo, hi = args.ph_hi;
#define IN(k) (lo <= (k) && (k) < hi)
#define BOTH(k) (IN(k) && IN((k) + 1))

    if (IN(0)) { p0_prologue(F); if (BOTH(0)) GRID_BAR(); }
    for (int l = 0; l < DEPTH; ++l) {
        const int pb = 1 + 4 * l;
        if (IN(pb)) {
            pg8::Gemm g{F.XB, F.WIN + (size_t)l * NIN * DM, MTOK, NIN, DM}; pg8::StaticOrder S; S.init(MTOK, NIN, F.G, (int)blockIdx.x);
            pg8::EpiProj E{F.PROJ, NIN, F.ROWSS};
            pg8::gemm_phase<pg8::EpiProj, pg8::StaticOrder, true, true>(F.lds + RING_OFF, g, S, E);
            if (BOTH(pb)) GRID_BAR();
        }
        if (IN(pb + 1)) { kmean_phase(F, l); if (BOTH(pb + 1)) GRID_BAR(); }
        if (IN(pb + 2)) { hgrn_naive_phase(F, l); moba_naive_phase(F, l); if (BOTH(pb + 2)) GRID_BAR(); }
        if (IN(pb + 3)) {
            pg8::Gemm g{F.MIXED, F.WOUT + (size_t)l * DM * DM, MTOK, DM, DM}; pg8::StaticOrder S; S.init(MTOK, DM, F.G, (int)blockIdx.x);
            pg8::EpiOut E{l == 0 ? F.x : F.out, F.out, F.XB, F.ROWSS};
            pg8::gemm_phase<pg8::EpiOut, pg8::StaticOrder, true, true>(F.lds + RING_OFF, g, S, E);
            if (pb + 3 < N_PHASES - 1 && BOTH(pb + 3)) GRID_BAR();
        }
    }
#undef IN
#undef BOTH
}

extern "C" void kernel_launch(void* const* d_in, const int* in_sizes, int n_in, void* d_out, int out_size, void* d_ws, size_t ws_size, hipStream_t stream) {
    static int grid = 0;
    if (grid == 0) {
        if (n_in != 8 || in_sizes[0] != MTOK * DM || out_size != MTOK * DM || ws_size < WS_END) { fprintf(stderr, "kernel_launch: unexpected shapes n_in %d in0 %d out %d ws %zu\n", n_in, n_in > 0 ? in_sizes[0] : -1, out_size, ws_size); grid = -1; return; }
        int dev = 0, cus = 0, per_cu = 0;
        if (hipGetDevice(&dev) != hipSuccess || hipDeviceGetAttribute(&cus, hipDeviceAttributeMultiprocessorCount, dev) != hipSuccess) { grid = -1; return; }
        if (hipFuncSetAttribute((const void*)fwd, hipFuncAttributeMaxDynamicSharedMemorySize, LDS_BYTES) != hipSuccess) { fprintf(stderr, "kernel_launch: hipFuncSetAttribute failed\n"); grid = -1; return; }
        if (hipOccupancyMaxActiveBlocksPerMultiprocessor(&per_cu, (const void*)fwd, NWAVES * 64, LDS_BYTES) != hipSuccess || per_cu < 1) fprintf(stderr, "kernel_launch: occupancy query says %d\n", per_cu);
        (void)hipGetLastError();
        grid = cus;
    }
    if (grid < 0) return;
    if (hipMemsetAsync((char*)d_ws + WS_CTL, 0, CTL_ZERO_BYTES, stream) != hipSuccess) return;
    Args a{};
    for (int i = 0; i < 8; ++i) a.in[i] = (const float*)d_in[i];
    a.out = (float*)d_out; a.ws = (unsigned char*)d_ws;
    for (int li = 0; li < N_LAUNCHES; ++li) {
        a.ph_lo = (N_LAUNCHES == 1) ? 0 : li; a.ph_hi = (N_LAUNCHES == 1) ? N_PHASES : li + 1; a.li = li;
        hipLaunchKernelGGL(fwd, dim3(grid), dim3(NWAVES * 64), LDS_BYTES, stream, a);
        const hipError_t le = hipPeekAtLastError();
        if (le != hipSuccess) { fprintf(stderr, "kernel_launch: launch %d failed: %s\n", li, hipGetErrorName(le)); break; }
    }
}
```

```cpp
#include <hip/hip_runtime.h>
#include <cstdio>
#include <cstdint>
namespace pg8 {
#define PG8_LAS __attribute__((address_space(3)))
typedef unsigned short bf16_t;
typedef short bf16x8 __attribute__((ext_vector_type(8)));
typedef float f32x4 __attribute__((ext_vector_type(4)));
typedef unsigned u32x4 __attribute__((ext_vector_type(4)));
typedef unsigned u32x2 __attribute__((ext_vector_type(2)));
constexpr int BM = 256, BK = 64, HALF = 128, HTB = HALF * BK * 2  , STAGE_BYTES = 8 * HTB, NXCD = 8, WGM = 8;

__host__ __device__ __forceinline__ int lds_byte(int r, int c) { const int st = (r >> 4) * 2 + (c >> 5), rr = r & 15, cc = c & 31, ob = rr * 64 + cc * 2; return st * 1024 + (ob ^ (((ob >> 9) & 1) << 5)); }
__host__ __device__ __forceinline__ void stage_rc(int b, int& R, int& C) { const int st = b / 1024, sb = b % 1024, swz = sb ^ (((sb >> 9) & 1) << 5); R = (st >> 1) * 16 + swz / 64; C = (st & 1) * 32 + (swz % 64) / 2; }
__host__ __device__ __forceinline__ int perm32(int rho) { const int n = rho >> 4, i = rho & 15; return 8 * (i >> 2) + 4 * n + (i & 3); }

struct Unit { int pm, pn; };
struct Gemm { const bf16_t* A; const bf16_t* Bt; int M, N, K; };

struct StaticOrder {
    int nM, nN, nwg, G, c;
    __host__ __device__ void init(int M, int N, int G_, int c_) { nM = M / BM; nN = N / BM; nwg = nM * nN; G = G_; c = c_; }
    __host__ __device__ bool next(int i, Unit& u) const {
        const long L = (long)i * G + c; if (L >= nwg) return false;
        int wgid = (int)L; { const int q = nwg / NXCD, r = nwg % NXCD, xcd = wgid % NXCD, off = wgid / NXCD; wgid = (xcd < r ? xcd * (q + 1) : r * (q + 1) + (xcd - r) * q) + off; }
        const int nig = WGM * nN, gid = wgid / nig, fm = gid * WGM, gsz = (nM - fm) < WGM ? (nM - fm) : WGM;
        u.pm = fm + ((wgid % nig) % gsz); u.pn = (wgid % nig) / gsz; return true;
    }
    __device__ __forceinline__ void a_ready(const Unit&) const {}
    __device__ __forceinline__ void done(const Unit&) const {}
};

__device__ __forceinline__ unsigned cvt_pk_bf16(float lo, float hi) { unsigned r; asm volatile("v_cvt_pk_bf16_f32 %0, %1, %2" : "=v"(r) : "v"(lo), "v"(hi)); return r; }


struct EpiProj {
    static constexpr bool PERM = true, AFTER_DRAIN = false;
    bf16_t* O; int ldc; const float* rowss;
    __device__ __forceinline__ void operator()(const f32x4 (&acc)[2][2][4][2], const Unit& u, int wr, int wc, int fr, int fq) const {
        const int row0 = u.pm * BM + wr * 64 + fr; const int col0 = u.pn * BM + wc * 32 + 8 * fq;
#pragma unroll
        for (int ai = 0; ai < 2; ++ai)
#pragma unroll
            for (int m = 0; m < 4; ++m) {
                const int row = row0 + ai * HALF + m * 16;
                const f32x4* rp = (const f32x4*)(rowss + (size_t)row * 16);
                const f32x4 a = rp[0], b = rp[1], c = rp[2], d = rp[3];
                const float ss = ((a[0] + a[1]) + (a[2] + a[3])) + ((b[0] + b[1]) + (b[2] + b[3])) + ((c[0] + c[1]) + (c[2] + c[3])) + ((d[0] + d[1]) + (d[2] + d[3]));
                const float rs = 1.0f / sqrtf(ss * (1.0f / 1024.0f) + 1e-6f);
                bf16_t* rowp = O + (size_t)row * ldc + col0;
#pragma unroll
                for (int bj = 0; bj < 2; ++bj) { const f32x4 v0 = acc[ai][bj][m][0] * rs, v1 = acc[ai][bj][m][1] * rs;
                    u32x4 w; w.x = cvt_pk_bf16(v0[0], v0[1]); w.y = cvt_pk_bf16(v0[2], v0[3]); w.z = cvt_pk_bf16(v1[0], v1[1]); w.w = cvt_pk_bf16(v1[2], v1[3]);
                    *(u32x4*)(rowp + bj * HALF) = w; }
            }
    }
};
struct EpiOut {
    static constexpr bool PERM = false, AFTER_DRAIN = false;
    const float* xres; float* out; bf16_t* xb; float* rowss;
    __device__ __forceinline__ void operator()(const f32x4 (&acc)[2][2][4][2], const Unit& u, int wr, int wc, int fr, int fq) const {
        const int col0 = u.pn * BM + wc * 32 + 4 * fq;
#pragma unroll
        for (int ai = 0; ai < 2; ++ai)
#pragma unroll
            for (int m = 0; m < 4; ++m) {
                const int row = u.pm * BM + ai * HALF + wr * 64 + m * 16 + fr; float ss = 0.f;
#pragma unroll
                for (int bj = 0; bj < 2; ++bj)
#pragma unroll
                    for (int n = 0; n < 2; ++n) { const size_t off = (size_t)row * 1024 + col0 + bj * HALF + n * 16;
                        const f32x4 v = *(const f32x4*)(xres + off) + acc[ai][bj][m][n];
                        *(f32x4*)(out + off) = v; u32x2 w; w.x = cvt_pk_bf16(v[0], v[1]); w.y = cvt_pk_bf16(v[2], v[3]); *(u32x2*)(xb + off) = w;
                        ss += (v[0] * v[0] + v[1] * v[1]) + (v[2] * v[2] + v[3] * v[3]); }
                ss += __shfl_xor(ss, 16); ss += __shfl_xor(ss, 32);
                if (fq == 0) rowss[(size_t)row * 16 + u.pn * 4 + wc] = ss;
            }
    }
};

template <class Epi, class Sched, bool ALIGN_EPI = false, bool SP2 = false>
__device__ __forceinline__ void gemm_phase(PG8_LAS unsigned char* lds, const Gemm g, const Sched& S, const Epi& E) {
    int tid = threadIdx.x; asm volatile("" : "+v"(tid));
    const int wid = __builtin_amdgcn_readfirstlane(tid >> 6), lane = tid & 63, wr = wid >> 2, wc = wid & 3, fr = lane & 15, fq = lane >> 4;
    const int K = g.K, nt = K / BK;
    unsigned voffA[2], voffB[2];
#pragma unroll
    for (int i = 0; i < 2; ++i) { int R, C; stage_rc(tid * 16 + i * 8192, R, C); const int Rb = Epi::PERM ? ((R & ~31) + perm32(R & 31)) : R;
        voffA[i] = (unsigned)(R * K + C) * 2u; voffB[i] = (unsigned)(Rb * K + C) * 2u; }
    const size_t kstep = (size_t)(BK * 2);
    const size_t hstep = (size_t)HALF * K * 2;
    const size_t tstep = 2 * hstep;
    const unsigned ldsw = (unsigned)wid * 1024u;
    const int aoff = lds_byte(wr * 64 + fr, fq * 8), boff = lds_byte(wc * 32 + fr, fq * 8);
#define PG8_SA(b, h) (((b) * 2 + (h)) * HTB)
#define PG8_SB(b, h) ((4 + (b) * 2 + (h)) * HTB)
#define PG8_STAGE(bufoff, gbase, voff) do { _Pragma("unroll") for (int _i = 0; _i < 2; ++_i) \
        __builtin_amdgcn_global_load_lds((const unsigned*)((const char*)(gbase) + (voff)[_i]), (PG8_LAS unsigned*)(lds + (bufoff) + ldsw + _i * 8192), 16, 0, 0); } while (0)
#define PG8_LDA(dst, b, h) do { _Pragma("unroll") for (int m = 0; m < 4; ++m) _Pragma("unroll") for (int k = 0; k < 2; ++k) dst[m][k] = *(const PG8_LAS bf16x8*)(lds + PG8_SA(b, h) + aoff + m * 2048 + k * 1024); } while (0)
#define PG8_LDB(dst, b, h) do { _Pragma("unroll") for (int n = 0; n < 2; ++n) _Pragma("unroll") for (int k = 0; k < 2; ++k) dst[n][k] = *(const PG8_LAS bf16x8*)(lds + PG8_SB(b, h) + boff + n * 2048 + k * 1024); } while (0)
#define PG8_MMA(ai, bj, At, Bt) do { __builtin_amdgcn_s_setprio(1); _Pragma("unroll") for (int m = 0; m < 4; ++m) _Pragma("unroll") for (int n = 0; n < 2; ++n) _Pragma("unroll") for (int k = 0; k < 2; ++k) \
        acc[ai][bj][m][n] = __builtin_amdgcn_mfma_f32_16x16x32_bf16(Bt[n][k], At[m][k], acc[ai][bj][m][n], 0, 0, 0); __builtin_amdgcn_s_setprio(0); } while (0)
#define PG8_WAIT_V(n) asm volatile("s_waitcnt vmcnt(" #n ")" ::: "memory")
#define PG8_WAIT_L(n) asm volatile("s_waitcnt lgkmcnt(" #n ")" ::: "memory")
#define PG8_BAR __builtin_amdgcn_s_barrier()
#define PG8_SCHED __builtin_amdgcn_sched_barrier(0)
    Unit cur, nxt; int ui = 0;
    if (!S.next(0, cur)) return;
    f32x4 acc[2][2][4][2];
#pragma unroll
    for (int a = 0; a < 2; ++a)
#pragma unroll
        for (int b = 0; b < 2; ++b)
#pragma unroll
            for (int m = 0; m < 4; ++m)
#pragma unroll
                for (int n = 0; n < 2; ++n) acc[a][b][m][n] = (f32x4){0.f, 0.f, 0.f, 0.f};
    bf16x8 At[4][2], B0[2][2], B1[2][2];
    const char* cA = (const char*)g.A + (size_t)cur.pm * tstep; const char* cB = (const char*)g.Bt + (size_t)cur.pn * tstep;
    S.a_ready(cur);
    if constexpr (SP2) {
        PG8_STAGE(PG8_SB(0, 0), cB, voffB); PG8_STAGE(PG8_SB(0, 1), cB + hstep, voffB); PG8_STAGE(PG8_SA(0, 0), cA, voffA); PG8_STAGE(PG8_SA(0, 1), cA + hstep, voffA);
        if (wr == 1) PG8_BAR;
        PG8_WAIT_V(2); PG8_BAR;
        PG8_STAGE(PG8_SB(1, 0), cB + kstep, voffB); PG8_STAGE(PG8_SA(1, 0), cA + kstep, voffA); PG8_STAGE(PG8_SB(1, 1), cB + hstep + kstep, voffB);
        PG8_WAIT_V(6); PG8_BAR;
    } else {
        PG8_STAGE(PG8_SB(0, 0), cB, voffB); PG8_STAGE(PG8_SA(0, 0), cA, voffA); PG8_STAGE(PG8_SB(0, 1), cB + hstep, voffB); PG8_STAGE(PG8_SA(0, 1), cA + hstep, voffA);
        if (wr == 1) PG8_BAR;
        PG8_WAIT_V(4); PG8_BAR;
        PG8_STAGE(PG8_SB(1, 0), cB + kstep, voffB); PG8_STAGE(PG8_SA(1, 0), cA + kstep, voffA); PG8_STAGE(PG8_SB(1, 1), cB + hstep + kstep, voffB);
        PG8_WAIT_V(6); PG8_BAR;
    }
    for (;;) {
        const bool has_next = S.next(ui + 1, nxt);
        const char* nA = has_next ? (const char*)g.A + (size_t)nxt.pm * tstep : cA; const char* nB = has_next ? (const char*)g.Bt + (size_t)nxt.pn * tstep : cB;
        for (int t = 0; t < nt; t += 2) {
            const bool last = (t == nt - 2);
            const char* a1 = cA + (size_t)(t + 1) * kstep;
            const char* a2 = last ? nA : cA + (size_t)(t + 2) * kstep; const char* b2 = last ? nB : cB + (size_t)(t + 2) * kstep;
            const char* a3 = a2 + kstep; const char* b3 = b2 + kstep;
            if (last && has_next) S.a_ready(nxt);
            if constexpr (SP2) {
            PG8_LDB(B0, 0, 0); PG8_LDB(B1, 0, 1); PG8_SCHED; PG8_LDA(At, 0, 0); PG8_STAGE(PG8_SA(1, 1), a1 + hstep, voffA);
            PG8_WAIT_V(8); PG8_WAIT_L(0); PG8_BAR; PG8_MMA(0, 0, At, B0); PG8_MMA(0, 1, At, B1); PG8_BAR; PG8_SCHED;
            PG8_LDA(At, 0, 1); PG8_STAGE(PG8_SB(0, 0), b2, voffB); PG8_STAGE(PG8_SB(0, 1), b2 + hstep, voffB); PG8_STAGE(PG8_SA(0, 0), a2, voffA);
            PG8_WAIT_V(8); PG8_WAIT_L(0); PG8_BAR; PG8_MMA(1, 0, At, B0); PG8_MMA(1, 1, At, B1); PG8_BAR; PG8_SCHED;
            PG8_LDB(B0, 1, 0); PG8_LDB(B1, 1, 1); PG8_SCHED; PG8_LDA(At, 1, 0); PG8_STAGE(PG8_SA(0, 1), a2 + hstep, voffA);
            PG8_WAIT_V(8); PG8_WAIT_L(0); PG8_BAR; PG8_MMA(0, 0, At, B0); PG8_MMA(0, 1, At, B1); PG8_BAR; PG8_SCHED;
            PG8_LDA(At, 1, 1); PG8_STAGE(PG8_SB(1, 0), b3, voffB); PG8_STAGE(PG8_SB(1, 1), b3 + hstep, voffB); PG8_STAGE(PG8_SA(1, 0), a3, voffA);
            PG8_WAIT_V(8); PG8_WAIT_L(0); PG8_BAR; PG8_MMA(1, 0, At, B0); PG8_MMA(1, 1, At, B1); PG8_BAR; PG8_SCHED;
            } else {
            PG8_LDB(B0, 0, 0); PG8_SCHED; PG8_LDA(At, 0, 0); PG8_STAGE(PG8_SA(1, 1), a1 + hstep, voffA);
            PG8_WAIT_L(8); PG8_BAR; PG8_WAIT_L(0); PG8_MMA(0, 0, At, B0); PG8_BAR; PG8_SCHED;
            PG8_LDB(B1, 0, 1); PG8_STAGE(PG8_SB(0, 0), b2, voffB);
            PG8_BAR; PG8_WAIT_L(0); PG8_MMA(0, 1, At, B1); PG8_BAR;
            PG8_LDA(At, 0, 1); PG8_STAGE(PG8_SA(0, 0), a2, voffA);
            PG8_BAR; PG8_WAIT_L(0); PG8_MMA(1, 0, At, B0); PG8_BAR; PG8_SCHED;
            PG8_STAGE(PG8_SB(0, 1), b2 + hstep, voffB);
            PG8_WAIT_V(6); PG8_BAR; PG8_MMA(1, 1, At, B1); PG8_BAR;
            PG8_LDB(B0, 1, 0); PG8_SCHED; PG8_LDA(At, 1, 0); PG8_STAGE(PG8_SA(0, 1), a2 + hstep, voffA);
            PG8_WAIT_L(8); PG8_BAR; PG8_WAIT_L(0); PG8_MMA(0, 0, At, B0); PG8_BAR; PG8_SCHED;
            PG8_LDB(B1, 1, 1); PG8_STAGE(PG8_SB(1, 0), b3, voffB);
            PG8_BAR; PG8_WAIT_L(0); PG8_MMA(0, 1, At, B1); PG8_BAR;
            PG8_LDA(At, 1, 1); PG8_STAGE(PG8_SA(1, 0), a3, voffA);
            PG8_BAR; PG8_WAIT_L(0); PG8_MMA(1, 0, At, B0); PG8_BAR; PG8_SCHED;
            PG8_STAGE(PG8_SB(1, 1), b3 + hstep, voffB);
            PG8_WAIT_V(6); PG8_BAR; PG8_MMA(1, 1, At, B1); PG8_BAR;
            }
        }
        if constexpr (ALIGN_EPI) { if (wr == 0) PG8_BAR; }
        if constexpr (!Epi::AFTER_DRAIN) { E(acc, cur, wr, wc, fr, fq); S.done(cur); }
        if (!has_next) break;
#pragma unroll
        for (int a = 0; a < 2; ++a)
#pragma unroll
            for (int b = 0; b < 2; ++b)
#pragma unroll
                for (int m = 0; m < 4; ++m)
#pragma unroll
                    for (int n = 0; n < 2; ++n) acc[a][b][m][n] = (f32x4){0.f, 0.f, 0.f, 0.f};
        cur = nxt; cA = nA; cB = nB; ++ui;
        if constexpr (ALIGN_EPI) { if (wr == 1) PG8_BAR; }
    }
    PG8_WAIT_V(0);
    if constexpr (!ALIGN_EPI) { if (wr == 0) PG8_BAR; }
    PG8_BAR;
    if constexpr (Epi::AFTER_DRAIN) { E.fused(acc, cur, wr, wc, fr, fq, lds, wid, lane); S.done(cur); }
#undef PG8_SA
#undef PG8_SB
#undef PG8_STAGE
#undef PG8_LDA
#undef PG8_LDB
#undef PG8_MMA
#undef PG8_WAIT_V
#undef PG8_WAIT_L
#undef PG8_BAR
#undef PG8_SCHED
}
}


constexpr int NWAVES = 8;
#ifndef MK_N_LAUNCHES
#define MK_N_LAUNCHES 1
#endif
constexpr int N_PHASES = 9;
constexpr int N_LAUNCHES = MK_N_LAUNCHES;

constexpr int BATCH = 16, SEQ = 2048, DM = 1024, DEPTH = 2, MTOK = BATCH * SEQ, NIN = 4096;
constexpr int C_HQ = 0, C_HF = 512, C_HI = 1024, C_HG = 1536, C_AQ = 2048, C_AK = 2560, C_AV = 3072, C_AG = 3584;
constexpr float NORM_EPS = 1e-6f;

constexpr size_t MiB = 1u << 20;
constexpr size_t WS_CTL = 0, CTL_ZERO_BYTES = 1 * MiB;
constexpr size_t WS_WIN = 2 * MiB;
constexpr size_t WS_WOUT = 18 * MiB;
constexpr size_t WS_LB = 22 * MiB;
constexpr size_t WS_KMEAN = 22 * MiB + 65536;
constexpr size_t WS_ROWSS = 24 * MiB;
constexpr size_t WS_XB = 32 * MiB;
constexpr size_t WS_MIXED = 96 * MiB;
constexpr size_t WS_PROJ = 160 * MiB;
constexpr size_t WS_END = 416 * MiB;
constexpr int CW_BAR = 4096;

constexpr int RING_OFF = 0, RING_BYTES = 131072;
constexpr int EXTRA_OFF = RING_BYTES, EXTRA_BYTES = 16384;
constexpr int LDSCTL_OFF = EXTRA_OFF + EXTRA_BYTES, MISC_OFF = LDSCTL_OFF + 320;
constexpr int LDS_BYTES = LDSCTL_OFF + 1024;

#define GAS __attribute__((address_space(1)))
#define LAS __attribute__((address_space(3)))
typedef unsigned short bf16;
typedef unsigned v4u __attribute__((ext_vector_type(4)));
typedef float f32x4 __attribute__((ext_vector_type(4)));
typedef GAS unsigned gu32;
#define RLX_AGENT __ATOMIC_RELAXED, __HIP_MEMORY_SCOPE_AGENT
#define LDS_WAIT() asm volatile("s_waitcnt lgkmcnt(0)" ::: "memory")
#define VM_WAIT() asm volatile("s_waitcnt vmcnt(0)" ::: "memory")
__device__ __forceinline__ unsigned f2bf(float f) { unsigned u = __builtin_bit_cast(unsigned, f); return (u + 0x7fffu + ((u >> 16) & 1u)) >> 16; }
__device__ __forceinline__ unsigned pk2(float lo, float hi) { return f2bf(lo) | (f2bf(hi) << 16); }
__device__ __forceinline__ float bf2f(unsigned short b) { return __builtin_bit_cast(float, (unsigned)b << 16); }
__device__ __forceinline__ float bflo(unsigned w) { return __builtin_bit_cast(float, w << 16); }
__device__ __forceinline__ float bfhi(unsigned w) { return __builtin_bit_cast(float, w & 0xffff0000u); }
__device__ __forceinline__ float silu_f(float z) { return z / (1.0f + __expf(-z)); }
__device__ __forceinline__ float sigmoid_f(float z) { return 1.0f / (1.0f + __expf(-z)); }

#define XB_TMO      128
#define XB_XCNT(j)  (256  + 64 * (j))
#define XB_XSUB(j)  (1280 + 64 * (j))
#define XB_XGEN(j)  (2304 + 64 * (j))
#define XB_TOP      3328
#define XB_TOPGEN   3392
#define XCD_BAR_WORDS 3456
#define XB_SPIN_CAP (1u << 18)

__device__ __forceinline__ unsigned xb_ld(unsigned* p)              { return __hip_atomic_load(p, __ATOMIC_RELAXED, __HIP_MEMORY_SCOPE_AGENT); }
__device__ __forceinline__ unsigned xb_add(unsigned* p, unsigned v) { return __hip_atomic_fetch_add(p, v, __ATOMIC_RELAXED, __HIP_MEMORY_SCOPE_AGENT); }
__device__ __forceinline__ unsigned xb_xcc_id() { return (unsigned)__builtin_amdgcn_s_getreg((3 << 11) | 20) & 0xFu; }
#define XB_SPIN(cond, bar) do { unsigned _sp = 0; while (cond) { __builtin_amdgcn_s_sleep(1); \
    if ((++_sp & 255u) == 0u) { if (xb_ld(&(bar)[XB_TMO])) break; if (_sp > XB_SPIN_CAP) { atomicAdd(&(bar)[XB_TMO], 1u); break; } } } } while (0)

struct XcdBarrier {
    unsigned* bar; unsigned x;
    volatile LAS unsigned* st;
};

__device__ __forceinline__ XcdBarrier xcd_barrier_post(unsigned* bar, volatile LAS unsigned* st) {
    XcdBarrier b; b.bar = bar; b.x = xb_xcc_id(); b.st = st;
    if (threadIdx.x == 0) (void)xb_add(&bar[XB_XCNT(b.x)], 1u);
    return b;
}
__device__ __forceinline__ void xcd_barrier_complete(unsigned* bar, unsigned x, unsigned& nloc, unsigned& nx) {
    const unsigned G = gridDim.x * gridDim.y * gridDim.z;
    unsigned sum, cnt, mine, sp = 0u;
    for (;;) {
        sum = 0u; cnt = 0u; mine = 0u;
#pragma unroll
        for (unsigned j = 0; j < 16; ++j) { const unsigned c = xb_ld(&bar[XB_XCNT(j)]); sum += c; cnt += (c > 0u) ? 1u : 0u; mine = (j == x) ? c : mine; }
        if (sum == G) break;
        __builtin_amdgcn_s_sleep(1);
        if ((++sp & 255u) == 0u) { if (xb_ld(&bar[XB_TMO])) break; if (sp > XB_SPIN_CAP) { atomicAdd(&bar[XB_TMO], 1u); break; } }
    }
    nloc = mine > 0u ? mine : 1u; nx = cnt > 0u ? cnt : 1u;
}

__device__ __forceinline__ void xcd_barrier(const XcdBarrier& b) {
    asm volatile("s_waitcnt vmcnt(0)" ::: "memory");
    __syncthreads();
    if (threadIdx.x == 0) {
        unsigned* bar = b.bar;
        __builtin_amdgcn_s_waitcnt(0);
        unsigned nloc = b.st[0], nx = b.st[1];
        if (nloc == 0u) { xcd_barrier_complete(bar, b.x, nloc, nx); b.st[0] = nloc; b.st[1] = nx; }
        const unsigned old = xb_add(&bar[XB_XSUB(b.x)], 1u);
        const unsigned gen = old / nloc;
        if (old + 1u == (gen + 1u) * nloc) {
            __builtin_amdgcn_fence(__ATOMIC_RELEASE, "agent");
            asm volatile("s_waitcnt vmcnt(0)" ::: "memory");
            const unsigned og = xb_add(&bar[XB_TOP], 1u);
            const unsigned tg = og / nx;
            if (og + 1u == (tg + 1u) * nx) xb_add(&bar[XB_TOPGEN], 1u);
            else XB_SPIN(xb_ld(&bar[XB_TOPGEN]) == tg, bar);
            __builtin_amdgcn_fence(__ATOMIC_ACQUIRE, "agent");
            xb_add(&bar[XB_XGEN(b.x)], 1u);
            asm volatile("s_waitcnt vmcnt(0)" ::: "memory");
        } else {
            XB_SPIN(xb_ld(&bar[XB_XGEN(b.x)]) == gen, bar);
            __builtin_amdgcn_fence(__ATOMIC_ACQUIRE, "agent");
            asm volatile("s_waitcnt vmcnt(0)" ::: "memory");
        }
    }
    __syncthreads();
}


struct Frame {
    LAS unsigned char* lds;
    volatile LAS unsigned* MISC;
    gu32* ctl;
    int vcu, G;
    const float* x; float* out;
    const float *norm_w, *w_in, *lb_logits, *hg_norm_w, *q_norm_w, *k_norm_w, *w_out;
    bf16 *WIN, *WOUT, *XB, *MIXED, *PROJ;
    float *LB, *KMEAN, *ROWSS;
};

__device__ __forceinline__ float wave_sum(float v) {
#pragma unroll
    for (int o = 1; o < 64; o <<= 1) v += __shfl_xor(v, o);
    return v;
}
__device__ __forceinline__ void p0_transpose_item(const float* W, int K, int N, bf16* WT, const float* kscale, LAS float* scr, int item, int lane) {
    const int nblk = N / 32, kb = item / nblk, nb = item % nblk, k0 = 64 * kb, n0 = 32 * nb;
#pragma unroll 8
    for (int i = 0; i < 32; ++i) { const int kk = 2 * i + (lane >> 5); const float s = kscale ? kscale[k0 + kk] : 1.0f; scr[kk * 33 + (lane & 31)] = W[(size_t)(k0 + kk) * N + n0 + (lane & 31)] * s; }
    LDS_WAIT(); asm volatile("" ::: "memory");
    const int c = lane & 7;
#pragma unroll
    for (int j = 0; j < 4; ++j) { const int n = (lane >> 3) + 8 * j; const LAS float* s = scr + (8 * c) * 33 + n;
        v4u o; o.x = pk2(s[0 * 33], s[1 * 33]); o.y = pk2(s[2 * 33], s[3 * 33]); o.z = pk2(s[4 * 33], s[5 * 33]); o.w = pk2(s[6 * 33], s[7 * 33]);
        *(GAS v4u*)(WT + (size_t)(n0 + n) * K + k0 + 8 * c) = o; }
    LDS_WAIT(); asm volatile("" ::: "memory");
}
#define PHASE_IDS() int t_ = threadIdx.x; asm volatile("" : "+v"(t_)); const int tid = t_, lane = tid & 63, wave = __builtin_amdgcn_readfirstlane(tid >> 6); (void)lane; (void)wave
__device__ __forceinline__ void p0_prologue(Frame& F) {
    PHASE_IDS();
    LAS float* scr = (LAS float*)(F.lds + RING_OFF + wave * 16384);
    const int gw = F.vcu * NWAVES + wave, NGW = F.G * NWAVES;
    constexpr int I_IN = (DM / 64) * (NIN / 32), I_OUT = (DM / 64) * (DM / 32);
    constexpr int NITEMS = DEPTH * (I_IN + I_OUT);
    for (int it = gw; it < NITEMS; it += NGW) {
        int r = it;
        if (r < DEPTH * I_IN) { const int l = r / I_IN; r -= l * I_IN;
            p0_transpose_item(F.w_in + (size_t)l * DM * NIN, DM, NIN, F.WIN + (size_t)l * NIN * DM, F.norm_w + l * DM, scr, r, lane); continue; }
        r -= DEPTH * I_IN; { const int l = r / I_OUT; r -= l * I_OUT;
            p0_transpose_item(F.w_out + (size_t)l * DM * DM, DM, DM, F.WOUT + (size_t)l * DM * DM, nullptr, scr, r, lane); }
    }
    for (int m = gw; m < MTOK; m += NGW) {
        const GAS f32x4* xr = (const GAS f32x4*)(F.x + (size_t)m * DM) + lane;
        f32x4 v[4]; float s = 0.f;
#pragma unroll
        for (int j = 0; j < 4; ++j) { v[j] = xr[64 * j]; s += (v[j].x * v[j].x + v[j].y * v[j].y) + (v[j].z * v[j].z + v[j].w * v[j].w); }
        s = wave_sum(s);
        GAS unsigned long long* o8 = (GAS unsigned long long*)(F.XB + (size_t)m * DM) + lane;
#pragma unroll
        for (int j = 0; j < 4; ++j) o8[64 * j] = (unsigned long long)pk2(v[j].x, v[j].y) | ((unsigned long long)pk2(v[j].z, v[j].w) << 32);
        if (lane < 16) F.ROWSS[(size_t)m * 16 + lane] = (lane == 0) ? s : 0.f;
    }
    if (blockIdx.x == 0) { const int c = tid; const float a0 = F.lb_logits[c], a1 = F.lb_logits[512 + c]; const float mx = fmaxf(a0, a1);
        const float e0 = expf(a0 - mx), e1 = expf(a1 - mx); const float p0 = e0 / (e0 + e1), p1 = e1 / (e0 + e1);
        F.LB[c] = 0.f; F.LB[512 + c] = fminf(fmaxf((p0 + p1) - p0, 0.f), 1.0f - 1e-6f); }
}

__device__ __forceinline__ void kmean_phase(Frame& F, int l) {
    PHASE_IDS();
    LAS float* rs = (LAS float*)(F.lds + RING_OFF);
    const int t = tid;
    for (int it = F.vcu; it < 128; it += F.G) {
        const size_t row0 = (size_t)it * 256;
        const int sub = t & 7;
        for (int pp = t >> 3; pp < 2048; pp += 64) { const int row = pp >> 3, h = pp & 7;
            const v4u w = *(const GAS v4u*)(F.PROJ + (row0 + row) * NIN + C_AK + h * 64 + sub * 8);
            float ss = 0.f;
#pragma unroll
            for (int e = 0; e < 4; ++e) { const float a = bflo(w[e]), b = bfhi(w[e]); ss += a * a + b * b; }
            ss += __shfl_xor(ss, 1); ss += __shfl_xor(ss, 2); ss += __shfl_xor(ss, 4);
            if (sub == 0) rs[row * 8 + h] = 1.0f / sqrtf(ss * (1.0f / 64.0f) + NORM_EPS); }
        __syncthreads();
        { const int c = t; float sum = 0.f; const GAS bf16* kp = (const GAS bf16*)(F.PROJ + row0 * NIN + C_AK + c);
            for (int row = 0; row < 256; ++row) sum += bf2f(kp[(size_t)row * NIN]) * rs[row * 8 + (c >> 6)];
            F.KMEAN[(size_t)it * 512 + c] = sum * F.k_norm_w[l * 64 + (c & 63)] * (1.0f / 256.0f); }
        __syncthreads();
    }
}

__device__ __forceinline__ void hgrn_naive_phase(Frame& F, int l) {
    LAS float* qs = (LAS float*)(F.lds + RING_OFF);
    LAS float* fs = qs + 2048; LAS float* ks = fs + 2048; LAS float* is = ks + 2048; LAS float* gs = is + 2048;
    LAS float* op = gs + 2048;
    PHASE_IDS();
    const int t = tid, dv = t & 127, dq = t >> 7;
    for (int it = F.vcu; it < 64; it += F.G) {
        const int b = it >> 2, h = it & 3;
        float S[32];
#pragma unroll
        for (int r = 0; r < 32; ++r) S[r] = 0.f;
        for (int g = 0; g < 128; ++g) {
#pragma unroll
            for (int j = 0; j < 4; ++j) { const int idx = t + 512 * j, tt = idx >> 7, d = idx & 127;
                const GAS bf16* base = (const GAS bf16*)(F.PROJ + ((size_t)b * SEQ + g * 16 + tt) * NIN + h * 128 + d);
                const float zq = bf2f(base[C_HQ]), zf = bf2f(base[C_HF]), zi = bf2f(base[C_HI]), zg = bf2f(base[C_HG]);
                const float lbv = F.LB[l * 512 + h * 128 + d]; const float f = lbv + (1.0f - lbv) * sigmoid_f(zf);
                qs[idx] = silu_f(zq); fs[idx] = f; ks[idx] = 1.0f - f; is[idx] = zi; gs[idx] = silu_f(zg); }
            __syncthreads();
            for (int tt = 0; tt < 16; ++tt) { const float iv = is[tt * 128 + dv]; float part = 0.f;
                const LAS float* fp = fs + tt * 128 + 32 * dq; const LAS float* kp = ks + tt * 128 + 32 * dq; const LAS float* qp = qs + tt * 128 + 32 * dq;
#pragma unroll
                for (int r = 0; r < 32; ++r) { S[r] = fp[r] * S[r] + kp[r] * iv; part += S[r] * qp[r]; }
                op[(tt * 4 + dq) * 128 + dv] = part; }
            __syncthreads();
#pragma unroll
            for (int e = 0; e < 2; ++e) { const int tt = 2 * wave + e; float o0 = 0.f, o1 = 0.f;
#pragma unroll
                for (int q4 = 0; q4 < 4; ++q4) { o0 += op[(tt * 4 + q4) * 128 + lane]; o1 += op[(tt * 4 + q4) * 128 + lane + 64]; }
                const float ss = wave_sum(o0 * o0 + o1 * o1); const float rstd = 1.0f / sqrtf(ss * (1.0f / 128.0f) + NORM_EPS);
                GAS bf16* mo = (GAS bf16*)(F.MIXED + ((size_t)b * SEQ + g * 16 + tt) * DM + h * 128);
                mo[lane] = (bf16)f2bf(o0 * rstd * F.hg_norm_w[l * 128 + lane] * gs[tt * 128 + lane]);
                mo[lane + 64] = (bf16)f2bf(o1 * rstd * F.hg_norm_w[l * 128 + lane + 64] * gs[tt * 128 + lane + 64]); }
            __syncthreads();
        }
    }
}

__device__ __forceinline__ void moba_naive_phase(Frame& F, int l) {
    LAS float* Ks = (LAS float*)(F.lds + RING_OFF);
    LAS float* Vs = Ks + 16384;
    LAS float* km = (LAS float*)(F.lds + EXTRA_OFF);
    PHASE_IDS();
    const int t = tid, tql = t & 255, half = t >> 8, wq = (t & 255) >> 6;
    for (int it = F.vcu; it < 1024; it += F.G) {
        const int rnd = it >> 8, v = it & 255;
        const int hf2 = v >> 7, bh = v & 127;
        const int qb = (rnd == 0) ? (hf2 ? 6 : 7) : (rnd == 1) ? (hf2 ? 1 : 0) : (rnd == 2) ? (hf2 ? 4 : 5) : (hf2 ? 3 : 2);
        const int b = bh >> 3, h = bh & 7; const size_t rowbase = (size_t)b * SEQ; const int tq = qb * 256 + tql;
        const float slope = exp2f(-(float)(h + 1));
        float q[64];
        { const GAS v4u* qp = (const GAS v4u*)(F.PROJ + (rowbase + tq) * NIN + C_AQ + h * 64); float ss = 0.f;
#pragma unroll
            for (int c = 0; c < 8; ++c) { const v4u w = qp[c];
#pragma unroll
                for (int e = 0; e < 4; ++e) { q[c * 8 + 2 * e] = bflo(w[e]); q[c * 8 + 2 * e + 1] = bfhi(w[e]); ss += q[c * 8 + 2 * e] * q[c * 8 + 2 * e] + q[c * 8 + 2 * e + 1] * q[c * 8 + 2 * e + 1]; } }
            const float rstd = 1.0f / sqrtf(ss * (1.0f / 64.0f) + NORM_EPS) * 0.125f;
#pragma unroll
            for (int d = 0; d < 64; ++d) q[d] *= rstd * F.q_norm_w[l * 64 + d]; }
        if (t < qb * 64) km[t] = F.KMEAN[((size_t)b * 8 + (t >> 6)) * 512 + h * 64 + (t & 63)];
        __syncthreads();
        unsigned selmask = 0;
        { float gt[7];
#pragma unroll
            for (int j = 0; j < 7; ++j) { float s = 0.f; if (j < qb) {
#pragma unroll
                    for (int d = 0; d < 64; ++d) s += q[d] * km[j * 64 + d]; } gt[j] = s; }
#pragma unroll
            for (int j = 0; j < 7; ++j) { int rank = 0;
#pragma unroll
                for (int i = 0; i < 7; ++i) if (i != j && i < qb) rank += (gt[i] > gt[j] || (gt[i] == gt[j] && i < j)) ? 1 : 0;
                if (j < qb && rank < 3) selmask |= 1u << j; } }
        float mrun = -1e30f, lrun = 0.f; float acc[64];
#pragma unroll
        for (int d = 0; d < 64; ++d) acc[d] = 0.f;
        for (int j = 0; j <= qb; ++j) {
            __syncthreads();
            { const int sub = t & 7;
                for (int r = t >> 3; r < 256; r += 64) {
                    const size_t grow = (rowbase + j * 256 + r) * NIN + h * 64 + sub * 8;
                    const v4u kw = *(const GAS v4u*)(F.PROJ + grow + C_AK); const v4u vw = *(const GAS v4u*)(F.PROJ + grow + C_AV);
                    float kf[8], vf[8]; float ss = 0.f;
#pragma unroll
                    for (int e = 0; e < 4; ++e) { kf[2 * e] = bflo(kw[e]); kf[2 * e + 1] = bfhi(kw[e]); vf[2 * e] = bflo(vw[e]); vf[2 * e + 1] = bfhi(vw[e]); ss += kf[2 * e] * kf[2 * e] + kf[2 * e + 1] * kf[2 * e + 1]; }
                    ss += __shfl_xor(ss, 1); ss += __shfl_xor(ss, 2); ss += __shfl_xor(ss, 4);
                    const float rstd = 1.0f / sqrtf(ss * (1.0f / 64.0f) + NORM_EPS);
#pragma unroll
                    for (int e = 0; e < 8; ++e) { Ks[r * 64 + sub * 8 + e] = kf[e] * rstd * F.k_norm_w[l * 64 + sub * 8 + e]; Vs[r * 64 + sub * 8 + e] = vf[e]; } } }
            __syncthreads();
            const bool own = (j == qb); const bool act = own || ((selmask >> j) & 1u);
            const int k0 = half * 128; int k1 = k0 + 128; if (own) { const int lim = 64 * wq + 64; k1 = k1 < lim ? k1 : lim; }
            for (int kk = k0; kk < k1; ++kk) {
                const LAS f32x4* kr = (const LAS f32x4*)(Ks + kk * 64); float s = 0.f;
#pragma unroll
                for (int d4 = 0; d4 < 16; ++d4) { const f32x4 kv = kr[d4]; s += (q[4 * d4] * kv.x + q[4 * d4 + 1] * kv.y) + (q[4 * d4 + 2] * kv.z + q[4 * d4 + 3] * kv.w); }
                const int tk = j * 256 + kk; s -= slope * (float)(tq - tk);
                const bool valid = act && (!own || kk <= tql);
                if (valid) { const float mn = fmaxf(mrun, s); const float corr = __expf(mrun - mn), p = __expf(s - mn);
                    lrun = lrun * corr + p; mrun = mn;
                    const LAS f32x4* vr = (const LAS f32x4*)(Vs + kk * 64);
#pragma unroll
                    for (int d4 = 0; d4 < 16; ++d4) { const f32x4 vv = vr[d4];
                        acc[4 * d4] = acc[4 * d4] * corr + p * vv.x; acc[4 * d4 + 1] = acc[4 * d4 + 1] * corr + p * vv.y;
                        acc[4 * d4 + 2] = acc[4 * d4 + 2] * corr + p * vv.z; acc[4 * d4 + 3] = acc[4 * d4 + 3] * corr + p * vv.w; } }
            }
        }
        __syncthreads();
        LAS float* mg = Ks;
        if (half == 1) { mg[tql * 66] = mrun; mg[tql * 66 + 1] = lrun;
#pragma unroll
            for (int d = 0; d < 64; ++d) mg[tql * 66 + 2 + d] = acc[d]; }
        __syncthreads();
        if (half == 0) { const float m1 = mg[tql * 66], l1 = mg[tql * 66 + 1]; const float M2 = fmaxf(mrun, m1);
            const float c0 = __expf(mrun - M2), c1 = __expf(m1 - M2); const float inv = 1.0f / (lrun * c0 + l1 * c1);
            const GAS v4u* gp = (const GAS v4u*)(F.PROJ + (rowbase + tq) * NIN + C_AG + h * 64);
            GAS v4u* op = (GAS v4u*)(F.MIXED + (rowbase + tq) * DM + 512 + h * 64);
#pragma unroll
            for (int c = 0; c < 8; ++c) { const v4u gw = gp[c]; v4u ow;
#pragma unroll
                for (int e = 0; e < 4; ++e) { const int d = c * 8 + 2 * e;
                    const float o0 = (acc[d] * c0 + mg[tql * 66 + 2 + d] * c1) * inv * silu_f(bflo(gw[e]));
                    const float o1 = (acc[d + 1] * c0 + mg[tql * 66 + 3 + d] * c1) * inv * silu_f(bfhi(gw[e]));
                    ow[e] = pk2(o0, o1); }
                op[c] = ow; } }
        __syncthreads();
    }
}

struct Args { const float* in[8]; float* out; unsigned char* ws; int ph_lo, ph_hi, li, pad; };
__global__ void __launch_bounds__(NWAVES * 64, 2) fwd(Args args) {
    extern __shared__ __attribute__((aligned(16))) unsigned char lds[];
    Frame F;
    F.lds = (LAS unsigned char*)lds;
    F.MISC = (volatile LAS unsigned*)(F.lds + MISC_OFF);
    F.G = gridDim.x; { const int bx = blockIdx.x; F.vcu = (F.G % 8 == 0) ? (bx % 8) * (F.G / 8) + bx / 8 : bx; }
    unsigned char* ws = args.ws;
    F.ctl = (gu32*)(ws + WS_CTL);
    F.x = args.in[0]; F.norm_w = args.in[1]; F.w_in = args.in[2]; F.lb_logits = args.in[3]; F.hg_norm_w = args.in[4]; F.q_norm_w = args.in[5]; F.k_norm_w = args.in[6]; F.w_out = args.in[7];
    F.out = args.out;
    F.WIN = (bf16*)(ws + WS_WIN); F.WOUT = (bf16*)(ws + WS_WOUT); F.XB = (bf16*)(ws + WS_XB); F.MIXED = (bf16*)(ws + WS_MIXED); F.PROJ = (bf16*)(ws + WS_PROJ);
    F.LB = (float*)(ws + WS_LB); F.KMEAN = (float*)(ws + WS_KMEAN); F.ROWSS = (float*)(ws + WS_ROWSS);
    for (int u = threadIdx.x; u < (LDS_BYTES - LDSCTL_OFF) / 4; u += NWAVES * 64) ((LAS unsigned*)(F.lds + LDSCTL_OFF))[u] = 0u;
    __syncthreads();
    XcdBarrier bar; bar.bar = (unsigned*)(F.ctl + CW_BAR); bar.x = 0; bar.st = nullptr;
    if (N_LAUNCHES == 1) bar = xcd_barrier_post((unsigned*)(F.ctl + CW_BAR), F.MISC + 8);
#define GRID_BAR() do { if (N_LAUNCHES == 1) xcd_barrier(bar); } while (0)
    const int lo = args.ph_lo, hi = args.ph_hi;
#define IN(k) (lo <= (k) && (k) < hi)
#define BOTH(k) (IN(k) && IN((k) + 1))

    if (IN(0)) { p0_prologue(F); if (BOTH(0)) GRID_BAR(); }
    for (int l = 0; l < DEPTH; ++l) {
        const int pb = 1 + 4 * l;
        if (IN(pb)) {
            pg8::Gemm g{F.XB, F.WIN + (size_t)l * NIN * DM, MTOK, NIN, DM}; pg8::StaticOrder S; S.init(MTOK, NIN, F.G, (int)blockIdx.x);
            pg8::EpiProj E{F.PROJ, NIN, F.ROWSS};
            pg8::gemm_phase<pg8::EpiProj, pg8::StaticOrder, true, true>(F.lds + RING_OFF, g, S, E);
            if (BOTH(pb)) GRID_BAR();
        }
        if (IN(pb + 1)) { kmean_phase(F, l); if (BOTH(pb + 1)) GRID_BAR(); }
        if (IN(pb + 2)) { hgrn_naive_phase(F, l); moba_naive_phase(F, l); if (BOTH(pb + 2)) GRID_BAR(); }
        if (IN(pb + 3)) {
            pg8::Gemm g{F.MIXED, F.WOUT + (size_t)l * DM * DM, MTOK, DM, DM}; pg8::StaticOrder S; S.init(MTOK, DM, F.G, (int)blockIdx.x);
            pg8::EpiOut E{l == 0 ? F.x : F.out, F.out, F.XB, F.ROWSS};
            pg8::gemm_phase<pg8::EpiOut, pg8::StaticOrder, true, true>(F.lds + RING_OFF, g, S, E);
            if (pb + 3 < N_PHASES - 1 && BOTH(pb + 3)) GRID_BAR();
        }
    }
#undef IN
#undef BOTH
}

extern "C" void kernel_launch(void* const* d_in, const int* in_sizes, int n_in, void* d_out, int out_size, void* d_ws, size_t ws_size, hipStream_t stream) {
    static int grid = 0;
    if (grid == 0) {
        if (n_in != 8 || in_sizes[0] != MTOK * DM || out_size != MTOK * DM || ws_size < WS_END) { fprintf(stderr, "kernel_launch: unexpected shapes n_in %d in0 %d out %d ws %zu\n", n_in, n_in > 0 ? in_sizes[0] : -1, out_size, ws_size); grid = -1; return; }
        int dev = 0, cus = 0, per_cu = 0;
        if (hipGetDevice(&dev) != hipSuccess || hipDeviceGetAttribute(&cus, hipDeviceAttributeMultiprocessorCount, dev) != hipSuccess) { grid = -1; return; }
        if (hipFuncSetAttribute((const void*)fwd, hipFuncAttributeMaxDynamicSharedMemorySize, LDS_BYTES) != hipSuccess) { fprintf(stderr, "kernel_launch: hipFuncSetAttribute failed\n"); grid = -1; return; }
        if (hipOccupancyMaxActiveBlocksPerMultiprocessor(&per_cu, (const void*)fwd, NWAVES * 64, LDS_BYTES) != hipSuccess || per_cu < 1) fprintf(stderr, "kernel_launch: occupancy query says %d\n", per_cu);
        (void)hipGetLastError();
        if (per_cu < 1) { grid = -1; return; }
        grid = cus;
    }
    if (grid < 0) return;
    if (hipMemsetAsync((char*)d_ws + WS_CTL, 0, CTL_ZERO_BYTES, stream) != hipSuccess) return;
    Args a{};
    for (int i = 0; i < 8; ++i) a.in[i] = (const float*)d_in[i];
    a.out = (float*)d_out; a.ws = (unsigned char*)d_ws;
    for (int li = 0; li < N_LAUNCHES; ++li) {
        a.ph_lo = (N_LAUNCHES == 1) ? 0 : li; a.ph_hi = (N_LAUNCHES == 1) ? N_PHASES : li + 1; a.li = li;
        hipError_t le;
        if (N_LAUNCHES == 1) { void* kargs[] = {(void*)&a}; le = hipLaunchCooperativeKernel((const void*)fwd, dim3(grid), dim3(NWAVES * 64), kargs, LDS_BYTES, stream); }
        else { hipLaunchKernelGGL(fwd, dim3(grid), dim3(NWAVES * 64), LDS_BYTES, stream, a); le = hipPeekAtLastError(); }
        if (le != hipSuccess) { fprintf(stderr, "kernel_launch: launch %d failed: %s\n", li, hipGetErrorName(le)); break; }
    }
}
```

```cpp
#include <hip/hip_runtime.h>
#include <cstdio>
#include <cstdint>
namespace pg8 {
#define PG8_LAS __attribute__((address_space(3)))
typedef unsigned short bf16_t;
typedef short bf16x8 __attribute__((ext_vector_type(8)));
typedef float f32x4 __attribute__((ext_vector_type(4)));
typedef unsigned u32x4 __attribute__((ext_vector_type(4)));
typedef unsigned u32x2 __attribute__((ext_vector_type(2)));
constexpr int BM = 256, BK = 64, HALF = 128, HTB = HALF * BK * 2  , STAGE_BYTES = 8 * HTB, NXCD = 8, WGM = 8;

__host__ __device__ __forceinline__ int lds_byte(int r, int c) { const int st = (r >> 4) * 2 + (c >> 5), rr = r & 15, cc = c & 31, ob = rr * 64 + cc * 2; return st * 1024 + (ob ^ (((ob >> 9) & 1) << 5)); }
__host__ __device__ __forceinline__ void stage_rc(int b, int& R, int& C) { const int st = b / 1024, sb = b % 1024, swz = sb ^ (((sb >> 9) & 1) << 5); R = (st >> 1) * 16 + swz / 64; C = (st & 1) * 32 + (swz % 64) / 2; }
__host__ __device__ __forceinline__ int perm32(int rho) { const int n = rho >> 4, i = rho & 15; return 8 * (i >> 2) + 4 * n + (i & 3); }

struct Unit { int pm, pn; };
struct Gemm { const bf16_t* A; const bf16_t* Bt; int M, N, K; };

struct StaticOrder {
    int nM, nN, nwg, G, c;
    __host__ __device__ void init(int M, int N, int G_, int c_) { nM = M / BM; nN = N / BM; nwg = nM * nN; G = G_; c = c_; }
    __host__ __device__ bool next(int i, Unit& u) const {
        const long L = (long)i * G + c; if (L >= nwg) return false;
        int wgid = (int)L; { const int q = nwg / NXCD, r = nwg % NXCD, xcd = wgid % NXCD, off = wgid / NXCD; wgid = (xcd < r ? xcd * (q + 1) : r * (q + 1) + (xcd - r) * q) + off; }
        const int nig = WGM * nN, gid = wgid / nig, fm = gid * WGM, gsz = (nM - fm) < WGM ? (nM - fm) : WGM;
        u.pm = fm + ((wgid % nig) % gsz); u.pn = (wgid % nig) / gsz; return true;
    }
    __device__ __forceinline__ void a_ready(const Unit&) const {}
    __device__ __forceinline__ void done(const Unit&) const {}
};

__device__ __forceinline__ unsigned cvt_pk_bf16(float lo, float hi) { unsigned r; asm volatile("v_cvt_pk_bf16_f32 %0, %1, %2" : "=v"(r) : "v"(lo), "v"(hi)); return r; }


struct EpiProj {
    static constexpr bool PERM = true, AFTER_DRAIN = false;
    bf16_t* O; int ldc; const float* rowss;
    __device__ __forceinline__ void operator()(const f32x4 (&acc)[2][2][4][2], const Unit& u, int wr, int wc, int fr, int fq) const {
        const int row0 = u.pm * BM + wr * 64 + fr; const int col0 = u.pn * BM + wc * 32 + 8 * fq;
#pragma unroll
        for (int ai = 0; ai < 2; ++ai)
#pragma unroll
            for (int m = 0; m < 4; ++m) {
                const int row = row0 + ai * HALF + m * 16;
                const f32x4* rp = (const f32x4*)(rowss + (size_t)row * 16);
                const f32x4 a = rp[0], b = rp[1], c = rp[2], d = rp[3];
                const float ss = ((a[0] + a[1]) + (a[2] + a[3])) + ((b[0] + b[1]) + (b[2] + b[3])) + ((c[0] + c[1]) + (c[2] + c[3])) + ((d[0] + d[1]) + (d[2] + d[3]));
                const float rs = 1.0f / sqrtf(ss * (1.0f / 1024.0f) + 1e-6f);
                bf16_t* rowp = O + (size_t)row * ldc + col0;
#pragma unroll
                for (int bj = 0; bj < 2; ++bj) { const f32x4 v0 = acc[ai][bj][m][0] * rs, v1 = acc[ai][bj][m][1] * rs;
                    u32x4 w; w.x = cvt_pk_bf16(v0[0], v0[1]); w.y = cvt_pk_bf16(v0[2], v0[3]); w.z = cvt_pk_bf16(v1[0], v1[1]); w.w = cvt_pk_bf16(v1[2], v1[3]);
                    *(u32x4*)(rowp + bj * HALF) = w; }
            }
    }
};
struct EpiOut {
    static constexpr bool PERM = false, AFTER_DRAIN = false;
    const float* xres; float* out; bf16_t* xb; float* rowss;
    __device__ __forceinline__ void operator()(const f32x4 (&acc)[2][2][4][2], const Unit& u, int wr, int wc, int fr, int fq) const {
        const int col0 = u.pn * BM + wc * 32 + 4 * fq;
#pragma unroll
        for (int ai = 0; ai < 2; ++ai)
#pragma unroll
            for (int m = 0; m < 4; ++m) {
                const int row = u.pm * BM + ai * HALF + wr * 64 + m * 16 + fr; float ss = 0.f;
#pragma unroll
                for (int bj = 0; bj < 2; ++bj)
#pragma unroll
                    for (int n = 0; n < 2; ++n) { const size_t off = (size_t)row * 1024 + col0 + bj * HALF + n * 16;
                        const f32x4 v = *(const f32x4*)(xres + off) + acc[ai][bj][m][n];
                        *(f32x4*)(out + off) = v; u32x2 w; w.x = cvt_pk_bf16(v[0], v[1]); w.y = cvt_pk_bf16(v[2], v[3]); *(u32x2*)(xb + off) = w;
                        ss += (v[0] * v[0] + v[1] * v[1]) + (v[2] * v[2] + v[3] * v[3]); }
                ss += __shfl_xor(ss, 16); ss += __shfl_xor(ss, 32);
                if (fq == 0) rowss[(size_t)row * 16 + u.pn * 4 + wc] = ss;
            }
    }
};

template <class Epi, class Sched, bool ALIGN_EPI = false, bool SP2 = false>
__device__ __forceinline__ void gemm_phase(PG8_LAS unsigned char* lds, const Gemm g, const Sched& S, const Epi& E) {
    int tid = threadIdx.x; asm volatile("" : "+v"(tid));
    const int wid = __builtin_amdgcn_readfirstlane(tid >> 6), lane = tid & 63, wr = wid >> 2, wc = wid & 3, fr = lane & 15, fq = lane >> 4;
    const int K = g.K, nt = K / BK;
    unsigned voffA[2], voffB[2];
#pragma unroll
    for (int i = 0; i < 2; ++i) { int R, C; stage_rc(tid * 16 + i * 8192, R, C); const int Rb = Epi::PERM ? ((R & ~31) + perm32(R & 31)) : R;
        voffA[i] = (unsigned)(R * K + C) * 2u; voffB[i] = (unsigned)(Rb * K + C) * 2u; }
    const size_t kstep = (size_t)(BK * 2);
    const size_t hstep = (size_t)HALF * K * 2;
    const size_t tstep = 2 * hstep;
    const unsigned ldsw = (unsigned)wid * 1024u;
    const int aoff = lds_byte(wr * 64 + fr, fq * 8), boff = lds_byte(wc * 32 + fr, fq * 8);
#define PG8_SA(b, h) (((b) * 2 + (h)) * HTB)
#define PG8_SB(b, h) ((4 + (b) * 2 + (h)) * HTB)
#define PG8_STAGE(bufoff, gbase, voff) do { _Pragma("unroll") for (int _i = 0; _i < 2; ++_i) \
        __builtin_amdgcn_global_load_lds((const unsigned*)((const char*)(gbase) + (voff)[_i]), (PG8_LAS unsigned*)(lds + (bufoff) + ldsw + _i * 8192), 16, 0, 0); } while (0)
#define PG8_LDA(dst, b, h) do { _Pragma("unroll") for (int m = 0; m < 4; ++m) _Pragma("unroll") for (int k = 0; k < 2; ++k) dst[m][k] = *(const PG8_LAS bf16x8*)(lds + PG8_SA(b, h) + aoff + m * 2048 + k * 1024); } while (0)
#define PG8_LDB(dst, b, h) do { _Pragma("unroll") for (int n = 0; n < 2; ++n) _Pragma("unroll") for (int k = 0; k < 2; ++k) dst[n][k] = *(const PG8_LAS bf16x8*)(lds + PG8_SB(b, h) + boff + n * 2048 + k * 1024); } while (0)
#define PG8_MMA(ai, bj, At, Bt) do { __builtin_amdgcn_s_setprio(1); _Pragma("unroll") for (int m = 0; m < 4; ++m) _Pragma("unroll") for (int n = 0; n < 2; ++n) _Pragma("unroll") for (int k = 0; k < 2; ++k) \
        acc[ai][bj][m][n] = __builtin_amdgcn_mfma_f32_16x16x32_bf16(Bt[n][k], At[m][k], acc[ai][bj][m][n], 0, 0, 0); __builtin_amdgcn_s_setprio(0); } while (0)
#define PG8_WAIT_V(n) asm volatile("s_waitcnt vmcnt(" #n ")" ::: "memory")
#define PG8_WAIT_L(n) asm volatile("s_waitcnt lgkmcnt(" #n ")" ::: "memory")
#define PG8_BAR __builtin_amdgcn_s_barrier()
#define PG8_SCHED __builtin_amdgcn_sched_barrier(0)
    Unit cur, nxt; int ui = 0;
    if (!S.next(0, cur)) return;
    f32x4 acc[2][2][4][2];
#pragma unroll
    for (int a = 0; a < 2; ++a)
#pragma unroll
        for (int b = 0; b < 2; ++b)
#pragma unroll
            for (int m = 0; m < 4; ++m)
#pragma unroll
                for (int n = 0; n < 2; ++n) acc[a][b][m][n] = (f32x4){0.f, 0.f, 0.f, 0.f};
    bf16x8 At[4][2], B0[2][2], B1[2][2];
    const char* cA = (const char*)g.A + (size_t)cur.pm * tstep; const char* cB = (const char*)g.Bt + (size_t)cur.pn * tstep;
    S.a_ready(cur);
    if constexpr (SP2) {
        PG8_STAGE(PG8_SB(0, 0), cB, voffB); PG8_STAGE(PG8_SB(0, 1), cB + hstep, voffB); PG8_STAGE(PG8_SA(0, 0), cA, voffA); PG8_STAGE(PG8_SA(0, 1), cA + hstep, voffA);
        if (wr == 1) PG8_BAR;
        PG8_WAIT_V(2); PG8_BAR;
        PG8_STAGE(PG8_SB(1, 0), cB + kstep, voffB); PG8_STAGE(PG8_SA(1, 0), cA + kstep, voffA); PG8_STAGE(PG8_SB(1, 1), cB + hstep + kstep, voffB);
        PG8_WAIT_V(6); PG8_BAR;
    } else {
        PG8_STAGE(PG8_SB(0, 0), cB, voffB); PG8_STAGE(PG8_SA(0, 0), cA, voffA); PG8_STAGE(PG8_SB(0, 1), cB + hstep, voffB); PG8_STAGE(PG8_SA(0, 1), cA + hstep, voffA);
        if (wr == 1) PG8_BAR;
        PG8_WAIT_V(4); PG8_BAR;
        PG8_STAGE(PG8_SB(1, 0), cB + kstep, voffB); PG8_STAGE(PG8_SA(1, 0), cA + kstep, voffA); PG8_STAGE(PG8_SB(1, 1), cB + hstep + kstep, voffB);
        PG8_WAIT_V(6); PG8_BAR;
    }
    for (;;) {
        const bool has_next = S.next(ui + 1, nxt);
        const char* nA = has_next ? (const char*)g.A + (size_t)nxt.pm * tstep : cA; const char* nB = has_next ? (const char*)g.Bt + (size_t)nxt.pn * tstep : cB;
        for (int t = 0; t < nt; t += 2) {
            const bool last = (t == nt - 2);
            const char* a1 = cA + (size_t)(t + 1) * kstep;
            const char* a2 = last ? nA : cA + (size_t)(t + 2) * kstep; const char* b2 = last ? nB : cB + (size_t)(t + 2) * kstep;
            const char* a3 = a2 + kstep; const char* b3 = b2 + kstep;
            if (last && has_next) S.a_ready(nxt);
            if constexpr (SP2) {
            PG8_LDB(B0, 0, 0); PG8_LDB(B1, 0, 1); PG8_SCHED; PG8_LDA(At, 0, 0); PG8_STAGE(PG8_SA(1, 1), a1 + hstep, voffA);
            PG8_WAIT_V(8); PG8_WAIT_L(0); PG8_BAR; PG8_MMA(0, 0, At, B0); PG8_MMA(0, 1, At, B1); PG8_BAR; PG8_SCHED;
            PG8_LDA(At, 0, 1); PG8_STAGE(PG8_SB(0, 0), b2, voffB); PG8_STAGE(PG8_SB(0, 1), b2 + hstep, voffB); PG8_STAGE(PG8_SA(0, 0), a2, voffA);
            PG8_WAIT_V(8); PG8_WAIT_L(0); PG8_BAR; PG8_MMA(1, 0, At, B0); PG8_MMA(1, 1, At, B1); PG8_BAR; PG8_SCHED;
            PG8_LDB(B0, 1, 0); PG8_LDB(B1, 1, 1); PG8_SCHED; PG8_LDA(At, 1, 0); PG8_STAGE(PG8_SA(0, 1), a2 + hstep, voffA);
            PG8_WAIT_V(8); PG8_WAIT_L(0); PG8_BAR; PG8_MMA(0, 0, At, B0); PG8_MMA(0, 1, At, B1); PG8_BAR; PG8_SCHED;
            PG8_LDA(At, 1, 1); PG8_STAGE(PG8_SB(1, 0), b3, voffB); PG8_STAGE(PG8_SB(1, 1), b3 + hstep, voffB); PG8_STAGE(PG8_SA(1, 0), a3, voffA);
            PG8_WAIT_V(8); PG8_WAIT_L(0); PG8_BAR; PG8_MMA(1, 0, At, B0); PG8_MMA(1, 1, At, B1); PG8_BAR; PG8_SCHED;
            } else {
            PG8_LDB(B0, 0, 0); PG8_SCHED; PG8_LDA(At, 0, 0); PG8_STAGE(PG8_SA(1, 1), a1 + hstep, voffA);
            PG8_WAIT_L(8); PG8_BAR; PG8_WAIT_L(0); PG8_MMA(0, 0, At, B0); PG8_BAR; PG8_SCHED;
            PG8_LDB(B1, 0, 1); PG8_STAGE(PG8_SB(0, 0), b2, voffB);
            PG8_BAR; PG8_WAIT_L(0); PG8_MMA(0, 1, At, B1); PG8_BAR;
            PG8_LDA(At, 0, 1); PG8_STAGE(PG8_SA(0, 0), a2, voffA);
            PG8_BAR; PG8_WAIT_L(0); PG8_MMA(1, 0, At, B0); PG8_BAR; PG8_SCHED;
            PG8_STAGE(PG8_SB(0, 1), b2 + hstep, voffB);
            PG8_WAIT_V(6); PG8_BAR; PG8_MMA(1, 1, At, B1); PG8_BAR;
            PG8_LDB(B0, 1, 0); PG8_SCHED; PG8_LDA(At, 1, 0); PG8_STAGE(PG8_SA(0, 1), a2 + hstep, voffA);
            PG8_WAIT_L(8); PG8_BAR; PG8_WAIT_L(0); PG8_MMA(0, 0, At, B0); PG8_BAR; PG8_SCHED;
            PG8_LDB(B1, 1, 1); PG8_STAGE(PG8_SB(1, 0), b3, voffB);
            PG8_BAR; PG8_WAIT_L(0); PG8_MMA(0, 1, At, B1); PG8_BAR;
            PG8_LDA(At, 1, 1); PG8_STAGE(PG8_SA(1, 0), a3, voffA);
            PG8_BAR; PG8_WAIT_L(0); PG8_MMA(1, 0, At, B0); PG8_BAR; PG8_SCHED;
            PG8_STAGE(PG8_SB(1, 1), b3 + hstep, voffB);
            PG8_WAIT_V(6); PG8_BAR; PG8_MMA(1, 1, At, B1); PG8_BAR;
            }
        }
        if constexpr (ALIGN_EPI) { if (wr == 0) PG8_BAR; }
        if constexpr (!Epi::AFTER_DRAIN) { E(acc, cur, wr, wc, fr, fq); S.done(cur); }
        if (!has_next) break;
#pragma unroll
        for (int a = 0; a < 2; ++a)
#pragma unroll
            for (int b = 0; b < 2; ++b)
#pragma unroll
                for (int m = 0; m < 4; ++m)
#pragma unroll
                    for (int n = 0; n < 2; ++n) acc[a][b][m][n] = (f32x4){0.f, 0.f, 0.f, 0.f};
        cur = nxt; cA = nA; cB = nB; ++ui;
        if constexpr (ALIGN_EPI) { if (wr == 1) PG8_BAR; }
    }
    PG8_WAIT_V(0);
    if constexpr (!ALIGN_EPI) { if (wr == 0) PG8_BAR; }
    PG8_BAR;
    if constexpr (Epi::AFTER_DRAIN) { E.fused(acc, cur, wr, wc, fr, fq, lds, wid, lane); S.done(cur); }
#undef PG8_SA
#undef PG8_SB
#undef PG8_STAGE
#undef PG8_LDA
#undef PG8_LDB
#undef PG8_MMA
#undef PG8_WAIT_V
#undef PG8_WAIT_L
#undef PG8_BAR
#undef PG8_SCHED
}
}


constexpr int NWAVES = 8;
#ifndef MK_N_LAUNCHES
#define MK_N_LAUNCHES 1
#endif
constexpr int N_PHASES = 9;
constexpr int N_LAUNCHES = MK_N_LAUNCHES;

constexpr int BATCH = 16, SEQ = 2048, DM = 1024, DEPTH = 2, MTOK = BATCH * SEQ, NIN = 4096;
constexpr int C_HQ = 0, C_HF = 512, C_HI = 1024, C_HG = 1536, C_AQ = 2048, C_AK = 2560, C_AV = 3072, C_AG = 3584;
constexpr float NORM_EPS = 1e-6f;

constexpr size_t MiB = 1u << 20;
constexpr size_t WS_CTL = 0, CTL_ZERO_BYTES = 1 * MiB;
constexpr size_t WS_WIN = 2 * MiB;
constexpr size_t WS_WOUT = 18 * MiB;
constexpr size_t WS_LB = 22 * MiB;
constexpr size_t WS_KMEAN = 22 * MiB + 65536;
constexpr size_t WS_ROWSS = 24 * MiB;
constexpr size_t WS_XB = 32 * MiB;
constexpr size_t WS_MIXED = 96 * MiB;
constexpr size_t WS_PROJ = 160 * MiB;
constexpr size_t WS_QN = 416 * MiB;
constexpr size_t WS_KN = 448 * MiB;
constexpr size_t WS_END = 480 * MiB;
constexpr int CW_BAR = 4096;

constexpr int RING_OFF = 0, RING_BYTES = 131072;
constexpr int EXTRA_OFF = RING_BYTES, EXTRA_BYTES = 16384;
constexpr int LDSCTL_OFF = EXTRA_OFF + EXTRA_BYTES, MISC_OFF = LDSCTL_OFF + 320;
constexpr int LDS_BYTES = LDSCTL_OFF + 1024;

#define GAS __attribute__((address_space(1)))
#define LAS __attribute__((address_space(3)))
typedef unsigned short bf16;
typedef unsigned v4u __attribute__((ext_vector_type(4)));
typedef float f32x4 __attribute__((ext_vector_type(4)));
typedef GAS unsigned gu32;
#define RLX_AGENT __ATOMIC_RELAXED, __HIP_MEMORY_SCOPE_AGENT
#define LDS_WAIT() asm volatile("s_waitcnt lgkmcnt(0)" ::: "memory")
#define VM_WAIT() asm volatile("s_waitcnt vmcnt(0)" ::: "memory")
__device__ __forceinline__ unsigned f2bf(float f) { unsigned u = __builtin_bit_cast(unsigned, f); return (u + 0x7fffu + ((u >> 16) & 1u)) >> 16; }
__device__ __forceinline__ unsigned pk2(float lo, float hi) { return f2bf(lo) | (f2bf(hi) << 16); }
__device__ __forceinline__ float bf2f(unsigned short b) { return __builtin_bit_cast(float, (unsigned)b << 16); }
__device__ __forceinline__ float bflo(unsigned w) { return __builtin_bit_cast(float, w << 16); }
__device__ __forceinline__ float bfhi(unsigned w) { return __builtin_bit_cast(float, w & 0xffff0000u); }
__device__ __forceinline__ float silu_f(float z) { return z / (1.0f + __expf(-z)); }
__device__ __forceinline__ float sigmoid_f(float z) { return 1.0f / (1.0f + __expf(-z)); }

#define XB_TMO      128
#define XB_XCNT(j)  (256  + 64 * (j))
#define XB_XSUB(j)  (1280 + 64 * (j))
#define XB_XGEN(j)  (2304 + 64 * (j))
#define XB_TOP      3328
#define XB_TOPGEN   3392
#define XCD_BAR_WORDS 3456
#define XB_SPIN_CAP (1u << 18)

__device__ __forceinline__ unsigned xb_ld(unsigned* p)              { return __hip_atomic_load(p, __ATOMIC_RELAXED, __HIP_MEMORY_SCOPE_AGENT); }
__device__ __forceinline__ unsigned xb_add(unsigned* p, unsigned v) { return __hip_atomic_fetch_add(p, v, __ATOMIC_RELAXED, __HIP_MEMORY_SCOPE_AGENT); }
__device__ __forceinline__ unsigned xb_xcc_id() { return (unsigned)__builtin_amdgcn_s_getreg((3 << 11) | 20) & 0xFu; }
#define XB_SPIN(cond, bar) do { unsigned _sp = 0; while (cond) { __builtin_amdgcn_s_sleep(1); \
    if ((++_sp & 255u) == 0u) { if (xb_ld(&(bar)[XB_TMO])) break; if (_sp > XB_SPIN_CAP) { atomicAdd(&(bar)[XB_TMO], 1u); break; } } } } while (0)

struct XcdBarrier {
    unsigned* bar; unsigned x;
    volatile LAS unsigned* st;
};

__device__ __forceinline__ XcdBarrier xcd_barrier_post(unsigned* bar, volatile LAS unsigned* st) {
    XcdBarrier b; b.bar = bar; b.x = xb_xcc_id(); b.st = st;
    if (threadIdx.x == 0) (void)xb_add(&bar[XB_XCNT(b.x)], 1u);
    return b;
}
__device__ __forceinline__ void xcd_barrier_complete(unsigned* bar, unsigned x, unsigned& nloc, unsigned& nx) {
    const unsigned G = gridDim.x * gridDim.y * gridDim.z;
    unsigned sum, cnt, mine, sp = 0u;
    for (;;) {
        sum = 0u; cnt = 0u; mine = 0u;
#pragma unroll
        for (unsigned j = 0; j < 16; ++j) { const unsigned c = xb_ld(&bar[XB_XCNT(j)]); sum += c; cnt += (c > 0u) ? 1u : 0u; mine = (j == x) ? c : mine; }
        if (sum == G) break;
        __builtin_amdgcn_s_sleep(1);
        if ((++sp & 255u) == 0u) { if (xb_ld(&bar[XB_TMO])) break; if (sp > XB_SPIN_CAP) { atomicAdd(&bar[XB_TMO], 1u); break; } }
    }
    nloc = mine > 0u ? mine : 1u; nx = cnt > 0u ? cnt : 1u;
}

__device__ __forceinline__ void xcd_barrier(const XcdBarrier& b) {
    asm volatile("s_waitcnt vmcnt(0)" ::: "memory");
    __syncthreads();
    if (threadIdx.x == 0) {
        unsigned* bar = b.bar;
        __builtin_amdgcn_s_waitcnt(0);
        unsigned nloc = b.st[0], nx = b.st[1];
        if (nloc == 0u) { xcd_barrier_complete(bar, b.x, nloc, nx); b.st[0] = nloc; b.st[1] = nx; }
        const unsigned old = xb_add(&bar[XB_XSUB(b.x)], 1u);
        const unsigned gen = old / nloc;
        if (old + 1u == (gen + 1u) * nloc) {
            __builtin_amdgcn_fence(__ATOMIC_RELEASE, "agent");
            asm volatile("s_waitcnt vmcnt(0)" ::: "memory");
            const unsigned og = xb_add(&bar[XB_TOP], 1u);
            const unsigned tg = og / nx;
            if (og + 1u == (tg + 1u) * nx) xb_add(&bar[XB_TOPGEN], 1u);
            else XB_SPIN(xb_ld(&bar[XB_TOPGEN]) == tg, bar);
            __builtin_amdgcn_fence(__ATOMIC_ACQUIRE, "agent");
            xb_add(&bar[XB_XGEN(b.x)], 1u);
            asm volatile("s_waitcnt vmcnt(0)" ::: "memory");
        } else {
            XB_SPIN(xb_ld(&bar[XB_XGEN(b.x)]) == gen, bar);
            __builtin_amdgcn_fence(__ATOMIC_ACQUIRE, "agent");
            asm volatile("s_waitcnt vmcnt(0)" ::: "memory");
        }
    }
    __syncthreads();
}


struct Frame {
    LAS unsigned char* lds;
    volatile LAS unsigned* MISC;
    gu32* ctl;
    int vcu, G;
    const float* x; float* out;
    const float *norm_w, *w_in, *lb_logits, *hg_norm_w, *q_norm_w, *k_norm_w, *w_out;
    bf16 *WIN, *WOUT, *XB, *MIXED, *PROJ, *QN, *KN;
    float *LB, *KMEAN, *ROWSS;
};

__device__ __forceinline__ float wave_sum(float v) {
#pragma unroll
    for (int o = 1; o < 64; o <<= 1) v += __shfl_xor(v, o);
    return v;
}
__device__ __forceinline__ void p0_transpose_item(const float* W, int K, int N, bf16* WT, const float* kscale, LAS float* scr, int item, int lane) {
    const int nblk = N / 32, kb = item / nblk, nb = item % nblk, k0 = 64 * kb, n0 = 32 * nb;
#pragma unroll 8
    for (int i = 0; i < 32; ++i) { const int kk = 2 * i + (lane >> 5); const float s = kscale ? kscale[k0 + kk] : 1.0f; scr[kk * 33 + (lane & 31)] = W[(size_t)(k0 + kk) * N + n0 + (lane & 31)] * s; }
    LDS_WAIT(); asm volatile("" ::: "memory");
    const int c = lane & 7;
#pragma unroll
    for (int j = 0; j < 4; ++j) { const int n = (lane >> 3) + 8 * j; const LAS float* s = scr + (8 * c) * 33 + n;
        v4u o; o.x = pk2(s[0 * 33], s[1 * 33]); o.y = pk2(s[2 * 33], s[3 * 33]); o.z = pk2(s[4 * 33], s[5 * 33]); o.w = pk2(s[6 * 33], s[7 * 33]);
        *(GAS v4u*)(WT + (size_t)(n0 + n) * K + k0 + 8 * c) = o; }
    LDS_WAIT(); asm volatile("" ::: "memory");
}
#define PHASE_IDS() int t_ = threadIdx.x; asm volatile("" : "+v"(t_)); const int tid = t_, lane = tid & 63, wave = __builtin_amdgcn_readfirstlane(tid >> 6); (void)lane; (void)wave
__device__ __forceinline__ void p0_prologue(Frame& F) {
    PHASE_IDS();
    LAS float* scr = (LAS float*)(F.lds + RING_OFF + wave * 16384);
    const int gw = F.vcu * NWAVES + wave, NGW = F.G * NWAVES;
    constexpr int I_IN = (DM / 64) * (NIN / 32), I_OUT = (DM / 64) * (DM / 32);
    constexpr int NITEMS = DEPTH * (I_IN + I_OUT);
    for (int it = gw; it < NITEMS; it += NGW) {
        int r = it;
        if (r < DEPTH * I_IN) { const int l = r / I_IN; r -= l * I_IN;
            p0_transpose_item(F.w_in + (size_t)l * DM * NIN, DM, NIN, F.WIN + (size_t)l * NIN * DM, F.norm_w + l * DM, scr, r, lane); continue; }
        r -= DEPTH * I_IN; { const int l = r / I_OUT; r -= l * I_OUT;
            p0_transpose_item(F.w_out + (size_t)l * DM * DM, DM, DM, F.WOUT + (size_t)l * DM * DM, nullptr, scr, r, lane); }
    }
    for (int m = gw; m < MTOK; m += NGW) {
        const GAS f32x4* xr = (const GAS f32x4*)(F.x + (size_t)m * DM) + lane;
        f32x4 v[4]; float s = 0.f;
#pragma unroll
        for (int j = 0; j < 4; ++j) { v[j] = xr[64 * j]; s += (v[j].x * v[j].x + v[j].y * v[j].y) + (v[j].z * v[j].z + v[j].w * v[j].w); }
        s = wave_sum(s);
        GAS unsigned long long* o8 = (GAS unsigned long long*)(F.XB + (size_t)m * DM) + lane;
#pragma unroll
        for (int j = 0; j < 4; ++j) o8[64 * j] = (unsigned long long)pk2(v[j].x, v[j].y) | ((unsigned long long)pk2(v[j].z, v[j].w) << 32);
        if (lane < 16) F.ROWSS[(size_t)m * 16 + lane] = (lane == 0) ? s : 0.f;
    }
    if (blockIdx.x == 0) { const int c = tid; const float a0 = F.lb_logits[c], a1 = F.lb_logits[512 + c]; const float mx = fmaxf(a0, a1);
        const float e0 = expf(a0 - mx), e1 = expf(a1 - mx); const float p0 = e0 / (e0 + e1), p1 = e1 / (e0 + e1);
        F.LB[c] = 0.f; F.LB[512 + c] = fminf(fmaxf((p0 + p1) - p0, 0.f), 1.0f - 1e-6f); }
}

__device__ __forceinline__ void kmean_phase(Frame& F, int l) {
    PHASE_IDS();
    LAS float* rs = (LAS float*)(F.lds + RING_OFF);
    const int t = tid;
    for (int it = F.vcu; it < 128; it += F.G) {
        const size_t row0 = (size_t)it * 256;
        const int sub = t & 7;
        for (int pp = t >> 3; pp < 2048; pp += 64) { const int row = pp >> 3, h = pp & 7;
            const v4u w = *(const GAS v4u*)(F.PROJ + (row0 + row) * NIN + C_AK + h * 64 + sub * 8);
            float ss = 0.f;
#pragma unroll
            for (int e = 0; e < 4; ++e) { const float a = bflo(w[e]), b = bfhi(w[e]); ss += a * a + b * b; }
            ss += __shfl_xor(ss, 1); ss += __shfl_xor(ss, 2); ss += __shfl_xor(ss, 4);
            if (sub == 0) rs[row * 8 + h] = 1.0f / sqrtf(ss * (1.0f / 64.0f) + NORM_EPS); }
        __syncthreads();
        { const int c = t; float sum = 0.f; const GAS bf16* kp = (const GAS bf16*)(F.PROJ + row0 * NIN + C_AK + c);
            for (int row = 0; row < 256; ++row) sum += bf2f(kp[(size_t)row * NIN]) * rs[row * 8 + (c >> 6)];
            F.KMEAN[(size_t)it * 512 + c] = sum * F.k_norm_w[l * 64 + (c & 63)] * (1.0f / 256.0f); }
        __syncthreads();
    }
}

__device__ __forceinline__ void hgrn_naive_phase(Frame& F, int l) {
    LAS float* qs = (LAS float*)(F.lds + RING_OFF);
    LAS float* fs = qs + 2048; LAS float* ks = fs + 2048; LAS float* is = ks + 2048; LAS float* gs = is + 2048;
    LAS float* op = gs + 2048;
    PHASE_IDS();
    const int t = tid, dv = t & 127, dq = t >> 7;
    for (int it = F.vcu; it < 64; it += F.G) {
        const int b = it >> 2, h = it & 3;
        float S[32];
#pragma unroll
        for (int r = 0; r < 32; ++r) S[r] = 0.f;
        for (int g = 0; g < 128; ++g) {
#pragma unroll
            for (int j = 0; j < 4; ++j) { const int idx = t + 512 * j, tt = idx >> 7, d = idx & 127;
                const GAS bf16* base = (const GAS bf16*)(F.PROJ + ((size_t)b * SEQ + g * 16 + tt) * NIN + h * 128 + d);
                const float zq = bf2f(base[C_HQ]), zf = bf2f(base[C_HF]), zi = bf2f(base[C_HI]), zg = bf2f(base[C_HG]);
                const float lbv = F.LB[l * 512 + h * 128 + d]; const float f = lbv + (1.0f - lbv) * sigmoid_f(zf);
                qs[idx] = silu_f(zq); fs[idx] = f; ks[idx] = 1.0f - f; is[idx] = zi; gs[idx] = silu_f(zg); }
            __syncthreads();
            for (int tt = 0; tt < 16; ++tt) { const float iv = is[tt * 128 + dv]; float part = 0.f;
                const LAS float* fp = fs + tt * 128 + 32 * dq; const LAS float* kp = ks + tt * 128 + 32 * dq; const LAS float* qp = qs + tt * 128 + 32 * dq;
#pragma unroll
                for (int r = 0; r < 32; ++r) { S[r] = fp[r] * S[r] + kp[r] * iv; part += S[r] * qp[r]; }
                op[(tt * 4 + dq) * 128 + dv] = part; }
            __syncthreads();
#pragma unroll
            for (int e = 0; e < 2; ++e) { const int tt = 2 * wave + e; float o0 = 0.f, o1 = 0.f;
#pragma unroll
                for (int q4 = 0; q4 < 4; ++q4) { o0 += op[(tt * 4 + q4) * 128 + lane]; o1 += op[(tt * 4 + q4) * 128 + lane + 64]; }
                const float ss = wave_sum(o0 * o0 + o1 * o1); const float rstd = 1.0f / sqrtf(ss * (1.0f / 128.0f) + NORM_EPS);
                GAS bf16* mo = (GAS bf16*)(F.MIXED + ((size_t)b * SEQ + g * 16 + tt) * DM + h * 128);
                mo[lane] = (bf16)f2bf(o0 * rstd * F.hg_norm_w[l * 128 + lane] * gs[tt * 128 + lane]);
                mo[lane + 64] = (bf16)f2bf(o1 * rstd * F.hg_norm_w[l * 128 + lane + 64] * gs[tt * 128 + lane + 64]); }
            __syncthreads();
        }
    }
}

__device__ __forceinline__ void moba_naive_phase(Frame& F, int l) {
    LAS float* Ks = (LAS float*)(F.lds + RING_OFF);
    LAS float* Vs = Ks + 16384;
    LAS float* km = (LAS float*)(F.lds + EXTRA_OFF);
    PHASE_IDS();
    const int t = tid, tql = t & 255, half = t >> 8, wq = (t & 255) >> 6;
    for (int it = F.vcu; it < 1024; it += F.G) {
        const int rnd = it >> 8, v = it & 255;
        const int hf2 = v >> 7, bh = v & 127;
        const int qb = (rnd == 0) ? (hf2 ? 6 : 7) : (rnd == 1) ? (hf2 ? 1 : 0) : (rnd == 2) ? (hf2 ? 4 : 5) : (hf2 ? 3 : 2);
        const int b = bh >> 3, h = bh & 7; const size_t rowbase = (size_t)b * SEQ; const int tq = qb * 256 + tql;
        const float slope = exp2f(-(float)(h + 1));
        float q[64];
        { const GAS v4u* qp = (const GAS v4u*)(F.PROJ + (rowbase + tq) * NIN + C_AQ + h * 64); float ss = 0.f;
#pragma unroll
            for (int c = 0; c < 8; ++c) { const v4u w = qp[c];
#pragma unroll
                for (int e = 0; e < 4; ++e) { q[c * 8 + 2 * e] = bflo(w[e]); q[c * 8 + 2 * e + 1] = bfhi(w[e]); ss += q[c * 8 + 2 * e] * q[c * 8 + 2 * e] + q[c * 8 + 2 * e + 1] * q[c * 8 + 2 * e + 1]; } }
            const float rstd = 1.0f / sqrtf(ss * (1.0f / 64.0f) + NORM_EPS) * 0.125f;
#pragma unroll
            for (int d = 0; d < 64; ++d) q[d] *= rstd * F.q_norm_w[l * 64 + d]; }
        if (t < qb * 64) km[t] = F.KMEAN[((size_t)b * 8 + (t >> 6)) * 512 + h * 64 + (t & 63)];
        __syncthreads();
        unsigned selmask = 0;
        { float gt[7];
#pragma unroll
            for (int j = 0; j < 7; ++j) { float s = 0.f; if (j < qb) {
#pragma unroll
                    for (int d = 0; d < 64; ++d) s += q[d] * km[j * 64 + d]; } gt[j] = s; }
#pragma unroll
            for (int j = 0; j < 7; ++j) { int rank = 0;
#pragma unroll
                for (int i = 0; i < 7; ++i) if (i != j && i < qb) rank += (gt[i] > gt[j] || (gt[i] == gt[j] && i < j)) ? 1 : 0;
                if (j < qb && rank < 3) selmask |= 1u << j; } }
        float mrun = -1e30f, lrun = 0.f; float acc[64];
#pragma unroll
        for (int d = 0; d < 64; ++d) acc[d] = 0.f;
        for (int j = 0; j <= qb; ++j) {
            __syncthreads();
            { const int sub = t & 7;
                for (int r = t >> 3; r < 256; r += 64) {
                    const size_t grow = (rowbase + j * 256 + r) * NIN + h * 64 + sub * 8;
                    const v4u kw = *(const GAS v4u*)(F.PROJ + grow + C_AK); const v4u vw = *(const GAS v4u*)(F.PROJ + grow + C_AV);
                    float kf[8], vf[8]; float ss = 0.f;
#pragma unroll
                    for (int e = 0; e < 4; ++e) { kf[2 * e] = bflo(kw[e]); kf[2 * e + 1] = bfhi(kw[e]); vf[2 * e] = bflo(vw[e]); vf[2 * e + 1] = bfhi(vw[e]); ss += kf[2 * e] * kf[2 * e] + kf[2 * e + 1] * kf[2 * e + 1]; }
                    ss += __shfl_xor(ss, 1); ss += __shfl_xor(ss, 2); ss += __shfl_xor(ss, 4);
                    const float rstd = 1.0f / sqrtf(ss * (1.0f / 64.0f) + NORM_EPS);
#pragma unroll
                    for (int e = 0; e < 8; ++e) { Ks[r * 64 + sub * 8 + e] = kf[e] * rstd * F.k_norm_w[l * 64 + sub * 8 + e]; Vs[r * 64 + sub * 8 + e] = vf[e]; } } }
            __syncthreads();
            const bool own = (j == qb); const bool act = own || ((selmask >> j) & 1u);
            const int k0 = half * 128; int k1 = k0 + 128; if (own) { const int lim = 64 * wq + 64; k1 = k1 < lim ? k1 : lim; }
            for (int kk = k0; kk < k1; ++kk) {
                const LAS f32x4* kr = (const LAS f32x4*)(Ks + kk * 64); float s = 0.f;
#pragma unroll
                for (int d4 = 0; d4 < 16; ++d4) { const f32x4 kv = kr[d4]; s += (q[4 * d4] * kv.x + q[4 * d4 + 1] * kv.y) + (q[4 * d4 + 2] * kv.z + q[4 * d4 + 3] * kv.w); }
                const int tk = j * 256 + kk; s -= slope * (float)(tq - tk);
                const bool valid = act && (!own || kk <= tql);
                if (valid) { const float mn = fmaxf(mrun, s); const float corr = __expf(mrun - mn), p = __expf(s - mn);
                    lrun = lrun * corr + p; mrun = mn;
                    const LAS f32x4* vr = (const LAS f32x4*)(Vs + kk * 64);
#pragma unroll
                    for (int d4 = 0; d4 < 16; ++d4) { const f32x4 vv = vr[d4];
                        acc[4 * d4] = acc[4 * d4] * corr + p * vv.x; acc[4 * d4 + 1] = acc[4 * d4 + 1] * corr + p * vv.y;
                        acc[4 * d4 + 2] = acc[4 * d4 + 2] * corr + p * vv.z; acc[4 * d4 + 3] = acc[4 * d4 + 3] * corr + p * vv.w; } }
            }
        }
        __syncthreads();
        LAS float* mg = Ks;
        if (half == 1) { mg[tql * 66] = mrun; mg[tql * 66 + 1] = lrun;
#pragma unroll
            for (int d = 0; d < 64; ++d) mg[tql * 66 + 2 + d] = acc[d]; }
        __syncthreads();
        if (half == 0) { const float m1 = mg[tql * 66], l1 = mg[tql * 66 + 1]; const float M2 = fmaxf(mrun, m1);
            const float c0 = __expf(mrun - M2), c1 = __expf(m1 - M2); const float inv = 1.0f / (lrun * c0 + l1 * c1);
            const GAS v4u* gp = (const GAS v4u*)(F.PROJ + (rowbase + tq) * NIN + C_AG + h * 64);
            GAS v4u* op = (GAS v4u*)(F.MIXED + (rowbase + tq) * DM + 512 + h * 64);
#pragma unroll
            for (int c = 0; c < 8; ++c) { const v4u gw = gp[c]; v4u ow;
#pragma unroll
                for (int e = 0; e < 4; ++e) { const int d = c * 8 + 2 * e;
                    const float o0 = (acc[d] * c0 + mg[tql * 66 + 2 + d] * c1) * inv * silu_f(bflo(gw[e]));
                    const float o1 = (acc[d + 1] * c0 + mg[tql * 66 + 3 + d] * c1) * inv * silu_f(bfhi(gw[e]));
                    ow[e] = pk2(o0, o1); }
                op[c] = ow; } }
        __syncthreads();
    }
}


constexpr float LOG2E = 1.4426950408889634f;
constexpr float QSCALE2 = 0.125f * LOG2E;
__device__ __forceinline__ void prep_phase(Frame& F, int l) {
    PHASE_IDS();
    LAS float* kt = (LAS float*)(F.lds + RING_OFF);
    LAS float* part = kt + 16384;
    const int row = tid >> 1, half = tid & 1;
    for (int it = F.vcu; it < 1024; it += F.G) {
        const int bb = it >> 3, h = it & 7; const size_t grow = (size_t)bb * 256 + row;
        const GAS v4u* qp = (const GAS v4u*)(F.PROJ + grow * NIN + C_AQ + h * 64 + 32 * half);
        const GAS v4u* kp = (const GAS v4u*)(F.PROJ + grow * NIN + C_AK + h * 64 + 32 * half);
        float qv[32], kv[32]; float ssq = 0.f, ssk = 0.f;
#pragma unroll
        for (int c = 0; c < 4; ++c) { const v4u qw = qp[c], kw = kp[c];
#pragma unroll
            for (int e = 0; e < 4; ++e) { qv[c * 8 + 2 * e] = bflo(qw[e]); qv[c * 8 + 2 * e + 1] = bfhi(qw[e]); kv[c * 8 + 2 * e] = bflo(kw[e]); kv[c * 8 + 2 * e + 1] = bfhi(kw[e]); } }
#pragma unroll
        for (int e = 0; e < 32; ++e) { ssq += qv[e] * qv[e]; ssk += kv[e] * kv[e]; }
        ssq += __shfl_xor(ssq, 1); ssk += __shfl_xor(ssk, 1);
        const float rq = 1.0f / sqrtf(ssq * (1.0f / 64.0f) + NORM_EPS) * QSCALE2, rk = 1.0f / sqrtf(ssk * (1.0f / 64.0f) + NORM_EPS);
#pragma unroll
        for (int e = 0; e < 32; ++e) { qv[e] *= rq * F.q_norm_w[l * 64 + 32 * half + e]; kv[e] *= rk * F.k_norm_w[l * 64 + 32 * half + e]; kt[row * 64 + 32 * half + e] = kv[e]; }
        GAS v4u* qo = (GAS v4u*)(F.QN + grow * 512 + h * 64 + 32 * half); GAS v4u* ko = (GAS v4u*)(F.KN + grow * 512 + h * 64 + 32 * half);
#pragma unroll
        for (int c = 0; c < 4; ++c) { v4u a, b2;
#pragma unroll
            for (int e = 0; e < 4; ++e) { a[e] = pk2(qv[c * 8 + 2 * e], qv[c * 8 + 2 * e + 1]); b2[e] = pk2(kv[c * 8 + 2 * e], kv[c * 8 + 2 * e + 1]); }
            qo[c] = a; ko[c] = b2; }
        __syncthreads();
        { const int c = tid & 63, rg = tid >> 6; float s = 0.f;
            for (int rr = 0; rr < 32; ++rr) s += kt[(32 * rg + rr) * 64 + c];
            part[rg * 64 + c] = s; }
        __syncthreads();
        if (tid < 64) { float s = 0.f;
#pragma unroll
            for (int rg = 0; rg < 8; ++rg) s += part[rg * 64 + tid];
            F.KMEAN[(size_t)bb * 512 + h * 64 + tid] = s * (1.0f / 256.0f); }
        __syncthreads();
    }
}

namespace moba {
typedef short bf16x8 __attribute__((ext_vector_type(8)));
typedef short s16x4 __attribute__((ext_vector_type(4)));
typedef float f32x16 __attribute__((ext_vector_type(16)));
typedef float f32x2_t __attribute__((ext_vector_type(2))); typedef __bf16 bf16x2_t __attribute__((ext_vector_type(2)));
__device__ __forceinline__ unsigned cvtpk(float lo, float hi) { f32x2_t v = {lo, hi}; bf16x2_t b = __builtin_convertvector(v, bf16x2_t); return __builtin_bit_cast(unsigned, b); }
__device__ __forceinline__ int crow(int r, int hi) { return (r & 3) + 8 * (r >> 2) + 4 * hi; }
constexpr int L_K = 0, L_V = 16384, L_WSF = 32768, L_KM = 34816, L_OST = 36864;
constexpr float NEG_BIG = -1e30f;
constexpr float THR = 8.0f;
__device__ __forceinline__ s16x4 vtr(const LAS unsigned char* p) { return __builtin_bit_cast(s16x4, __builtin_amdgcn_ds_read_tr16_b64_v4i16((LAS s16x4*)p)); }
}

__device__ __forceinline__ void moba_mfma_phase(Frame& F, int l) {
    using namespace moba;
    PHASE_IDS();
    const int r32 = lane & 31, hi = lane >> 5, wid = wave;
    LAS unsigned char* L = F.lds + RING_OFF;
    LAS float* wsf = (LAS float*)(L + L_WSF) + wid * 64;
    LAS float* km = (LAS float*)(L + L_KM);
    LAS float* ost = (LAS float*)(L + L_OST) + wid * 2048;
    float gq = fabsf(F.q_norm_w[l * 64 + lane]), gk = fabsf(F.k_norm_w[l * 64 + lane]);
#pragma unroll
    for (int o = 1; o < 64; o <<= 1) { gq = fmaxf(gq, __shfl_xor(gq, o)); gk = fmaxf(gk, __shfl_xor(gk, o)); }
    const float mhat0 = -(8.0f * gq * gk * LOG2E * 1.02f + 1.0f);
    for (int it = F.vcu; it < 1024; it += F.G) {
        const int rnd = it >> 8, v = it & 255;
        const int hf2 = v >> 7, bh = v & 127;
        const int qb = (rnd == 0) ? (hf2 ? 6 : 7) : (rnd == 1) ? (hf2 ? 1 : 0) : (rnd == 2) ? (hf2 ? 4 : 5) : (hf2 ? 3 : 2);
        const int b = bh >> 3, h = bh & 7; const size_t rowbase = (size_t)b * SEQ; const int q0 = qb * 256, qrel = wid * 32 + r32, tq = q0 + qrel;
        const float sl2 = exp2f(-(float)(h + 1)) * LOG2E;
        bf16x8 qr[4];
        { const GAS bf16* Qw = (const GAS bf16*)(F.QN + (rowbase + q0 + wid * 32 + r32) * 512 + h * 64 + hi * 8);
#pragma unroll
            for (int d0 = 0; d0 < 4; ++d0) qr[d0] = *(const GAS bf16x8*)(Qw + d0 * 16); }
        if (tid < qb * 64) km[tid] = F.KMEAN[((size_t)b * 8 + (tid >> 6)) * 512 + h * 64 + (tid & 63)];
        const GAS bf16* ksrc = (const GAS bf16*)(F.KN + (rowbase + lane) * 512 + h * 64 + wid * 8);
        const GAS bf16* vsrc = (const GAS bf16*)(F.PROJ + (rowbase + (tid >> 3)) * NIN + C_AV + h * 64 + (tid & 7) * 8);
        const int kdst = L_K + wid * 1024 + lane * 16;
        const int vrow = tid >> 3, vch = tid & 7;
        const int vdst = L_V + vrow * 128 + (((vch >> 2) ^ ((vrow >> 1) & 1)) * 64) + (vch & 3) * 16;
        const int NT = 4 * (qb + 1);
        v4u kreg = *(const GAS v4u*)(ksrc), vreg = *(const GAS v4u*)(vsrc);
        __syncthreads();
        *(LAS v4u*)(L + kdst) = kreg; *(LAS v4u*)(L + vdst) = vreg;
        unsigned selmask = 0;
        { float gt[7];
#pragma unroll
            for (int j = 0; j < 7; ++j) { float s = 0.f;
                if (j < qb) {
#pragma unroll
                    for (int d0 = 0; d0 < 4; ++d0)
#pragma unroll
                        for (int e = 0; e < 8; ++e) s += bf2f((unsigned short)qr[d0][e]) * km[j * 64 + d0 * 16 + hi * 8 + e];
                    auto rr = __builtin_amdgcn_permlane32_swap(__float_as_uint(s), __float_as_uint(s), false, false);
                    s = __uint_as_float(rr[0]) + __uint_as_float(rr[1]); }
                gt[j] = s; }
#pragma unroll
            for (int j = 0; j < 7; ++j) { int rank = 0;
#pragma unroll
                for (int i = 0; i < 7; ++i) if (i != j && i < qb) rank += (gt[i] > gt[j] || (gt[i] == gt[j] && i < j)) ? 1 : 0;
                if (j < qb && rank < 3) selmask |= 1u << j; } }
        float kb[16];
#pragma unroll
        for (int r = 0; r < 16; ++r) kb[r] = sl2 * (float)crow(r, hi);
        float mhat = mhat0, l_reg = 0.f; f32x16 o[2]; o[0] = f32x16{}; o[1] = f32x16{};
        const int kbase = L_K + hi * 1024 + r32 * 16;
        const int g16 = lane >> 4, i16 = lane & 15, tq4 = i16 >> 2, tp4 = i16 & 3;
        const int vrow0 = 4 * hi + tq4;
        __syncthreads();
        for (int t = 0; t < NT; ++t) {
            const int cur = t & 1;
            if (t + 1 < NT) { kreg = *(const GAS v4u*)(ksrc + (size_t)(t + 1) * 64 * 512); vreg = *(const GAS v4u*)(vsrc + (size_t)(t + 1) * 64 * NIN); }
            const int blk = t >> 2; const bool own = (blk == qb); const int jb = t & 3;
            const bool skip = own && (64 * jb > 32 * wid + 31);
            if (!skip) {
                const bool sel = own || ((selmask >> blk) & 1u);
                const float sc0 = sel ? (-mhat - sl2 * (float)(tq - 64 * t)) : NEG_BIG; const float sc1 = sc0 + 32.0f * sl2;
                f32x16 p0, p1;
#pragma unroll
                for (int r = 0; r < 16; ++r) { p0[r] = sc0 + kb[r]; p1[r] = sc1 + kb[r]; }
#pragma unroll
                for (int d0 = 0; d0 < 4; ++d0) {
                    const bf16x8 b0 = *(const LAS bf16x8*)(L + cur * 8192 + kbase + d0 * 2048);
                    const bf16x8 b1 = *(const LAS bf16x8*)(L + cur * 8192 + kbase + d0 * 2048 + 512);
                    p0 = __builtin_amdgcn_mfma_f32_32x32x16_bf16(b0, qr[d0], p0, 0, 0, 0);
                    p1 = __builtin_amdgcn_mfma_f32_32x32x16_bf16(b1, qr[d0], p1, 0, 0, 0); }
                if (own && (64 * jb + 63 > 32 * wid)) {
#pragma unroll
                    for (int r = 0; r < 16; ++r) { const int kvl = 64 * jb + crow(r, hi); if (kvl > qrel) p0[r] = NEG_BIG; if (kvl + 32 > qrel) p1[r] = NEG_BIG; } }
                float rm = fmaxf(p0[0], p1[0]);
#pragma unroll
                for (int r = 1; r < 16; ++r) rm = fmaxf(rm, fmaxf(p0[r], p1[r]));
                { auto rr = __builtin_amdgcn_permlane32_swap(__float_as_uint(rm), __float_as_uint(rm), false, false); rm = fmaxf(__uint_as_float(rr[0]), __uint_as_float(rr[1])); }
                if (__any(rm > THR)) {
                    const float dl = fmaxf(rm, 0.f); mhat += dl;
#pragma unroll
                    for (int r = 0; r < 16; ++r) { p0[r] -= dl; p1[r] -= dl; }
                    const float f = __builtin_amdgcn_exp2f(-dl); l_reg *= f;
                    if (hi == 0) wsf[r32] = f;
#pragma unroll
                    for (int r = 0; r < 16; ++r) { const float fr = wsf[crow(r, hi)]; o[0][r] *= fr; o[1][r] *= fr; } }
                float sacc = 0.f;
#pragma unroll
                for (int r = 0; r < 16; ++r) { p0[r] = __builtin_amdgcn_exp2f(p0[r]); p1[r] = __builtin_amdgcn_exp2f(p1[r]); sacc += p0[r] + p1[r]; }
                l_reg += sacc;
                bf16x8 pa[4];
                { v4u w;
#pragma unroll
                    for (int ks = 0; ks < 4; ++ks) {
#pragma unroll
                        for (int e = 0; e < 4; ++e) { const int rb = (ks & 1) * 8 + 2 * e; w[e] = (ks < 2) ? cvtpk(p0[rb], p0[rb + 1]) : cvtpk(p1[rb], p1[rb + 1]); }
                        pa[ks] = __builtin_bit_cast(bf16x8, w); } }
#pragma unroll
                for (int dblk = 0; dblk < 2; ++dblk)
#pragma unroll
                    for (int ks = 0; ks < 4; ++ks) {
                        const int rlo = 16 * ks + vrow0, rhi = rlo + 8;
                        const int alo = L_V + cur * 8192 + rlo * 128 + ((dblk ^ ((rlo >> 1) & 1)) * 64) + (16 * (g16 & 1) + 4 * tp4) * 2;
                        const int ahi = L_V + cur * 8192 + rhi * 128 + ((dblk ^ ((rhi >> 1) & 1)) * 64) + (16 * (g16 & 1) + 4 * tp4) * 2;
                        const s16x4 lo = vtr(L + alo), hh = vtr(L + ahi);
                        const bf16x8 vf = (bf16x8){lo[0], lo[1], lo[2], lo[3], hh[0], hh[1], hh[2], hh[3]};
                        o[dblk] = __builtin_amdgcn_mfma_f32_32x32x16_bf16(pa[ks], vf, o[dblk], 0, 0, 0); }
            }
            if (t + 1 < NT) { *(LAS v4u*)(L + (cur ^ 1) * 8192 + kdst) = kreg; *(LAS v4u*)(L + (cur ^ 1) * 8192 + vdst) = vreg; }
            __syncthreads();
        }
        { auto rr = __builtin_amdgcn_permlane32_swap(__float_as_uint(l_reg), __float_as_uint(l_reg), false, false); l_reg = __uint_as_float(rr[0]) + __uint_as_float(rr[1]); }
        if (hi == 0) wsf[r32] = 1.0f / l_reg;
#pragma unroll
        for (int r = 0; r < 16; ++r) { const float rl = wsf[crow(r, hi)]; ost[crow(r, hi) * 64 + r32] = o[0][r] * rl; ost[crow(r, hi) * 64 + 32 + r32] = o[1][r] * rl; }
#pragma unroll
        for (int i = 0; i < 4; ++i) { const int row = i * 8 + (lane >> 3), ch = lane & 7;
            const f32x4 a = *(const LAS f32x4*)(ost + row * 64 + ch * 8), c2 = *(const LAS f32x4*)(ost + row * 64 + ch * 8 + 4);
            const size_t grow = rowbase + q0 + wid * 32 + row;
            const v4u gw = *(const GAS v4u*)(F.PROJ + grow * NIN + C_AG + h * 64 + ch * 8);
            v4u ow; ow.x = pk2(a[0] * silu_f(bflo(gw.x)), a[1] * silu_f(bfhi(gw.x))); ow.y = pk2(a[2] * silu_f(bflo(gw.y)), a[3] * silu_f(bfhi(gw.y)));
            ow.z = pk2(c2[0] * silu_f(bflo(gw.z)), c2[1] * silu_f(bfhi(gw.z))); ow.w = pk2(c2[2] * silu_f(bflo(gw.w)), c2[3] * silu_f(bfhi(gw.w)));
            *(GAS v4u*)(F.MIXED + grow * DM + 512 + h * 64 + ch * 8) = ow; }
    }
    __syncthreads();
}

struct Args { const float* in[8]; float* out; unsigned char* ws; int ph_lo, ph_hi, li, pad; };
__global__ void __launch_bounds__(NWAVES * 64, 2) fwd(Args args) {
    extern __shared__ __attribute__((aligned(16))) unsigned char lds[];
    Frame F;
    F.lds = (LAS unsigned char*)lds;
    F.MISC = (volatile LAS unsigned*)(F.lds + MISC_OFF);
    F.G = gridDim.x; { const int bx = blockIdx.x; F.vcu = (F.G % 8 == 0) ? (bx % 8) * (F.G / 8) + bx / 8 : bx; }
    unsigned char* ws = args.ws;
    F.ctl = (gu32*)(ws + WS_CTL);
    F.x = args.in[0]; F.norm_w = args.in[1]; F.w_in = args.in[2]; F.lb_logits = args.in[3]; F.hg_norm_w = args.in[4]; F.q_norm_w = args.in[5]; F.k_norm_w = args.in[6]; F.w_out = args.in[7];
    F.out = args.out;
    F.WIN = (bf16*)(ws + WS_WIN); F.WOUT = (bf16*)(ws + WS_WOUT); F.XB = (bf16*)(ws + WS_XB); F.MIXED = (bf16*)(ws + WS_MIXED); F.PROJ = (bf16*)(ws + WS_PROJ); F.QN = (bf16*)(ws + WS_QN); F.KN = (bf16*)(ws + WS_KN);
    F.LB = (float*)(ws + WS_LB); F.KMEAN = (float*)(ws + WS_KMEAN); F.ROWSS = (float*)(ws + WS_ROWSS);
    for (int u = threadIdx.x; u < (LDS_BYTES - LDSCTL_OFF) / 4; u += NWAVES * 64) ((LAS unsigned*)(F.lds + LDSCTL_OFF))[u] = 0u;
    __syncthreads();
    XcdBarrier bar; bar.bar = (unsigned*)(F.ctl + CW_BAR); bar.x = 0; bar.st = nullptr;
    if (N_LAUNCHES == 1) bar = xcd_barrier_post((unsigned*)(F.ctl + CW_BAR), F.MISC + 8);
#define GRID_BAR() do { if (N_LAUNCHES == 1) xcd_barrier(bar); } while (0)
    const int lo = args.ph_lo, hi = args.ph_hi;
#define IN(k) (lo <= (k) && (k) < hi)
#define BOTH(k) (IN(k) && IN((k) + 1))

    if (IN(0)) { p0_prologue(F); if (BOTH(0)) GRID_BAR(); }
    for (int l = 0; l < DEPTH; ++l) {
        const int pb = 1 + 4 * l;
        if (IN(pb)) {
            pg8::Gemm g{F.XB, F.WIN + (size_t)l * NIN * DM, MTOK, NIN, DM}; pg8::StaticOrder S; S.init(MTOK, NIN, F.G, (int)blockIdx.x);
            pg8::EpiProj E{F.PROJ, NIN, F.ROWSS};
            pg8::gemm_phase<pg8::EpiProj, pg8::StaticOrder, true, true>(F.lds + RING_OFF, g, S, E);
            if (BOTH(pb)) GRID_BAR();
        }
        if (IN(pb + 1)) { prep_phase(F, l); if (BOTH(pb + 1)) GRID_BAR(); }
        if (IN(pb + 2)) { hgrn_naive_phase(F, l); moba_mfma_phase(F, l); if (BOTH(pb + 2)) GRID_BAR(); }
        if (IN(pb + 3)) {
            pg8::Gemm g{F.MIXED, F.WOUT + (size_t)l * DM * DM, MTOK, DM, DM}; pg8::StaticOrder S; S.init(MTOK, DM, F.G, (int)blockIdx.x);
            pg8::EpiOut E{l == 0 ? F.x : F.out, F.out, F.XB, F.ROWSS};
            pg8::gemm_phase<pg8::EpiOut, pg8::StaticOrder, true, true>(F.lds + RING_OFF, g, S, E);
            if (pb + 3 < N_PHASES - 1 && BOTH(pb + 3)) GRID_BAR();
        }
    }
#undef IN
#undef BOTH
}

extern "C" void kernel_launch(void* const* d_in, const int* in_sizes, int n_in, void* d_out, int out_size, void* d_ws, size_t ws_size, hipStream_t stream) {
    static int grid = 0;
    if (grid == 0) {
        if (n_in != 8 || in_sizes[0] != MTOK * DM || out_size != MTOK * DM || ws_size < WS_END) { fprintf(stderr, "kernel_launch: unexpected shapes n_in %d in0 %d out %d ws %zu\n", n_in, n_in > 0 ? in_sizes[0] : -1, out_size, ws_size); grid = -1; return; }
        int dev = 0, cus = 0, per_cu = 0;
        if (hipGetDevice(&dev) != hipSuccess || hipDeviceGetAttribute(&cus, hipDeviceAttributeMultiprocessorCount, dev) != hipSuccess) { grid = -1; return; }
        if (hipFuncSetAttribute((const void*)fwd, hipFuncAttributeMaxDynamicSharedMemorySize, LDS_BYTES) != hipSuccess) { fprintf(stderr, "kernel_launch: hipFuncSetAttribute failed\n"); grid = -1; return; }
        if (hipOccupancyMaxActiveBlocksPerMultiprocessor(&per_cu, (const void*)fwd, NWAVES * 64, LDS_BYTES) != hipSuccess || per_cu < 1) fprintf(stderr, "kernel_launch: occupancy query says %d\n", per_cu);
        (void)hipGetLastError();
        if (per_cu < 1) { grid = -1; return; }
        grid = cus;
    }
    if (grid < 0) return;
    if (hipMemsetAsync((char*)d_ws + WS_CTL, 0, CTL_ZERO_BYTES, stream) != hipSuccess) return;
    Args a{};
    for (int i = 0; i < 8; ++i) a.in[i] = (const float*)d_in[i];
    a.out = (float*)d_out; a.ws = (unsigned char*)d_ws;
    for (int li = 0; li < N_LAUNCHES; ++li) {
        a.ph_lo = (N_LAUNCHES == 1) ? 0 : li; a.ph_hi = (N_LAUNCHES == 1) ? N_PHASES : li + 1; a.li = li;
        hipError_t le;
        if (N_LAUNCHES == 1) { void* kargs[] = {(void*)&a}; le = hipLaunchCooperativeKernel((const void*)fwd, dim3(grid), dim3(NWAVES * 64), kargs, LDS_BYTES, stream); }
        else { hipLaunchKernelGGL(fwd, dim3(grid), dim3(NWAVES * 64), LDS_BYTES, stream, a); le = hipPeekAtLastError(); }
        if (le != hipSuccess) { fprintf(stderr, "kernel_launch: launch %d failed: %s\n", li, hipGetErrorName(le)); break; }
    }
}
```

```cpp
#include <hip/hip_runtime.h>
#include <cstdio>
#include <cstdint>
namespace pg8 {
#define PG8_LAS __attribute__((address_space(3)))
typedef unsigned short bf16_t;
typedef short bf16x8 __attribute__((ext_vector_type(8)));
typedef float f32x4 __attribute__((ext_vector_type(4)));
typedef unsigned u32x4 __attribute__((ext_vector_type(4)));
typedef unsigned u32x2 __attribute__((ext_vector_type(2)));
constexpr int BM = 256, BK = 64, HALF = 128, HTB = HALF * BK * 2  , STAGE_BYTES = 8 * HTB, NXCD = 8, WGM = 8;

__host__ __device__ __forceinline__ int lds_byte(int r, int c) { const int st = (r >> 4) * 2 + (c >> 5), rr = r & 15, cc = c & 31, ob = rr * 64 + cc * 2; return st * 1024 + (ob ^ (((ob >> 9) & 1) << 5)); }
__host__ __device__ __forceinline__ void stage_rc(int b, int& R, int& C) { const int st = b / 1024, sb = b % 1024, swz = sb ^ (((sb >> 9) & 1) << 5); R = (st >> 1) * 16 + swz / 64; C = (st & 1) * 32 + (swz % 64) / 2; }
__host__ __device__ __forceinline__ int perm32(int rho) { const int n = rho >> 4, i = rho & 15; return 8 * (i >> 2) + 4 * n + (i & 3); }

struct Unit { int pm, pn; };
struct Gemm { const bf16_t* A; const bf16_t* Bt; int M, N, K; };

struct StaticOrder {
    int nM, nN, nwg, G, c;
    __host__ __device__ void init(int M, int N, int G_, int c_) { nM = M / BM; nN = N / BM; nwg = nM * nN; G = G_; c = c_; }
    __host__ __device__ bool next(int i, Unit& u) const {
        const long L = (long)i * G + c; if (L >= nwg) return false;
        int wgid = (int)L; { const int q = nwg / NXCD, r = nwg % NXCD, xcd = wgid % NXCD, off = wgid / NXCD; wgid = (xcd < r ? xcd * (q + 1) : r * (q + 1) + (xcd - r) * q) + off; }
        const int nig = WGM * nN, gid = wgid / nig, fm = gid * WGM, gsz = (nM - fm) < WGM ? (nM - fm) : WGM;
        u.pm = fm + ((wgid % nig) % gsz); u.pn = (wgid % nig) / gsz; return true;
    }
    __device__ __forceinline__ void a_ready(const Unit&) const {}
    __device__ __forceinline__ void done(const Unit&) const {}
};

__device__ __forceinline__ unsigned cvt_pk_bf16(float lo, float hi) { unsigned r; asm volatile("v_cvt_pk_bf16_f32 %0, %1, %2" : "=v"(r) : "v"(lo), "v"(hi)); return r; }


__device__ __forceinline__ float dpp_row_shr(float v, int n) {
    const int x = __builtin_bit_cast(int, v);
    int r;
    if (n == 1) r = __builtin_amdgcn_update_dpp(0, x, 0x111, 0xf, 0xf, false);
    else if (n == 2) r = __builtin_amdgcn_update_dpp(0, x, 0x112, 0xf, 0xf, false);
    else if (n == 4) r = __builtin_amdgcn_update_dpp(0, x, 0x114, 0xf, 0xf, false);
    else r = __builtin_amdgcn_update_dpp(0, x, 0x118, 0xf, 0xf, false);
    return __builtin_bit_cast(float, r);
}
__device__ __forceinline__ float fsig(float z) { return __builtin_amdgcn_rcpf(1.0f + __expf(-z)); }
struct EpiFused {
    static constexpr bool PERM = true, AFTER_DRAIN = false;
    bf16_t* ARR; float* DEC; float* KPART; const float* rowss; const float* lb; const float* qg; const float* kg;
    static constexpr size_t AS = (size_t)32768 * 512;
    __device__ __forceinline__ float rstd_of(int row) const {
        const f32x4* rp = (const f32x4*)(rowss + (size_t)row * 16);
        const f32x4 a = rp[0], b = rp[1], c = rp[2], d = rp[3];
        const float ss = ((a[0] + a[1]) + (a[2] + a[3])) + ((b[0] + b[1]) + (b[2] + b[3])) + ((c[0] + c[1]) + (c[2] + c[3])) + ((d[0] + d[1]) + (d[2] + d[3]));
        return 1.0f / sqrtf(ss * (1.0f / 1024.0f) + 1e-6f);
    }
    static __device__ __forceinline__ u32x4 pack8(const float (&v)[8]) { u32x4 w; w.x = cvt_pk_bf16(v[0], v[1]); w.y = cvt_pk_bf16(v[2], v[3]); w.z = cvt_pk_bf16(v[4], v[5]); w.w = cvt_pk_bf16(v[6], v[7]); return w; }
    __device__ __forceinline__ void operator()(const f32x4 (&acc)[2][2][4][2], const Unit& u, int wr, int wc, int fr, int fq) const {
        const int row0 = u.pm * BM + wr * 64 + fr; const int pn = u.pn;
        if (pn < 4) {
            const int cb = pn * 128 + wc * 32 + 8 * fq;
            float lbv[8];
#pragma unroll
            for (int k = 0; k < 8; ++k) lbv[k] = lb[cb + k];
#pragma unroll
            for (int ai = 0; ai < 2; ++ai)
#pragma unroll
                for (int m = 0; m < 4; ++m) { const int row = row0 + ai * HALF + m * 16; const float rs = rstd_of(row);
                    float qi[8], kt[8], dc[8];
#pragma unroll
                    for (int k = 0; k < 8; ++k) { const float zq = acc[ai][0][m][k >> 2][k & 3] * rs, zf = acc[ai][1][m][k >> 2][k & 3] * rs;
                        const float f = lbv[k] + (1.0f - lbv[k]) * fsig(zf);
                        float b = __logf(f);
                        b += dpp_row_shr(b, 1); b += dpp_row_shr(b, 2); b += dpp_row_shr(b, 4); b += dpp_row_shr(b, 8);
                        const float e = __expf(b);
                        qi[k] = zq * fsig(zq) * e; kt[k] = (1.0f - f) * __expf(fminf(-b, 80.0f)); dc[k] = e; }
                    *(u32x4*)(ARR + (size_t)row * 512 + cb) = pack8(qi); *(u32x4*)(ARR + AS + (size_t)row * 512 + cb) = pack8(kt);
                    if (fr == 15) { float* dp = DEC + (size_t)(row >> 4) * 512 + cb; *(f32x4*)dp = (f32x4){dc[0], dc[1], dc[2], dc[3]}; *(f32x4*)(dp + 4) = (f32x4){dc[4], dc[5], dc[6], dc[7]}; }
                    asm volatile("" ::: "memory"); }
        } else if (pn < 8) {
            const int cb = (pn - 4) * 128 + wc * 32 + 8 * fq;
#pragma unroll
            for (int ai = 0; ai < 2; ++ai)
#pragma unroll
                for (int m = 0; m < 4; ++m) { const int row = row0 + ai * HALF + m * 16; const float rs = rstd_of(row);
                    float iv[8], gv[8];
#pragma unroll
                    for (int k = 0; k < 8; ++k) { iv[k] = acc[ai][0][m][k >> 2][k & 3] * rs; const float zg = acc[ai][1][m][k >> 2][k & 3] * rs; gv[k] = zg * fsig(zg); }
                    *(u32x4*)(ARR + 2 * AS + (size_t)row * 512 + cb) = pack8(iv); *(u32x4*)(ARR + 3 * AS + (size_t)row * 512 + cb) = pack8(gv);
                    asm volatile("" ::: "memory"); }
        } else {
            const int ty = (pn - 8) >> 1, head = 4 * ((pn - 8) & 1) + wc; const int d0 = 8 * fq;
            bf16_t* dst = ARR + (size_t)(4 + ty) * AS;
            float gain[2][8]; float csum[2][8];
#pragma unroll
            for (int bj = 0; bj < 2; ++bj)
#pragma unroll
                for (int k = 0; k < 8; ++k) { gain[bj][k] = (ty == 0) ? qg[bj * 32 + d0 + k] * (0.125f * 1.4426950408889634f) : (ty == 1) ? kg[bj * 32 + d0 + k] : 1.0f; csum[bj][k] = 0.f; }
#pragma unroll
            for (int ai = 0; ai < 2; ++ai)
#pragma unroll
                for (int m = 0; m < 4; ++m) { const int row = row0 + ai * HALF + m * 16; const float rs = rstd_of(row);
                    float v[2][8];
#pragma unroll
                    for (int bj = 0; bj < 2; ++bj)
#pragma unroll
                        for (int k = 0; k < 8; ++k) v[bj][k] = acc[ai][bj][m][k >> 2][k & 3] * rs;
                    if (ty < 2) { float ss = 0.f;
#pragma unroll
                        for (int bj = 0; bj < 2; ++bj)
#pragma unroll
                            for (int k = 0; k < 8; ++k) ss += v[bj][k] * v[bj][k];
                        ss += __shfl_xor(ss, 16); ss += __shfl_xor(ss, 32);
                        const float r2 = 1.0f / sqrtf(ss * (1.0f / 64.0f) + 1e-6f);
#pragma unroll
                        for (int bj = 0; bj < 2; ++bj)
#pragma unroll
                            for (int k = 0; k < 8; ++k) { v[bj][k] *= r2 * gain[bj][k]; csum[bj][k] += v[bj][k]; }
                    } else if (ty == 3) {
#pragma unroll
                        for (int bj = 0; bj < 2; ++bj)
#pragma unroll
                            for (int k = 0; k < 8; ++k) v[bj][k] = v[bj][k] * fsig(v[bj][k]); }
                    *(u32x4*)(dst + (size_t)row * 512 + head * 64 + d0) = pack8(v[0]); *(u32x4*)(dst + (size_t)row * 512 + head * 64 + 32 + d0) = pack8(v[1]);
                    asm volatile("" ::: "memory"); }
            if (ty == 1) {
#pragma unroll
                for (int bj = 0; bj < 2; ++bj)
#pragma unroll
                    for (int k = 0; k < 8; ++k) { float s = csum[bj][k]; s += __shfl_xor(s, 1); s += __shfl_xor(s, 2); s += __shfl_xor(s, 4); s += __shfl_xor(s, 8); csum[bj][k] = s; }
                if (fr == 0) { float* kp = KPART + ((size_t)u.pm * 2 + wr) * 512 + head * 64 + d0;
#pragma unroll
                    for (int bj = 0; bj < 2; ++bj) { *(f32x4*)(kp + bj * 32) = (f32x4){csum[bj][0], csum[bj][1], csum[bj][2], csum[bj][3]}; *(f32x4*)(kp + bj * 32 + 4) = (f32x4){csum[bj][4], csum[bj][5], csum[bj][6], csum[bj][7]}; } }
            }
        }
    }
};
struct EpiOut {
    static constexpr bool PERM = false, AFTER_DRAIN = false;
    const float* xres; float* out; bf16_t* xb; float* rowss;
    __device__ __forceinline__ void operator()(const f32x4 (&acc)[2][2][4][2], const Unit& u, int wr, int wc, int fr, int fq) const {
        const int col0 = u.pn * BM + wc * 32 + 4 * fq;
#pragma unroll
        for (int ai = 0; ai < 2; ++ai)
#pragma unroll
            for (int m = 0; m < 4; ++m) {
                const int row = u.pm * BM + ai * HALF + wr * 64 + m * 16 + fr; float ss = 0.f;
#pragma unroll
                for (int bj = 0; bj < 2; ++bj)
#pragma unroll
                    for (int n = 0; n < 2; ++n) { const size_t off = (size_t)row * 1024 + col0 + bj * HALF + n * 16;
                        const f32x4 v = *(const f32x4*)(xres + off) + acc[ai][bj][m][n];
                        *(f32x4*)(out + off) = v; if (xb) { u32x2 w; w.x = cvt_pk_bf16(v[0], v[1]); w.y = cvt_pk_bf16(v[2], v[3]); *(u32x2*)(xb + off) = w; }
                        ss += (v[0] * v[0] + v[1] * v[1]) + (v[2] * v[2] + v[3] * v[3]); }
                ss += __shfl_xor(ss, 16); ss += __shfl_xor(ss, 32);
                if (fq == 0 && rowss) rowss[(size_t)row * 16 + u.pn * 4 + wc] = ss;
            }
    }
};

template <class Epi, class Sched, bool ALIGN_EPI = false, bool SP2 = false>
__device__ __forceinline__ void gemm_phase(PG8_LAS unsigned char* lds, const Gemm g, const Sched& S, const Epi& E) {
    int tid = threadIdx.x; asm volatile("" : "+v"(tid));
    const int wid = __builtin_amdgcn_readfirstlane(tid >> 6), lane = tid & 63, wr = wid >> 2, wc = wid & 3, fr = lane & 15, fq = lane >> 4;
    const int K = g.K, nt = K / BK;
    unsigned voffA[2], voffB[2];
#pragma unroll
    for (int i = 0; i < 2; ++i) { int R, C; stage_rc(tid * 16 + i * 8192, R, C); const int Rb = Epi::PERM ? ((R & ~31) + perm32(R & 31)) : R;
        voffA[i] = (unsigned)(R * K + C) * 2u; voffB[i] = (unsigned)(Rb * K + C) * 2u; }
    const size_t kstep = (size_t)(BK * 2);
    const size_t hstep = (size_t)HALF * K * 2;
    const size_t tstep = 2 * hstep;
    const unsigned ldsw = (unsigned)wid * 1024u;
    const int aoff = lds_byte(wr * 64 + fr, fq * 8), boff = lds_byte(wc * 32 + fr, fq * 8);
#define PG8_SA(b, h) (((b) * 2 + (h)) * HTB)
#define PG8_SB(b, h) ((4 + (b) * 2 + (h)) * HTB)
#define PG8_STAGE(bufoff, gbase, voff) do { _Pragma("unroll") for (int _i = 0; _i < 2; ++_i) \
        __builtin_amdgcn_global_load_lds((const unsigned*)((const char*)(gbase) + (voff)[_i]), (PG8_LAS unsigned*)(lds + (bufoff) + ldsw + _i * 8192), 16, 0, 0); } while (0)
#define PG8_LDA(dst, b, h) do { _Pragma("unroll") for (int m = 0; m < 4; ++m) _Pragma("unroll") for (int k = 0; k < 2; ++k) dst[m][k] = *(const PG8_LAS bf16x8*)(lds + PG8_SA(b, h) + aoff + m * 2048 + k * 1024); } while (0)
#define PG8_LDB(dst, b, h) do { _Pragma("unroll") for (int n = 0; n < 2; ++n) _Pragma("unroll") for (int k = 0; k < 2; ++k) dst[n][k] = *(const PG8_LAS bf16x8*)(lds + PG8_SB(b, h) + boff + n * 2048 + k * 1024); } while (0)
#define PG8_MMA(ai, bj, At, Bt) do { __builtin_amdgcn_s_setprio(1); _Pragma("unroll") for (int m = 0; m < 4; ++m) _Pragma("unroll") for (int n = 0; n < 2; ++n) _Pragma("unroll") for (int k = 0; k < 2; ++k) \
        acc[ai][bj][m][n] = __builtin_amdgcn_mfma_f32_16x16x32_bf16(Bt[n][k], At[m][k], acc[ai][bj][m][n], 0, 0, 0); __builtin_amdgcn_s_setprio(0); } while (0)
#define PG8_WAIT_V(n) asm volatile("s_waitcnt vmcnt(" #n ")" ::: "memory")
#define PG8_WAIT_L(n) asm volatile("s_waitcnt lgkmcnt(" #n ")" ::: "memory")
#define PG8_BAR __builtin_amdgcn_s_barrier()
#define PG8_SCHED __builtin_amdgcn_sched_barrier(0)
    Unit cur, nxt; int ui = 0;
    if (!S.next(0, cur)) return;
    f32x4 acc[2][2][4][2];
#pragma unroll
    for (int a = 0; a < 2; ++a)
#pragma unroll
        for (int b = 0; b < 2; ++b)
#pragma unroll
            for (int m = 0; m < 4; ++m)
#pragma unroll
                for (int n = 0; n < 2; ++n) acc[a][b][m][n] = (f32x4){0.f, 0.f, 0.f, 0.f};
    bf16x8 At[4][2], B0[2][2], B1[2][2];
    const char* cA = (const char*)g.A + (size_t)cur.pm * tstep; const char* cB = (const char*)g.Bt + (size_t)cur.pn * tstep;
    S.a_ready(cur);
    if constexpr (SP2) {
        PG8_STAGE(PG8_SB(0, 0), cB, voffB); PG8_STAGE(PG8_SB(0, 1), cB + hstep, voffB); PG8_STAGE(PG8_SA(0, 0), cA, voffA); PG8_STAGE(PG8_SA(0, 1), cA + hstep, voffA);
        if (wr == 1) PG8_BAR;
        PG8_WAIT_V(2); PG8_BAR;
        PG8_STAGE(PG8_SB(1, 0), cB + kstep, voffB); PG8_STAGE(PG8_SA(1, 0), cA + kstep, voffA); PG8_STAGE(PG8_SB(1, 1), cB + hstep + kstep, voffB);
        PG8_WAIT_V(6); PG8_BAR;
    } else {
        PG8_STAGE(PG8_SB(0, 0), cB, voffB); PG8_STAGE(PG8_SA(0, 0), cA, voffA); PG8_STAGE(PG8_SB(0, 1), cB + hstep, voffB); PG8_STAGE(PG8_SA(0, 1), cA + hstep, voffA);
        if (wr == 1) PG8_BAR;
        PG8_WAIT_V(4); PG8_BAR;
        PG8_STAGE(PG8_SB(1, 0), cB + kstep, voffB); PG8_STAGE(PG8_SA(1, 0), cA + kstep, voffA); PG8_STAGE(PG8_SB(1, 1), cB + hstep + kstep, voffB);
        PG8_WAIT_V(6); PG8_BAR;
    }
    for (;;) {
        const bool has_next = S.next(ui + 1, nxt);
        const char* nA = has_next ? (const char*)g.A + (size_t)nxt.pm * tstep : cA; const char* nB = has_next ? (const char*)g.Bt + (size_t)nxt.pn * tstep : cB;
        for (int t = 0; t < nt; t += 2) {
            const bool last = (t == nt - 2);
            const char* a1 = cA + (size_t)(t + 1) * kstep;
            const char* a2 = last ? nA : cA + (size_t)(t + 2) * kstep; const char* b2 = last ? nB : cB + (size_t)(t + 2) * kstep;
            const char* a3 = a2 + kstep; const char* b3 = b2 + kstep;
            if (last && has_next) S.a_ready(nxt);
            if constexpr (SP2) {
            PG8_LDB(B0, 0, 0); PG8_LDB(B1, 0, 1); PG8_SCHED; PG8_LDA(At, 0, 0); PG8_STAGE(PG8_SA(1, 1), a1 + hstep, voffA);
            PG8_WAIT_V(8); PG8_WAIT_L(0); PG8_BAR; PG8_MMA(0, 0, At, B0); PG8_MMA(0, 1, At, B1); PG8_BAR; PG8_SCHED;
            PG8_LDA(At, 0, 1); PG8_STAGE(PG8_SB(0, 0), b2, voffB); PG8_STAGE(PG8_SB(0, 1), b2 + hstep, voffB); PG8_STAGE(PG8_SA(0, 0), a2, voffA);
            PG8_WAIT_V(8); PG8_WAIT_L(0); PG8_BAR; PG8_MMA(1, 0, At, B0); PG8_MMA(1, 1, At, B1); PG8_BAR; PG8_SCHED;
            PG8_LDB(B0, 1, 0); PG8_LDB(B1, 1, 1); PG8_SCHED; PG8_LDA(At, 1, 0); PG8_STAGE(PG8_SA(0, 1), a2 + hstep, voffA);
            PG8_WAIT_V(8); PG8_WAIT_L(0); PG8_BAR; PG8_MMA(0, 0, At, B0); PG8_MMA(0, 1, At, B1); PG8_BAR; PG8_SCHED;
            PG8_LDA(At, 1, 1); PG8_STAGE(PG8_SB(1, 0), b3, voffB); PG8_STAGE(PG8_SB(1, 1), b3 + hstep, voffB); PG8_STAGE(PG8_SA(1, 0), a3, voffA);
            PG8_WAIT_V(8); PG8_WAIT_L(0); PG8_BAR; PG8_MMA(1, 0, At, B0); PG8_MMA(1, 1, At, B1); PG8_BAR; PG8_SCHED;
            } else {
            PG8_LDB(B0, 0, 0); PG8_SCHED; PG8_LDA(At, 0, 0); PG8_STAGE(PG8_SA(1, 1), a1 + hstep, voffA);
            PG8_WAIT_L(8); PG8_BAR; PG8_WAIT_L(0); PG8_MMA(0, 0, At, B0); PG8_BAR; PG8_SCHED;
            PG8_LDB(B1, 0, 1); PG8_STAGE(PG8_SB(0, 0), b2, voffB);
            PG8_BAR; PG8_WAIT_L(0); PG8_MMA(0, 1, At, B1); PG8_BAR;
            PG8_LDA(At, 0, 1); PG8_STAGE(PG8_SA(0, 0), a2, voffA);
            PG8_BAR; PG8_WAIT_L(0); PG8_MMA(1, 0, At, B0); PG8_BAR; PG8_SCHED;
            PG8_STAGE(PG8_SB(0, 1), b2 + hstep, voffB);
            PG8_WAIT_V(6); PG8_BAR; PG8_MMA(1, 1, At, B1); PG8_BAR;
            PG8_LDB(B0, 1, 0); PG8_SCHED; PG8_LDA(At, 1, 0); PG8_STAGE(PG8_SA(0, 1), a2 + hstep, voffA);
            PG8_WAIT_L(8); PG8_BAR; PG8_WAIT_L(0); PG8_MMA(0, 0, At, B0); PG8_BAR; PG8_SCHED;
            PG8_LDB(B1, 1, 1); PG8_STAGE(PG8_SB(1, 0), b3, voffB);
            PG8_BAR; PG8_WAIT_L(0); PG8_MMA(0, 1, At, B1); PG8_BAR;
            PG8_LDA(At, 1, 1); PG8_STAGE(PG8_SA(1, 0), a3, voffA);
            PG8_BAR; PG8_WAIT_L(0); PG8_MMA(1, 0, At, B0); PG8_BAR; PG8_SCHED;
            PG8_STAGE(PG8_SB(1, 1), b3 + hstep, voffB);
            PG8_WAIT_V(6); PG8_BAR; PG8_MMA(1, 1, At, B1); PG8_BAR;
            }
        }
        if constexpr (ALIGN_EPI) { if (wr == 0) PG8_BAR; }
        if constexpr (!Epi::AFTER_DRAIN) { E(acc, cur, wr, wc, fr, fq); S.done(cur); }
        if (!has_next) break;
#pragma unroll
        for (int a = 0; a < 2; ++a)
#pragma unroll
            for (int b = 0; b < 2; ++b)
#pragma unroll
                for (int m = 0; m < 4; ++m)
#pragma unroll
                    for (int n = 0; n < 2; ++n) acc[a][b][m][n] = (f32x4){0.f, 0.f, 0.f, 0.f};
        cur = nxt; cA = nA; cB = nB; ++ui;
        if constexpr (ALIGN_EPI) { if (wr == 1) PG8_BAR; }
    }
    PG8_WAIT_V(0);
    if constexpr (!ALIGN_EPI) { if (wr == 0) PG8_BAR; }
    PG8_BAR;
    if constexpr (Epi::AFTER_DRAIN) { E.fused(acc, cur, wr, wc, fr, fq, lds, wid, lane); S.done(cur); }
#undef PG8_SA
#undef PG8_SB
#undef PG8_STAGE
#undef PG8_LDA
#undef PG8_LDB
#undef PG8_MMA
#undef PG8_WAIT_V
#undef PG8_WAIT_L
#undef PG8_BAR
#undef PG8_SCHED
}
}


constexpr int NWAVES = 8;
#ifndef MK_N_LAUNCHES
#define MK_N_LAUNCHES 1
#endif
constexpr int N_PHASES = 7;
constexpr int N_LAUNCHES = MK_N_LAUNCHES;

constexpr int BATCH = 16, SEQ = 2048, DM = 1024, DEPTH = 2, MTOK = BATCH * SEQ, NIN = 4096;
constexpr int C_HQ = 0, C_HF = 512, C_HI = 1024, C_HG = 1536, C_AQ = 2048, C_AK = 2560, C_AV = 3072, C_AG = 3584;
constexpr float NORM_EPS = 1e-6f;

constexpr size_t MiB = 1u << 20;
constexpr size_t WS_CTL = 0, CTL_ZERO_BYTES = 1 * MiB;
constexpr size_t WS_WIN = 2 * MiB;
constexpr size_t WS_WOUT = 18 * MiB;
constexpr size_t WS_LB = 22 * MiB;
constexpr size_t WS_KPART = 22 * MiB + 65536;
constexpr size_t WS_ROWSS = 24 * MiB;
constexpr size_t WS_DEC = 28 * MiB;
constexpr size_t WS_XB = 32 * MiB;
constexpr size_t WS_MIXED = 160 * MiB;
constexpr size_t WS_ARR = 224 * MiB;
constexpr size_t ARR_BYTES = 32 * MiB;
constexpr size_t WS_END = 480 * MiB;
constexpr int CW_BAR = 4096;

constexpr int RING_OFF = 0, RING_BYTES = 131072;
constexpr int EXTRA_OFF = RING_BYTES, EXTRA_BYTES = 16384;
constexpr int LDSCTL_OFF = EXTRA_OFF + EXTRA_BYTES, MISC_OFF = LDSCTL_OFF + 320;
constexpr int LDS_BYTES = LDSCTL_OFF + 1024;

#define GAS __attribute__((address_space(1)))
#define LAS __attribute__((address_space(3)))
typedef unsigned short bf16;
typedef unsigned v4u __attribute__((ext_vector_type(4)));
typedef float f32x4 __attribute__((ext_vector_type(4)));
typedef GAS unsigned gu32;
#define RLX_AGENT __ATOMIC_RELAXED, __HIP_MEMORY_SCOPE_AGENT
#define LDS_WAIT() asm volatile("s_waitcnt lgkmcnt(0)" ::: "memory")
#define VM_WAIT() asm volatile("s_waitcnt vmcnt(0)" ::: "memory")
__device__ __forceinline__ unsigned f2bf(float f) { unsigned u = __builtin_bit_cast(unsigned, f); return (u + 0x7fffu + ((u >> 16) & 1u)) >> 16; }
__device__ __forceinline__ unsigned pk2(float lo, float hi) { return f2bf(lo) | (f2bf(hi) << 16); }
__device__ __forceinline__ float bf2f(unsigned short b) { return __builtin_bit_cast(float, (unsigned)b << 16); }
__device__ __forceinline__ float bflo(unsigned w) { return __builtin_bit_cast(float, w << 16); }
__device__ __forceinline__ float bfhi(unsigned w) { return __builtin_bit_cast(float, w & 0xffff0000u); }
__device__ __forceinline__ float silu_f(float z) { return z / (1.0f + __expf(-z)); }
__device__ __forceinline__ float sigmoid_f(float z) { return 1.0f / (1.0f + __expf(-z)); }

#define XB_TMO      128
#define XB_XCNT(j)  (256  + 64 * (j))
#define XB_XSUB(j)  (1280 + 64 * (j))
#define XB_XGEN(j)  (2304 + 64 * (j))
#define XB_TOP      3328
#define XB_TOPGEN   3392
#define XCD_BAR_WORDS 3456
#define XB_SPIN_CAP (1u << 18)

__device__ __forceinline__ unsigned xb_ld(unsigned* p)              { return __hip_atomic_load(p, __ATOMIC_RELAXED, __HIP_MEMORY_SCOPE_AGENT); }
__device__ __forceinline__ unsigned xb_add(unsigned* p, unsigned v) { return __hip_atomic_fetch_add(p, v, __ATOMIC_RELAXED, __HIP_MEMORY_SCOPE_AGENT); }
__device__ __forceinline__ unsigned xb_xcc_id() { return (unsigned)__builtin_amdgcn_s_getreg((3 << 11) | 20) & 0xFu; }
#define XB_SPIN(cond, bar) do { unsigned _sp = 0; while (cond) { __builtin_amdgcn_s_sleep(1); \
    if ((++_sp & 255u) == 0u) { if (xb_ld(&(bar)[XB_TMO])) break; if (_sp > XB_SPIN_CAP) { atomicAdd(&(bar)[XB_TMO], 1u); break; } } } } while (0)

struct XcdBarrier {
    unsigned* bar; unsigned x;
    volatile LAS unsigned* st;
};

__device__ __forceinline__ XcdBarrier xcd_barrier_post(unsigned* bar, volatile LAS unsigned* st) {
    XcdBarrier b; b.bar = bar; b.x = xb_xcc_id(); b.st = st;
    if (threadIdx.x == 0) (void)xb_add(&bar[XB_XCNT(b.x)], 1u);
    return b;
}
__device__ __forceinline__ void xcd_barrier_complete(unsigned* bar, unsigned x, unsigned& nloc, unsigned& nx) {
    const unsigned G = gridDim.x * gridDim.y * gridDim.z;
    unsigned sum, cnt, mine, sp = 0u;
    for (;;) {
        sum = 0u; cnt = 0u; mine = 0u;
#pragma unroll
        for (unsigned j = 0; j < 16; ++j) { const unsigned c = xb_ld(&bar[XB_XCNT(j)]); sum += c; cnt += (c > 0u) ? 1u : 0u; mine = (j == x) ? c : mine; }
        if (sum == G) break;
        __builtin_amdgcn_s_sleep(1);
        if ((++sp & 255u) == 0u) { if (xb_ld(&bar[XB_TMO])) break; if (sp > XB_SPIN_CAP) { atomicAdd(&bar[XB_TMO], 1u); break; } }
    }
    nloc = mine > 0u ? mine : 1u; nx = cnt > 0u ? cnt : 1u;
}

__device__ __forceinline__ void xcd_barrier(const XcdBarrier& b) {
    asm volatile("s_waitcnt vmcnt(0)" ::: "memory");
    __syncthreads();
    if (threadIdx.x == 0) {
        unsigned* bar = b.bar;
        __builtin_amdgcn_s_waitcnt(0);
        unsigned nloc = b.st[0], nx = b.st[1];
        if (nloc == 0u) { xcd_barrier_complete(bar, b.x, nloc, nx); b.st[0] = nloc; b.st[1] = nx; }
        const unsigned old = xb_add(&bar[XB_XSUB(b.x)], 1u);
        const unsigned gen = old / nloc;
        if (old + 1u == (gen + 1u) * nloc) {
            __builtin_amdgcn_fence(__ATOMIC_RELEASE, "agent");
            asm volatile("s_waitcnt vmcnt(0)" ::: "memory");
            const unsigned og = xb_add(&bar[XB_TOP], 1u);
            const unsigned tg = og / nx;
            if (og + 1u == (tg + 1u) * nx) xb_add(&bar[XB_TOPGEN], 1u);
            else XB_SPIN(xb_ld(&bar[XB_TOPGEN]) == tg, bar);
            __builtin_amdgcn_fence(__ATOMIC_ACQUIRE, "agent");
            xb_add(&bar[XB_XGEN(b.x)], 1u);
            asm volatile("s_waitcnt vmcnt(0)" ::: "memory");
        } else {
            XB_SPIN(xb_ld(&bar[XB_XGEN(b.x)]) == gen, bar);
            __builtin_amdgcn_fence(__ATOMIC_ACQUIRE, "agent");
            asm volatile("s_waitcnt vmcnt(0)" ::: "memory");
        }
    }
    __syncthreads();
}


struct Frame {
    LAS unsigned char* lds;
    volatile LAS unsigned* MISC;
    gu32* ctl;
    int vcu, G;
    const float* x; float* out;
    const float *norm_w, *w_in, *lb_logits, *hg_norm_w, *q_norm_w, *k_norm_w, *w_out;
    bf16 *WIN, *WOUT, *XB, *MIXED, *QI, *KT, *HI, *GH, *QN, *KN, *V, *GA;
    float *LB, *KPART, *ROWSS, *DEC;
};

__device__ __forceinline__ float wave_sum(float v) {
#pragma unroll
    for (int o = 1; o < 64; o <<= 1) v += __shfl_xor(v, o);
    return v;
}
__device__ __forceinline__ int win_dest(int oc) {
    if (oc < 2048) { const int grp = oc >> 9, hh = (oc >> 7) & 3, w = oc & 127; return 256 * (((grp >> 1) << 2) + hh) + 128 * (grp & 1) + w; }
    const int ty = (oc - 2048) >> 9, head = (oc >> 6) & 7, bj = (oc >> 5) & 1; return 256 * (8 + 2 * ty + (head >> 2)) + 128 * bj + 32 * (head & 3);
}
__device__ __forceinline__ void p0_transpose_item(const float* W, int K, int N, bf16* WT, const float* kscale, LAS float* scr, int item, int lane, bool permute) {
    const int nblk = N / 32, kb = item / nblk, nb = item % nblk, k0 = 64 * kb, n0 = 32 * nb; const int nd = permute ? win_dest(n0) : n0;
#pragma unroll 8
    for (int i = 0; i < 32; ++i) { const int kk = 2 * i + (lane >> 5); const float s = kscale ? kscale[k0 + kk] : 1.0f; scr[kk * 33 + (lane & 31)] = W[(size_t)(k0 + kk) * N + n0 + (lane & 31)] * s; }
    LDS_WAIT(); asm volatile("" ::: "memory");
    const int c = lane & 7;
#pragma unroll
    for (int j = 0; j < 4; ++j) { const int n = (lane >> 3) + 8 * j; const LAS float* s = scr + (8 * c) * 33 + n;
        v4u o; o.x = pk2(s[0 * 33], s[1 * 33]); o.y = pk2(s[2 * 33], s[3 * 33]); o.z = pk2(s[4 * 33], s[5 * 33]); o.w = pk2(s[6 * 33], s[7 * 33]);
        *(GAS v4u*)(WT + (size_t)(nd + n) * K + k0 + 8 * c) = o; }
    LDS_WAIT(); asm volatile("" ::: "memory");
}
#define PHASE_IDS() int t_ = threadIdx.x; asm volatile("" : "+v"(t_)); const int tid = t_, lane = tid & 63, wave = __builtin_amdgcn_readfirstlane(tid >> 6); (void)lane; (void)wave
__device__ __forceinline__ void p0_prologue(Frame& F) {
    PHASE_IDS();
    LAS float* scr = (LAS float*)(F.lds + RING_OFF + wave * 16384);
    const int gw = F.vcu * NWAVES + wave, NGW = F.G * NWAVES;
    constexpr int I_IN = (DM / 64) * (NIN / 32), I_OUT = (DM / 64) * (DM / 32);
    constexpr int NITEMS = DEPTH * (I_IN + I_OUT);
    for (int it = gw; it < NITEMS; it += NGW) {
        int r = it;
        if (r < DEPTH * I_IN) { const int l = r / I_IN; r -= l * I_IN;
            p0_transpose_item(F.w_in + (size_t)l * DM * NIN, DM, NIN, F.WIN + (size_t)l * NIN * DM, F.norm_w + l * DM, scr, r, lane, true); continue; }
        r -= DEPTH * I_IN; { const int l = r / I_OUT; r -= l * I_OUT;
            p0_transpose_item(F.w_out + (size_t)l * DM * DM, DM, DM, F.WOUT + (size_t)l * DM * DM, nullptr, scr, r, lane, false); }
    }
    for (int m = gw; m < MTOK; m += NGW) {
        const GAS f32x4* xr = (const GAS f32x4*)(F.x + (size_t)m * DM) + lane;
        f32x4 v[4]; float s = 0.f;
#pragma unroll
        for (int j = 0; j < 4; ++j) { v[j] = xr[64 * j]; s += (v[j].x * v[j].x + v[j].y * v[j].y) + (v[j].z * v[j].z + v[j].w * v[j].w); }
        s = wave_sum(s);
        GAS unsigned long long* o8 = (GAS unsigned long long*)(F.XB + (size_t)m * DM) + lane;
#pragma unroll
        for (int j = 0; j < 4; ++j) o8[64 * j] = (unsigned long long)pk2(v[j].x, v[j].y) | ((unsigned long long)pk2(v[j].z, v[j].w) << 32);
        if (lane < 16) F.ROWSS[(size_t)m * 16 + lane] = (lane == 0) ? s : 0.f;
    }
    if (blockIdx.x == 0) { const int c = tid; const float a0 = F.lb_logits[c], a1 = F.lb_logits[512 + c]; const float mx = fmaxf(a0, a1);
        const float e0 = expf(a0 - mx), e1 = expf(a1 - mx); const float p0 = e0 / (e0 + e1), p1 = e1 / (e0 + e1);
        F.LB[c] = 0.f; F.LB[512 + c] = fminf(fmaxf((p0 + p1) - p0, 0.f), 1.0f - 1e-6f); }
}

constexpr float LOG2E = 1.4426950408889634f;
constexpr float QSCALE2 = 0.125f * LOG2E;
namespace moba {
typedef short bf16x8 __attribute__((ext_vector_type(8)));
typedef short s16x4 __attribute__((ext_vector_type(4)));
typedef float f32x16 __attribute__((ext_vector_type(16)));
typedef float f32x2_t __attribute__((ext_vector_type(2))); typedef __bf16 bf16x2_t __attribute__((ext_vector_type(2)));
__device__ __forceinline__ unsigned cvtpk(float lo, float hi) { f32x2_t v = {lo, hi}; bf16x2_t b = __builtin_convertvector(v, bf16x2_t); return __builtin_bit_cast(unsigned, b); }
__device__ __forceinline__ int crow(int r, int hi) { return (r & 3) + 8 * (r >> 2) + 4 * hi; }
constexpr int L_K = 0, L_V = 16384, L_WSF = 32768, L_KM = 34816, L_OST = 36864;
constexpr float NEG_BIG = -1e30f;
constexpr float THR = 8.0f;
__device__ __forceinline__ s16x4 vtr(const LAS unsigned char* p) { return __builtin_bit_cast(s16x4, __builtin_amdgcn_ds_read_tr16_b64_v4i16((LAS s16x4*)p)); }
}

__device__ __forceinline__ void moba_mfma_phase(Frame& F, int l) {
    using namespace moba;
    PHASE_IDS();
    const int r32 = lane & 31, hi = lane >> 5, wid = wave;
    LAS unsigned char* L = F.lds + RING_OFF;
    LAS float* wsf = (LAS float*)(L + L_WSF) + wid * 64;
    LAS float* km = (LAS float*)(L + L_KM);
    LAS float* ost = (LAS float*)(L + L_OST) + wid * 2048;
    float gq = fabsf(F.q_norm_w[l * 64 + lane]), gk = fabsf(F.k_norm_w[l * 64 + lane]);
#pragma unroll
    for (int o = 1; o < 64; o <<= 1) { gq = fmaxf(gq, __shfl_xor(gq, o)); gk = fmaxf(gk, __shfl_xor(gk, o)); }
    const float mhat0 = -(8.0f * gq * gk * LOG2E * 1.02f + 1.0f);
    for (int it = F.vcu; it < 1024; it += F.G) {
        const int rnd = it >> 8, v = it & 255;
        const int hf2 = v >> 7, bh = v & 127;
        const int qb = (rnd == 0) ? (hf2 ? 6 : 7) : (rnd == 1) ? (hf2 ? 1 : 0) : (rnd == 2) ? (hf2 ? 4 : 5) : (hf2 ? 3 : 2);
        const int b = bh >> 3, h = bh & 7; const size_t rowbase = (size_t)b * SEQ; const int q0 = qb * 256, qrel = wid * 32 + r32, tq = q0 + qrel;
        const float sl2 = exp2f(-(float)(h + 1)) * LOG2E;
        bf16x8 qr[4];
        { const GAS bf16* Qw = (const GAS bf16*)(F.QN + (rowbase + q0 + wid * 32 + r32) * 512 + h * 64 + hi * 8);
#pragma unroll
            for (int d0 = 0; d0 < 4; ++d0) qr[d0] = *(const GAS bf16x8*)(Qw + d0 * 16); }
        if (tid < qb * 64) { const GAS float* kp = (const GAS float*)(F.KPART + ((size_t)b * 8 + (tid >> 6)) * 1024 + h * 64 + (tid & 63)); km[tid] = (kp[0] + kp[512]) * (1.0f / 256.0f); }
        const GAS bf16* ksrc = (const GAS bf16*)(F.KN + (rowbase + lane) * 512 + h * 64 + wid * 8);
        const GAS bf16* vsrc = (const GAS bf16*)(F.V + (rowbase + (tid >> 3)) * 512 + h * 64 + (tid & 7) * 8);
        const int kdst = L_K + wid * 1024 + lane * 16;
        const int vrow = tid >> 3, vch = tid & 7;
        const int vdst = L_V + vrow * 128 + (((vch >> 2) ^ ((vrow >> 1) & 1)) * 64) + (vch & 3) * 16;
        const int NT = 4 * (qb + 1);
        v4u kreg = *(const GAS v4u*)(ksrc), vreg = *(const GAS v4u*)(vsrc);
        __syncthreads();
        *(LAS v4u*)(L + kdst) = kreg; *(LAS v4u*)(L + vdst) = vreg;
        unsigned selmask = 0;
        { float gt[7];
#pragma unroll
            for (int j = 0; j < 7; ++j) { float s = 0.f;
                if (j < qb) {
#pragma unroll
                    for (int d0 = 0; d0 < 4; ++d0)
#pragma unroll
                        for (int e = 0; e < 8; ++e) s += bf2f((unsigned short)qr[d0][e]) * km[j * 64 + d0 * 16 + hi * 8 + e];
                    auto rr = __builtin_amdgcn_permlane32_swap(__float_as_uint(s), __float_as_uint(s), false, false);
                    s = __uint_as_float(rr[0]) + __uint_as_float(rr[1]); }
                gt[j] = s; }
#pragma unroll
            for (int j = 0; j < 7; ++j) { int rank = 0;
#pragma unroll
                for (int i = 0; i < 7; ++i) if (i != j && i < qb) rank += (gt[i] > gt[j] || (gt[i] == gt[j] && i < j)) ? 1 : 0;
                if (j < qb && rank < 3) selmask |= 1u << j; } }
        float kb[16];
#pragma unroll
        for (int r = 0; r < 16; ++r) kb[r] = sl2 * (float)crow(r, hi);
        float mhat = mhat0, l_reg = 0.f; f32x16 o[2]; o[0] = f32x16{}; o[1] = f32x16{};
        const int kbase = L_K + hi * 1024 + r32 * 16;
        const int g16 = lane >> 4, i16 = lane & 15, tq4 = i16 >> 2, tp4 = i16 & 3;
        const int vrow0 = 4 * hi + tq4;
        __syncthreads();
        for (int t = 0; t < NT; ++t) {
            const int cur = t & 1;
            if (t + 1 < NT) { kreg = *(const GAS v4u*)(ksrc + (size_t)(t + 1) * 64 * 512); vreg = *(const GAS v4u*)(vsrc + (size_t)(t + 1) * 64 * 512); }
            const int blk = t >> 2; const bool own = (blk == qb); const int jb = t & 3;
            const bool skip = own && (64 * jb > 32 * wid + 31);
            if (!skip) {
                const bool sel = own || ((selmask >> blk) & 1u);
                const float sc0 = sel ? (-mhat - sl2 * (float)(tq - 64 * t)) : NEG_BIG; const float sc1 = sc0 + 32.0f * sl2;
                f32x16 p0, p1;
#pragma unroll
                for (int r = 0; r < 16; ++r) { p0[r] = sc0 + kb[r]; p1[r] = sc1 + kb[r]; }
#pragma unroll
                for (int d0 = 0; d0 < 4; ++d0) {
                    const bf16x8 b0 = *(const LAS bf16x8*)(L + cur * 8192 + kbase + d0 * 2048);
                    const bf16x8 b1 = *(const LAS bf16x8*)(L + cur * 8192 + kbase + d0 * 2048 + 512);
                    p0 = __builtin_amdgcn_mfma_f32_32x32x16_bf16(b0, qr[d0], p0, 0, 0, 0);
                    p1 = __builtin_amdgcn_mfma_f32_32x32x16_bf16(b1, qr[d0], p1, 0, 0, 0); }
                if (own && (64 * jb + 63 > 32 * wid)) {
#pragma unroll
                    for (int r = 0; r < 16; ++r) { const int kvl = 64 * jb + crow(r, hi); if (kvl > qrel) p0[r] = NEG_BIG; if (kvl + 32 > qrel) p1[r] = NEG_BIG; } }
                float rm = fmaxf(p0[0], p1[0]);
#pragma unroll
                for (int r = 1; r < 16; ++r) rm = fmaxf(rm, fmaxf(p0[r], p1[r]));
                { auto rr = __builtin_amdgcn_permlane32_swap(__float_as_uint(rm), __float_as_uint(rm), false, false); rm = fmaxf(__uint_as_float(rr[0]), __uint_as_float(rr[1])); }
                if (__any(rm > THR)) {
                    const float dl = fmaxf(rm, 0.f); mhat += dl;
#pragma unroll
                    for (int r = 0; r < 16; ++r) { p0[r] -= dl; p1[r] -= dl; }
                    const float f = __builtin_amdgcn_exp2f(-dl); l_reg *= f;
                    if (hi == 0) wsf[r32] = f;
#pragma unroll
                    for (int r = 0; r < 16; ++r) { const float fr = wsf[crow(r, hi)]; o[0][r] *= fr; o[1][r] *= fr; } }
                float sacc = 0.f;
#pragma unroll
                for (int r = 0; r < 16; ++r) { p0[r] = __builtin_amdgcn_exp2f(p0[r]); p1[r] = __builtin_amdgcn_exp2f(p1[r]); sacc += p0[r] + p1[r]; }
                l_reg += sacc;
                bf16x8 pa[4];
                { v4u w;
#pragma unroll
                    for (int ks = 0; ks < 4; ++ks) {
#pragma unroll
                        for (int e = 0; e < 4; ++e) { const int rb = (ks & 1) * 8 + 2 * e; w[e] = (ks < 2) ? cvtpk(p0[rb], p0[rb + 1]) : cvtpk(p1[rb], p1[rb + 1]); }
                        pa[ks] = __builtin_bit_cast(bf16x8, w); } }
#pragma unroll
                for (int dblk = 0; dblk < 2; ++dblk)
#pragma unroll
                    for (int ks = 0; ks < 4; ++ks) {
                        const int rlo = 16 * ks + vrow0, rhi = rlo + 8;
                        const int alo = L_V + cur * 8192 + rlo * 128 + ((dblk ^ ((rlo >> 1) & 1)) * 64) + (16 * (g16 & 1) + 4 * tp4) * 2;
                        const int ahi = L_V + cur * 8192 + rhi * 128 + ((dblk ^ ((rhi >> 1) & 1)) * 64) + (16 * (g16 & 1) + 4 * tp4) * 2;
                        const s16x4 lo = vtr(L + alo), hh = vtr(L + ahi);
                        const bf16x8 vf = (bf16x8){lo[0], lo[1], lo[2], lo[3], hh[0], hh[1], hh[2], hh[3]};
                        o[dblk] = __builtin_amdgcn_mfma_f32_32x32x16_bf16(pa[ks], vf, o[dblk], 0, 0, 0); }
            }
            if (t + 1 < NT) { *(LAS v4u*)(L + (cur ^ 1) * 8192 + kdst) = kreg; *(LAS v4u*)(L + (cur ^ 1) * 8192 + vdst) = vreg; }
            __syncthreads();
        }
        { auto rr = __builtin_amdgcn_permlane32_swap(__float_as_uint(l_reg), __float_as_uint(l_reg), false, false); l_reg = __uint_as_float(rr[0]) + __uint_as_float(rr[1]); }
        if (hi == 0) wsf[r32] = 1.0f / l_reg;
#pragma unroll
        for (int r = 0; r < 16; ++r) { const float rl = wsf[crow(r, hi)]; ost[crow(r, hi) * 64 + r32] = o[0][r] * rl; ost[crow(r, hi) * 64 + 32 + r32] = o[1][r] * rl; }
#pragma unroll
        for (int i = 0; i < 4; ++i) { const int row = i * 8 + (lane >> 3), ch = lane & 7;
            const f32x4 a = *(const LAS f32x4*)(ost + row * 64 + ch * 8), c2 = *(const LAS f32x4*)(ost + row * 64 + ch * 8 + 4);
            const size_t grow = rowbase + q0 + wid * 32 + row;
            const v4u gw = *(const GAS v4u*)(F.GA + grow * 512 + h * 64 + ch * 8);
            v4u ow; ow.x = pk2(a[0] * bflo(gw.x), a[1] * bfhi(gw.x)); ow.y = pk2(a[2] * bflo(gw.y), a[3] * bfhi(gw.y));
            ow.z = pk2(c2[0] * bflo(gw.z), c2[1] * bfhi(gw.z)); ow.w = pk2(c2[2] * bflo(gw.w), c2[3] * bfhi(gw.w));
            *(GAS v4u*)(F.MIXED + grow * DM + 512 + h * 64 + ch * 8) = ow; }
    }
    __syncthreads();
}


namespace hg {
typedef short bf16x8 __attribute__((ext_vector_type(8)));
typedef short s16x4 __attribute__((ext_vector_type(4)));
typedef float f32x4 __attribute__((ext_vector_type(4)));
typedef unsigned u32x2 __attribute__((ext_vector_type(2)));
constexpr int BUF = 12800, GRP = 3 * BUF, L_NRM = 2 * GRP;
__device__ __forceinline__ int fsw(int t) { return ((t & 7) << 2) | ((t >> 3) << 1); }
__device__ __forceinline__ int unit_off(int tok, int cg) { return 8 * (32 * tok + (cg ^ fsw(tok))); }
__device__ __forceinline__ s16x4 rd64(const LAS unsigned char* p) { return *(const LAS s16x4*)p; }
__device__ __forceinline__ s16x4 vtr(const LAS unsigned char* p) { return __builtin_bit_cast(s16x4, __builtin_amdgcn_ds_read_tr16_b64_v4i16((LAS s16x4*)p)); }
__device__ __forceinline__ bf16x8 cat(s16x4 a, s16x4 b) { return (bf16x8){a[0], a[1], a[2], a[3], b[0], b[1], b[2], b[3]}; }
__device__ __forceinline__ f32x4 mfma16(s16x4 a, s16x4 b, f32x4 c) { const s16x4 z = (s16x4){0, 0, 0, 0}; return __builtin_amdgcn_mfma_f32_16x16x32_bf16(cat(a, z), cat(b, z), c, 0, 0, 0); }
__device__ __forceinline__ s16x4 pack4(f32x4 v) { u32x2 w; w.x = moba::cvtpk(v[0], v[1]); w.y = moba::cvtpk(v[2], v[3]); return __builtin_bit_cast(s16x4, w); }
}

__device__ __forceinline__ void hgrn_mfma_phase(Frame& F, int l) {
    using namespace hg;
    PHASE_IDS();
    const int gi = wave >> 2, wg = wave & 3, tig = tid & 255;
    const int c16 = lane & 15, g = lane >> 4;
    LAS unsigned char* L = F.lds + RING_OFF;
    for (int it = F.vcu; it < 32; it += F.G) {
        const int bh = it * 2 + gi, b = bh >> 2, h = bh & 3; const size_t rowbase = (size_t)b * SEQ;
        f32x4 S[8][2]; bf16x8 Sb[4][2];
#pragma unroll
        for (int tk = 0; tk < 8; ++tk) { S[tk][0] = (f32x4){0.f, 0.f, 0.f, 0.f}; S[tk][1] = (f32x4){0.f, 0.f, 0.f, 0.f}; }
#pragma unroll
        for (int ks = 0; ks < 4; ++ks) { Sb[ks][0] = (bf16x8){0, 0, 0, 0, 0, 0, 0, 0}; Sb[ks][1] = (bf16x8){0, 0, 0, 0, 0, 0, 0, 0}; }
        f32x4 oprev[2]; oprev[0] = (f32x4){0.f, 0.f, 0.f, 0.f}; oprev[1] = oprev[0];
        LAS unsigned char* G0 = L + gi * GRP;
        LAS float* nrm = (LAS float*)(L + L_NRM) + gi * 128;
        const int st_tok = tig >> 4, st_c = tig & 15;
        const GAS bf16* qsrc = (const GAS bf16*)(F.QI + (rowbase + st_tok) * 512 + h * 128 + 8 * st_c);
        const GAS bf16* ksrc = (const GAS bf16*)(F.KT + (rowbase + st_tok) * 512 + h * 128 + 8 * st_c);
        const GAS bf16* isrc = (const GAS bf16*)(F.HI + (rowbase + st_tok) * 512 + h * 128 + 8 * st_c);
        const GAS float* dsrc = (const GAS float*)(F.DEC + (size_t)b * 128 * 512 + h * 128 + 4 * (tig & 31));
        const int st_off = unit_off(st_tok, 2 * st_c);
        const int dvl = 32 * wg + 4 * g;
        float hw[2][4];
#pragma unroll
        for (int j = 0; j < 2; ++j)
#pragma unroll
            for (int r = 0; r < 4; ++r) hw[j][r] = F.hg_norm_w[l * 128 + dvl + 16 * j + r];
        v4u qreg, kreg, ireg; f32x4 dreg = (f32x4){0.f, 0.f, 0.f, 0.f};
#pragma unroll
        for (int c0 = 0; c0 < 2; ++c0) {
            qreg = *(const GAS v4u*)(qsrc + (size_t)c0 * 16 * 512); kreg = *(const GAS v4u*)(ksrc + (size_t)c0 * 16 * 512); ireg = *(const GAS v4u*)(isrc + (size_t)c0 * 16 * 512);
            if (tig < 32) dreg = *(const GAS f32x4*)(dsrc + (size_t)c0 * 512);
            LAS unsigned char* B0 = G0 + c0 * BUF;
            *(LAS v4u*)(B0 + st_off) = qreg; *(LAS v4u*)(B0 + 4096 + st_off) = kreg; *(LAS v4u*)(B0 + 8192 + st_off) = ireg;
            if (tig < 32) *(LAS f32x4*)(B0 + 12288 + 16 * tig) = dreg; }
        __syncthreads();
        int buf = 0;
        for (int n = 0; n < 128; ++n) {
            if (n + 2 < 128) {
                qreg = *(const GAS v4u*)(qsrc + (size_t)(n + 2) * 16 * 512); kreg = *(const GAS v4u*)(ksrc + (size_t)(n + 2) * 16 * 512); ireg = *(const GAS v4u*)(isrc + (size_t)(n + 2) * 16 * 512);
                if (tig < 32) dreg = *(const GAS f32x4*)(dsrc + (size_t)(n + 2) * 512); }
            u32x2 gw[2];
            if (n > 0) { const GAS bf16* gp = (const GAS bf16*)(F.GH + (rowbase + (size_t)(n - 1) * 16 + c16) * 512 + h * 128 + dvl);
                gw[0] = *(const GAS u32x2*)(gp); gw[1] = *(const GAS u32x2*)(gp + 16); }
            const LAS unsigned char* Qs = G0 + buf * BUF; const LAS unsigned char* Ks = Qs + 4096; const LAS unsigned char* Is = Qs + 8192; const LAS float* Ds = (const LAS float*)(Qs + 12288);
            bf16x8 qf[4], kf[4];
#pragma unroll
            for (int ks = 0; ks < 4; ++ks) {
                qf[ks] = cat(rd64(Qs + unit_off(c16, 8 * ks + g)), rd64(Qs + unit_off(c16, 8 * ks + 4 + g)));
                kf[ks] = cat(rd64(Ks + unit_off(c16, 8 * ks + g)), rd64(Ks + unit_off(c16, 8 * ks + 4 + g))); }
            f32x4 sc = (f32x4){0.f, 0.f, 0.f, 0.f};
#pragma unroll
            for (int ks = 0; ks < 4; ++ks) sc = __builtin_amdgcn_mfma_f32_16x16x32_bf16(kf[ks], qf[ks], sc, 0, 0, 0);
#pragma unroll
            for (int r = 0; r < 4; ++r) if (4 * g + r > c16) sc[r] = 0.f;
            const s16x4 scb = pack4(sc);
            const int trtok = 4 * g + (c16 >> 2), trp = c16 & 3;
            s16x4 itr[2];
#pragma unroll
            for (int j = 0; j < 2; ++j) itr[j] = vtr(Is + unit_off(trtok, 4 * (2 * wg + j) + trp));
            f32x4 o[2];
#pragma unroll
            for (int j = 0; j < 2; ++j) { f32x4 a = (f32x4){0.f, 0.f, 0.f, 0.f};
#pragma unroll
                for (int ks = 0; ks < 4; ++ks) a = __builtin_amdgcn_mfma_f32_16x16x32_bf16(Sb[ks][j], qf[ks], a, 0, 0, 0);
                o[j] = mfma16(itr[j], scb, a); }
            { float ss = 0.f;
#pragma unroll
                for (int j = 0; j < 2; ++j)
#pragma unroll
                    for (int r = 0; r < 4; ++r) ss += o[j][r] * o[j][r];
                ss += __shfl_xor(ss, 16); ss += __shfl_xor(ss, 32);
                if (g == 0) nrm[(n & 1) * 64 + wg * 16 + c16] = ss; }
#pragma unroll
            for (int tk = 0; tk < 8; ++tk) {
                const s16x4 ktr = vtr(Ks + unit_off(trtok, 4 * tk + trp));
                const f32x4 dv4 = *(const LAS f32x4*)(Ds + 16 * tk + 4 * g);
#pragma unroll
                for (int j = 0; j < 2; ++j) { S[tk][j] = mfma16(ktr, itr[j], S[tk][j]); S[tk][j] = S[tk][j] * dv4; } }
#pragma unroll
            for (int ks = 0; ks < 4; ++ks)
#pragma unroll
                for (int j = 0; j < 2; ++j) Sb[ks][j] = cat(pack4(S[2 * ks][j]), pack4(S[2 * ks + 1][j]));
            if (n > 0) { const LAS float* np = nrm + ((n - 1) & 1) * 64 + c16;
                const float ssum = (np[0] + np[16]) + (np[32] + np[48]); const float rstd = 1.0f / sqrtf(ssum * (1.0f / 128.0f) + NORM_EPS);
                GAS bf16* mo = (GAS bf16*)(F.MIXED + (rowbase + (size_t)(n - 1) * 16 + c16) * DM + h * 128 + dvl);
#pragma unroll
                for (int j = 0; j < 2; ++j) { u32x2 w;
                    w.x = pk2(oprev[j][0] * rstd * hw[j][0] * bflo(gw[j].x), oprev[j][1] * rstd * hw[j][1] * bfhi(gw[j].x));
                    w.y = pk2(oprev[j][2] * rstd * hw[j][2] * bflo(gw[j].y), oprev[j][3] * rstd * hw[j][3] * bfhi(gw[j].y));
                    *(GAS u32x2*)(mo + 16 * j) = w; } }
            oprev[0] = o[0]; oprev[1] = o[1];
            if (n + 2 < 128) { const int nb = (buf == 0) ? 2 : buf - 1;
                LAS unsigned char* B0 = G0 + nb * BUF;
                *(LAS v4u*)(B0 + st_off) = qreg; *(LAS v4u*)(B0 + 4096 + st_off) = kreg; *(LAS v4u*)(B0 + 8192 + st_off) = ireg;
                if (tig < 32) *(LAS f32x4*)(B0 + 12288 + 16 * tig) = dreg; }
            __syncthreads();
            buf = (buf == 2) ? 0 : buf + 1;
        }
        { const GAS bf16* gp = (const GAS bf16*)(F.GH + (rowbase + (size_t)127 * 16 + c16) * 512 + h * 128 + dvl);
            u32x2 gw[2]; gw[0] = *(const GAS u32x2*)(gp); gw[1] = *(const GAS u32x2*)(gp + 16);
            const LAS float* np = nrm + 64 + c16;
            const float ssum = (np[0] + np[16]) + (np[32] + np[48]); const float rstd = 1.0f / sqrtf(ssum * (1.0f / 128.0f) + NORM_EPS);
            GAS bf16* mo = (GAS bf16*)(F.MIXED + (rowbase + (size_t)127 * 16 + c16) * DM + h * 128 + dvl);
#pragma unroll
            for (int j = 0; j < 2; ++j) { u32x2 w;
                w.x = pk2(oprev[j][0] * rstd * hw[j][0] * bflo(gw[j].x), oprev[j][1] * rstd * hw[j][1] * bfhi(gw[j].x));
                w.y = pk2(oprev[j][2] * rstd * hw[j][2] * bflo(gw[j].y), oprev[j][3] * rstd * hw[j][3] * bfhi(gw[j].y));
                *(GAS u32x2*)(mo + 16 * j) = w; } }
        __syncthreads();
    }
}

struct Args { const float* in[8]; float* out; unsigned char* ws; int ph_lo, ph_hi, li, pad; };
__global__ void __launch_bounds__(NWAVES * 64, 2) fwd(Args args) {
    extern __shared__ __attribute__((aligned(16))) unsigned char lds[];
    Frame F;
    F.lds = (LAS unsigned char*)lds;
    F.MISC = (volatile LAS unsigned*)(F.lds + MISC_OFF);
    F.G = gridDim.x; { const int bx = blockIdx.x; F.vcu = (F.G % 8 == 0) ? (bx % 8) * (F.G / 8) + bx / 8 : bx; }
    unsigned char* ws = args.ws;
    F.ctl = (gu32*)(ws + WS_CTL);
    F.x = args.in[0]; F.norm_w = args.in[1]; F.w_in = args.in[2]; F.lb_logits = args.in[3]; F.hg_norm_w = args.in[4]; F.q_norm_w = args.in[5]; F.k_norm_w = args.in[6]; F.w_out = args.in[7];
    F.out = args.out;
    F.WIN = (bf16*)(ws + WS_WIN); F.WOUT = (bf16*)(ws + WS_WOUT); F.XB = (bf16*)(ws + WS_XB); F.MIXED = (bf16*)(ws + WS_MIXED);
    F.QI = (bf16*)(ws + WS_ARR); F.KT = (bf16*)(ws + WS_ARR + ARR_BYTES); F.HI = (bf16*)(ws + WS_ARR + 2 * ARR_BYTES); F.GH = (bf16*)(ws + WS_ARR + 3 * ARR_BYTES);
    F.QN = (bf16*)(ws + WS_ARR + 4 * ARR_BYTES); F.KN = (bf16*)(ws + WS_ARR + 5 * ARR_BYTES); F.V = (bf16*)(ws + WS_ARR + 6 * ARR_BYTES); F.GA = (bf16*)(ws + WS_ARR + 7 * ARR_BYTES);
    F.LB = (float*)(ws + WS_LB); F.KPART = (float*)(ws + WS_KPART); F.ROWSS = (float*)(ws + WS_ROWSS); F.DEC = (float*)(ws + WS_DEC);
    for (int u = threadIdx.x; u < (LDS_BYTES - LDSCTL_OFF) / 4; u += NWAVES * 64) ((LAS unsigned*)(F.lds + LDSCTL_OFF))[u] = 0u;
    __syncthreads();
    XcdBarrier bar; bar.bar = (unsigned*)(F.ctl + CW_BAR); bar.x = 0; bar.st = nullptr;
    if (N_LAUNCHES == 1) bar = xcd_barrier_post((unsigned*)(F.ctl + CW_BAR), F.MISC + 8);
#define GRID_BAR() do { if (N_LAUNCHES == 1) xcd_barrier(bar); } while (0)
    const int lo = args.ph_lo, hi = args.ph_hi;
#define IN(k) (lo <= (k) && (k) < hi)
#define BOTH(k) (IN(k) && IN((k) + 1))

    if (IN(0)) { p0_prologue(F); if (BOTH(0)) GRID_BAR(); }
    for (int l = 0; l < DEPTH; ++l) {
        const int pb = 1 + 3 * l;
        if (IN(pb)) {
            pg8::Gemm g{F.XB + (size_t)l * MTOK * DM, F.WIN + (size_t)l * NIN * DM, MTOK, NIN, DM}; pg8::StaticOrder S; S.init(MTOK, NIN, F.G, (int)blockIdx.x);
            pg8::EpiFused E{F.QI, F.DEC, F.KPART, F.ROWSS + (size_t)l * MTOK * 16, F.LB + l * 512, F.q_norm_w + l * 64, F.k_norm_w + l * 64};
            pg8::gemm_phase<pg8::EpiFused, pg8::StaticOrder, true, true>(F.lds + RING_OFF, g, S, E);
            if (BOTH(pb)) GRID_BAR();
        }
        if (IN(pb + 1)) { hgrn_mfma_phase(F, l); moba_mfma_phase(F, l); if (BOTH(pb + 1)) GRID_BAR(); }
        if (IN(pb + 2)) {
            pg8::Gemm g{F.MIXED, F.WOUT + (size_t)l * DM * DM, MTOK, DM, DM}; pg8::StaticOrder S; S.init(MTOK, DM, F.G, (int)blockIdx.x);
            pg8::EpiOut E{l == 0 ? F.x : F.out, F.out, l == 0 ? F.XB + (size_t)MTOK * DM : nullptr, l == 0 ? F.ROWSS + (size_t)MTOK * 16 : nullptr};
            pg8::gemm_phase<pg8::EpiOut, pg8::StaticOrder, true, true>(F.lds + RING_OFF, g, S, E);
            if (pb + 2 < N_PHASES - 1 && BOTH(pb + 2)) GRID_BAR();
        }
    }
#undef IN
#undef BOTH
}

extern "C" void kernel_launch(void* const* d_in, const int* in_sizes, int n_in, void* d_out, int out_size, void* d_ws, size_t ws_size, hipStream_t stream) {
    static int grid = 0;
    if (grid == 0) {
        if (n_in != 8 || in_sizes[0] != MTOK * DM || out_size != MTOK * DM || ws_size < WS_END) { fprintf(stderr, "kernel_launch: unexpected shapes n_in %d in0 %d out %d ws %zu\n", n_in, n_in > 0 ? in_sizes[0] : -1, out_size, ws_size); grid = -1; return; }
        int dev = 0, cus = 0, per_cu = 0;
        if (hipGetDevice(&dev) != hipSuccess || hipDeviceGetAttribute(&cus, hipDeviceAttributeMultiprocessorCount, dev) != hipSuccess) { grid = -1; return; }
        if (hipFuncSetAttribute((const void*)fwd, hipFuncAttributeMaxDynamicSharedMemorySize, LDS_BYTES) != hipSuccess) { fprintf(stderr, "kernel_launch: hipFuncSetAttribute failed\n"); grid = -1; return; }
        if (hipOccupancyMaxActiveBlocksPerMultiprocessor(&per_cu, (const void*)fwd, NWAVES * 64, LDS_BYTES) != hipSuccess || per_cu < 1) fprintf(stderr, "kernel_launch: occupancy query says %d\n", per_cu);
        (void)hipGetLastError();
        if (per_cu < 1) { grid = -1; return; }
        grid = cus;
    }
    if (grid < 0) return;
    if (hipMemsetAsync((char*)d_ws + WS_CTL, 0, CTL_ZERO_BYTES, stream) != hipSuccess) return;
    Args a{};
    for (int i = 0; i < 8; ++i) a.in[i] = (const float*)d_in[i];
    a.out = (float*)d_out; a.ws = (unsigned char*)d_ws;
    for (int li = 0; li < N_LAUNCHES; ++li) {
        a.ph_lo = (N_LAUNCHES == 1) ? 0 : li; a.ph_hi = (N_LAUNCHES == 1) ? N_PHASES : li + 1; a.li = li;
        hipError_t le;
        if (N_LAUNCHES == 1) { void* kargs[] = {(void*)&a}; le = hipLaunchCooperativeKernel((const void*)fwd, dim3(grid), dim3(NWAVES * 64), kargs, LDS_BYTES, stream); }
        else { hipLaunchKernelGGL(fwd, dim3(grid), dim3(NWAVES * 64), LDS_BYTES, stream, a); le = hipPeekAtLastError(); }
        if (le != hipSuccess) { fprintf(stderr, "kernel_launch: launch %d failed: %s\n", li, hipGetErrorName(le)); break; }
    }
}
```

```cpp
#include <hip/hip_runtime.h>
#include <cstdio>
#include <cstdint>
namespace pg8 {
#define PG8_LAS __attribute__((address_space(3)))
typedef unsigned short bf16_t;
typedef short bf16x8 __attribute__((ext_vector_type(8)));
typedef float f32x4 __attribute__((ext_vector_type(4)));
typedef unsigned u32x4 __attribute__((ext_vector_type(4)));
typedef unsigned u32x2 __attribute__((ext_vector_type(2)));
constexpr int BM = 256, BK = 64, HALF = 128, HTB = HALF * BK * 2  , STAGE_BYTES = 8 * HTB, NXCD = 8, WGM = 8;

__host__ __device__ __forceinline__ int lds_byte(int r, int c) { const int st = (r >> 4) * 2 + (c >> 5), rr = r & 15, cc = c & 31, ob = rr * 64 + cc * 2; return st * 1024 + (ob ^ (((ob >> 9) & 1) << 5)); }
__host__ __device__ __forceinline__ void stage_rc(int b, int& R, int& C) { const int st = b / 1024, sb = b % 1024, swz = sb ^ (((sb >> 9) & 1) << 5); R = (st >> 1) * 16 + swz / 64; C = (st & 1) * 32 + (swz % 64) / 2; }
__host__ __device__ __forceinline__ int perm32(int rho) { const int n = rho >> 4, i = rho & 15; return 8 * (i >> 2) + 4 * n + (i & 3); }

struct Unit { int pm, pn; };
struct Gemm { const bf16_t* A; const bf16_t* Bt; int M, N, K; };

struct StaticOrder {
    int nM, nN, nwg, G, c;
    __host__ __device__ void init(int M, int N, int G_, int c_) { nM = M / BM; nN = N / BM; nwg = nM * nN; G = G_; c = c_; }
    __host__ __device__ bool next(int i, Unit& u) const {
        const long L = (long)i * G + c; if (L >= nwg) return false;
        int wgid = (int)L; { const int q = nwg / NXCD, r = nwg % NXCD, xcd = wgid % NXCD, off = wgid / NXCD; wgid = (xcd < r ? xcd * (q + 1) : r * (q + 1) + (xcd - r) * q) + off; }
        const int nig = WGM * nN, gid = wgid / nig, fm = gid * WGM, gsz = (nM - fm) < WGM ? (nM - fm) : WGM;
        u.pm = fm + ((wgid % nig) % gsz); u.pn = (wgid % nig) / gsz; return true;
    }
    __device__ __forceinline__ void a_ready(const Unit&) const {}
    __device__ __forceinline__ void done(const Unit&) const {}
};

__device__ __forceinline__ unsigned cvt_pk_bf16(float lo, float hi) { unsigned r; asm volatile("v_cvt_pk_bf16_f32 %0, %1, %2" : "=v"(r) : "v"(lo), "v"(hi)); return r; }


__device__ __forceinline__ float dpp_row_shr(float v, int n) {
    const int x = __builtin_bit_cast(int, v);
    int r;
    if (n == 1) r = __builtin_amdgcn_update_dpp(0, x, 0x111, 0xf, 0xf, false);
    else if (n == 2) r = __builtin_amdgcn_update_dpp(0, x, 0x112, 0xf, 0xf, false);
    else if (n == 4) r = __builtin_amdgcn_update_dpp(0, x, 0x114, 0xf, 0xf, false);
    else r = __builtin_amdgcn_update_dpp(0, x, 0x118, 0xf, 0xf, false);
    return __builtin_bit_cast(float, r);
}
__device__ __forceinline__ float fsig(float z) { return __builtin_amdgcn_rcpf(1.0f + __expf(-z)); }
struct EpiFused {
    static constexpr bool PERM = true, AFTER_DRAIN = false;
    bf16_t* ARR; float* DEC; float* KPART; const float* rowss; const float* lb; const float* qg; const float* kg;
    static constexpr size_t AS = (size_t)32768 * 512;
    __device__ __forceinline__ float rstd_of(int row) const {
        const f32x4* rp = (const f32x4*)(rowss + (size_t)row * 16);
        const f32x4 a = rp[0], b = rp[1], c = rp[2], d = rp[3];
        const float ss = ((a[0] + a[1]) + (a[2] + a[3])) + ((b[0] + b[1]) + (b[2] + b[3])) + ((c[0] + c[1]) + (c[2] + c[3])) + ((d[0] + d[1]) + (d[2] + d[3]));
        return 1.0f / sqrtf(ss * (1.0f / 1024.0f) + 1e-6f);
    }
    static __device__ __forceinline__ u32x4 pack8(const float (&v)[8]) { u32x4 w; w.x = cvt_pk_bf16(v[0], v[1]); w.y = cvt_pk_bf16(v[2], v[3]); w.z = cvt_pk_bf16(v[4], v[5]); w.w = cvt_pk_bf16(v[6], v[7]); return w; }
    __device__ __forceinline__ void operator()(const f32x4 (&acc)[2][2][4][2], const Unit& u, int wr, int wc, int fr, int fq) const {
        const int row0 = u.pm * BM + wr * 64 + fr; const int pn = u.pn;
        if (pn < 4) {
            const int cb = pn * 128 + wc * 32 + 8 * fq;
            float lbv[8];
#pragma unroll
            for (int k = 0; k < 8; ++k) lbv[k] = lb[cb + k];
#pragma unroll
            for (int ai = 0; ai < 2; ++ai)
#pragma unroll
                for (int m = 0; m < 4; ++m) { const int row = row0 + ai * HALF + m * 16; const float rs = rstd_of(row);
                    float qi[8], kt[8], dc[8];
#pragma unroll
                    for (int k = 0; k < 8; ++k) { const float zq = acc[ai][0][m][k >> 2][k & 3] * rs, zf = acc[ai][1][m][k >> 2][k & 3] * rs;
                        const float f = lbv[k] + (1.0f - lbv[k]) * fsig(zf);
                        float b = __logf(f);
                        b += dpp_row_shr(b, 1); b += dpp_row_shr(b, 2); b += dpp_row_shr(b, 4); b += dpp_row_shr(b, 8);
                        const float e = __expf(b);
                        qi[k] = zq * fsig(zq) * e; kt[k] = (1.0f - f) * __expf(fminf(-b, 80.0f)); dc[k] = e; }
                    *(u32x4*)(ARR + (size_t)row * 512 + cb) = pack8(qi); *(u32x4*)(ARR + AS + (size_t)row * 512 + cb) = pack8(kt);
                    if (fr == 15) { float* dp = DEC + (size_t)(row >> 4) * 512 + cb; *(f32x4*)dp = (f32x4){dc[0], dc[1], dc[2], dc[3]}; *(f32x4*)(dp + 4) = (f32x4){dc[4], dc[5], dc[6], dc[7]}; }
                    asm volatile("" ::: "memory"); }
        } else if (pn < 8) {
            const int cb = (pn - 4) * 128 + wc * 32 + 8 * fq;
#pragma unroll
            for (int ai = 0; ai < 2; ++ai)
#pragma unroll
                for (int m = 0; m < 4; ++m) { const int row = row0 + ai * HALF + m * 16; const float rs = rstd_of(row);
                    float iv[8], gv[8];
#pragma unroll
                    for (int k = 0; k < 8; ++k) { iv[k] = acc[ai][0][m][k >> 2][k & 3] * rs; const float zg = acc[ai][1][m][k >> 2][k & 3] * rs; gv[k] = zg * fsig(zg); }
                    *(u32x4*)(ARR + 2 * AS + (size_t)row * 512 + cb) = pack8(iv); *(u32x4*)(ARR + 3 * AS + (size_t)row * 512 + cb) = pack8(gv);
                    asm volatile("" ::: "memory"); }
        } else {
            const int ty = (pn - 8) >> 1, head = 4 * ((pn - 8) & 1) + wc; const int d0 = 8 * fq;
            bf16_t* dst = ARR + (size_t)(4 + ty) * AS;
            float gain[2][8]; float csum[2][8];
#pragma unroll
            for (int bj = 0; bj < 2; ++bj)
#pragma unroll
                for (int k = 0; k < 8; ++k) { gain[bj][k] = (ty == 0) ? qg[bj * 32 + d0 + k] * (0.125f * 1.4426950408889634f) : (ty == 1) ? kg[bj * 32 + d0 + k] : 1.0f; csum[bj][k] = 0.f; }
#pragma unroll
            for (int ai = 0; ai < 2; ++ai)
#pragma unroll
                for (int m = 0; m < 4; ++m) { const int row = row0 + ai * HALF + m * 16; const float rs = rstd_of(row);
                    float v[2][8];
#pragma unroll
                    for (int bj = 0; bj < 2; ++bj)
#pragma unroll
                        for (int k = 0; k < 8; ++k) v[bj][k] = acc[ai][bj][m][k >> 2][k & 3] * rs;
                    if (ty < 2) { float ss = 0.f;
#pragma unroll
                        for (int bj = 0; bj < 2; ++bj)
#pragma unroll
                            for (int k = 0; k < 8; ++k) ss += v[bj][k] * v[bj][k];
                        ss += __shfl_xor(ss, 16); ss += __shfl_xor(ss, 32);
                        const float r2 = 1.0f / sqrtf(ss * (1.0f / 64.0f) + 1e-6f);
#pragma unroll
                        for (int bj = 0; bj < 2; ++bj)
#pragma unroll
                            for (int k = 0; k < 8; ++k) { v[bj][k] *= r2 * gain[bj][k]; csum[bj][k] += v[bj][k]; }
                    } else if (ty == 3) {
#pragma unroll
                        for (int bj = 0; bj < 2; ++bj)
#pragma unroll
                            for (int k = 0; k < 8; ++k) v[bj][k] = v[bj][k] * fsig(v[bj][k]); }
                    *(u32x4*)(dst + (size_t)row * 512 + head * 64 + d0) = pack8(v[0]); *(u32x4*)(dst + (size_t)row * 512 + head * 64 + 32 + d0) = pack8(v[1]);
                    asm volatile("" ::: "memory"); }
            if (ty == 1) {
#pragma unroll
                for (int bj = 0; bj < 2; ++bj)
#pragma unroll
                    for (int k = 0; k < 8; ++k) { float s = csum[bj][k]; s += __shfl_xor(s, 1); s += __shfl_xor(s, 2); s += __shfl_xor(s, 4); s += __shfl_xor(s, 8); csum[bj][k] = s; }
                if (fr == 0) { float* kp = KPART + ((size_t)u.pm * 2 + wr) * 512 + head * 64 + d0;
#pragma unroll
                    for (int bj = 0; bj < 2; ++bj) { *(f32x4*)(kp + bj * 32) = (f32x4){csum[bj][0], csum[bj][1], csum[bj][2], csum[bj][3]}; *(f32x4*)(kp + bj * 32 + 4) = (f32x4){csum[bj][4], csum[bj][5], csum[bj][6], csum[bj][7]}; } }
            }
        }
    }
};
struct EpiOut {
    static constexpr bool PERM = false, AFTER_DRAIN = false;
    const float* xres; float* out; bf16_t* xb; float* rowss;
    __device__ __forceinline__ void operator()(const f32x4 (&acc)[2][2][4][2], const Unit& u, int wr, int wc, int fr, int fq) const {
        const int col0 = u.pn * BM + wc * 32 + 4 * fq;
#pragma unroll
        for (int ai = 0; ai < 2; ++ai)
#pragma unroll
            for (int m = 0; m < 4; ++m) {
                const int row = u.pm * BM + ai * HALF + wr * 64 + m * 16 + fr; float ss = 0.f;
#pragma unroll
                for (int bj = 0; bj < 2; ++bj)
#pragma unroll
                    for (int n = 0; n < 2; ++n) { const size_t off = (size_t)row * 1024 + col0 + bj * HALF + n * 16;
                        const f32x4 v = *(const f32x4*)(xres + off) + acc[ai][bj][m][n];
                        *(f32x4*)(out + off) = v; if (xb) { u32x2 w; w.x = cvt_pk_bf16(v[0], v[1]); w.y = cvt_pk_bf16(v[2], v[3]); *(u32x2*)(xb + off) = w; }
                        ss += (v[0] * v[0] + v[1] * v[1]) + (v[2] * v[2] + v[3] * v[3]); }
                ss += __shfl_xor(ss, 16); ss += __shfl_xor(ss, 32);
                if (fq == 0 && rowss) rowss[(size_t)row * 16 + u.pn * 4 + wc] = ss;
            }
    }
};

template <class Epi, class Sched, bool ALIGN_EPI = false, bool SP2 = false>
__device__ __forceinline__ void gemm_phase(PG8_LAS unsigned char* lds, const Gemm g, const Sched& S, const Epi& E) {
    int tid = threadIdx.x; asm volatile("" : "+v"(tid));
    const int wid = __builtin_amdgcn_readfirstlane(tid >> 6), lane = tid & 63, wr = wid >> 2, wc = wid & 3, fr = lane & 15, fq = lane >> 4;
    const int K = g.K, nt = K / BK;
    unsigned voffA[2], voffB[2];
#pragma unroll
    for (int i = 0; i < 2; ++i) { int R, C; stage_rc(tid * 16 + i * 8192, R, C); const int Rb = Epi::PERM ? ((R & ~31) + perm32(R & 31)) : R;
        voffA[i] = (unsigned)(R * K + C) * 2u; voffB[i] = (unsigned)(Rb * K + C) * 2u; }
    const size_t kstep = (size_t)(BK * 2);
    const size_t hstep = (size_t)HALF * K * 2;
    const size_t tstep = 2 * hstep;
    const unsigned ldsw = (unsigned)wid * 1024u;
    const int aoff = lds_byte(wr * 64 + fr, fq * 8), boff = lds_byte(wc * 32 + fr, fq * 8);
#define PG8_SA(b, h) (((b) * 2 + (h)) * HTB)
#define PG8_SB(b, h) ((4 + (b) * 2 + (h)) * HTB)
#define PG8_STAGE(bufoff, gbase, voff) do { _Pragma("unroll") for (int _i = 0; _i < 2; ++_i) \
        __builtin_amdgcn_global_load_lds((const unsigned*)((const char*)(gbase) + (voff)[_i]), (PG8_LAS unsigned*)(lds + (bufoff) + ldsw + _i * 8192), 16, 0, 0); } while (0)
#define PG8_LDA(dst, b, h) do { _Pragma("unroll") for (int m = 0; m < 4; ++m) _Pragma("unroll") for (int k = 0; k < 2; ++k) dst[m][k] = *(const PG8_LAS bf16x8*)(lds + PG8_SA(b, h) + aoff + m * 2048 + k * 1024); } while (0)
#define PG8_LDB(dst, b, h) do { _Pragma("unroll") for (int n = 0; n < 2; ++n) _Pragma("unroll") for (int k = 0; k < 2; ++k) dst[n][k] = *(const PG8_LAS bf16x8*)(lds + PG8_SB(b, h) + boff + n * 2048 + k * 1024); } while (0)
#define PG8_MMA(ai, bj, At, Bt) do { __builtin_amdgcn_s_setprio(1); _Pragma("unroll") for (int m = 0; m < 4; ++m) _Pragma("unroll") for (int n = 0; n < 2; ++n) _Pragma("unroll") for (int k = 0; k < 2; ++k) \
        acc[ai][bj][m][n] = __builtin_amdgcn_mfma_f32_16x16x32_bf16(Bt[n][k], At[m][k], acc[ai][bj][m][n], 0, 0, 0); __builtin_amdgcn_s_setprio(0); } while (0)
#define PG8_WAIT_V(n) asm volatile("s_waitcnt vmcnt(" #n ")" ::: "memory")
#define PG8_WAIT_L(n) asm volatile("s_waitcnt lgkmcnt(" #n ")" ::: "memory")
#define PG8_BAR __builtin_amdgcn_s_barrier()
#define PG8_SCHED __builtin_amdgcn_sched_barrier(0)
    Unit cur, nxt; int ui = 0;
    if (!S.next(0, cur)) return;
    f32x4 acc[2][2][4][2];
#pragma unroll
    for (int a = 0; a < 2; ++a)
#pragma unroll
        for (int b = 0; b < 2; ++b)
#pragma unroll
            for (int m = 0; m < 4; ++m)
#pragma unroll
                for (int n = 0; n < 2; ++n) acc[a][b][m][n] = (f32x4){0.f, 0.f, 0.f, 0.f};
    bf16x8 At[4][2], B0[2][2], B1[2][2];
    const char* cA = (const char*)g.A + (size_t)cur.pm * tstep; const char* cB = (const char*)g.Bt + (size_t)cur.pn * tstep;
    S.a_ready(cur);
    if constexpr (SP2) {
        PG8_STAGE(PG8_SB(0, 0), cB, voffB); PG8_STAGE(PG8_SB(0, 1), cB + hstep, voffB); PG8_STAGE(PG8_SA(0, 0), cA, voffA); PG8_STAGE(PG8_SA(0, 1), cA + hstep, voffA);
        if (wr == 1) PG8_BAR;
        PG8_WAIT_V(2); PG8_BAR;
        PG8_STAGE(PG8_SB(1, 0), cB + kstep, voffB); PG8_STAGE(PG8_SA(1, 0), cA + kstep, voffA); PG8_STAGE(PG8_SB(1, 1), cB + hstep + kstep, voffB);
        PG8_WAIT_V(6); PG8_BAR;
    } else {
        PG8_STAGE(PG8_SB(0, 0), cB, voffB); PG8_STAGE(PG8_SA(0, 0), cA, voffA); PG8_STAGE(PG8_SB(0, 1), cB + hstep, voffB); PG8_STAGE(PG8_SA(0, 1), cA + hstep, voffA);
        if (wr == 1) PG8_BAR;
        PG8_WAIT_V(4); PG8_BAR;
        PG8_STAGE(PG8_SB(1, 0), cB + kstep, voffB); PG8_STAGE(PG8_SA(1, 0), cA + kstep, voffA); PG8_STAGE(PG8_SB(1, 1), cB + hstep + kstep, voffB);
        PG8_WAIT_V(6); PG8_BAR;
    }
    for (;;) {
        const bool has_next = S.next(ui + 1, nxt);
        const char* nA = has_next ? (const char*)g.A + (size_t)nxt.pm * tstep : cA; const char* nB = has_next ? (const char*)g.Bt + (size_t)nxt.pn * tstep : cB;
        for (int t = 0; t < nt; t += 2) {
            const bool last = (t == nt - 2);
            const char* a1 = cA + (size_t)(t + 1) * kstep;
            const char* a2 = last ? nA : cA + (size_t)(t + 2) * kstep; const char* b2 = last ? nB : cB + (size_t)(t + 2) * kstep;
            const char* a3 = a2 + kstep; const char* b3 = b2 + kstep;
            if (last && has_next) S.a_ready(nxt);
            if constexpr (SP2) {
            PG8_LDB(B0, 0, 0); PG8_LDB(B1, 0, 1); PG8_SCHED; PG8_LDA(At, 0, 0); PG8_STAGE(PG8_SA(1, 1), a1 + hstep, voffA);
            PG8_WAIT_V(8); PG8_WAIT_L(0); PG8_BAR; PG8_MMA(0, 0, At, B0); PG8_MMA(0, 1, At, B1); PG8_BAR; PG8_SCHED;
            PG8_LDA(At, 0, 1); PG8_STAGE(PG8_SB(0, 0), b2, voffB); PG8_STAGE(PG8_SB(0, 1), b2 + hstep, voffB); PG8_STAGE(PG8_SA(0, 0), a2, voffA);
            PG8_WAIT_V(8); PG8_WAIT_L(0); PG8_BAR; PG8_MMA(1, 0, At, B0); PG8_MMA(1, 1, At, B1); PG8_BAR; PG8_SCHED;
            PG8_LDB(B0, 1, 0); PG8_LDB(B1, 1, 1); PG8_SCHED; PG8_LDA(At, 1, 0); PG8_STAGE(PG8_SA(0, 1), a2 + hstep, voffA);
            PG8_WAIT_V(8); PG8_WAIT_L(0); PG8_BAR; PG8_MMA(0, 0, At, B0); PG8_MMA(0, 1, At, B1); PG8_BAR; PG8_SCHED;
            PG8_LDA(At, 1, 1); PG8_STAGE(PG8_SB(1, 0), b3, voffB); PG8_STAGE(PG8_SB(1, 1), b3 + hstep, voffB); PG8_STAGE(PG8_SA(1, 0), a3, voffA);
            PG8_WAIT_V(8); PG8_WAIT_L(0); PG8_BAR; PG8_MMA(1, 0, At, B0); PG8_MMA(1, 1, At, B1); PG8_BAR; PG8_SCHED;
            } else {
            PG8_LDB(B0, 0, 0); PG8_SCHED; PG8_LDA(At, 0, 0); PG8_STAGE(PG8_SA(1, 1), a1 + hstep, voffA);
            PG8_WAIT_L(8); PG8_BAR; PG8_WAIT_L(0); PG8_MMA(0, 0, At, B0); PG8_BAR; PG8_SCHED;
            PG8_LDB(B1, 0, 1); PG8_STAGE(PG8_SB(0, 0), b2, voffB);
            PG8_BAR; PG8_WAIT_L(0); PG8_MMA(0, 1, At, B1); PG8_BAR;
            PG8_LDA(At, 0, 1); PG8_STAGE(PG8_SA(0, 0), a2, voffA);
            PG8_BAR; PG8_WAIT_L(0); PG8_MMA(1, 0, At, B0); PG8_BAR; PG8_SCHED;
            PG8_STAGE(PG8_SB(0, 1), b2 + hstep, voffB);
            PG8_WAIT_V(6); PG8_BAR; PG8_MMA(1, 1, At, B1); PG8_BAR;
            PG8_LDB(B0, 1, 0); PG8_SCHED; PG8_LDA(At, 1, 0); PG8_STAGE(PG8_SA(0, 1), a2 + hstep, voffA);
            PG8_WAIT_L(8); PG8_BAR; PG8_WAIT_L(0); PG8_MMA(0, 0, At, B0); PG8_BAR; PG8_SCHED;
            PG8_LDB(B1, 1, 1); PG8_STAGE(PG8_SB(1, 0), b3, voffB);
            PG8_BAR; PG8_WAIT_L(0); PG8_MMA(0, 1, At, B1); PG8_BAR;
            PG8_LDA(At, 1, 1); PG8_STAGE(PG8_SA(1, 0), a3, voffA);
            PG8_BAR; PG8_WAIT_L(0); PG8_MMA(1, 0, At, B0); PG8_BAR; PG8_SCHED;
            PG8_STAGE(PG8_SB(1, 1), b3 + hstep, voffB);
            PG8_WAIT_V(6); PG8_BAR; PG8_MMA(1, 1, At, B1); PG8_BAR;
            }
        }
        if constexpr (ALIGN_EPI) { if (wr == 0) PG8_BAR; }
        if constexpr (!Epi::AFTER_DRAIN) { E(acc, cur, wr, wc, fr, fq); S.done(cur); }
        if (!has_next) break;
#pragma unroll
        for (int a = 0; a < 2; ++a)
#pragma unroll
            for (int b = 0; b < 2; ++b)
#pragma unroll
                for (int m = 0; m < 4; ++m)
#pragma unroll
                    for (int n = 0; n < 2; ++n) acc[a][b][m][n] = (f32x4){0.f, 0.f, 0.f, 0.f};
        cur = nxt; cA = nA; cB = nB; ++ui;
        if constexpr (ALIGN_EPI) { if (wr == 1) PG8_BAR; }
    }
    PG8_WAIT_V(0);
    if constexpr (!ALIGN_EPI) { if (wr == 0) PG8_BAR; }
    PG8_BAR;
    if constexpr (Epi::AFTER_DRAIN) { E.fused(acc, cur, wr, wc, fr, fq, lds, wid, lane); S.done(cur); }
#undef PG8_SA
#undef PG8_SB
#undef PG8_STAGE
#undef PG8_LDA
#undef PG8_LDB
#undef PG8_MMA
#undef PG8_WAIT_V
#undef PG8_WAIT_L
#undef PG8_BAR
#undef PG8_SCHED
}
}


constexpr int NWAVES = 8;
#ifndef MK_N_LAUNCHES
#define MK_N_LAUNCHES 1
#endif
constexpr int N_PHASES = 7;
constexpr int N_LAUNCHES = MK_N_LAUNCHES;

constexpr int BATCH = 16, SEQ = 2048, DM = 1024, DEPTH = 2, MTOK = BATCH * SEQ, NIN = 4096;
constexpr int C_HQ = 0, C_HF = 512, C_HI = 1024, C_HG = 1536, C_AQ = 2048, C_AK = 2560, C_AV = 3072, C_AG = 3584;
constexpr float NORM_EPS = 1e-6f;

constexpr size_t MiB = 1u << 20;
constexpr size_t WS_CTL = 0, CTL_ZERO_BYTES = 1 * MiB;
constexpr size_t WS_WIN = 2 * MiB;
constexpr size_t WS_WOUT = 18 * MiB;
constexpr size_t WS_LB = 22 * MiB;
constexpr size_t WS_KPART = 22 * MiB + 65536;
constexpr size_t WS_ROWSS = 24 * MiB;
constexpr size_t WS_DEC = 28 * MiB;
constexpr size_t WS_XB = 32 * MiB;
constexpr size_t WS_MIXED = 160 * MiB;
constexpr size_t WS_ARR = 224 * MiB;
constexpr size_t ARR_BYTES = 32 * MiB;
constexpr size_t WS_END = 480 * MiB;
constexpr int CW_QUEUE = 1024;
constexpr int CW_BAR = 4096;

constexpr int RING_OFF = 0, RING_BYTES = 131072;
constexpr int EXTRA_OFF = RING_BYTES, EXTRA_BYTES = 16384;
constexpr int LDSCTL_OFF = EXTRA_OFF + EXTRA_BYTES, MISC_OFF = LDSCTL_OFF + 320;
constexpr int LDS_BYTES = LDSCTL_OFF + 1024;

#define GAS __attribute__((address_space(1)))
#define LAS __attribute__((address_space(3)))
typedef unsigned short bf16;
typedef unsigned v4u __attribute__((ext_vector_type(4)));
typedef float f32x4 __attribute__((ext_vector_type(4)));
typedef GAS unsigned gu32;
#define RLX_AGENT __ATOMIC_RELAXED, __HIP_MEMORY_SCOPE_AGENT
#define LDS_WAIT() asm volatile("s_waitcnt lgkmcnt(0)" ::: "memory")
#define VM_WAIT() asm volatile("s_waitcnt vmcnt(0)" ::: "memory")
__device__ __forceinline__ unsigned f2bf(float f) { unsigned u = __builtin_bit_cast(unsigned, f); return (u + 0x7fffu + ((u >> 16) & 1u)) >> 16; }
__device__ __forceinline__ unsigned pk2(float lo, float hi) { return f2bf(lo) | (f2bf(hi) << 16); }
__device__ __forceinline__ float bf2f(unsigned short b) { return __builtin_bit_cast(float, (unsigned)b << 16); }
__device__ __forceinline__ float bflo(unsigned w) { return __builtin_bit_cast(float, w << 16); }
__device__ __forceinline__ float bfhi(unsigned w) { return __builtin_bit_cast(float, w & 0xffff0000u); }
__device__ __forceinline__ float silu_f(float z) { return z / (1.0f + __expf(-z)); }
__device__ __forceinline__ float sigmoid_f(float z) { return 1.0f / (1.0f + __expf(-z)); }

#define XB_TMO      128
#define XB_XCNT(j)  (256  + 64 * (j))
#define XB_XSUB(j)  (1280 + 64 * (j))
#define XB_XGEN(j)  (2304 + 64 * (j))
#define XB_TOP      3328
#define XB_TOPGEN   3392
#define XCD_BAR_WORDS 3456
#define XB_SPIN_CAP (1u << 18)

__device__ __forceinline__ unsigned xb_ld(unsigned* p)              { return __hip_atomic_load(p, __ATOMIC_RELAXED, __HIP_MEMORY_SCOPE_AGENT); }
__device__ __forceinline__ unsigned xb_add(unsigned* p, unsigned v) { return __hip_atomic_fetch_add(p, v, __ATOMIC_RELAXED, __HIP_MEMORY_SCOPE_AGENT); }
__device__ __forceinline__ unsigned xb_xcc_id() { return (unsigned)__builtin_amdgcn_s_getreg((3 << 11) | 20) & 0xFu; }
#define XB_SPIN(cond, bar) do { unsigned _sp = 0; while (cond) { __builtin_amdgcn_s_sleep(1); \
    if ((++_sp & 255u) == 0u) { if (xb_ld(&(bar)[XB_TMO])) break; if (_sp > XB_SPIN_CAP) { atomicAdd(&(bar)[XB_TMO], 1u); break; } } } } while (0)

struct XcdBarrier {
    unsigned* bar; unsigned x;
    volatile LAS unsigned* st;
};

__device__ __forceinline__ XcdBarrier xcd_barrier_post(unsigned* bar, volatile LAS unsigned* st) {
    XcdBarrier b; b.bar = bar; b.x = xb_xcc_id(); b.st = st;
    if (threadIdx.x == 0) (void)xb_add(&bar[XB_XCNT(b.x)], 1u);
    return b;
}
__device__ __forceinline__ void xcd_barrier_complete(unsigned* bar, unsigned x, unsigned& nloc, unsigned& nx) {
    const unsigned G = gridDim.x * gridDim.y * gridDim.z;
    unsigned sum, cnt, mine, sp = 0u;
    for (;;) {
        sum = 0u; cnt = 0u; mine = 0u;
#pragma unroll
        for (unsigned j = 0; j < 16; ++j) { const unsigned c = xb_ld(&bar[XB_XCNT(j)]); sum += c; cnt += (c > 0u) ? 1u : 0u; mine = (j == x) ? c : mine; }
        if (sum == G) break;
        __builtin_amdgcn_s_sleep(1);
        if ((++sp & 255u) == 0u) { if (xb_ld(&bar[XB_TMO])) break; if (sp > XB_SPIN_CAP) { atomicAdd(&bar[XB_TMO], 1u); break; } }
    }
    nloc = mine > 0u ? mine : 1u; nx = cnt > 0u ? cnt : 1u;
}

__device__ __forceinline__ void xcd_barrier(const XcdBarrier& b) {
    asm volatile("s_waitcnt vmcnt(0)" ::: "memory");
    __syncthreads();
    if (threadIdx.x == 0) {
        unsigned* bar = b.bar;
        __builtin_amdgcn_s_waitcnt(0);
        unsigned nloc = b.st[0], nx = b.st[1];
        if (nloc == 0u) { xcd_barrier_complete(bar, b.x, nloc, nx); b.st[0] = nloc; b.st[1] = nx; }
        const unsigned old = xb_add(&bar[XB_XSUB(b.x)], 1u);
        const unsigned gen = old / nloc;
        if (old + 1u == (gen + 1u) * nloc) {
            __builtin_amdgcn_fence(__ATOMIC_RELEASE, "agent");
            asm volatile("s_waitcnt vmcnt(0)" ::: "memory");
            const unsigned og = xb_add(&bar[XB_TOP], 1u);
            const unsigned tg = og / nx;
            if (og + 1u == (tg + 1u) * nx) xb_add(&bar[XB_TOPGEN], 1u);
            else XB_SPIN(xb_ld(&bar[XB_TOPGEN]) == tg, bar);
            __builtin_amdgcn_fence(__ATOMIC_ACQUIRE, "agent");
            xb_add(&bar[XB_XGEN(b.x)], 1u);
            asm volatile("s_waitcnt vmcnt(0)" ::: "memory");
        } else {
            XB_SPIN(xb_ld(&bar[XB_XGEN(b.x)]) == gen, bar);
            __builtin_amdgcn_fence(__ATOMIC_ACQUIRE, "agent");
            asm volatile("s_waitcnt vmcnt(0)" ::: "memory");
        }
    }
    __syncthreads();
}


struct Frame {
    LAS unsigned char* lds;
    volatile LAS unsigned* MISC;
    gu32* ctl;
    int vcu, G;
    const float* x; float* out;
    const float *norm_w, *w_in, *lb_logits, *hg_norm_w, *q_norm_w, *k_norm_w, *w_out;
    bf16 *WIN, *WOUT, *XB, *MIXED, *QI, *KT, *HI, *GH, *QN, *KN, *V, *GA;
    float *LB, *KPART, *ROWSS, *DEC;
};

__device__ __forceinline__ float wave_sum(float v) {
#pragma unroll
    for (int o = 1; o < 64; o <<= 1) v += __shfl_xor(v, o);
    return v;
}
__device__ __forceinline__ int win_dest(int oc) {
    if (oc < 2048) { const int grp = oc >> 9, hh = (oc >> 7) & 3, w = oc & 127; return 256 * (((grp >> 1) << 2) + hh) + 128 * (grp & 1) + w; }
    const int ty = (oc - 2048) >> 9, head = (oc >> 6) & 7, bj = (oc >> 5) & 1; return 256 * (8 + 2 * ty + (head >> 2)) + 128 * bj + 32 * (head & 3);
}
__device__ __forceinline__ void p0_transpose_item(const float* W, int K, int N, bf16* WT, const float* kscale, LAS float* scr, int item, int lane, bool permute) {
    const int nblk = N / 32, kb = item / nblk, nb = item % nblk, k0 = 64 * kb, n0 = 32 * nb; const int nd = permute ? win_dest(n0) : n0;
#pragma unroll 8
    for (int i = 0; i < 32; ++i) { const int kk = 2 * i + (lane >> 5); const float s = kscale ? kscale[k0 + kk] : 1.0f; scr[kk * 33 + (lane & 31)] = W[(size_t)(k0 + kk) * N + n0 + (lane & 31)] * s; }
    LDS_WAIT(); asm volatile("" ::: "memory");
    const int c = lane & 7;
#pragma unroll
    for (int j = 0; j < 4; ++j) { const int n = (lane >> 3) + 8 * j; const LAS float* s = scr + (8 * c) * 33 + n;
        v4u o; o.x = pk2(s[0 * 33], s[1 * 33]); o.y = pk2(s[2 * 33], s[3 * 33]); o.z = pk2(s[4 * 33], s[5 * 33]); o.w = pk2(s[6 * 33], s[7 * 33]);
        *(GAS v4u*)(WT + (size_t)(nd + n) * K + k0 + 8 * c) = o; }
    LDS_WAIT(); asm volatile("" ::: "memory");
}
#define PHASE_IDS() int t_ = threadIdx.x; asm volatile("" : "+v"(t_)); const int tid = t_, lane = tid & 63, wave = __builtin_amdgcn_readfirstlane(tid >> 6); (void)lane; (void)wave
__device__ __forceinline__ void p0_prologue(Frame& F) {
    PHASE_IDS();
    LAS float* scr = (LAS float*)(F.lds + RING_OFF + wave * 16384);
    const int gw = F.vcu * NWAVES + wave, NGW = F.G * NWAVES;
    constexpr int I_IN = (DM / 64) * (NIN / 32), I_OUT = (DM / 64) * (DM / 32);
    constexpr int NITEMS = DEPTH * (I_IN + I_OUT);
    for (int it = gw; it < NITEMS; it += NGW) {
        int r = it;
        if (r < DEPTH * I_IN) { const int l = r / I_IN; r -= l * I_IN;
            p0_transpose_item(F.w_in + (size_t)l * DM * NIN, DM, NIN, F.WIN + (size_t)l * NIN * DM, F.norm_w + l * DM, scr, r, lane, true); continue; }
        r -= DEPTH * I_IN; { const int l = r / I_OUT; r -= l * I_OUT;
            p0_transpose_item(F.w_out + (size_t)l * DM * DM, DM, DM, F.WOUT + (size_t)l * DM * DM, nullptr, scr, r, lane, false); }
    }
    for (int m = gw; m < MTOK; m += NGW) {
        const GAS f32x4* xr = (const GAS f32x4*)(F.x + (size_t)m * DM) + lane;
        f32x4 v[4]; float s = 0.f;
#pragma unroll
        for (int j = 0; j < 4; ++j) { v[j] = xr[64 * j]; s += (v[j].x * v[j].x + v[j].y * v[j].y) + (v[j].z * v[j].z + v[j].w * v[j].w); }
        s = wave_sum(s);
        GAS unsigned long long* o8 = (GAS unsigned long long*)(F.XB + (size_t)m * DM) + lane;
#pragma unroll
        for (int j = 0; j < 4; ++j) o8[64 * j] = (unsigned long long)pk2(v[j].x, v[j].y) | ((unsigned long long)pk2(v[j].z, v[j].w) << 32);
        if (lane < 16) F.ROWSS[(size_t)m * 16 + lane] = (lane == 0) ? s : 0.f;
    }
    if (blockIdx.x == 0) { const int c = tid; const float a0 = F.lb_logits[c], a1 = F.lb_logits[512 + c]; const float mx = fmaxf(a0, a1);
        const float e0 = expf(a0 - mx), e1 = expf(a1 - mx); const float p0 = e0 / (e0 + e1), p1 = e1 / (e0 + e1);
        F.LB[c] = 0.f; F.LB[512 + c] = fminf(fmaxf((p0 + p1) - p0, 0.f), 1.0f - 1e-6f); }
}

constexpr float LOG2E = 1.4426950408889634f;
constexpr float QSCALE2 = 0.125f * LOG2E;
namespace moba {
typedef short bf16x8 __attribute__((ext_vector_type(8)));
typedef short s16x4 __attribute__((ext_vector_type(4)));
typedef float f32x16 __attribute__((ext_vector_type(16)));
typedef float f32x2_t __attribute__((ext_vector_type(2))); typedef __bf16 bf16x2_t __attribute__((ext_vector_type(2)));
__device__ __forceinline__ unsigned cvtpk(float lo, float hi) { f32x2_t v = {lo, hi}; bf16x2_t b = __builtin_convertvector(v, bf16x2_t); return __builtin_bit_cast(unsigned, b); }
__device__ __forceinline__ int crow(int r, int hi) { return (r & 3) + 8 * (r >> 2) + 4 * hi; }
constexpr int L_K = 0, L_V = 16384, L_WSF = 32768, L_KM = 34816, L_OST = 36864;
constexpr float NEG_BIG = -1e30f;
constexpr float THR = 8.0f;
__device__ __forceinline__ s16x4 vtr(const LAS unsigned char* p) { return __builtin_bit_cast(s16x4, __builtin_amdgcn_ds_read_tr16_b64_v4i16((LAS s16x4*)p)); }
}

__device__ __forceinline__ void moba_mfma_phase(Frame& F, int l) {
    using namespace moba;
    PHASE_IDS();
    const int r32 = lane & 31, hi = lane >> 5, wid = wave;
    LAS unsigned char* L = F.lds + RING_OFF;
    LAS float* wsf = (LAS float*)(L + L_WSF) + wid * 64;
    LAS float* km = (LAS float*)(L + L_KM);
    LAS float* ost = (LAS float*)(L + L_OST) + wid * 2048;
    float gq = fabsf(F.q_norm_w[l * 64 + lane]), gk = fabsf(F.k_norm_w[l * 64 + lane]);
#pragma unroll
    for (int o = 1; o < 64; o <<= 1) { gq = fmaxf(gq, __shfl_xor(gq, o)); gk = fmaxf(gk, __shfl_xor(gk, o)); }
    const float mhat0 = -(8.0f * gq * gk * LOG2E * 1.02f + 1.0f);
    gu32* qctr = F.ctl + CW_QUEUE + 64 * l;
    volatile LAS unsigned* tick = (volatile LAS unsigned*)(F.lds + EXTRA_OFF + 8192);
    for (;;) {
        __syncthreads();
        if (tid == 0) tick[0] = __hip_atomic_fetch_add(qctr, 1u, RLX_AGENT);
        __syncthreads();
        const int it = (int)tick[0]; if (it >= 1024) break;
        const int qb = 7 - (it >> 7), bh = it & 127;
        const int b = bh >> 3, h = bh & 7; const size_t rowbase = (size_t)b * SEQ; const int q0 = qb * 256, qrel = wid * 32 + r32, tq = q0 + qrel;
        const float sl2 = exp2f(-(float)(h + 1)) * LOG2E;
        bf16x8 qr[4];
        { const GAS bf16* Qw = (const GAS bf16*)(F.QN + (rowbase + q0 + wid * 32 + r32) * 512 + h * 64 + hi * 8);
#pragma unroll
            for (int d0 = 0; d0 < 4; ++d0) qr[d0] = *(const GAS bf16x8*)(Qw + d0 * 16); }
        if (tid < qb * 64) { const GAS float* kp = (const GAS float*)(F.KPART + ((size_t)b * 8 + (tid >> 6)) * 1024 + h * 64 + (tid & 63)); km[tid] = (kp[0] + kp[512]) * (1.0f / 256.0f); }
        const GAS bf16* ksrc = (const GAS bf16*)(F.KN + (rowbase + lane) * 512 + h * 64 + wid * 8);
        const GAS bf16* vsrc = (const GAS bf16*)(F.V + (rowbase + (tid >> 3)) * 512 + h * 64 + (tid & 7) * 8);
        const int kdst = L_K + wid * 1024 + lane * 16;
        const int vrow = tid >> 3, vch = tid & 7;
        const int vdst = L_V + vrow * 128 + (((vch >> 2) ^ ((vrow >> 1) & 1)) * 64) + (vch & 3) * 16;
        const int NT = 4 * (qb + 1);
        v4u kreg = *(const GAS v4u*)(ksrc), vreg = *(const GAS v4u*)(vsrc);
        __syncthreads();
        *(LAS v4u*)(L + kdst) = kreg; *(LAS v4u*)(L + vdst) = vreg;
        unsigned selmask = 0;
        { float gt[7];
#pragma unroll
            for (int j = 0; j < 7; ++j) { float s = 0.f;
                if (j < qb) {
#pragma unroll
                    for (int d0 = 0; d0 < 4; ++d0)
#pragma unroll
                        for (int e = 0; e < 8; ++e) s += bf2f((unsigned short)qr[d0][e]) * km[j * 64 + d0 * 16 + hi * 8 + e];
                    auto rr = __builtin_amdgcn_permlane32_swap(__float_as_uint(s), __float_as_uint(s), false, false);
                    s = __uint_as_float(rr[0]) + __uint_as_float(rr[1]); }
                gt[j] = s; }
#pragma unroll
            for (int j = 0; j < 7; ++j) { int rank = 0;
#pragma unroll
                for (int i = 0; i < 7; ++i) if (i != j && i < qb) rank += (gt[i] > gt[j] || (gt[i] == gt[j] && i < j)) ? 1 : 0;
                if (j < qb && rank < 3) selmask |= 1u << j; } }
        float kb[16];
#pragma unroll
        for (int r = 0; r < 16; ++r) kb[r] = sl2 * (float)crow(r, hi);
        float mhat = mhat0, l_reg = 0.f; f32x16 o[2]; o[0] = f32x16{}; o[1] = f32x16{};
        const int kbase = L_K + hi * 1024 + r32 * 16;
        const int g16 = lane >> 4, i16 = lane & 15, tq4 = i16 >> 2, tp4 = i16 & 3;
        const int vrow0 = 4 * hi + tq4;
        __syncthreads();
        for (int t = 0; t < NT; ++t) {
            const int cur = t & 1;
            if (t + 1 < NT) { kreg = *(const GAS v4u*)(ksrc + (size_t)(t + 1) * 64 * 512); vreg = *(const GAS v4u*)(vsrc + (size_t)(t + 1) * 64 * 512); }
            const int blk = t >> 2; const bool own = (blk == qb); const int jb = t & 3;
            const bool skip = own && (64 * jb > 32 * wid + 31);
            if (!skip) {
                const bool sel = own || ((selmask >> blk) & 1u);
                const float sc0 = sel ? (-mhat - sl2 * (float)(tq - 64 * t)) : NEG_BIG; const float sc1 = sc0 + 32.0f * sl2;
                f32x16 p0, p1;
#pragma unroll
                for (int r = 0; r < 16; ++r) { p0[r] = sc0 + kb[r]; p1[r] = sc1 + kb[r]; }
#pragma unroll
                for (int d0 = 0; d0 < 4; ++d0) {
                    const bf16x8 b0 = *(const LAS bf16x8*)(L + cur * 8192 + kbase + d0 * 2048);
                    const bf16x8 b1 = *(const LAS bf16x8*)(L + cur * 8192 + kbase + d0 * 2048 + 512);
                    p0 = __builtin_amdgcn_mfma_f32_32x32x16_bf16(b0, qr[d0], p0, 0, 0, 0);
                    p1 = __builtin_amdgcn_mfma_f32_32x32x16_bf16(b1, qr[d0], p1, 0, 0, 0); }
                if (own && (64 * jb + 63 > 32 * wid)) {
#pragma unroll
                    for (int r = 0; r < 16; ++r) { const int kvl = 64 * jb + crow(r, hi); if (kvl > qrel) p0[r] = NEG_BIG; if (kvl + 32 > qrel) p1[r] = NEG_BIG; } }
                float rm = fmaxf(p0[0], p1[0]);
#pragma unroll
                for (int r = 1; r < 16; ++r) rm = fmaxf(rm, fmaxf(p0[r], p1[r]));
                { auto rr = __builtin_amdgcn_permlane32_swap(__float_as_uint(rm), __float_as_uint(rm), false, false); rm = fmaxf(__uint_as_float(rr[0]), __uint_as_float(rr[1])); }
                if (__any(rm > THR)) {
                    const float dl = fmaxf(rm, 0.f); mhat += dl;
#pragma unroll
                    for (int r = 0; r < 16; ++r) { p0[r] -= dl; p1[r] -= dl; }
                    const float f = __builtin_amdgcn_exp2f(-dl); l_reg *= f;
                    if (hi == 0) wsf[r32] = f;
#pragma unroll
                    for (int r = 0; r < 16; ++r) { const float fr = wsf[crow(r, hi)]; o[0][r] *= fr; o[1][r] *= fr; } }
                float sacc = 0.f;
#pragma unroll
                for (int r = 0; r < 16; ++r) { p0[r] = __builtin_amdgcn_exp2f(p0[r]); p1[r] = __builtin_amdgcn_exp2f(p1[r]); sacc += p0[r] + p1[r]; }
                l_reg += sacc;
                bf16x8 pa[4];
                { v4u w;
#pragma unroll
                    for (int ks = 0; ks < 4; ++ks) {
#pragma unroll
                        for (int e = 0; e < 4; ++e) { const int rb = (ks & 1) * 8 + 2 * e; w[e] = (ks < 2) ? cvtpk(p0[rb], p0[rb + 1]) : cvtpk(p1[rb], p1[rb + 1]); }
                        pa[ks] = __builtin_bit_cast(bf16x8, w); } }
#pragma unroll
                for (int dblk = 0; dblk < 2; ++dblk)
#pragma unroll
                    for (int ks = 0; ks < 4; ++ks) {
                        const int rlo = 16 * ks + vrow0, rhi = rlo + 8;
                        const int alo = L_V + cur * 8192 + rlo * 128 + ((dblk ^ ((rlo >> 1) & 1)) * 64) + (16 * (g16 & 1) + 4 * tp4) * 2;
                        const int ahi = L_V + cur * 8192 + rhi * 128 + ((dblk ^ ((rhi >> 1) & 1)) * 64) + (16 * (g16 & 1) + 4 * tp4) * 2;
                        const s16x4 lo = vtr(L + alo), hh = vtr(L + ahi);
                        const bf16x8 vf = (bf16x8){lo[0], lo[1], lo[2], lo[3], hh[0], hh[1], hh[2], hh[3]};
                        o[dblk] = __builtin_amdgcn_mfma_f32_32x32x16_bf16(pa[ks], vf, o[dblk], 0, 0, 0); }
            }
            if (t + 1 < NT) { *(LAS v4u*)(L + (cur ^ 1) * 8192 + kdst) = kreg; *(LAS v4u*)(L + (cur ^ 1) * 8192 + vdst) = vreg; }
            __syncthreads();
        }
        { auto rr = __builtin_amdgcn_permlane32_swap(__float_as_uint(l_reg), __float_as_uint(l_reg), false, false); l_reg = __uint_as_float(rr[0]) + __uint_as_float(rr[1]); }
        if (hi == 0) wsf[r32] = 1.0f / l_reg;
#pragma unroll
        for (int r = 0; r < 16; ++r) { const float rl = wsf[crow(r, hi)]; ost[crow(r, hi) * 64 + r32] = o[0][r] * rl; ost[crow(r, hi) * 64 + 32 + r32] = o[1][r] * rl; }
#pragma unroll
        for (int i = 0; i < 4; ++i) { const int row = i * 8 + (lane >> 3), ch = lane & 7;
            const f32x4 a = *(const LAS f32x4*)(ost + row * 64 + ch * 8), c2 = *(const LAS f32x4*)(ost + row * 64 + ch * 8 + 4);
            const size_t grow = rowbase + q0 + wid * 32 + row;
            const v4u gw = *(const GAS v4u*)(F.GA + grow * 512 + h * 64 + ch * 8);
            v4u ow; ow.x = pk2(a[0] * bflo(gw.x), a[1] * bfhi(gw.x)); ow.y = pk2(a[2] * bflo(gw.y), a[3] * bfhi(gw.y));
            ow.z = pk2(c2[0] * bflo(gw.z), c2[1] * bfhi(gw.z)); ow.w = pk2(c2[2] * bflo(gw.w), c2[3] * bfhi(gw.w));
            *(GAS v4u*)(F.MIXED + grow * DM + 512 + h * 64 + ch * 8) = ow; }
    }
    __syncthreads();
}


namespace hg {
typedef short bf16x8 __attribute__((ext_vector_type(8)));
typedef short s16x4 __attribute__((ext_vector_type(4)));
typedef float f32x4 __attribute__((ext_vector_type(4)));
typedef unsigned u32x2 __attribute__((ext_vector_type(2)));
constexpr int BUF = 12800, GRP = 3 * BUF, L_NRM = 2 * GRP;
__device__ __forceinline__ int fsw(int t) { return ((t & 7) << 2) | ((t >> 3) << 1); }
__device__ __forceinline__ int unit_off(int tok, int cg) { return 8 * (32 * tok + (cg ^ fsw(tok))); }
__device__ __forceinline__ s16x4 rd64(const LAS unsigned char* p) { return *(const LAS s16x4*)p; }
__device__ __forceinline__ s16x4 vtr(const LAS unsigned char* p) { return __builtin_bit_cast(s16x4, __builtin_amdgcn_ds_read_tr16_b64_v4i16((LAS s16x4*)p)); }
__device__ __forceinline__ bf16x8 cat(s16x4 a, s16x4 b) { return (bf16x8){a[0], a[1], a[2], a[3], b[0], b[1], b[2], b[3]}; }
__device__ __forceinline__ f32x4 mfma16(s16x4 a, s16x4 b, f32x4 c) { const s16x4 z = (s16x4){0, 0, 0, 0}; return __builtin_amdgcn_mfma_f32_16x16x32_bf16(cat(a, z), cat(b, z), c, 0, 0, 0); }
__device__ __forceinline__ s16x4 pack4(f32x4 v) { u32x2 w; w.x = moba::cvtpk(v[0], v[1]); w.y = moba::cvtpk(v[2], v[3]); return __builtin_bit_cast(s16x4, w); }
}

__device__ __forceinline__ void hgrn_mfma_phase(Frame& F, int l) {
    using namespace hg;
    PHASE_IDS();
    const int gi = wave >> 2, wg = wave & 3, tig = tid & 255;
    const int c16 = lane & 15, g = lane >> 4;
    LAS unsigned char* L = F.lds + RING_OFF;
    for (int it = (int)blockIdx.x; it < 32; it += F.G) {
        const int bh = it * 2 + gi, b = bh >> 2, h = bh & 3; const size_t rowbase = (size_t)b * SEQ;
        f32x4 S[8][2]; bf16x8 Sb[4][2];
#pragma unroll
        for (int tk = 0; tk < 8; ++tk) { S[tk][0] = (f32x4){0.f, 0.f, 0.f, 0.f}; S[tk][1] = (f32x4){0.f, 0.f, 0.f, 0.f}; }
#pragma unroll
        for (int ks = 0; ks < 4; ++ks) { Sb[ks][0] = (bf16x8){0, 0, 0, 0, 0, 0, 0, 0}; Sb[ks][1] = (bf16x8){0, 0, 0, 0, 0, 0, 0, 0}; }
        f32x4 oprev[2]; oprev[0] = (f32x4){0.f, 0.f, 0.f, 0.f}; oprev[1] = oprev[0];
        LAS unsigned char* G0 = L + gi * GRP;
        LAS float* nrm = (LAS float*)(L + L_NRM) + gi * 128;
        const int st_tok = tig >> 4, st_c = tig & 15;
        const GAS bf16* qsrc = (const GAS bf16*)(F.QI + (rowbase + st_tok) * 512 + h * 128 + 8 * st_c);
        const GAS bf16* ksrc = (const GAS bf16*)(F.KT + (rowbase + st_tok) * 512 + h * 128 + 8 * st_c);
        const GAS bf16* isrc = (const GAS bf16*)(F.HI + (rowbase + st_tok) * 512 + h * 128 + 8 * st_c);
        const GAS float* dsrc = (const GAS float*)(F.DEC + (size_t)b * 128 * 512 + h * 128 + 4 * (tig & 31));
        const int st_off = unit_off(st_tok, 2 * st_c);
        const int dvl = 32 * wg + 4 * g;
        float hw[2][4];
#pragma unroll
        for (int j = 0; j < 2; ++j)
#pragma unroll
            for (int r = 0; r < 4; ++r) hw[j][r] = F.hg_norm_w[l * 128 + dvl + 16 * j + r];
        v4u qreg, kreg, ireg; f32x4 dreg = (f32x4){0.f, 0.f, 0.f, 0.f};
#pragma unroll
        for (int c0 = 0; c0 < 2; ++c0) {
            qreg = *(const GAS v4u*)(qsrc + (size_t)c0 * 16 * 512); kreg = *(const GAS v4u*)(ksrc + (size_t)c0 * 16 * 512); ireg = *(const GAS v4u*)(isrc + (size_t)c0 * 16 * 512);
            if (tig < 32) dreg = *(const GAS f32x4*)(dsrc + (size_t)c0 * 512);
            LAS unsigned char* B0 = G0 + c0 * BUF;
            *(LAS v4u*)(B0 + st_off) = qreg; *(LAS v4u*)(B0 + 4096 + st_off) = kreg; *(LAS v4u*)(B0 + 8192 + st_off) = ireg;
            if (tig < 32) *(LAS f32x4*)(B0 + 12288 + 16 * tig) = dreg; }
        __syncthreads();
        int buf = 0;
        for (int n = 0; n < 128; ++n) {
            if (n + 2 < 128) {
                qreg = *(const GAS v4u*)(qsrc + (size_t)(n + 2) * 16 * 512); kreg = *(const GAS v4u*)(ksrc + (size_t)(n + 2) * 16 * 512); ireg = *(const GAS v4u*)(isrc + (size_t)(n + 2) * 16 * 512);
                if (tig < 32) dreg = *(const GAS f32x4*)(dsrc + (size_t)(n + 2) * 512); }
            u32x2 gw[2];
            if (n > 0) { const GAS bf16* gp = (const GAS bf16*)(F.GH + (rowbase + (size_t)(n - 1) * 16 + c16) * 512 + h * 128 + dvl);
                gw[0] = *(const GAS u32x2*)(gp); gw[1] = *(const GAS u32x2*)(gp + 16); }
            const LAS unsigned char* Qs = G0 + buf * BUF; const LAS unsigned char* Ks = Qs + 4096; const LAS unsigned char* Is = Qs + 8192; const LAS float* Ds = (const LAS float*)(Qs + 12288);
            bf16x8 qf[4], kf[4];
#pragma unroll
            for (int ks = 0; ks < 4; ++ks) {
                qf[ks] = cat(rd64(Qs + unit_off(c16, 8 * ks + g)), rd64(Qs + unit_off(c16, 8 * ks + 4 + g)));
                kf[ks] = cat(rd64(Ks + unit_off(c16, 8 * ks + g)), rd64(Ks + unit_off(c16, 8 * ks + 4 + g))); }
            f32x4 sc = (f32x4){0.f, 0.f, 0.f, 0.f};
#pragma unroll
            for (int ks = 0; ks < 4; ++ks) sc = __builtin_amdgcn_mfma_f32_16x16x32_bf16(kf[ks], qf[ks], sc, 0, 0, 0);
#pragma unroll
            for (int r = 0; r < 4; ++r) if (4 * g + r > c16) sc[r] = 0.f;
            const s16x4 scb = pack4(sc);
            const int trtok = 4 * g + (c16 >> 2), trp = c16 & 3;
            s16x4 itr[2];
#pragma unroll
            for (int j = 0; j < 2; ++j) itr[j] = vtr(Is + unit_off(trtok, 4 * (2 * wg + j) + trp));
            f32x4 o[2];
#pragma unroll
            for (int j = 0; j < 2; ++j) { f32x4 a = (f32x4){0.f, 0.f, 0.f, 0.f};
#pragma unroll
                for (int ks = 0; ks < 4; ++ks) a = __builtin_amdgcn_mfma_f32_16x16x32_bf16(Sb[ks][j], qf[ks], a, 0, 0, 0);
                o[j] = mfma16(itr[j], scb, a); }
            { float ss = 0.f;
#pragma unroll
                for (int j = 0; j < 2; ++j)
#pragma unroll
                    for (int r = 0; r < 4; ++r) ss += o[j][r] * o[j][r];
                ss += __shfl_xor(ss, 16); ss += __shfl_xor(ss, 32);
                if (g == 0) nrm[(n & 1) * 64 + wg * 16 + c16] = ss; }
#pragma unroll
            for (int tk = 0; tk < 8; ++tk) {
                const s16x4 ktr = vtr(Ks + unit_off(trtok, 4 * tk + trp));
                const f32x4 dv4 = *(const LAS f32x4*)(Ds + 16 * tk + 4 * g);
#pragma unroll
                for (int j = 0; j < 2; ++j) { S[tk][j] = mfma16(ktr, itr[j], S[tk][j]); S[tk][j] = S[tk][j] * dv4; } }
#pragma unroll
            for (int ks = 0; ks < 4; ++ks)
#pragma unroll
                for (int j = 0; j < 2; ++j) Sb[ks][j] = cat(pack4(S[2 * ks][j]), pack4(S[2 * ks + 1][j]));
            if (n > 0) { const LAS float* np = nrm + ((n - 1) & 1) * 64 + c16;
                const float ssum = (np[0] + np[16]) + (np[32] + np[48]); const float rstd = 1.0f / sqrtf(ssum * (1.0f / 128.0f) + NORM_EPS);
                GAS bf16* mo = (GAS bf16*)(F.MIXED + (rowbase + (size_t)(n - 1) * 16 + c16) * DM + h * 128 + dvl);
#pragma unroll
                for (int j = 0; j < 2; ++j) { u32x2 w;
                    w.x = pk2(oprev[j][0] * rstd * hw[j][0] * bflo(gw[j].x), oprev[j][1] * rstd * hw[j][1] * bfhi(gw[j].x));
                    w.y = pk2(oprev[j][2] * rstd * hw[j][2] * bflo(gw[j].y), oprev[j][3] * rstd * hw[j][3] * bfhi(gw[j].y));
                    *(GAS u32x2*)(mo + 16 * j) = w; } }
            oprev[0] = o[0]; oprev[1] = o[1];
            if (n + 2 < 128) { const int nb = (buf == 0) ? 2 : buf - 1;
                LAS unsigned char* B0 = G0 + nb * BUF;
                *(LAS v4u*)(B0 + st_off) = qreg; *(LAS v4u*)(B0 + 4096 + st_off) = kreg; *(LAS v4u*)(B0 + 8192 + st_off) = ireg;
                if (tig < 32) *(LAS f32x4*)(B0 + 12288 + 16 * tig) = dreg; }
            __syncthreads();
            buf = (buf == 2) ? 0 : buf + 1;
        }
        { const GAS bf16* gp = (const GAS bf16*)(F.GH + (rowbase + (size_t)127 * 16 + c16) * 512 + h * 128 + dvl);
            u32x2 gw[2]; gw[0] = *(const GAS u32x2*)(gp); gw[1] = *(const GAS u32x2*)(gp + 16);
            const LAS float* np = nrm + 64 + c16;
            const float ssum = (np[0] + np[16]) + (np[32] + np[48]); const float rstd = 1.0f / sqrtf(ssum * (1.0f / 128.0f) + NORM_EPS);
            GAS bf16* mo = (GAS bf16*)(F.MIXED + (rowbase + (size_t)127 * 16 + c16) * DM + h * 128 + dvl);
#pragma unroll
            for (int j = 0; j < 2; ++j) { u32x2 w;
                w.x = pk2(oprev[j][0] * rstd * hw[j][0] * bflo(gw[j].x), oprev[j][1] * rstd * hw[j][1] * bfhi(gw[j].x));
                w.y = pk2(oprev[j][2] * rstd * hw[j][2] * bflo(gw[j].y), oprev[j][3] * rstd * hw[j][3] * bfhi(gw[j].y));
                *(GAS u32x2*)(mo + 16 * j) = w; } }
        __syncthreads();
    }
}

struct Args { const float* in[8]; float* out; unsigned char* ws; int ph_lo, ph_hi, li, pad; };
__global__ void __launch_bounds__(NWAVES * 64, 2) fwd(Args args) {
    extern __shared__ __attribute__((aligned(16))) unsigned char lds[];
    Frame F;
    F.lds = (LAS unsigned char*)lds;
    F.MISC = (volatile LAS unsigned*)(F.lds + MISC_OFF);
    F.G = gridDim.x; { const int bx = blockIdx.x; F.vcu = (F.G % 8 == 0) ? (bx % 8) * (F.G / 8) + bx / 8 : bx; }
    unsigned char* ws = args.ws;
    F.ctl = (gu32*)(ws + WS_CTL);
    F.x = args.in[0]; F.norm_w = args.in[1]; F.w_in = args.in[2]; F.lb_logits = args.in[3]; F.hg_norm_w = args.in[4]; F.q_norm_w = args.in[5]; F.k_norm_w = args.in[6]; F.w_out = args.in[7];
    F.out = args.out;
    F.WIN = (bf16*)(ws + WS_WIN); F.WOUT = (bf16*)(ws + WS_WOUT); F.XB = (bf16*)(ws + WS_XB); F.MIXED = (bf16*)(ws + WS_MIXED);
    F.QI = (bf16*)(ws + WS_ARR); F.KT = (bf16*)(ws + WS_ARR + ARR_BYTES); F.HI = (bf16*)(ws + WS_ARR + 2 * ARR_BYTES); F.GH = (bf16*)(ws + WS_ARR + 3 * ARR_BYTES);
    F.QN = (bf16*)(ws + WS_ARR + 4 * ARR_BYTES); F.KN = (bf16*)(ws + WS_ARR + 5 * ARR_BYTES); F.V = (bf16*)(ws + WS_ARR + 6 * ARR_BYTES); F.GA = (bf16*)(ws + WS_ARR + 7 * ARR_BYTES);
    F.LB = (float*)(ws + WS_LB); F.KPART = (float*)(ws + WS_KPART); F.ROWSS = (float*)(ws + WS_ROWSS); F.DEC = (float*)(ws + WS_DEC);
    for (int u = threadIdx.x; u < (LDS_BYTES - LDSCTL_OFF) / 4; u += NWAVES * 64) ((LAS unsigned*)(F.lds + LDSCTL_OFF))[u] = 0u;
    __syncthreads();
    XcdBarrier bar; bar.bar = (unsigned*)(F.ctl + CW_BAR); bar.x = 0; bar.st = nullptr;
    if (N_LAUNCHES == 1) bar = xcd_barrier_post((unsigned*)(F.ctl + CW_BAR), F.MISC + 8);
#define GRID_BAR() do { if (N_LAUNCHES == 1) xcd_barrier(bar); } while (0)
    const int lo = args.ph_lo, hi = args.ph_hi;
#define IN(k) (lo <= (k) && (k) < hi)
#define BOTH(k) (IN(k) && IN((k) + 1))

    if (IN(0)) { p0_prologue(F); if (BOTH(0)) GRID_BAR(); }
    for (int l = 0; l < DEPTH; ++l) {
        const int pb = 1 + 3 * l;
        if (IN(pb)) {
            pg8::Gemm g{F.XB + (size_t)l * MTOK * DM, F.WIN + (size_t)l * NIN * DM, MTOK, NIN, DM}; pg8::StaticOrder S; S.init(MTOK, NIN, F.G, (int)blockIdx.x);
            pg8::EpiFused E{F.QI, F.DEC, F.KPART, F.ROWSS + (size_t)l * MTOK * 16, F.LB + l * 512, F.q_norm_w + l * 64, F.k_norm_w + l * 64};
            pg8::gemm_phase<pg8::EpiFused, pg8::StaticOrder, true, true>(F.lds + RING_OFF, g, S, E);
            if (BOTH(pb)) GRID_BAR();
        }
        if (IN(pb + 1)) { hgrn_mfma_phase(F, l); moba_mfma_phase(F, l); if (BOTH(pb + 1)) GRID_BAR(); }
        if (IN(pb + 2)) {
            pg8::Gemm g{F.MIXED, F.WOUT + (size_t)l * DM * DM, MTOK, DM, DM}; pg8::StaticOrder S; S.init(MTOK, DM, F.G, (int)blockIdx.x);
            pg8::EpiOut E{l == 0 ? F.x : F.out, F.out, l == 0 ? F.XB + (size_t)MTOK * DM : nullptr, l == 0 ? F.ROWSS + (size_t)MTOK * 16 : nullptr};
            pg8::gemm_phase<pg8::EpiOut, pg8::StaticOrder, true, true>(F.lds + RING_OFF, g, S, E);
            if (pb + 2 < N_PHASES - 1 && BOTH(pb + 2)) GRID_BAR();
        }
    }
#undef IN
#undef BOTH
}

extern "C" void kernel_launch(void* const* d_in, const int* in_sizes, int n_in, void* d_out, int out_size, void* d_ws, size_t ws_size, hipStream_t stream) {
    static int grid = 0;
    if (grid == 0) {
        if (n_in != 8 || in_sizes[0] != MTOK * DM || out_size != MTOK * DM || ws_size < WS_END) { fprintf(stderr, "kernel_launch: unexpected shapes n_in %d in0 %d out %d ws %zu\n", n_in, n_in > 0 ? in_sizes[0] : -1, out_size, ws_size); grid = -1; return; }
        int dev = 0, cus = 0, per_cu = 0;
        if (hipGetDevice(&dev) != hipSuccess || hipDeviceGetAttribute(&cus, hipDeviceAttributeMultiprocessorCount, dev) != hipSuccess) { grid = -1; return; }
        if (hipFuncSetAttribute((const void*)fwd, hipFuncAttributeMaxDynamicSharedMemorySize, LDS_BYTES) != hipSuccess) { fprintf(stderr, "kernel_launch: hipFuncSetAttribute failed\n"); grid = -1; return; }
        if (hipOccupancyMaxActiveBlocksPerMultiprocessor(&per_cu, (const void*)fwd, NWAVES * 64, LDS_BYTES) != hipSuccess || per_cu < 1) fprintf(stderr, "kernel_launch: occupancy query says %d\n", per_cu);
        (void)hipGetLastError();
        if (per_cu < 1) { grid = -1; return; }
        grid = cus;
    }
    if (grid < 0) return;
    if (hipMemsetAsync((char*)d_ws + WS_CTL, 0, CTL_ZERO_BYTES, stream) != hipSuccess) return;
    Args a{};
    for (int i = 0; i < 8; ++i) a.in[i] = (const float*)d_in[i];
    a.out = (float*)d_out; a.ws = (unsigned char*)d_ws;
    for (int li = 0; li < N_LAUNCHES; ++li) {
        a.ph_lo = (N_LAUNCHES == 1) ? 0 : li; a.ph_hi = (N_LAUNCHES == 1) ? N_PHASES : li + 1; a.li = li;
        hipError_t le;
        if (N_LAUNCHES == 1) { void* kargs[] = {(void*)&a}; le = hipLaunchCooperativeKernel((const void*)fwd, dim3(grid), dim3(NWAVES * 64), kargs, LDS_BYTES, stream); }
        else { hipLaunchKernelGGL(fwd, dim3(grid), dim3(NWAVES * 64), LDS_BYTES, stream, a); le = hipPeekAtLastError(); }
        if (le != hipSuccess) { fprintf(stderr, "kernel_launch: launch %d failed: %s\n", li, hipGetErrorName(le)); break; }
    }
}
```

```cpp
#include <hip/hip_runtime.h>
#include <cstdio>
#include <cstdint>
namespace pg8 {
#define PG8_LAS __attribute__((address_space(3)))
typedef unsigned short bf16_t;
typedef short bf16x8 __attribute__((ext_vector_type(8)));
typedef float f32x4 __attribute__((ext_vector_type(4)));
typedef unsigned u32x4 __attribute__((ext_vector_type(4)));
typedef unsigned u32x2 __attribute__((ext_vector_type(2)));
constexpr int BM = 256, BK = 64, HALF = 128, HTB = HALF * BK * 2  , STAGE_BYTES = 8 * HTB, NXCD = 8, WGM = 8;

__host__ __device__ __forceinline__ int lds_byte(int r, int c) { const int st = (r >> 4) * 2 + (c >> 5), rr = r & 15, cc = c & 31, ob = rr * 64 + cc * 2; return st * 1024 + (ob ^ (((ob >> 9) & 1) << 5)); }
__host__ __device__ __forceinline__ void stage_rc(int b, int& R, int& C) { const int st = b / 1024, sb = b % 1024, swz = sb ^ (((sb >> 9) & 1) << 5); R = (st >> 1) * 16 + swz / 64; C = (st & 1) * 32 + (swz % 64) / 2; }
__host__ __device__ __forceinline__ int perm32(int rho) { const int n = rho >> 4, i = rho & 15; return 8 * (i >> 2) + 4 * n + (i & 3); }

struct Unit { int pm, pn; };
struct Gemm { const bf16_t* A; const bf16_t* Bt; int M, N, K; };

struct StaticOrder {
    int nM, nN, nwg, G, c;
    __host__ __device__ void init(int M, int N, int G_, int c_) { nM = M / BM; nN = N / BM; nwg = nM * nN; G = G_; c = c_; }
    __host__ __device__ bool next(int i, Unit& u) const {
        const long L = (long)i * G + c; if (L >= nwg) return false;
        int wgid = (int)L; { const int q = nwg / NXCD, r = nwg % NXCD, xcd = wgid % NXCD, off = wgid / NXCD; wgid = (xcd < r ? xcd * (q + 1) : r * (q + 1) + (xcd - r) * q) + off; }
        const int nig = WGM * nN, gid = wgid / nig, fm = gid * WGM, gsz = (nM - fm) < WGM ? (nM - fm) : WGM;
        u.pm = fm + ((wgid % nig) % gsz); u.pn = (wgid % nig) / gsz; return true;
    }
    __device__ __forceinline__ void a_ready(const Unit&) const {}
    __device__ __forceinline__ void done(const Unit&) const {}
};

__device__ __forceinline__ unsigned cvt_pk_bf16(float lo, float hi) { unsigned r; asm volatile("v_cvt_pk_bf16_f32 %0, %1, %2" : "=v"(r) : "v"(lo), "v"(hi)); return r; }


__device__ __forceinline__ float dpp_row_shr(float v, int n) {
    const int x = __builtin_bit_cast(int, v);
    int r;
    if (n == 1) r = __builtin_amdgcn_update_dpp(0, x, 0x111, 0xf, 0xf, false);
    else if (n == 2) r = __builtin_amdgcn_update_dpp(0, x, 0x112, 0xf, 0xf, false);
    else if (n == 4) r = __builtin_amdgcn_update_dpp(0, x, 0x114, 0xf, 0xf, false);
    else r = __builtin_amdgcn_update_dpp(0, x, 0x118, 0xf, 0xf, false);
    return __builtin_bit_cast(float, r);
}
__device__ __forceinline__ float fsig(float z) { return __builtin_amdgcn_rcpf(1.0f + __expf(-z)); }
struct EpiFused {
    static constexpr bool PERM = true, AFTER_DRAIN = false;
    bf16_t* ARR; float* DEC; float* KPART; const float* rowss; const float* lb; const float* qg; const float* kg;
    static constexpr size_t AS = (size_t)32768 * 512;
    __device__ __forceinline__ float rstd_of(int row) const {
        const f32x4* rp = (const f32x4*)(rowss + (size_t)row * 16);
        const f32x4 a = rp[0], b = rp[1], c = rp[2], d = rp[3];
        const float ss = ((a[0] + a[1]) + (a[2] + a[3])) + ((b[0] + b[1]) + (b[2] + b[3])) + ((c[0] + c[1]) + (c[2] + c[3])) + ((d[0] + d[1]) + (d[2] + d[3]));
        return 1.0f / sqrtf(ss * (1.0f / 1024.0f) + 1e-6f);
    }
    static __device__ __forceinline__ u32x4 pack8(const float (&v)[8]) { u32x4 w; w.x = cvt_pk_bf16(v[0], v[1]); w.y = cvt_pk_bf16(v[2], v[3]); w.z = cvt_pk_bf16(v[4], v[5]); w.w = cvt_pk_bf16(v[6], v[7]); return w; }
    __device__ __forceinline__ void operator()(const f32x4 (&acc)[2][2][4][2], const Unit& u, int wr, int wc, int fr, int fq) const {
        const int row0 = u.pm * BM + wr * 64 + fr; const int pn = u.pn;
        if (pn < 4) {
            const int cb = pn * 128 + wc * 32 + 8 * fq;
            float lbv[8];
#pragma unroll
            for (int k = 0; k < 8; ++k) lbv[k] = lb[cb + k];
#pragma unroll
            for (int ai = 0; ai < 2; ++ai)
#pragma unroll
                for (int mp = 0; mp < 2; ++mp) { const int row1 = row0 + ai * HALF + mp * 32, row2 = row1 + 16; const float rs1 = rstd_of(row1), rs2 = rstd_of(row2);
                    float qi1[8], kt1[8], qi2[8], kt2[8], dc[8];
#pragma unroll
                    for (int k = 0; k < 8; ++k) {
                        const float zq1 = acc[ai][0][2 * mp][k >> 2][k & 3] * rs1, zf1 = acc[ai][1][2 * mp][k >> 2][k & 3] * rs1;
                        const float zq2 = acc[ai][0][2 * mp + 1][k >> 2][k & 3] * rs2, zf2 = acc[ai][1][2 * mp + 1][k >> 2][k & 3] * rs2;
                        const float f1 = lbv[k] + (1.0f - lbv[k]) * fsig(zf1), f2 = lbv[k] + (1.0f - lbv[k]) * fsig(zf2);
                        float b1 = __logf(f1), b2 = __logf(f2);
                        b1 += dpp_row_shr(b1, 1); b2 += dpp_row_shr(b2, 1); b1 += dpp_row_shr(b1, 2); b2 += dpp_row_shr(b2, 2);
                        b1 += dpp_row_shr(b1, 4); b2 += dpp_row_shr(b2, 4); b1 += dpp_row_shr(b1, 8); b2 += dpp_row_shr(b2, 8);
                        b2 += __shfl(b1, (fq << 4) | 15);
                        const float e1 = __expf(b1), e2 = __expf(b2);
                        qi1[k] = zq1 * fsig(zq1) * e1; kt1[k] = (1.0f - f1) * __expf(fminf(-b1, 80.0f));
                        qi2[k] = zq2 * fsig(zq2) * e2; kt2[k] = (1.0f - f2) * __expf(fminf(-b2, 80.0f)); dc[k] = e2; }
                    *(u32x4*)(ARR + (size_t)row1 * 512 + cb) = pack8(qi1); *(u32x4*)(ARR + AS + (size_t)row1 * 512 + cb) = pack8(kt1);
                    *(u32x4*)(ARR + (size_t)row2 * 512 + cb) = pack8(qi2); *(u32x4*)(ARR + AS + (size_t)row2 * 512 + cb) = pack8(kt2);
                    if (fr == 15) { float* dp = DEC + (size_t)(row1 >> 5) * 512 + cb; *(f32x4*)dp = (f32x4){dc[0], dc[1], dc[2], dc[3]}; *(f32x4*)(dp + 4) = (f32x4){dc[4], dc[5], dc[6], dc[7]}; }
                    asm volatile("" ::: "memory"); }
        } else if (pn < 8) {
            const int cb = (pn - 4) * 128 + wc * 32 + 8 * fq;
#pragma unroll
            for (int ai = 0; ai < 2; ++ai)
#pragma unroll
                for (int m = 0; m < 4; ++m) { const int row = row0 + ai * HALF + m * 16; const float rs = rstd_of(row);
                    float iv[8], gv[8];
#pragma unroll
                    for (int k = 0; k < 8; ++k) { iv[k] = acc[ai][0][m][k >> 2][k & 3] * rs; const float zg = acc[ai][1][m][k >> 2][k & 3] * rs; gv[k] = zg * fsig(zg); }
                    *(u32x4*)(ARR + 2 * AS + (size_t)row * 512 + cb) = pack8(iv); *(u32x4*)(ARR + 3 * AS + (size_t)row * 512 + cb) = pack8(gv);
                    asm volatile("" ::: "memory"); }
        } else {
            const int ty = (pn - 8) >> 1, head = 4 * ((pn - 8) & 1) + wc; const int d0 = 8 * fq;
            bf16_t* dst = ARR + (size_t)(4 + ty) * AS;
            float gain[2][8]; float csum[2][8];
#pragma unroll
            for (int bj = 0; bj < 2; ++bj)
#pragma unroll
                for (int k = 0; k < 8; ++k) { gain[bj][k] = (ty == 0) ? qg[bj * 32 + d0 + k] * (0.125f * 1.4426950408889634f) : (ty == 1) ? kg[bj * 32 + d0 + k] : 1.0f; csum[bj][k] = 0.f; }
#pragma unroll
            for (int ai = 0; ai < 2; ++ai)
#pragma unroll
                for (int m = 0; m < 4; ++m) { const int row = row0 + ai * HALF + m * 16; const float rs = rstd_of(row);
                    float v[2][8];
#pragma unroll
                    for (int bj = 0; bj < 2; ++bj)
#pragma unroll
                        for (int k = 0; k < 8; ++k) v[bj][k] = acc[ai][bj][m][k >> 2][k & 3] * rs;
                    if (ty < 2) { float ss = 0.f;
#pragma unroll
                        for (int bj = 0; bj < 2; ++bj)
#pragma unroll
                            for (int k = 0; k < 8; ++k) ss += v[bj][k] * v[bj][k];
                        ss += __shfl_xor(ss, 16); ss += __shfl_xor(ss, 32);
                        const float r2 = 1.0f / sqrtf(ss * (1.0f / 64.0f) + 1e-6f);
#pragma unroll
                        for (int bj = 0; bj < 2; ++bj)
#pragma unroll
                            for (int k = 0; k < 8; ++k) { v[bj][k] *= r2 * gain[bj][k]; csum[bj][k] += v[bj][k]; }
                    } else if (ty == 3) {
#pragma unroll
                        for (int bj = 0; bj < 2; ++bj)
#pragma unroll
                            for (int k = 0; k < 8; ++k) v[bj][k] = v[bj][k] * fsig(v[bj][k]); }
                    *(u32x4*)(dst + (size_t)row * 512 + head * 64 + d0) = pack8(v[0]); *(u32x4*)(dst + (size_t)row * 512 + head * 64 + 32 + d0) = pack8(v[1]);
                    asm volatile("" ::: "memory"); }
            if (ty == 1) {
#pragma unroll
                for (int bj = 0; bj < 2; ++bj)
#pragma unroll
                    for (int k = 0; k < 8; ++k) { float s = csum[bj][k]; s += __shfl_xor(s, 1); s += __shfl_xor(s, 2); s += __shfl_xor(s, 4); s += __shfl_xor(s, 8); csum[bj][k] = s; }
                if (fr == 0) { float* kp = KPART + ((size_t)u.pm * 2 + wr) * 512 + head * 64 + d0;
#pragma unroll
                    for (int bj = 0; bj < 2; ++bj) { *(f32x4*)(kp + bj * 32) = (f32x4){csum[bj][0], csum[bj][1], csum[bj][2], csum[bj][3]}; *(f32x4*)(kp + bj * 32 + 4) = (f32x4){csum[bj][4], csum[bj][5], csum[bj][6], csum[bj][7]}; } }
            }
        }
    }
};
struct EpiOut {
    static constexpr bool PERM = false, AFTER_DRAIN = false;
    const float* xres; float* out; bf16_t* xb; float* rowss;
    __device__ __forceinline__ void operator()(const f32x4 (&acc)[2][2][4][2], const Unit& u, int wr, int wc, int fr, int fq) const {
        const int col0 = u.pn * BM + wc * 32 + 4 * fq;
#pragma unroll
        for (int ai = 0; ai < 2; ++ai)
#pragma unroll
            for (int m = 0; m < 4; ++m) {
                const int row = u.pm * BM + ai * HALF + wr * 64 + m * 16 + fr; float ss = 0.f;
#pragma unroll
                for (int bj = 0; bj < 2; ++bj)
#pragma unroll
                    for (int n = 0; n < 2; ++n) { const size_t off = (size_t)row * 1024 + col0 + bj * HALF + n * 16;
                        const f32x4 v = *(const f32x4*)(xres + off) + acc[ai][bj][m][n];
                        *(f32x4*)(out + off) = v; if (xb) { u32x2 w; w.x = cvt_pk_bf16(v[0], v[1]); w.y = cvt_pk_bf16(v[2], v[3]); *(u32x2*)(xb + off) = w; }
                        ss += (v[0] * v[0] + v[1] * v[1]) + (v[2] * v[2] + v[3] * v[3]); }
                ss += __shfl_xor(ss, 16); ss += __shfl_xor(ss, 32);
                if (fq == 0 && rowss) rowss[(size_t)row * 16 + u.pn * 4 + wc] = ss;
            }
    }
};

template <class Epi, class Sched, bool ALIGN_EPI = false, bool SP2 = false>
__device__ __forceinline__ void gemm_phase(PG8_LAS unsigned char* lds, const Gemm g, const Sched& S, const Epi& E) {
    int tid = threadIdx.x; asm volatile("" : "+v"(tid));
    const int wid = __builtin_amdgcn_readfirstlane(tid >> 6), lane = tid & 63, wr = wid >> 2, wc = wid & 3, fr = lane & 15, fq = lane >> 4;
    const int K = g.K, nt = K / BK;
    unsigned voffA[2], voffB[2];
#pragma unroll
    for (int i = 0; i < 2; ++i) { int R, C; stage_rc(tid * 16 + i * 8192, R, C); const int Rb = Epi::PERM ? ((R & ~31) + perm32(R & 31)) : R;
        voffA[i] = (unsigned)(R * K + C) * 2u; voffB[i] = (unsigned)(Rb * K + C) * 2u; }
    const size_t kstep = (size_t)(BK * 2);
    const size_t hstep = (size_t)HALF * K * 2;
    const size_t tstep = 2 * hstep;
    const unsigned ldsw = (unsigned)wid * 1024u;
    const int aoff = lds_byte(wr * 64 + fr, fq * 8), boff = lds_byte(wc * 32 + fr, fq * 8);
#define PG8_SA(b, h) (((b) * 2 + (h)) * HTB)
#define PG8_SB(b, h) ((4 + (b) * 2 + (h)) * HTB)
#define PG8_STAGE(bufoff, gbase, voff) do { _Pragma("unroll") for (int _i = 0; _i < 2; ++_i) \
        __builtin_amdgcn_global_load_lds((const unsigned*)((const char*)(gbase) + (voff)[_i]), (PG8_LAS unsigned*)(lds + (bufoff) + ldsw + _i * 8192), 16, 0, 0); } while (0)
#define PG8_LDA(dst, b, h) do { _Pragma("unroll") for (int m = 0; m < 4; ++m) _Pragma("unroll") for (int k = 0; k < 2; ++k) dst[m][k] = *(const PG8_LAS bf16x8*)(lds + PG8_SA(b, h) + aoff + m * 2048 + k * 1024); } while (0)
#define PG8_LDB(dst, b, h) do { _Pragma("unroll") for (int n = 0; n < 2; ++n) _Pragma("unroll") for (int k = 0; k < 2; ++k) dst[n][k] = *(const PG8_LAS bf16x8*)(lds + PG8_SB(b, h) + boff + n * 2048 + k * 1024); } while (0)
#define PG8_MMA(ai, bj, At, Bt) do { __builtin_amdgcn_s_setprio(1); _Pragma("unroll") for (int m = 0; m < 4; ++m) _Pragma("unroll") for (int n = 0; n < 2; ++n) _Pragma("unroll") for (int k = 0; k < 2; ++k) \
        acc[ai][bj][m][n] = __builtin_amdgcn_mfma_f32_16x16x32_bf16(Bt[n][k], At[m][k], acc[ai][bj][m][n], 0, 0, 0); __builtin_amdgcn_s_setprio(0); } while (0)
#define PG8_WAIT_V(n) asm volatile("s_waitcnt vmcnt(" #n ")" ::: "memory")
#define PG8_WAIT_L(n) asm volatile("s_waitcnt lgkmcnt(" #n ")" ::: "memory")
#define PG8_BAR __builtin_amdgcn_s_barrier()
#define PG8_SCHED __builtin_amdgcn_sched_barrier(0)
    Unit cur, nxt; int ui = 0;
    if (!S.next(0, cur)) return;
    f32x4 acc[2][2][4][2];
#pragma unroll
    for (int a = 0; a < 2; ++a)
#pragma unroll
        for (int b = 0; b < 2; ++b)
#pragma unroll
            for (int m = 0; m < 4; ++m)
#pragma unroll
                for (int n = 0; n < 2; ++n) acc[a][b][m][n] = (f32x4){0.f, 0.f, 0.f, 0.f};
    bf16x8 At[4][2], B0[2][2], B1[2][2];
    const char* cA = (const char*)g.A + (size_t)cur.pm * tstep; const char* cB = (const char*)g.Bt + (size_t)cur.pn * tstep;
    S.a_ready(cur);
    if constexpr (SP2) {
        PG8_STAGE(PG8_SB(0, 0), cB, voffB); PG8_STAGE(PG8_SB(0, 1), cB + hstep, voffB); PG8_STAGE(PG8_SA(0, 0), cA, voffA); PG8_STAGE(PG8_SA(0, 1), cA + hstep, voffA);
        if (wr == 1) PG8_BAR;
        PG8_WAIT_V(2); PG8_BAR;
        PG8_STAGE(PG8_SB(1, 0), cB + kstep, voffB); PG8_STAGE(PG8_SA(1, 0), cA + kstep, voffA); PG8_STAGE(PG8_SB(1, 1), cB + hstep + kstep, voffB);
        PG8_WAIT_V(6); PG8_BAR;
    } else {
        PG8_STAGE(PG8_SB(0, 0), cB, voffB); PG8_STAGE(PG8_SA(0, 0), cA, voffA); PG8_STAGE(PG8_SB(0, 1), cB + hstep, voffB); PG8_STAGE(PG8_SA(0, 1), cA + hstep, voffA);
        if (wr == 1) PG8_BAR;
        PG8_WAIT_V(4); PG8_BAR;
        PG8_STAGE(PG8_SB(1, 0), cB + kstep, voffB); PG8_STAGE(PG8_SA(1, 0), cA + kstep, voffA); PG8_STAGE(PG8_SB(1, 1), cB + hstep + kstep, voffB);
        PG8_WAIT_V(6); PG8_BAR;
    }
    for (;;) {
        const bool has_next = S.next(ui + 1, nxt);
        const char* nA = has_next ? (const char*)g.A + (size_t)nxt.pm * tstep : cA; const char* nB = has_next ? (const char*)g.Bt + (size_t)nxt.pn * tstep : cB;
        for (int t = 0; t < nt; t += 2) {
            const bool last = (t == nt - 2);
            const char* a1 = cA + (size_t)(t + 1) * kstep;
            const char* a2 = last ? nA : cA + (size_t)(t + 2) * kstep; const char* b2 = last ? nB : cB + (size_t)(t + 2) * kstep;
            const char* a3 = a2 + kstep; const char* b3 = b2 + kstep;
            if (last && has_next) S.a_ready(nxt);
            if constexpr (SP2) {
            PG8_LDB(B0, 0, 0); PG8_LDB(B1, 0, 1); PG8_SCHED; PG8_LDA(At, 0, 0); PG8_STAGE(PG8_SA(1, 1), a1 + hstep, voffA);
            PG8_WAIT_V(8); PG8_WAIT_L(0); PG8_BAR; PG8_MMA(0, 0, At, B0); PG8_MMA(0, 1, At, B1); PG8_BAR; PG8_SCHED;
            PG8_LDA(At, 0, 1); PG8_STAGE(PG8_SB(0, 0), b2, voffB); PG8_STAGE(PG8_SB(0, 1), b2 + hstep, voffB); PG8_STAGE(PG8_SA(0, 0), a2, voffA);
            PG8_WAIT_V(8); PG8_WAIT_L(0); PG8_BAR; PG8_MMA(1, 0, At, B0); PG8_MMA(1, 1, At, B1); PG8_BAR; PG8_SCHED;
            PG8_LDB(B0, 1, 0); PG8_LDB(B1, 1, 1); PG8_SCHED; PG8_LDA(At, 1, 0); PG8_STAGE(PG8_SA(0, 1), a2 + hstep, voffA);
            PG8_WAIT_V(8); PG8_WAIT_L(0); PG8_BAR; PG8_MMA(0, 0, At, B0); PG8_MMA(0, 1, At, B1); PG8_BAR; PG8_SCHED;
            PG8_LDA(At, 1, 1); PG8_STAGE(PG8_SB(1, 0), b3, voffB); PG8_STAGE(PG8_SB(1, 1), b3 + hstep, voffB); PG8_STAGE(PG8_SA(1, 0), a3, voffA);
            PG8_WAIT_V(8); PG8_WAIT_L(0); PG8_BAR; PG8_MMA(1, 0, At, B0); PG8_MMA(1, 1, At, B1); PG8_BAR; PG8_SCHED;
            } else {
            PG8_LDB(B0, 0, 0); PG8_SCHED; PG8_LDA(At, 0, 0); PG8_STAGE(PG8_SA(1, 1), a1 + hstep, voffA);
            PG8_WAIT_L(8); PG8_BAR; PG8_WAIT_L(0); PG8_MMA(0, 0, At, B0); PG8_BAR; PG8_SCHED;
            PG8_LDB(B1, 0, 1); PG8_STAGE(PG8_SB(0, 0), b2, voffB);
            PG8_BAR; PG8_WAIT_L(0); PG8_MMA(0, 1, At, B1); PG8_BAR;
            PG8_LDA(At, 0, 1); PG8_STAGE(PG8_SA(0, 0), a2, voffA);
            PG8_BAR; PG8_WAIT_L(0); PG8_MMA(1, 0, At, B0); PG8_BAR; PG8_SCHED;
            PG8_STAGE(PG8_SB(0, 1), b2 + hstep, voffB);
            PG8_WAIT_V(6); PG8_BAR; PG8_MMA(1, 1, At, B1); PG8_BAR;
            PG8_LDB(B0, 1, 0); PG8_SCHED; PG8_LDA(At, 1, 0); PG8_STAGE(PG8_SA(0, 1), a2 + hstep, voffA);
            PG8_WAIT_L(8); PG8_BAR; PG8_WAIT_L(0); PG8_MMA(0, 0, At, B0); PG8_BAR; PG8_SCHED;
            PG8_LDB(B1, 1, 1); PG8_STAGE(PG8_SB(1, 0), b3, voffB);
            PG8_BAR; PG8_WAIT_L(0); PG8_MMA(0, 1, At, B1); PG8_BAR;
            PG8_LDA(At, 1, 1); PG8_STAGE(PG8_SA(1, 0), a3, voffA);
            PG8_BAR; PG8_WAIT_L(0); PG8_MMA(1, 0, At, B0); PG8_BAR; PG8_SCHED;
            PG8_STAGE(PG8_SB(1, 1), b3 + hstep, voffB);
            PG8_WAIT_V(6); PG8_BAR; PG8_MMA(1, 1, At, B1); PG8_BAR;
            }
        }
        if constexpr (ALIGN_EPI) { if (wr == 0) PG8_BAR; }
        if constexpr (!Epi::AFTER_DRAIN) { E(acc, cur, wr, wc, fr, fq); S.done(cur); }
        if (!has_next) break;
#pragma unroll
        for (int a = 0; a < 2; ++a)
#pragma unroll
            for (int b = 0; b < 2; ++b)
#pragma unroll
                for (int m = 0; m < 4; ++m)
#pragma unroll
                    for (int n = 0; n < 2; ++n) acc[a][b][m][n] = (f32x4){0.f, 0.f, 0.f, 0.f};
        cur = nxt; cA = nA; cB = nB; ++ui;
        if constexpr (ALIGN_EPI) { if (wr == 1) PG8_BAR; }
    }
    PG8_WAIT_V(0);
    if constexpr (!ALIGN_EPI) { if (wr == 0) PG8_BAR; }
    PG8_BAR;
    if constexpr (Epi::AFTER_DRAIN) { E.fused(acc, cur, wr, wc, fr, fq, lds, wid, lane); S.done(cur); }
#undef PG8_SA
#undef PG8_SB
#undef PG8_STAGE
#undef PG8_LDA
#undef PG8_LDB
#undef PG8_MMA
#undef PG8_WAIT_V
#undef PG8_WAIT_L
#undef PG8_BAR
#undef PG8_SCHED
}
}


constexpr int NWAVES = 8;
#ifndef MK_N_LAUNCHES
#define MK_N_LAUNCHES 1
#endif
constexpr int N_PHASES = 7;
constexpr int N_LAUNCHES = MK_N_LAUNCHES;

constexpr int BATCH = 16, SEQ = 2048, DM = 1024, DEPTH = 2, MTOK = BATCH * SEQ, NIN = 4096;
constexpr int C_HQ = 0, C_HF = 512, C_HI = 1024, C_HG = 1536, C_AQ = 2048, C_AK = 2560, C_AV = 3072, C_AG = 3584;
constexpr float NORM_EPS = 1e-6f;

constexpr size_t MiB = 1u << 20;
constexpr size_t WS_CTL = 0, CTL_ZERO_BYTES = 1 * MiB;
constexpr size_t WS_WIN = 2 * MiB;
constexpr size_t WS_WOUT = 18 * MiB;
constexpr size_t WS_LB = 22 * MiB;
constexpr size_t WS_KPART = 22 * MiB + 65536;
constexpr size_t WS_ROWSS = 24 * MiB;
constexpr size_t WS_DEC = 28 * MiB;
constexpr size_t WS_XB = 32 * MiB;
constexpr size_t WS_MIXED = 160 * MiB;
constexpr size_t WS_ARR = 224 * MiB;
constexpr size_t ARR_BYTES = 32 * MiB;
constexpr size_t WS_END = 480 * MiB;
constexpr int CW_QUEUE = 1024;
constexpr int CW_BAR = 4096;

constexpr int RING_OFF = 0, RING_BYTES = 131072;
constexpr int EXTRA_OFF = RING_BYTES, EXTRA_BYTES = 16384;
constexpr int LDSCTL_OFF = EXTRA_OFF + EXTRA_BYTES, MISC_OFF = LDSCTL_OFF + 320;
constexpr int LDS_BYTES = LDSCTL_OFF + 1024;

#define GAS __attribute__((address_space(1)))
#define LAS __attribute__((address_space(3)))
typedef unsigned short bf16;
typedef unsigned v4u __attribute__((ext_vector_type(4)));
typedef float f32x4 __attribute__((ext_vector_type(4)));
typedef GAS unsigned gu32;
#define RLX_AGENT __ATOMIC_RELAXED, __HIP_MEMORY_SCOPE_AGENT
#define LDS_WAIT() asm volatile("s_waitcnt lgkmcnt(0)" ::: "memory")
#define VM_WAIT() asm volatile("s_waitcnt vmcnt(0)" ::: "memory")
__device__ __forceinline__ unsigned f2bf(float f) { unsigned u = __builtin_bit_cast(unsigned, f); return (u + 0x7fffu + ((u >> 16) & 1u)) >> 16; }
__device__ __forceinline__ unsigned pk2(float lo, float hi) { return f2bf(lo) | (f2bf(hi) << 16); }
__device__ __forceinline__ float bf2f(unsigned short b) { return __builtin_bit_cast(float, (unsigned)b << 16); }
__device__ __forceinline__ float bflo(unsigned w) { return __builtin_bit_cast(float, w << 16); }
__device__ __forceinline__ float bfhi(unsigned w) { return __builtin_bit_cast(float, w & 0xffff0000u); }
__device__ __forceinline__ float silu_f(float z) { return z / (1.0f + __expf(-z)); }
__device__ __forceinline__ float sigmoid_f(float z) { return 1.0f / (1.0f + __expf(-z)); }

#define XB_TMO      128
#define XB_XCNT(j)  (256  + 64 * (j))
#define XB_XSUB(j)  (1280 + 64 * (j))
#define XB_XGEN(j)  (2304 + 64 * (j))
#define XB_TOP      3328
#define XB_TOPGEN   3392
#define XCD_BAR_WORDS 3456
#define XB_SPIN_CAP (1u << 18)

__device__ __forceinline__ unsigned xb_ld(unsigned* p)              { return __hip_atomic_load(p, __ATOMIC_RELAXED, __HIP_MEMORY_SCOPE_AGENT); }
__device__ __forceinline__ unsigned xb_add(unsigned* p, unsigned v) { return __hip_atomic_fetch_add(p, v, __ATOMIC_RELAXED, __HIP_MEMORY_SCOPE_AGENT); }
__device__ __forceinline__ unsigned xb_xcc_id() { return (unsigned)__builtin_amdgcn_s_getreg((3 << 11) | 20) & 0xFu; }
#define XB_SPIN(cond, bar) do { unsigned _sp = 0; while (cond) { __builtin_amdgcn_s_sleep(1); \
    if ((++_sp & 255u) == 0u) { if (xb_ld(&(bar)[XB_TMO])) break; if (_sp > XB_SPIN_CAP) { atomicAdd(&(bar)[XB_TMO], 1u); break; } } } } while (0)

struct XcdBarrier {
    unsigned* bar; unsigned x;
    volatile LAS unsigned* st;
};

__device__ __forceinline__ XcdBarrier xcd_barrier_post(unsigned* bar, volatile LAS unsigned* st) {
    XcdBarrier b; b.bar = bar; b.x = xb_xcc_id(); b.st = st;
    if (threadIdx.x == 0) (void)xb_add(&bar[XB_XCNT(b.x)], 1u);
    return b;
}
__device__ __forceinline__ void xcd_barrier_complete(unsigned* bar, unsigned x, unsigned& nloc, unsigned& nx) {
    const unsigned G = gridDim.x * gridDim.y * gridDim.z;
    unsigned sum, cnt, mine, sp = 0u;
    for (;;) {
        sum = 0u; cnt = 0u; mine = 0u;
#pragma unroll
        for (unsigned j = 0; j < 16; ++j) { const unsigned c = xb_ld(&bar[XB_XCNT(j)]); sum += c; cnt += (c > 0u) ? 1u : 0u; mine = (j == x) ? c : mine; }
        if (sum == G) break;
        __builtin_amdgcn_s_sleep(1);
        if ((++sp & 255u) == 0u) { if (xb_ld(&bar[XB_TMO])) break; if (sp > XB_SPIN_CAP) { atomicAdd(&bar[XB_TMO], 1u); break; } }
    }
    nloc = mine > 0u ? mine : 1u; nx = cnt > 0u ? cnt : 1u;
}

__device__ __forceinline__ void xcd_barrier(const XcdBarrier& b) {
    asm volatile("s_waitcnt vmcnt(0)" ::: "memory");
    __syncthreads();
    if (threadIdx.x == 0) {
        unsigned* bar = b.bar;
        __builtin_amdgcn_s_waitcnt(0);
        unsigned nloc = b.st[0], nx = b.st[1];
        if (nloc == 0u) { xcd_barrier_complete(bar, b.x, nloc, nx); b.st[0] = nloc; b.st[1] = nx; }
        const unsigned old = xb_add(&bar[XB_XSUB(b.x)], 1u);
        const unsigned gen = old / nloc;
        if (old + 1u == (gen + 1u) * nloc) {
            __builtin_amdgcn_fence(__ATOMIC_RELEASE, "agent");
            asm volatile("s_waitcnt vmcnt(0)" ::: "memory");
            const unsigned og = xb_add(&bar[XB_TOP], 1u);
            const unsigned tg = og / nx;
            if (og + 1u == (tg + 1u) * nx) xb_add(&bar[XB_TOPGEN], 1u);
            else XB_SPIN(xb_ld(&bar[XB_TOPGEN]) == tg, bar);
            __builtin_amdgcn_fence(__ATOMIC_ACQUIRE, "agent");
            xb_add(&bar[XB_XGEN(b.x)], 1u);
            asm volatile("s_waitcnt vmcnt(0)" ::: "memory");
        } else {
            XB_SPIN(xb_ld(&bar[XB_XGEN(b.x)]) == gen, bar);
            __builtin_amdgcn_fence(__ATOMIC_ACQUIRE, "agent");
            asm volatile("s_waitcnt vmcnt(0)" ::: "memory");
        }
    }
    __syncthreads();
}


struct Frame {
    LAS unsigned char* lds;
    volatile LAS unsigned* MISC;
    gu32* ctl;
    int vcu, G;
    const float* x; float* out;
    const float *norm_w, *w_in, *lb_logits, *hg_norm_w, *q_norm_w, *k_norm_w, *w_out;
    bf16 *WIN, *WOUT, *XB, *MIXED, *QI, *KT, *HI, *GH, *QN, *KN, *V, *GA;
    float *LB, *KPART, *ROWSS, *DEC;
};

__device__ __forceinline__ float wave_sum(float v) {
#pragma unroll
    for (int o = 1; o < 64; o <<= 1) v += __shfl_xor(v, o);
    return v;
}
__device__ __forceinline__ int win_dest(int oc) {
    if (oc < 2048) { const int grp = oc >> 9, hh = (oc >> 7) & 3, w = oc & 127; return 256 * (((grp >> 1) << 2) + hh) + 128 * (grp & 1) + w; }
    const int ty = (oc - 2048) >> 9, head = (oc >> 6) & 7, bj = (oc >> 5) & 1; return 256 * (8 + 2 * ty + (head >> 2)) + 128 * bj + 32 * (head & 3);
}
__device__ __forceinline__ void p0_transpose_item(const float* W, int K, int N, bf16* WT, const float* kscale, LAS float* scr, int item, int lane, bool permute) {
    const int nblk = N / 32, kb = item / nblk, nb = item % nblk, k0 = 64 * kb, n0 = 32 * nb; const int nd = permute ? win_dest(n0) : n0;
#pragma unroll 8
    for (int i = 0; i < 32; ++i) { const int kk = 2 * i + (lane >> 5); const float s = kscale ? kscale[k0 + kk] : 1.0f; scr[kk * 33 + (lane & 31)] = W[(size_t)(k0 + kk) * N + n0 + (lane & 31)] * s; }
    LDS_WAIT(); asm volatile("" ::: "memory");
    const int c = lane & 7;
#pragma unroll
    for (int j = 0; j < 4; ++j) { const int n = (lane >> 3) + 8 * j; const LAS float* s = scr + (8 * c) * 33 + n;
        v4u o; o.x = pk2(s[0 * 33], s[1 * 33]); o.y = pk2(s[2 * 33], s[3 * 33]); o.z = pk2(s[4 * 33], s[5 * 33]); o.w = pk2(s[6 * 33], s[7 * 33]);
        *(GAS v4u*)(WT + (size_t)(nd + n) * K + k0 + 8 * c) = o; }
    LDS_WAIT(); asm volatile("" ::: "memory");
}
#define PHASE_IDS() int t_ = threadIdx.x; asm volatile("" : "+v"(t_)); const int tid = t_, lane = tid & 63, wave = __builtin_amdgcn_readfirstlane(tid >> 6); (void)lane; (void)wave
__device__ __forceinline__ void p0_prologue(Frame& F) {
    PHASE_IDS();
    LAS float* scr = (LAS float*)(F.lds + RING_OFF + wave * 16384);
    const int gw = F.vcu * NWAVES + wave, NGW = F.G * NWAVES;
    constexpr int I_IN = (DM / 64) * (NIN / 32), I_OUT = (DM / 64) * (DM / 32);
    constexpr int NITEMS = DEPTH * (I_IN + I_OUT);
    for (int it = gw; it < NITEMS; it += NGW) {
        int r = it;
        if (r < DEPTH * I_IN) { const int l = r / I_IN; r -= l * I_IN;
            p0_transpose_item(F.w_in + (size_t)l * DM * NIN, DM, NIN, F.WIN + (size_t)l * NIN * DM, F.norm_w + l * DM, scr, r, lane, true); continue; }
        r -= DEPTH * I_IN; { const int l = r / I_OUT; r -= l * I_OUT;
            p0_transpose_item(F.w_out + (size_t)l * DM * DM, DM, DM, F.WOUT + (size_t)l * DM * DM, nullptr, scr, r, lane, false); }
    }
    for (int m = gw; m < MTOK; m += NGW) {
        const GAS f32x4* xr = (const GAS f32x4*)(F.x + (size_t)m * DM) + lane;
        f32x4 v[4]; float s = 0.f;
#pragma unroll
        for (int j = 0; j < 4; ++j) { v[j] = xr[64 * j]; s += (v[j].x * v[j].x + v[j].y * v[j].y) + (v[j].z * v[j].z + v[j].w * v[j].w); }
        s = wave_sum(s);
        GAS unsigned long long* o8 = (GAS unsigned long long*)(F.XB + (size_t)m * DM) + lane;
#pragma unroll
        for (int j = 0; j < 4; ++j) o8[64 * j] = (unsigned long long)pk2(v[j].x, v[j].y) | ((unsigned long long)pk2(v[j].z, v[j].w) << 32);
        if (lane < 16) F.ROWSS[(size_t)m * 16 + lane] = (lane == 0) ? s : 0.f;
    }
    if (blockIdx.x == 0) { const int c = tid; const float a0 = F.lb_logits[c], a1 = F.lb_logits[512 + c]; const float mx = fmaxf(a0, a1);
        const float e0 = expf(a0 - mx), e1 = expf(a1 - mx); const float p0 = e0 / (e0 + e1), p1 = e1 / (e0 + e1);
        F.LB[c] = 0.f; F.LB[512 + c] = fminf(fmaxf((p0 + p1) - p0, 0.f), 1.0f - 1e-6f); }
}

constexpr float LOG2E = 1.4426950408889634f;
constexpr float QSCALE2 = 0.125f * LOG2E;
namespace moba {
typedef short bf16x8 __attribute__((ext_vector_type(8)));
typedef short s16x4 __attribute__((ext_vector_type(4)));
typedef float f32x16 __attribute__((ext_vector_type(16)));
typedef float f32x2_t __attribute__((ext_vector_type(2))); typedef __bf16 bf16x2_t __attribute__((ext_vector_type(2)));
__device__ __forceinline__ unsigned cvtpk(float lo, float hi) { f32x2_t v = {lo, hi}; bf16x2_t b = __builtin_convertvector(v, bf16x2_t); return __builtin_bit_cast(unsigned, b); }
__device__ __forceinline__ int crow(int r, int hi) { return (r & 3) + 8 * (r >> 2) + 4 * hi; }
constexpr int L_K = 0, L_V = 24576, L_WSF = 49152, L_KM = 51200, L_OST = 53248;
constexpr float NEG_BIG = -1e30f;
constexpr float THR = 8.0f;
__device__ __forceinline__ s16x4 vtr(const LAS unsigned char* p) { return __builtin_bit_cast(s16x4, __builtin_amdgcn_ds_read_tr16_b64_v4i16((LAS s16x4*)p)); }
}

__device__ __forceinline__ void moba_mfma_phase(Frame& F, int l) {
    using namespace moba;
    PHASE_IDS();
    const int r32 = lane & 31, hi = lane >> 5, wid = wave;
    LAS unsigned char* L = F.lds + RING_OFF;
    LAS float* wsf = (LAS float*)(L + L_WSF) + wid * 64;
    LAS float* km = (LAS float*)(L + L_KM);
    LAS float* ost = (LAS float*)(L + L_OST) + wid * 2048;
    float gq = fabsf(F.q_norm_w[l * 64 + lane]), gk = fabsf(F.k_norm_w[l * 64 + lane]);
#pragma unroll
    for (int o = 1; o < 64; o <<= 1) { gq = fmaxf(gq, __shfl_xor(gq, o)); gk = fmaxf(gk, __shfl_xor(gk, o)); }
    const float mhat0 = -(8.0f * gq * gk * LOG2E * 1.02f + 1.0f);
    gu32* qctr = F.ctl + CW_QUEUE + 64 * l;
    volatile LAS unsigned* tick = (volatile LAS unsigned*)(F.lds + EXTRA_OFF + 8192);
    for (;;) {
        __syncthreads();
        if (tid == 0) tick[0] = __hip_atomic_fetch_add(qctr, 1u, RLX_AGENT);
        __syncthreads();
        const int it = (int)tick[0]; if (it >= 1024) break;
        const int qb = 7 - (it >> 7), bh = it & 127;
        const int b = bh >> 3, h = bh & 7; const size_t rowbase = (size_t)b * SEQ; const int q0 = qb * 256, qrel = wid * 32 + r32, tq = q0 + qrel;
        const float sl2 = exp2f(-(float)(h + 1)) * LOG2E;
        bf16x8 qr[4];
        { const GAS bf16* Qw = (const GAS bf16*)(F.QN + (rowbase + q0 + wid * 32 + r32) * 512 + h * 64 + hi * 8);
#pragma unroll
            for (int d0 = 0; d0 < 4; ++d0) qr[d0] = *(const GAS bf16x8*)(Qw + d0 * 16); }
        if (tid < qb * 64) { const GAS float* kp = (const GAS float*)(F.KPART + ((size_t)b * 8 + (tid >> 6)) * 1024 + h * 64 + (tid & 63)); km[tid] = (kp[0] + kp[512]) * (1.0f / 256.0f); }
        const GAS bf16* ksrc = (const GAS bf16*)(F.KN + (rowbase + lane) * 512 + h * 64 + wid * 8);
        const GAS bf16* vsrc = (const GAS bf16*)(F.V + (rowbase + (tid >> 3)) * 512 + h * 64 + (tid & 7) * 8);
        const int kdst = L_K + wid * 1024 + lane * 16;
        const int vrow = tid >> 3, vch = tid & 7;
        const int vdst = L_V + vrow * 128 + (((vch >> 2) ^ ((vrow >> 1) & 1)) * 64) + (vch & 3) * 16;
        const int NT = 4 * (qb + 1);
        v4u kA = *(const GAS v4u*)(ksrc), vA = *(const GAS v4u*)(vsrc);
        v4u kB = *(const GAS v4u*)(ksrc + (size_t)64 * 512), vB = *(const GAS v4u*)(vsrc + (size_t)64 * 512);
        __syncthreads();
        *(LAS v4u*)(L + kdst) = kA; *(LAS v4u*)(L + vdst) = vA;
        kA = *(const GAS v4u*)(ksrc + (size_t)128 * 512); vA = *(const GAS v4u*)(vsrc + (size_t)128 * 512);
        unsigned selmask = 0;
        { float gt[7];
#pragma unroll
            for (int j = 0; j < 7; ++j) { float s = 0.f;
                if (j < qb) {
#pragma unroll
                    for (int d0 = 0; d0 < 4; ++d0)
#pragma unroll
                        for (int e = 0; e < 8; ++e) s += bf2f((unsigned short)qr[d0][e]) * km[j * 64 + d0 * 16 + hi * 8 + e];
                    auto rr = __builtin_amdgcn_permlane32_swap(__float_as_uint(s), __float_as_uint(s), false, false);
                    s = __uint_as_float(rr[0]) + __uint_as_float(rr[1]); }
                gt[j] = s; }
#pragma unroll
            for (int j = 0; j < 7; ++j) { int rank = 0;
#pragma unroll
                for (int i = 0; i < 7; ++i) if (i != j && i < qb) rank += (gt[i] > gt[j] || (gt[i] == gt[j] && i < j)) ? 1 : 0;
                if (j < qb && rank < 3) selmask |= 1u << j; } }
        float mhat = mhat0, l_reg = 0.f; f32x16 o[2]; o[0] = f32x16{}; o[1] = f32x16{};
        const int kbase = L_K + hi * 1024 + r32 * 16;
        const int g16 = lane >> 4, i16 = lane & 15, tq4 = i16 >> 2, tp4 = i16 & 3;
        const int vrow0 = 4 * hi + tq4;
        __syncthreads();
#define MOBA_TILE(TT, CUROFF) do { \
            const int blk = (TT) >> 2; const bool own = (blk == qb); const int jb = (TT) & 3; \
            const bool skip = own && (64 * jb > 32 * wid + 31); \
            if (!skip) { \
                const bool sel = own || ((selmask >> blk) & 1u); \
                const float sc0 = sel ? (-mhat - sl2 * (float)(tq - 64 * (TT) - 4 * hi)) : NEG_BIG; \
                f32x16 p0, p1; \
_Pragma("unroll") \
                for (int r = 0; r < 16; ++r) { p0[r] = __builtin_fmaf(sl2, (float)((r & 3) + 8 * (r >> 2)), sc0); p1[r] = __builtin_fmaf(sl2, (float)(32 + (r & 3) + 8 * (r >> 2)), sc0); } \
_Pragma("unroll") \
                for (int d0 = 0; d0 < 4; ++d0) { \
                    const bf16x8 b0 = *(const LAS bf16x8*)(L + CUROFF + kbase + d0 * 2048); \
                    const bf16x8 b1 = *(const LAS bf16x8*)(L + CUROFF + kbase + d0 * 2048 + 512); \
                    p0 = __builtin_amdgcn_mfma_f32_32x32x16_bf16(b0, qr[d0], p0, 0, 0, 0); \
                    p1 = __builtin_amdgcn_mfma_f32_32x32x16_bf16(b1, qr[d0], p1, 0, 0, 0); } \
                if (own && (64 * jb + 63 > 32 * wid)) { \
_Pragma("unroll") \
                    for (int r = 0; r < 16; ++r) { const int kvl = 64 * jb + crow(r, hi); if (kvl > qrel) p0[r] = NEG_BIG; if (kvl + 32 > qrel) p1[r] = NEG_BIG; } } \
                float rm = fmaxf(p0[0], p1[0]); \
_Pragma("unroll") \
                for (int r = 1; r < 16; ++r) rm = fmaxf(rm, fmaxf(p0[r], p1[r])); \
                { auto rr = __builtin_amdgcn_permlane32_swap(__float_as_uint(rm), __float_as_uint(rm), false, false); rm = fmaxf(__uint_as_float(rr[0]), __uint_as_float(rr[1])); } \
                if (__any(rm > THR)) { \
                    const float dl = fmaxf(rm, 0.f); mhat += dl; \
_Pragma("unroll") \
                    for (int r = 0; r < 16; ++r) { p0[r] -= dl; p1[r] -= dl; } \
                    const float f = __builtin_amdgcn_exp2f(-dl); l_reg *= f; \
                    if (hi == 0) wsf[r32] = f; \
_Pragma("unroll") \
                    for (int r = 0; r < 16; ++r) { const float fr = wsf[crow(r, hi)]; o[0][r] *= fr; o[1][r] *= fr; } } \
                float sacc = 0.f; \
_Pragma("unroll") \
                for (int r = 0; r < 16; ++r) { p0[r] = __builtin_amdgcn_exp2f(p0[r]); p1[r] = __builtin_amdgcn_exp2f(p1[r]); sacc += p0[r] + p1[r]; } \
                l_reg += sacc; \
                bf16x8 pa[4]; \
                { v4u w; \
_Pragma("unroll") \
                    for (int ks = 0; ks < 4; ++ks) { \
_Pragma("unroll") \
                        for (int e = 0; e < 4; ++e) { const int rb = (ks & 1) * 8 + 2 * e; w[e] = (ks < 2) ? cvtpk(p0[rb], p0[rb + 1]) : cvtpk(p1[rb], p1[rb + 1]); } \
                        pa[ks] = __builtin_bit_cast(bf16x8, w); } } \
_Pragma("unroll") \
                for (int dblk = 0; dblk < 2; ++dblk) \
_Pragma("unroll") \
                    for (int ks = 0; ks < 4; ++ks) { \
                        const int rlo = 16 * ks + vrow0, rhi = rlo + 8; \
                        const int alo = L_V + CUROFF + rlo * 128 + ((dblk ^ ((rlo >> 1) & 1)) * 64) + (16 * (g16 & 1) + 4 * tp4) * 2; \
                        const int ahi = L_V + CUROFF + rhi * 128 + ((dblk ^ ((rhi >> 1) & 1)) * 64) + (16 * (g16 & 1) + 4 * tp4) * 2; \
                        const s16x4 lo = vtr(L + alo), hh = vtr(L + ahi); \
                        const bf16x8 vf = (bf16x8){lo[0], lo[1], lo[2], lo[3], hh[0], hh[1], hh[2], hh[3]}; \
                        o[dblk] = __builtin_amdgcn_mfma_f32_32x32x16_bf16(pa[ks], vf, o[dblk], 0, 0, 0); } \
            } \
        } while (0)
        int c0o = 0;
        for (int t = 0; t < NT; t += 2) {
            const int c1o = (c0o == 2) ? 0 : c0o + 1, c2o = (c1o == 2) ? 0 : c1o + 1;
            MOBA_TILE(t, (c0o * 8192));
            *(LAS v4u*)(L + c1o * 8192 + kdst) = kB; *(LAS v4u*)(L + c1o * 8192 + vdst) = vB;
            if (t + 3 < NT) { kB = *(const GAS v4u*)(ksrc + (size_t)(t + 3) * 64 * 512); vB = *(const GAS v4u*)(vsrc + (size_t)(t + 3) * 64 * 512); }
            __syncthreads();
            MOBA_TILE(t + 1, (c1o * 8192));
            if (t + 2 < NT) { *(LAS v4u*)(L + c2o * 8192 + kdst) = kA; *(LAS v4u*)(L + c2o * 8192 + vdst) = vA; }
            if (t + 4 < NT) { kA = *(const GAS v4u*)(ksrc + (size_t)(t + 4) * 64 * 512); vA = *(const GAS v4u*)(vsrc + (size_t)(t + 4) * 64 * 512); }
            __syncthreads();
            c0o = c2o;
        }
#undef MOBA_TILE
        { auto rr = __builtin_amdgcn_permlane32_swap(__float_as_uint(l_reg), __float_as_uint(l_reg), false, false); l_reg = __uint_as_float(rr[0]) + __uint_as_float(rr[1]); }
        if (hi == 0) wsf[r32] = 1.0f / l_reg;
#pragma unroll
        for (int r = 0; r < 16; ++r) { const float rl = wsf[crow(r, hi)]; ost[crow(r, hi) * 64 + r32] = o[0][r] * rl; ost[crow(r, hi) * 64 + 32 + r32] = o[1][r] * rl; }
#pragma unroll
        for (int i = 0; i < 4; ++i) { const int row = i * 8 + (lane >> 3), ch = lane & 7;
            const f32x4 a = *(const LAS f32x4*)(ost + row * 64 + ch * 8), c2 = *(const LAS f32x4*)(ost + row * 64 + ch * 8 + 4);
            const size_t grow = rowbase + q0 + wid * 32 + row;
            const v4u gw = *(const GAS v4u*)(F.GA + grow * 512 + h * 64 + ch * 8);
            v4u ow; ow.x = pk2(a[0] * bflo(gw.x), a[1] * bfhi(gw.x)); ow.y = pk2(a[2] * bflo(gw.y), a[3] * bfhi(gw.y));
            ow.z = pk2(c2[0] * bflo(gw.z), c2[1] * bfhi(gw.z)); ow.w = pk2(c2[2] * bflo(gw.w), c2[3] * bfhi(gw.w));
            *(GAS v4u*)(F.MIXED + grow * DM + 512 + h * 64 + ch * 8) = ow; }
    }
    __syncthreads();
}


namespace hg {
typedef short bf16x8 __attribute__((ext_vector_type(8)));
typedef short s16x4 __attribute__((ext_vector_type(4)));
typedef float f32x4 __attribute__((ext_vector_type(4)));
typedef unsigned u32x2 __attribute__((ext_vector_type(2)));
constexpr int SLOT = 33792, NSLOT = 4;
constexpr int L_SC = NSLOT * SLOT, L_NRM = L_SC + 2048;
constexpr int NSTEP = SEQ / 32;
__device__ __forceinline__ int fsw(int t) { return ((t & 7) << 2) | (((t >> 3) & 1) << 1); }
__device__ __forceinline__ int unit_off(int tok, int cg) { return 8 * (32 * tok + (cg ^ fsw(tok))); }
__device__ __forceinline__ s16x4 rd64(const LAS unsigned char* p) { return *(const LAS s16x4*)p; }
__device__ __forceinline__ s16x4 vtr(const LAS unsigned char* p) { return __builtin_bit_cast(s16x4, __builtin_amdgcn_ds_read_tr16_b64_v4i16((LAS s16x4*)p)); }
__device__ __forceinline__ bf16x8 cat(s16x4 a, s16x4 b) { return (bf16x8){a[0], a[1], a[2], a[3], b[0], b[1], b[2], b[3]}; }
__device__ __forceinline__ s16x4 pack4(f32x4 v) { u32x2 w; w.x = moba::cvtpk(v[0], v[1]); w.y = moba::cvtpk(v[2], v[3]); return __builtin_bit_cast(s16x4, w); }
__device__ __forceinline__ void glds16(const GAS void* gsrc, unsigned lds_dst) { unsigned keep;
    asm volatile("s_mov_b32 %0, m0\n\ts_mov_b32 m0, %2\n\ts_nop 0\n\tglobal_load_lds_dwordx4 %1, off\n\ts_mov_b32 m0, %0" : "=&s"(keep) : "v"(gsrc), "s"(lds_dst) : "memory"); }
#define HG_MFMA(a, b, c) __builtin_amdgcn_mfma_f32_16x16x32_bf16((a), (b), (c), 0, 0, 0)
}

__device__ __forceinline__ void hgrn_mfma_phase(Frame& F, int l) {
    using namespace hg;
    PHASE_IDS();
    const int w = wave, c16 = lane & 15, g = lane >> 4;
    LAS unsigned char* L = F.lds + RING_OFF;
    const s16x4 z4 = (s16x4){0, 0, 0, 0};
    for (int it = (int)blockIdx.x; it < 64; it += F.G) {
        const int b = it >> 2, h = it & 3; const size_t rowbase = (size_t)b * SEQ;
        const int da = w >> 1;
        const GAS bf16* dsrc[4];
#pragma unroll
        for (int i = 0; i < 4; ++i) { const int t = 16 * (w & 1) + 4 * i + (lane >> 4); const int sc = (lane & 15) ^ (fsw(t) >> 1);
            dsrc[i] = (const GAS bf16*)(F.QI + (size_t)da * MTOK * 512 + (rowbase + t) * 512 + h * 128 + 8 * sc); }
        const GAS float* ddec = (const GAS float*)(F.DEC + (size_t)b * NSTEP * 512 + h * 128 + 4 * lane);
        const int ddst = da * 8192 + (w & 1) * 4096;
        const unsigned lds0 = (unsigned)(uintptr_t)(F.lds + RING_OFF);
#define HG_ISSUE(step) do { const unsigned so_ = lds0 + (unsigned)(((step) & 3) * SLOT); \
            _Pragma("unroll") for (int i = 0; i < 4; ++i) \
                glds16((const GAS void*)(dsrc[i] + (size_t)(step) * 32 * 512), (unsigned)__builtin_amdgcn_readfirstlane((int)(so_ + ddst + i * 1024))); \
            if (w == 0) glds16((const GAS void*)(ddec + (size_t)(step) * 512), (unsigned)__builtin_amdgcn_readfirstlane((int)(so_ + 32768))); } while (0)
        f32x4 S[8]; bf16x8 Sb[4];
#pragma unroll
        for (int tk = 0; tk < 8; ++tk) S[tk] = (f32x4){0.f, 0.f, 0.f, 0.f};
#pragma unroll
        for (int ks = 0; ks < 4; ++ks) Sb[ks] = (bf16x8){0, 0, 0, 0, 0, 0, 0, 0};
        f32x4 oprev[2]; oprev[0] = (f32x4){0.f, 0.f, 0.f, 0.f}; oprev[1] = oprev[0];
        u32x2 gprev[2]; gprev[0] = (u32x2){0u, 0u}; gprev[1] = gprev[0];
        float hw[4];
#pragma unroll
        for (int r = 0; r < 4; ++r) hw[r] = F.hg_norm_w[l * 128 + 16 * w + 4 * g + r];
        asm volatile("" : "+v"(hw[0]), "+v"(hw[1]), "+v"(hw[2]), "+v"(hw[3]));
        LAS float* nrm = (LAS float*)(L + L_NRM);
        LAS unsigned char* SC = L + L_SC;
        HG_ISSUE(0); HG_ISSUE(1); HG_ISSUE(2);
        asm volatile("s_waitcnt vmcnt(8)\n\ts_barrier" ::: "memory");
        const int trq = c16 >> 2, trp = c16 & 3;
        for (int n = 0; n < NSTEP; ++n) {
            if (n + 3 < NSTEP) HG_ISSUE(n + 3);
            const LAS unsigned char* Qs = L + (n & 3) * SLOT; const LAS unsigned char* Ks = Qs + 8192; const LAS unsigned char* Is = Qs + 16384; const LAS unsigned char* Gs = Qs + 24576;
            const LAS float* Ds = (const LAS float*)(Qs + 32768);
            bf16x8 qf[2][4];
#pragma unroll
            for (int tt = 0; tt < 2; ++tt)
#pragma unroll
                for (int ks = 0; ks < 4; ++ks) qf[tt][ks] = cat(rd64(Qs + unit_off(16 * tt + c16, 8 * ks + g)), rd64(Qs + unit_off(16 * tt + c16, 8 * ks + 4 + g)));
            f32x4 o[2];
#pragma unroll
            for (int tt = 0; tt < 2; ++tt) { f32x4 a = (f32x4){0.f, 0.f, 0.f, 0.f};
#pragma unroll
                for (int ks = 0; ks < 4; ++ks) a = HG_MFMA(Sb[ks], qf[tt][ks], a);
                o[tt] = a; }
            if (w < 3) { const int st = (w == 2) ? 1 : 0, tt = (w == 0) ? 0 : 1;
                f32x4 sc = (f32x4){0.f, 0.f, 0.f, 0.f};
#pragma unroll
                for (int ks = 0; ks < 4; ++ks) { const bf16x8 kf = cat(rd64(Ks + unit_off(16 * st + c16, 8 * ks + g)), rd64(Ks + unit_off(16 * st + c16, 8 * ks + 4 + g)));
                    sc = HG_MFMA(kf, (tt == 0) ? qf[0][ks] : qf[1][ks], sc); }
                if (st == tt) {
#pragma unroll
                    for (int r = 0; r < 4; ++r) if (4 * g + r > c16) sc[r] = 0.f; }
                *(LAS s16x4*)(SC + w * 512 + lane * 8) = pack4(sc); }
            u32x2 gcur[2];
#pragma unroll
            for (int tt = 0; tt < 2; ++tt) gcur[tt] = *(const LAS u32x2*)(Gs + unit_off(16 * tt + c16, 4 * w + g));
            asm volatile("s_waitcnt lgkmcnt(0)\n\ts_barrier" ::: "memory");
            const s16x4 sc00 = rd64(SC + lane * 8), sc01 = rd64(SC + 512 + lane * 8), sc11 = rd64(SC + 1024 + lane * 8);
            s16x4 itr[2];
#pragma unroll
            for (int st = 0; st < 2; ++st) itr[st] = vtr(Is + unit_off(16 * st + 4 * g + trq, 4 * w + trp));
            const bf16x8 i01 = cat(itr[0], itr[1]);
            o[0] = HG_MFMA(cat(itr[0], z4), cat(sc00, z4), o[0]);
            o[1] = HG_MFMA(i01, cat(sc01, sc11), o[1]);
#pragma unroll
            for (int tt = 0; tt < 2; ++tt) { float ss = (o[tt][0] * o[tt][0] + o[tt][1] * o[tt][1]) + (o[tt][2] * o[tt][2] + o[tt][3] * o[tt][3]);
                ss += __shfl_xor(ss, 16); ss += __shfl_xor(ss, 32);
                if (g == 0) nrm[(n & 1) * 256 + w * 32 + 16 * tt + c16] = ss; }
#pragma unroll
            for (int tk = 0; tk < 8; ++tk) {
                const bf16x8 k01 = cat(vtr(Ks + unit_off(4 * g + trq, 4 * tk + trp)), vtr(Ks + unit_off(16 + 4 * g + trq, 4 * tk + trp)));
                const f32x4 dv4 = *(const LAS f32x4*)(Ds + 16 * tk + 4 * g);
                S[tk] = HG_MFMA(k01, i01, S[tk]); S[tk] = S[tk] * dv4; }
#pragma unroll
            for (int ks = 0; ks < 4; ++ks) Sb[ks] = cat(pack4(S[2 * ks]), pack4(S[2 * ks + 1]));
            if (n > 0) {
#pragma unroll
                for (int tt = 0; tt < 2; ++tt) { const LAS float* np = nrm + ((n - 1) & 1) * 256 + 16 * tt + c16;
                    const float ssum = ((np[0] + np[32]) + (np[64] + np[96])) + ((np[128] + np[160]) + (np[192] + np[224]));
                    const float rstd = 1.0f / sqrtf(ssum * (1.0f / 128.0f) + NORM_EPS);
                    u32x2 wv; wv.x = pk2(oprev[tt][0] * rstd * hw[0] * bflo(gprev[tt].x), oprev[tt][1] * rstd * hw[1] * bfhi(gprev[tt].x));
                    wv.y = pk2(oprev[tt][2] * rstd * hw[2] * bflo(gprev[tt].y), oprev[tt][3] * rstd * hw[3] * bfhi(gprev[tt].y));
                    *(GAS u32x2*)(F.MIXED + (rowbase + (size_t)(n - 1) * 32 + 16 * tt + c16) * DM + h * 128 + 16 * w + 4 * g) = wv; } }
            oprev[0] = o[0]; oprev[1] = o[1]; gprev[0] = gcur[0]; gprev[1] = gcur[1];
            if (n >= NSTEP - 3) asm volatile("s_waitcnt vmcnt(0) lgkmcnt(0)\n\ts_barrier" ::: "memory");
            else if (n == 0) asm volatile("s_waitcnt vmcnt(8) lgkmcnt(0)\n\ts_barrier" ::: "memory");
            else if (n == 1) asm volatile("s_waitcnt vmcnt(10) lgkmcnt(0)\n\ts_barrier" ::: "memory");
            else asm volatile("s_waitcnt vmcnt(12) lgkmcnt(0)\n\ts_barrier" ::: "memory");
        }
#pragma unroll
        for (int tt = 0; tt < 2; ++tt) { const LAS float* np = nrm + ((NSTEP - 1) & 1) * 256 + 16 * tt + c16;
            const float ssum = ((np[0] + np[32]) + (np[64] + np[96])) + ((np[128] + np[160]) + (np[192] + np[224]));
            const float rstd = 1.0f / sqrtf(ssum * (1.0f / 128.0f) + NORM_EPS);
            u32x2 wv; wv.x = pk2(oprev[tt][0] * rstd * hw[0] * bflo(gprev[tt].x), oprev[tt][1] * rstd * hw[1] * bfhi(gprev[tt].x));
            wv.y = pk2(oprev[tt][2] * rstd * hw[2] * bflo(gprev[tt].y), oprev[tt][3] * rstd * hw[3] * bfhi(gprev[tt].y));
            *(GAS u32x2*)(F.MIXED + (rowbase + (size_t)(NSTEP - 1) * 32 + 16 * tt + c16) * DM + h * 128 + 16 * w + 4 * g) = wv; }
        asm volatile("s_waitcnt vmcnt(0) lgkmcnt(0)\n\ts_barrier" ::: "memory");
#undef HG_ISSUE
    }
}

struct Args { const float* in[8]; float* out; unsigned char* ws; int ph_lo, ph_hi, li, pad; };
__global__ void __launch_bounds__(NWAVES * 64, 2) fwd(Args args) {
    extern __shared__ __attribute__((aligned(16))) unsigned char lds[];
    Frame F;
    F.lds = (LAS unsigned char*)lds;
    F.MISC = (volatile LAS unsigned*)(F.lds + MISC_OFF);
    F.G = gridDim.x; { const int bx = blockIdx.x; F.vcu = (F.G % 8 == 0) ? (bx % 8) * (F.G / 8) + bx / 8 : bx; }
    unsigned char* ws = args.ws;
    F.ctl = (gu32*)(ws + WS_CTL);
    F.x = args.in[0]; F.norm_w = args.in[1]; F.w_in = args.in[2]; F.lb_logits = args.in[3]; F.hg_norm_w = args.in[4]; F.q_norm_w = args.in[5]; F.k_norm_w = args.in[6]; F.w_out = args.in[7];
    F.out = args.out;
    F.WIN = (bf16*)(ws + WS_WIN); F.WOUT = (bf16*)(ws + WS_WOUT); F.XB = (bf16*)(ws + WS_XB); F.MIXED = (bf16*)(ws + WS_MIXED);
    F.QI = (bf16*)(ws + WS_ARR); F.KT = (bf16*)(ws + WS_ARR + ARR_BYTES); F.HI = (bf16*)(ws + WS_ARR + 2 * ARR_BYTES); F.GH = (bf16*)(ws + WS_ARR + 3 * ARR_BYTES);
    F.QN = (bf16*)(ws + WS_ARR + 4 * ARR_BYTES); F.KN = (bf16*)(ws + WS_ARR + 5 * ARR_BYTES); F.V = (bf16*)(ws + WS_ARR + 6 * ARR_BYTES); F.GA = (bf16*)(ws + WS_ARR + 7 * ARR_BYTES);
    F.LB = (float*)(ws + WS_LB); F.KPART = (float*)(ws + WS_KPART); F.ROWSS = (float*)(ws + WS_ROWSS); F.DEC = (float*)(ws + WS_DEC);
    for (int u = threadIdx.x; u < (LDS_BYTES - LDSCTL_OFF) / 4; u += NWAVES * 64) ((LAS unsigned*)(F.lds + LDSCTL_OFF))[u] = 0u;
    __syncthreads();
    XcdBarrier bar; bar.bar = (unsigned*)(F.ctl + CW_BAR); bar.x = 0; bar.st = nullptr;
    if (N_LAUNCHES == 1) bar = xcd_barrier_post((unsigned*)(F.ctl + CW_BAR), F.MISC + 8);
#define GRID_BAR() do { if (N_LAUNCHES == 1) xcd_barrier(bar); } while (0)
    const int lo = args.ph_lo, hi = args.ph_hi;
#define IN(k) (lo <= (k) && (k) < hi)
#define BOTH(k) (IN(k) && IN((k) + 1))

    if (IN(0)) { p0_prologue(F); if (BOTH(0)) GRID_BAR(); }
    for (int l = 0; l < DEPTH; ++l) {
        const int pb = 1 + 3 * l;
        if (IN(pb)) {
            pg8::Gemm g{F.XB + (size_t)l * MTOK * DM, F.WIN + (size_t)l * NIN * DM, MTOK, NIN, DM}; pg8::StaticOrder S; S.init(MTOK, NIN, F.G, (int)blockIdx.x);
            pg8::EpiFused E{F.QI, F.DEC, F.KPART, F.ROWSS + (size_t)l * MTOK * 16, F.LB + l * 512, F.q_norm_w + l * 64, F.k_norm_w + l * 64};
            pg8::gemm_phase<pg8::EpiFused, pg8::StaticOrder, true, true>(F.lds + RING_OFF, g, S, E);
            if (BOTH(pb)) GRID_BAR();
        }
        if (IN(pb + 1)) { hgrn_mfma_phase(F, l); moba_mfma_phase(F, l); if (BOTH(pb + 1)) GRID_BAR(); }
        if (IN(pb + 2)) {
            pg8::Gemm g{F.MIXED, F.WOUT + (size_t)l * DM * DM, MTOK, DM, DM}; pg8::StaticOrder S; S.init(MTOK, DM, F.G, (int)blockIdx.x);
            pg8::EpiOut E{l == 0 ? F.x : F.out, F.out, l == 0 ? F.XB + (size_t)MTOK * DM : nullptr, l == 0 ? F.ROWSS + (size_t)MTOK * 16 : nullptr};
            pg8::gemm_phase<pg8::EpiOut, pg8::StaticOrder, true, true>(F.lds + RING_OFF, g, S, E);
            if (pb + 2 < N_PHASES - 1 && BOTH(pb + 2)) GRID_BAR();
        }
    }
#undef IN
#undef BOTH
}

extern "C" void kernel_launch(void* const* d_in, const int* in_sizes, int n_in, void* d_out, int out_size, void* d_ws, size_t ws_size, hipStream_t stream) {
    static int grid = 0;
    if (grid == 0) {
        if (n_in != 8 || in_sizes[0] != MTOK * DM || out_size != MTOK * DM || ws_size < WS_END) { fprintf(stderr, "kernel_launch: unexpected shapes n_in %d in0 %d out %d ws %zu\n", n_in, n_in > 0 ? in_sizes[0] : -1, out_size, ws_size); grid = -1; return; }
        int dev = 0, cus = 0, per_cu = 0;
        if (hipGetDevice(&dev) != hipSuccess || hipDeviceGetAttribute(&cus, hipDeviceAttributeMultiprocessorCount, dev) != hipSuccess) { grid = -1; return; }
        if (hipFuncSetAttribute((const void*)fwd, hipFuncAttributeMaxDynamicSharedMemorySize, LDS_BYTES) != hipSuccess) { fprintf(stderr, "kernel_launch: hipFuncSetAttribute failed\n"); grid = -1; return; }
        if (hipOccupancyMaxActiveBlocksPerMultiprocessor(&per_cu, (const void*)fwd, NWAVES * 64, LDS_BYTES) != hipSuccess || per_cu < 1) fprintf(stderr, "kernel_launch: occupancy query says %d\n", per_cu);
        (void)hipGetLastError();
        if (per_cu < 1) { grid = -1; return; }
        grid = cus;
    }
    if (grid < 0) return;
    if (hipMemsetAsync((char*)d_ws + WS_CTL, 0, CTL_ZERO_BYTES, stream) != hipSuccess) return;
    Args a{};
    for (int i = 0; i < 8; ++i) a.in[i] = (const float*)d_in[i];
    a.out = (float*)d_out; a.ws = (unsigned char*)d_ws;
    for (int li = 0; li < N_LAUNCHES; ++li) {
        a.ph_lo = (N_LAUNCHES == 1) ? 0 : li; a.ph_hi = (N_LAUNCHES == 1) ? N_PHASES : li + 1; a.li = li;
        hipError_t le;
        if (N_LAUNCHES == 1) { void* kargs[] = {(void*)&a}; le = hipLaunchCooperativeKernel((const void*)fwd, dim3(grid), dim3(NWAVES * 64), kargs, LDS_BYTES, stream); }
        else { hipLaunchKernelGGL(fwd, dim3(grid), dim3(NWAVES * 64), LDS_BYTES, stream, a); le = hipPeekAtLastError(); }
        if (le != hipSuccess) { fprintf(stderr, "kernel_launch: launch %d failed: %s\n", li, hipGetErrorName(le)); break; }
    }
}
```

```cpp
#include <hip/hip_runtime.h>
#include <cstdio>
#include <cstdint>
namespace pg8 {
#define PG8_LAS __attribute__((address_space(3)))
typedef unsigned short bf16_t;
typedef short bf16x8 __attribute__((ext_vector_type(8)));
typedef float f32x4 __attribute__((ext_vector_type(4)));
typedef unsigned u32x4 __attribute__((ext_vector_type(4)));
typedef unsigned u32x2 __attribute__((ext_vector_type(2)));
constexpr int BM = 256, BK = 64, HALF = 128, HTB = HALF * BK * 2  , STAGE_BYTES = 8 * HTB, NXCD = 8, WGM = 8;

__host__ __device__ __forceinline__ int lds_byte(int r, int c) { const int st = (r >> 4) * 2 + (c >> 5), rr = r & 15, cc = c & 31, ob = rr * 64 + cc * 2; return st * 1024 + (ob ^ (((ob >> 9) & 1) << 5)); }
__host__ __device__ __forceinline__ void stage_rc(int b, int& R, int& C) { const int st = b / 1024, sb = b % 1024, swz = sb ^ (((sb >> 9) & 1) << 5); R = (st >> 1) * 16 + swz / 64; C = (st & 1) * 32 + (swz % 64) / 2; }
__host__ __device__ __forceinline__ int perm32(int rho) { const int n = rho >> 4, i = rho & 15; return 8 * (i >> 2) + 4 * n + (i & 3); }

struct Unit { int pm, pn; };
struct Gemm { const bf16_t* A; const bf16_t* Bt; int M, N, K; };

struct StaticOrder {
    int nM, nN, nwg, G, c;
    __host__ __device__ void init(int M, int N, int G_, int c_) { nM = M / BM; nN = N / BM; nwg = nM * nN; G = G_; c = c_; }
    __host__ __device__ bool next(int i, Unit& u) const {
        const long L = (long)i * G + c; if (L >= nwg) return false;
        int wgid = (int)L; { const int q = nwg / NXCD, r = nwg % NXCD, xcd = wgid % NXCD, off = wgid / NXCD; wgid = (xcd < r ? xcd * (q + 1) : r * (q + 1) + (xcd - r) * q) + off; }
        const int nig = WGM * nN, gid = wgid / nig, fm = gid * WGM, gsz = (nM - fm) < WGM ? (nM - fm) : WGM;
        u.pm = fm + ((wgid % nig) % gsz); u.pn = (wgid % nig) / gsz; return true;
    }
    __device__ __forceinline__ void a_ready(const Unit&) const {}
    __device__ __forceinline__ void done(const Unit&) const {}
};

__device__ __forceinline__ unsigned cvt_pk_bf16(float lo, float hi) { unsigned r; asm volatile("v_cvt_pk_bf16_f32 %0, %1, %2" : "=v"(r) : "v"(lo), "v"(hi)); return r; }


__device__ __forceinline__ float dpp_row_shr(float v, int n) {
    const int x = __builtin_bit_cast(int, v);
    int r;
    if (n == 1) r = __builtin_amdgcn_update_dpp(0, x, 0x111, 0xf, 0xf, false);
    else if (n == 2) r = __builtin_amdgcn_update_dpp(0, x, 0x112, 0xf, 0xf, false);
    else if (n == 4) r = __builtin_amdgcn_update_dpp(0, x, 0x114, 0xf, 0xf, false);
    else r = __builtin_amdgcn_update_dpp(0, x, 0x118, 0xf, 0xf, false);
    return __builtin_bit_cast(float, r);
}
__device__ __forceinline__ float fsig(float z) { return __builtin_amdgcn_rcpf(1.0f + __expf(-z)); }
struct EpiFused {
    static constexpr bool PERM = true, AFTER_DRAIN = false;
    bf16_t* ARR; float* DEC; float* KPART; const float* rowss; const float* lb; const float* qg; const float* kg;
    static constexpr size_t AS = (size_t)32768 * 512;
    __device__ __forceinline__ float rstd_of(int row) const {
        const f32x4* rp = (const f32x4*)(rowss + (size_t)row * 16);
        const f32x4 a = rp[0], b = rp[1], c = rp[2], d = rp[3];
        const float ss = ((a[0] + a[1]) + (a[2] + a[3])) + ((b[0] + b[1]) + (b[2] + b[3])) + ((c[0] + c[1]) + (c[2] + c[3])) + ((d[0] + d[1]) + (d[2] + d[3]));
        return 1.0f / sqrtf(ss * (1.0f / 1024.0f) + 1e-6f);
    }
    static __device__ __forceinline__ u32x4 pack8(const float (&v)[8]) { u32x4 w; w.x = cvt_pk_bf16(v[0], v[1]); w.y = cvt_pk_bf16(v[2], v[3]); w.z = cvt_pk_bf16(v[4], v[5]); w.w = cvt_pk_bf16(v[6], v[7]); return w; }
    __device__ __forceinline__ void operator()(const f32x4 (&acc)[2][2][4][2], const Unit& u, int wr, int wc, int fr, int fq) const {
        const int row0 = u.pm * BM + wr * 64 + fr; const int pn = u.pn;
        if (pn < 4) {
            const int cb = pn * 128 + wc * 32 + 8 * fq;
            float lbv[8];
#pragma unroll
            for (int k = 0; k < 8; ++k) lbv[k] = lb[cb + k];
#pragma unroll
            for (int ai = 0; ai < 2; ++ai)
#pragma unroll
                for (int mp = 0; mp < 2; ++mp) { const int row1 = row0 + ai * HALF + mp * 32, row2 = row1 + 16; const float rs1 = rstd_of(row1), rs2 = rstd_of(row2);
                    float qi1[8], kt1[8], qi2[8], kt2[8], dc[8];
#pragma unroll
                    for (int k = 0; k < 8; ++k) {
                        const float zq1 = acc[ai][0][2 * mp][k >> 2][k & 3] * rs1, zf1 = acc[ai][1][2 * mp][k >> 2][k & 3] * rs1;
                        const float zq2 = acc[ai][0][2 * mp + 1][k >> 2][k & 3] * rs2, zf2 = acc[ai][1][2 * mp + 1][k >> 2][k & 3] * rs2;
                        const float f1 = lbv[k] + (1.0f - lbv[k]) * fsig(zf1), f2 = lbv[k] + (1.0f - lbv[k]) * fsig(zf2);
                        float b1 = __logf(f1), b2 = __logf(f2);
                        b1 += dpp_row_shr(b1, 1); b2 += dpp_row_shr(b2, 1); b1 += dpp_row_shr(b1, 2); b2 += dpp_row_shr(b2, 2);
                        b1 += dpp_row_shr(b1, 4); b2 += dpp_row_shr(b2, 4); b1 += dpp_row_shr(b1, 8); b2 += dpp_row_shr(b2, 8);
                        b2 += __shfl(b1, (fq << 4) | 15);
                        const float e1 = __expf(b1), e2 = __expf(b2);
                        qi1[k] = zq1 * fsig(zq1) * e1; kt1[k] = (1.0f - f1) * __expf(fminf(-b1, 80.0f));
                        qi2[k] = zq2 * fsig(zq2) * e2; kt2[k] = (1.0f - f2) * __expf(fminf(-b2, 80.0f)); dc[k] = e2; }
                    *(u32x4*)(ARR + (size_t)row1 * 512 + cb) = pack8(qi1); *(u32x4*)(ARR + AS + (size_t)row1 * 512 + cb) = pack8(kt1);
                    *(u32x4*)(ARR + (size_t)row2 * 512 + cb) = pack8(qi2); *(u32x4*)(ARR + AS + (size_t)row2 * 512 + cb) = pack8(kt2);
                    if (fr == 15) { float* dp = DEC + (size_t)(row1 >> 5) * 512 + cb; *(f32x4*)dp = (f32x4){dc[0], dc[1], dc[2], dc[3]}; *(f32x4*)(dp + 4) = (f32x4){dc[4], dc[5], dc[6], dc[7]}; }
                    asm volatile("" ::: "memory"); }
        } else if (pn < 8) {
            const int cb = (pn - 4) * 128 + wc * 32 + 8 * fq;
#pragma unroll
            for (int ai = 0; ai < 2; ++ai)
#pragma unroll
                for (int m = 0; m < 4; ++m) { const int row = row0 + ai * HALF + m * 16; const float rs = rstd_of(row);
                    float iv[8], gv[8];
#pragma unroll
                    for (int k = 0; k < 8; ++k) { iv[k] = acc[ai][0][m][k >> 2][k & 3] * rs; const float zg = acc[ai][1][m][k >> 2][k & 3] * rs; gv[k] = zg * fsig(zg); }
                    *(u32x4*)(ARR + 2 * AS + (size_t)row * 512 + cb) = pack8(iv); *(u32x4*)(ARR + 3 * AS + (size_t)row * 512 + cb) = pack8(gv);
                    asm volatile("" ::: "memory"); }
        } else {
            const int ty = (pn - 8) >> 1, head = 4 * ((pn - 8) & 1) + wc; const int d0 = 8 * fq;
            bf16_t* dst = ARR + (size_t)(4 + ty) * AS;
            float gain[2][8]; float csum[2][8];
#pragma unroll
            for (int bj = 0; bj < 2; ++bj)
#pragma unroll
                for (int k = 0; k < 8; ++k) { gain[bj][k] = (ty == 0) ? qg[bj * 32 + d0 + k] * (0.125f * 1.4426950408889634f) : (ty == 1) ? kg[bj * 32 + d0 + k] : 1.0f; csum[bj][k] = 0.f; }
#pragma unroll
            for (int ai = 0; ai < 2; ++ai)
#pragma unroll
                for (int m = 0; m < 4; ++m) { const int row = row0 + ai * HALF + m * 16; const float rs = rstd_of(row);
                    float v[2][8];
#pragma unroll
                    for (int bj = 0; bj < 2; ++bj)
#pragma unroll
                        for (int k = 0; k < 8; ++k) v[bj][k] = acc[ai][bj][m][k >> 2][k & 3] * rs;
                    if (ty < 2) { float ss = 0.f;
#pragma unroll
                        for (int bj = 0; bj < 2; ++bj)
#pragma unroll
                            for (int k = 0; k < 8; ++k) ss += v[bj][k] * v[bj][k];
                        ss += __shfl_xor(ss, 16); ss += __shfl_xor(ss, 32);
                        const float r2 = 1.0f / sqrtf(ss * (1.0f / 64.0f) + 1e-6f);
#pragma unroll
                        for (int bj = 0; bj < 2; ++bj)
#pragma unroll
                            for (int k = 0; k < 8; ++k) { v[bj][k] *= r2 * gain[bj][k]; csum[bj][k] += v[bj][k]; }
                    } else if (ty == 3) {
#pragma unroll
                        for (int bj = 0; bj < 2; ++bj)
#pragma unroll
                            for (int k = 0; k < 8; ++k) v[bj][k] = v[bj][k] * fsig(v[bj][k]); }
                    *(u32x4*)(dst + (size_t)row * 512 + head * 64 + d0) = pack8(v[0]); *(u32x4*)(dst + (size_t)row * 512 + head * 64 + 32 + d0) = pack8(v[1]);
                    asm volatile("" ::: "memory"); }
            if (ty == 1) {
#pragma unroll
                for (int bj = 0; bj < 2; ++bj)
#pragma unroll
                    for (int k = 0; k < 8; ++k) { float s = csum[bj][k]; s += __shfl_xor(s, 1); s += __shfl_xor(s, 2); s += __shfl_xor(s, 4); s += __shfl_xor(s, 8); csum[bj][k] = s; }
                if (fr == 0) { float* kp = KPART + ((size_t)u.pm * 2 + wr) * 512 + head * 64 + d0;
#pragma unroll
                    for (int bj = 0; bj < 2; ++bj) { *(f32x4*)(kp + bj * 32) = (f32x4){csum[bj][0], csum[bj][1], csum[bj][2], csum[bj][3]}; *(f32x4*)(kp + bj * 32 + 4) = (f32x4){csum[bj][4], csum[bj][5], csum[bj][6], csum[bj][7]}; } }
            }
        }
    }
};
struct EpiOut {
    static constexpr bool PERM = false, AFTER_DRAIN = false;
    const float* xres; float* out; bf16_t* xb; float* rowss;
    __device__ __forceinline__ void operator()(const f32x4 (&acc)[2][2][4][2], const Unit& u, int wr, int wc, int fr, int fq) const {
        const int col0 = u.pn * BM + wc * 32 + 4 * fq;
#pragma unroll
        for (int ai = 0; ai < 2; ++ai)
#pragma unroll
            for (int m = 0; m < 4; ++m) {
                const int row = u.pm * BM + ai * HALF + wr * 64 + m * 16 + fr; float ss = 0.f;
#pragma unroll
                for (int bj = 0; bj < 2; ++bj)
#pragma unroll
                    for (int n = 0; n < 2; ++n) { const size_t off = (size_t)row * 1024 + col0 + bj * HALF + n * 16;
                        const f32x4 v = *(const f32x4*)(xres + off) + acc[ai][bj][m][n];
                        *(f32x4*)(out + off) = v; if (xb) { u32x2 w; w.x = cvt_pk_bf16(v[0], v[1]); w.y = cvt_pk_bf16(v[2], v[3]); *(u32x2*)(xb + off) = w; }
                        ss += (v[0] * v[0] + v[1] * v[1]) + (v[2] * v[2] + v[3] * v[3]); }
                ss += __shfl_xor(ss, 16); ss += __shfl_xor(ss, 32);
                if (fq == 0 && rowss) rowss[(size_t)row * 16 + u.pn * 4 + wc] = ss;
            }
    }
};

template <class Epi, class Sched, bool ALIGN_EPI = false, bool SP2 = false>
__device__ __forceinline__ void gemm_phase(PG8_LAS unsigned char* lds, const Gemm g, const Sched& S, const Epi& E) {
    int tid = threadIdx.x; asm volatile("" : "+v"(tid));
    const int wid = __builtin_amdgcn_readfirstlane(tid >> 6), lane = tid & 63, wr = wid >> 2, wc = wid & 3, fr = lane & 15, fq = lane >> 4;
    const int K = g.K, nt = K / BK;
    unsigned voffA[2], voffB[2];
#pragma unroll
    for (int i = 0; i < 2; ++i) { int R, C; stage_rc(tid * 16 + i * 8192, R, C); const int Rb = Epi::PERM ? ((R & ~31) + perm32(R & 31)) : R;
        voffA[i] = (unsigned)(R * K + C) * 2u; voffB[i] = (unsigned)(Rb * K + C) * 2u; }
    const size_t kstep = (size_t)(BK * 2);
    const size_t hstep = (size_t)HALF * K * 2;
    const size_t tstep = 2 * hstep;
    const unsigned ldsw = (unsigned)wid * 1024u;
    const int aoff = lds_byte(wr * 64 + fr, fq * 8), boff = lds_byte(wc * 32 + fr, fq * 8);
#define PG8_SA(b, h) (((b) * 2 + (h)) * HTB)
#define PG8_SB(b, h) ((4 + (b) * 2 + (h)) * HTB)
#define PG8_STAGE(bufoff, gbase, voff) do { _Pragma("unroll") for (int _i = 0; _i < 2; ++_i) \
        __builtin_amdgcn_global_load_lds((const unsigned*)((const char*)(gbase) + (voff)[_i]), (PG8_LAS unsigned*)(lds + (bufoff) + ldsw + _i * 8192), 16, 0, 0); } while (0)
#define PG8_LDA(dst, b, h) do { _Pragma("unroll") for (int m = 0; m < 4; ++m) _Pragma("unroll") for (int k = 0; k < 2; ++k) dst[m][k] = *(const PG8_LAS bf16x8*)(lds + PG8_SA(b, h) + aoff + m * 2048 + k * 1024); } while (0)
#define PG8_LDB(dst, b, h) do { _Pragma("unroll") for (int n = 0; n < 2; ++n) _Pragma("unroll") for (int k = 0; k < 2; ++k) dst[n][k] = *(const PG8_LAS bf16x8*)(lds + PG8_SB(b, h) + boff + n * 2048 + k * 1024); } while (0)
#define PG8_MMA(ai, bj, At, Bt) do { __builtin_amdgcn_s_setprio(1); _Pragma("unroll") for (int m = 0; m < 4; ++m) _Pragma("unroll") for (int n = 0; n < 2; ++n) _Pragma("unroll") for (int k = 0; k < 2; ++k) \
        acc[ai][bj][m][n] = __builtin_amdgcn_mfma_f32_16x16x32_bf16(Bt[n][k], At[m][k], acc[ai][bj][m][n], 0, 0, 0); __builtin_amdgcn_s_setprio(0); } while (0)
#define PG8_WAIT_V(n) asm volatile("s_waitcnt vmcnt(" #n ")" ::: "memory")
#define PG8_WAIT_L(n) asm volatile("s_waitcnt lgkmcnt(" #n ")" ::: "memory")
#define PG8_BAR __builtin_amdgcn_s_barrier()
#define PG8_SCHED __builtin_amdgcn_sched_barrier(0)
    Unit cur, nxt; int ui = 0;
    if (!S.next(0, cur)) return;
    f32x4 acc[2][2][4][2];
#pragma unroll
    for (int a = 0; a < 2; ++a)
#pragma unroll
        for (int b = 0; b < 2; ++b)
#pragma unroll
            for (int m = 0; m < 4; ++m)
#pragma unroll
                for (int n = 0; n < 2; ++n) acc[a][b][m][n] = (f32x4){0.f, 0.f, 0.f, 0.f};
    bf16x8 At[4][2], B0[2][2], B1[2][2];
    const char* cA = (const char*)g.A + (size_t)cur.pm * tstep; const char* cB = (const char*)g.Bt + (size_t)cur.pn * tstep;
    S.a_ready(cur);
    if constexpr (SP2) {
        PG8_STAGE(PG8_SB(0, 0), cB, voffB); PG8_STAGE(PG8_SB(0, 1), cB + hstep, voffB); PG8_STAGE(PG8_SA(0, 0), cA, voffA); PG8_STAGE(PG8_SA(0, 1), cA + hstep, voffA);
        if (wr == 1) PG8_BAR;
        PG8_WAIT_V(2); PG8_BAR;
        PG8_STAGE(PG8_SB(1, 0), cB + kstep, voffB); PG8_STAGE(PG8_SA(1, 0), cA + kstep, voffA); PG8_STAGE(PG8_SB(1, 1), cB + hstep + kstep, voffB);
        PG8_WAIT_V(6); PG8_BAR;
    } else {
        PG8_STAGE(PG8_SB(0, 0), cB, voffB); PG8_STAGE(PG8_SA(0, 0), cA, voffA); PG8_STAGE(PG8_SB(0, 1), cB + hstep, voffB); PG8_STAGE(PG8_SA(0, 1), cA + hstep, voffA);
        if (wr == 1) PG8_BAR;
        PG8_WAIT_V(4); PG8_BAR;
        PG8_STAGE(PG8_SB(1, 0), cB + kstep, voffB); PG8_STAGE(PG8_SA(1, 0), cA + kstep, voffA); PG8_STAGE(PG8_SB(1, 1), cB + hstep + kstep, voffB);
        PG8_WAIT_V(6); PG8_BAR;
    }
    for (;;) {
        const bool has_next = S.next(ui + 1, nxt);
        const char* nA = has_next ? (const char*)g.A + (size_t)nxt.pm * tstep : cA; const char* nB = has_next ? (const char*)g.Bt + (size_t)nxt.pn * tstep : cB;
        for (int t = 0; t < nt; t += 2) {
            const bool last = (t == nt - 2);
            const char* a1 = cA + (size_t)(t + 1) * kstep;
            const char* a2 = last ? nA : cA + (size_t)(t + 2) * kstep; const char* b2 = last ? nB : cB + (size_t)(t + 2) * kstep;
            const char* a3 = a2 + kstep; const char* b3 = b2 + kstep;
            if (last && has_next) S.a_ready(nxt);
            if constexpr (SP2) {
            PG8_LDB(B0, 0, 0); PG8_LDB(B1, 0, 1); PG8_SCHED; PG8_LDA(At, 0, 0); PG8_STAGE(PG8_SA(1, 1), a1 + hstep, voffA);
            PG8_WAIT_V(8); PG8_WAIT_L(0); PG8_BAR; PG8_MMA(0, 0, At, B0); PG8_MMA(0, 1, At, B1); PG8_BAR; PG8_SCHED;
            PG8_LDA(At, 0, 1); PG8_STAGE(PG8_SB(0, 0), b2, voffB); PG8_STAGE(PG8_SB(0, 1), b2 + hstep, voffB); PG8_STAGE(PG8_SA(0, 0), a2, voffA);
            PG8_WAIT_V(8); PG8_WAIT_L(0); PG8_BAR; PG8_MMA(1, 0, At, B0); PG8_MMA(1, 1, At, B1); PG8_BAR; PG8_SCHED;
            PG8_LDB(B0, 1, 0); PG8_LDB(B1, 1, 1); PG8_SCHED; PG8_LDA(At, 1, 0); PG8_STAGE(PG8_SA(0, 1), a2 + hstep, voffA);
            PG8_WAIT_V(8); PG8_WAIT_L(0); PG8_BAR; PG8_MMA(0, 0, At, B0); PG8_MMA(0, 1, At, B1); PG8_BAR; PG8_SCHED;
            PG8_LDA(At, 1, 1); PG8_STAGE(PG8_SB(1, 0), b3, voffB); PG8_STAGE(PG8_SB(1, 1), b3 + hstep, voffB); PG8_STAGE(PG8_SA(1, 0), a3, voffA);
            PG8_WAIT_V(8); PG8_WAIT_L(0); PG8_BAR; PG8_MMA(1, 0, At, B0); PG8_MMA(1, 1, At, B1); PG8_BAR; PG8_SCHED;
            } else {
            PG8_LDB(B0, 0, 0); PG8_SCHED; PG8_LDA(At, 0, 0); PG8_STAGE(PG8_SA(1, 1), a1 + hstep, voffA);
            PG8_WAIT_L(8); PG8_BAR; PG8_WAIT_L(0); PG8_MMA(0, 0, At, B0); PG8_BAR; PG8_SCHED;
            PG8_LDB(B1, 0, 1); PG8_STAGE(PG8_SB(0, 0), b2, voffB);
            PG8_BAR; PG8_WAIT_L(0); PG8_MMA(0, 1, At, B1); PG8_BAR;
            PG8_LDA(At, 0, 1); PG8_STAGE(PG8_SA(0, 0), a2, voffA);
            PG8_BAR; PG8_WAIT_L(0); PG8_MMA(1, 0, At, B0); PG8_BAR; PG8_SCHED;
            PG8_STAGE(PG8_SB(0, 1), b2 + hstep, voffB);
            PG8_WAIT_V(6); PG8_BAR; PG8_MMA(1, 1, At, B1); PG8_BAR;
            PG8_LDB(B0, 1, 0); PG8_SCHED; PG8_LDA(At, 1, 0); PG8_STAGE(PG8_SA(0, 1), a2 + hstep, voffA);
            PG8_WAIT_L(8); PG8_BAR; PG8_WAIT_L(0); PG8_MMA(0, 0, At, B0); PG8_BAR; PG8_SCHED;
            PG8_LDB(B1, 1, 1); PG8_STAGE(PG8_SB(1, 0), b3, voffB);
            PG8_BAR; PG8_WAIT_L(0); PG8_MMA(0, 1, At, B1); PG8_BAR;
            PG8_LDA(At, 1, 1); PG8_STAGE(PG8_SA(1, 0), a3, voffA);
            PG8_BAR; PG8_WAIT_L(0); PG8_MMA(1, 0, At, B0); PG8_BAR; PG8_SCHED;
            PG8_STAGE(PG8_SB(1, 1), b3 + hstep, voffB);
            PG8_WAIT_V(6); PG8_BAR; PG8_MMA(1, 1, At, B1); PG8_BAR;
            }
        }
        if constexpr (ALIGN_EPI) { if (wr == 0) PG8_BAR; }
        if constexpr (!Epi::AFTER_DRAIN) { E(acc, cur, wr, wc, fr, fq); S.done(cur); }
        if (!has_next) break;
#pragma unroll
        for (int a = 0; a < 2; ++a)
#pragma unroll
            for (int b = 0; b < 2; ++b)
#pragma unroll
                for (int m = 0; m < 4; ++m)
#pragma unroll
                    for (int n = 0; n < 2; ++n) acc[a][b][m][n] = (f32x4){0.f, 0.f, 0.f, 0.f};
        cur = nxt; cA = nA; cB = nB; ++ui;
        if constexpr (ALIGN_EPI) { if (wr == 1) PG8_BAR; }
    }
    PG8_WAIT_V(0);
    if constexpr (!ALIGN_EPI) { if (wr == 0) PG8_BAR; }
    PG8_BAR;
    if constexpr (Epi::AFTER_DRAIN) { E.fused(acc, cur, wr, wc, fr, fq, lds, wid, lane); S.done(cur); }
#undef PG8_SA
#undef PG8_SB
#undef PG8_STAGE
#undef PG8_LDA
#undef PG8_LDB
#undef PG8_MMA
#undef PG8_WAIT_V
#undef PG8_WAIT_L
#undef PG8_BAR
#undef PG8_SCHED
}
}


constexpr int NWAVES = 8;
#ifndef MK_N_LAUNCHES
#define MK_N_LAUNCHES 1
#endif
constexpr int N_PHASES = 7;
constexpr int N_LAUNCHES = MK_N_LAUNCHES;

constexpr int BATCH = 16, SEQ = 2048, DM = 1024, DEPTH = 2, MTOK = BATCH * SEQ, NIN = 4096;
constexpr int C_HQ = 0, C_HF = 512, C_HI = 1024, C_HG = 1536, C_AQ = 2048, C_AK = 2560, C_AV = 3072, C_AG = 3584;
constexpr float NORM_EPS = 1e-6f;

constexpr size_t MiB = 1u << 20;
constexpr size_t WS_CTL = 0, CTL_ZERO_BYTES = 1 * MiB;
constexpr size_t WS_WIN = 2 * MiB;
constexpr size_t WS_WOUT = 18 * MiB;
constexpr size_t WS_LB = 22 * MiB;
constexpr size_t WS_KPART = 22 * MiB + 65536;
constexpr size_t WS_ROWSS = 24 * MiB;
constexpr size_t WS_DEC = 28 * MiB;
constexpr size_t WS_XB = 32 * MiB;
constexpr size_t WS_MIXED = 160 * MiB;
constexpr size_t WS_ARR = 224 * MiB;
constexpr size_t ARR_BYTES = 32 * MiB;
constexpr size_t WS_END = 480 * MiB;
constexpr int CW_QUEUE = 1024;
constexpr int CW_BAR = 4096;

constexpr int RING_OFF = 0, RING_BYTES = 131072;
constexpr int EXTRA_OFF = RING_BYTES, EXTRA_BYTES = 16384;
constexpr int LDSCTL_OFF = EXTRA_OFF + EXTRA_BYTES, MISC_OFF = LDSCTL_OFF + 320;
constexpr int LDS_BYTES = LDSCTL_OFF + 1024;

#define GAS __attribute__((address_space(1)))
#define LAS __attribute__((address_space(3)))
typedef unsigned short bf16;
typedef unsigned v4u __attribute__((ext_vector_type(4)));
typedef float f32x4 __attribute__((ext_vector_type(4)));
typedef GAS unsigned gu32;
#define RLX_AGENT __ATOMIC_RELAXED, __HIP_MEMORY_SCOPE_AGENT
#define LDS_WAIT() asm volatile("s_waitcnt lgkmcnt(0)" ::: "memory")
#define VM_WAIT() asm volatile("s_waitcnt vmcnt(0)" ::: "memory")
__device__ __forceinline__ unsigned f2bf(float f) { unsigned u = __builtin_bit_cast(unsigned, f); return (u + 0x7fffu + ((u >> 16) & 1u)) >> 16; }
__device__ __forceinline__ unsigned pk2(float lo, float hi) { return f2bf(lo) | (f2bf(hi) << 16); }
__device__ __forceinline__ float bf2f(unsigned short b) { return __builtin_bit_cast(float, (unsigned)b << 16); }
__device__ __forceinline__ float bflo(unsigned w) { return __builtin_bit_cast(float, w << 16); }
__device__ __forceinline__ float bfhi(unsigned w) { return __builtin_bit_cast(float, w & 0xffff0000u); }
__device__ __forceinline__ float silu_f(float z) { return z / (1.0f + __expf(-z)); }
__device__ __forceinline__ float sigmoid_f(float z) { return 1.0f / (1.0f + __expf(-z)); }

#define XB_TMO      128
#define XB_XCNT(j)  (256  + 64 * (j))
#define XB_XSUB(j)  (1280 + 64 * (j))
#define XB_XGEN(j)  (2304 + 64 * (j))
#define XB_TOP      3328
#define XB_TOPGEN   3392
#define XCD_BAR_WORDS 3456
#define XB_SPIN_CAP (1u << 18)

__device__ __forceinline__ unsigned xb_ld(unsigned* p)              { return __hip_atomic_load(p, __ATOMIC_RELAXED, __HIP_MEMORY_SCOPE_AGENT); }
__device__ __forceinline__ unsigned xb_add(unsigned* p, unsigned v) { return __hip_atomic_fetch_add(p, v, __ATOMIC_RELAXED, __HIP_MEMORY_SCOPE_AGENT); }
__device__ __forceinline__ unsigned xb_xcc_id() { return (unsigned)__builtin_amdgcn_s_getreg((3 << 11) | 20) & 0xFu; }
#define XB_SPIN(cond, bar) do { unsigned _sp = 0; while (cond) { __builtin_amdgcn_s_sleep(1); \
    if ((++_sp & 255u) == 0u) { if (xb_ld(&(bar)[XB_TMO])) break; if (_sp > XB_SPIN_CAP) { atomicAdd(&(bar)[XB_TMO], 1u); break; } } } } while (0)

struct XcdBarrier {
    unsigned* bar; unsigned x;
    volatile LAS unsigned* st;
};

__device__ __forceinline__ XcdBarrier xcd_barrier_post(unsigned* bar, volatile LAS unsigned* st) {
    XcdBarrier b; b.bar = bar; b.x = xb_xcc_id(); b.st = st;
    if (threadIdx.x == 0) (void)xb_add(&bar[XB_XCNT(b.x)], 1u);
    return b;
}
__device__ __forceinline__ void xcd_barrier_complete(unsigned* bar, unsigned x, unsigned& nloc, unsigned& nx) {
    const unsigned G = gridDim.x * gridDim.y * gridDim.z;
    unsigned sum, cnt, mine, sp = 0u;
    for (;;) {
        sum = 0u; cnt = 0u; mine = 0u;
#pragma unroll
        for (unsigned j = 0; j < 16; ++j) { const unsigned c = xb_ld(&bar[XB_XCNT(j)]); sum += c; cnt += (c > 0u) ? 1u : 0u; mine = (j == x) ? c : mine; }
        if (sum == G) break;
        __builtin_amdgcn_s_sleep(1);
        if ((++sp & 255u) == 0u) { if (xb_ld(&bar[XB_TMO])) break; if (sp > XB_SPIN_CAP) { atomicAdd(&bar[XB_TMO], 1u); break; } }
    }
    nloc = mine > 0u ? mine : 1u; nx = cnt > 0u ? cnt : 1u;
}

__device__ __forceinline__ void xcd_barrier(const XcdBarrier& b) {
    asm volatile("s_waitcnt vmcnt(0)" ::: "memory");
    __syncthreads();
    if (threadIdx.x == 0) {
        unsigned* bar = b.bar;
        __builtin_amdgcn_s_waitcnt(0);
        unsigned nloc = b.st[0], nx = b.st[1];
        if (nloc == 0u) { xcd_barrier_complete(bar, b.x, nloc, nx); b.st[0] = nloc; b.st[1] = nx; }
        const unsigned old = xb_add(&bar[XB_XSUB(b.x)], 1u);
        const unsigned gen = old / nloc;
        if (old + 1u == (gen + 1u) * nloc) {
            __builtin_amdgcn_fence(__ATOMIC_RELEASE, "agent");
            asm volatile("s_waitcnt vmcnt(0)" ::: "memory");
            const unsigned og = xb_add(&bar[XB_TOP], 1u);
            const unsigned tg = og / nx;
            if (og + 1u == (tg + 1u) * nx) xb_add(&bar[XB_TOPGEN], 1u);
            else XB_SPIN(xb_ld(&bar[XB_TOPGEN]) == tg, bar);
            __builtin_amdgcn_fence(__ATOMIC_ACQUIRE, "agent");
            xb_add(&bar[XB_XGEN(b.x)], 1u);
            asm volatile("s_waitcnt vmcnt(0)" ::: "memory");
        } else {
            XB_SPIN(xb_ld(&bar[XB_XGEN(b.x)]) == gen, bar);
            __builtin_amdgcn_fence(__ATOMIC_ACQUIRE, "agent");
            asm volatile("s_waitcnt vmcnt(0)" ::: "memory");
        }
    }
    __syncthreads();
}


struct Frame {
    LAS unsigned char* lds;
    volatile LAS unsigned* MISC;
    gu32* ctl;
    int vcu, G;
    const float* x; float* out;
    const float *norm_w, *w_in, *lb_logits, *hg_norm_w, *q_norm_w, *k_norm_w, *w_out;
    bf16 *WIN, *WOUT, *XB, *MIXED, *QI, *KT, *HI, *GH, *QN, *KN, *V, *GA;
    float *LB, *KPART, *ROWSS, *DEC;
};

__device__ __forceinline__ float wave_sum(float v) {
#pragma unroll
    for (int o = 1; o < 64; o <<= 1) v += __shfl_xor(v, o);
    return v;
}
__device__ __forceinline__ int win_dest(int oc) {
    if (oc < 2048) { const int grp = oc >> 9, hh = (oc >> 7) & 3, w = oc & 127; return 256 * (((grp >> 1) << 2) + hh) + 128 * (grp & 1) + w; }
    const int ty = (oc - 2048) >> 9, head = (oc >> 6) & 7, bj = (oc >> 5) & 1; return 256 * (8 + 2 * ty + (head >> 2)) + 128 * bj + 32 * (head & 3);
}
__device__ __forceinline__ void p0_transpose_item(const float* W, int K, int N, bf16* WT, const float* kscale, LAS float* scr, int item, int lane, bool permute) {
    const int nblk = N / 32, kb = item / nblk, nb = item % nblk, k0 = 64 * kb, n0 = 32 * nb; const int nd = permute ? win_dest(n0) : n0;
#pragma unroll 8
    for (int i = 0; i < 32; ++i) { const int kk = 2 * i + (lane >> 5); const float s = kscale ? kscale[k0 + kk] : 1.0f; scr[kk * 33 + (lane & 31)] = W[(size_t)(k0 + kk) * N + n0 + (lane & 31)] * s; }
    LDS_WAIT(); asm volatile("" ::: "memory");
    const int c = lane & 7;
#pragma unroll
    for (int j = 0; j < 4; ++j) { const int n = (lane >> 3) + 8 * j; const LAS float* s = scr + (8 * c) * 33 + n;
        v4u o; o.x = pk2(s[0 * 33], s[1 * 33]); o.y = pk2(s[2 * 33], s[3 * 33]); o.z = pk2(s[4 * 33], s[5 * 33]); o.w = pk2(s[6 * 33], s[7 * 33]);
        *(GAS v4u*)(WT + (size_t)(nd + n) * K + k0 + 8 * c) = o; }
    LDS_WAIT(); asm volatile("" ::: "memory");
}
#define PHASE_IDS() int t_ = threadIdx.x; asm volatile("" : "+v"(t_)); const int tid = t_, lane = tid & 63, wave = __builtin_amdgcn_readfirstlane(tid >> 6); (void)lane; (void)wave
__device__ __forceinline__ void p0_prologue(Frame& F) {
    PHASE_IDS();
    LAS float* scr = (LAS float*)(F.lds + RING_OFF + wave * 16384);
    const int gw = F.vcu * NWAVES + wave, NGW = F.G * NWAVES;
    constexpr int I_IN = (DM / 64) * (NIN / 32), I_OUT = (DM / 64) * (DM / 32);
    constexpr int NITEMS = DEPTH * (I_IN + I_OUT);
    for (int it = gw; it < NITEMS; it += NGW) {
        int r = it;
        if (r < DEPTH * I_IN) { const int l = r / I_IN; r -= l * I_IN;
            p0_transpose_item(F.w_in + (size_t)l * DM * NIN, DM, NIN, F.WIN + (size_t)l * NIN * DM, F.norm_w + l * DM, scr, r, lane, true); continue; }
        r -= DEPTH * I_IN; { const int l = r / I_OUT; r -= l * I_OUT;
            p0_transpose_item(F.w_out + (size_t)l * DM * DM, DM, DM, F.WOUT + (size_t)l * DM * DM, nullptr, scr, r, lane, false); }
    }
    for (int m = gw; m < MTOK; m += NGW) {
        const GAS f32x4* xr = (const GAS f32x4*)(F.x + (size_t)m * DM) + lane;
        f32x4 v[4]; float s = 0.f;
#pragma unroll
        for (int j = 0; j < 4; ++j) { v[j] = xr[64 * j]; s += (v[j].x * v[j].x + v[j].y * v[j].y) + (v[j].z * v[j].z + v[j].w * v[j].w); }
        s = wave_sum(s);
        GAS unsigned long long* o8 = (GAS unsigned long long*)(F.XB + (size_t)m * DM) + lane;
#pragma unroll
        for (int j = 0; j < 4; ++j) o8[64 * j] = (unsigned long long)pk2(v[j].x, v[j].y) | ((unsigned long long)pk2(v[j].z, v[j].w) << 32);
        if (lane < 16) F.ROWSS[(size_t)m * 16 + lane] = (lane == 0) ? s : 0.f;
    }
    if (blockIdx.x == 0) { const int c = tid; const float a0 = F.lb_logits[c], a1 = F.lb_logits[512 + c]; const float mx = fmaxf(a0, a1);
        const float e0 = expf(a0 - mx), e1 = expf(a1 - mx); const float p0 = e0 / (e0 + e1), p1 = e1 / (e0 + e1);
        F.LB[c] = 0.f; F.LB[512 + c] = fminf(fmaxf((p0 + p1) - p0, 0.f), 1.0f - 1e-6f); }
}

constexpr float LOG2E = 1.4426950408889634f;
constexpr float QSCALE2 = 0.125f * LOG2E;
namespace moba {
typedef short bf16x8 __attribute__((ext_vector_type(8)));
typedef short s16x4 __attribute__((ext_vector_type(4)));
typedef float f32x16 __attribute__((ext_vector_type(16)));
typedef float f32x2_t __attribute__((ext_vector_type(2))); typedef __bf16 bf16x2_t __attribute__((ext_vector_type(2)));
__device__ __forceinline__ unsigned cvtpk(float lo, float hi) { f32x2_t v = {lo, hi}; bf16x2_t b = __builtin_convertvector(v, bf16x2_t); return __builtin_bit_cast(unsigned, b); }
__device__ __forceinline__ int crow(int r, int hi) { return (r & 3) + 8 * (r >> 2) + 4 * hi; }
constexpr int L_K = 0, L_V = 24576, L_WSF = 49152, L_KM = 51200, L_OST = 53248;
constexpr float NEG_BIG = -1e30f;
constexpr float THR = 8.0f;
__device__ __forceinline__ s16x4 vtr(const LAS unsigned char* p) { return __builtin_bit_cast(s16x4, __builtin_amdgcn_ds_read_tr16_b64_v4i16((LAS s16x4*)p)); }
}

__device__ __forceinline__ void moba_mfma_phase(Frame& F, int l) {
    using namespace moba;
    PHASE_IDS();
    const int r32 = lane & 31, hi = lane >> 5, wid = wave;
    LAS unsigned char* L = F.lds + RING_OFF;
    LAS float* wsf = (LAS float*)(L + L_WSF) + wid * 64;
    LAS float* km = (LAS float*)(L + L_KM);
    LAS float* ost = (LAS float*)(L + L_OST) + wid * 2048;
    float gq = fabsf(F.q_norm_w[l * 64 + lane]), gk = fabsf(F.k_norm_w[l * 64 + lane]);
#pragma unroll
    for (int o = 1; o < 64; o <<= 1) { gq = fmaxf(gq, __shfl_xor(gq, o)); gk = fmaxf(gk, __shfl_xor(gk, o)); }
    const float smax2 = 8.0f * gq * gk * LOG2E * 1.02f;
    const float mhat0 = -(smax2 + 1.0f);
    gu32* qctr = F.ctl + CW_QUEUE + 64 * l;
    volatile LAS unsigned* tick = (volatile LAS unsigned*)(F.lds + EXTRA_OFF + 8192);
    for (;;) {
        __syncthreads();
        if (tid == 0) tick[0] = __hip_atomic_fetch_add(qctr, 1u, RLX_AGENT);
        __syncthreads();
        const int it = __builtin_amdgcn_readfirstlane((int)tick[0]); if (it >= 1024) break;
        const int qb = 7 - (it >> 7), bh = it & 127;
        const int b = bh >> 3, h = bh & 7; const size_t rowbase = (size_t)b * SEQ; const int q0 = qb * 256, qrel = wid * 32 + r32, tq = q0 + qrel;
        const float sl2 = exp2f(-(float)(h + 1)) * LOG2E;
        bf16x8 qr[4];
        { const GAS bf16* Qw = (const GAS bf16*)(F.QN + (rowbase + q0 + wid * 32 + r32) * 512 + h * 64 + hi * 8);
#pragma unroll
            for (int d0 = 0; d0 < 4; ++d0) qr[d0] = *(const GAS bf16x8*)(Qw + d0 * 16); }
        if (tid < qb * 64) { const GAS float* kp = (const GAS float*)(F.KPART + ((size_t)b * 8 + (tid >> 6)) * 1024 + h * 64 + (tid & 63)); km[tid] = (kp[0] + kp[512]) * (1.0f / 256.0f); }
        const GAS bf16* ksrc = (const GAS bf16*)(F.KN + (rowbase + lane) * 512 + h * 64 + wid * 8);
        const GAS bf16* vsrc = (const GAS bf16*)(F.V + (rowbase + (tid >> 3)) * 512 + h * 64 + (tid & 7) * 8);
        const int kdst = L_K + wid * 1024 + lane * 16;
        const int vrow = tid >> 3, vch = tid & 7;
        const int vdst = L_V + vrow * 128 + (((vch >> 2) ^ ((vrow >> 1) & 1)) * 64) + (vch & 3) * 16;
        const int NT = 4 * (qb + 1);
        int t0 = 0; { const float dstar = (151.0f + 2.0f * smax2) / sl2; const float x = ((float)(q0 - 63) - dstar) * (1.0f / 64.0f); if (x > 0.f) t0 = ((int)x) & ~1; if (t0 > NT - 4) t0 = NT - 4; }
        v4u kA = *(const GAS v4u*)(ksrc + (size_t)t0 * 64 * 512), vA = *(const GAS v4u*)(vsrc + (size_t)t0 * 64 * 512);
        v4u kB = *(const GAS v4u*)(ksrc + (size_t)(t0 + 1) * 64 * 512), vB = *(const GAS v4u*)(vsrc + (size_t)(t0 + 1) * 64 * 512);
        __syncthreads();
        *(LAS v4u*)(L + kdst) = kA; *(LAS v4u*)(L + vdst) = vA; *(LAS v4u*)(L + 8192 + kdst) = kB; *(LAS v4u*)(L + 8192 + vdst) = vB;
        kA = *(const GAS v4u*)(ksrc + (size_t)(t0 + 2) * 64 * 512); vA = *(const GAS v4u*)(vsrc + (size_t)(t0 + 2) * 64 * 512);
        kB = *(const GAS v4u*)(ksrc + (size_t)(t0 + 3) * 64 * 512); vB = *(const GAS v4u*)(vsrc + (size_t)(t0 + 3) * 64 * 512);
        unsigned selmask = 0;
        { float gt[7];
#pragma unroll
            for (int j = 0; j < 7; ++j) { float s = 0.f;
                if (j < qb) {
#pragma unroll
                    for (int d0 = 0; d0 < 4; ++d0)
#pragma unroll
                        for (int e = 0; e < 8; ++e) s += bf2f((unsigned short)qr[d0][e]) * km[j * 64 + d0 * 16 + hi * 8 + e];
                    auto rr = __builtin_amdgcn_permlane32_swap(__float_as_uint(s), __float_as_uint(s), false, false);
                    s = __uint_as_float(rr[0]) + __uint_as_float(rr[1]); }
                gt[j] = s; }
#pragma unroll
            for (int j = 0; j < 7; ++j) { int rank = 0;
#pragma unroll
                for (int i = 0; i < 7; ++i) if (i != j && i < qb) rank += (gt[i] > gt[j] || (gt[i] == gt[j] && i < j)) ? 1 : 0;
                if (j < qb && rank < 3) selmask |= 1u << j; } }
        float mhat = mhat0, l_reg = 0.f; f32x16 o[2]; o[0] = f32x16{}; o[1] = f32x16{};
        const int kbase = L_K + hi * 1024 + r32 * 16;
        const int g16 = lane >> 4, i16 = lane & 15, tq4 = i16 >> 2, tp4 = i16 & 3;
        const int vrow0 = 4 * hi + tq4;
        __syncthreads();
#define MOBA_QK(TT, KOFF, P0, P1) do { \
            const int blk_ = (TT) >> 2; const bool own_ = (blk_ == qb); \
            if (!(own_ && (64 * ((TT) & 3) > 32 * wid + 31))) { \
                const bool sel_ = own_ || ((selmask >> blk_) & 1u); \
                const float sc0_ = sel_ ? (-mhat - sl2 * (float)(tq - 64 * (TT) - 4 * hi)) : NEG_BIG; \
_Pragma("unroll") \
                for (int r = 0; r < 16; ++r) { P0[r] = __builtin_fmaf(sl2, (float)((r & 3) + 8 * (r >> 2)), sc0_); P1[r] = __builtin_fmaf(sl2, (float)(32 + (r & 3) + 8 * (r >> 2)), sc0_); } \
_Pragma("unroll") \
                for (int d0 = 0; d0 < 4; ++d0) { \
                    const bf16x8 b0 = *(const LAS bf16x8*)(L + (KOFF) + kbase + d0 * 2048); \
                    const bf16x8 b1 = *(const LAS bf16x8*)(L + (KOFF) + kbase + d0 * 2048 + 512); \
                    P0 = __builtin_amdgcn_mfma_f32_32x32x16_bf16(b0, qr[d0], P0, 0, 0, 0); \
                    P1 = __builtin_amdgcn_mfma_f32_32x32x16_bf16(b1, qr[d0], P1, 0, 0, 0); } \
            } } while (0)
#define MOBA_SMPV(TT, VOFF, P0, P1, HAVE_NEXT, N0, N1) do { \
            const int blk = (TT) >> 2; const bool own = (blk == qb); const int jb = (TT) & 3; \
            if (!(own && (64 * jb > 32 * wid + 31))) { \
                if (own && (64 * jb + 63 > 32 * wid)) { \
_Pragma("unroll") \
                    for (int r = 0; r < 16; ++r) { const int kvl = 64 * jb + crow(r, hi); if (kvl > qrel) P0[r] = NEG_BIG; if (kvl + 32 > qrel) P1[r] = NEG_BIG; } } \
                float rm = fmaxf(P0[0], P1[0]); \
_Pragma("unroll") \
                for (int r = 1; r < 16; ++r) rm = fmaxf(rm, fmaxf(P0[r], P1[r])); \
                { auto rr = __builtin_amdgcn_permlane32_swap(__float_as_uint(rm), __float_as_uint(rm), false, false); rm = fmaxf(__uint_as_float(rr[0]), __uint_as_float(rr[1])); } \
                if (__any(rm > THR)) { \
                    const float dl = fmaxf(rm, 0.f); mhat += dl; \
_Pragma("unroll") \
                    for (int r = 0; r < 16; ++r) { P0[r] -= dl; P1[r] -= dl; } \
                    if (HAVE_NEXT) { \
_Pragma("unroll") \
                        for (int r = 0; r < 16; ++r) { N0[r] -= dl; N1[r] -= dl; } } \
                    const float f = __builtin_amdgcn_exp2f(-dl); l_reg *= f; \
                    if (hi == 0) wsf[r32] = f; \
_Pragma("unroll") \
                    for (int r = 0; r < 16; ++r) { const float fr = wsf[crow(r, hi)]; o[0][r] *= fr; o[1][r] *= fr; } } \
                float sacc = 0.f; \
_Pragma("unroll") \
                for (int r = 0; r < 16; ++r) { P0[r] = __builtin_amdgcn_exp2f(P0[r]); P1[r] = __builtin_amdgcn_exp2f(P1[r]); sacc += P0[r] + P1[r]; } \
                l_reg += sacc; \
                bf16x8 pa[4]; \
                { v4u w; \
_Pragma("unroll") \
                    for (int ks = 0; ks < 4; ++ks) { \
_Pragma("unroll") \
                        for (int e = 0; e < 4; ++e) { const int rb = (ks & 1) * 8 + 2 * e; w[e] = (ks < 2) ? cvtpk(P0[rb], P0[rb + 1]) : cvtpk(P1[rb], P1[rb + 1]); } \
                        pa[ks] = __builtin_bit_cast(bf16x8, w); } } \
_Pragma("unroll") \
                for (int dblk = 0; dblk < 2; ++dblk) \
_Pragma("unroll") \
                    for (int ks = 0; ks < 4; ++ks) { \
                        const int rlo = 16 * ks + vrow0, rhi = rlo + 8; \
                        const int alo = L_V + (VOFF) + rlo * 128 + ((dblk ^ ((rlo >> 1) & 1)) * 64) + (16 * (g16 & 1) + 4 * tp4) * 2; \
                        const int ahi = L_V + (VOFF) + rhi * 128 + ((dblk ^ ((rhi >> 1) & 1)) * 64) + (16 * (g16 & 1) + 4 * tp4) * 2; \
                        const s16x4 lo = vtr(L + alo), hh = vtr(L + ahi); \
                        const bf16x8 vf = (bf16x8){lo[0], lo[1], lo[2], lo[3], hh[0], hh[1], hh[2], hh[3]}; \
                        o[dblk] = __builtin_amdgcn_mfma_f32_32x32x16_bf16(pa[ks], vf, o[dblk], 0, 0, 0); } \
            } } while (0)
        f32x16 pA0, pA1, pB0, pB1;
        MOBA_QK(t0, 0, pA0, pA1);
        int c0o = 0;
        for (int t = t0; t < NT; t += 2) {
            const int c1o = (c0o == 2) ? 0 : c0o + 1, c2o = (c1o == 2) ? 0 : c1o + 1;
            MOBA_QK(t + 1, (c1o * 8192), pB0, pB1);
            MOBA_SMPV(t, (c0o * 8192), pA0, pA1, true, pB0, pB1);
            if (t + 2 < NT) { *(LAS v4u*)(L + c2o * 8192 + kdst) = kA; *(LAS v4u*)(L + c2o * 8192 + vdst) = vA; }
            if (t + 4 < NT) { kA = *(const GAS v4u*)(ksrc + (size_t)(t + 4) * 64 * 512); vA = *(const GAS v4u*)(vsrc + (size_t)(t + 4) * 64 * 512); }
            __syncthreads();
            if (t + 2 < NT) MOBA_QK(t + 2, (c2o * 8192), pA0, pA1);
            MOBA_SMPV(t + 1, (c1o * 8192), pB0, pB1, (t + 2 < NT), pA0, pA1);
            if (t + 3 < NT) { *(LAS v4u*)(L + c0o * 8192 + kdst) = kB; *(LAS v4u*)(L + c0o * 8192 + vdst) = vB; }
            if (t + 5 < NT) { kB = *(const GAS v4u*)(ksrc + (size_t)(t + 5) * 64 * 512); vB = *(const GAS v4u*)(vsrc + (size_t)(t + 5) * 64 * 512); }
            __syncthreads();
            c0o = c2o;
        }
#undef MOBA_QK
#undef MOBA_SMPV
        { auto rr = __builtin_amdgcn_permlane32_swap(__float_as_uint(l_reg), __float_as_uint(l_reg), false, false); l_reg = __uint_as_float(rr[0]) + __uint_as_float(rr[1]); }
        if (hi == 0) wsf[r32] = 1.0f / l_reg;
#pragma unroll
        for (int r = 0; r < 16; ++r) { const float rl = wsf[crow(r, hi)]; ost[crow(r, hi) * 64 + r32] = o[0][r] * rl; ost[crow(r, hi) * 64 + 32 + r32] = o[1][r] * rl; }
#pragma unroll
        for (int i = 0; i < 4; ++i) { const int row = i * 8 + (lane >> 3), ch = lane & 7;
            const f32x4 a = *(const LAS f32x4*)(ost + row * 64 + ch * 8), c2 = *(const LAS f32x4*)(ost + row * 64 + ch * 8 + 4);
            const size_t grow = rowbase + q0 + wid * 32 + row;
            const v4u gw = *(const GAS v4u*)(F.GA + grow * 512 + h * 64 + ch * 8);
            v4u ow; ow.x = pk2(a[0] * bflo(gw.x), a[1] * bfhi(gw.x)); ow.y = pk2(a[2] * bflo(gw.y), a[3] * bfhi(gw.y));
            ow.z = pk2(c2[0] * bflo(gw.z), c2[1] * bfhi(gw.z)); ow.w = pk2(c2[2] * bflo(gw.w), c2[3] * bfhi(gw.w));
            *(GAS v4u*)(F.MIXED + grow * DM + 512 + h * 64 + ch * 8) = ow; }
    }
    __syncthreads();
}


namespace hg {
typedef short bf16x8 __attribute__((ext_vector_type(8)));
typedef short s16x4 __attribute__((ext_vector_type(4)));
typedef float f32x4 __attribute__((ext_vector_type(4)));
typedef unsigned u32x2 __attribute__((ext_vector_type(2)));
constexpr int SLOT = 33792, NSLOT = 4;
constexpr int L_SC = NSLOT * SLOT, L_NRM = L_SC + 2048;
constexpr int NSTEP = SEQ / 32;
__device__ __forceinline__ int fsw(int t) { return ((t & 7) << 2) | (((t >> 3) & 1) << 1); }
__device__ __forceinline__ int unit_off(int tok, int cg) { return 8 * (32 * tok + (cg ^ fsw(tok))); }
__device__ __forceinline__ s16x4 rd64(const LAS unsigned char* p) { return *(const LAS s16x4*)p; }
__device__ __forceinline__ s16x4 vtr(const LAS unsigned char* p) { return __builtin_bit_cast(s16x4, __builtin_amdgcn_ds_read_tr16_b64_v4i16((LAS s16x4*)p)); }
__device__ __forceinline__ bf16x8 cat(s16x4 a, s16x4 b) { return (bf16x8){a[0], a[1], a[2], a[3], b[0], b[1], b[2], b[3]}; }
__device__ __forceinline__ s16x4 pack4(f32x4 v) { u32x2 w; w.x = moba::cvtpk(v[0], v[1]); w.y = moba::cvtpk(v[2], v[3]); return __builtin_bit_cast(s16x4, w); }
__device__ __forceinline__ void glds16(const GAS void* gsrc, unsigned lds_dst) { unsigned keep;
    asm volatile("s_mov_b32 %0, m0\n\ts_mov_b32 m0, %2\n\ts_nop 0\n\tglobal_load_lds_dwordx4 %1, off\n\ts_mov_b32 m0, %0" : "=&s"(keep) : "v"(gsrc), "s"(lds_dst) : "memory"); }
#define HG_MFMA(a, b, c) __builtin_amdgcn_mfma_f32_16x16x32_bf16((a), (b), (c), 0, 0, 0)
}

__device__ __forceinline__ void hgrn_mfma_phase(Frame& F, int l) {
    using namespace hg;
    PHASE_IDS();
    const int w = wave, c16 = lane & 15, g = lane >> 4;
    LAS unsigned char* L = F.lds + RING_OFF;
    const s16x4 z4 = (s16x4){0, 0, 0, 0};
    for (int it = (int)blockIdx.x; it < 64; it += F.G) {
        const int b = it >> 2, h = it & 3; const size_t rowbase = (size_t)b * SEQ;
        const int da = w >> 1;
        const GAS bf16* dsrc[4];
#pragma unroll
        for (int i = 0; i < 4; ++i) { const int t = 16 * (w & 1) + 4 * i + (lane >> 4); const int sc = (lane & 15) ^ (fsw(t) >> 1);
            dsrc[i] = (const GAS bf16*)(F.QI + (size_t)da * MTOK * 512 + (rowbase + t) * 512 + h * 128 + 8 * sc); }
        const GAS float* ddec = (const GAS float*)(F.DEC + (size_t)b * NSTEP * 512 + h * 128 + 4 * lane);
        const int ddst = da * 8192 + (w & 1) * 4096;
        const unsigned lds0 = (unsigned)(uintptr_t)(F.lds + RING_OFF);
#define HG_ISSUE(step) do { const unsigned so_ = lds0 + (unsigned)(((step) & 3) * SLOT); \
            _Pragma("unroll") for (int i = 0; i < 4; ++i) \
                glds16((const GAS void*)(dsrc[i] + (size_t)(step) * 32 * 512), (unsigned)__builtin_amdgcn_readfirstlane((int)(so_ + ddst + i * 1024))); \
            if (w == 0) glds16((const GAS void*)(ddec + (size_t)(step) * 512), (unsigned)__builtin_amdgcn_readfirstlane((int)(so_ + 32768))); } while (0)
        f32x4 S[8]; bf16x8 Sb[4];
#pragma unroll
        for (int tk = 0; tk < 8; ++tk) S[tk] = (f32x4){0.f, 0.f, 0.f, 0.f};
#pragma unroll
        for (int ks = 0; ks < 4; ++ks) Sb[ks] = (bf16x8){0, 0, 0, 0, 0, 0, 0, 0};
        f32x4 oprev[2]; oprev[0] = (f32x4){0.f, 0.f, 0.f, 0.f}; oprev[1] = oprev[0];
        u32x2 gprev[2]; gprev[0] = (u32x2){0u, 0u}; gprev[1] = gprev[0];
        float hw[4];
#pragma unroll
        for (int r = 0; r < 4; ++r) hw[r] = F.hg_norm_w[l * 128 + 16 * w + 4 * g + r];
        asm volatile("" : "+v"(hw[0]), "+v"(hw[1]), "+v"(hw[2]), "+v"(hw[3]));
        LAS float* nrm = (LAS float*)(L + L_NRM);
        LAS unsigned char* SC = L + L_SC;
        HG_ISSUE(0); HG_ISSUE(1); HG_ISSUE(2);
        asm volatile("s_waitcnt vmcnt(8)\n\ts_barrier" ::: "memory");
        const int trq = c16 >> 2, trp = c16 & 3;
        for (int n = 0; n < NSTEP; ++n) {
            if (n + 3 < NSTEP) HG_ISSUE(n + 3);
            const LAS unsigned char* Qs = L + (n & 3) * SLOT; const LAS unsigned char* Ks = Qs + 8192; const LAS unsigned char* Is = Qs + 16384; const LAS unsigned char* Gs = Qs + 24576;
            const LAS float* Ds = (const LAS float*)(Qs + 32768);
            bf16x8 qf[2][4];
#pragma unroll
            for (int tt = 0; tt < 2; ++tt)
#pragma unroll
                for (int ks = 0; ks < 4; ++ks) qf[tt][ks] = cat(rd64(Qs + unit_off(16 * tt + c16, 8 * ks + g)), rd64(Qs + unit_off(16 * tt + c16, 8 * ks + 4 + g)));
            f32x4 o[2];
#pragma unroll
            for (int tt = 0; tt < 2; ++tt) { f32x4 a = (f32x4){0.f, 0.f, 0.f, 0.f};
#pragma unroll
                for (int ks = 0; ks < 4; ++ks) a = HG_MFMA(Sb[ks], qf[tt][ks], a);
                o[tt] = a; }
            if (w < 3) { const int st = (w == 2) ? 1 : 0, tt = (w == 0) ? 0 : 1;
                f32x4 sc = (f32x4){0.f, 0.f, 0.f, 0.f}; bf16x8 kf[4];
#pragma unroll
                for (int ks = 0; ks < 4; ++ks) kf[ks] = cat(rd64(Ks + unit_off(16 * st + c16, 8 * ks + g)), rd64(Ks + unit_off(16 * st + c16, 8 * ks + 4 + g)));
#pragma unroll
                for (int ks = 0; ks < 4; ++ks) sc = HG_MFMA(kf[ks], (tt == 0) ? qf[0][ks] : qf[1][ks], sc);
                if (st == tt) {
#pragma unroll
                    for (int r = 0; r < 4; ++r) if (4 * g + r > c16) sc[r] = 0.f; }
                *(LAS s16x4*)(SC + w * 512 + lane * 8) = pack4(sc); }
            u32x2 gcur[2];
#pragma unroll
            for (int tt = 0; tt < 2; ++tt) gcur[tt] = *(const LAS u32x2*)(Gs + unit_off(16 * tt + c16, 4 * w + g));
            s16x4 itr[2];
#pragma unroll
            for (int st = 0; st < 2; ++st) itr[st] = vtr(Is + unit_off(16 * st + 4 * g + trq, 4 * w + trp));
            const bf16x8 i01 = cat(itr[0], itr[1]);
            bf16x8 k01[8]; f32x4 dv4[8];
#pragma unroll
            for (int tk = 0; tk < 8; ++tk) { k01[tk] = cat(vtr(Ks + unit_off(4 * g + trq, 4 * tk + trp)), vtr(Ks + unit_off(16 + 4 * g + trq, 4 * tk + trp))); dv4[tk] = *(const LAS f32x4*)(Ds + 16 * tk + 4 * g); }
            asm volatile("s_waitcnt lgkmcnt(0)\n\ts_barrier" ::: "memory");
            const s16x4 sc00 = rd64(SC + lane * 8), sc01 = rd64(SC + 512 + lane * 8), sc11 = rd64(SC + 1024 + lane * 8);
            o[0] = HG_MFMA(cat(itr[0], z4), cat(sc00, z4), o[0]);
            o[1] = HG_MFMA(i01, cat(sc01, sc11), o[1]);
            { float ss0 = (o[0][0] * o[0][0] + o[0][1] * o[0][1]) + (o[0][2] * o[0][2] + o[0][3] * o[0][3]);
              float ss1 = (o[1][0] * o[1][0] + o[1][1] * o[1][1]) + (o[1][2] * o[1][2] + o[1][3] * o[1][3]);
              { auto r0 = __builtin_amdgcn_permlane16_swap(__float_as_uint(ss0), __float_as_uint(ss0), false, false); auto r1 = __builtin_amdgcn_permlane16_swap(__float_as_uint(ss1), __float_as_uint(ss1), false, false);
                ss0 = __uint_as_float(r0[0]) + __uint_as_float(r0[1]); ss1 = __uint_as_float(r1[0]) + __uint_as_float(r1[1]); }
              { auto r0 = __builtin_amdgcn_permlane32_swap(__float_as_uint(ss0), __float_as_uint(ss0), false, false); auto r1 = __builtin_amdgcn_permlane32_swap(__float_as_uint(ss1), __float_as_uint(ss1), false, false);
                ss0 = __uint_as_float(r0[0]) + __uint_as_float(r0[1]); ss1 = __uint_as_float(r1[0]) + __uint_as_float(r1[1]); }
              if (g == 0) { nrm[(n & 1) * 256 + w * 32 + c16] = ss0; nrm[(n & 1) * 256 + w * 32 + 16 + c16] = ss1; } }
#pragma unroll
            for (int tk = 0; tk < 8; ++tk) S[tk] = HG_MFMA(k01[tk], i01, S[tk]);
#pragma unroll
            for (int tk = 0; tk < 8; ++tk) S[tk] = S[tk] * dv4[tk];
#pragma unroll
            for (int ks = 0; ks < 4; ++ks) Sb[ks] = cat(pack4(S[2 * ks]), pack4(S[2 * ks + 1]));
            if (n > 0) {
#pragma unroll
                for (int tt = 0; tt < 2; ++tt) { const LAS float* np = nrm + ((n - 1) & 1) * 256 + 16 * tt + c16;
                    const float ssum = ((np[0] + np[32]) + (np[64] + np[96])) + ((np[128] + np[160]) + (np[192] + np[224]));
                    const float rstd = __builtin_amdgcn_rsqf(ssum * (1.0f / 128.0f) + NORM_EPS);
                    u32x2 wv; wv.x = pk2(oprev[tt][0] * rstd * hw[0] * bflo(gprev[tt].x), oprev[tt][1] * rstd * hw[1] * bfhi(gprev[tt].x));
                    wv.y = pk2(oprev[tt][2] * rstd * hw[2] * bflo(gprev[tt].y), oprev[tt][3] * rstd * hw[3] * bfhi(gprev[tt].y));
                    *(GAS u32x2*)(F.MIXED + (rowbase + (size_t)(n - 1) * 32 + 16 * tt + c16) * DM + h * 128 + 16 * w + 4 * g) = wv; } }
            oprev[0] = o[0]; oprev[1] = o[1]; gprev[0] = gcur[0]; gprev[1] = gcur[1];
            if (n >= NSTEP - 3) asm volatile("s_waitcnt vmcnt(0) lgkmcnt(0)\n\ts_barrier" ::: "memory");
            else if (n == 0) asm volatile("s_waitcnt vmcnt(8) lgkmcnt(0)\n\ts_barrier" ::: "memory");
            else if (n == 1) asm volatile("s_waitcnt vmcnt(10) lgkmcnt(0)\n\ts_barrier" ::: "memory");
            else asm volatile("s_waitcnt vmcnt(12) lgkmcnt(0)\n\ts_barrier" ::: "memory");
        }
#pragma unroll
        for (int tt = 0; tt < 2; ++tt) { const LAS float* np = nrm + ((NSTEP - 1) & 1) * 256 + 16 * tt + c16;
            const float ssum = ((np[0] + np[32]) + (np[64] + np[96])) + ((np[128] + np[160]) + (np[192] + np[224]));
            const float rstd = __builtin_amdgcn_rsqf(ssum * (1.0f / 128.0f) + NORM_EPS);
            u32x2 wv; wv.x = pk2(oprev[tt][0] * rstd * hw[0] * bflo(gprev[tt].x), oprev[tt][1] * rstd * hw[1] * bfhi(gprev[tt].x));
            wv.y = pk2(oprev[tt][2] * rstd * hw[2] * bflo(gprev[tt].y), oprev[tt][3] * rstd * hw[3] * bfhi(gprev[tt].y));
            *(GAS u32x2*)(F.MIXED + (rowbase + (size_t)(NSTEP - 1) * 32 + 16 * tt + c16) * DM + h * 128 + 16 * w + 4 * g) = wv; }
        asm volatile("s_waitcnt vmcnt(0) lgkmcnt(0)\n\ts_barrier" ::: "memory");
#undef HG_ISSUE
    }
}

struct Args { const float* in[8]; float* out; unsigned char* ws; int ph_lo, ph_hi, li, pad; };
__global__ void __launch_bounds__(NWAVES * 64, 2) fwd(Args args) {
    extern __shared__ __attribute__((aligned(16))) unsigned char lds[];
    Frame F;
    F.lds = (LAS unsigned char*)lds;
    F.MISC = (volatile LAS unsigned*)(F.lds + MISC_OFF);
    F.G = gridDim.x; { const int bx = blockIdx.x; F.vcu = (F.G % 8 == 0) ? (bx % 8) * (F.G / 8) + bx / 8 : bx; }
    unsigned char* ws = args.ws;
    F.ctl = (gu32*)(ws + WS_CTL);
    F.x = args.in[0]; F.norm_w = args.in[1]; F.w_in = args.in[2]; F.lb_logits = args.in[3]; F.hg_norm_w = args.in[4]; F.q_norm_w = args.in[5]; F.k_norm_w = args.in[6]; F.w_out = args.in[7];
    F.out = args.out;
    F.WIN = (bf16*)(ws + WS_WIN); F.WOUT = (bf16*)(ws + WS_WOUT); F.XB = (bf16*)(ws + WS_XB); F.MIXED = (bf16*)(ws + WS_MIXED);
    F.QI = (bf16*)(ws + WS_ARR); F.KT = (bf16*)(ws + WS_ARR + ARR_BYTES); F.HI = (bf16*)(ws + WS_ARR + 2 * ARR_BYTES); F.GH = (bf16*)(ws + WS_ARR + 3 * ARR_BYTES);
    F.QN = (bf16*)(ws + WS_ARR + 4 * ARR_BYTES); F.KN = (bf16*)(ws + WS_ARR + 5 * ARR_BYTES); F.V = (bf16*)(ws + WS_ARR + 6 * ARR_BYTES); F.GA = (bf16*)(ws + WS_ARR + 7 * ARR_BYTES);
    F.LB = (float*)(ws + WS_LB); F.KPART = (float*)(ws + WS_KPART); F.ROWSS = (float*)(ws + WS_ROWSS); F.DEC = (float*)(ws + WS_DEC);
    for (int u = threadIdx.x; u < (LDS_BYTES - LDSCTL_OFF) / 4; u += NWAVES * 64) ((LAS unsigned*)(F.lds + LDSCTL_OFF))[u] = 0u;
    __syncthreads();
    XcdBarrier bar; bar.bar = (unsigned*)(F.ctl + CW_BAR); bar.x = 0; bar.st = nullptr;
    if (N_LAUNCHES == 1) bar = xcd_barrier_post((unsigned*)(F.ctl + CW_BAR), F.MISC + 8);
#define GRID_BAR() do { if (N_LAUNCHES == 1) xcd_barrier(bar); } while (0)
    const int lo = args.ph_lo, hi = args.ph_hi;
#define IN(k) (lo <= (k) && (k) < hi)
#define BOTH(k) (IN(k) && IN((k) + 1))

    if (IN(0)) { p0_prologue(F); if (BOTH(0)) GRID_BAR(); }
    for (int l = 0; l < DEPTH; ++l) {
        const int pb = 1 + 3 * l;
        if (IN(pb)) {
            pg8::Gemm g{F.XB + (size_t)l * MTOK * DM, F.WIN + (size_t)l * NIN * DM, MTOK, NIN, DM}; pg8::StaticOrder S; S.init(MTOK, NIN, F.G, (int)blockIdx.x);
            pg8::EpiFused E{F.QI, F.DEC, F.KPART, F.ROWSS + (size_t)l * MTOK * 16, F.LB + l * 512, F.q_norm_w + l * 64, F.k_norm_w + l * 64};
            pg8::gemm_phase<pg8::EpiFused, pg8::StaticOrder, true, true>(F.lds + RING_OFF, g, S, E);
            if (BOTH(pb)) GRID_BAR();
        }
        if (IN(pb + 1)) { hgrn_mfma_phase(F, l); moba_mfma_phase(F, l); if (BOTH(pb + 1)) GRID_BAR(); }
        if (IN(pb + 2)) {
            pg8::Gemm g{F.MIXED, F.WOUT + (size_t)l * DM * DM, MTOK, DM, DM}; pg8::StaticOrder S; S.init(MTOK, DM, F.G, (int)blockIdx.x);
            pg8::EpiOut E{l == 0 ? F.x : F.out, F.out, l == 0 ? F.XB + (size_t)MTOK * DM : nullptr, l == 0 ? F.ROWSS + (size_t)MTOK * 16 : nullptr};
            pg8::gemm_phase<pg8::EpiOut, pg8::StaticOrder, true, true>(F.lds + RING_OFF, g, S, E);
            if (pb + 2 < N_PHASES - 1 && BOTH(pb + 2)) GRID_BAR();
        }
    }
#undef IN
#undef BOTH
}

extern "C" void kernel_launch(void* const* d_in, const int* in_sizes, int n_in, void* d_out, int out_size, void* d_ws, size_t ws_size, hipStream_t stream) {
    static int grid = 0;
    if (grid == 0) {
        if (n_in != 8 || in_sizes[0] != MTOK * DM || out_size != MTOK * DM || ws_size < WS_END) { fprintf(stderr, "kernel_launch: unexpected shapes n_in %d in0 %d out %d ws %zu\n", n_in, n_in > 0 ? in_sizes[0] : -1, out_size, ws_size); grid = -1; return; }
        int dev = 0, cus = 0, per_cu = 0;
        if (hipGetDevice(&dev) != hipSuccess || hipDeviceGetAttribute(&cus, hipDeviceAttributeMultiprocessorCount, dev) != hipSuccess) { grid = -1; return; }
        if (hipFuncSetAttribute((const void*)fwd, hipFuncAttributeMaxDynamicSharedMemorySize, LDS_BYTES) != hipSuccess) { fprintf(stderr, "kernel_launch: hipFuncSetAttribute failed\n"); grid = -1; return; }
        if (hipOccupancyMaxActiveBlocksPerMultiprocessor(&per_cu, (const void*)fwd, NWAVES * 64, LDS_BYTES) != hipSuccess || per_cu < 1) fprintf(stderr, "kernel_launch: occupancy query says %d\n", per_cu);
        (void)hipGetLastError();
        if (per_cu < 1) { grid = -1; return; }
        grid = cus;
    }
    if (grid < 0) return;
    if (hipMemsetAsync((char*)d_ws + WS_CTL, 0, CTL_ZERO_BYTES, stream) != hipSuccess) return;
    Args a{};
    for (int i = 0; i < 8; ++i) a.in[i] = (const float*)d_in[i];
    a.out = (float*)d_out; a.ws = (unsigned char*)d_ws;
    for (int li = 0; li < N_LAUNCHES; ++li) {
        a.ph_lo = (N_LAUNCHES == 1) ? 0 : li; a.ph_hi = (N_LAUNCHES == 1) ? N_PHASES : li + 1; a.li = li;
        hipError_t le;
        if (N_LAUNCHES == 1) { void* kargs[] = {(void*)&a}; le = hipLaunchCooperativeKernel((const void*)fwd, dim3(grid), dim3(NWAVES * 64), kargs, LDS_BYTES, stream); }
        else { hipLaunchKernelGGL(fwd, dim3(grid), dim3(NWAVES * 64), LDS_BYTES, stream, a); le = hipPeekAtLastError(); }
        if (le != hipSuccess) { fprintf(stderr, "kernel_launch: launch %d failed: %s\n", li, hipGetErrorName(le)); break; }
    }
}
```

```cpp
#include <hip/hip_runtime.h>
#include <cstdio>
#include <cstdint>
__device__ __forceinline__ int lane_id_asm() { int l; asm volatile("v_mbcnt_lo_u32_b32 %0, -1, 0\n\tv_mbcnt_hi_u32_b32 %0, -1, %0" : "=v"(l)); return l; }
namespace pg8 {
#define PG8_LAS __attribute__((address_space(3)))
typedef unsigned short bf16_t;
typedef short bf16x8 __attribute__((ext_vector_type(8)));
typedef float f32x4 __attribute__((ext_vector_type(4)));
typedef unsigned u32x4 __attribute__((ext_vector_type(4)));
typedef unsigned u32x2 __attribute__((ext_vector_type(2)));
constexpr int BM = 256, BK = 64, HALF = 128, HTB = HALF * BK * 2  , STAGE_BYTES = 8 * HTB, NXCD = 8, WGM = 8;

__host__ __device__ __forceinline__ int lds_byte(int r, int c) { const int st = (r >> 4) * 2 + (c >> 5), rr = r & 15, cc = c & 31, ob = rr * 64 + cc * 2; return st * 1024 + (ob ^ (((ob >> 9) & 1) << 5)); }
__host__ __device__ __forceinline__ void stage_rc(int b, int& R, int& C) { const int st = b / 1024, sb = b % 1024, swz = sb ^ (((sb >> 9) & 1) << 5); R = (st >> 1) * 16 + swz / 64; C = (st & 1) * 32 + (swz % 64) / 2; }
__host__ __device__ __forceinline__ int perm32(int rho) { const int n = rho >> 4, i = rho & 15; return 8 * (i >> 2) + 4 * n + (i & 3); }

struct Unit { int pm, pn; };
struct Gemm { const bf16_t* A; const bf16_t* Bt; int M, N, K; };

struct StaticOrder {
    int nM, nN, nwg, G, c;
    __host__ __device__ void init(int M, int N, int G_, int c_) { nM = M / BM; nN = N / BM; nwg = nM * nN; G = G_; c = c_; }
    __host__ __device__ bool next(int i, Unit& u) const {
        const long L = (long)i * G + c; if (L >= nwg) return false;
        int wgid = (int)L; { const int q = nwg / NXCD, r = nwg % NXCD, xcd = wgid % NXCD, off = wgid / NXCD; wgid = (xcd < r ? xcd * (q + 1) : r * (q + 1) + (xcd - r) * q) + off; }
        const int nig = WGM * nN, gid = wgid / nig, fm = gid * WGM, gsz = (nM - fm) < WGM ? (nM - fm) : WGM;
        u.pm = fm + ((wgid % nig) % gsz); u.pn = (wgid % nig) / gsz; return true;
    }
    __device__ __forceinline__ void a_ready(const Unit&) const {}
    __device__ __forceinline__ void done(const Unit&) const {}
};

__device__ __forceinline__ unsigned cvt_pk_bf16(float lo, float hi) { unsigned r; asm volatile("v_cvt_pk_bf16_f32 %0, %1, %2" : "=v"(r) : "v"(lo), "v"(hi)); return r; }


__device__ __forceinline__ float dpp_row_shr(float v, int n) {
    const int x = __builtin_bit_cast(int, v);
    int r;
    if (n == 1) r = __builtin_amdgcn_update_dpp(0, x, 0x111, 0xf, 0xf, false);
    else if (n == 2) r = __builtin_amdgcn_update_dpp(0, x, 0x112, 0xf, 0xf, false);
    else if (n == 4) r = __builtin_amdgcn_update_dpp(0, x, 0x114, 0xf, 0xf, false);
    else r = __builtin_amdgcn_update_dpp(0, x, 0x118, 0xf, 0xf, false);
    return __builtin_bit_cast(float, r);
}
__device__ __forceinline__ float fsig(float z) { return __builtin_amdgcn_rcpf(1.0f + __expf(-z)); }
struct EpiFused {
    static constexpr bool PERM = true, AFTER_DRAIN = false;
    bf16_t* ARR; float* DEC; float* KPART; const float* rowss; const float* lb; const float* qg; const float* kg;
    static constexpr size_t AS = (size_t)32768 * 512;
    __device__ __forceinline__ float rstd_of(int row) const {
        const f32x4* rp = (const f32x4*)(rowss + (size_t)row * 16);
        const f32x4 a = rp[0], b = rp[1], c = rp[2], d = rp[3];
        const float ss = ((a[0] + a[1]) + (a[2] + a[3])) + ((b[0] + b[1]) + (b[2] + b[3])) + ((c[0] + c[1]) + (c[2] + c[3])) + ((d[0] + d[1]) + (d[2] + d[3]));
        return 1.0f / sqrtf(ss * (1.0f / 1024.0f) + 1e-6f);
    }
    static __device__ __forceinline__ u32x4 pack8(const float (&v)[8]) { u32x4 w; w.x = cvt_pk_bf16(v[0], v[1]); w.y = cvt_pk_bf16(v[2], v[3]); w.z = cvt_pk_bf16(v[4], v[5]); w.w = cvt_pk_bf16(v[6], v[7]); return w; }
    __device__ __forceinline__ void operator()(const f32x4 (&acc)[2][2][4][2], const Unit& u, int wr, int wc, int fr, int fq) const {
        const int row0 = u.pm * BM + wr * 64 + fr; const int pn = u.pn;
        if (pn < 4) {
            const int cb = pn * 128 + wc * 32 + 8 * fq;
            float lbv[8];
#pragma unroll
            for (int k = 0; k < 8; ++k) lbv[k] = lb[cb + k];
#pragma unroll
            for (int ai = 0; ai < 2; ++ai)
#pragma unroll
                for (int mp = 0; mp < 2; ++mp) { const int row1 = row0 + ai * HALF + mp * 32, row2 = row1 + 16; const float rs1 = rstd_of(row1), rs2 = rstd_of(row2);
                    float qi1[8], kt1[8], qi2[8], kt2[8], dc[8];
#pragma unroll
                    for (int k = 0; k < 8; ++k) {
                        const float zq1 = acc[ai][0][2 * mp][k >> 2][k & 3] * rs1, zf1 = acc[ai][1][2 * mp][k >> 2][k & 3] * rs1;
                        const float zq2 = acc[ai][0][2 * mp + 1][k >> 2][k & 3] * rs2, zf2 = acc[ai][1][2 * mp + 1][k >> 2][k & 3] * rs2;
                        const float f1 = lbv[k] + (1.0f - lbv[k]) * fsig(zf1), f2 = lbv[k] + (1.0f - lbv[k]) * fsig(zf2);
                        float b1 = __logf(f1), b2 = __logf(f2);
                        b1 += dpp_row_shr(b1, 1); b2 += dpp_row_shr(b2, 1); b1 += dpp_row_shr(b1, 2); b2 += dpp_row_shr(b2, 2);
                        b1 += dpp_row_shr(b1, 4); b2 += dpp_row_shr(b2, 4); b1 += dpp_row_shr(b1, 8); b2 += dpp_row_shr(b2, 8);
                        b2 += __shfl(b1, (fq << 4) | 15);
                        const float e1 = __expf(b1), e2 = __expf(b2);
                        qi1[k] = zq1 * fsig(zq1) * e1; kt1[k] = (1.0f - f1) * __expf(fminf(-b1, 80.0f));
                        qi2[k] = zq2 * fsig(zq2) * e2; kt2[k] = (1.0f - f2) * __expf(fminf(-b2, 80.0f)); dc[k] = e2; }
                    *(u32x4*)(ARR + (size_t)row1 * 512 + cb) = pack8(qi1); *(u32x4*)(ARR + AS + (size_t)row1 * 512 + cb) = pack8(kt1);
                    *(u32x4*)(ARR + (size_t)row2 * 512 + cb) = pack8(qi2); *(u32x4*)(ARR + AS + (size_t)row2 * 512 + cb) = pack8(kt2);
                    if (fr == 15) { float* dp = DEC + (size_t)(row1 >> 5) * 512 + cb; *(f32x4*)dp = (f32x4){dc[0], dc[1], dc[2], dc[3]}; *(f32x4*)(dp + 4) = (f32x4){dc[4], dc[5], dc[6], dc[7]}; }
                    asm volatile("" ::: "memory"); }
        } else if (pn < 8) {
            const int cb = (pn - 4) * 128 + wc * 32 + 8 * fq;
#pragma unroll
            for (int ai = 0; ai < 2; ++ai)
#pragma unroll
                for (int m = 0; m < 4; ++m) { const int row = row0 + ai * HALF + m * 16; const float rs = rstd_of(row);
                    float iv[8], gv[8];
#pragma unroll
                    for (int k = 0; k < 8; ++k) { iv[k] = acc[ai][0][m][k >> 2][k & 3] * rs; const float zg = acc[ai][1][m][k >> 2][k & 3] * rs; gv[k] = zg * fsig(zg); }
                    *(u32x4*)(ARR + 2 * AS + (size_t)row * 512 + cb) = pack8(iv); *(u32x4*)(ARR + 3 * AS + (size_t)row * 512 + cb) = pack8(gv);
                    asm volatile("" ::: "memory"); }
        } else {
            const int ty = (pn - 8) >> 1, head = 4 * ((pn - 8) & 1) + wc; const int d0 = 8 * fq;
            bf16_t* dst = ARR + (size_t)(4 + ty) * AS;
            float gain[2][8]; float csum[2][8];
#pragma unroll
            for (int bj = 0; bj < 2; ++bj)
#pragma unroll
                for (int k = 0; k < 8; ++k) { gain[bj][k] = (ty == 0) ? qg[bj * 32 + d0 + k] * (0.125f * 1.4426950408889634f) : (ty == 1) ? kg[bj * 32 + d0 + k] : 1.0f; csum[bj][k] = 0.f; }
#pragma unroll
            for (int ai = 0; ai < 2; ++ai)
#pragma unroll
                for (int m = 0; m < 4; ++m) { const int row = row0 + ai * HALF + m * 16; const float rs = rstd_of(row);
                    float v[2][8];
#pragma unroll
                    for (int bj = 0; bj < 2; ++bj)
#pragma unroll
                        for (int k = 0; k < 8; ++k) v[bj][k] = acc[ai][bj][m][k >> 2][k & 3] * rs;
                    if (ty < 2) { float ss = 0.f;
#pragma unroll
                        for (int bj = 0; bj < 2; ++bj)
#pragma unroll
                            for (int k = 0; k < 8; ++k) ss += v[bj][k] * v[bj][k];
                        ss += __shfl_xor(ss, 16); ss += __shfl_xor(ss, 32);
                        const float r2 = 1.0f / sqrtf(ss * (1.0f / 64.0f) + 1e-6f);
#pragma unroll
                        for (int bj = 0; bj < 2; ++bj)
#pragma unroll
                            for (int k = 0; k < 8; ++k) { v[bj][k] *= r2 * gain[bj][k]; csum[bj][k] += v[bj][k]; }
                    } else if (ty == 3) {
#pragma unroll
                        for (int bj = 0; bj < 2; ++bj)
#pragma unroll
                            for (int k = 0; k < 8; ++k) v[bj][k] = v[bj][k] * fsig(v[bj][k]); }
                    *(u32x4*)(dst + (size_t)row * 512 + head * 64 + d0) = pack8(v[0]); *(u32x4*)(dst + (size_t)row * 512 + head * 64 + 32 + d0) = pack8(v[1]);
                    asm volatile("" ::: "memory"); }
            if (ty == 1) {
#pragma unroll
                for (int bj = 0; bj < 2; ++bj)
#pragma unroll
                    for (int k = 0; k < 8; ++k) { float s = csum[bj][k]; s += __shfl_xor(s, 1); s += __shfl_xor(s, 2); s += __shfl_xor(s, 4); s += __shfl_xor(s, 8); csum[bj][k] = s; }
                if (fr == 0) { float* kp = KPART + ((size_t)u.pm * 2 + wr) * 512 + head * 64 + d0;
#pragma unroll
                    for (int bj = 0; bj < 2; ++bj) { *(f32x4*)(kp + bj * 32) = (f32x4){csum[bj][0], csum[bj][1], csum[bj][2], csum[bj][3]}; *(f32x4*)(kp + bj * 32 + 4) = (f32x4){csum[bj][4], csum[bj][5], csum[bj][6], csum[bj][7]}; } }
            }
        }
    }
};
struct EpiOut {
    static constexpr bool PERM = false, AFTER_DRAIN = false;
    const float* xres; const bf16_t* xres16; float* out; bf16_t* xb; float* rowss;
    __device__ __forceinline__ void operator()(const f32x4 (&acc)[2][2][4][2], const Unit& u, int wr, int wc, int fr, int fq) const {
        const int col0 = u.pn * BM + wc * 32 + 4 * fq;
#pragma unroll
        for (int ai = 0; ai < 2; ++ai)
#pragma unroll
            for (int m = 0; m < 4; ++m) {
                const int row = u.pm * BM + ai * HALF + wr * 64 + m * 16 + fr; float ss = 0.f;
#pragma unroll
                for (int bj = 0; bj < 2; ++bj)
#pragma unroll
                    for (int n = 0; n < 2; ++n) { const size_t off = (size_t)row * 1024 + col0 + bj * HALF + n * 16;
                        f32x4 v;
                        if (xres) v = *(const f32x4*)(xres + off); else { const u32x2 r = *(const u32x2*)(xres16 + off); v = (f32x4){__builtin_bit_cast(float, r.x << 16), __builtin_bit_cast(float, r.x & 0xffff0000u), __builtin_bit_cast(float, r.y << 16), __builtin_bit_cast(float, r.y & 0xffff0000u)}; }
                        v = v + acc[ai][bj][m][n];
                        if (out) *(f32x4*)(out + off) = v;
                        if (xb) { u32x2 w; w.x = cvt_pk_bf16(v[0], v[1]); w.y = cvt_pk_bf16(v[2], v[3]); *(u32x2*)(xb + off) = w; }
                        ss += (v[0] * v[0] + v[1] * v[1]) + (v[2] * v[2] + v[3] * v[3]); }
                ss += __shfl_xor(ss, 16); ss += __shfl_xor(ss, 32);
                if (fq == 0 && rowss) rowss[(size_t)row * 16 + u.pn * 4 + wc] = ss;
            }
    }
};

template <class Epi, class Sched, bool ALIGN_EPI = false, bool SP2 = false>
__device__ __forceinline__ void gemm_phase(PG8_LAS unsigned char* lds, const Gemm g, const Sched& S, const Epi& E, const int wave0) {
    int tid = wave0 * 64 + lane_id_asm(); asm volatile("" : "+v"(tid));
    const int wid = __builtin_amdgcn_readfirstlane(tid >> 6), lane = tid & 63, wr = wid >> 2, wc = wid & 3, fr = lane & 15, fq = lane >> 4;
    const int K = g.K, nt = K / BK;
    unsigned voffA[2], voffB[2];
#pragma unroll
    for (int i = 0; i < 2; ++i) { int R, C; stage_rc(tid * 16 + i * 8192, R, C); const int Rb = Epi::PERM ? ((R & ~31) + perm32(R & 31)) : R;
        voffA[i] = (unsigned)(R * K + C) * 2u; voffB[i] = (unsigned)(Rb * K + C) * 2u; }
    const size_t kstep = (size_t)(BK * 2);
    const size_t hstep = (size_t)HALF * K * 2;
    const size_t tstep = 2 * hstep;
    const unsigned ldsw = (unsigned)wid * 1024u;
    const int aoff = lds_byte(wr * 64 + fr, fq * 8), boff = lds_byte(wc * 32 + fr, fq * 8);
#define PG8_SA(b, h) (((b) * 2 + (h)) * HTB)
#define PG8_SB(b, h) ((4 + (b) * 2 + (h)) * HTB)
#define PG8_STAGE(bufoff, gbase, voff) do { _Pragma("unroll") for (int _i = 0; _i < 2; ++_i) \
        __builtin_amdgcn_global_load_lds((const unsigned*)((const char*)(gbase) + (voff)[_i]), (PG8_LAS unsigned*)(lds + (bufoff) + ldsw + _i * 8192), 16, 0, 0); } while (0)
#define PG8_LDA(dst, b, h) do { _Pragma("unroll") for (int m = 0; m < 4; ++m) _Pragma("unroll") for (int k = 0; k < 2; ++k) dst[m][k] = *(const PG8_LAS bf16x8*)(lds + PG8_SA(b, h) + aoff + m * 2048 + k * 1024); } while (0)
#define PG8_LDB(dst, b, h) do { _Pragma("unroll") for (int n = 0; n < 2; ++n) _Pragma("unroll") for (int k = 0; k < 2; ++k) dst[n][k] = *(const PG8_LAS bf16x8*)(lds + PG8_SB(b, h) + boff + n * 2048 + k * 1024); } while (0)
#define PG8_MMA(ai, bj, At, Bt) do { __builtin_amdgcn_s_setprio(1); _Pragma("unroll") for (int m = 0; m < 4; ++m) _Pragma("unroll") for (int n = 0; n < 2; ++n) _Pragma("unroll") for (int k = 0; k < 2; ++k) \
        acc[ai][bj][m][n] = __builtin_amdgcn_mfma_f32_16x16x32_bf16(Bt[n][k], At[m][k], acc[ai][bj][m][n], 0, 0, 0); __builtin_amdgcn_s_setprio(0); } while (0)
#define PG8_WAIT_V(n) asm volatile("s_waitcnt vmcnt(" #n ")" ::: "memory")
#define PG8_WAIT_L(n) asm volatile("s_waitcnt lgkmcnt(" #n ")" ::: "memory")
#define PG8_BAR __builtin_amdgcn_s_barrier()
#define PG8_SCHED __builtin_amdgcn_sched_barrier(0)
    Unit cur, nxt; int ui = 0;
    if (!S.next(0, cur)) return;
    f32x4 acc[2][2][4][2];
#pragma unroll
    for (int a = 0; a < 2; ++a)
#pragma unroll
        for (int b = 0; b < 2; ++b)
#pragma unroll
            for (int m = 0; m < 4; ++m)
#pragma unroll
                for (int n = 0; n < 2; ++n) acc[a][b][m][n] = (f32x4){0.f, 0.f, 0.f, 0.f};
    bf16x8 At[4][2], B0[2][2], B1[2][2];
    const char* cA = (const char*)g.A + (size_t)cur.pm * tstep; const char* cB = (const char*)g.Bt + (size_t)cur.pn * tstep;
    S.a_ready(cur);
    if constexpr (SP2) {
        PG8_STAGE(PG8_SB(0, 0), cB, voffB); PG8_STAGE(PG8_SB(0, 1), cB + hstep, voffB); PG8_STAGE(PG8_SA(0, 0), cA, voffA); PG8_STAGE(PG8_SA(0, 1), cA + hstep, voffA);
        if (wr == 1) PG8_BAR;
        PG8_WAIT_V(2); PG8_BAR;
        PG8_STAGE(PG8_SB(1, 0), cB + kstep, voffB); PG8_STAGE(PG8_SA(1, 0), cA + kstep, voffA); PG8_STAGE(PG8_SB(1, 1), cB + hstep + kstep, voffB);
        PG8_WAIT_V(6); PG8_BAR;
    } else {
        PG8_STAGE(PG8_SB(0, 0), cB, voffB); PG8_STAGE(PG8_SA(0, 0), cA, voffA); PG8_STAGE(PG8_SB(0, 1), cB + hstep, voffB); PG8_STAGE(PG8_SA(0, 1), cA + hstep, voffA);
        if (wr == 1) PG8_BAR;
        PG8_WAIT_V(4); PG8_BAR;
        PG8_STAGE(PG8_SB(1, 0), cB + kstep, voffB); PG8_STAGE(PG8_SA(1, 0), cA + kstep, voffA); PG8_STAGE(PG8_SB(1, 1), cB + hstep + kstep, voffB);
        PG8_WAIT_V(6); PG8_BAR;
    }
    for (;;) {
        const bool has_next = S.next(ui + 1, nxt);
        const char* nA = has_next ? (const char*)g.A + (size_t)nxt.pm * tstep : cA; const char* nB = has_next ? (const char*)g.Bt + (size_t)nxt.pn * tstep : cB;
        for (int t = 0; t < nt; t += 2) {
            const bool last = (t == nt - 2);
            const char* a1 = cA + (size_t)(t + 1) * kstep;
            const char* a2 = last ? nA : cA + (size_t)(t + 2) * kstep; const char* b2 = last ? nB : cB + (size_t)(t + 2) * kstep;
            const char* a3 = a2 + kstep; const char* b3 = b2 + kstep;
            if (last && has_next) S.a_ready(nxt);
            if constexpr (SP2) {
            PG8_LDB(B0, 0, 0); PG8_LDB(B1, 0, 1); PG8_SCHED; PG8_LDA(At, 0, 0); PG8_STAGE(PG8_SA(1, 1), a1 + hstep, voffA);
            PG8_WAIT_V(8); PG8_WAIT_L(0); PG8_BAR; PG8_MMA(0, 0, At, B0); PG8_MMA(0, 1, At, B1); PG8_BAR; PG8_SCHED;
            PG8_LDA(At, 0, 1); PG8_STAGE(PG8_SB(0, 0), b2, voffB); PG8_STAGE(PG8_SB(0, 1), b2 + hstep, voffB); PG8_STAGE(PG8_SA(0, 0), a2, voffA);
            PG8_WAIT_V(8); PG8_WAIT_L(0); PG8_BAR; PG8_MMA(1, 0, At, B0); PG8_MMA(1, 1, At, B1); PG8_BAR; PG8_SCHED;
            PG8_LDB(B0, 1, 0); PG8_LDB(B1, 1, 1); PG8_SCHED; PG8_LDA(At, 1, 0); PG8_STAGE(PG8_SA(0, 1), a2 + hstep, voffA);
            PG8_WAIT_V(8); PG8_WAIT_L(0); PG8_BAR; PG8_MMA(0, 0, At, B0); PG8_MMA(0, 1, At, B1); PG8_BAR; PG8_SCHED;
            PG8_LDA(At, 1, 1); PG8_STAGE(PG8_SB(1, 0), b3, voffB); PG8_STAGE(PG8_SB(1, 1), b3 + hstep, voffB); PG8_STAGE(PG8_SA(1, 0), a3, voffA);
            PG8_WAIT_V(8); PG8_WAIT_L(0); PG8_BAR; PG8_MMA(1, 0, At, B0); PG8_MMA(1, 1, At, B1); PG8_BAR; PG8_SCHED;
            } else {
            PG8_LDB(B0, 0, 0); PG8_SCHED; PG8_LDA(At, 0, 0); PG8_STAGE(PG8_SA(1, 1), a1 + hstep, voffA);
            PG8_WAIT_L(8); PG8_BAR; PG8_WAIT_L(0); PG8_MMA(0, 0, At, B0); PG8_BAR; PG8_SCHED;
            PG8_LDB(B1, 0, 1); PG8_STAGE(PG8_SB(0, 0), b2, voffB);
            PG8_BAR; PG8_WAIT_L(0); PG8_MMA(0, 1, At, B1); PG8_BAR;
            PG8_LDA(At, 0, 1); PG8_STAGE(PG8_SA(0, 0), a2, voffA);
            PG8_BAR; PG8_WAIT_L(0); PG8_MMA(1, 0, At, B0); PG8_BAR; PG8_SCHED;
            PG8_STAGE(PG8_SB(0, 1), b2 + hstep, voffB);
            PG8_WAIT_V(6); PG8_BAR; PG8_MMA(1, 1, At, B1); PG8_BAR;
            PG8_LDB(B0, 1, 0); PG8_SCHED; PG8_LDA(At, 1, 0); PG8_STAGE(PG8_SA(0, 1), a2 + hstep, voffA);
            PG8_WAIT_L(8); PG8_BAR; PG8_WAIT_L(0); PG8_MMA(0, 0, At, B0); PG8_BAR; PG8_SCHED;
            PG8_LDB(B1, 1, 1); PG8_STAGE(PG8_SB(1, 0), b3, voffB);
            PG8_BAR; PG8_WAIT_L(0); PG8_MMA(0, 1, At, B1); PG8_BAR;
            PG8_LDA(At, 1, 1); PG8_STAGE(PG8_SA(1, 0), a3, voffA);
            PG8_BAR; PG8_WAIT_L(0); PG8_MMA(1, 0, At, B0); PG8_BAR; PG8_SCHED;
            PG8_STAGE(PG8_SB(1, 1), b3 + hstep, voffB);
            PG8_WAIT_V(6); PG8_BAR; PG8_MMA(1, 1, At, B1); PG8_BAR;
            }
        }
        if constexpr (ALIGN_EPI) { if (wr == 0) PG8_BAR; }
        if constexpr (!Epi::AFTER_DRAIN) { E(acc, cur, wr, wc, fr, fq); S.done(cur); }
        if (!has_next) break;
#pragma unroll
        for (int a = 0; a < 2; ++a)
#pragma unroll
            for (int b = 0; b < 2; ++b)
#pragma unroll
                for (int m = 0; m < 4; ++m)
#pragma unroll
                    for (int n = 0; n < 2; ++n) acc[a][b][m][n] = (f32x4){0.f, 0.f, 0.f, 0.f};
        cur = nxt; cA = nA; cB = nB; ++ui;
        if constexpr (ALIGN_EPI) { if (wr == 1) PG8_BAR; }
    }
    PG8_WAIT_V(0);
    if constexpr (!ALIGN_EPI) { if (wr == 0) PG8_BAR; }
    PG8_BAR;
    if constexpr (Epi::AFTER_DRAIN) { E.fused(acc, cur, wr, wc, fr, fq, lds, wid, lane); S.done(cur); }
#undef PG8_SA
#undef PG8_SB
#undef PG8_STAGE
#undef PG8_LDA
#undef PG8_LDB
#undef PG8_MMA
#undef PG8_WAIT_V
#undef PG8_WAIT_L
#undef PG8_BAR
#undef PG8_SCHED
}
}


constexpr int NWAVES = 8;
#ifndef MK_N_LAUNCHES
#define MK_N_LAUNCHES 1
#endif
constexpr int N_PHASES = 7;
constexpr int N_LAUNCHES = MK_N_LAUNCHES;

constexpr int BATCH = 16, SEQ = 2048, DM = 1024, DEPTH = 2, MTOK = BATCH * SEQ, NIN = 4096;
constexpr int C_HQ = 0, C_HF = 512, C_HI = 1024, C_HG = 1536, C_AQ = 2048, C_AK = 2560, C_AV = 3072, C_AG = 3584;
constexpr float NORM_EPS = 1e-6f;

constexpr size_t MiB = 1u << 20;
constexpr size_t WS_CTL = 0, CTL_ZERO_BYTES = 1 * MiB;
constexpr size_t WS_WIN = 2 * MiB;
constexpr size_t WS_WOUT = 18 * MiB;
constexpr size_t WS_LB = 22 * MiB;
constexpr size_t WS_KPART = 22 * MiB + 65536;
constexpr size_t WS_ROWSS = 24 * MiB;
constexpr size_t WS_DEC = 28 * MiB;
constexpr size_t WS_XB = 32 * MiB;
constexpr size_t WS_MIXED = 160 * MiB;
constexpr size_t WS_ARR = 224 * MiB;
constexpr size_t ARR_BYTES = 32 * MiB;
constexpr size_t WS_END = 480 * MiB;
constexpr int CW_QUEUE = 1024;
constexpr int CW_BAR = 4096;

constexpr int RING_OFF = 0, RING_BYTES = 131072;
constexpr int EXTRA_OFF = RING_BYTES, EXTRA_BYTES = 16384;
constexpr int LDSCTL_OFF = EXTRA_OFF + EXTRA_BYTES, MISC_OFF = LDSCTL_OFF + 320;
constexpr int LDS_BYTES = LDSCTL_OFF + 1024;

#define GAS __attribute__((address_space(1)))
#define LAS __attribute__((address_space(3)))
typedef unsigned short bf16;
typedef unsigned v4u __attribute__((ext_vector_type(4)));
typedef float f32x4 __attribute__((ext_vector_type(4)));
typedef GAS unsigned gu32;
#define RLX_AGENT __ATOMIC_RELAXED, __HIP_MEMORY_SCOPE_AGENT
#define LDS_WAIT() asm volatile("s_waitcnt lgkmcnt(0)" ::: "memory")
#define VM_WAIT() asm volatile("s_waitcnt vmcnt(0)" ::: "memory")
__device__ __forceinline__ unsigned f2bf(float f) { unsigned u = __builtin_bit_cast(unsigned, f); return (u + 0x7fffu + ((u >> 16) & 1u)) >> 16; }
__device__ __forceinline__ unsigned pk2(float lo, float hi) { return f2bf(lo) | (f2bf(hi) << 16); }
__device__ __forceinline__ float bf2f(unsigned short b) { return __builtin_bit_cast(float, (unsigned)b << 16); }
__device__ __forceinline__ float bflo(unsigned w) { return __builtin_bit_cast(float, w << 16); }
__device__ __forceinline__ float bfhi(unsigned w) { return __builtin_bit_cast(float, w & 0xffff0000u); }
__device__ __forceinline__ float silu_f(float z) { return z / (1.0f + __expf(-z)); }
__device__ __forceinline__ float sigmoid_f(float z) { return 1.0f / (1.0f + __expf(-z)); }

#define XB_TMO      128
#define XB_XCNT(j)  (256  + 64 * (j))
#define XB_XSUB(j)  (1280 + 64 * (j))
#define XB_XGEN(j)  (2304 + 64 * (j))
#define XB_TOP      3328
#define XB_TOPGEN   3392
#define XCD_BAR_WORDS 3456
#define XB_SPIN_CAP (1u << 18)

__device__ __forceinline__ unsigned xb_ld(unsigned* p)              { return __hip_atomic_load(p, __ATOMIC_RELAXED, __HIP_MEMORY_SCOPE_AGENT); }
__device__ __forceinline__ unsigned xb_add(unsigned* p, unsigned v) { return __hip_atomic_fetch_add(p, v, __ATOMIC_RELAXED, __HIP_MEMORY_SCOPE_AGENT); }
__device__ __forceinline__ unsigned xb_xcc_id() { return (unsigned)__builtin_amdgcn_s_getreg((3 << 11) | 20) & 0xFu; }
#define XB_SPIN(cond, bar) do { unsigned _sp = 0; while (cond) { __builtin_amdgcn_s_sleep(1); \
    if ((++_sp & 255u) == 0u) { if (xb_ld(&(bar)[XB_TMO])) break; if (_sp > XB_SPIN_CAP) { atomicAdd(&(bar)[XB_TMO], 1u); break; } } } } while (0)

struct XcdBarrier {
    unsigned* bar; unsigned x; int wave0;
    volatile LAS unsigned* st;
};

#define XB_IS_T0(wv) ((wv) == 0 && lane_id_asm() == 0)
__device__ __forceinline__ XcdBarrier xcd_barrier_post(unsigned* bar, volatile LAS unsigned* st, int wave0) {
    XcdBarrier b; b.bar = bar; b.x = xb_xcc_id(); b.st = st; b.wave0 = wave0;
    if (XB_IS_T0(wave0)) (void)xb_add(&bar[XB_XCNT(b.x)], 1u);
    return b;
}
__device__ __forceinline__ void xcd_barrier_complete(unsigned* bar, unsigned x, unsigned& nloc, unsigned& nx) {
    const unsigned G = gridDim.x * gridDim.y * gridDim.z;
    unsigned sum, cnt, mine, sp = 0u;
    for (;;) {
        sum = 0u; cnt = 0u; mine = 0u;
#pragma unroll
        for (unsigned j = 0; j < 16; ++j) { const unsigned c = xb_ld(&bar[XB_XCNT(j)]); sum += c; cnt += (c > 0u) ? 1u : 0u; mine = (j == x) ? c : mine; }
        if (sum == G) break;
        __builtin_amdgcn_s_sleep(1);
        if ((++sp & 255u) == 0u) { if (xb_ld(&bar[XB_TMO])) break; if (sp > XB_SPIN_CAP) { atomicAdd(&bar[XB_TMO], 1u); break; } }
    }
    nloc = mine > 0u ? mine : 1u; nx = cnt > 0u ? cnt : 1u;
}

__device__ __forceinline__ void xcd_barrier(const XcdBarrier& b) {
    asm volatile("s_waitcnt vmcnt(0)" ::: "memory");
    __syncthreads();
    if (XB_IS_T0(b.wave0)) {
        unsigned* bar = b.bar;
        __builtin_amdgcn_s_waitcnt(0);
        unsigned nloc = b.st[0], nx = b.st[1];
        if (nloc == 0u) { xcd_barrier_complete(bar, b.x, nloc, nx); b.st[0] = nloc; b.st[1] = nx; }
        const unsigned old = xb_add(&bar[XB_XSUB(b.x)], 1u);
        const unsigned gen = old / nloc;
        if (old + 1u == (gen + 1u) * nloc) {
            __builtin_amdgcn_fence(__ATOMIC_RELEASE, "agent");
            asm volatile("s_waitcnt vmcnt(0)" ::: "memory");
            const unsigned og = xb_add(&bar[XB_TOP], 1u);
            const unsigned tg = og / nx;
            if (og + 1u == (tg + 1u) * nx) xb_add(&bar[XB_TOPGEN], 1u);
            else XB_SPIN(xb_ld(&bar[XB_TOPGEN]) == tg, bar);
            __builtin_amdgcn_fence(__ATOMIC_ACQUIRE, "agent");
            xb_add(&bar[XB_XGEN(b.x)], 1u);
            asm volatile("s_waitcnt vmcnt(0)" ::: "memory");
        } else {
            XB_SPIN(xb_ld(&bar[XB_XGEN(b.x)]) == gen, bar);
            __builtin_amdgcn_fence(__ATOMIC_ACQUIRE, "agent");
            asm volatile("s_waitcnt vmcnt(0)" ::: "memory");
        }
    }
    __syncthreads();
}


struct Frame {
    LAS unsigned char* lds;
    volatile LAS unsigned* MISC;
    int wave0;
    gu32* ctl;
    int vcu, G;
    const float* x; float* out;
    const float *norm_w, *w_in, *lb_logits, *hg_norm_w, *q_norm_w, *k_norm_w, *w_out;
    bf16 *WIN, *WOUT, *XB, *MIXED, *QI, *KT, *HI, *GH, *QN, *KN, *V, *GA;
    float *LB, *KPART, *ROWSS, *DEC;
};

__device__ __forceinline__ float wave_sum(float v) {
#pragma unroll
    for (int o = 1; o < 64; o <<= 1) v += __shfl_xor(v, o);
    return v;
}
__device__ __forceinline__ int win_dest(int oc) {
    if (oc < 2048) { const int grp = oc >> 9, hh = (oc >> 7) & 3, w = oc & 127; return 256 * (((grp >> 1) << 2) + hh) + 128 * (grp & 1) + w; }
    const int ty = (oc - 2048) >> 9, head = (oc >> 6) & 7, bj = (oc >> 5) & 1; return 256 * (8 + 2 * ty + (head >> 2)) + 128 * bj + 32 * (head & 3);
}
__device__ __forceinline__ void p0_transpose_item(const float* W, int K, int N, bf16* WT, const float* kscale, LAS float* scr, int item, int lane, bool permute) {
    const int nblk = N / 32, kb = item / nblk, nb = item % nblk, k0 = 64 * kb, n0 = 32 * nb; const int nd = permute ? win_dest(n0) : n0;
#pragma unroll 8
    for (int i = 0; i < 32; ++i) { const int kk = 2 * i + (lane >> 5); const float s = kscale ? kscale[k0 + kk] : 1.0f; scr[kk * 33 + (lane & 31)] = W[(size_t)(k0 + kk) * N + n0 + (lane & 31)] * s; }
    LDS_WAIT(); asm volatile("" ::: "memory");
    const int c = lane & 7;
#pragma unroll
    for (int j = 0; j < 4; ++j) { const int n = (lane >> 3) + 8 * j; const LAS float* s = scr + (8 * c) * 33 + n;
        v4u o; o.x = pk2(s[0 * 33], s[1 * 33]); o.y = pk2(s[2 * 33], s[3 * 33]); o.z = pk2(s[4 * 33], s[5 * 33]); o.w = pk2(s[6 * 33], s[7 * 33]);
        *(GAS v4u*)(WT + (size_t)(nd + n) * K + k0 + 8 * c) = o; }
    LDS_WAIT(); asm volatile("" ::: "memory");
}
#define PHASE_IDS() int t_ = F.wave0 * 64 + lane_id_asm(); asm volatile("" : "+v"(t_)); const int tid = t_, lane = tid & 63, wave = __builtin_amdgcn_readfirstlane(tid >> 6); (void)lane; (void)wave
__device__ __forceinline__ void p0_prologue(Frame& F) {
    PHASE_IDS();
    LAS float* scr = (LAS float*)(F.lds + RING_OFF + wave * 16384);
    const int gw = F.vcu * NWAVES + wave, NGW = F.G * NWAVES;
    constexpr int I_IN = (DM / 64) * (NIN / 32), I_OUT = (DM / 64) * (DM / 32);
    constexpr int NITEMS = DEPTH * (I_IN + I_OUT);
    for (int it = gw; it < NITEMS; it += NGW) {
        int r = it;
        if (r < DEPTH * I_IN) { const int l = r / I_IN; r -= l * I_IN;
            p0_transpose_item(F.w_in + (size_t)l * DM * NIN, DM, NIN, F.WIN + (size_t)l * NIN * DM, F.norm_w + l * DM, scr, r, lane, true); continue; }
        r -= DEPTH * I_IN; { const int l = r / I_OUT; r -= l * I_OUT;
            p0_transpose_item(F.w_out + (size_t)l * DM * DM, DM, DM, F.WOUT + (size_t)l * DM * DM, nullptr, scr, r, lane, false); }
    }
    for (int m = gw; m < MTOK; m += NGW) {
        const GAS f32x4* xr = (const GAS f32x4*)(F.x + (size_t)m * DM) + lane;
        f32x4 v[4]; float s = 0.f;
#pragma unroll
        for (int j = 0; j < 4; ++j) { v[j] = xr[64 * j]; s += (v[j].x * v[j].x + v[j].y * v[j].y) + (v[j].z * v[j].z + v[j].w * v[j].w); }
        s = wave_sum(s);
        GAS unsigned long long* o8 = (GAS unsigned long long*)(F.XB + (size_t)m * DM) + lane;
#pragma unroll
        for (int j = 0; j < 4; ++j) o8[64 * j] = (unsigned long long)pk2(v[j].x, v[j].y) | ((unsigned long long)pk2(v[j].z, v[j].w) << 32);
        if (lane < 16) F.ROWSS[(size_t)m * 16 + lane] = (lane == 0) ? s : 0.f;
    }
    if (blockIdx.x == 0) { const int c = tid; const float a0 = F.lb_logits[c], a1 = F.lb_logits[512 + c]; const float mx = fmaxf(a0, a1);
        const float e0 = expf(a0 - mx), e1 = expf(a1 - mx); const float p0 = e0 / (e0 + e1), p1 = e1 / (e0 + e1);
        F.LB[c] = 0.f; F.LB[512 + c] = fminf(fmaxf((p0 + p1) - p0, 0.f), 1.0f - 1e-6f); }
}

constexpr float LOG2E = 1.4426950408889634f;
constexpr float QSCALE2 = 0.125f * LOG2E;
namespace moba {
typedef short bf16x8 __attribute__((ext_vector_type(8)));
typedef short s16x4 __attribute__((ext_vector_type(4)));
typedef float f32x16 __attribute__((ext_vector_type(16)));
typedef float f32x2_t __attribute__((ext_vector_type(2))); typedef __bf16 bf16x2_t __attribute__((ext_vector_type(2)));
__device__ __forceinline__ unsigned cvtpk(float lo, float hi) { f32x2_t v = {lo, hi}; bf16x2_t b = __builtin_convertvector(v, bf16x2_t); return __builtin_bit_cast(unsigned, b); }
__device__ __forceinline__ int crow(int r, int hi) { return (r & 3) + 8 * (r >> 2) + 4 * hi; }
constexpr int L_K = 0, L_V = 24576, L_WSF = 49152, L_KM = 51200, L_OST = 53248;
constexpr float NEG_BIG = -1e30f;
constexpr float THR = 8.0f;
__device__ __forceinline__ s16x4 vtr(const LAS unsigned char* p) { return __builtin_bit_cast(s16x4, __builtin_amdgcn_ds_read_tr16_b64_v4i16((LAS s16x4*)p)); }
}

__device__ __forceinline__ void moba_mfma_phase(Frame& F, int l) {
    using namespace moba;
    PHASE_IDS();
    const int r32 = lane & 31, hi = lane >> 5, wid = wave;
    LAS unsigned char* L = F.lds + RING_OFF;
    LAS float* wsf = (LAS float*)(L + L_WSF) + wid * 64;
    LAS float* km = (LAS float*)(L + L_KM);
    LAS float* ost = (LAS float*)(L + L_OST) + wid * 2048;
    float gq = fabsf(F.q_norm_w[l * 64 + lane]), gk = fabsf(F.k_norm_w[l * 64 + lane]);
#pragma unroll
    for (int o = 1; o < 64; o <<= 1) { gq = fmaxf(gq, __shfl_xor(gq, o)); gk = fmaxf(gk, __shfl_xor(gk, o)); }
    gq = __builtin_bit_cast(float, __builtin_amdgcn_readfirstlane(__builtin_bit_cast(int, gq))); gk = __builtin_bit_cast(float, __builtin_amdgcn_readfirstlane(__builtin_bit_cast(int, gk)));
    const float smax2 = 8.0f * gq * gk * LOG2E * 1.02f;
    const float mhat0 = -(smax2 + 1.0f);
    gu32* qctr = F.ctl + CW_QUEUE + 64 * l;
    volatile LAS unsigned* tick = (volatile LAS unsigned*)(F.lds + EXTRA_OFF + 8192);
    for (;;) {
        __syncthreads();
        if (tid == 0) tick[0] = __hip_atomic_fetch_add(qctr, 1u, RLX_AGENT);
        __syncthreads();
        const int it = __builtin_amdgcn_readfirstlane((int)tick[0]); if (it >= 1024) break;
        const int qb = 7 - (it >> 7), bh = it & 127;
        const int b = bh >> 3, h = bh & 7; const size_t rowbase = (size_t)b * SEQ; const int q0 = qb * 256, qrel = wid * 32 + r32, tq = q0 + qrel;
        const float sl2 = exp2f(-(float)(h + 1)) * LOG2E;
        bf16x8 qr[4];
        { const GAS bf16* Qw = (const GAS bf16*)(F.QN + (rowbase + q0 + wid * 32 + r32) * 512 + h * 64 + hi * 8);
#pragma unroll
            for (int d0 = 0; d0 < 4; ++d0) qr[d0] = *(const GAS bf16x8*)(Qw + d0 * 16); }
        if (tid < qb * 64) { const GAS float* kp = (const GAS float*)(F.KPART + ((size_t)b * 8 + (tid >> 6)) * 1024 + h * 64 + (tid & 63)); km[tid] = (kp[0] + kp[512]) * (1.0f / 256.0f); }
        const GAS bf16* ksrc = (const GAS bf16*)(F.KN + (rowbase + lane) * 512 + h * 64 + wid * 8);
        const GAS bf16* vsrc = (const GAS bf16*)(F.V + (rowbase + (tid >> 3)) * 512 + h * 64 + (tid & 7) * 8);
        const int kdst = L_K + wid * 1024 + lane * 16;
        const int vrow = tid >> 3, vch = tid & 7;
        const int vdst = L_V + vrow * 128 + (((vch >> 2) ^ ((vrow >> 1) & 1)) * 64) + (vch & 3) * 16;
        const int NT = 4 * (qb + 1);
        int t0 = 0; { const float dstar = (151.0f + 2.0f * smax2) / sl2; const float x = ((float)(q0 - 63) - dstar) * (1.0f / 64.0f); if (x > 0.f) t0 = ((int)x) & ~1; if (t0 > NT - 4) t0 = NT - 4; t0 = __builtin_amdgcn_readfirstlane(t0); }
        v4u kA = *(const GAS v4u*)(ksrc + (size_t)t0 * 64 * 512), vA = *(const GAS v4u*)(vsrc + (size_t)t0 * 64 * 512);
        v4u kB = *(const GAS v4u*)(ksrc + (size_t)(t0 + 1) * 64 * 512), vB = *(const GAS v4u*)(vsrc + (size_t)(t0 + 1) * 64 * 512);
        __syncthreads();
        *(LAS v4u*)(L + kdst) = kA; *(LAS v4u*)(L + vdst) = vA; *(LAS v4u*)(L + 8192 + kdst) = kB; *(LAS v4u*)(L + 8192 + vdst) = vB;
        kA = *(const GAS v4u*)(ksrc + (size_t)(t0 + 2) * 64 * 512); vA = *(const GAS v4u*)(vsrc + (size_t)(t0 + 2) * 64 * 512);
        kB = *(const GAS v4u*)(ksrc + (size_t)(t0 + 3) * 64 * 512); vB = *(const GAS v4u*)(vsrc + (size_t)(t0 + 3) * 64 * 512);
        unsigned selmask = 0;
        { float gt[7];
#pragma unroll
            for (int j = 0; j < 7; ++j) { float s = 0.f;
                if (j < qb) {
#pragma unroll
                    for (int d0 = 0; d0 < 4; ++d0)
#pragma unroll
                        for (int e = 0; e < 8; ++e) s += bf2f((unsigned short)qr[d0][e]) * km[j * 64 + d0 * 16 + hi * 8 + e];
                    auto rr = __builtin_amdgcn_permlane32_swap(__float_as_uint(s), __float_as_uint(s), false, false);
                    s = __uint_as_float(rr[0]) + __uint_as_float(rr[1]); }
                gt[j] = s; }
#pragma unroll
            for (int j = 0; j < 7; ++j) { int rank = 0;
#pragma unroll
                for (int i = 0; i < 7; ++i) if (i != j && i < qb) rank += (gt[i] > gt[j] || (gt[i] == gt[j] && i < j)) ? 1 : 0;
                if (j < qb && rank < 3) selmask |= 1u << j; } }
        float mhat = mhat0, l_reg = 0.f; f32x16 o[2]; o[0] = f32x16{}; o[1] = f32x16{};
        const int kbase = L_K + hi * 1024 + r32 * 16;
        const int g16 = lane >> 4, i16 = lane & 15, tq4 = i16 >> 2, tp4 = i16 & 3;
        const int vrow0 = 4 * hi + tq4;
        __syncthreads();
#define MOBA_QK(TT, KOFF, P0, P1) do { \
            const int blk_ = (TT) >> 2; const bool own_ = (blk_ == qb); \
            if (!(own_ && (64 * ((TT) & 3) > 32 * wid + 31))) { \
                const bool sel_ = own_ || ((selmask >> blk_) & 1u); \
                const float sc0_ = sel_ ? (-mhat - sl2 * (float)(tq - 64 * (TT) - 4 * hi)) : NEG_BIG; \
_Pragma("unroll") \
                for (int r = 0; r < 16; ++r) { P0[r] = __builtin_fmaf(sl2, (float)((r & 3) + 8 * (r >> 2)), sc0_); P1[r] = __builtin_fmaf(sl2, (float)(32 + (r & 3) + 8 * (r >> 2)), sc0_); } \
_Pragma("unroll") \
                for (int d0 = 0; d0 < 4; ++d0) { \
                    const bf16x8 b0 = *(const LAS bf16x8*)(L + (KOFF) + kbase + d0 * 2048); \
                    const bf16x8 b1 = *(const LAS bf16x8*)(L + (KOFF) + kbase + d0 * 2048 + 512); \
                    P0 = __builtin_amdgcn_mfma_f32_32x32x16_bf16(b0, qr[d0], P0, 0, 0, 0); \
                    P1 = __builtin_amdgcn_mfma_f32_32x32x16_bf16(b1, qr[d0], P1, 0, 0, 0); } \
            } } while (0)
#define MOBA_SMPV(TT, VOFF, P0, P1, HAVE_NEXT, N0, N1) do { \
            const int blk = (TT) >> 2; const bool own = (blk == qb); const int jb = (TT) & 3; \
            if (!(own && (64 * jb > 32 * wid + 31))) { \
                if (own && (64 * jb + 63 > 32 * wid)) { \
_Pragma("unroll") \
                    for (int r = 0; r < 16; ++r) { const int kvl = 64 * jb + crow(r, hi); if (kvl > qrel) P0[r] = NEG_BIG; if (kvl + 32 > qrel) P1[r] = NEG_BIG; } } \
                float rm = fmaxf(P0[0], P1[0]); \
_Pragma("unroll") \
                for (int r = 1; r < 16; ++r) rm = fmaxf(rm, fmaxf(P0[r], P1[r])); \
                { auto rr = __builtin_amdgcn_permlane32_swap(__float_as_uint(rm), __float_as_uint(rm), false, false); rm = fmaxf(__uint_as_float(rr[0]), __uint_as_float(rr[1])); } \
                if (__any(rm > THR)) { \
                    const float dl = fmaxf(rm, 0.f); mhat += dl; \
_Pragma("unroll") \
                    for (int r = 0; r < 16; ++r) { P0[r] -= dl; P1[r] -= dl; } \
                    if (HAVE_NEXT) { \
_Pragma("unroll") \
                        for (int r = 0; r < 16; ++r) { N0[r] -= dl; N1[r] -= dl; } } \
                    const float f = __builtin_amdgcn_exp2f(-dl); l_reg *= f; \
                    if (hi == 0) wsf[r32] = f; \
_Pragma("unroll") \
                    for (int r = 0; r < 16; ++r) { const float fr = wsf[crow(r, hi)]; o[0][r] *= fr; o[1][r] *= fr; } } \
                float sacc = 0.f; \
_Pragma("unroll") \
                for (int r = 0; r < 16; ++r) { P0[r] = __builtin_amdgcn_exp2f(P0[r]); P1[r] = __builtin_amdgcn_exp2f(P1[r]); sacc += P0[r] + P1[r]; } \
                l_reg += sacc; \
                bf16x8 pa[4]; \
                { v4u w; \
_Pragma("unroll") \
                    for (int ks = 0; ks < 4; ++ks) { \
_Pragma("unroll") \
                        for (int e = 0; e < 4; ++e) { const int rb = (ks & 1) * 8 + 2 * e; w[e] = (ks < 2) ? cvtpk(P0[rb], P0[rb + 1]) : cvtpk(P1[rb], P1[rb + 1]); } \
                        pa[ks] = __builtin_bit_cast(bf16x8, w); } } \
_Pragma("unroll") \
                for (int dblk = 0; dblk < 2; ++dblk) \
_Pragma("unroll") \
                    for (int ks = 0; ks < 4; ++ks) { \
                        const int rlo = 16 * ks + vrow0, rhi = rlo + 8; \
                        const int alo = L_V + (VOFF) + rlo * 128 + ((dblk ^ ((rlo >> 1) & 1)) * 64) + (16 * (g16 & 1) + 4 * tp4) * 2; \
                        const int ahi = L_V + (VOFF) + rhi * 128 + ((dblk ^ ((rhi >> 1) & 1)) * 64) + (16 * (g16 & 1) + 4 * tp4) * 2; \
                        const s16x4 lo = vtr(L + alo), hh = vtr(L + ahi); \
                        const bf16x8 vf = (bf16x8){lo[0], lo[1], lo[2], lo[3], hh[0], hh[1], hh[2], hh[3]}; \
                        o[dblk] = __builtin_amdgcn_mfma_f32_32x32x16_bf16(pa[ks], vf, o[dblk], 0, 0, 0); } \
            } } while (0)
        f32x16 pA0, pA1, pB0, pB1;
        MOBA_QK(t0, 0, pA0, pA1);
        int c0o = 0;
        for (int t = t0; t < NT; t += 2) {
            const int c1o = (c0o == 2) ? 0 : c0o + 1, c2o = (c1o == 2) ? 0 : c1o + 1;
            MOBA_QK(t + 1, (c1o * 8192), pB0, pB1);
            MOBA_SMPV(t, (c0o * 8192), pA0, pA1, true, pB0, pB1);
            if (t + 2 < NT) { *(LAS v4u*)(L + c2o * 8192 + kdst) = kA; *(LAS v4u*)(L + c2o * 8192 + vdst) = vA; }
            if (t + 4 < NT) { kA = *(const GAS v4u*)(ksrc + (size_t)(t + 4) * 64 * 512); vA = *(const GAS v4u*)(vsrc + (size_t)(t + 4) * 64 * 512); }
            __syncthreads();
            if (t + 2 < NT) MOBA_QK(t + 2, (c2o * 8192), pA0, pA1);
            MOBA_SMPV(t + 1, (c1o * 8192), pB0, pB1, (t + 2 < NT), pA0, pA1);
            if (t + 3 < NT) { *(LAS v4u*)(L + c0o * 8192 + kdst) = kB; *(LAS v4u*)(L + c0o * 8192 + vdst) = vB; }
            if (t + 5 < NT) { kB = *(const GAS v4u*)(ksrc + (size_t)(t + 5) * 64 * 512); vB = *(const GAS v4u*)(vsrc + (size_t)(t + 5) * 64 * 512); }
            __syncthreads();
            c0o = c2o;
        }
#undef MOBA_QK
#undef MOBA_SMPV
        { auto rr = __builtin_amdgcn_permlane32_swap(__float_as_uint(l_reg), __float_as_uint(l_reg), false, false); l_reg = __uint_as_float(rr[0]) + __uint_as_float(rr[1]); }
        if (hi == 0) wsf[r32] = 1.0f / l_reg;
#pragma unroll
        for (int r = 0; r < 16; ++r) { const float rl = wsf[crow(r, hi)]; ost[crow(r, hi) * 64 + r32] = o[0][r] * rl; ost[crow(r, hi) * 64 + 32 + r32] = o[1][r] * rl; }
#pragma unroll
        for (int i = 0; i < 4; ++i) { const int row = i * 8 + (lane >> 3), ch = lane & 7;
            const f32x4 a = *(const LAS f32x4*)(ost + row * 64 + ch * 8), c2 = *(const LAS f32x4*)(ost + row * 64 + ch * 8 + 4);
            const size_t grow = rowbase + q0 + wid * 32 + row;
            const v4u gw = *(const GAS v4u*)(F.GA + grow * 512 + h * 64 + ch * 8);
            v4u ow; ow.x = pk2(a[0] * bflo(gw.x), a[1] * bfhi(gw.x)); ow.y = pk2(a[2] * bflo(gw.y), a[3] * bfhi(gw.y));
            ow.z = pk2(c2[0] * bflo(gw.z), c2[1] * bfhi(gw.z)); ow.w = pk2(c2[2] * bflo(gw.w), c2[3] * bfhi(gw.w));
            *(GAS v4u*)(F.MIXED + grow * DM + 512 + h * 64 + ch * 8) = ow; }
    }
    __syncthreads();
}


namespace hg {
typedef short bf16x8 __attribute__((ext_vector_type(8)));
typedef short s16x4 __attribute__((ext_vector_type(4)));
typedef float f32x4 __attribute__((ext_vector_type(4)));
typedef unsigned u32x2 __attribute__((ext_vector_type(2)));
constexpr int SLOT = 33792, NSLOT = 4;
constexpr int L_SC = NSLOT * SLOT, L_NRM = L_SC + 4096;
constexpr int NSTEP = SEQ / 32;
__device__ __forceinline__ int fsw(int t) { return ((t & 7) << 2) | (((t >> 3) & 1) << 1); }
__device__ __forceinline__ int unit_off(int tok, int cg) { return 8 * (32 * tok + (cg ^ fsw(tok))); }
__device__ __forceinline__ s16x4 rd64(const LAS unsigned char* p) { return *(const LAS s16x4*)p; }
__device__ __forceinline__ s16x4 vtr(const LAS unsigned char* p) { return __builtin_bit_cast(s16x4, __builtin_amdgcn_ds_read_tr16_b64_v4i16((LAS s16x4*)p)); }
__device__ __forceinline__ bf16x8 cat(s16x4 a, s16x4 b) { return (bf16x8){a[0], a[1], a[2], a[3], b[0], b[1], b[2], b[3]}; }
__device__ __forceinline__ s16x4 pack4(f32x4 v) { u32x2 w; w.x = moba::cvtpk(v[0], v[1]); w.y = moba::cvtpk(v[2], v[3]); return __builtin_bit_cast(s16x4, w); }
__device__ __forceinline__ void glds16(const GAS void* gsrc, unsigned lds_dst) { unsigned keep;
    asm volatile("s_mov_b32 %0, m0\n\ts_mov_b32 m0, %2\n\ts_nop 0\n\tglobal_load_lds_dwordx4 %1, off\n\ts_mov_b32 m0, %0" : "=&s"(keep) : "v"(gsrc), "s"(lds_dst) : "memory"); }
__device__ __forceinline__ void glds16s(unsigned voff, const void* sbase, unsigned lds_dst) { unsigned keep;
    asm volatile("s_mov_b32 %0, m0\n\ts_mov_b32 m0, %3\n\ts_nop 0\n\tglobal_load_lds_dwordx4 %1, %2\n\ts_mov_b32 m0, %0" : "=&s"(keep) : "v"(voff), "s"(sbase), "s"(lds_dst) : "memory"); }
#define HG_MFMA(a, b, c) __builtin_amdgcn_mfma_f32_16x16x32_bf16((a), (b), (c), 0, 0, 0)
}

__device__ __forceinline__ void hgrn_mfma_phase(Frame& F, int l) {
    using namespace hg;
    PHASE_IDS();
    const int w = wave, c16 = lane & 15, g = lane >> 4;
    LAS unsigned char* L = F.lds + RING_OFF;
    const s16x4 z4 = (s16x4){0, 0, 0, 0};
    for (int it = (int)blockIdx.x; it < 64; it += F.G) {
        const int b = it >> 2, h = it & 3; const size_t rowbase = (size_t)b * SEQ;
        const int da = w >> 1;
        unsigned dsrc[4];
#pragma unroll
        for (int i = 0; i < 4; ++i) { const int t = 16 * (w & 1) + 4 * i + (lane >> 4); const int sc = (lane & 15) ^ (fsw(t) >> 1);
            dsrc[i] = (unsigned)((((size_t)da * MTOK + rowbase + t) * 512 + h * 128 + 8 * sc) * 2); }
        const unsigned ddec = (unsigned)((((size_t)b * NSTEP) * 512 + h * 128 + 4 * lane) * 4);
        const int ddst = da * 8192 + (w & 1) * 4096;
        const unsigned lds0 = (unsigned)(uintptr_t)(F.lds + RING_OFF);
#define HG_ISSUE(step) do { const unsigned so_ = lds0 + (unsigned)(((step) & 3) * SLOT); \
            _Pragma("unroll") for (int i = 0; i < 4; ++i) \
                glds16s(dsrc[i], (const void*)((const char*)F.QI + (size_t)(step) * (32 * 512 * 2)), (unsigned)__builtin_amdgcn_readfirstlane((int)(so_ + ddst + i * 1024))); \
            if (w == 0) glds16s(ddec, (const void*)((const char*)F.DEC + (size_t)(step) * 2048), (unsigned)__builtin_amdgcn_readfirstlane((int)(so_ + 32768))); } while (0)
        f32x4 S[8]; bf16x8 Sb[4];
#pragma unroll
        for (int tk = 0; tk < 8; ++tk) S[tk] = (f32x4){0.f, 0.f, 0.f, 0.f};
#pragma unroll
        for (int ks = 0; ks < 4; ++ks) Sb[ks] = (bf16x8){0, 0, 0, 0, 0, 0, 0, 0};
        f32x4 oprev[2]; oprev[0] = (f32x4){0.f, 0.f, 0.f, 0.f}; oprev[1] = oprev[0];
        u32x2 gprev[2]; gprev[0] = (u32x2){0u, 0u}; gprev[1] = gprev[0];
        float hw[4];
#pragma unroll
        for (int r = 0; r < 4; ++r) hw[r] = F.hg_norm_w[l * 128 + 16 * w + 4 * g + r];
        asm volatile("" : "+v"(hw[0]), "+v"(hw[1]), "+v"(hw[2]), "+v"(hw[3]));
        LAS float* nrm = (LAS float*)(L + L_NRM);
        LAS unsigned char* SC = L + L_SC;
        HG_ISSUE(0); HG_ISSUE(1); HG_ISSUE(2);
        asm volatile("s_waitcnt vmcnt(8)\n\ts_barrier" ::: "memory");
        const int trq = c16 >> 2, trp = c16 & 3;
        int ro0 = unit_off(c16, g), ko0 = unit_off(4 * g + trq, trp);
#define RO(ks, e) (ro0 ^ (64 * (ks) + 32 * (e)))
#define KO(tk) (ko0 ^ (32 * (tk)))
        const int io_ = unit_off(4 * g + trq, 4 * w + trp), go_ = unit_off(c16, 4 * w + g);
        bf16x8 qf[2][4];
#define HG_LOADQ(slotbase) do { _Pragma("unroll") for (int tt = 0; tt < 2; ++tt) _Pragma("unroll") for (int ks = 0; ks < 4; ++ks) \
            qf[tt][ks] = cat(rd64((slotbase) + RO(ks, 0) + 4096 * tt), rd64((slotbase) + RO(ks, 1) + 4096 * tt)); } while (0)
#define HG_FINAL(step, P) do { _Pragma("unroll") for (int tt = 0; tt < 2; ++tt) { \
            const float ssum = ((P[tt][0] + P[tt][1]) + (P[tt][2] + P[tt][3])) + ((P[tt][4] + P[tt][5]) + (P[tt][6] + P[tt][7])); \
            const float rstd = __builtin_amdgcn_rsqf(ssum * (1.0f / 128.0f) + NORM_EPS); \
            u32x2 wv; wv.x = moba::cvtpk(oprev[tt][0] * rstd * hw[0] * bflo(gprev[tt].x), oprev[tt][1] * rstd * hw[1] * bfhi(gprev[tt].x)); \
            wv.y = moba::cvtpk(oprev[tt][2] * rstd * hw[2] * bflo(gprev[tt].y), oprev[tt][3] * rstd * hw[3] * bfhi(gprev[tt].y)); \
            *(GAS u32x2*)(F.MIXED + (rowbase + (size_t)(step) * 32 + 16 * tt + c16) * DM + h * 128 + 16 * w + 4 * g) = wv; } } while (0)
        HG_LOADQ(L);
        for (int n = 0; n < NSTEP; ++n) {
            asm volatile("" : "+v"(ro0), "+v"(ko0));
            if (n + 3 < NSTEP) HG_ISSUE(n + 3);
            const LAS unsigned char* Qs = L + (n & 3) * SLOT; const LAS unsigned char* Ks = Qs + 8192; const LAS unsigned char* Is = Qs + 16384; const LAS unsigned char* Gs = Qs + 24576;
            const LAS float* Ds = (const LAS float*)(Qs + 32768);
            LAS unsigned char* SCn = SC + (n & 1) * 1536;
            bf16x8 kf[4];
            if (w < 3) { const int st = (w == 2) ? 1 : 0;
#pragma unroll
                for (int ks = 0; ks < 4; ++ks) kf[ks] = cat(rd64(Ks + RO(ks, 0) + 4096 * st), rd64(Ks + RO(ks, 1) + 4096 * st)); }
            u32x2 gcur[2];
#pragma unroll
            for (int tt = 0; tt < 2; ++tt) gcur[tt] = *(const LAS u32x2*)(Gs + go_ + 4096 * tt);
            s16x4 itr[2];
#pragma unroll
            for (int st = 0; st < 2; ++st) itr[st] = vtr(Is + io_ + 4096 * st);
            const bf16x8 i01 = cat(itr[0], itr[1]);
            bf16x8 k01[4]; f32x4 dv4[4];
#pragma unroll
            for (int tk = 0; tk < 4; ++tk) { k01[tk] = cat(vtr(Ks + KO(tk)), vtr(Ks + KO(tk) + 4096)); dv4[tk] = *(const LAS f32x4*)(Ds + 16 * tk + 4 * g); }
            f32x4 o[2];
#pragma unroll
            for (int tt = 0; tt < 2; ++tt) { f32x4 a = (f32x4){0.f, 0.f, 0.f, 0.f};
#pragma unroll
                for (int ks = 0; ks < 4; ++ks) a = HG_MFMA(Sb[ks], qf[tt][ks], a);
                o[tt] = a; }
            if (w < 3) { f32x4 sc = (f32x4){0.f, 0.f, 0.f, 0.f};
                if (w == 0) {
#pragma unroll
                    for (int ks = 0; ks < 4; ++ks) sc = HG_MFMA(kf[ks], qf[0][ks], sc);
                } else {
#pragma unroll
                    for (int ks = 0; ks < 4; ++ks) sc = HG_MFMA(kf[ks], qf[1][ks], sc); }
                if (w != 1) {
#pragma unroll
                    for (int r = 0; r < 4; ++r) if (4 * g + r > c16) sc[r] = 0.f; }
                *(LAS s16x4*)(SCn + w * 512 + lane * 8) = pack4(sc); }
#pragma unroll
            for (int tk = 0; tk < 4; ++tk) S[tk] = HG_MFMA(k01[tk], i01, S[tk]);
            asm volatile("" ::: "memory");
            { bf16x8 k2[4]; f32x4 d2[4];
#pragma unroll
                for (int tk = 0; tk < 4; ++tk) { k2[tk] = cat(vtr(Ks + KO(tk + 4)), vtr(Ks + KO(tk + 4) + 4096)); d2[tk] = *(const LAS f32x4*)(Ds + 16 * (tk + 4) + 4 * g); }
#pragma unroll
                for (int tk = 0; tk < 4; ++tk) S[tk] = S[tk] * dv4[tk];
#pragma unroll
                for (int ks = 0; ks < 2; ++ks) Sb[ks] = cat(pack4(S[2 * ks]), pack4(S[2 * ks + 1]));
#pragma unroll
                for (int tk = 0; tk < 4; ++tk) S[tk + 4] = HG_MFMA(k2[tk], i01, S[tk + 4]);
#pragma unroll
                for (int tk = 0; tk < 4; ++tk) S[tk + 4] = S[tk + 4] * d2[tk];
#pragma unroll
                for (int ks = 2; ks < 4; ++ks) Sb[ks] = cat(pack4(S[2 * ks]), pack4(S[2 * ks + 1])); }
            if (n >= NSTEP - 3) asm volatile("s_waitcnt vmcnt(0) lgkmcnt(0)\n\ts_barrier" ::: "memory");
            else if (n <= 1) asm volatile("s_waitcnt vmcnt(8) lgkmcnt(0)\n\ts_barrier" ::: "memory");
            else if (n == 2) asm volatile("s_waitcnt vmcnt(10) lgkmcnt(0)\n\ts_barrier" ::: "memory");
            else asm volatile("s_waitcnt vmcnt(12) lgkmcnt(0)\n\ts_barrier" ::: "memory");
            const s16x4 sc00 = rd64(SCn + lane * 8), sc01 = rd64(SCn + 512 + lane * 8), sc11 = rd64(SCn + 1024 + lane * 8);
            float pn[2][8];
            if (n > 0) {
#pragma unroll
                for (int tt = 0; tt < 2; ++tt)
#pragma unroll
                    for (int ww = 0; ww < 8; ++ww) pn[tt][ww] = nrm[((n - 1) & 1) * 256 + ww * 32 + 16 * tt + c16]; }
            if (n + 1 < NSTEP) HG_LOADQ(L + ((n + 1) & 3) * SLOT);
            o[0] = HG_MFMA(cat(itr[0], z4), cat(sc00, z4), o[0]);
            o[1] = HG_MFMA(i01, cat(sc01, sc11), o[1]);
            { float ss0 = (o[0][0] * o[0][0] + o[0][1] * o[0][1]) + (o[0][2] * o[0][2] + o[0][3] * o[0][3]);
              float ss1 = (o[1][0] * o[1][0] + o[1][1] * o[1][1]) + (o[1][2] * o[1][2] + o[1][3] * o[1][3]);
              { auto r0 = __builtin_amdgcn_permlane16_swap(__float_as_uint(ss0), __float_as_uint(ss0), false, false); auto r1 = __builtin_amdgcn_permlane16_swap(__float_as_uint(ss1), __float_as_uint(ss1), false, false);
                ss0 = __uint_as_float(r0[0]) + __uint_as_float(r0[1]); ss1 = __uint_as_float(r1[0]) + __uint_as_float(r1[1]); }
              { auto r0 = __builtin_amdgcn_permlane32_swap(__float_as_uint(ss0), __float_as_uint(ss0), false, false); auto r1 = __builtin_amdgcn_permlane32_swap(__float_as_uint(ss1), __float_as_uint(ss1), false, false);
                ss0 = __uint_as_float(r0[0]) + __uint_as_float(r0[1]); ss1 = __uint_as_float(r1[0]) + __uint_as_float(r1[1]); }
              if (g == 0) { nrm[(n & 1) * 256 + w * 32 + c16] = ss0; nrm[(n & 1) * 256 + w * 32 + 16 + c16] = ss1; } }
            if (n > 0) HG_FINAL(n - 1, pn);
            oprev[0] = o[0]; oprev[1] = o[1]; gprev[0] = gcur[0]; gprev[1] = gcur[1];
        }
        asm volatile("s_waitcnt vmcnt(0) lgkmcnt(0)\n\ts_barrier" ::: "memory");
        { float pn[2][8];
#pragma unroll
            for (int tt = 0; tt < 2; ++tt)
#pragma unroll
                for (int ww = 0; ww < 8; ++ww) pn[tt][ww] = nrm[((NSTEP - 1) & 1) * 256 + ww * 32 + 16 * tt + c16];
            HG_FINAL(NSTEP - 1, pn); }
        asm volatile("s_waitcnt vmcnt(0) lgkmcnt(0)\n\ts_barrier" ::: "memory");
#undef RO
#undef KO
#undef HG_LOADQ
#undef HG_FINAL
#undef HG_ISSUE
    }
}

struct Args { const float* in[8]; float* out; unsigned char* ws; int ph_lo, ph_hi, li, pad; };
__global__ void __launch_bounds__(NWAVES * 64, 2) fwd(Args args) {
    extern __shared__ __attribute__((aligned(16))) unsigned char lds[];
    Frame F;
    F.lds = (LAS unsigned char*)lds;
    F.MISC = (volatile LAS unsigned*)(F.lds + MISC_OFF);
    F.G = gridDim.x; { const int bx = blockIdx.x; F.vcu = (F.G % 8 == 0) ? (bx % 8) * (F.G / 8) + bx / 8 : bx; }
    unsigned char* ws = args.ws;
    F.ctl = (gu32*)(ws + WS_CTL);
    F.x = args.in[0]; F.norm_w = args.in[1]; F.w_in = args.in[2]; F.lb_logits = args.in[3]; F.hg_norm_w = args.in[4]; F.q_norm_w = args.in[5]; F.k_norm_w = args.in[6]; F.w_out = args.in[7];
    F.out = args.out;
    F.WIN = (bf16*)(ws + WS_WIN); F.WOUT = (bf16*)(ws + WS_WOUT); F.XB = (bf16*)(ws + WS_XB); F.MIXED = (bf16*)(ws + WS_MIXED);
    F.QI = (bf16*)(ws + WS_ARR); F.KT = (bf16*)(ws + WS_ARR + ARR_BYTES); F.HI = (bf16*)(ws + WS_ARR + 2 * ARR_BYTES); F.GH = (bf16*)(ws + WS_ARR + 3 * ARR_BYTES);
    F.QN = (bf16*)(ws + WS_ARR + 4 * ARR_BYTES); F.KN = (bf16*)(ws + WS_ARR + 5 * ARR_BYTES); F.V = (bf16*)(ws + WS_ARR + 6 * ARR_BYTES); F.GA = (bf16*)(ws + WS_ARR + 7 * ARR_BYTES);
    F.LB = (float*)(ws + WS_LB); F.KPART = (float*)(ws + WS_KPART); F.ROWSS = (float*)(ws + WS_ROWSS); F.DEC = (float*)(ws + WS_DEC);
    F.wave0 = __builtin_amdgcn_readfirstlane((int)threadIdx.x >> 6);
    for (int u = F.wave0 * 64 + lane_id_asm(); u < (LDS_BYTES - LDSCTL_OFF) / 4; u += NWAVES * 64) ((LAS unsigned*)(F.lds + LDSCTL_OFF))[u] = 0u;
    __syncthreads();
    XcdBarrier bar; bar.bar = (unsigned*)(F.ctl + CW_BAR); bar.x = 0; bar.st = nullptr; bar.wave0 = F.wave0;
    if (N_LAUNCHES == 1) bar = xcd_barrier_post((unsigned*)(F.ctl + CW_BAR), F.MISC + 8, F.wave0);
#define GRID_BAR() do { if (N_LAUNCHES == 1) xcd_barrier(bar); } while (0)
    const int lo = args.ph_lo, hi = args.ph_hi;
#define IN(k) (lo <= (k) && (k) < hi)
#define BOTH(k) (IN(k) && IN((k) + 1))

    if (IN(0)) { p0_prologue(F); if (BOTH(0)) GRID_BAR(); }
    for (int l = 0; l < DEPTH; ++l) {
        const int pb = 1 + 3 * l;
        if (IN(pb)) {
            pg8::Gemm g{F.XB + (size_t)l * MTOK * DM, F.WIN + (size_t)l * NIN * DM, MTOK, NIN, DM}; pg8::StaticOrder S; S.init(MTOK, NIN, F.G, (int)blockIdx.x);
            pg8::EpiFused E{F.QI, F.DEC, F.KPART, F.ROWSS + (size_t)l * MTOK * 16, F.LB + l * 512, F.q_norm_w + l * 64, F.k_norm_w + l * 64};
            pg8::gemm_phase<pg8::EpiFused, pg8::StaticOrder, true, true>(F.lds + RING_OFF, g, S, E, F.wave0);
            if (BOTH(pb)) GRID_BAR();
        }
        if (IN(pb + 1)) { hgrn_mfma_phase(F, l); moba_mfma_phase(F, l); if (BOTH(pb + 1)) GRID_BAR(); }
        if (IN(pb + 2)) {
            pg8::Gemm g{F.MIXED, F.WOUT + (size_t)l * DM * DM, MTOK, DM, DM}; pg8::StaticOrder S; S.init(MTOK, DM, F.G, (int)blockIdx.x);
            pg8::EpiOut E{l == 0 ? F.x : nullptr, F.XB + (size_t)MTOK * DM, l == 0 ? nullptr : F.out, l == 0 ? F.XB + (size_t)MTOK * DM : nullptr, l == 0 ? F.ROWSS + (size_t)MTOK * 16 : nullptr};
            pg8::gemm_phase<pg8::EpiOut, pg8::StaticOrder, true, true>(F.lds + RING_OFF, g, S, E, F.wave0);
            if (pb + 2 < N_PHASES - 1 && BOTH(pb + 2)) GRID_BAR();
        }
    }
#undef IN
#undef BOTH
}

extern "C" void kernel_launch(void* const* d_in, const int* in_sizes, int n_in, void* d_out, int out_size, void* d_ws, size_t ws_size, hipStream_t stream) {
    static int grid = 0;
    if (grid == 0) {
        if (n_in != 8 || in_sizes[0] != MTOK * DM || out_size != MTOK * DM || ws_size < WS_END) { fprintf(stderr, "kernel_launch: unexpected shapes n_in %d in0 %d out %d ws %zu\n", n_in, n_in > 0 ? in_sizes[0] : -1, out_size, ws_size); grid = -1; return; }
        int dev = 0, cus = 0, per_cu = 0;
        if (hipGetDevice(&dev) != hipSuccess || hipDeviceGetAttribute(&cus, hipDeviceAttributeMultiprocessorCount, dev) != hipSuccess) { grid = -1; return; }
        if (hipFuncSetAttribute((const void*)fwd, hipFuncAttributeMaxDynamicSharedMemorySize, LDS_BYTES) != hipSuccess) { fprintf(stderr, "kernel_launch: hipFuncSetAttribute failed\n"); grid = -1; return; }
        if (hipOccupancyMaxActiveBlocksPerMultiprocessor(&per_cu, (const void*)fwd, NWAVES * 64, LDS_BYTES) != hipSuccess || per_cu < 1) fprintf(stderr, "kernel_launch: occupancy query says %d\n", per_cu);
        (void)hipGetLastError();
        if (per_cu < 1) { grid = -1; return; }
        grid = cus;
    }
    if (grid < 0) return;
    if (hipMemsetAsync((char*)d_ws + WS_CTL, 0, CTL_ZERO_BYTES, stream) != hipSuccess) return;
    Args a{};
    for (int i = 0; i < 8; ++i) a.in[i] = (const float*)d_in[i];
    a.out = (float*)d_out; a.ws = (unsigned char*)d_ws;
    for (int li = 0; li < N_LAUNCHES; ++li) {
        a.ph_lo = (N_LAUNCHES == 1) ? 0 : li; a.ph_hi = (N_LAUNCHES == 1) ? N_PHASES : li + 1; a.li = li;
        hipError_t le;
        if (N_LAUNCHES == 1) { void* kargs[] = {(void*)&a}; le = hipLaunchCooperativeKernel((const void*)fwd, dim3(grid), dim3(NWAVES * 64), kargs, LDS_BYTES, stream); }
        else { hipLaunchKernelGGL(fwd, dim3(grid), dim3(NWAVES * 64), LDS_BYTES, stream, a); le = hipPeekAtLastError(); }
        if (le != hipSuccess) { fprintf(stderr, "kernel_launch: launch %d failed: %s\n", li, hipGetErrorName(le)); break; }
    }
}
```

```cpp
#include <hip/hip_runtime.h>
#include <cstdio>
#include <cstdint>
__device__ __forceinline__ int lane_id_asm() { int l; asm volatile("v_mbcnt_lo_u32_b32 %0, -1, 0\n\tv_mbcnt_hi_u32_b32 %0, -1, %0" : "=v"(l)); return l; }
namespace pg8 {
#define PG8_LAS __attribute__((address_space(3)))
typedef unsigned short bf16_t;
typedef short bf16x8 __attribute__((ext_vector_type(8)));
typedef float f32x4 __attribute__((ext_vector_type(4)));
typedef unsigned u32x4 __attribute__((ext_vector_type(4)));
typedef unsigned u32x2 __attribute__((ext_vector_type(2)));
constexpr int BM = 256, BK = 64, HALF = 128, HTB = HALF * BK * 2  , STAGE_BYTES = 8 * HTB, NXCD = 8, WGM = 8;

__host__ __device__ __forceinline__ int lds_byte(int r, int c) { const int st = (r >> 4) * 2 + (c >> 5), rr = r & 15, cc = c & 31, ob = rr * 64 + cc * 2; return st * 1024 + (ob ^ (((ob >> 9) & 1) << 5)); }
__host__ __device__ __forceinline__ void stage_rc(int b, int& R, int& C) { const int st = b / 1024, sb = b % 1024, swz = sb ^ (((sb >> 9) & 1) << 5); R = (st >> 1) * 16 + swz / 64; C = (st & 1) * 32 + (swz % 64) / 2; }
__host__ __device__ __forceinline__ int perm32(int rho) { const int n = rho >> 4, i = rho & 15; return 8 * (i >> 2) + 4 * n + (i & 3); }

struct Unit { int pm, pn; };
struct Gemm { const bf16_t* A; const bf16_t* Bt; int M, N, K; };

struct StaticOrder {
    int nM, nN, nwg, G, c;
    __host__ __device__ void init(int M, int N, int G_, int c_) { nM = M / BM; nN = N / BM; nwg = nM * nN; G = G_; c = c_; }
    __host__ __device__ bool next(int i, Unit& u) const {
        const long L = (long)i * G + c; if (L >= nwg) return false;
        int wgid = (int)L; { const int q = nwg / NXCD, r = nwg % NXCD, xcd = wgid % NXCD, off = wgid / NXCD; wgid = (xcd < r ? xcd * (q + 1) : r * (q + 1) + (xcd - r) * q) + off; }
        const int nig = WGM * nN, gid = wgid / nig, fm = gid * WGM, gsz = (nM - fm) < WGM ? (nM - fm) : WGM;
        u.pm = fm + ((wgid % nig) % gsz); u.pn = (wgid % nig) / gsz; return true;
    }
    __device__ __forceinline__ void a_ready(const Unit&) const {}
    __device__ __forceinline__ void done(const Unit&) const {}
};

__device__ __forceinline__ unsigned cvt_pk_bf16(float lo, float hi) { unsigned r; asm volatile("v_cvt_pk_bf16_f32 %0, %1, %2" : "=v"(r) : "v"(lo), "v"(hi)); return r; }


__device__ __forceinline__ float dpp_row_shr(float v, int n) {
    const int x = __builtin_bit_cast(int, v);
    int r;
    if (n == 1) r = __builtin_amdgcn_update_dpp(0, x, 0x111, 0xf, 0xf, false);
    else if (n == 2) r = __builtin_amdgcn_update_dpp(0, x, 0x112, 0xf, 0xf, false);
    else if (n == 4) r = __builtin_amdgcn_update_dpp(0, x, 0x114, 0xf, 0xf, false);
    else r = __builtin_amdgcn_update_dpp(0, x, 0x118, 0xf, 0xf, false);
    return __builtin_bit_cast(float, r);
}
__device__ __forceinline__ float fsig(float z) { return __builtin_amdgcn_rcpf(1.0f + __expf(-z)); }
struct EpiFused {
    static constexpr bool PERM = true, AFTER_DRAIN = false;
    bf16_t* ARR; float* DEC; float* KPART; const float* rowss; const float* lb; const float* qg; const float* kg;
    static constexpr size_t AS = (size_t)32768 * 512;
    __device__ __forceinline__ float rstd_of(int row) const {
        const f32x4* rp = (const f32x4*)(rowss + (size_t)row * 16);
        const f32x4 a = rp[0], b = rp[1], c = rp[2], d = rp[3];
        const float ss = ((a[0] + a[1]) + (a[2] + a[3])) + ((b[0] + b[1]) + (b[2] + b[3])) + ((c[0] + c[1]) + (c[2] + c[3])) + ((d[0] + d[1]) + (d[2] + d[3]));
        return 1.0f / sqrtf(ss * (1.0f / 1024.0f) + 1e-6f);
    }
    static __device__ __forceinline__ u32x4 pack8(const float (&v)[8]) { u32x4 w; w.x = cvt_pk_bf16(v[0], v[1]); w.y = cvt_pk_bf16(v[2], v[3]); w.z = cvt_pk_bf16(v[4], v[5]); w.w = cvt_pk_bf16(v[6], v[7]); return w; }
    __device__ __forceinline__ void operator()(const f32x4 (&acc)[2][2][4][2], const Unit& u, int wr, int wc, int fr, int fq) const {
        const int row0 = u.pm * BM + wr * 64 + fr; const int pn = u.pn;
        if (pn < 4) {
            const int cb = pn * 128 + wc * 32 + 8 * fq;
            float lbv[8];
#pragma unroll
            for (int k = 0; k < 8; ++k) lbv[k] = lb[cb + k];
#pragma unroll
            for (int ai = 0; ai < 2; ++ai)
#pragma unroll
                for (int mp = 0; mp < 2; ++mp) { const int row1 = row0 + ai * HALF + mp * 32, row2 = row1 + 16; const float rs1 = rstd_of(row1), rs2 = rstd_of(row2);
                    float qi1[8], kt1[8], qi2[8], kt2[8], dc[8];
#pragma unroll
                    for (int k = 0; k < 8; ++k) {
                        const float zq1 = acc[ai][0][2 * mp][k >> 2][k & 3] * rs1, zf1 = acc[ai][1][2 * mp][k >> 2][k & 3] * rs1;
                        const float zq2 = acc[ai][0][2 * mp + 1][k >> 2][k & 3] * rs2, zf2 = acc[ai][1][2 * mp + 1][k >> 2][k & 3] * rs2;
                        const float f1 = lbv[k] + (1.0f - lbv[k]) * fsig(zf1), f2 = lbv[k] + (1.0f - lbv[k]) * fsig(zf2);
                        float b1 = __logf(f1), b2 = __logf(f2);
                        b1 += dpp_row_shr(b1, 1); b2 += dpp_row_shr(b2, 1); b1 += dpp_row_shr(b1, 2); b2 += dpp_row_shr(b2, 2);
                        b1 += dpp_row_shr(b1, 4); b2 += dpp_row_shr(b2, 4); b1 += dpp_row_shr(b1, 8); b2 += dpp_row_shr(b2, 8);
                        b2 += __shfl(b1, (fq << 4) | 15);
                        const float e1 = __expf(b1), e2 = __expf(b2);
                        qi1[k] = zq1 * fsig(zq1) * e1; kt1[k] = (1.0f - f1) * __expf(fminf(-b1, 80.0f));
                        qi2[k] = zq2 * fsig(zq2) * e2; kt2[k] = (1.0f - f2) * __expf(fminf(-b2, 80.0f)); dc[k] = e2; }
                    *(u32x4*)(ARR + (size_t)row1 * 512 + cb) = pack8(qi1); *(u32x4*)(ARR + AS + (size_t)row1 * 512 + cb) = pack8(kt1);
                    *(u32x4*)(ARR + (size_t)row2 * 512 + cb) = pack8(qi2); *(u32x4*)(ARR + AS + (size_t)row2 * 512 + cb) = pack8(kt2);
                    if (fr == 15) { float* dp = DEC + (size_t)(row1 >> 5) * 512 + cb; *(f32x4*)dp = (f32x4){dc[0], dc[1], dc[2], dc[3]}; *(f32x4*)(dp + 4) = (f32x4){dc[4], dc[5], dc[6], dc[7]}; }
                    asm volatile("" ::: "memory"); }
        } else if (pn < 8) {
            const int cb = (pn - 4) * 128 + wc * 32 + 8 * fq;
#pragma unroll
            for (int ai = 0; ai < 2; ++ai)
#pragma unroll
                for (int m = 0; m < 4; ++m) { const int row = row0 + ai * HALF + m * 16; const float rs = rstd_of(row);
                    float iv[8], gv[8];
#pragma unroll
                    for (int k = 0; k < 8; ++k) { iv[k] = acc[ai][0][m][k >> 2][k & 3] * rs; const float zg = acc[ai][1][m][k >> 2][k & 3] * rs; gv[k] = zg * fsig(zg); }
                    *(u32x4*)(ARR + 2 * AS + (size_t)row * 512 + cb) = pack8(iv); *(u32x4*)(ARR + 3 * AS + (size_t)row * 512 + cb) = pack8(gv);
                    asm volatile("" ::: "memory"); }
        } else {
            const int ty = (pn - 8) >> 1, head = 4 * ((pn - 8) & 1) + wc; const int d0 = 8 * fq;
            bf16_t* dst = ARR + (size_t)(4 + ty) * AS;
            float gain[2][8]; float csum[2][8];
#pragma unroll
            for (int bj = 0; bj < 2; ++bj)
#pragma unroll
                for (int k = 0; k < 8; ++k) { gain[bj][k] = (ty == 0) ? qg[bj * 32 + d0 + k] * (0.125f * 1.4426950408889634f) : (ty == 1) ? kg[bj * 32 + d0 + k] : 1.0f; csum[bj][k] = 0.f; }
#pragma unroll
            for (int ai = 0; ai < 2; ++ai)
#pragma unroll
                for (int m = 0; m < 4; ++m) { const int row = row0 + ai * HALF + m * 16; const float rs = rstd_of(row);
                    float v[2][8];
#pragma unroll
                    for (int bj = 0; bj < 2; ++bj)
#pragma unroll
                        for (int k = 0; k < 8; ++k) v[bj][k] = acc[ai][bj][m][k >> 2][k & 3] * rs;
                    if (ty < 2) { float ss = 0.f;
#pragma unroll
                        for (int bj = 0; bj < 2; ++bj)
#pragma unroll
                            for (int k = 0; k < 8; ++k) ss += v[bj][k] * v[bj][k];
                        ss += __shfl_xor(ss, 16); ss += __shfl_xor(ss, 32);
                        const float r2 = 1.0f / sqrtf(ss * (1.0f / 64.0f) + 1e-6f);
#pragma unroll
                        for (int bj = 0; bj < 2; ++bj)
#pragma unroll
                            for (int k = 0; k < 8; ++k) { v[bj][k] *= r2 * gain[bj][k]; csum[bj][k] += v[bj][k]; }
                    } else if (ty == 3) {
#pragma unroll
                        for (int bj = 0; bj < 2; ++bj)
#pragma unroll
                            for (int k = 0; k < 8; ++k) v[bj][k] = v[bj][k] * fsig(v[bj][k]); }
                    *(u32x4*)(dst + (size_t)row * 512 + head * 64 + d0) = pack8(v[0]); *(u32x4*)(dst + (size_t)row * 512 + head * 64 + 32 + d0) = pack8(v[1]);
                    asm volatile("" ::: "memory"); }
            if (ty == 1) {
#pragma unroll
                for (int bj = 0; bj < 2; ++bj)
#pragma unroll
                    for (int k = 0; k < 8; ++k) { float s = csum[bj][k]; s += __shfl_xor(s, 1); s += __shfl_xor(s, 2); s += __shfl_xor(s, 4); s += __shfl_xor(s, 8); csum[bj][k] = s; }
                if (fr == 0) { float* kp = KPART + ((size_t)u.pm * 2 + wr) * 512 + head * 64 + d0;
#pragma unroll
                    for (int bj = 0; bj < 2; ++bj) { *(f32x4*)(kp + bj * 32) = (f32x4){csum[bj][0], csum[bj][1], csum[bj][2], csum[bj][3]}; *(f32x4*)(kp + bj * 32 + 4) = (f32x4){csum[bj][4], csum[bj][5], csum[bj][6], csum[bj][7]}; } }
            }
        }
    }
};
struct EpiOut {
    static constexpr bool PERM = false, AFTER_DRAIN = false;
    const float* xres; const bf16_t* xres16; float* out; bf16_t* xb; float* rowss;
    __device__ __forceinline__ void operator()(const f32x4 (&acc)[2][2][4][2], const Unit& u, int wr, int wc, int fr, int fq) const {
        const int col0 = u.pn * BM + wc * 32 + 4 * fq;
#pragma unroll
        for (int ai = 0; ai < 2; ++ai)
#pragma unroll
            for (int m = 0; m < 4; ++m) {
                const int row = u.pm * BM + ai * HALF + wr * 64 + m * 16 + fr; float ss = 0.f;
#pragma unroll
                for (int bj = 0; bj < 2; ++bj)
#pragma unroll
                    for (int n = 0; n < 2; ++n) { const size_t off = (size_t)row * 1024 + col0 + bj * HALF + n * 16;
                        f32x4 v;
                        if (xres) v = *(const f32x4*)(xres + off); else { const u32x2 r = *(const u32x2*)(xres16 + off); v = (f32x4){__builtin_bit_cast(float, r.x << 16), __builtin_bit_cast(float, r.x & 0xffff0000u), __builtin_bit_cast(float, r.y << 16), __builtin_bit_cast(float, r.y & 0xffff0000u)}; }
                        v = v + acc[ai][bj][m][n];
                        if (out) *(f32x4*)(out + off) = v;
                        if (xb) { u32x2 w; w.x = cvt_pk_bf16(v[0], v[1]); w.y = cvt_pk_bf16(v[2], v[3]); *(u32x2*)(xb + off) = w; }
                        ss += (v[0] * v[0] + v[1] * v[1]) + (v[2] * v[2] + v[3] * v[3]); }
                ss += __shfl_xor(ss, 16); ss += __shfl_xor(ss, 32);
                if (fq == 0 && rowss) rowss[(size_t)row * 16 + u.pn * 4 + wc] = ss;
            }
    }
};

template <class Epi, class Sched, bool ALIGN_EPI = false, bool SP2 = false>
__device__ __forceinline__ void gemm_phase(PG8_LAS unsigned char* lds, const Gemm g, const Sched& S, const Epi& E, const int wave0) {
    int tid = wave0 * 64 + lane_id_asm(); asm volatile("" : "+v"(tid));
    const int wid = __builtin_amdgcn_readfirstlane(tid >> 6), lane = tid & 63, wr = wid >> 2, wc = wid & 3, fr = lane & 15, fq = lane >> 4;
    const int K = g.K, nt = K / BK;
    unsigned voffA[2], voffB[2];
#pragma unroll
    for (int i = 0; i < 2; ++i) { int R, C; stage_rc(tid * 16 + i * 8192, R, C); const int Rb = Epi::PERM ? ((R & ~31) + perm32(R & 31)) : R;
        voffA[i] = (unsigned)(R * K + C) * 2u; voffB[i] = (unsigned)(Rb * K + C) * 2u; }
    const size_t kstep = (size_t)(BK * 2);
    const size_t hstep = (size_t)HALF * K * 2;
    const size_t tstep = 2 * hstep;
    const unsigned ldsw = (unsigned)wid * 1024u;
    const int aoff = lds_byte(wr * 64 + fr, fq * 8), boff = lds_byte(wc * 32 + fr, fq * 8);
#define PG8_SA(b, h) (((b) * 2 + (h)) * HTB)
#define PG8_SB(b, h) ((4 + (b) * 2 + (h)) * HTB)
#define PG8_STAGE(bufoff, gbase, voff) do { _Pragma("unroll") for (int _i = 0; _i < 2; ++_i) \
        __builtin_amdgcn_global_load_lds((const unsigned*)((const char*)(gbase) + (voff)[_i]), (PG8_LAS unsigned*)(lds + (bufoff) + ldsw + _i * 8192), 16, 0, 0); } while (0)
#define PG8_LDA(dst, b, h) do { _Pragma("unroll") for (int m = 0; m < 4; ++m) _Pragma("unroll") for (int k = 0; k < 2; ++k) dst[m][k] = *(const PG8_LAS bf16x8*)(lds + PG8_SA(b, h) + aoff + m * 2048 + k * 1024); } while (0)
#define PG8_LDB(dst, b, h) do { _Pragma("unroll") for (int n = 0; n < 2; ++n) _Pragma("unroll") for (int k = 0; k < 2; ++k) dst[n][k] = *(const PG8_LAS bf16x8*)(lds + PG8_SB(b, h) + boff + n * 2048 + k * 1024); } while (0)
#define PG8_MMA(ai, bj, At, Bt) do { __builtin_amdgcn_s_setprio(1); _Pragma("unroll") for (int m = 0; m < 4; ++m) _Pragma("unroll") for (int n = 0; n < 2; ++n) _Pragma("unroll") for (int k = 0; k < 2; ++k) \
        acc[ai][bj][m][n] = __builtin_amdgcn_mfma_f32_16x16x32_bf16(Bt[n][k], At[m][k], acc[ai][bj][m][n], 0, 0, 0); __builtin_amdgcn_s_setprio(0); } while (0)
#define PG8_WAIT_V(n) asm volatile("s_waitcnt vmcnt(" #n ")" ::: "memory")
#define PG8_WAIT_L(n) asm volatile("s_waitcnt lgkmcnt(" #n ")" ::: "memory")
#define PG8_BAR __builtin_amdgcn_s_barrier()
#define PG8_SCHED __builtin_amdgcn_sched_barrier(0)
    Unit cur, nxt; int ui = 0;
    if (!S.next(0, cur)) return;
    f32x4 acc[2][2][4][2];
#pragma unroll
    for (int a = 0; a < 2; ++a)
#pragma unroll
        for (int b = 0; b < 2; ++b)
#pragma unroll
            for (int m = 0; m < 4; ++m)
#pragma unroll
                for (int n = 0; n < 2; ++n) acc[a][b][m][n] = (f32x4){0.f, 0.f, 0.f, 0.f};
    bf16x8 At[4][2], B0[2][2], B1[2][2];
    const char* cA = (const char*)g.A + (size_t)cur.pm * tstep; const char* cB = (const char*)g.Bt + (size_t)cur.pn * tstep;
    S.a_ready(cur);
    if constexpr (SP2) {
        PG8_STAGE(PG8_SB(0, 0), cB, voffB); PG8_STAGE(PG8_SB(0, 1), cB + hstep, voffB); PG8_STAGE(PG8_SA(0, 0), cA, voffA); PG8_STAGE(PG8_SA(0, 1), cA + hstep, voffA);
        if (wr == 1) PG8_BAR;
        PG8_WAIT_V(2); PG8_BAR;
        PG8_STAGE(PG8_SB(1, 0), cB + kstep, voffB); PG8_STAGE(PG8_SA(1, 0), cA + kstep, voffA); PG8_STAGE(PG8_SB(1, 1), cB + hstep + kstep, voffB);
        PG8_WAIT_V(6); PG8_BAR;
    } else {
        PG8_STAGE(PG8_SB(0, 0), cB, voffB); PG8_STAGE(PG8_SA(0, 0), cA, voffA); PG8_STAGE(PG8_SB(0, 1), cB + hstep, voffB); PG8_STAGE(PG8_SA(0, 1), cA + hstep, voffA);
        if (wr == 1) PG8_BAR;
        PG8_WAIT_V(4); PG8_BAR;
        PG8_STAGE(PG8_SB(1, 0), cB + kstep, voffB); PG8_STAGE(PG8_SA(1, 0), cA + kstep, voffA); PG8_STAGE(PG8_SB(1, 1), cB + hstep + kstep, voffB);
        PG8_WAIT_V(6); PG8_BAR;
    }
    for (;;) {
        const bool has_next = S.next(ui + 1, nxt);
        const char* nA = has_next ? (const char*)g.A + (size_t)nxt.pm * tstep : cA; const char* nB = has_next ? (const char*)g.Bt + (size_t)nxt.pn * tstep : cB;
        for (int t = 0; t < nt; t += 2) {
            const bool last = (t == nt - 2);
            const char* a1 = cA + (size_t)(t + 1) * kstep;
            const char* a2 = last ? nA : cA + (size_t)(t + 2) * kstep; const char* b2 = last ? nB : cB + (size_t)(t + 2) * kstep;
            const char* a3 = a2 + kstep; const char* b3 = b2 + kstep;
            if (last && has_next) S.a_ready(nxt);
            if constexpr (SP2) {
            PG8_LDB(B0, 0, 0); PG8_LDB(B1, 0, 1); PG8_SCHED; PG8_LDA(At, 0, 0); PG8_STAGE(PG8_SA(1, 1), a1 + hstep, voffA);
            PG8_WAIT_V(8); PG8_WAIT_L(0); PG8_BAR; PG8_MMA(0, 0, At, B0); PG8_MMA(0, 1, At, B1); PG8_BAR; PG8_SCHED;
            PG8_LDA(At, 0, 1); PG8_STAGE(PG8_SB(0, 0), b2, voffB); PG8_STAGE(PG8_SB(0, 1), b2 + hstep, voffB); PG8_STAGE(PG8_SA(0, 0), a2, voffA);
            PG8_WAIT_V(8); PG8_WAIT_L(0); PG8_BAR; PG8_MMA(1, 0, At, B0); PG8_MMA(1, 1, At, B1); PG8_BAR; PG8_SCHED;
            PG8_LDB(B0, 1, 0); PG8_LDB(B1, 1, 1); PG8_SCHED; PG8_LDA(At, 1, 0); PG8_STAGE(PG8_SA(0, 1), a2 + hstep, voffA);
            PG8_WAIT_V(8); PG8_WAIT_L(0); PG8_BAR; PG8_MMA(0, 0, At, B0); PG8_MMA(0, 1, At, B1); PG8_BAR; PG8_SCHED;
            PG8_LDA(At, 1, 1); PG8_STAGE(PG8_SB(1, 0), b3, voffB); PG8_STAGE(PG8_SB(1, 1), b3 + hstep, voffB); PG8_STAGE(PG8_SA(1, 0), a3, voffA);
            PG8_WAIT_V(8); PG8_WAIT_L(0); PG8_BAR; PG8_MMA(1, 0, At, B0); PG8_MMA(1, 1, At, B1); PG8_BAR; PG8_SCHED;
            } else {
            PG8_LDB(B0, 0, 0); PG8_SCHED; PG8_LDA(At, 0, 0); PG8_STAGE(PG8_SA(1, 1), a1 + hstep, voffA);
            PG8_WAIT_L(8); PG8_BAR; PG8_WAIT_L(0); PG8_MMA(0, 0, At, B0); PG8_BAR; PG8_SCHED;
            PG8_LDB(B1, 0, 1); PG8_STAGE(PG8_SB(0, 0), b2, voffB);
            PG8_BAR; PG8_WAIT_L(0); PG8_MMA(0, 1, At, B1); PG8_BAR;
            PG8_LDA(At, 0, 1); PG8_STAGE(PG8_SA(0, 0), a2, voffA);
            PG8_BAR; PG8_WAIT_L(0); PG8_MMA(1, 0, At, B0); PG8_BAR; PG8_SCHED;
            PG8_STAGE(PG8_SB(0, 1), b2 + hstep, voffB);
            PG8_WAIT_V(6); PG8_BAR; PG8_MMA(1, 1, At, B1); PG8_BAR;
            PG8_LDB(B0, 1, 0); PG8_SCHED; PG8_LDA(At, 1, 0); PG8_STAGE(PG8_SA(0, 1), a2 + hstep, voffA);
            PG8_WAIT_L(8); PG8_BAR; PG8_WAIT_L(0); PG8_MMA(0, 0, At, B0); PG8_BAR; PG8_SCHED;
            PG8_LDB(B1, 1, 1); PG8_STAGE(PG8_SB(1, 0), b3, voffB);
            PG8_BAR; PG8_WAIT_L(0); PG8_MMA(0, 1, At, B1); PG8_BAR;
            PG8_LDA(At, 1, 1); PG8_STAGE(PG8_SA(1, 0), a3, voffA);
            PG8_BAR; PG8_WAIT_L(0); PG8_MMA(1, 0, At, B0); PG8_BAR; PG8_SCHED;
            PG8_STAGE(PG8_SB(1, 1), b3 + hstep, voffB);
            PG8_WAIT_V(6); PG8_BAR; PG8_MMA(1, 1, At, B1); PG8_BAR;
            }
        }
        if constexpr (ALIGN_EPI) { if (wr == 0) PG8_BAR; }
        if constexpr (!Epi::AFTER_DRAIN) { E(acc, cur, wr, wc, fr, fq); S.done(cur); }
        if (!has_next) break;
#pragma unroll
        for (int a = 0; a < 2; ++a)
#pragma unroll
            for (int b = 0; b < 2; ++b)
#pragma unroll
                for (int m = 0; m < 4; ++m)
#pragma unroll
                    for (int n = 0; n < 2; ++n) acc[a][b][m][n] = (f32x4){0.f, 0.f, 0.f, 0.f};
        cur = nxt; cA = nA; cB = nB; ++ui;
        if constexpr (ALIGN_EPI) { if (wr == 1) PG8_BAR; }
    }
    PG8_WAIT_V(0);
    if constexpr (!ALIGN_EPI) { if (wr == 0) PG8_BAR; }
    PG8_BAR;
    if constexpr (Epi::AFTER_DRAIN) { E.fused(acc, cur, wr, wc, fr, fq, lds, wid, lane); S.done(cur); }
#undef PG8_SA
#undef PG8_SB
#undef PG8_STAGE
#undef PG8_LDA
#undef PG8_LDB
#undef PG8_MMA
#undef PG8_WAIT_V
#undef PG8_WAIT_L
#undef PG8_BAR
#undef PG8_SCHED
}
}


constexpr int NWAVES = 8;
#ifndef MK_N_LAUNCHES
#define MK_N_LAUNCHES 1
#endif
constexpr int N_PHASES = 7;
constexpr int N_LAUNCHES = MK_N_LAUNCHES;

constexpr int BATCH = 16, SEQ = 2048, DM = 1024, DEPTH = 2, MTOK = BATCH * SEQ, NIN = 4096;
constexpr int C_HQ = 0, C_HF = 512, C_HI = 1024, C_HG = 1536, C_AQ = 2048, C_AK = 2560, C_AV = 3072, C_AG = 3584;
constexpr float NORM_EPS = 1e-6f;

constexpr size_t MiB = 1u << 20;
constexpr size_t WS_CTL = 0, CTL_ZERO_BYTES = 1 * MiB;
constexpr size_t WS_WIN = 2 * MiB;
constexpr size_t WS_WOUT = 18 * MiB;
constexpr size_t WS_LB = 22 * MiB;
constexpr size_t WS_KPART = 22 * MiB + 65536;
constexpr size_t WS_ROWSS = 24 * MiB;
constexpr size_t WS_DEC = 28 * MiB;
constexpr size_t WS_XB = 32 * MiB;
constexpr size_t WS_MIXED = 160 * MiB;
constexpr size_t WS_ARR = 224 * MiB;
constexpr size_t ARR_BYTES = 32 * MiB;
constexpr size_t WS_END = 480 * MiB;
constexpr int CW_QUEUE = 1024;
constexpr int CW_BAR = 4096;

constexpr int RING_OFF = 0, RING_BYTES = 131072;
constexpr int EXTRA_OFF = RING_BYTES, EXTRA_BYTES = 16384;
constexpr int LDSCTL_OFF = EXTRA_OFF + EXTRA_BYTES, MISC_OFF = LDSCTL_OFF + 320;
constexpr int LDS_BYTES = LDSCTL_OFF + 1024;

#define GAS __attribute__((address_space(1)))
#define LAS __attribute__((address_space(3)))
typedef unsigned short bf16;
typedef unsigned v4u __attribute__((ext_vector_type(4)));
typedef float f32x4 __attribute__((ext_vector_type(4)));
typedef GAS unsigned gu32;
#define RLX_AGENT __ATOMIC_RELAXED, __HIP_MEMORY_SCOPE_AGENT
#define LDS_WAIT() asm volatile("s_waitcnt lgkmcnt(0)" ::: "memory")
#define VM_WAIT() asm volatile("s_waitcnt vmcnt(0)" ::: "memory")
__device__ __forceinline__ unsigned f2bf(float f) { unsigned u = __builtin_bit_cast(unsigned, f); return (u + 0x7fffu + ((u >> 16) & 1u)) >> 16; }
__device__ __forceinline__ unsigned pk2(float lo, float hi) { return f2bf(lo) | (f2bf(hi) << 16); }
__device__ __forceinline__ float bf2f(unsigned short b) { return __builtin_bit_cast(float, (unsigned)b << 16); }
__device__ __forceinline__ float bflo(unsigned w) { return __builtin_bit_cast(float, w << 16); }
__device__ __forceinline__ float bfhi(unsigned w) { return __builtin_bit_cast(float, w & 0xffff0000u); }
__device__ __forceinline__ float silu_f(float z) { return z / (1.0f + __expf(-z)); }
__device__ __forceinline__ float sigmoid_f(float z) { return 1.0f / (1.0f + __expf(-z)); }

#define XB_TMO      128
#define XB_XCNT(j)  (256  + 64 * (j))
#define XB_XSUB(j)  (1280 + 64 * (j))
#define XB_XGEN(j)  (2304 + 64 * (j))
#define XB_TOP      3328
#define XB_TOPGEN   3392
#define XCD_BAR_WORDS 3456
#define XB_SPIN_CAP (1u << 18)

__device__ __forceinline__ unsigned xb_ld(unsigned* p)              { return __hip_atomic_load(p, __ATOMIC_RELAXED, __HIP_MEMORY_SCOPE_AGENT); }
__device__ __forceinline__ unsigned xb_add(unsigned* p, unsigned v) { return __hip_atomic_fetch_add(p, v, __ATOMIC_RELAXED, __HIP_MEMORY_SCOPE_AGENT); }
__device__ __forceinline__ unsigned xb_xcc_id() { return (unsigned)__builtin_amdgcn_s_getreg((3 << 11) | 20) & 0xFu; }
#define XB_SPIN(cond, bar) do { unsigned _sp = 0; while (cond) { __builtin_amdgcn_s_sleep(1); \
    if ((++_sp & 255u) == 0u) { if (xb_ld(&(bar)[XB_TMO])) break; if (_sp > XB_SPIN_CAP) { atomicAdd(&(bar)[XB_TMO], 1u); break; } } } } while (0)

struct XcdBarrier {
    unsigned* bar; unsigned x; int wave0;
    volatile LAS unsigned* st;
};

#define XB_IS_T0(wv) ((wv) == 0 && lane_id_asm() == 0)
__device__ __forceinline__ XcdBarrier xcd_barrier_post(unsigned* bar, volatile LAS unsigned* st, int wave0) {
    XcdBarrier b; b.bar = bar; b.x = xb_xcc_id(); b.st = st; b.wave0 = wave0;
    if (XB_IS_T0(wave0)) (void)xb_add(&bar[XB_XCNT(b.x)], 1u);
    return b;
}
__device__ __forceinline__ void xcd_barrier_complete(unsigned* bar, unsigned x, unsigned& nloc, unsigned& nx) {
    const unsigned G = gridDim.x * gridDim.y * gridDim.z;
    unsigned sum, cnt, mine, sp = 0u;
    for (;;) {
        sum = 0u; cnt = 0u; mine = 0u;
#pragma unroll
        for (unsigned j = 0; j < 16; ++j) { const unsigned c = xb_ld(&bar[XB_XCNT(j)]); sum += c; cnt += (c > 0u) ? 1u : 0u; mine = (j == x) ? c : mine; }
        if (sum == G) break;
        __builtin_amdgcn_s_sleep(1);
        if ((++sp & 255u) == 0u) { if (xb_ld(&bar[XB_TMO])) break; if (sp > XB_SPIN_CAP) { atomicAdd(&bar[XB_TMO], 1u); break; } }
    }
    nloc = mine > 0u ? mine : 1u; nx = cnt > 0u ? cnt : 1u;
}

__device__ __forceinline__ void xcd_barrier(const XcdBarrier& b) {
    asm volatile("s_waitcnt vmcnt(0)" ::: "memory");
    __syncthreads();
    if (XB_IS_T0(b.wave0)) {
        unsigned* bar = b.bar;
        __builtin_amdgcn_s_waitcnt(0);
        unsigned nloc = b.st[0], nx = b.st[1];
        if (nloc == 0u) { xcd_barrier_complete(bar, b.x, nloc, nx); b.st[0] = nloc; b.st[1] = nx; }
        const unsigned old = xb_add(&bar[XB_XSUB(b.x)], 1u);
        const unsigned gen = old / nloc;
        if (old + 1u == (gen + 1u) * nloc) {
            __builtin_amdgcn_fence(__ATOMIC_RELEASE, "agent");
            asm volatile("s_waitcnt vmcnt(0)" ::: "memory");
            const unsigned og = xb_add(&bar[XB_TOP], 1u);
            const unsigned tg = og / nx;
            if (og + 1u == (tg + 1u) * nx) xb_add(&bar[XB_TOPGEN], 1u);
            else XB_SPIN(xb_ld(&bar[XB_TOPGEN]) == tg, bar);
            __builtin_amdgcn_fence(__ATOMIC_ACQUIRE, "agent");
            xb_add(&bar[XB_XGEN(b.x)], 1u);
            asm volatile("s_waitcnt vmcnt(0)" ::: "memory");
        } else {
            XB_SPIN(xb_ld(&bar[XB_XGEN(b.x)]) == gen, bar);
            __builtin_amdgcn_fence(__ATOMIC_ACQUIRE, "agent");
            asm volatile("s_waitcnt vmcnt(0)" ::: "memory");
        }
    }
    __syncthreads();
}


struct Frame {
    LAS unsigned char* lds;
    volatile LAS unsigned* MISC;
    int wave0;
    gu32* ctl;
    int vcu, G;
    const float* x; float* out;
    const float *norm_w, *w_in, *lb_logits, *hg_norm_w, *q_norm_w, *k_norm_w, *w_out;
    bf16 *WIN, *WOUT, *XB, *MIXED, *QI, *KT, *HI, *GH, *QN, *KN, *V, *GA;
    float *LB, *KPART, *ROWSS, *DEC;
};

__device__ __forceinline__ float wave_sum(float v) {
#pragma unroll
    for (int o = 1; o < 64; o <<= 1) v += __shfl_xor(v, o);
    return v;
}
__device__ __forceinline__ int win_dest(int oc) {
    if (oc < 2048) { const int grp = oc >> 9, hh = (oc >> 7) & 3, w = oc & 127; return 256 * (((grp >> 1) << 2) + hh) + 128 * (grp & 1) + w; }
    const int ty = (oc - 2048) >> 9, head = (oc >> 6) & 7, bj = (oc >> 5) & 1; return 256 * (8 + 2 * ty + (head >> 2)) + 128 * bj + 32 * (head & 3);
}
__device__ __forceinline__ void p0_transpose_item(const float* W, int K, int N, bf16* WT, const float* kscale, LAS float* scr, int item, int lane, bool permute) {
    const int nblk = N / 32, kb = item / nblk, nb = item % nblk, k0 = 64 * kb, n0 = 32 * nb; const int nd = permute ? win_dest(n0) : n0;
    float wv_[32];
#pragma unroll
    for (int i = 0; i < 32; ++i) wv_[i] = W[(size_t)(k0 + 2 * i + (lane >> 5)) * N + n0 + (lane & 31)];
#pragma unroll
    for (int i = 0; i < 32; ++i) { const int kk = 2 * i + (lane >> 5); const float s = kscale ? kscale[k0 + kk] : 1.0f; scr[kk * 33 + (lane & 31)] = wv_[i] * s; }
    LDS_WAIT(); asm volatile("" ::: "memory");
    const int c = lane & 7;
#pragma unroll
    for (int j = 0; j < 4; ++j) { const int n = (lane >> 3) + 8 * j; const LAS float* s = scr + (8 * c) * 33 + n;
        v4u o; o.x = pk2(s[0 * 33], s[1 * 33]); o.y = pk2(s[2 * 33], s[3 * 33]); o.z = pk2(s[4 * 33], s[5 * 33]); o.w = pk2(s[6 * 33], s[7 * 33]);
        *(GAS v4u*)(WT + (size_t)(nd + n) * K + k0 + 8 * c) = o; }
    LDS_WAIT(); asm volatile("" ::: "memory");
}
#define PHASE_IDS() int t_ = F.wave0 * 64 + lane_id_asm(); asm volatile("" : "+v"(t_)); const int tid = t_, lane = tid & 63, wave = __builtin_amdgcn_readfirstlane(tid >> 6); (void)lane; (void)wave
__device__ __forceinline__ void p0_prologue(Frame& F) {
    PHASE_IDS();
    LAS float* scr = (LAS float*)(F.lds + RING_OFF + wave * 16384);
    const int gw = F.vcu * NWAVES + wave, NGW = F.G * NWAVES;
    constexpr int I_IN = (DM / 64) * (NIN / 32), I_OUT = (DM / 64) * (DM / 32);
    constexpr int NITEMS = DEPTH * (I_IN + I_OUT);
    for (int it = gw; it < NITEMS; it += NGW) {
        int r = it;
        if (r < DEPTH * I_IN) { const int l = r / I_IN; r -= l * I_IN;
            p0_transpose_item(F.w_in + (size_t)l * DM * NIN, DM, NIN, F.WIN + (size_t)l * NIN * DM, F.norm_w + l * DM, scr, r, lane, true); continue; }
        r -= DEPTH * I_IN; { const int l = r / I_OUT; r -= l * I_OUT;
            p0_transpose_item(F.w_out + (size_t)l * DM * DM, DM, DM, F.WOUT + (size_t)l * DM * DM, nullptr, scr, r, lane, false); }
    }
    for (int m0 = gw * 4; m0 < MTOK; m0 += NGW * 4) {
        f32x4 v[4][4]; float sq[4];
#pragma unroll
        for (int r = 0; r < 4; ++r) { const GAS f32x4* xr = (const GAS f32x4*)(F.x + (size_t)(m0 + r) * DM) + lane;
#pragma unroll
            for (int j = 0; j < 4; ++j) v[r][j] = xr[64 * j]; }
#pragma unroll
        for (int r = 0; r < 4; ++r) { float a = 0.f;
#pragma unroll
            for (int j = 0; j < 4; ++j) a += (v[r][j].x * v[r][j].x + v[r][j].y * v[r][j].y) + (v[r][j].z * v[r][j].z + v[r][j].w * v[r][j].w);
            sq[r] = a; }
#pragma unroll
        for (int o = 1; o < 64; o <<= 1) {
#pragma unroll
            for (int r = 0; r < 4; ++r) sq[r] += __shfl_xor(sq[r], o); }
#pragma unroll
        for (int r = 0; r < 4; ++r) { GAS unsigned long long* o8 = (GAS unsigned long long*)(F.XB + (size_t)(m0 + r) * DM) + lane;
#pragma unroll
            for (int j = 0; j < 4; ++j) o8[64 * j] = (unsigned long long)pk2(v[r][j].x, v[r][j].y) | ((unsigned long long)pk2(v[r][j].z, v[r][j].w) << 32);
            if (lane < 16) F.ROWSS[(size_t)(m0 + r) * 16 + lane] = (lane == 0) ? sq[r] : 0.f; }
    }
    if (blockIdx.x == 0) { const int c = tid; const float a0 = F.lb_logits[c], a1 = F.lb_logits[512 + c]; const float mx = fmaxf(a0, a1);
        const float e0 = expf(a0 - mx), e1 = expf(a1 - mx); const float p0 = e0 / (e0 + e1), p1 = e1 / (e0 + e1);
        F.LB[c] = 0.f; F.LB[512 + c] = fminf(fmaxf((p0 + p1) - p0, 0.f), 1.0f - 1e-6f); }
}

constexpr float LOG2E = 1.4426950408889634f;
constexpr float QSCALE2 = 0.125f * LOG2E;
namespace moba {
typedef short bf16x8 __attribute__((ext_vector_type(8)));
typedef short s16x4 __attribute__((ext_vector_type(4)));
typedef float f32x16 __attribute__((ext_vector_type(16)));
typedef float f32x2_t __attribute__((ext_vector_type(2))); typedef __bf16 bf16x2_t __attribute__((ext_vector_type(2)));
__device__ __forceinline__ unsigned cvtpk(float lo, float hi) { f32x2_t v = {lo, hi}; bf16x2_t b = __builtin_convertvector(v, bf16x2_t); return __builtin_bit_cast(unsigned, b); }
__device__ __forceinline__ int crow(int r, int hi) { return (r & 3) + 8 * (r >> 2) + 4 * hi; }
constexpr int L_K = 0, L_V = 32768, L_WSF = 65536, L_KM = 67584, L_OST = 69632;
constexpr float NEG_BIG = -1e30f;
constexpr float THR = 8.0f;
__device__ __forceinline__ s16x4 vtr(const LAS unsigned char* p) { return __builtin_bit_cast(s16x4, __builtin_amdgcn_ds_read_tr16_b64_v4i16((LAS s16x4*)p)); }
}

__device__ __forceinline__ void moba_glds(unsigned voff, const void* sbase, unsigned lds_dst) { unsigned keep;
    asm volatile("s_mov_b32 %0, m0\n\ts_mov_b32 m0, %3\n\ts_nop 0\n\tglobal_load_lds_dwordx4 %1, %2\n\ts_mov_b32 m0, %0" : "=&s"(keep) : "v"(voff), "s"(sbase), "s"(lds_dst) : "memory"); }
__device__ __forceinline__ void moba_mfma_phase(Frame& F, int l) {
    using namespace moba;
    PHASE_IDS();
    const int r32 = lane & 31, hi = lane >> 5, wid = wave;
    LAS unsigned char* L = F.lds + RING_OFF;
    LAS float* wsf = (LAS float*)(L + L_WSF) + wid * 64;
    LAS float* km = (LAS float*)(L + L_KM);
    LAS float* ost = (LAS float*)(L + L_OST) + wid * 2048;
    float gq = fabsf(F.q_norm_w[l * 64 + lane]), gk = fabsf(F.k_norm_w[l * 64 + lane]);
#pragma unroll
    for (int o = 1; o < 64; o <<= 1) { gq = fmaxf(gq, __shfl_xor(gq, o)); gk = fmaxf(gk, __shfl_xor(gk, o)); }
    gq = __builtin_bit_cast(float, __builtin_amdgcn_readfirstlane(__builtin_bit_cast(int, gq))); gk = __builtin_bit_cast(float, __builtin_amdgcn_readfirstlane(__builtin_bit_cast(int, gk)));
    const float smax2 = 8.0f * gq * gk * LOG2E * 1.02f;
    const float mhat0 = -(smax2 + 1.0f);
    gu32* qctr = F.ctl + CW_QUEUE + 64 * l;
    volatile LAS unsigned* tick = (volatile LAS unsigned*)(F.lds + EXTRA_OFF + 8192);
    if (tid == 0) tick[0] = __hip_atomic_fetch_add(qctr, 1u, RLX_AGENT);
    for (int ui = 0;; ++ui) {
        __syncthreads();
        const int it = __builtin_amdgcn_readfirstlane((int)tick[ui & 1]); if (it >= 1024) break;
        const int qb = 7 - (it >> 7), bh = it & 127;
        const int b = bh >> 3, h = bh & 7; const size_t rowbase = (size_t)b * SEQ; const int q0 = qb * 256, qrel = wid * 32 + r32, tq = q0 + qrel;
        const float sl2 = exp2f(-(float)(h + 1)) * LOG2E;
        bf16x8 qr[4];
        { const GAS bf16* Qw = (const GAS bf16*)(F.QN + (rowbase + q0 + wid * 32 + r32) * 512 + h * 64 + hi * 8);
#pragma unroll
            for (int d0 = 0; d0 < 4; ++d0) qr[d0] = *(const GAS bf16x8*)(Qw + d0 * 16); }
        LAS unsigned char* qlds = (LAS unsigned char*)ost + lane * 16;
        if (tid < qb * 64) { const GAS float* kp = (const GAS float*)(F.KPART + ((size_t)b * 8 + (tid >> 6)) * 1024 + h * 64 + (tid & 63)); km[tid] = (kp[0] + kp[512]) * (1.0f / 256.0f); }
        const unsigned koff = (unsigned)(((rowbase + lane) * 512 + h * 64 + wid * 8) * 2);
        unsigned voff; { const int vr = 8 * wid + (lane >> 3), sl = lane & 7; const int ch = ((((sl >> 2) ^ ((vr >> 1) & 1)) << 2) | (sl & 3)); voff = (unsigned)((((size_t)MTOK + rowbase + vr) * 512 + h * 64 + ch * 8) * 2); }
        const unsigned lds0 = (unsigned)(uintptr_t)L;
#define MOBA_ISSUE(t_, bufi) do { moba_glds(koff, (const void*)((const char*)F.KN + (size_t)(t_) * 65536), (unsigned)__builtin_amdgcn_readfirstlane((int)(lds0 + L_K + (bufi) * 8192 + wid * 1024))); \
            moba_glds(voff, (const void*)((const char*)F.KN + (size_t)(t_) * 65536), (unsigned)__builtin_amdgcn_readfirstlane((int)(lds0 + L_V + (bufi) * 8192 + wid * 1024))); } while (0)
        const int NT = 4 * (qb + 1);
        int t0 = 0; { const float dstar = (151.0f + 2.0f * smax2) / sl2; const float x = ((float)(q0 - 63) - dstar) * (1.0f / 64.0f); if (x > 0.f) t0 = ((int)x) & ~1; if (t0 > NT - 4) t0 = NT - 4; t0 = __builtin_amdgcn_readfirstlane(t0); }
        unsigned nticket = 0u; if (tid == 0) nticket = __hip_atomic_fetch_add(qctr, 1u, RLX_AGENT);
        MOBA_ISSUE(t0, 0); MOBA_ISSUE(t0 + 1, 1); MOBA_ISSUE(t0 + 2, 2);
        __syncthreads();
        unsigned selmask = 0;
        { float gt[7];
#pragma unroll
            for (int j = 0; j < 7; ++j) { float s = 0.f;
                if (j < qb) {
#pragma unroll
                    for (int d0 = 0; d0 < 4; ++d0)
#pragma unroll
                        for (int e = 0; e < 8; ++e) s += bf2f((unsigned short)qr[d0][e]) * km[j * 64 + d0 * 16 + hi * 8 + e];
                    auto rr = __builtin_amdgcn_permlane32_swap(__float_as_uint(s), __float_as_uint(s), false, false);
                    s = __uint_as_float(rr[0]) + __uint_as_float(rr[1]); }
                gt[j] = s; }
#pragma unroll
            for (int j = 0; j < 7; ++j) { int rank = 0;
#pragma unroll
                for (int i = 0; i < 7; ++i) if (i != j && i < qb) rank += (gt[i] > gt[j] || (gt[i] == gt[j] && i < j)) ? 1 : 0;
                if (j < qb && rank < 3) selmask |= 1u << j; } }
#pragma unroll
        for (int d0 = 0; d0 < 4; ++d0) *(LAS bf16x8*)(qlds + d0 * 1024) = qr[d0];
        float mhat = mhat0, l_reg = 0.f; f32x16 o[2]; o[0] = f32x16{}; o[1] = f32x16{};
        const int kbase = L_K + hi * 1024 + r32 * 16;
        const int g16 = lane >> 4, i16 = lane & 15, tq4 = i16 >> 2, tp4 = i16 & 3;
        const int vrow0 = 4 * hi + tq4;
        if (tid == 0) tick[(ui + 1) & 1] = nticket;
        asm volatile("s_waitcnt vmcnt(2)" ::: "memory");
        __syncthreads();
#define MOBA_KLOAD(KOFF) do { _Pragma("unroll") for (int d0 = 0; d0 < 4; ++d0) qf_[d0] = *(const LAS bf16x8*)(qlds + d0 * 1024); \
            _Pragma("unroll") for (int d0 = 0; d0 < 4; ++d0) { \
            kfr[2 * d0] = *(const LAS bf16x8*)(L + (KOFF) + kbase + d0 * 2048); kfr[2 * d0 + 1] = *(const LAS bf16x8*)(L + (KOFF) + kbase + d0 * 2048 + 512); } } while (0)
#define MOBA_VLOAD(VOFF) do { _Pragma("unroll") for (int dblk = 0; dblk < 2; ++dblk) _Pragma("unroll") for (int ks = 0; ks < 4; ++ks) { \
            const int rlo = 16 * ks + vrow0, rhi = rlo + 8; \
            vlo[dblk * 4 + ks] = vtr(L + L_V + (VOFF) + rlo * 128 + ((dblk ^ ((rlo >> 1) & 1)) * 64) + (16 * (g16 & 1) + 4 * tp4) * 2); \
            vhi[dblk * 4 + ks] = vtr(L + L_V + (VOFF) + rhi * 128 + ((dblk ^ ((rhi >> 1) & 1)) * 64) + (16 * (g16 & 1) + 4 * tp4) * 2); } } while (0)
#define MOBA_QK(TT, P0, P1) do { \
            const int blk_ = (TT) >> 2; const bool own_ = (blk_ == qb); \
            if (!(own_ && (64 * ((TT) & 3) > 32 * wid + 31))) { \
                const bool sel_ = own_ || ((selmask >> blk_) & 1u); \
                const float sc0_ = sel_ ? (-mhat - sl2 * (float)(tq - 64 * (TT) - 4 * hi)) : NEG_BIG; \
_Pragma("unroll") \
                for (int r = 0; r < 16; ++r) { P0[r] = __builtin_fmaf(sl2, (float)((r & 3) + 8 * (r >> 2)), sc0_); P1[r] = __builtin_fmaf(sl2, (float)(32 + (r & 3) + 8 * (r >> 2)), sc0_); } \
_Pragma("unroll") \
                for (int d0 = 0; d0 < 4; ++d0) { \
                    P0 = __builtin_amdgcn_mfma_f32_32x32x16_bf16(kfr[2 * d0], qf_[d0], P0, 0, 0, 0); \
                    P1 = __builtin_amdgcn_mfma_f32_32x32x16_bf16(kfr[2 * d0 + 1], qf_[d0], P1, 0, 0, 0); } \
            } } while (0)
#define MOBA_SMPV(TT, P0, P1, HAVE_NEXT, N0, N1) do { \
            const int blk = (TT) >> 2; const bool own = (blk == qb); const int jb = (TT) & 3; \
            if (!(own && (64 * jb > 32 * wid + 31))) { \
                if (own && (64 * jb + 63 > 32 * wid)) { \
_Pragma("unroll") \
                    for (int r = 0; r < 16; ++r) { const int kvl = 64 * jb + crow(r, hi); if (kvl > qrel) P0[r] = NEG_BIG; if (kvl + 32 > qrel) P1[r] = NEG_BIG; } } \
                float rm = fmaxf(fmaxf(P0[0], P1[0]), fmaxf(P0[1], P1[1])); float rm2 = fmaxf(fmaxf(P0[2], P1[2]), fmaxf(P0[3], P1[3])); \
_Pragma("unroll") \
                for (int r = 4; r < 16; r += 2) { rm = fmaxf(rm, fmaxf(P0[r], P1[r])); rm2 = fmaxf(rm2, fmaxf(P0[r + 1], P1[r + 1])); } \
                rm = fmaxf(rm, rm2); \
                { auto rr = __builtin_amdgcn_permlane32_swap(__float_as_uint(rm), __float_as_uint(rm), false, false); rm = fmaxf(__uint_as_float(rr[0]), __uint_as_float(rr[1])); } \
                if (__any(rm > THR)) { \
                    const float dl = fmaxf(rm, 0.f); mhat += dl; \
_Pragma("unroll") \
                    for (int r = 0; r < 16; ++r) { P0[r] -= dl; P1[r] -= dl; } \
                    if (HAVE_NEXT) { \
_Pragma("unroll") \
                        for (int r = 0; r < 16; ++r) { N0[r] -= dl; N1[r] -= dl; } } \
                    const float f = __builtin_amdgcn_exp2f(-dl); l_reg *= f; \
                    if (hi == 0) wsf[r32] = f; \
_Pragma("unroll") \
                    for (int r = 0; r < 16; ++r) { const float fr = wsf[crow(r, hi)]; o[0][r] *= fr; o[1][r] *= fr; } } \
                float sacc = 0.f, sacc2 = 0.f; \
_Pragma("unroll") \
                for (int r = 0; r < 16; ++r) { P0[r] = __builtin_amdgcn_exp2f(P0[r]); P1[r] = __builtin_amdgcn_exp2f(P1[r]); sacc += P0[r]; sacc2 += P1[r]; } \
                l_reg += sacc + sacc2; \
                bf16x8 pa[4]; \
                { v4u w; \
_Pragma("unroll") \
                    for (int ks = 0; ks < 4; ++ks) { \
_Pragma("unroll") \
                        for (int e = 0; e < 4; ++e) { const int rb = (ks & 1) * 8 + 2 * e; w[e] = (ks < 2) ? cvtpk(P0[rb], P0[rb + 1]) : cvtpk(P1[rb], P1[rb + 1]); } \
                        pa[ks] = __builtin_bit_cast(bf16x8, w); } } \
_Pragma("unroll") \
                for (int dblk = 0; dblk < 2; ++dblk) \
_Pragma("unroll") \
                    for (int ks = 0; ks < 4; ++ks) { \
                        const s16x4 lo = vlo[dblk * 4 + ks], hh = vhi[dblk * 4 + ks]; \
                        const bf16x8 vf = (bf16x8){lo[0], lo[1], lo[2], lo[3], hh[0], hh[1], hh[2], hh[3]}; \
                        o[dblk] = __builtin_amdgcn_mfma_f32_32x32x16_bf16(pa[ks], vf, o[dblk], 0, 0, 0); } \
            } } while (0)
        f32x16 pA0, pA1, pB0, pB1; bf16x8 kfr[8], qf_[4]; s16x4 vlo[8], vhi[8];
        MOBA_KLOAD(0); MOBA_QK(t0, pA0, pA1);
        int c0o = 0;
        for (int t = t0; t < NT; t += 2) {
            const int c1o = (c0o + 1) & 3, c2o = (c0o + 2) & 3, c3o = (c0o + 3) & 3;
            if (t + 3 < NT) MOBA_ISSUE(t + 3, c3o);
            MOBA_KLOAD(c1o * 8192); __builtin_amdgcn_sched_barrier(0);
            MOBA_QK(t + 1, pB0, pB1); __builtin_amdgcn_sched_barrier(0);
            MOBA_VLOAD(c0o * 8192); __builtin_amdgcn_sched_barrier(0);
            MOBA_SMPV(t, pA0, pA1, true, pB0, pB1);
            if (t + 3 < NT) asm volatile("s_waitcnt vmcnt(2)" ::: "memory"); else asm volatile("s_waitcnt vmcnt(0)" ::: "memory");
            __syncthreads();
            if (t + 4 < NT) MOBA_ISSUE(t + 4, c0o);
            if (t + 2 < NT) { MOBA_KLOAD(c2o * 8192); __builtin_amdgcn_sched_barrier(0); MOBA_QK(t + 2, pA0, pA1); __builtin_amdgcn_sched_barrier(0); }
            MOBA_VLOAD(c1o * 8192); __builtin_amdgcn_sched_barrier(0);
            MOBA_SMPV(t + 1, pB0, pB1, (t + 2 < NT), pA0, pA1);
            if (t + 4 < NT) asm volatile("s_waitcnt vmcnt(2)" ::: "memory"); else asm volatile("s_waitcnt vmcnt(0)" ::: "memory");
            __syncthreads();
            c0o = c2o;
        }
#undef MOBA_ISSUE
#undef MOBA_KLOAD
#undef MOBA_VLOAD
#undef MOBA_QK
#undef MOBA_SMPV
        v4u gwv[4];
#pragma unroll
        for (int i = 0; i < 4; ++i) gwv[i] = *(const GAS v4u*)(F.GA + (rowbase + q0 + wid * 32 + i * 8 + (lane >> 3)) * 512 + h * 64 + (lane & 7) * 8);
        { auto rr = __builtin_amdgcn_permlane32_swap(__float_as_uint(l_reg), __float_as_uint(l_reg), false, false); l_reg = __uint_as_float(rr[0]) + __uint_as_float(rr[1]); }
        if (hi == 0) wsf[r32] = 1.0f / l_reg;
#pragma unroll
        for (int r = 0; r < 16; ++r) { const float rl = wsf[crow(r, hi)]; ost[crow(r, hi) * 64 + r32] = o[0][r] * rl; ost[crow(r, hi) * 64 + 32 + r32] = o[1][r] * rl; }
#pragma unroll
        for (int i = 0; i < 4; ++i) { const int row = i * 8 + (lane >> 3), ch = lane & 7;
            const f32x4 a = *(const LAS f32x4*)(ost + row * 64 + ch * 8), c2 = *(const LAS f32x4*)(ost + row * 64 + ch * 8 + 4);
            const size_t grow = rowbase + q0 + wid * 32 + row;
            const v4u gw = gwv[i];
            v4u ow; ow.x = pk2(a[0] * bflo(gw.x), a[1] * bfhi(gw.x)); ow.y = pk2(a[2] * bflo(gw.y), a[3] * bfhi(gw.y));
            ow.z = pk2(c2[0] * bflo(gw.z), c2[1] * bfhi(gw.z)); ow.w = pk2(c2[2] * bflo(gw.w), c2[3] * bfhi(gw.w));
            *(GAS v4u*)(F.MIXED + grow * DM + 512 + h * 64 + ch * 8) = ow; }
    }
    __syncthreads();
}


namespace hg {
typedef short bf16x8 __attribute__((ext_vector_type(8)));
typedef short s16x4 __attribute__((ext_vector_type(4)));
typedef float f32x4 __attribute__((ext_vector_type(4)));
typedef unsigned u32x2 __attribute__((ext_vector_type(2)));
constexpr int SLOT = 33792, NSLOT = 4;
constexpr int L_SC = NSLOT * SLOT, L_NRM = L_SC + 4096;
constexpr int NSTEP = SEQ / 32;
__device__ __forceinline__ int fsw(int t) { return ((t & 7) << 2) | (((t >> 3) & 1) << 1); }
__device__ __forceinline__ int unit_off(int tok, int cg) { return 8 * (32 * tok + (cg ^ fsw(tok))); }
__device__ __forceinline__ s16x4 rd64(const LAS unsigned char* p) { return *(const LAS s16x4*)p; }
__device__ __forceinline__ s16x4 vtr(const LAS unsigned char* p) { return __builtin_bit_cast(s16x4, __builtin_amdgcn_ds_read_tr16_b64_v4i16((LAS s16x4*)p)); }
__device__ __forceinline__ bf16x8 cat(s16x4 a, s16x4 b) { return (bf16x8){a[0], a[1], a[2], a[3], b[0], b[1], b[2], b[3]}; }
__device__ __forceinline__ s16x4 pack4(f32x4 v) { u32x2 w; w.x = moba::cvtpk(v[0], v[1]); w.y = moba::cvtpk(v[2], v[3]); return __builtin_bit_cast(s16x4, w); }
__device__ __forceinline__ void glds16(const GAS void* gsrc, unsigned lds_dst) { unsigned keep;
    asm volatile("s_mov_b32 %0, m0\n\ts_mov_b32 m0, %2\n\ts_nop 0\n\tglobal_load_lds_dwordx4 %1, off\n\ts_mov_b32 m0, %0" : "=&s"(keep) : "v"(gsrc), "s"(lds_dst) : "memory"); }
__device__ __forceinline__ void glds16s(unsigned voff, const void* sbase, unsigned lds_dst) { unsigned keep;
    asm volatile("s_mov_b32 %0, m0\n\ts_mov_b32 m0, %3\n\ts_nop 0\n\tglobal_load_lds_dwordx4 %1, %2\n\ts_mov_b32 m0, %0" : "=&s"(keep) : "v"(voff), "s"(sbase), "s"(lds_dst) : "memory"); }
#define HG_MFMA(a, b, c) __builtin_amdgcn_mfma_f32_16x16x32_bf16((a), (b), (c), 0, 0, 0)
}

__device__ __forceinline__ void hgrn_mfma_phase(Frame& F, int l) {
    using namespace hg;
    PHASE_IDS();
    const int w = wave, c16 = lane & 15, g = lane >> 4;
    LAS unsigned char* L = F.lds + RING_OFF;
    const s16x4 z4 = (s16x4){0, 0, 0, 0};
    for (int it = (int)blockIdx.x; it < 64; it += F.G) {
        const int b = it >> 2, h = it & 3; const size_t rowbase = (size_t)b * SEQ;
        const int da = w >> 1;
        unsigned dsrc[4];
#pragma unroll
        for (int i = 0; i < 4; ++i) { const int t = 16 * (w & 1) + 4 * i + (lane >> 4); const int sc = (lane & 15) ^ (fsw(t) >> 1);
            dsrc[i] = (unsigned)((((size_t)da * MTOK + rowbase + t) * 512 + h * 128 + 8 * sc) * 2); }
        const unsigned ddec = (unsigned)((((size_t)b * NSTEP) * 512 + h * 128 + 4 * lane) * 4);
        const int ddst = da * 8192 + (w & 1) * 4096;
        const unsigned lds0 = (unsigned)(uintptr_t)(F.lds + RING_OFF);
#define HG_ISSUE(step) do { const unsigned so_ = lds0 + (unsigned)(((step) & 3) * SLOT); \
            _Pragma("unroll") for (int i = 0; i < 4; ++i) \
                glds16s(dsrc[i], (const void*)((const char*)F.QI + (size_t)(step) * (32 * 512 * 2)), (unsigned)__builtin_amdgcn_readfirstlane((int)(so_ + ddst + i * 1024))); \
            if (w == 0) glds16s(ddec, (const void*)((const char*)F.DEC + (size_t)(step) * 2048), (unsigned)__builtin_amdgcn_readfirstlane((int)(so_ + 32768))); } while (0)
        f32x4 S[8]; bf16x8 Sb[4];
#pragma unroll
        for (int tk = 0; tk < 8; ++tk) S[tk] = (f32x4){0.f, 0.f, 0.f, 0.f};
#pragma unroll
        for (int ks = 0; ks < 4; ++ks) Sb[ks] = (bf16x8){0, 0, 0, 0, 0, 0, 0, 0};
        f32x4 oprev[2]; oprev[0] = (f32x4){0.f, 0.f, 0.f, 0.f}; oprev[1] = oprev[0];
        u32x2 gprev[2]; gprev[0] = (u32x2){0u, 0u}; gprev[1] = gprev[0];
        float hw[4];
#pragma unroll
        for (int r = 0; r < 4; ++r) hw[r] = F.hg_norm_w[l * 128 + 16 * w + 4 * g + r];
        asm volatile("" : "+v"(hw[0]), "+v"(hw[1]), "+v"(hw[2]), "+v"(hw[3]));
        LAS float* nrm = (LAS float*)(L + L_NRM);
        LAS unsigned char* SC = L + L_SC;
        HG_ISSUE(0); HG_ISSUE(1); HG_ISSUE(2);
        asm volatile("s_waitcnt vmcnt(8)\n\ts_barrier" ::: "memory");
        const int trq = c16 >> 2, trp = c16 & 3;
        int ro0 = unit_off(c16, g), ko0 = unit_off(4 * g + trq, trp);
#define RO(ks, e) (ro0 ^ (64 * (ks) + 32 * (e)))
#define KO(tk) (ko0 ^ (32 * (tk)))
        const int io_ = unit_off(4 * g + trq, 4 * w + trp), go_ = unit_off(c16, 4 * w + g);
        bf16x8 qf[2][4];
#define HG_LOADQ(slotbase) do { _Pragma("unroll") for (int tt = 0; tt < 2; ++tt) _Pragma("unroll") for (int ks = 0; ks < 4; ++ks) \
            qf[tt][ks] = cat(rd64((slotbase) + RO(ks, 0) + 4096 * tt), rd64((slotbase) + RO(ks, 1) + 4096 * tt)); } while (0)
#define HG_FINAL(step, P) do { _Pragma("unroll") for (int tt = 0; tt < 2; ++tt) { \
            const float ssum = ((P[tt][0] + P[tt][1]) + (P[tt][2] + P[tt][3])) + ((P[tt][4] + P[tt][5]) + (P[tt][6] + P[tt][7])); \
            const float rstd = __builtin_amdgcn_rsqf(ssum * (1.0f / 128.0f) + NORM_EPS); \
            u32x2 wv; wv.x = moba::cvtpk(oprev[tt][0] * rstd * hw[0] * bflo(gprev[tt].x), oprev[tt][1] * rstd * hw[1] * bfhi(gprev[tt].x)); \
            wv.y = moba::cvtpk(oprev[tt][2] * rstd * hw[2] * bflo(gprev[tt].y), oprev[tt][3] * rstd * hw[3] * bfhi(gprev[tt].y)); \
            *(GAS u32x2*)(F.MIXED + (rowbase + (size_t)(step) * 32 + 16 * tt + c16) * DM + h * 128 + 16 * w + 4 * g) = wv; } } while (0)
        HG_LOADQ(L);
        for (int n = 0; n < NSTEP; ++n) {
            asm volatile("" : "+v"(ro0), "+v"(ko0));
            if (n + 3 < NSTEP) HG_ISSUE(n + 3);
            const LAS unsigned char* Qs = L + (n & 3) * SLOT; const LAS unsigned char* Ks = Qs + 8192; const LAS unsigned char* Is = Qs + 16384; const LAS unsigned char* Gs = Qs + 24576;
            const LAS float* Ds = (const LAS float*)(Qs + 32768);
            LAS unsigned char* SCn = SC + (n & 1) * 1536;
            bf16x8 kf[4];
            if (w < 3) { const int st = (w == 2) ? 1 : 0;
#pragma unroll
                for (int ks = 0; ks < 4; ++ks) kf[ks] = cat(rd64(Ks + RO(ks, 0) + 4096 * st), rd64(Ks + RO(ks, 1) + 4096 * st)); }
            u32x2 gcur[2];
#pragma unroll
            for (int tt = 0; tt < 2; ++tt) gcur[tt] = *(const LAS u32x2*)(Gs + go_ + 4096 * tt);
            s16x4 itr[2];
#pragma unroll
            for (int st = 0; st < 2; ++st) itr[st] = vtr(Is + io_ + 4096 * st);
            const bf16x8 i01 = cat(itr[0], itr[1]);
            bf16x8 k01[4]; f32x4 dv4[4];
#pragma unroll
            for (int tk = 0; tk < 4; ++tk) { k01[tk] = cat(vtr(Ks + KO(tk)), vtr(Ks + KO(tk) + 4096)); dv4[tk] = *(const LAS f32x4*)(Ds + 16 * tk + 4 * g); }
            f32x4 o[2];
#pragma unroll
            for (int tt = 0; tt < 2; ++tt) { f32x4 a = (f32x4){0.f, 0.f, 0.f, 0.f};
#pragma unroll
                for (int ks = 0; ks < 4; ++ks) a = HG_MFMA(Sb[ks], qf[tt][ks], a);
                o[tt] = a; }
            if (w < 3) { f32x4 sc = (f32x4){0.f, 0.f, 0.f, 0.f};
                if (w == 0) {
#pragma unroll
                    for (int ks = 0; ks < 4; ++ks) sc = HG_MFMA(kf[ks], qf[0][ks], sc);
                } else {
#pragma unroll
                    for (int ks = 0; ks < 4; ++ks) sc = HG_MFMA(kf[ks], qf[1][ks], sc); }
                if (w != 1) {
#pragma unroll
                    for (int r = 0; r < 4; ++r) if (4 * g + r > c16) sc[r] = 0.f; }
                *(LAS s16x4*)(SCn + w * 512 + lane * 8) = pack4(sc); }
#pragma unroll
            for (int tk = 0; tk < 4; ++tk) S[tk] = HG_MFMA(k01[tk], i01, S[tk]);
            asm volatile("" ::: "memory");
            { bf16x8 k2[4]; f32x4 d2[4];
#pragma unroll
                for (int tk = 0; tk < 4; ++tk) { k2[tk] = cat(vtr(Ks + KO(tk + 4)), vtr(Ks + KO(tk + 4) + 4096)); d2[tk] = *(const LAS f32x4*)(Ds + 16 * (tk + 4) + 4 * g); }
#pragma unroll
                for (int tk = 0; tk < 4; ++tk) S[tk] = S[tk] * dv4[tk];
#pragma unroll
                for (int ks = 0; ks < 2; ++ks) Sb[ks] = cat(pack4(S[2 * ks]), pack4(S[2 * ks + 1]));
#pragma unroll
                for (int tk = 0; tk < 4; ++tk) S[tk + 4] = HG_MFMA(k2[tk], i01, S[tk + 4]);
#pragma unroll
                for (int tk = 0; tk < 4; ++tk) S[tk + 4] = S[tk + 4] * d2[tk];
#pragma unroll
                for (int ks = 2; ks < 4; ++ks) Sb[ks] = cat(pack4(S[2 * ks]), pack4(S[2 * ks + 1])); }
            if (n >= NSTEP - 3) asm volatile("s_waitcnt vmcnt(0) lgkmcnt(0)\n\ts_barrier" ::: "memory");
            else if (n <= 1) asm volatile("s_waitcnt vmcnt(8) lgkmcnt(0)\n\ts_barrier" ::: "memory");
            else if (n == 2) asm volatile("s_waitcnt vmcnt(10) lgkmcnt(0)\n\ts_barrier" ::: "memory");
            else asm volatile("s_waitcnt vmcnt(12) lgkmcnt(0)\n\ts_barrier" ::: "memory");
            const s16x4 sc00 = rd64(SCn + lane * 8), sc01 = rd64(SCn + 512 + lane * 8), sc11 = rd64(SCn + 1024 + lane * 8);
            float pn[2][8];
            if (n > 0) {
#pragma unroll
                for (int tt = 0; tt < 2; ++tt)
#pragma unroll
                    for (int ww = 0; ww < 8; ++ww) pn[tt][ww] = nrm[((n - 1) & 1) * 256 + ww * 32 + 16 * tt + c16]; }
            if (n + 1 < NSTEP) HG_LOADQ(L + ((n + 1) & 3) * SLOT);
            o[0] = HG_MFMA(cat(itr[0], z4), cat(sc00, z4), o[0]);
            o[1] = HG_MFMA(i01, cat(sc01, sc11), o[1]);
            { float ss0 = (o[0][0] * o[0][0] + o[0][1] * o[0][1]) + (o[0][2] * o[0][2] + o[0][3] * o[0][3]);
              float ss1 = (o[1][0] * o[1][0] + o[1][1] * o[1][1]) + (o[1][2] * o[1][2] + o[1][3] * o[1][3]);
              { auto r0 = __builtin_amdgcn_permlane16_swap(__float_as_uint(ss0), __float_as_uint(ss0), false, false); auto r1 = __builtin_amdgcn_permlane16_swap(__float_as_uint(ss1), __float_as_uint(ss1), false, false);
                ss0 = __uint_as_float(r0[0]) + __uint_as_float(r0[1]); ss1 = __uint_as_float(r1[0]) + __uint_as_float(r1[1]); }
              { auto r0 = __builtin_amdgcn_permlane32_swap(__float_as_uint(ss0), __float_as_uint(ss0), false, false); auto r1 = __builtin_amdgcn_permlane32_swap(__float_as_uint(ss1), __float_as_uint(ss1), false, false);
                ss0 = __uint_as_float(r0[0]) + __uint_as_float(r0[1]); ss1 = __uint_as_float(r1[0]) + __uint_as_float(r1[1]); }
              if (g == 0) { nrm[(n & 1) * 256 + w * 32 + c16] = ss0; nrm[(n & 1) * 256 + w * 32 + 16 + c16] = ss1; } }
            if (n > 0) HG_FINAL(n - 1, pn);
            oprev[0] = o[0]; oprev[1] = o[1]; gprev[0] = gcur[0]; gprev[1] = gcur[1];
        }
        asm volatile("s_waitcnt vmcnt(0) lgkmcnt(0)\n\ts_barrier" ::: "memory");
        { float pn[2][8];
#pragma unroll
            for (int tt = 0; tt < 2; ++tt)
#pragma unroll
                for (int ww = 0; ww < 8; ++ww) pn[tt][ww] = nrm[((NSTEP - 1) & 1) * 256 + ww * 32 + 16 * tt + c16];
            HG_FINAL(NSTEP - 1, pn); }
        asm volatile("s_waitcnt vmcnt(0) lgkmcnt(0)\n\ts_barrier" ::: "memory");
#undef RO
#undef KO
#undef HG_LOADQ
#undef HG_FINAL
#undef HG_ISSUE
    }
}

struct Args { const float* in[8]; float* out; unsigned char* ws; int ph_lo, ph_hi, li, pad; };
__global__ void __launch_bounds__(NWAVES * 64, 2) fwd(Args args) {
    extern __shared__ __attribute__((aligned(16))) unsigned char lds[];
    Frame F;
    F.lds = (LAS unsigned char*)lds;
    F.MISC = (volatile LAS unsigned*)(F.lds + MISC_OFF);
    F.G = gridDim.x; { const int bx = blockIdx.x; F.vcu = (F.G % 8 == 0) ? (bx % 8) * (F.G / 8) + bx / 8 : bx; }
    unsigned char* ws = args.ws;
    F.ctl = (gu32*)(ws + WS_CTL);
    F.x = args.in[0]; F.norm_w = args.in[1]; F.w_in = args.in[2]; F.lb_logits = args.in[3]; F.hg_norm_w = args.in[4]; F.q_norm_w = args.in[5]; F.k_norm_w = args.in[6]; F.w_out = args.in[7];
    F.out = args.out;
    F.WIN = (bf16*)(ws + WS_WIN); F.WOUT = (bf16*)(ws + WS_WOUT); F.XB = (bf16*)(ws + WS_XB); F.MIXED = (bf16*)(ws + WS_MIXED);
    F.QI = (bf16*)(ws + WS_ARR); F.KT = (bf16*)(ws + WS_ARR + ARR_BYTES); F.HI = (bf16*)(ws + WS_ARR + 2 * ARR_BYTES); F.GH = (bf16*)(ws + WS_ARR + 3 * ARR_BYTES);
    F.QN = (bf16*)(ws + WS_ARR + 4 * ARR_BYTES); F.KN = (bf16*)(ws + WS_ARR + 5 * ARR_BYTES); F.V = (bf16*)(ws + WS_ARR + 6 * ARR_BYTES); F.GA = (bf16*)(ws + WS_ARR + 7 * ARR_BYTES);
    F.LB = (float*)(ws + WS_LB); F.KPART = (float*)(ws + WS_KPART); F.ROWSS = (float*)(ws + WS_ROWSS); F.DEC = (float*)(ws + WS_DEC);
    F.wave0 = __builtin_amdgcn_readfirstlane((int)threadIdx.x >> 6);
    for (int u = F.wave0 * 64 + lane_id_asm(); u < (LDS_BYTES - LDSCTL_OFF) / 4; u += NWAVES * 64) ((LAS unsigned*)(F.lds + LDSCTL_OFF))[u] = 0u;
    __syncthreads();
    XcdBarrier bar; bar.bar = (unsigned*)(F.ctl + CW_BAR); bar.x = 0; bar.st = nullptr; bar.wave0 = F.wave0;
    if (N_LAUNCHES == 1) bar = xcd_barrier_post((unsigned*)(F.ctl + CW_BAR), F.MISC + 8, F.wave0);
#define GRID_BAR() do { if (N_LAUNCHES == 1) xcd_barrier(bar); } while (0)
    const int lo = args.ph_lo, hi = args.ph_hi;
#define IN(k) (lo <= (k) && (k) < hi)
#define BOTH(k) (IN(k) && IN((k) + 1))

    if (IN(0)) { p0_prologue(F); if (BOTH(0)) GRID_BAR(); }
    for (int l = 0; l < DEPTH; ++l) {
        const int pb = 1 + 3 * l;
        if (IN(pb)) {
            pg8::Gemm g{F.XB + (size_t)l * MTOK * DM, F.WIN + (size_t)l * NIN * DM, MTOK, NIN, DM}; pg8::StaticOrder S; S.init(MTOK, NIN, F.G, (int)blockIdx.x);
            pg8::EpiFused E{F.QI, F.DEC, F.KPART, F.ROWSS + (size_t)l * MTOK * 16, F.LB + l * 512, F.q_norm_w + l * 64, F.k_norm_w + l * 64};
            pg8::gemm_phase<pg8::EpiFused, pg8::StaticOrder, true, true>(F.lds + RING_OFF, g, S, E, F.wave0);
            if (BOTH(pb)) GRID_BAR();
        }
        if (IN(pb + 1)) { hgrn_mfma_phase(F, l); moba_mfma_phase(F, l); if (BOTH(pb + 1)) GRID_BAR(); }
        if (IN(pb + 2)) {
            pg8::Gemm g{F.MIXED, F.WOUT + (size_t)l * DM * DM, MTOK, DM, DM}; pg8::StaticOrder S; S.init(MTOK, DM, F.G, (int)blockIdx.x);
            pg8::EpiOut E{l == 0 ? F.x : nullptr, F.XB + (size_t)MTOK * DM, l == 0 ? nullptr : F.out, l == 0 ? F.XB + (size_t)MTOK * DM : nullptr, l == 0 ? F.ROWSS + (size_t)MTOK * 16 : nullptr};
            pg8::gemm_phase<pg8::EpiOut, pg8::StaticOrder, true, true>(F.lds + RING_OFF, g, S, E, F.wave0);
            if (pb + 2 < N_PHASES - 1 && BOTH(pb + 2)) GRID_BAR();
        }
    }
#undef IN
#undef BOTH
}

extern "C" void kernel_launch(void* const* d_in, const int* in_sizes, int n_in, void* d_out, int out_size, void* d_ws, size_t ws_size, hipStream_t stream) {
    static int grid = 0;
    if (grid == 0) {
        if (n_in != 8 || in_sizes[0] != MTOK * DM || out_size != MTOK * DM || ws_size < WS_END) { fprintf(stderr, "kernel_launch: unexpected shapes n_in %d in0 %d out %d ws %zu\n", n_in, n_in > 0 ? in_sizes[0] : -1, out_size, ws_size); grid = -1; return; }
        int dev = 0, cus = 0, per_cu = 0;
        if (hipGetDevice(&dev) != hipSuccess || hipDeviceGetAttribute(&cus, hipDeviceAttributeMultiprocessorCount, dev) != hipSuccess) { grid = -1; return; }
        if (hipFuncSetAttribute((const void*)fwd, hipFuncAttributeMaxDynamicSharedMemorySize, LDS_BYTES) != hipSuccess) { fprintf(stderr, "kernel_launch: hipFuncSetAttribute failed\n"); grid = -1; return; }
        if (hipOccupancyMaxActiveBlocksPerMultiprocessor(&per_cu, (const void*)fwd, NWAVES * 64, LDS_BYTES) != hipSuccess || per_cu < 1) fprintf(stderr, "kernel_launch: occupancy query says %d\n", per_cu);
        (void)hipGetLastError();
        if (per_cu < 1) { grid = -1; return; }
        grid = cus;
    }
    if (grid < 0) return;
    if (hipMemsetAsync((char*)d_ws + WS_CTL, 0, CTL_ZERO_BYTES, stream) != hipSuccess) return;
    Args a{};
    for (int i = 0; i < 8; ++i) a.in[i] = (const float*)d_in[i];
    a.out = (float*)d_out; a.ws = (unsigned char*)d_ws;
    for (int li = 0; li < N_LAUNCHES; ++li) {
        a.ph_lo = (N_LAUNCHES == 1) ? 0 : li; a.ph_hi = (N_LAUNCHES == 1) ? N_PHASES : li + 1; a.li = li;
        hipError_t le;
        if (N_LAUNCHES == 1) { void* kargs[] = {(void*)&a}; le = hipLaunchCooperativeKernel((const void*)fwd, dim3(grid), dim3(NWAVES * 64), kargs, LDS_BYTES, stream); }
        else { hipLaunchKernelGGL(fwd, dim3(grid), dim3(NWAVES * 64), LDS_BYTES, stream, a); le = hipPeekAtLastError(); }
        if (le != hipSuccess) { fprintf(stderr, "kernel_launch: launch %d failed: %s\n", li, hipGetErrorName(le)); break; }
    }
}
```

```cpp
#include <hip/hip_runtime.h>
#include <cstdio>
#include <cstdint>
__device__ __forceinline__ int lane_id_asm() { int l; asm volatile("v_mbcnt_lo_u32_b32 %0, -1, 0\n\tv_mbcnt_hi_u32_b32 %0, -1, %0" : "=v"(l)); return l; }
namespace pg8 {
#define PG8_LAS __attribute__((address_space(3)))
typedef unsigned short bf16_t;
typedef short bf16x8 __attribute__((ext_vector_type(8)));
typedef float f32x4 __attribute__((ext_vector_type(4)));
typedef unsigned u32x4 __attribute__((ext_vector_type(4)));
typedef unsigned u32x2 __attribute__((ext_vector_type(2)));
constexpr int BM = 256, BK = 64, HALF = 128, HTB = HALF * BK * 2  , STAGE_BYTES = 8 * HTB, NXCD = 8, WGM = 8;

__host__ __device__ __forceinline__ int lds_byte(int r, int c) { const int st = (r >> 4) * 2 + (c >> 5), rr = r & 15, cc = c & 31, ob = rr * 64 + cc * 2; return st * 1024 + (ob ^ (((ob >> 9) & 1) << 5)); }
__host__ __device__ __forceinline__ void stage_rc(int b, int& R, int& C) { const int st = b / 1024, sb = b % 1024, swz = sb ^ (((sb >> 9) & 1) << 5); R = (st >> 1) * 16 + swz / 64; C = (st & 1) * 32 + (swz % 64) / 2; }
__host__ __device__ __forceinline__ int perm32(int rho) { const int n = rho >> 4, i = rho & 15; return 8 * (i >> 2) + 4 * n + (i & 3); }

struct Unit { int pm, pn; };
struct Gemm { const bf16_t* A; const bf16_t* Bt; int M, N, K; };

struct StaticOrder {
    int nM, nN, nwg, G, c;
    __host__ __device__ void init(int M, int N, int G_, int c_) { nM = M / BM; nN = N / BM; nwg = nM * nN; G = G_; c = c_; }
    __host__ __device__ bool next(int i, Unit& u) const {
        const long L = (long)i * G + c; if (L >= nwg) return false;
        int wgid = (int)L; { const int q = nwg / NXCD, r = nwg % NXCD, xcd = wgid % NXCD, off = wgid / NXCD; wgid = (xcd < r ? xcd * (q + 1) : r * (q + 1) + (xcd - r) * q) + off; }
        const int nig = WGM * nN, gid = wgid / nig, fm = gid * WGM, gsz = (nM - fm) < WGM ? (nM - fm) : WGM;
        u.pm = fm + ((wgid % nig) % gsz); u.pn = (wgid % nig) / gsz; return true;
    }
    __device__ __forceinline__ void a_ready(const Unit&) const {}
    __device__ __forceinline__ void done(const Unit&) const {}
};

__device__ __forceinline__ unsigned cvt_pk_bf16(float lo, float hi) { unsigned r; asm volatile("v_cvt_pk_bf16_f32 %0, %1, %2" : "=v"(r) : "v"(lo), "v"(hi)); return r; }


__device__ __forceinline__ float dpp_row_shr(float v, int n) {
    const int x = __builtin_bit_cast(int, v);
    int r;
    if (n == 1) r = __builtin_amdgcn_update_dpp(0, x, 0x111, 0xf, 0xf, false);
    else if (n == 2) r = __builtin_amdgcn_update_dpp(0, x, 0x112, 0xf, 0xf, false);
    else if (n == 4) r = __builtin_amdgcn_update_dpp(0, x, 0x114, 0xf, 0xf, false);
    else r = __builtin_amdgcn_update_dpp(0, x, 0x118, 0xf, 0xf, false);
    return __builtin_bit_cast(float, r);
}
__device__ __forceinline__ float fsig(float z) { return __builtin_amdgcn_rcpf(1.0f + __expf(-z)); }
struct EpiFused {
    static constexpr bool PERM = true, AFTER_DRAIN = false;
    bf16_t* ARR; float* DEC; float* KPART; const float* rowss; const float* lb; const float* qg; const float* kg;
    static constexpr size_t AS = (size_t)32768 * 512;
    __device__ __forceinline__ float rstd_of(int row) const {
        const f32x4* rp = (const f32x4*)(rowss + (size_t)row * 16);
        const f32x4 a = rp[0], b = rp[1], c = rp[2], d = rp[3];
        const float ss = ((a[0] + a[1]) + (a[2] + a[3])) + ((b[0] + b[1]) + (b[2] + b[3])) + ((c[0] + c[1]) + (c[2] + c[3])) + ((d[0] + d[1]) + (d[2] + d[3]));
        return 1.0f / sqrtf(ss * (1.0f / 1024.0f) + 1e-6f);
    }
    static __device__ __forceinline__ u32x4 pack8(const float (&v)[8]) { u32x4 w; w.x = cvt_pk_bf16(v[0], v[1]); w.y = cvt_pk_bf16(v[2], v[3]); w.z = cvt_pk_bf16(v[4], v[5]); w.w = cvt_pk_bf16(v[6], v[7]); return w; }
    __device__ __forceinline__ void operator()(const f32x4 (&acc)[2][2][4][2], const Unit& u, int wr, int wc, int fr, int fq) const {
        const int row0 = u.pm * BM + wr * 64 + fr; const int pn = u.pn;
        if (pn < 4) {
            const int cb = pn * 128 + wc * 32 + 8 * fq;
            float lbv[8];
#pragma unroll
            for (int k = 0; k < 8; ++k) lbv[k] = lb[cb + k];
#pragma unroll
            for (int ai = 0; ai < 2; ++ai)
#pragma unroll
                for (int mp = 0; mp < 2; ++mp) { const int row1 = row0 + ai * HALF + mp * 32, row2 = row1 + 16; const float rs1 = rstd_of(row1), rs2 = rstd_of(row2);
                    float qi1[8], kt1[8], qi2[8], kt2[8], dc[8];
#pragma unroll
                    for (int k = 0; k < 8; ++k) {
                        const float zq1 = acc[ai][0][2 * mp][k >> 2][k & 3] * rs1, zf1 = acc[ai][1][2 * mp][k >> 2][k & 3] * rs1;
                        const float zq2 = acc[ai][0][2 * mp + 1][k >> 2][k & 3] * rs2, zf2 = acc[ai][1][2 * mp + 1][k >> 2][k & 3] * rs2;
                        const float f1 = lbv[k] + (1.0f - lbv[k]) * fsig(zf1), f2 = lbv[k] + (1.0f - lbv[k]) * fsig(zf2);
                        float b1 = __logf(f1), b2 = __logf(f2);
                        b1 += dpp_row_shr(b1, 1); b2 += dpp_row_shr(b2, 1); b1 += dpp_row_shr(b1, 2); b2 += dpp_row_shr(b2, 2);
                        b1 += dpp_row_shr(b1, 4); b2 += dpp_row_shr(b2, 4); b1 += dpp_row_shr(b1, 8); b2 += dpp_row_shr(b2, 8);
                        b2 += __shfl(b1, (fq << 4) | 15);
                        const float e1 = __expf(b1), e2 = __expf(b2);
                        qi1[k] = zq1 * fsig(zq1) * e1; kt1[k] = (1.0f - f1) * __expf(fminf(-b1, 80.0f));
                        qi2[k] = zq2 * fsig(zq2) * e2; kt2[k] = (1.0f - f2) * __expf(fminf(-b2, 80.0f)); dc[k] = e2; }
                    { const int pc = pn * 128 + wc * 32 + 16 * (fq & 1) + 4 * (fq >> 1);
                      const u32x4 a1 = pack8(qi1), b1 = pack8(kt1), a2 = pack8(qi2), b2 = pack8(kt2);
                      bf16_t* q1 = ARR + (size_t)row1 * 512 + pc; bf16_t* q2 = ARR + (size_t)row2 * 512 + pc;
                      *(u32x2*)(q1) = (u32x2){a1.x, a1.y}; *(u32x2*)(q1 + 8) = (u32x2){a1.z, a1.w}; *(u32x2*)(q1 + AS) = (u32x2){b1.x, b1.y}; *(u32x2*)(q1 + AS + 8) = (u32x2){b1.z, b1.w};
                      *(u32x2*)(q2) = (u32x2){a2.x, a2.y}; *(u32x2*)(q2 + 8) = (u32x2){a2.z, a2.w}; *(u32x2*)(q2 + AS) = (u32x2){b2.x, b2.y}; *(u32x2*)(q2 + AS + 8) = (u32x2){b2.z, b2.w}; }
                    if (fr == 15) { float* dp = DEC + (size_t)(row1 >> 5) * 512 + cb; *(f32x4*)dp = (f32x4){dc[0], dc[1], dc[2], dc[3]}; *(f32x4*)(dp + 4) = (f32x4){dc[4], dc[5], dc[6], dc[7]}; }
                    asm volatile("" ::: "memory"); }
        } else if (pn < 8) {
            const int cb = (pn - 4) * 128 + wc * 32 + 8 * fq;
#pragma unroll
            for (int ai = 0; ai < 2; ++ai)
#pragma unroll
                for (int m = 0; m < 4; ++m) { const int row = row0 + ai * HALF + m * 16; const float rs = rstd_of(row);
                    float iv[8], gv[8];
#pragma unroll
                    for (int k = 0; k < 8; ++k) { iv[k] = acc[ai][0][m][k >> 2][k & 3] * rs; const float zg = acc[ai][1][m][k >> 2][k & 3] * rs; gv[k] = zg * fsig(zg); }
                    *(u32x4*)(ARR + 2 * AS + (size_t)row * 512 + cb) = pack8(iv); *(u32x4*)(ARR + 3 * AS + (size_t)row * 512 + cb) = pack8(gv);
                    asm volatile("" ::: "memory"); }
        } else {
            const int ty = (pn - 8) >> 1, head = 4 * ((pn - 8) & 1) + wc; const int d0 = 8 * fq;
            bf16_t* dst = ARR + (size_t)(4 + ty) * AS;
            float gain[2][8]; float csum[2][8];
#pragma unroll
            for (int bj = 0; bj < 2; ++bj)
#pragma unroll
                for (int k = 0; k < 8; ++k) { gain[bj][k] = (ty == 0) ? qg[bj * 32 + d0 + k] * (0.125f * 1.4426950408889634f) : (ty == 1) ? kg[bj * 32 + d0 + k] : 1.0f; csum[bj][k] = 0.f; }
#pragma unroll
            for (int ai = 0; ai < 2; ++ai)
#pragma unroll
                for (int m = 0; m < 4; ++m) { const int row = row0 + ai * HALF + m * 16; const float rs = rstd_of(row);
                    float v[2][8];
#pragma unroll
                    for (int bj = 0; bj < 2; ++bj)
#pragma unroll
                        for (int k = 0; k < 8; ++k) v[bj][k] = acc[ai][bj][m][k >> 2][k & 3] * rs;
                    if (ty < 2) { float ss = 0.f;
#pragma unroll
                        for (int bj = 0; bj < 2; ++bj)
#pragma unroll
                            for (int k = 0; k < 8; ++k) ss += v[bj][k] * v[bj][k];
                        ss += __shfl_xor(ss, 16); ss += __shfl_xor(ss, 32);
                        const float r2 = 1.0f / sqrtf(ss * (1.0f / 64.0f) + 1e-6f);
#pragma unroll
                        for (int bj = 0; bj < 2; ++bj)
#pragma unroll
                            for (int k = 0; k < 8; ++k) { v[bj][k] *= r2 * gain[bj][k]; csum[bj][k] += v[bj][k]; }
                    } else if (ty == 3) {
#pragma unroll
                        for (int bj = 0; bj < 2; ++bj)
#pragma unroll
                            for (int k = 0; k < 8; ++k) v[bj][k] = v[bj][k] * fsig(v[bj][k]); }
                    *(u32x4*)(dst + (size_t)row * 512 + head * 64 + d0) = pack8(v[0]); *(u32x4*)(dst + (size_t)row * 512 + head * 64 + 32 + d0) = pack8(v[1]);
                    asm volatile("" ::: "memory"); }
            if (ty == 1) {
#pragma unroll
                for (int bj = 0; bj < 2; ++bj)
#pragma unroll
                    for (int k = 0; k < 8; ++k) { float s = csum[bj][k]; s += __shfl_xor(s, 1); s += __shfl_xor(s, 2); s += __shfl_xor(s, 4); s += __shfl_xor(s, 8); csum[bj][k] = s; }
                if (fr == 0) { float* kp = KPART + ((size_t)u.pm * 2 + wr) * 512 + head * 64 + d0;
#pragma unroll
                    for (int bj = 0; bj < 2; ++bj) { *(f32x4*)(kp + bj * 32) = (f32x4){csum[bj][0], csum[bj][1], csum[bj][2], csum[bj][3]}; *(f32x4*)(kp + bj * 32 + 4) = (f32x4){csum[bj][4], csum[bj][5], csum[bj][6], csum[bj][7]}; } }
            }
        }
    }
};
struct EpiOut {
    static constexpr bool PERM = false, AFTER_DRAIN = false;
    const float* xres; const bf16_t* xres16; float* out; bf16_t* xb; float* rowss;
    __device__ __forceinline__ void operator()(const f32x4 (&acc)[2][2][4][2], const Unit& u, int wr, int wc, int fr, int fq) const {
        const int col0 = u.pn * BM + wc * 32 + 4 * fq;
#pragma unroll
        for (int ai = 0; ai < 2; ++ai)
#pragma unroll
            for (int m = 0; m < 4; ++m) {
                const int row = u.pm * BM + ai * HALF + wr * 64 + m * 16 + fr; float ss = 0.f;
#pragma unroll
                for (int bj = 0; bj < 2; ++bj)
#pragma unroll
                    for (int n = 0; n < 2; ++n) { const size_t off = (size_t)row * 1024 + col0 + bj * HALF + n * 16;
                        f32x4 v;
                        if (xres) v = *(const f32x4*)(xres + off); else { const u32x2 r = *(const u32x2*)(xres16 + off); v = (f32x4){__builtin_bit_cast(float, r.x << 16), __builtin_bit_cast(float, r.x & 0xffff0000u), __builtin_bit_cast(float, r.y << 16), __builtin_bit_cast(float, r.y & 0xffff0000u)}; }
                        v = v + acc[ai][bj][m][n];
                        if (out) *(f32x4*)(out + off) = v;
                        if (xb) { u32x2 w; w.x = cvt_pk_bf16(v[0], v[1]); w.y = cvt_pk_bf16(v[2], v[3]); *(u32x2*)(xb + off) = w; }
                        ss += (v[0] * v[0] + v[1] * v[1]) + (v[2] * v[2] + v[3] * v[3]); }
                ss += __shfl_xor(ss, 16); ss += __shfl_xor(ss, 32);
                if (fq == 0 && rowss) rowss[(size_t)row * 16 + u.pn * 4 + wc] = ss;
            }
    }
};

template <class Epi, class Sched, bool ALIGN_EPI = false, bool SP2 = false>
__device__ __forceinline__ void gemm_phase(PG8_LAS unsigned char* lds, const Gemm g, const Sched& S, const Epi& E, const int wave0) {
    int tid = wave0 * 64 + lane_id_asm(); asm volatile("" : "+v"(tid));
    const int wid = __builtin_amdgcn_readfirstlane(tid >> 6), lane = tid & 63, wr = wid >> 2, wc = wid & 3, fr = lane & 15, fq = lane >> 4;
    const int K = g.K, nt = K / BK;
    unsigned voffA[2], voffB[2];
#pragma unroll
    for (int i = 0; i < 2; ++i) { int R, C; stage_rc(tid * 16 + i * 8192, R, C); const int Rb = Epi::PERM ? ((R & ~31) + perm32(R & 31)) : R;
        voffA[i] = (unsigned)(R * K + C) * 2u; voffB[i] = (unsigned)(Rb * K + C) * 2u; }
    const size_t kstep = (size_t)(BK * 2);
    const size_t hstep = (size_t)HALF * K * 2;
    const size_t tstep = 2 * hstep;
    const unsigned ldsw = (unsigned)wid * 1024u;
    const int aoff = lds_byte(wr * 64 + fr, fq * 8), boff = lds_byte(wc * 32 + fr, fq * 8);
#define PG8_SA(b, h) (((b) * 2 + (h)) * HTB)
#define PG8_SB(b, h) ((4 + (b) * 2 + (h)) * HTB)
#define PG8_STAGE(bufoff, gbase, voff) do { _Pragma("unroll") for (int _i = 0; _i < 2; ++_i) \
        __builtin_amdgcn_global_load_lds((const unsigned*)((const char*)(gbase) + (voff)[_i]), (PG8_LAS unsigned*)(lds + (bufoff) + ldsw + _i * 8192), 16, 0, 0); } while (0)
#define PG8_LDA(dst, b, h) do { _Pragma("unroll") for (int m = 0; m < 4; ++m) _Pragma("unroll") for (int k = 0; k < 2; ++k) dst[m][k] = *(const PG8_LAS bf16x8*)(lds + PG8_SA(b, h) + aoff + m * 2048 + k * 1024); } while (0)
#define PG8_LDB(dst, b, h) do { _Pragma("unroll") for (int n = 0; n < 2; ++n) _Pragma("unroll") for (int k = 0; k < 2; ++k) dst[n][k] = *(const PG8_LAS bf16x8*)(lds + PG8_SB(b, h) + boff + n * 2048 + k * 1024); } while (0)
#define PG8_MMA(ai, bj, At, Bt) do { __builtin_amdgcn_s_setprio(1); _Pragma("unroll") for (int m = 0; m < 4; ++m) _Pragma("unroll") for (int n = 0; n < 2; ++n) _Pragma("unroll") for (int k = 0; k < 2; ++k) \
        acc[ai][bj][m][n] = __builtin_amdgcn_mfma_f32_16x16x32_bf16(Bt[n][k], At[m][k], acc[ai][bj][m][n], 0, 0, 0); __builtin_amdgcn_s_setprio(0); } while (0)
#define PG8_WAIT_V(n) asm volatile("s_waitcnt vmcnt(" #n ")" ::: "memory")
#define PG8_WAIT_L(n) asm volatile("s_waitcnt lgkmcnt(" #n ")" ::: "memory")
#define PG8_BAR __builtin_amdgcn_s_barrier()
#define PG8_SCHED __builtin_amdgcn_sched_barrier(0)
    Unit cur, nxt; int ui = 0;
    if (!S.next(0, cur)) return;
    f32x4 acc[2][2][4][2];
#pragma unroll
    for (int a = 0; a < 2; ++a)
#pragma unroll
        for (int b = 0; b < 2; ++b)
#pragma unroll
            for (int m = 0; m < 4; ++m)
#pragma unroll
                for (int n = 0; n < 2; ++n) acc[a][b][m][n] = (f32x4){0.f, 0.f, 0.f, 0.f};
    bf16x8 At[4][2], B0[2][2], B1[2][2];
    const char* cA = (const char*)g.A + (size_t)cur.pm * tstep; const char* cB = (const char*)g.Bt + (size_t)cur.pn * tstep;
    S.a_ready(cur);
    if constexpr (SP2) {
        PG8_STAGE(PG8_SB(0, 0), cB, voffB); PG8_STAGE(PG8_SB(0, 1), cB + hstep, voffB); PG8_STAGE(PG8_SA(0, 0), cA, voffA); PG8_STAGE(PG8_SA(0, 1), cA + hstep, voffA);
        if (wr == 1) PG8_BAR;
        PG8_WAIT_V(2); PG8_BAR;
        PG8_STAGE(PG8_SB(1, 0), cB + kstep, voffB); PG8_STAGE(PG8_SA(1, 0), cA + kstep, voffA); PG8_STAGE(PG8_SB(1, 1), cB + hstep + kstep, voffB);
        PG8_WAIT_V(6); PG8_BAR;
    } else {
        PG8_STAGE(PG8_SB(0, 0), cB, voffB); PG8_STAGE(PG8_SA(0, 0), cA, voffA); PG8_STAGE(PG8_SB(0, 1), cB + hstep, voffB); PG8_STAGE(PG8_SA(0, 1), cA + hstep, voffA);
        if (wr == 1) PG8_BAR;
        PG8_WAIT_V(4); PG8_BAR;
        PG8_STAGE(PG8_SB(1, 0), cB + kstep, voffB); PG8_STAGE(PG8_SA(1, 0), cA + kstep, voffA); PG8_STAGE(PG8_SB(1, 1), cB + hstep + kstep, voffB);
        PG8_WAIT_V(6); PG8_BAR;
    }
    for (;;) {
        const bool has_next = S.next(ui + 1, nxt);
        const char* nA = has_next ? (const char*)g.A + (size_t)nxt.pm * tstep : cA; const char* nB = has_next ? (const char*)g.Bt + (size_t)nxt.pn * tstep : cB;
        for (int t = 0; t < nt; t += 2) {
            const bool last = (t == nt - 2);
            const char* a1 = cA + (size_t)(t + 1) * kstep;
            const char* a2 = last ? nA : cA + (size_t)(t + 2) * kstep; const char* b2 = last ? nB : cB + (size_t)(t + 2) * kstep;
            const char* a3 = a2 + kstep; const char* b3 = b2 + kstep;
            if (last && has_next) S.a_ready(nxt);
            if constexpr (SP2) {
            PG8_LDB(B0, 0, 0); PG8_LDB(B1, 0, 1); PG8_SCHED; PG8_LDA(At, 0, 0); PG8_STAGE(PG8_SA(1, 1), a1 + hstep, voffA);
            PG8_WAIT_V(8); PG8_WAIT_L(0); PG8_BAR; PG8_MMA(0, 0, At, B0); PG8_MMA(0, 1, At, B1); PG8_BAR; PG8_SCHED;
            PG8_LDA(At, 0, 1); PG8_STAGE(PG8_SB(0, 0), b2, voffB); PG8_STAGE(PG8_SB(0, 1), b2 + hstep, voffB); PG8_STAGE(PG8_SA(0, 0), a2, voffA);
            PG8_WAIT_V(8); PG8_WAIT_L(0); PG8_BAR; PG8_MMA(1, 0, At, B0); PG8_MMA(1, 1, At, B1); PG8_BAR; PG8_SCHED;
            PG8_LDB(B0, 1, 0); PG8_LDB(B1, 1, 1); PG8_SCHED; PG8_LDA(At, 1, 0); PG8_STAGE(PG8_SA(0, 1), a2 + hstep, voffA);
            PG8_WAIT_V(8); PG8_WAIT_L(0); PG8_BAR; PG8_MMA(0, 0, At, B0); PG8_MMA(0, 1, At, B1); PG8_BAR; PG8_SCHED;
            PG8_LDA(At, 1, 1); PG8_STAGE(PG8_SB(1, 0), b3, voffB); PG8_STAGE(PG8_SB(1, 1), b3 + hstep, voffB); PG8_STAGE(PG8_SA(1, 0), a3, voffA);
            PG8_WAIT_V(8); PG8_WAIT_L(0); PG8_BAR; PG8_MMA(1, 0, At, B0); PG8_MMA(1, 1, At, B1); PG8_BAR; PG8_SCHED;
            } else {
            PG8_LDB(B0, 0, 0); PG8_SCHED; PG8_LDA(At, 0, 0); PG8_STAGE(PG8_SA(1, 1), a1 + hstep, voffA);
            PG8_WAIT_L(8); PG8_BAR; PG8_WAIT_L(0); PG8_MMA(0, 0, At, B0); PG8_BAR; PG8_SCHED;
            PG8_LDB(B1, 0, 1); PG8_STAGE(PG8_SB(0, 0), b2, voffB);
            PG8_BAR; PG8_WAIT_L(0); PG8_MMA(0, 1, At, B1); PG8_BAR;
            PG8_LDA(At, 0, 1); PG8_STAGE(PG8_SA(0, 0), a2, voffA);
            PG8_BAR; PG8_WAIT_L(0); PG8_MMA(1, 0, At, B0); PG8_BAR; PG8_SCHED;
            PG8_STAGE(PG8_SB(0, 1), b2 + hstep, voffB);
            PG8_WAIT_V(6); PG8_BAR; PG8_MMA(1, 1, At, B1); PG8_BAR;
            PG8_LDB(B0, 1, 0); PG8_SCHED; PG8_LDA(At, 1, 0); PG8_STAGE(PG8_SA(0, 1), a2 + hstep, voffA);
            PG8_WAIT_L(8); PG8_BAR; PG8_WAIT_L(0); PG8_MMA(0, 0, At, B0); PG8_BAR; PG8_SCHED;
            PG8_LDB(B1, 1, 1); PG8_STAGE(PG8_SB(1, 0), b3, voffB);
            PG8_BAR; PG8_WAIT_L(0); PG8_MMA(0, 1, At, B1); PG8_BAR;
            PG8_LDA(At, 1, 1); PG8_STAGE(PG8_SA(1, 0), a3, voffA);
            PG8_BAR; PG8_WAIT_L(0); PG8_MMA(1, 0, At, B0); PG8_BAR; PG8_SCHED;
            PG8_STAGE(PG8_SB(1, 1), b3 + hstep, voffB);
            PG8_WAIT_V(6); PG8_BAR; PG8_MMA(1, 1, At, B1); PG8_BAR;
            }
        }
        if constexpr (ALIGN_EPI) { if (wr == 0) PG8_BAR; }
        if constexpr (!Epi::AFTER_DRAIN) { E(acc, cur, wr, wc, fr, fq); S.done(cur); }
        if (!has_next) break;
#pragma unroll
        for (int a = 0; a < 2; ++a)
#pragma unroll
            for (int b = 0; b < 2; ++b)
#pragma unroll
                for (int m = 0; m < 4; ++m)
#pragma unroll
                    for (int n = 0; n < 2; ++n) acc[a][b][m][n] = (f32x4){0.f, 0.f, 0.f, 0.f};
        cur = nxt; cA = nA; cB = nB; ++ui;
        if constexpr (ALIGN_EPI) { if (wr == 1) PG8_BAR; }
    }
    PG8_WAIT_V(0);
    if constexpr (!ALIGN_EPI) { if (wr == 0) PG8_BAR; }
    PG8_BAR;
    if constexpr (Epi::AFTER_DRAIN) { E.fused(acc, cur, wr, wc, fr, fq, lds, wid, lane); S.done(cur); }
#undef PG8_SA
#undef PG8_SB
#undef PG8_STAGE
#undef PG8_LDA
#undef PG8_LDB
#undef PG8_MMA
#undef PG8_WAIT_V
#undef PG8_WAIT_L
#undef PG8_BAR
#undef PG8_SCHED
}
}


constexpr int NWAVES = 8;
#ifndef REP_PROJ
#define REP_PROJ 1
#endif
#ifndef REP_HGRN
#define REP_HGRN 1
#endif
#ifndef REP_MOBA
#define REP_MOBA 1
#endif
#ifndef REP_OUT
#define REP_OUT 1
#endif
#ifndef MK_N_LAUNCHES
#define MK_N_LAUNCHES 1
#endif
constexpr int N_PHASES = 7;
constexpr int N_LAUNCHES = MK_N_LAUNCHES;

constexpr int BATCH = 16, SEQ = 2048, DM = 1024, DEPTH = 2, MTOK = BATCH * SEQ, NIN = 4096;
constexpr int C_HQ = 0, C_HF = 512, C_HI = 1024, C_HG = 1536, C_AQ = 2048, C_AK = 2560, C_AV = 3072, C_AG = 3584;
constexpr float NORM_EPS = 1e-6f;

constexpr size_t MiB = 1u << 20;
constexpr size_t WS_CTL = 0, CTL_ZERO_BYTES = 1 * MiB;
constexpr size_t WS_WIN = 2 * MiB;
constexpr size_t WS_WOUT = 18 * MiB;
constexpr size_t WS_LB = 22 * MiB;
constexpr size_t WS_KPART = 22 * MiB + 65536;
constexpr size_t WS_ROWSS = 24 * MiB;
constexpr size_t WS_DEC = 28 * MiB;
constexpr size_t WS_XB = 32 * MiB;
constexpr size_t WS_MIXED = 160 * MiB;
constexpr size_t WS_ARR = 224 * MiB;
constexpr size_t ARR_BYTES = 32 * MiB;
constexpr size_t WS_END = 480 * MiB;
constexpr int CW_QUEUE = 1024;
constexpr int CW_BAR = 4096;

constexpr int RING_OFF = 0, RING_BYTES = 131072;
constexpr int EXTRA_OFF = RING_BYTES, EXTRA_BYTES = 16384;
constexpr int LDSCTL_OFF = EXTRA_OFF + EXTRA_BYTES, MISC_OFF = LDSCTL_OFF + 320;
constexpr int LDS_BYTES = LDSCTL_OFF + 1024;

#define GAS __attribute__((address_space(1)))
#define LAS __attribute__((address_space(3)))
typedef unsigned short bf16;
typedef unsigned v4u __attribute__((ext_vector_type(4)));
typedef float f32x4 __attribute__((ext_vector_type(4)));
typedef GAS unsigned gu32;
#define RLX_AGENT __ATOMIC_RELAXED, __HIP_MEMORY_SCOPE_AGENT
#define LDS_WAIT() asm volatile("s_waitcnt lgkmcnt(0)" ::: "memory")
#define VM_WAIT() asm volatile("s_waitcnt vmcnt(0)" ::: "memory")
__device__ __forceinline__ unsigned f2bf(float f) { unsigned u = __builtin_bit_cast(unsigned, f); return (u + 0x7fffu + ((u >> 16) & 1u)) >> 16; }
__device__ __forceinline__ unsigned pk2(float lo, float hi) { return f2bf(lo) | (f2bf(hi) << 16); }
__device__ __forceinline__ float bf2f(unsigned short b) { return __builtin_bit_cast(float, (unsigned)b << 16); }
__device__ __forceinline__ float bflo(unsigned w) { return __builtin_bit_cast(float, w << 16); }
__device__ __forceinline__ float bfhi(unsigned w) { return __builtin_bit_cast(float, w & 0xffff0000u); }
__device__ __forceinline__ float silu_f(float z) { return z / (1.0f + __expf(-z)); }
__device__ __forceinline__ float sigmoid_f(float z) { return 1.0f / (1.0f + __expf(-z)); }

#define XB_TMO      128
#define XB_XCNT(j)  (256  + 64 * (j))
#define XB_XSUB(j)  (1280 + 64 * (j))
#define XB_XGEN(j)  (2304 + 64 * (j))
#define XB_TOP      3328
#define XB_TOPGEN   3392
#define XCD_BAR_WORDS 3456
#define XB_SPIN_CAP (1u << 18)

__device__ __forceinline__ unsigned xb_ld(unsigned* p)              { return __hip_atomic_load(p, __ATOMIC_RELAXED, __HIP_MEMORY_SCOPE_AGENT); }
__device__ __forceinline__ unsigned xb_add(unsigned* p, unsigned v) { return __hip_atomic_fetch_add(p, v, __ATOMIC_RELAXED, __HIP_MEMORY_SCOPE_AGENT); }
__device__ __forceinline__ unsigned xb_xcc_id() { return (unsigned)__builtin_amdgcn_s_getreg((3 << 11) | 20) & 0xFu; }
#define XB_SPIN(cond, bar) do { unsigned _sp = 0; while (cond) { __builtin_amdgcn_s_sleep(1); \
    if ((++_sp & 255u) == 0u) { if (xb_ld(&(bar)[XB_TMO])) break; if (_sp > XB_SPIN_CAP) { atomicAdd(&(bar)[XB_TMO], 1u); break; } } } } while (0)

struct XcdBarrier {
    unsigned* bar; unsigned x; int wave0;
    volatile LAS unsigned* st;
};

#define XB_IS_T0(wv) ((wv) == 0 && lane_id_asm() == 0)
__device__ __forceinline__ XcdBarrier xcd_barrier_post(unsigned* bar, volatile LAS unsigned* st, int wave0) {
    XcdBarrier b; b.bar = bar; b.x = xb_xcc_id(); b.st = st; b.wave0 = wave0;
    if (XB_IS_T0(wave0)) (void)xb_add(&bar[XB_XCNT(b.x)], 1u);
    return b;
}
__device__ __forceinline__ void xcd_barrier_complete(unsigned* bar, unsigned x, unsigned& nloc, unsigned& nx) {
    const unsigned G = gridDim.x * gridDim.y * gridDim.z;
    unsigned sum, cnt, mine, sp = 0u;
    for (;;) {
        sum = 0u; cnt = 0u; mine = 0u;
#pragma unroll
        for (unsigned j = 0; j < 16; ++j) { const unsigned c = xb_ld(&bar[XB_XCNT(j)]); sum += c; cnt += (c > 0u) ? 1u : 0u; mine = (j == x) ? c : mine; }
        if (sum == G) break;
        __builtin_amdgcn_s_sleep(1);
        if ((++sp & 255u) == 0u) { if (xb_ld(&bar[XB_TMO])) break; if (sp > XB_SPIN_CAP) { atomicAdd(&bar[XB_TMO], 1u); break; } }
    }
    nloc = mine > 0u ? mine : 1u; nx = cnt > 0u ? cnt : 1u;
}

__device__ __forceinline__ void xcd_barrier(const XcdBarrier& b) {
    asm volatile("s_waitcnt vmcnt(0)" ::: "memory");
    __syncthreads();
    if (XB_IS_T0(b.wave0)) {
        unsigned* bar = b.bar;
        __builtin_amdgcn_s_waitcnt(0);
        unsigned nloc = b.st[0], nx = b.st[1];
        if (nloc == 0u) { xcd_barrier_complete(bar, b.x, nloc, nx); b.st[0] = nloc; b.st[1] = nx; }
        const unsigned old = xb_add(&bar[XB_XSUB(b.x)], 1u);
        const unsigned gen = old / nloc;
        if (old + 1u == (gen + 1u) * nloc) {
            __builtin_amdgcn_fence(__ATOMIC_RELEASE, "agent");
            asm volatile("s_waitcnt vmcnt(0)" ::: "memory");
            const unsigned og = xb_add(&bar[XB_TOP], 1u);
            const unsigned tg = og / nx;
            if (og + 1u == (tg + 1u) * nx) xb_add(&bar[XB_TOPGEN], 1u);
            else XB_SPIN(xb_ld(&bar[XB_TOPGEN]) == tg, bar);
            __builtin_amdgcn_fence(__ATOMIC_ACQUIRE, "agent");
            xb_add(&bar[XB_XGEN(b.x)], 1u);
            asm volatile("s_waitcnt vmcnt(0)" ::: "memory");
        } else {
            XB_SPIN(xb_ld(&bar[XB_XGEN(b.x)]) == gen, bar);
            __builtin_amdgcn_fence(__ATOMIC_ACQUIRE, "agent");
            asm volatile("s_waitcnt vmcnt(0)" ::: "memory");
        }
    }
    __syncthreads();
}


struct Frame {
    LAS unsigned char* lds;
    volatile LAS unsigned* MISC;
    int wave0;
    gu32* ctl;
    int vcu, G;
    const float* x; float* out;
    const float *norm_w, *w_in, *lb_logits, *hg_norm_w, *q_norm_w, *k_norm_w, *w_out;
    bf16 *WIN, *WOUT, *XB, *MIXED, *QI, *KT, *HI, *GH, *QN, *KN, *V, *GA;
    float *LB, *KPART, *ROWSS, *DEC;
};

__device__ __forceinline__ float wave_sum(float v) {
#pragma unroll
    for (int o = 1; o < 64; o <<= 1) v += __shfl_xor(v, o);
    return v;
}
__device__ __forceinline__ int win_dest(int oc) {
    if (oc < 2048) { const int grp = oc >> 9, hh = (oc >> 7) & 3, w = oc & 127; return 256 * (((grp >> 1) << 2) + hh) + 128 * (grp & 1) + w; }
    const int ty = (oc - 2048) >> 9, head = (oc >> 6) & 7, bj = (oc >> 5) & 1; return 256 * (8 + 2 * ty + (head >> 2)) + 128 * bj + 32 * (head & 3);
}
__device__ __forceinline__ void p0_transpose_item(const float* W, int K, int N, bf16* WT, const float* kscale, LAS float* scr, int item, int lane, bool permute) {
    const int nblk = N / 32, kb = item / nblk, nb = item % nblk, k0 = 64 * kb, n0 = 32 * nb; const int nd = permute ? win_dest(n0) : n0;
    float wv_[32];
#pragma unroll
    for (int i = 0; i < 32; ++i) wv_[i] = W[(size_t)(k0 + 2 * i + (lane >> 5)) * N + n0 + (lane & 31)];
#pragma unroll
    for (int i = 0; i < 32; ++i) { const int kk = 2 * i + (lane >> 5); const float s = kscale ? kscale[k0 + kk] : 1.0f; scr[kk * 33 + (lane & 31)] = wv_[i] * s; }
    LDS_WAIT(); asm volatile("" ::: "memory");
    const int c = lane & 7;
#pragma unroll
    for (int j = 0; j < 4; ++j) { const int n = (lane >> 3) + 8 * j; const LAS float* s = scr + (8 * c) * 33 + n;
        v4u o; o.x = pk2(s[0 * 33], s[1 * 33]); o.y = pk2(s[2 * 33], s[3 * 33]); o.z = pk2(s[4 * 33], s[5 * 33]); o.w = pk2(s[6 * 33], s[7 * 33]);
        *(GAS v4u*)(WT + (size_t)(nd + n) * K + k0 + 8 * c) = o; }
    LDS_WAIT(); asm volatile("" ::: "memory");
}
#define PHASE_IDS() int t_ = F.wave0 * 64 + lane_id_asm(); asm volatile("" : "+v"(t_)); const int tid = t_, lane = tid & 63, wave = __builtin_amdgcn_readfirstlane(tid >> 6); (void)lane; (void)wave
__device__ __forceinline__ void p0_prologue(Frame& F) {
    PHASE_IDS();
    LAS float* scr = (LAS float*)(F.lds + RING_OFF + wave * 16384);
    const int gw = F.vcu * NWAVES + wave, NGW = F.G * NWAVES;
    constexpr int I_IN = (DM / 64) * (NIN / 32), I_OUT = (DM / 64) * (DM / 32);
    constexpr int NITEMS = DEPTH * (I_IN + I_OUT);
    for (int it = gw; it < NITEMS; it += NGW) {
        int r = it;
        if (r < DEPTH * I_IN) { const int l = r / I_IN; r -= l * I_IN;
            p0_transpose_item(F.w_in + (size_t)l * DM * NIN, DM, NIN, F.WIN + (size_t)l * NIN * DM, F.norm_w + l * DM, scr, r, lane, true); continue; }
        r -= DEPTH * I_IN; { const int l = r / I_OUT; r -= l * I_OUT;
            p0_transpose_item(F.w_out + (size_t)l * DM * DM, DM, DM, F.WOUT + (size_t)l * DM * DM, nullptr, scr, r, lane, false); }
    }
    for (int m0 = gw * 4; m0 < MTOK; m0 += NGW * 4) {
        f32x4 v[4][4]; float sq[4];
#pragma unroll
        for (int r = 0; r < 4; ++r) { const GAS f32x4* xr = (const GAS f32x4*)(F.x + (size_t)(m0 + r) * DM) + lane;
#pragma unroll
            for (int j = 0; j < 4; ++j) v[r][j] = xr[64 * j]; }
#pragma unroll
        for (int r = 0; r < 4; ++r) { float a = 0.f;
#pragma unroll
            for (int j = 0; j < 4; ++j) a += (v[r][j].x * v[r][j].x + v[r][j].y * v[r][j].y) + (v[r][j].z * v[r][j].z + v[r][j].w * v[r][j].w);
            sq[r] = a; }
#pragma unroll
        for (int o = 1; o < 64; o <<= 1) {
#pragma unroll
            for (int r = 0; r < 4; ++r) sq[r] += __shfl_xor(sq[r], o); }
#pragma unroll
        for (int r = 0; r < 4; ++r) { GAS unsigned long long* o8 = (GAS unsigned long long*)(F.XB + (size_t)(m0 + r) * DM) + lane;
#pragma unroll
            for (int j = 0; j < 4; ++j) o8[64 * j] = (unsigned long long)pk2(v[r][j].x, v[r][j].y) | ((unsigned long long)pk2(v[r][j].z, v[r][j].w) << 32);
            if (lane < 16) F.ROWSS[(size_t)(m0 + r) * 16 + lane] = (lane == 0) ? sq[r] : 0.f; }
    }
    if (blockIdx.x == 0) { const int c = tid; const float a0 = F.lb_logits[c], a1 = F.lb_logits[512 + c]; const float mx = fmaxf(a0, a1);
        const float e0 = expf(a0 - mx), e1 = expf(a1 - mx); const float p0 = e0 / (e0 + e1), p1 = e1 / (e0 + e1);
        F.LB[c] = 0.f; F.LB[512 + c] = fminf(fmaxf((p0 + p1) - p0, 0.f), 1.0f - 1e-6f); }
}

constexpr float LOG2E = 1.4426950408889634f;
constexpr float QSCALE2 = 0.125f * LOG2E;
namespace moba {
typedef short bf16x8 __attribute__((ext_vector_type(8)));
typedef short s16x4 __attribute__((ext_vector_type(4)));
typedef float f32x16 __attribute__((ext_vector_type(16)));
typedef float f32x2_t __attribute__((ext_vector_type(2))); typedef __bf16 bf16x2_t __attribute__((ext_vector_type(2)));
__device__ __forceinline__ unsigned cvtpk(float lo, float hi) { f32x2_t v = {lo, hi}; bf16x2_t b = __builtin_convertvector(v, bf16x2_t); return __builtin_bit_cast(unsigned, b); }
__device__ __forceinline__ int crow(int r, int hi) { return (r & 3) + 8 * (r >> 2) + 4 * hi; }
__device__ __forceinline__ float max3f(float a, float b, float c) { float r; asm("v_max3_f32 %0, %1, %2, %3" : "=v"(r) : "v"(a), "v"(b), "v"(c)); return r; }
constexpr int L_K = 0, L_V = 32768, L_WSF = 65536, L_KM = 67584, L_OST = 69632;
constexpr float NEG_BIG = -1e30f;
constexpr float THR = 8.0f;
__device__ __forceinline__ s16x4 vtr(const LAS unsigned char* p) { return __builtin_bit_cast(s16x4, __builtin_amdgcn_ds_read_tr16_b64_v4i16((LAS s16x4*)p)); }
}

__device__ __forceinline__ void moba_glds(unsigned voff, const void* sbase, unsigned lds_dst) { unsigned keep;
    asm volatile("s_mov_b32 %0, m0\n\ts_mov_b32 m0, %3\n\ts_nop 0\n\tglobal_load_lds_dwordx4 %1, %2\n\ts_mov_b32 m0, %0" : "=&s"(keep) : "v"(voff), "s"(sbase), "s"(lds_dst) : "memory"); }
__device__ __forceinline__ void moba_mfma_phase(Frame& F, int l) {
    using namespace moba;
    PHASE_IDS();
    const int r32 = lane & 31, hi = lane >> 5, wid = wave;
    LAS unsigned char* L = F.lds + RING_OFF;
    LAS float* wsf = (LAS float*)(L + L_WSF) + wid * 64;
    LAS float* km = (LAS float*)(L + L_KM);
    LAS float* ost = (LAS float*)(L + L_OST) + wid * 2048;
    float gq = fabsf(F.q_norm_w[l * 64 + lane]), gk = fabsf(F.k_norm_w[l * 64 + lane]);
#pragma unroll
    for (int o = 1; o < 64; o <<= 1) { gq = fmaxf(gq, __shfl_xor(gq, o)); gk = fmaxf(gk, __shfl_xor(gk, o)); }
    gq = __builtin_bit_cast(float, __builtin_amdgcn_readfirstlane(__builtin_bit_cast(int, gq))); gk = __builtin_bit_cast(float, __builtin_amdgcn_readfirstlane(__builtin_bit_cast(int, gk)));
    const float smax2 = 8.0f * gq * gk * LOG2E * 1.02f;
    const float mhat0 = -(smax2 + 1.0f);
    gu32* qctr = F.ctl + CW_QUEUE + 64 * l;
    volatile LAS unsigned* tick = (volatile LAS unsigned*)(F.lds + EXTRA_OFF + 8192);
    if (tid == 0) tick[0] = __hip_atomic_fetch_add(qctr, 1u, RLX_AGENT);
    for (int ui = 0;; ++ui) {
        __syncthreads();
        const int it = __builtin_amdgcn_readfirstlane((int)tick[ui & 1]); if (it >= 1024) break;
        const int qb = 7 - (it >> 7), bh = it & 127;
        const int b = bh >> 3, h = bh & 7; const size_t rowbase = (size_t)b * SEQ; const int q0 = qb * 256, qrel = wid * 32 + r32, tq = q0 + qrel;
        const float sl2 = exp2f(-(float)(h + 1)) * LOG2E;
        bf16x8 qr[4];
        { const GAS bf16* Qw = (const GAS bf16*)(F.QN + (rowbase + q0 + wid * 32 + r32) * 512 + h * 64 + hi * 8);
#pragma unroll
            for (int d0 = 0; d0 < 4; ++d0) qr[d0] = *(const GAS bf16x8*)(Qw + d0 * 16); }
        LAS unsigned char* qlds = (LAS unsigned char*)ost + lane * 16;
        if (tid < qb * 64) { const GAS float* kp = (const GAS float*)(F.KPART + ((size_t)b * 8 + (tid >> 6)) * 1024 + h * 64 + (tid & 63)); km[tid] = (kp[0] + kp[512]) * (1.0f / 256.0f); }
        const unsigned koff = (unsigned)(((rowbase + lane) * 512 + h * 64 + wid * 8) * 2);
        unsigned voff; { const int vr = 8 * wid + (lane >> 3), sl = lane & 7; const int ch = ((((sl >> 2) ^ ((vr >> 1) & 1)) << 2) | (sl & 3)); voff = (unsigned)((((size_t)MTOK + rowbase + vr) * 512 + h * 64 + ch * 8) * 2); }
        const unsigned lds0 = (unsigned)(uintptr_t)L;
#define MOBA_ISSUE(t_, bufi) do { moba_glds(koff, (const void*)((const char*)F.KN + (size_t)(t_) * 65536), (unsigned)__builtin_amdgcn_readfirstlane((int)(lds0 + L_K + (bufi) * 8192 + wid * 1024))); \
            moba_glds(voff, (const void*)((const char*)F.KN + (size_t)(t_) * 65536), (unsigned)__builtin_amdgcn_readfirstlane((int)(lds0 + L_V + (bufi) * 8192 + wid * 1024))); } while (0)
        const int NT = 4 * (qb + 1);
        int t0 = 0; { const float dstar = (151.0f + 2.0f * smax2) / sl2; const float x = ((float)(q0 - 63) - dstar) * (1.0f / 64.0f); if (x > 0.f) t0 = ((int)x) & ~1; if (t0 > NT - 4) t0 = NT - 4; t0 = __builtin_amdgcn_readfirstlane(t0); }
        unsigned nticket = 0u; if (tid == 0) nticket = __hip_atomic_fetch_add(qctr, 1u, RLX_AGENT);
        MOBA_ISSUE(t0, 0); MOBA_ISSUE(t0 + 1, 1); MOBA_ISSUE(t0 + 2, 2);
        __syncthreads();
        unsigned selmask = 0;
        { float gt[7];
#pragma unroll
            for (int j = 0; j < 7; ++j) { float s = 0.f;
                if (j < qb) {
#pragma unroll
                    for (int d0 = 0; d0 < 4; ++d0)
#pragma unroll
                        for (int e = 0; e < 8; ++e) s += bf2f((unsigned short)qr[d0][e]) * km[j * 64 + d0 * 16 + hi * 8 + e];
                    auto rr = __builtin_amdgcn_permlane32_swap(__float_as_uint(s), __float_as_uint(s), false, false);
                    s = __uint_as_float(rr[0]) + __uint_as_float(rr[1]); }
                gt[j] = s; }
#pragma unroll
            for (int j = 0; j < 7; ++j) { int rank = 0;
#pragma unroll
                for (int i = 0; i < 7; ++i) if (i != j && i < qb) rank += (gt[i] > gt[j] || (gt[i] == gt[j] && i < j)) ? 1 : 0;
                if (j < qb && rank < 3) selmask |= 1u << j; } }
#pragma unroll
        for (int d0 = 0; d0 < 4; ++d0) *(LAS bf16x8*)(qlds + d0 * 1024) = qr[d0];
        float mhat = mhat0, l_reg = 0.f; f32x16 o[2]; o[0] = f32x16{}; o[1] = f32x16{};
        const int kbase = L_K + hi * 1024 + r32 * 16;
        const int g16 = lane >> 4, i16 = lane & 15, tq4 = i16 >> 2, tp4 = i16 & 3;
        const int vrow0 = 4 * hi + tq4;
        if (tid == 0) tick[(ui + 1) & 1] = nticket;
        asm volatile("s_waitcnt vmcnt(2)" ::: "memory");
        __syncthreads();
#define MOBA_KLOAD(KOFF) do { _Pragma("unroll") for (int d0 = 0; d0 < 4; ++d0) qf_[d0] = *(const LAS bf16x8*)(qlds + d0 * 1024); \
            _Pragma("unroll") for (int d0 = 0; d0 < 4; ++d0) { \
            kfr[2 * d0] = *(const LAS bf16x8*)(L + (KOFF) + kbase + d0 * 2048); kfr[2 * d0 + 1] = *(const LAS bf16x8*)(L + (KOFF) + kbase + d0 * 2048 + 512); } } while (0)
#define MOBA_VLOAD(VOFF) do { _Pragma("unroll") for (int dblk = 0; dblk < 2; ++dblk) _Pragma("unroll") for (int ks = 0; ks < 4; ++ks) { \
            const int rlo = 16 * ks + vrow0, rhi = rlo + 8; \
            vlo[dblk * 4 + ks] = vtr(L + L_V + (VOFF) + rlo * 128 + ((dblk ^ ((rlo >> 1) & 1)) * 64) + (16 * (g16 & 1) + 4 * tp4) * 2); \
            vhi[dblk * 4 + ks] = vtr(L + L_V + (VOFF) + rhi * 128 + ((dblk ^ ((rhi >> 1) & 1)) * 64) + (16 * (g16 & 1) + 4 * tp4) * 2); } } while (0)
#define MOBA_QK(TT, P0, P1) do { \
            const int blk_ = (TT) >> 2; const bool own_ = (blk_ == qb); \
            if (!(own_ && (64 * ((TT) & 3) > 32 * wid + 31))) { \
                const bool sel_ = own_ || ((selmask >> blk_) & 1u); \
                const float sc0_ = sel_ ? (-mhat - sl2 * (float)(tq - 64 * (TT) - 4 * hi)) : NEG_BIG; \
_Pragma("unroll") \
                for (int r = 0; r < 16; ++r) { P0[r] = __builtin_fmaf(sl2, (float)((r & 3) + 8 * (r >> 2)), sc0_); P1[r] = __builtin_fmaf(sl2, (float)(32 + (r & 3) + 8 * (r >> 2)), sc0_); } \
_Pragma("unroll") \
                for (int d0 = 0; d0 < 4; ++d0) { \
                    P0 = __builtin_amdgcn_mfma_f32_32x32x16_bf16(kfr[2 * d0], qf_[d0], P0, 0, 0, 0); \
                    P1 = __builtin_amdgcn_mfma_f32_32x32x16_bf16(kfr[2 * d0 + 1], qf_[d0], P1, 0, 0, 0); } \
            } } while (0)
#define MOBA_SMPV(TT, P0, P1, HAVE_NEXT, N0, N1) do { \
            const int blk = (TT) >> 2; const bool own = (blk == qb); const int jb = (TT) & 3; \
            if (!(own && (64 * jb > 32 * wid + 31))) { \
                if (own && (64 * jb + 63 > 32 * wid)) { \
_Pragma("unroll") \
                    for (int r = 0; r < 16; ++r) { const int kvl = 64 * jb + crow(r, hi); if (kvl > qrel) P0[r] = NEG_BIG; if (kvl + 32 > qrel) P1[r] = NEG_BIG; } } \
                float rm = max3f(P0[0], P1[0], P0[1]), rm2 = max3f(P1[1], P0[2], P1[2]); \
_Pragma("unroll") \
                for (int r = 3; r < 15; r += 2) { rm = max3f(rm, P0[r], P1[r]); rm2 = max3f(rm2, P0[r + 1], P1[r + 1]); } \
                rm = max3f(rm, rm2, fmaxf(P0[15], P1[15])); \
                { auto rr = __builtin_amdgcn_permlane32_swap(__float_as_uint(rm), __float_as_uint(rm), false, false); rm = fmaxf(__uint_as_float(rr[0]), __uint_as_float(rr[1])); } \
                if (__any(rm > THR)) { \
                    const float dl = fmaxf(rm, 0.f); mhat += dl; \
_Pragma("unroll") \
                    for (int r = 0; r < 16; ++r) { P0[r] -= dl; P1[r] -= dl; } \
                    if (HAVE_NEXT) { \
_Pragma("unroll") \
                        for (int r = 0; r < 16; ++r) { N0[r] -= dl; N1[r] -= dl; } } \
                    const float f = __builtin_amdgcn_exp2f(-dl); l_reg *= f; \
                    if (hi == 0) wsf[r32] = f; \
_Pragma("unroll") \
                    for (int r = 0; r < 16; ++r) { const float fr = wsf[crow(r, hi)]; o[0][r] *= fr; o[1][r] *= fr; } } \
                float sacc = 0.f, sacc2 = 0.f; \
_Pragma("unroll") \
                for (int r = 0; r < 16; ++r) { P0[r] = __builtin_amdgcn_exp2f(P0[r]); P1[r] = __builtin_amdgcn_exp2f(P1[r]); sacc += P0[r]; sacc2 += P1[r]; } \
                l_reg += sacc + sacc2; \
                bf16x8 pa[4]; \
                { v4u w; \
_Pragma("unroll") \
                    for (int ks = 0; ks < 4; ++ks) { \
_Pragma("unroll") \
                        for (int e = 0; e < 4; ++e) { const int rb = (ks & 1) * 8 + 2 * e; w[e] = (ks < 2) ? cvtpk(P0[rb], P0[rb + 1]) : cvtpk(P1[rb], P1[rb + 1]); } \
                        pa[ks] = __builtin_bit_cast(bf16x8, w); } } \
_Pragma("unroll") \
                for (int dblk = 0; dblk < 2; ++dblk) \
_Pragma("unroll") \
                    for (int ks = 0; ks < 4; ++ks) { \
                        const s16x4 lo = vlo[dblk * 4 + ks], hh = vhi[dblk * 4 + ks]; \
                        const bf16x8 vf = (bf16x8){lo[0], lo[1], lo[2], lo[3], hh[0], hh[1], hh[2], hh[3]}; \
                        o[dblk] = __builtin_amdgcn_mfma_f32_32x32x16_bf16(pa[ks], vf, o[dblk], 0, 0, 0); } \
            } } while (0)
        f32x16 pA0, pA1, pB0, pB1; bf16x8 kfr[8], qf_[4]; s16x4 vlo[8], vhi[8];
        MOBA_KLOAD(0); MOBA_QK(t0, pA0, pA1);
        int c0o = 0;
        for (int t = t0; t < NT; t += 2) {
            const int c1o = (c0o + 1) & 3, c2o = (c0o + 2) & 3, c3o = (c0o + 3) & 3;
            if (t + 3 < NT) MOBA_ISSUE(t + 3, c3o);
            MOBA_KLOAD(c1o * 8192); __builtin_amdgcn_sched_barrier(0);
            MOBA_QK(t + 1, pB0, pB1); __builtin_amdgcn_sched_barrier(0);
            MOBA_VLOAD(c0o * 8192); __builtin_amdgcn_sched_barrier(0);
            MOBA_SMPV(t, pA0, pA1, true, pB0, pB1);
            if (t + 3 < NT) asm volatile("s_waitcnt vmcnt(2)" ::: "memory"); else asm volatile("s_waitcnt vmcnt(0)" ::: "memory");
            __syncthreads();
            if (t + 4 < NT) MOBA_ISSUE(t + 4, c0o);
            if (t + 2 < NT) { MOBA_KLOAD(c2o * 8192); __builtin_amdgcn_sched_barrier(0); MOBA_QK(t + 2, pA0, pA1); __builtin_amdgcn_sched_barrier(0); }
            MOBA_VLOAD(c1o * 8192); __builtin_amdgcn_sched_barrier(0);
            MOBA_SMPV(t + 1, pB0, pB1, (t + 2 < NT), pA0, pA1);
            if (t + 4 < NT) asm volatile("s_waitcnt vmcnt(2)" ::: "memory"); else asm volatile("s_waitcnt vmcnt(0)" ::: "memory");
            __syncthreads();
            c0o = c2o;
        }
#undef MOBA_ISSUE
#undef MOBA_KLOAD
#undef MOBA_VLOAD
#undef MOBA_QK
#undef MOBA_SMPV
        v4u gwv[4];
#pragma unroll
        for (int i = 0; i < 4; ++i) gwv[i] = *(const GAS v4u*)(F.GA + (rowbase + q0 + wid * 32 + i * 8 + (lane >> 3)) * 512 + h * 64 + (lane & 7) * 8);
        { auto rr = __builtin_amdgcn_permlane32_swap(__float_as_uint(l_reg), __float_as_uint(l_reg), false, false); l_reg = __uint_as_float(rr[0]) + __uint_as_float(rr[1]); }
        if (hi == 0) wsf[r32] = 1.0f / l_reg;
#pragma unroll
        for (int r = 0; r < 16; ++r) { const float rl = wsf[crow(r, hi)]; ost[crow(r, hi) * 64 + r32] = o[0][r] * rl; ost[crow(r, hi) * 64 + 32 + r32] = o[1][r] * rl; }
#pragma unroll
        for (int i = 0; i < 4; ++i) { const int row = i * 8 + (lane >> 3), ch = lane & 7;
            const f32x4 a = *(const LAS f32x4*)(ost + row * 64 + ch * 8), c2 = *(const LAS f32x4*)(ost + row * 64 + ch * 8 + 4);
            const size_t grow = rowbase + q0 + wid * 32 + row;
            const v4u gw = gwv[i];
            v4u ow; ow.x = pk2(a[0] * bflo(gw.x), a[1] * bfhi(gw.x)); ow.y = pk2(a[2] * bflo(gw.y), a[3] * bfhi(gw.y));
            ow.z = pk2(c2[0] * bflo(gw.z), c2[1] * bfhi(gw.z)); ow.w = pk2(c2[2] * bflo(gw.w), c2[3] * bfhi(gw.w));
            *(GAS v4u*)(F.MIXED + grow * DM + 512 + h * 64 + ch * 8) = ow; }
    }
    __syncthreads();
}


namespace hg {
typedef short bf16x8 __attribute__((ext_vector_type(8)));
typedef short s16x4 __attribute__((ext_vector_type(4)));
typedef float f32x4 __attribute__((ext_vector_type(4)));
typedef unsigned u32x2 __attribute__((ext_vector_type(2)));
constexpr int SLOT = 33792, NSLOT = 4;
constexpr int L_SC = NSLOT * SLOT, L_NRM = L_SC + 4096;
constexpr int NSTEP = SEQ / 32;
__device__ __forceinline__ int fsw(int t) { return ((t & 7) << 2) | (((t >> 3) & 1) << 1); }
__device__ __forceinline__ int unit_off(int tok, int cg) { return 8 * (32 * tok + (cg ^ fsw(tok))); }
__device__ __forceinline__ s16x4 rd64(const LAS unsigned char* p) { return *(const LAS s16x4*)p; }
__device__ __forceinline__ s16x4 vtr(const LAS unsigned char* p) { return __builtin_bit_cast(s16x4, __builtin_amdgcn_ds_read_tr16_b64_v4i16((LAS s16x4*)p)); }
__device__ __forceinline__ bf16x8 cat(s16x4 a, s16x4 b) { return (bf16x8){a[0], a[1], a[2], a[3], b[0], b[1], b[2], b[3]}; }
__device__ __forceinline__ s16x4 pack4(f32x4 v) { u32x2 w; w.x = moba::cvtpk(v[0], v[1]); w.y = moba::cvtpk(v[2], v[3]); return __builtin_bit_cast(s16x4, w); }
__device__ __forceinline__ void glds16(const GAS void* gsrc, unsigned lds_dst) { unsigned keep;
    asm volatile("s_mov_b32 %0, m0\n\ts_mov_b32 m0, %2\n\ts_nop 0\n\tglobal_load_lds_dwordx4 %1, off\n\ts_mov_b32 m0, %0" : "=&s"(keep) : "v"(gsrc), "s"(lds_dst) : "memory"); }
__device__ __forceinline__ void glds16s(unsigned voff, const void* sbase, unsigned lds_dst) { unsigned keep;
    asm volatile("s_mov_b32 %0, m0\n\ts_mov_b32 m0, %3\n\ts_nop 0\n\tglobal_load_lds_dwordx4 %1, %2\n\ts_mov_b32 m0, %0" : "=&s"(keep) : "v"(voff), "s"(sbase), "s"(lds_dst) : "memory"); }
#define HG_MFMA(a, b, c) __builtin_amdgcn_mfma_f32_16x16x32_bf16((a), (b), (c), 0, 0, 0)
}

__device__ __forceinline__ void hgrn_mfma_phase(Frame& F, int l) {
    using namespace hg;
    PHASE_IDS();
    const int w = wave, c16 = lane & 15, g = lane >> 4;
    LAS unsigned char* L = F.lds + RING_OFF;
    const s16x4 z4 = (s16x4){0, 0, 0, 0};
    for (int it = (int)blockIdx.x; it < 64; it += F.G) {
        const int b = it >> 2, h = it & 3; const size_t rowbase = (size_t)b * SEQ;
        const int da = w >> 1;
        unsigned dsrc[4];
#pragma unroll
        for (int i = 0; i < 4; ++i) { const int t = 16 * (w & 1) + 4 * i + (lane >> 4); const int sc = (lane & 15) ^ (fsw(t) >> 1);
            dsrc[i] = (unsigned)((((size_t)da * MTOK + rowbase + t) * 512 + h * 128 + 8 * sc) * 2); }
        const unsigned ddec = (unsigned)((((size_t)b * NSTEP) * 512 + h * 128 + 4 * lane) * 4);
        const int ddst = da * 8192 + (w & 1) * 4096;
        const unsigned lds0 = (unsigned)(uintptr_t)(F.lds + RING_OFF);
#define HG_ISSUE(step) do { const unsigned so_ = lds0 + (unsigned)(((step) & 3) * SLOT); \
            _Pragma("unroll") for (int i = 0; i < 4; ++i) \
                glds16s(dsrc[i], (const void*)((const char*)F.QI + (size_t)(step) * (32 * 512 * 2)), (unsigned)__builtin_amdgcn_readfirstlane((int)(so_ + ddst + i * 1024))); \
            if (w == 0) glds16s(ddec, (const void*)((const char*)F.DEC + (size_t)(step) * 2048), (unsigned)__builtin_amdgcn_readfirstlane((int)(so_ + 32768))); } while (0)
        f32x4 S[8]; bf16x8 Sb[4];
#pragma unroll
        for (int tk = 0; tk < 8; ++tk) S[tk] = (f32x4){0.f, 0.f, 0.f, 0.f};
#pragma unroll
        for (int ks = 0; ks < 4; ++ks) Sb[ks] = (bf16x8){0, 0, 0, 0, 0, 0, 0, 0};
        f32x4 oprev[2]; oprev[0] = (f32x4){0.f, 0.f, 0.f, 0.f}; oprev[1] = oprev[0];
        u32x2 gprev[2]; gprev[0] = (u32x2){0u, 0u}; gprev[1] = gprev[0];
        float hw[4];
#pragma unroll
        for (int r = 0; r < 4; ++r) hw[r] = F.hg_norm_w[l * 128 + 16 * w + 4 * g + r];
        asm volatile("" : "+v"(hw[0]), "+v"(hw[1]), "+v"(hw[2]), "+v"(hw[3]));
        LAS float* nrm = (LAS float*)(L + L_NRM);
        LAS unsigned char* SC = L + L_SC;
        HG_ISSUE(0); HG_ISSUE(1); HG_ISSUE(2);
        asm volatile("s_waitcnt vmcnt(8)\n\ts_barrier" ::: "memory");
        const int trq = c16 >> 2, trp = c16 & 3;
        int ro0 = 256 * c16 + 16 * (g ^ (fsw(c16) >> 1)), ko0 = 256 * (4 * g + trq) + 16 * (trp ^ (fsw(4 * g + trq) >> 1));
#define RO(ks) (ro0 ^ (64 * (ks)))
#define KO(tk) (ko0 ^ (64 * ((tk) >> 1) + 8 * ((tk) & 1)))
        const int io_ = unit_off(4 * g + trq, 4 * w + trp), go_ = unit_off(c16, 4 * w + g);
        bf16x8 qf[2][4];
#define HG_LOADQ(slotbase) do { _Pragma("unroll") for (int tt = 0; tt < 2; ++tt) _Pragma("unroll") for (int ks = 0; ks < 4; ++ks) \
            qf[tt][ks] = *(const LAS bf16x8*)((slotbase) + RO(ks) + 4096 * tt); } while (0)
#define HG_FINAL(step, P) do { _Pragma("unroll") for (int tt = 0; tt < 2; ++tt) { \
            const float ssum = ((P[tt][0] + P[tt][1]) + (P[tt][2] + P[tt][3])) + ((P[tt][4] + P[tt][5]) + (P[tt][6] + P[tt][7])); \
            const float rstd = __builtin_amdgcn_rsqf(ssum * (1.0f / 128.0f) + NORM_EPS); \
            u32x2 wv; wv.x = moba::cvtpk(oprev[tt][0] * rstd * hw[0] * bflo(gprev[tt].x), oprev[tt][1] * rstd * hw[1] * bfhi(gprev[tt].x)); \
            wv.y = moba::cvtpk(oprev[tt][2] * rstd * hw[2] * bflo(gprev[tt].y), oprev[tt][3] * rstd * hw[3] * bfhi(gprev[tt].y)); \
            *(GAS u32x2*)(F.MIXED + (rowbase + (size_t)(step) * 32 + 16 * tt + c16) * DM + h * 128 + 16 * w + 4 * g) = wv; } } while (0)
        HG_LOADQ(L);
        for (int n = 0; n < NSTEP; ++n) {
            asm volatile("" : "+v"(ro0), "+v"(ko0));
            if (n + 3 < NSTEP) HG_ISSUE(n + 3);
            const LAS unsigned char* Qs = L + (n & 3) * SLOT; const LAS unsigned char* Ks = Qs + 8192; const LAS unsigned char* Is = Qs + 16384; const LAS unsigned char* Gs = Qs + 24576;
            const LAS float* Ds = (const LAS float*)(Qs + 32768);
            LAS unsigned char* SCn = SC + (n & 1) * 1536;
            bf16x8 kf[4];
            if (w < 3) { const int st = (w == 2) ? 1 : 0;
#pragma unroll
                for (int ks = 0; ks < 4; ++ks) kf[ks] = *(const LAS bf16x8*)(Ks + RO(ks) + 4096 * st); }
            u32x2 gcur[2];
#pragma unroll
            for (int tt = 0; tt < 2; ++tt) gcur[tt] = *(const LAS u32x2*)(Gs + go_ + 4096 * tt);
            s16x4 itr[2];
#pragma unroll
            for (int st = 0; st < 2; ++st) itr[st] = vtr(Is + io_ + 4096 * st);
            const bf16x8 i01 = cat(itr[0], itr[1]);
            bf16x8 k01[4]; f32x4 dv4[4];
#pragma unroll
            for (int tk = 0; tk < 4; ++tk) { k01[tk] = cat(vtr(Ks + KO(tk)), vtr(Ks + KO(tk) + 4096)); dv4[tk] = *(const LAS f32x4*)(Ds + 16 * tk + 4 * g); }
            f32x4 o[2];
#pragma unroll
            for (int tt = 0; tt < 2; ++tt) { f32x4 a = (f32x4){0.f, 0.f, 0.f, 0.f};
#pragma unroll
                for (int ks = 0; ks < 4; ++ks) a = HG_MFMA(Sb[ks], qf[tt][ks], a);
                o[tt] = a; }
            if (w < 3) { f32x4 sc = (f32x4){0.f, 0.f, 0.f, 0.f};
                if (w == 0) {
#pragma unroll
                    for (int ks = 0; ks < 4; ++ks) sc = HG_MFMA(kf[ks], qf[0][ks], sc);
                } else {
#pragma unroll
                    for (int ks = 0; ks < 4; ++ks) sc = HG_MFMA(kf[ks], qf[1][ks], sc); }
                if (w != 1) {
#pragma unroll
                    for (int r = 0; r < 4; ++r) if (4 * g + r > c16) sc[r] = 0.f; }
                *(LAS s16x4*)(SCn + w * 512 + lane * 8) = pack4(sc); }
#pragma unroll
            for (int tk = 0; tk < 4; ++tk) S[tk] = HG_MFMA(k01[tk], i01, S[tk]);
            asm volatile("" ::: "memory");
            { bf16x8 k2[4]; f32x4 d2[4];
#pragma unroll
                for (int tk = 0; tk < 4; ++tk) { k2[tk] = cat(vtr(Ks + KO(tk + 4)), vtr(Ks + KO(tk + 4) + 4096)); d2[tk] = *(const LAS f32x4*)(Ds + 16 * (tk + 4) + 4 * g); }
#pragma unroll
                for (int tk = 0; tk < 4; ++tk) S[tk] = S[tk] * dv4[tk];
#pragma unroll
                for (int ks = 0; ks < 2; ++ks) Sb[ks] = cat(pack4(S[2 * ks]), pack4(S[2 * ks + 1]));
#pragma unroll
                for (int tk = 0; tk < 4; ++tk) S[tk + 4] = HG_MFMA(k2[tk], i01, S[tk + 4]);
#pragma unroll
                for (int tk = 0; tk < 4; ++tk) S[tk + 4] = S[tk + 4] * d2[tk];
#pragma unroll
                for (int ks = 2; ks < 4; ++ks) Sb[ks] = cat(pack4(S[2 * ks]), pack4(S[2 * ks + 1])); }
            if (n >= NSTEP - 3) asm volatile("s_waitcnt vmcnt(0) lgkmcnt(0)\n\ts_barrier" ::: "memory");
            else if (n <= 1) asm volatile("s_waitcnt vmcnt(8) lgkmcnt(0)\n\ts_barrier" ::: "memory");
            else if (n == 2) asm volatile("s_waitcnt vmcnt(10) lgkmcnt(0)\n\ts_barrier" ::: "memory");
            else asm volatile("s_waitcnt vmcnt(12) lgkmcnt(0)\n\ts_barrier" ::: "memory");
            const s16x4 sc00 = rd64(SCn + lane * 8), sc01 = rd64(SCn + 512 + lane * 8), sc11 = rd64(SCn + 1024 + lane * 8);
            float pn[2][8];
            if (n > 0) {
#pragma unroll
                for (int tt = 0; tt < 2; ++tt)
#pragma unroll
                    for (int ww = 0; ww < 8; ++ww) pn[tt][ww] = nrm[((n - 1) & 1) * 256 + ww * 32 + 16 * tt + c16]; }
            if (n + 1 < NSTEP) HG_LOADQ(L + ((n + 1) & 3) * SLOT);
            o[0] = HG_MFMA(cat(itr[0], z4), cat(sc00, z4), o[0]);
            o[1] = HG_MFMA(i01, cat(sc01, sc11), o[1]);
            { float ss0 = (o[0][0] * o[0][0] + o[0][1] * o[0][1]) + (o[0][2] * o[0][2] + o[0][3] * o[0][3]);
              float ss1 = (o[1][0] * o[1][0] + o[1][1] * o[1][1]) + (o[1][2] * o[1][2] + o[1][3] * o[1][3]);
              { auto r0 = __builtin_amdgcn_permlane16_swap(__float_as_uint(ss0), __float_as_uint(ss0), false, false); auto r1 = __builtin_amdgcn_permlane16_swap(__float_as_uint(ss1), __float_as_uint(ss1), false, false);
                ss0 = __uint_as_float(r0[0]) + __uint_as_float(r0[1]); ss1 = __uint_as_float(r1[0]) + __uint_as_float(r1[1]); }
              { auto r0 = __builtin_amdgcn_permlane32_swap(__float_as_uint(ss0), __float_as_uint(ss0), false, false); auto r1 = __builtin_amdgcn_permlane32_swap(__float_as_uint(ss1), __float_as_uint(ss1), false, false);
                ss0 = __uint_as_float(r0[0]) + __uint_as_float(r0[1]); ss1 = __uint_as_float(r1[0]) + __uint_as_float(r1[1]); }
              if (g == 0) { nrm[(n & 1) * 256 + w * 32 + c16] = ss0; nrm[(n & 1) * 256 + w * 32 + 16 + c16] = ss1; } }
            if (n > 0) HG_FINAL(n - 1, pn);
            oprev[0] = o[0]; oprev[1] = o[1]; gprev[0] = gcur[0]; gprev[1] = gcur[1];
        }
        asm volatile("s_waitcnt vmcnt(0) lgkmcnt(0)\n\ts_barrier" ::: "memory");
        { float pn[2][8];
#pragma unroll
            for (int tt = 0; tt < 2; ++tt)
#pragma unroll
                for (int ww = 0; ww < 8; ++ww) pn[tt][ww] = nrm[((NSTEP - 1) & 1) * 256 + ww * 32 + 16 * tt + c16];
            HG_FINAL(NSTEP - 1, pn); }
        asm volatile("s_waitcnt vmcnt(0) lgkmcnt(0)\n\ts_barrier" ::: "memory");
#undef RO
#undef KO
#undef HG_LOADQ
#undef HG_FINAL
#undef HG_ISSUE
    }
}

struct Args { const float* in[8]; float* out; unsigned char* ws; int ph_lo, ph_hi, li, pad; };
__global__ void __launch_bounds__(NWAVES * 64, 2) fwd(Args args) {
    extern __shared__ __attribute__((aligned(16))) unsigned char lds[];
    Frame F;
    F.lds = (LAS unsigned char*)lds;
    F.MISC = (volatile LAS unsigned*)(F.lds + MISC_OFF);
    F.G = gridDim.x; { const int bx = blockIdx.x; F.vcu = (F.G % 8 == 0) ? (bx % 8) * (F.G / 8) + bx / 8 : bx; }
    unsigned char* ws = args.ws;
    F.ctl = (gu32*)(ws + WS_CTL);
    F.x = args.in[0]; F.norm_w = args.in[1]; F.w_in = args.in[2]; F.lb_logits = args.in[3]; F.hg_norm_w = args.in[4]; F.q_norm_w = args.in[5]; F.k_norm_w = args.in[6]; F.w_out = args.in[7];
    F.out = args.out;
    F.WIN = (bf16*)(ws + WS_WIN); F.WOUT = (bf16*)(ws + WS_WOUT); F.XB = (bf16*)(ws + WS_XB); F.MIXED = (bf16*)(ws + WS_MIXED);
    F.QI = (bf16*)(ws + WS_ARR); F.KT = (bf16*)(ws + WS_ARR + ARR_BYTES); F.HI = (bf16*)(ws + WS_ARR + 2 * ARR_BYTES); F.GH = (bf16*)(ws + WS_ARR + 3 * ARR_BYTES);
    F.QN = (bf16*)(ws + WS_ARR + 4 * ARR_BYTES); F.KN = (bf16*)(ws + WS_ARR + 5 * ARR_BYTES); F.V = (bf16*)(ws + WS_ARR + 6 * ARR_BYTES); F.GA = (bf16*)(ws + WS_ARR + 7 * ARR_BYTES);
    F.LB = (float*)(ws + WS_LB); F.KPART = (float*)(ws + WS_KPART); F.ROWSS = (float*)(ws + WS_ROWSS); F.DEC = (float*)(ws + WS_DEC);
    F.wave0 = __builtin_amdgcn_readfirstlane((int)threadIdx.x >> 6);
    for (int u = F.wave0 * 64 + lane_id_asm(); u < (LDS_BYTES - LDSCTL_OFF) / 4; u += NWAVES * 64) ((LAS unsigned*)(F.lds + LDSCTL_OFF))[u] = 0u;
    __syncthreads();
    XcdBarrier bar; bar.bar = (unsigned*)(F.ctl + CW_BAR); bar.x = 0; bar.st = nullptr; bar.wave0 = F.wave0;
    if (N_LAUNCHES == 1) bar = xcd_barrier_post((unsigned*)(F.ctl + CW_BAR), F.MISC + 8, F.wave0);
#define GRID_BAR() do { if (N_LAUNCHES == 1) xcd_barrier(bar); } while (0)
    const int lo = args.ph_lo, hi = args.ph_hi;
#define IN(k) (lo <= (k) && (k) < hi)
#define BOTH(k) (IN(k) && IN((k) + 1))

    if (IN(0)) { p0_prologue(F); if (BOTH(0)) GRID_BAR(); }
    for (int l = 0; l < DEPTH; ++l) {
        const int pb = 1 + 3 * l;
        if (IN(pb)) {
            pg8::Gemm g{F.XB + (size_t)l * MTOK * DM, F.WIN + (size_t)l * NIN * DM, MTOK, NIN, DM}; pg8::StaticOrder S; S.init(MTOK, NIN, F.G, (int)blockIdx.x);
            pg8::EpiFused E{F.QI, F.DEC, F.KPART, F.ROWSS + (size_t)l * MTOK * 16, F.LB + l * 512, F.q_norm_w + l * 64, F.k_norm_w + l * 64};
            for (int rp = 0; rp < REP_PROJ; ++rp) { if (rp) GRID_BAR(); pg8::gemm_phase<pg8::EpiFused, pg8::StaticOrder, true, true>(F.lds + RING_OFF, g, S, E, F.wave0); }
            if (BOTH(pb)) GRID_BAR();
        }
        if (IN(pb + 1)) {
            for (int rp = 0; rp < REP_HGRN; ++rp) { if (rp) GRID_BAR(); hgrn_mfma_phase(F, l); }
            for (int rp = 0; rp < REP_MOBA; ++rp) { if (rp) { GRID_BAR(); if (blockIdx.x == 0 && F.wave0 == 0 && lane_id_asm() == 0) __hip_atomic_store(F.ctl + CW_QUEUE + 64 * l, 0u, RLX_AGENT); GRID_BAR(); } moba_mfma_phase(F, l); }
            if (BOTH(pb + 1)) GRID_BAR(); }
        if (IN(pb + 2)) {
            pg8::Gemm g{F.MIXED, F.WOUT + (size_t)l * DM * DM, MTOK, DM, DM}; pg8::StaticOrder S; S.init(MTOK, DM, F.G, (int)blockIdx.x);
            pg8::EpiOut E{l == 0 ? F.x : nullptr, F.XB + (size_t)MTOK * DM, l == 0 ? nullptr : F.out, l == 0 ? F.XB + (size_t)MTOK * DM : nullptr, l == 0 ? F.ROWSS + (size_t)MTOK * 16 : nullptr};
            for (int rp = 0; rp < REP_OUT; ++rp) { if (rp) GRID_BAR(); pg8::gemm_phase<pg8::EpiOut, pg8::StaticOrder, true, true>(F.lds + RING_OFF, g, S, E, F.wave0); }
            if (pb + 2 < N_PHASES - 1 && BOTH(pb + 2)) GRID_BAR();
        }
    }
#undef IN
#undef BOTH
}

extern "C" void kernel_launch(void* const* d_in, const int* in_sizes, int n_in, void* d_out, int out_size, void* d_ws, size_t ws_size, hipStream_t stream) {
    static int grid = 0;
    if (grid == 0) {
        if (n_in != 8 || in_sizes[0] != MTOK * DM || out_size != MTOK * DM || ws_size < WS_END) { fprintf(stderr, "kernel_launch: unexpected shapes n_in %d in0 %d out %d ws %zu\n", n_in, n_in > 0 ? in_sizes[0] : -1, out_size, ws_size); grid = -1; return; }
        int dev = 0, cus = 0, per_cu = 0;
        if (hipGetDevice(&dev) != hipSuccess || hipDeviceGetAttribute(&cus, hipDeviceAttributeMultiprocessorCount, dev) != hipSuccess) { grid = -1; return; }
        if (hipFuncSetAttribute((const void*)fwd, hipFuncAttributeMaxDynamicSharedMemorySize, LDS_BYTES) != hipSuccess) { fprintf(stderr, "kernel_launch: hipFuncSetAttribute failed\n"); grid = -1; return; }
        if (hipOccupancyMaxActiveBlocksPerMultiprocessor(&per_cu, (const void*)fwd, NWAVES * 64, LDS_BYTES) != hipSuccess || per_cu < 1) fprintf(stderr, "kernel_launch: occupancy query says %d\n", per_cu);
        (void)hipGetLastError();
        if (per_cu < 1) { grid = -1; return; }
        grid = cus;
    }
    if (grid < 0) return;
    if (hipMemsetAsync((char*)d_ws + WS_CTL, 0, CTL_ZERO_BYTES, stream) != hipSuccess) return;
    Args a{};
    for (int i = 0; i < 8; ++i) a.in[i] = (const float*)d_in[i];
    a.out = (float*)d_out; a.ws = (unsigned char*)d_ws;
    for (int li = 0; li < N_LAUNCHES; ++li) {
        a.ph_lo = (N_LAUNCHES == 1) ? 0 : li; a.ph_hi = (N_LAUNCHES == 1) ? N_PHASES : li + 1; a.li = li;
        hipError_t le;
        if (N_LAUNCHES == 1) { void* kargs[] = {(void*)&a}; le = hipLaunchCooperativeKernel((const void*)fwd, dim3(grid), dim3(NWAVES * 64), kargs, LDS_BYTES, stream); }
        else { hipLaunchKernelGGL(fwd, dim3(grid), dim3(NWAVES * 64), LDS_BYTES, stream, a); le = hipPeekAtLastError(); }
        if (le != hipSuccess) { fprintf(stderr, "kernel_launch: launch %d failed: %s\n", li, hipGetErrorName(le)); break; }
    }
}
```

```cpp
#include <hip/hip_runtime.h>
#include <cstdio>
#include <cstdint>
__device__ __forceinline__ int lane_id_asm() { int l; asm volatile("v_mbcnt_lo_u32_b32 %0, -1, 0\n\tv_mbcnt_hi_u32_b32 %0, -1, %0" : "=v"(l)); return l; }
namespace pg8 {
#define PG8_LAS __attribute__((address_space(3)))
typedef unsigned short bf16_t;
typedef short bf16x8 __attribute__((ext_vector_type(8)));
typedef float f32x4 __attribute__((ext_vector_type(4)));
typedef unsigned u32x4 __attribute__((ext_vector_type(4)));
typedef unsigned u32x2 __attribute__((ext_vector_type(2)));
constexpr int BM = 256, BK = 64, HALF = 128, HTB = HALF * BK * 2  , STAGE_BYTES = 8 * HTB, NXCD = 8, WGM = 8;

__host__ __device__ __forceinline__ int lds_byte(int r, int c) { const int st = (r >> 4) * 2 + (c >> 5), rr = r & 15, cc = c & 31, ob = rr * 64 + cc * 2; return st * 1024 + (ob ^ (((ob >> 9) & 1) << 5)); }
__host__ __device__ __forceinline__ void stage_rc(int b, int& R, int& C) { const int st = b / 1024, sb = b % 1024, swz = sb ^ (((sb >> 9) & 1) << 5); R = (st >> 1) * 16 + swz / 64; C = (st & 1) * 32 + (swz % 64) / 2; }
__host__ __device__ __forceinline__ int perm32(int rho) { const int n = rho >> 4, i = rho & 15; return 8 * (i >> 2) + 4 * n + (i & 3); }

struct Unit { int pm, pn; };
struct Gemm { const bf16_t* A; const bf16_t* Bt; int M, N, K; };

struct StaticOrder {
    int nM, nN, nwg, G, c;
    __host__ __device__ void init(int M, int N, int G_, int c_) { nM = M / BM; nN = N / BM; nwg = nM * nN; G = G_; c = c_; }
    __host__ __device__ bool next(int i, Unit& u) const {
        const long L = (long)i * G + c; if (L >= nwg) return false;
        int wgid = (int)L; { const int q = nwg / NXCD, r = nwg % NXCD, xcd = wgid % NXCD, off = wgid / NXCD; wgid = (xcd < r ? xcd * (q + 1) : r * (q + 1) + (xcd - r) * q) + off; }
        const int nig = WGM * nN, gid = wgid / nig, fm = gid * WGM, gsz = (nM - fm) < WGM ? (nM - fm) : WGM;
        u.pm = fm + ((wgid % nig) % gsz); u.pn = (wgid % nig) / gsz; return true;
    }
    __device__ __forceinline__ void a_ready(const Unit&) const {}
    __device__ __forceinline__ void done(const Unit&) const {}
};

__device__ __forceinline__ unsigned cvt_pk_bf16(float lo, float hi) { unsigned r; asm volatile("v_cvt_pk_bf16_f32 %0, %1, %2" : "=v"(r) : "v"(lo), "v"(hi)); return r; }


__device__ __forceinline__ float dpp_row_shr(float v, int n) {
    const int x = __builtin_bit_cast(int, v);
    int r;
    if (n == 1) r = __builtin_amdgcn_update_dpp(0, x, 0x111, 0xf, 0xf, false);
    else if (n == 2) r = __builtin_amdgcn_update_dpp(0, x, 0x112, 0xf, 0xf, false);
    else if (n == 4) r = __builtin_amdgcn_update_dpp(0, x, 0x114, 0xf, 0xf, false);
    else r = __builtin_amdgcn_update_dpp(0, x, 0x118, 0xf, 0xf, false);
    return __builtin_bit_cast(float, r);
}
__device__ __forceinline__ float dpp_row_shr1(float v, int n) {
    const int x = __builtin_bit_cast(int, v); const int one = 0x3f800000;
    int r;
    if (n == 1) r = __builtin_amdgcn_update_dpp(one, x, 0x111, 0xf, 0xf, false);
    else if (n == 2) r = __builtin_amdgcn_update_dpp(one, x, 0x112, 0xf, 0xf, false);
    else if (n == 4) r = __builtin_amdgcn_update_dpp(one, x, 0x114, 0xf, 0xf, false);
    else r = __builtin_amdgcn_update_dpp(one, x, 0x118, 0xf, 0xf, false);
    return __builtin_bit_cast(float, r);
}
__device__ __forceinline__ float fsig(float z) { return __builtin_amdgcn_rcpf(1.0f + __expf(-z)); }
struct EpiFused {
    static constexpr bool PERM = true, AFTER_DRAIN = false;
    bf16_t* ARR; float* DEC; float* KPART; const float* rowss; const float* lb; const float* qg; const float* kg;
    static constexpr size_t AS = (size_t)32768 * 512;
    __device__ __forceinline__ float rstd_of(int row) const {
        const f32x4* rp = (const f32x4*)(rowss + (size_t)row * 16);
        const f32x4 a = rp[0], b = rp[1], c = rp[2], d = rp[3];
        const float ss = ((a[0] + a[1]) + (a[2] + a[3])) + ((b[0] + b[1]) + (b[2] + b[3])) + ((c[0] + c[1]) + (c[2] + c[3])) + ((d[0] + d[1]) + (d[2] + d[3]));
        return 1.0f / sqrtf(ss * (1.0f / 1024.0f) + 1e-6f);
    }
    static __device__ __forceinline__ u32x4 pack8(const float (&v)[8]) { u32x4 w; w.x = cvt_pk_bf16(v[0], v[1]); w.y = cvt_pk_bf16(v[2], v[3]); w.z = cvt_pk_bf16(v[4], v[5]); w.w = cvt_pk_bf16(v[6], v[7]); return w; }
    __device__ __forceinline__ void operator()(const f32x4 (&acc)[2][2][4][2], const Unit& u, int wr, int wc, int fr, int fq) const {
        const int row0 = u.pm * BM + wr * 64 + fr; const int pn = u.pn;
        if (pn < 4) {
            const int cb = pn * 128 + wc * 32 + 8 * fq;
            float lbv[8];
#pragma unroll
            for (int k = 0; k < 8; ++k) lbv[k] = lb[cb + k];
#pragma unroll
            for (int ai = 0; ai < 2; ++ai)
#pragma unroll
                for (int mp = 0; mp < 2; ++mp) { const int row1 = row0 + ai * HALF + mp * 32, row2 = row1 + 16; const float rs1 = rstd_of(row1), rs2 = rstd_of(row2);
                    float qi1[8], kt1[8], qi2[8], kt2[8], dc[8];
#pragma unroll
                    for (int k = 0; k < 8; ++k) {
                        const float zq1 = acc[ai][0][2 * mp][k >> 2][k & 3] * rs1, zf1 = acc[ai][1][2 * mp][k >> 2][k & 3] * rs1;
                        const float zq2 = acc[ai][0][2 * mp + 1][k >> 2][k & 3] * rs2, zf2 = acc[ai][1][2 * mp + 1][k >> 2][k & 3] * rs2;
                        const float f1 = lbv[k] + (1.0f - lbv[k]) * fsig(zf1), f2 = lbv[k] + (1.0f - lbv[k]) * fsig(zf2);
                        float e1 = f1, e2 = f2;
                        e1 *= dpp_row_shr1(e1, 1); e2 *= dpp_row_shr1(e2, 1); e1 *= dpp_row_shr1(e1, 2); e2 *= dpp_row_shr1(e2, 2);
                        e1 *= dpp_row_shr1(e1, 4); e2 *= dpp_row_shr1(e2, 4); e1 *= dpp_row_shr1(e1, 8); e2 *= dpp_row_shr1(e2, 8);
                        e2 *= __shfl(e1, (fq << 4) | 15);
                        qi1[k] = zq1 * fsig(zq1) * e1; kt1[k] = (1.0f - f1) * fminf(__builtin_amdgcn_rcpf(e1), 5.5406224e34f);
                        qi2[k] = zq2 * fsig(zq2) * e2; kt2[k] = (1.0f - f2) * fminf(__builtin_amdgcn_rcpf(e2), 5.5406224e34f); dc[k] = e2; }
                    { const int pc = pn * 128 + wc * 32 + 16 * (fq & 1) + 4 * (fq >> 1);
                      const u32x4 a1 = pack8(qi1), b1 = pack8(kt1), a2 = pack8(qi2), b2 = pack8(kt2);
                      bf16_t* q1 = ARR + (size_t)row1 * 512 + pc; bf16_t* q2 = ARR + (size_t)row2 * 512 + pc;
                      *(u32x2*)(q1) = (u32x2){a1.x, a1.y}; *(u32x2*)(q1 + 8) = (u32x2){a1.z, a1.w}; *(u32x2*)(q1 + AS) = (u32x2){b1.x, b1.y}; *(u32x2*)(q1 + AS + 8) = (u32x2){b1.z, b1.w};
                      *(u32x2*)(q2) = (u32x2){a2.x, a2.y}; *(u32x2*)(q2 + 8) = (u32x2){a2.z, a2.w}; *(u32x2*)(q2 + AS) = (u32x2){b2.x, b2.y}; *(u32x2*)(q2 + AS + 8) = (u32x2){b2.z, b2.w}; }
                    if (fr == 15) { float* dp = DEC + (size_t)(row1 >> 5) * 512 + cb; *(f32x4*)dp = (f32x4){dc[0], dc[1], dc[2], dc[3]}; *(f32x4*)(dp + 4) = (f32x4){dc[4], dc[5], dc[6], dc[7]}; }
                    asm volatile("" ::: "memory"); }
        } else if (pn < 8) {
            const int cb = (pn - 4) * 128 + wc * 32 + 8 * fq;
#pragma unroll
            for (int ai = 0; ai < 2; ++ai)
#pragma unroll
                for (int m = 0; m < 4; ++m) { const int row = row0 + ai * HALF + m * 16; const float rs = rstd_of(row);
                    float iv[8], gv[8];
#pragma unroll
                    for (int k = 0; k < 8; ++k) { iv[k] = acc[ai][0][m][k >> 2][k & 3] * rs; const float zg = acc[ai][1][m][k >> 2][k & 3] * rs; gv[k] = zg * fsig(zg); }
                    *(u32x4*)(ARR + 2 * AS + (size_t)row * 512 + cb) = pack8(iv); *(u32x4*)(ARR + 3 * AS + (size_t)row * 512 + cb) = pack8(gv);
                    asm volatile("" ::: "memory"); }
        } else {
            const int ty = (pn - 8) >> 1, head = 4 * ((pn - 8) & 1) + wc; const int d0 = 8 * fq;
            bf16_t* dst = ARR + (size_t)(4 + ty) * AS;
            float gain[2][8]; float csum[2][8];
#pragma unroll
            for (int bj = 0; bj < 2; ++bj)
#pragma unroll
                for (int k = 0; k < 8; ++k) { gain[bj][k] = (ty == 0) ? qg[bj * 32 + d0 + k] * (0.125f * 1.4426950408889634f) : (ty == 1) ? kg[bj * 32 + d0 + k] : 1.0f; csum[bj][k] = 0.f; }
#pragma unroll
            for (int ai = 0; ai < 2; ++ai)
#pragma unroll
                for (int m = 0; m < 4; ++m) { const int row = row0 + ai * HALF + m * 16; const float rs = rstd_of(row);
                    float v[2][8];
#pragma unroll
                    for (int bj = 0; bj < 2; ++bj)
#pragma unroll
                        for (int k = 0; k < 8; ++k) v[bj][k] = acc[ai][bj][m][k >> 2][k & 3] * rs;
                    if (ty < 2) { float ss = 0.f;
#pragma unroll
                        for (int bj = 0; bj < 2; ++bj)
#pragma unroll
                            for (int k = 0; k < 8; ++k) ss += v[bj][k] * v[bj][k];
                        ss += __shfl_xor(ss, 16); ss += __shfl_xor(ss, 32);
                        const float r2 = 1.0f / sqrtf(ss * (1.0f / 64.0f) + 1e-6f);
#pragma unroll
                        for (int bj = 0; bj < 2; ++bj)
#pragma unroll
                            for (int k = 0; k < 8; ++k) { v[bj][k] *= r2 * gain[bj][k]; csum[bj][k] += v[bj][k]; }
                    } else if (ty == 3) {
#pragma unroll
                        for (int bj = 0; bj < 2; ++bj)
#pragma unroll
                            for (int k = 0; k < 8; ++k) v[bj][k] = v[bj][k] * fsig(v[bj][k]); }
                    *(u32x4*)(dst + (size_t)row * 512 + head * 64 + d0) = pack8(v[0]); *(u32x4*)(dst + (size_t)row * 512 + head * 64 + 32 + d0) = pack8(v[1]);
                    asm volatile("" ::: "memory"); }
            if (ty == 1) {
#pragma unroll
                for (int bj = 0; bj < 2; ++bj)
#pragma unroll
                    for (int k = 0; k < 8; ++k) { float s = csum[bj][k]; s += __shfl_xor(s, 1); s += __shfl_xor(s, 2); s += __shfl_xor(s, 4); s += __shfl_xor(s, 8); csum[bj][k] = s; }
                if (fr == 0) { float* kp = KPART + ((size_t)u.pm * 2 + wr) * 512 + head * 64 + d0;
#pragma unroll
                    for (int bj = 0; bj < 2; ++bj) { *(f32x4*)(kp + bj * 32) = (f32x4){csum[bj][0], csum[bj][1], csum[bj][2], csum[bj][3]}; *(f32x4*)(kp + bj * 32 + 4) = (f32x4){csum[bj][4], csum[bj][5], csum[bj][6], csum[bj][7]}; } }
            }
        }
    }
};
struct EpiOut {
    static constexpr bool PERM = false, AFTER_DRAIN = false;
    const float* xres; const bf16_t* xres16; float* out; bf16_t* xb; float* rowss;
    __device__ __forceinline__ void operator()(const f32x4 (&acc)[2][2][4][2], const Unit& u, int wr, int wc, int fr, int fq) const {
        const int col0 = u.pn * BM + wc * 32 + 4 * fq;
#pragma unroll
        for (int ai = 0; ai < 2; ++ai)
#pragma unroll
            for (int m = 0; m < 4; ++m) {
                const int row = u.pm * BM + ai * HALF + wr * 64 + m * 16 + fr; float ss = 0.f;
#pragma unroll
                for (int bj = 0; bj < 2; ++bj)
#pragma unroll
                    for (int n = 0; n < 2; ++n) { const size_t off = (size_t)row * 1024 + col0 + bj * HALF + n * 16;
                        f32x4 v;
                        if (xres) v = *(const f32x4*)(xres + off); else { const u32x2 r = *(const u32x2*)(xres16 + off); v = (f32x4){__builtin_bit_cast(float, r.x << 16), __builtin_bit_cast(float, r.x & 0xffff0000u), __builtin_bit_cast(float, r.y << 16), __builtin_bit_cast(float, r.y & 0xffff0000u)}; }
                        v = v + acc[ai][bj][m][n];
                        if (out) *(f32x4*)(out + off) = v;
                        if (xb) { u32x2 w; w.x = cvt_pk_bf16(v[0], v[1]); w.y = cvt_pk_bf16(v[2], v[3]); *(u32x2*)(xb + off) = w; }
                        ss += (v[0] * v[0] + v[1] * v[1]) + (v[2] * v[2] + v[3] * v[3]); }
                ss += __shfl_xor(ss, 16); ss += __shfl_xor(ss, 32);
                if (fq == 0 && rowss) rowss[(size_t)row * 16 + u.pn * 4 + wc] = ss;
            }
    }
};

template <class Epi, class Sched, bool ALIGN_EPI = false, bool SP2 = false>
__device__ __forceinline__ void gemm_phase(PG8_LAS unsigned char* lds, const Gemm g, const Sched& S, const Epi& E, const int wave0) {
    int tid = wave0 * 64 + lane_id_asm(); asm volatile("" : "+v"(tid));
    const int wid = __builtin_amdgcn_readfirstlane(tid >> 6), lane = tid & 63, wr = wid >> 2, wc = wid & 3, fr = lane & 15, fq = lane >> 4;
    const int K = g.K, nt = K / BK;
    unsigned voffA[2], voffB[2];
#pragma unroll
    for (int i = 0; i < 2; ++i) { int R, C; stage_rc(tid * 16 + i * 8192, R, C); const int Rb = Epi::PERM ? ((R & ~31) + perm32(R & 31)) : R;
        voffA[i] = (unsigned)(R * K + C) * 2u; voffB[i] = (unsigned)(Rb * K + C) * 2u; }
    const size_t kstep = (size_t)(BK * 2);
    const size_t hstep = (size_t)HALF * K * 2;
    const size_t tstep = 2 * hstep;
    const unsigned ldsw = (unsigned)wid * 1024u;
    const int aoff = lds_byte(wr * 64 + fr, fq * 8), boff = lds_byte(wc * 32 + fr, fq * 8);
#define PG8_SA(b, h) (((b) * 2 + (h)) * HTB)
#define PG8_SB(b, h) ((4 + (b) * 2 + (h)) * HTB)
#define PG8_STAGE(bufoff, gbase, voff) do { _Pragma("unroll") for (int _i = 0; _i < 2; ++_i) \
        __builtin_amdgcn_global_load_lds((const unsigned*)((const char*)(gbase) + (voff)[_i]), (PG8_LAS unsigned*)(lds + (bufoff) + ldsw + _i * 8192), 16, 0, 0); } while (0)
#define PG8_LDA(dst, b, h) do { _Pragma("unroll") for (int m = 0; m < 4; ++m) _Pragma("unroll") for (int k = 0; k < 2; ++k) dst[m][k] = *(const PG8_LAS bf16x8*)(lds + PG8_SA(b, h) + aoff + m * 2048 + k * 1024); } while (0)
#define PG8_LDB(dst, b, h) do { _Pragma("unroll") for (int n = 0; n < 2; ++n) _Pragma("unroll") for (int k = 0; k < 2; ++k) dst[n][k] = *(const PG8_LAS bf16x8*)(lds + PG8_SB(b, h) + boff + n * 2048 + k * 1024); } while (0)
#define PG8_MMA(ai, bj, At, Bt) do { __builtin_amdgcn_s_setprio(1); _Pragma("unroll") for (int m = 0; m < 4; ++m) _Pragma("unroll") for (int n = 0; n < 2; ++n) _Pragma("unroll") for (int k = 0; k < 2; ++k) \
        acc[ai][bj][m][n] = __builtin_amdgcn_mfma_f32_16x16x32_bf16(Bt[n][k], At[m][k], acc[ai][bj][m][n], 0, 0, 0); __builtin_amdgcn_s_setprio(0); } while (0)
#define PG8_WAIT_V(n) asm volatile("s_waitcnt vmcnt(" #n ")" ::: "memory")
#define PG8_WAIT_L(n) asm volatile("s_waitcnt lgkmcnt(" #n ")" ::: "memory")
#define PG8_BAR __builtin_amdgcn_s_barrier()
#define PG8_SCHED __builtin_amdgcn_sched_barrier(0)
    Unit cur, nxt; int ui = 0;
    if (!S.next(0, cur)) return;
    f32x4 acc[2][2][4][2];
#pragma unroll
    for (int a = 0; a < 2; ++a)
#pragma unroll
        for (int b = 0; b < 2; ++b)
#pragma unroll
            for (int m = 0; m < 4; ++m)
#pragma unroll
                for (int n = 0; n < 2; ++n) acc[a][b][m][n] = (f32x4){0.f, 0.f, 0.f, 0.f};
    bf16x8 At[4][2], B0[2][2], B1[2][2];
    const char* cA = (const char*)g.A + (size_t)cur.pm * tstep; const char* cB = (const char*)g.Bt + (size_t)cur.pn * tstep;
    S.a_ready(cur);
    if constexpr (SP2) {
        PG8_STAGE(PG8_SB(0, 0), cB, voffB); PG8_STAGE(PG8_SB(0, 1), cB + hstep, voffB); PG8_STAGE(PG8_SA(0, 0), cA, voffA); PG8_STAGE(PG8_SA(0, 1), cA + hstep, voffA);
        if (wr == 1) PG8_BAR;
        PG8_WAIT_V(2); PG8_BAR;
        PG8_STAGE(PG8_SB(1, 0), cB + kstep, voffB); PG8_STAGE(PG8_SA(1, 0), cA + kstep, voffA); PG8_STAGE(PG8_SB(1, 1), cB + hstep + kstep, voffB);
        PG8_WAIT_V(6); PG8_BAR;
    } else {
        PG8_STAGE(PG8_SB(0, 0), cB, voffB); PG8_STAGE(PG8_SA(0, 0), cA, voffA); PG8_STAGE(PG8_SB(0, 1), cB + hstep, voffB); PG8_STAGE(PG8_SA(0, 1), cA + hstep, voffA);
        if (wr == 1) PG8_BAR;
        PG8_WAIT_V(4); PG8_BAR;
        PG8_STAGE(PG8_SB(1, 0), cB + kstep, voffB); PG8_STAGE(PG8_SA(1, 0), cA + kstep, voffA); PG8_STAGE(PG8_SB(1, 1), cB + hstep + kstep, voffB);
        PG8_WAIT_V(6); PG8_BAR;
    }
    for (;;) {
        const bool has_next = S.next(ui + 1, nxt);
        const char* nA = has_next ? (const char*)g.A + (size_t)nxt.pm * tstep : cA; const char* nB = has_next ? (const char*)g.Bt + (size_t)nxt.pn * tstep : cB;
        for (int t = 0; t < nt; t += 2) {
            const bool last = (t == nt - 2);
            const char* a1 = cA + (size_t)(t + 1) * kstep;
            const char* a2 = last ? nA : cA + (size_t)(t + 2) * kstep; const char* b2 = last ? nB : cB + (size_t)(t + 2) * kstep;
            const char* a3 = a2 + kstep; const char* b3 = b2 + kstep;
            if (last && has_next) S.a_ready(nxt);
            if constexpr (SP2) {
            PG8_LDB(B0, 0, 0); PG8_LDB(B1, 0, 1); PG8_SCHED; PG8_LDA(At, 0, 0); PG8_STAGE(PG8_SA(1, 1), a1 + hstep, voffA);
            PG8_WAIT_V(8); PG8_WAIT_L(0); PG8_BAR; PG8_MMA(0, 0, At, B0); PG8_MMA(0, 1, At, B1); PG8_BAR; PG8_SCHED;
            PG8_LDA(At, 0, 1); PG8_STAGE(PG8_SB(0, 0), b2, voffB); PG8_STAGE(PG8_SB(0, 1), b2 + hstep, voffB); PG8_STAGE(PG8_SA(0, 0), a2, voffA);
            PG8_WAIT_V(8); PG8_WAIT_L(0); PG8_BAR; PG8_MMA(1, 0, At, B0); PG8_MMA(1, 1, At, B1); PG8_BAR; PG8_SCHED;
            PG8_LDB(B0, 1, 0); PG8_LDB(B1, 1, 1); PG8_SCHED; PG8_LDA(At, 1, 0); PG8_STAGE(PG8_SA(0, 1), a2 + hstep, voffA);
            PG8_WAIT_V(8); PG8_WAIT_L(0); PG8_BAR; PG8_MMA(0, 0, At, B0); PG8_MMA(0, 1, At, B1); PG8_BAR; PG8_SCHED;
            PG8_LDA(At, 1, 1); PG8_STAGE(PG8_SB(1, 0), b3, voffB); PG8_STAGE(PG8_SB(1, 1), b3 + hstep, voffB); PG8_STAGE(PG8_SA(1, 0), a3, voffA);
            PG8_WAIT_V(8); PG8_WAIT_L(0); PG8_BAR; PG8_MMA(1, 0, At, B0); PG8_MMA(1, 1, At, B1); PG8_BAR; PG8_SCHED;
            } else {
            PG8_LDB(B0, 0, 0); PG8_SCHED; PG8_LDA(At, 0, 0); PG8_STAGE(PG8_SA(1, 1), a1 + hstep, voffA);
            PG8_WAIT_L(8); PG8_BAR; PG8_WAIT_L(0); PG8_MMA(0, 0, At, B0); PG8_BAR; PG8_SCHED;
            PG8_LDB(B1, 0, 1); PG8_STAGE(PG8_SB(0, 0), b2, voffB);
            PG8_BAR; PG8_WAIT_L(0); PG8_MMA(0, 1, At, B1); PG8_BAR;
            PG8_LDA(At, 0, 1); PG8_STAGE(PG8_SA(0, 0), a2, voffA);
            PG8_BAR; PG8_WAIT_L(0); PG8_MMA(1, 0, At, B0); PG8_BAR; PG8_SCHED;
            PG8_STAGE(PG8_SB(0, 1), b2 + hstep, voffB);
            PG8_WAIT_V(6); PG8_BAR; PG8_MMA(1, 1, At, B1); PG8_BAR;
            PG8_LDB(B0, 1, 0); PG8_SCHED; PG8_LDA(At, 1, 0); PG8_STAGE(PG8_SA(0, 1), a2 + hstep, voffA);
            PG8_WAIT_L(8); PG8_BAR; PG8_WAIT_L(0); PG8_MMA(0, 0, At, B0); PG8_BAR; PG8_SCHED;
            PG8_LDB(B1, 1, 1); PG8_STAGE(PG8_SB(1, 0), b3, voffB);
            PG8_BAR; PG8_WAIT_L(0); PG8_MMA(0, 1, At, B1); PG8_BAR;
            PG8_LDA(At, 1, 1); PG8_STAGE(PG8_SA(1, 0), a3, voffA);
            PG8_BAR; PG8_WAIT_L(0); PG8_MMA(1, 0, At, B0); PG8_BAR; PG8_SCHED;
            PG8_STAGE(PG8_SB(1, 1), b3 + hstep, voffB);
            PG8_WAIT_V(6); PG8_BAR; PG8_MMA(1, 1, At, B1); PG8_BAR;
            }
        }
        if constexpr (ALIGN_EPI) { if (wr == 0) PG8_BAR; }
        if constexpr (!Epi::AFTER_DRAIN) { E(acc, cur, wr, wc, fr, fq); S.done(cur); }
        if (!has_next) break;
#pragma unroll
        for (int a = 0; a < 2; ++a)
#pragma unroll
            for (int b = 0; b < 2; ++b)
#pragma unroll
                for (int m = 0; m < 4; ++m)
#pragma unroll
                    for (int n = 0; n < 2; ++n) acc[a][b][m][n] = (f32x4){0.f, 0.f, 0.f, 0.f};
        cur = nxt; cA = nA; cB = nB; ++ui;
        if constexpr (ALIGN_EPI) { if (wr == 1) PG8_BAR; }
    }
    PG8_WAIT_V(0);
    if constexpr (!ALIGN_EPI) { if (wr == 0) PG8_BAR; }
    PG8_BAR;
    if constexpr (Epi::AFTER_DRAIN) { E.fused(acc, cur, wr, wc, fr, fq, lds, wid, lane); S.done(cur); }
#undef PG8_SA
#undef PG8_SB
#undef PG8_STAGE
#undef PG8_LDA
#undef PG8_LDB
#undef PG8_MMA
#undef PG8_WAIT_V
#undef PG8_WAIT_L
#undef PG8_BAR
#undef PG8_SCHED
}
}


constexpr int NWAVES = 8;
#ifndef REP_PROJ
#define REP_PROJ 1
#endif
#ifndef REP_HGRN
#define REP_HGRN 1
#endif
#ifndef REP_MOBA
#define REP_MOBA 1
#endif
#ifndef REP_OUT
#define REP_OUT 1
#endif
#ifndef MK_N_LAUNCHES
#define MK_N_LAUNCHES 1
#endif
constexpr int N_PHASES = 7;
constexpr int N_LAUNCHES = MK_N_LAUNCHES;

constexpr int BATCH = 16, SEQ = 2048, DM = 1024, DEPTH = 2, MTOK = BATCH * SEQ, NIN = 4096;
constexpr int C_HQ = 0, C_HF = 512, C_HI = 1024, C_HG = 1536, C_AQ = 2048, C_AK = 2560, C_AV = 3072, C_AG = 3584;
constexpr float NORM_EPS = 1e-6f;

constexpr size_t MiB = 1u << 20;
constexpr size_t WS_CTL = 0, CTL_ZERO_BYTES = 1 * MiB;
constexpr size_t WS_WIN = 2 * MiB;
constexpr size_t WS_WOUT = 18 * MiB;
constexpr size_t WS_LB = 22 * MiB;
constexpr size_t WS_KPART = 22 * MiB + 65536;
constexpr size_t WS_ROWSS = 24 * MiB;
constexpr size_t WS_DEC = 28 * MiB;
constexpr size_t WS_XB = 32 * MiB;
constexpr size_t WS_MIXED = 160 * MiB;
constexpr size_t WS_ARR = 224 * MiB;
constexpr size_t ARR_BYTES = 32 * MiB;
constexpr size_t WS_END = 480 * MiB;
constexpr int CW_QUEUE = 1024;
constexpr int CW_BAR = 4096;

constexpr int RING_OFF = 0, RING_BYTES = 131072;
constexpr int EXTRA_OFF = RING_BYTES, EXTRA_BYTES = 16384;
constexpr int LDSCTL_OFF = EXTRA_OFF + EXTRA_BYTES, MISC_OFF = LDSCTL_OFF + 320;
constexpr int LDS_BYTES = LDSCTL_OFF + 1024;

#define GAS __attribute__((address_space(1)))
#define LAS __attribute__((address_space(3)))
typedef unsigned short bf16;
typedef unsigned v4u __attribute__((ext_vector_type(4)));
typedef float f32x4 __attribute__((ext_vector_type(4)));
typedef GAS unsigned gu32;
#define RLX_AGENT __ATOMIC_RELAXED, __HIP_MEMORY_SCOPE_AGENT
#define LDS_WAIT() asm volatile("s_waitcnt lgkmcnt(0)" ::: "memory")
#define VM_WAIT() asm volatile("s_waitcnt vmcnt(0)" ::: "memory")
__device__ __forceinline__ unsigned f2bf(float f) { unsigned u = __builtin_bit_cast(unsigned, f); return (u + 0x7fffu + ((u >> 16) & 1u)) >> 16; }
__device__ __forceinline__ unsigned pk2(float lo, float hi) { return f2bf(lo) | (f2bf(hi) << 16); }
__device__ __forceinline__ float bf2f(unsigned short b) { return __builtin_bit_cast(float, (unsigned)b << 16); }
__device__ __forceinline__ float bflo(unsigned w) { return __builtin_bit_cast(float, w << 16); }
__device__ __forceinline__ float bfhi(unsigned w) { return __builtin_bit_cast(float, w & 0xffff0000u); }
__device__ __forceinline__ float silu_f(float z) { return z / (1.0f + __expf(-z)); }
__device__ __forceinline__ float sigmoid_f(float z) { return 1.0f / (1.0f + __expf(-z)); }

#define XB_TMO      128
#define XB_XCNT(j)  (256  + 64 * (j))
#define XB_XSUB(j)  (1280 + 64 * (j))
#define XB_XGEN(j)  (2304 + 64 * (j))
#define XB_TOP      3328
#define XB_TOPGEN   3392
#define XCD_BAR_WORDS 3456
#define XB_SPIN_CAP (1u << 18)

__device__ __forceinline__ unsigned xb_ld(unsigned* p)              { return __hip_atomic_load(p, __ATOMIC_RELAXED, __HIP_MEMORY_SCOPE_AGENT); }
__device__ __forceinline__ unsigned xb_add(unsigned* p, unsigned v) { return __hip_atomic_fetch_add(p, v, __ATOMIC_RELAXED, __HIP_MEMORY_SCOPE_AGENT); }
__device__ __forceinline__ unsigned xb_xcc_id() { return (unsigned)__builtin_amdgcn_s_getreg((3 << 11) | 20) & 0xFu; }
#define XB_SPIN(cond, bar) do { unsigned _sp = 0; while (cond) { __builtin_amdgcn_s_sleep(1); \
    if ((++_sp & 255u) == 0u) { if (xb_ld(&(bar)[XB_TMO])) break; if (_sp > XB_SPIN_CAP) { atomicAdd(&(bar)[XB_TMO], 1u); break; } } } } while (0)

struct XcdBarrier {
    unsigned* bar; unsigned x; int wave0;
    volatile LAS unsigned* st;
};

#define XB_IS_T0(wv) ((wv) == 0 && lane_id_asm() == 0)
__device__ __forceinline__ XcdBarrier xcd_barrier_post(unsigned* bar, volatile LAS unsigned* st, int wave0) {
    XcdBarrier b; b.bar = bar; b.x = xb_xcc_id(); b.st = st; b.wave0 = wave0;
    if (XB_IS_T0(wave0)) (void)xb_add(&bar[XB_XCNT(b.x)], 1u);
    return b;
}
__device__ __forceinline__ void xcd_barrier_complete(unsigned* bar, unsigned x, unsigned& nloc, unsigned& nx) {
    const unsigned G = gridDim.x * gridDim.y * gridDim.z;
    unsigned sum, cnt, mine, sp = 0u;
    for (;;) {
        sum = 0u; cnt = 0u; mine = 0u;
#pragma unroll
        for (unsigned j = 0; j < 16; ++j) { const unsigned c = xb_ld(&bar[XB_XCNT(j)]); sum += c; cnt += (c > 0u) ? 1u : 0u; mine = (j == x) ? c : mine; }
        if (sum == G) break;
        __builtin_amdgcn_s_sleep(1);
        if ((++sp & 255u) == 0u) { if (xb_ld(&bar[XB_TMO])) break; if (sp > XB_SPIN_CAP) { atomicAdd(&bar[XB_TMO], 1u); break; } }
    }
    nloc = mine > 0u ? mine : 1u; nx = cnt > 0u ? cnt : 1u;
}

__device__ __forceinline__ void xcd_barrier(const XcdBarrier& b) {
    asm volatile("s_waitcnt vmcnt(0)" ::: "memory");
    __syncthreads();
    if (XB_IS_T0(b.wave0)) {
        unsigned* bar = b.bar;
        __builtin_amdgcn_s_waitcnt(0);
        unsigned nloc = b.st[0], nx = b.st[1];
        if (nloc == 0u) { xcd_barrier_complete(bar, b.x, nloc, nx); b.st[0] = nloc; b.st[1] = nx; }
        const unsigned old = xb_add(&bar[XB_XSUB(b.x)], 1u);
        const unsigned gen = old / nloc;
        if (old + 1u == (gen + 1u) * nloc) {
            __builtin_amdgcn_fence(__ATOMIC_RELEASE, "agent");
            asm volatile("s_waitcnt vmcnt(0)" ::: "memory");
            const unsigned og = xb_add(&bar[XB_TOP], 1u);
            const unsigned tg = og / nx;
            if (og + 1u == (tg + 1u) * nx) xb_add(&bar[XB_TOPGEN], 1u);
            else XB_SPIN(xb_ld(&bar[XB_TOPGEN]) == tg, bar);
            __builtin_amdgcn_fence(__ATOMIC_ACQUIRE, "agent");
            xb_add(&bar[XB_XGEN(b.x)], 1u);
            asm volatile("s_waitcnt vmcnt(0)" ::: "memory");
        } else {
            XB_SPIN(xb_ld(&bar[XB_XGEN(b.x)]) == gen, bar);
            __builtin_amdgcn_fence(__ATOMIC_ACQUIRE, "agent");
            asm volatile("s_waitcnt vmcnt(0)" ::: "memory");
        }
    }
    __syncthreads();
}


struct Frame {
    LAS unsigned char* lds;
    volatile LAS unsigned* MISC;
    int wave0;
    gu32* ctl;
    int vcu, G;
    const float* x; float* out;
    const float *norm_w, *w_in, *lb_logits, *hg_norm_w, *q_norm_w, *k_norm_w, *w_out;
    bf16 *WIN, *WOUT, *XB, *MIXED, *QI, *KT, *HI, *GH, *QN, *KN, *V, *GA;
    float *LB, *KPART, *ROWSS, *DEC;
};

__device__ __forceinline__ float wave_sum(float v) {
#pragma unroll
    for (int o = 1; o < 64; o <<= 1) v += __shfl_xor(v, o);
    return v;
}
__device__ __forceinline__ int win_dest(int oc) {
    if (oc < 2048) { const int grp = oc >> 9, hh = (oc >> 7) & 3, w = oc & 127; return 256 * (((grp >> 1) << 2) + hh) + 128 * (grp & 1) + w; }
    const int ty = (oc - 2048) >> 9, head = (oc >> 6) & 7, bj = (oc >> 5) & 1; return 256 * (8 + 2 * ty + (head >> 2)) + 128 * bj + 32 * (head & 3);
}
__device__ __forceinline__ void p0_transpose_item(const float* W, int K, int N, bf16* WT, const float* kscale, LAS float* scr, int item, int lane, bool permute) {
    const int nblk = N / 32, kb = item / nblk, nb = item % nblk, k0 = 64 * kb, n0 = 32 * nb; const int nd = permute ? win_dest(n0) : n0;
    float wv_[32];
#pragma unroll
    for (int i = 0; i < 32; ++i) wv_[i] = W[(size_t)(k0 + 2 * i + (lane >> 5)) * N + n0 + (lane & 31)];
#pragma unroll
    for (int i = 0; i < 32; ++i) { const int kk = 2 * i + (lane >> 5); const float s = kscale ? kscale[k0 + kk] : 1.0f; scr[kk * 33 + (lane & 31)] = wv_[i] * s; }
    LDS_WAIT(); asm volatile("" ::: "memory");
    const int c = lane & 7;
#pragma unroll
    for (int j = 0; j < 4; ++j) { const int n = (lane >> 3) + 8 * j; const LAS float* s = scr + (8 * c) * 33 + n;
        v4u o; o.x = pk2(s[0 * 33], s[1 * 33]); o.y = pk2(s[2 * 33], s[3 * 33]); o.z = pk2(s[4 * 33], s[5 * 33]); o.w = pk2(s[6 * 33], s[7 * 33]);
        *(GAS v4u*)(WT + (size_t)(nd + n) * K + k0 + 8 * c) = o; }
    LDS_WAIT(); asm volatile("" ::: "memory");
}
#define PHASE_IDS() int t_ = F.wave0 * 64 + lane_id_asm(); asm volatile("" : "+v"(t_)); const int tid = t_, lane = tid & 63, wave = __builtin_amdgcn_readfirstlane(tid >> 6); (void)lane; (void)wave
__device__ __forceinline__ void p0_prologue(Frame& F) {
    PHASE_IDS();
    LAS float* scr = (LAS float*)(F.lds + RING_OFF + wave * 16384);
    const int gw = F.vcu * NWAVES + wave, NGW = F.G * NWAVES;
    constexpr int I_IN = (DM / 64) * (NIN / 32), I_OUT = (DM / 64) * (DM / 32);
    constexpr int NITEMS = DEPTH * (I_IN + I_OUT);
    for (int it = gw; it < NITEMS; it += NGW) {
        int r = it;
        if (r < DEPTH * I_IN) { const int l = r / I_IN; r -= l * I_IN;
            p0_transpose_item(F.w_in + (size_t)l * DM * NIN, DM, NIN, F.WIN + (size_t)l * NIN * DM, F.norm_w + l * DM, scr, r, lane, true); continue; }
        r -= DEPTH * I_IN; { const int l = r / I_OUT; r -= l * I_OUT;
            p0_transpose_item(F.w_out + (size_t)l * DM * DM, DM, DM, F.WOUT + (size_t)l * DM * DM, nullptr, scr, r, lane, false); }
    }
    for (int m0 = gw * 4; m0 < MTOK; m0 += NGW * 4) {
        f32x4 v[4][4]; float sq[4];
#pragma unroll
        for (int r = 0; r < 4; ++r) { const GAS f32x4* xr = (const GAS f32x4*)(F.x + (size_t)(m0 + r) * DM) + lane;
#pragma unroll
            for (int j = 0; j < 4; ++j) v[r][j] = xr[64 * j]; }
#pragma unroll
        for (int r = 0; r < 4; ++r) { float a = 0.f;
#pragma unroll
            for (int j = 0; j < 4; ++j) a += (v[r][j].x * v[r][j].x + v[r][j].y * v[r][j].y) + (v[r][j].z * v[r][j].z + v[r][j].w * v[r][j].w);
            sq[r] = a; }
#pragma unroll
        for (int o = 1; o < 64; o <<= 1) {
#pragma unroll
            for (int r = 0; r < 4; ++r) sq[r] += __shfl_xor(sq[r], o); }
#pragma unroll
        for (int r = 0; r < 4; ++r) { GAS unsigned long long* o8 = (GAS unsigned long long*)(F.XB + (size_t)(m0 + r) * DM) + lane;
#pragma unroll
            for (int j = 0; j < 4; ++j) o8[64 * j] = (unsigned long long)pk2(v[r][j].x, v[r][j].y) | ((unsigned long long)pk2(v[r][j].z, v[r][j].w) << 32);
            if (lane < 16) F.ROWSS[(size_t)(m0 + r) * 16 + lane] = (lane == 0) ? sq[r] : 0.f; }
    }
    if (blockIdx.x == 0) { const int c = tid; const float a0 = F.lb_logits[c], a1 = F.lb_logits[512 + c]; const float mx = fmaxf(a0, a1);
        const float e0 = expf(a0 - mx), e1 = expf(a1 - mx); const float p0 = e0 / (e0 + e1), p1 = e1 / (e0 + e1);
        F.LB[c] = 0.f; F.LB[512 + c] = fminf(fmaxf((p0 + p1) - p0, 0.f), 1.0f - 1e-6f); }
}

constexpr float LOG2E = 1.4426950408889634f;
constexpr float QSCALE2 = 0.125f * LOG2E;
namespace moba {
typedef short bf16x8 __attribute__((ext_vector_type(8)));
typedef short s16x4 __attribute__((ext_vector_type(4)));
typedef float f32x16 __attribute__((ext_vector_type(16)));
typedef float f32x2_t __attribute__((ext_vector_type(2))); typedef __bf16 bf16x2_t __attribute__((ext_vector_type(2)));
__device__ __forceinline__ unsigned cvtpk(float lo, float hi) { f32x2_t v = {lo, hi}; bf16x2_t b = __builtin_convertvector(v, bf16x2_t); return __builtin_bit_cast(unsigned, b); }
__device__ __forceinline__ int crow(int r, int hi) { return (r & 3) + 8 * (r >> 2) + 4 * hi; }
__device__ __forceinline__ float max3f(float a, float b, float c) { float r; asm("v_max3_f32 %0, %1, %2, %3" : "=v"(r) : "v"(a), "v"(b), "v"(c)); return r; }
constexpr int L_K = 0, L_V = 32768, L_WSF = 65536, L_KM = 67584, L_OST = 69632;
constexpr float NEG_BIG = -1e30f;
constexpr float THR = 8.0f;
__device__ __forceinline__ s16x4 vtr(const LAS unsigned char* p) { return __builtin_bit_cast(s16x4, __builtin_amdgcn_ds_read_tr16_b64_v4i16((LAS s16x4*)p)); }
}

__device__ __forceinline__ void moba_glds(unsigned voff, const void* sbase, unsigned lds_dst) { unsigned keep;
    asm volatile("s_mov_b32 %0, m0\n\ts_mov_b32 m0, %3\n\ts_nop 0\n\tglobal_load_lds_dwordx4 %1, %2\n\ts_mov_b32 m0, %0" : "=&s"(keep) : "v"(voff), "s"(sbase), "s"(lds_dst) : "memory"); }
__device__ __forceinline__ void moba_mfma_phase(Frame& F, int l) {
    using namespace moba;
    PHASE_IDS();
    const int r32 = lane & 31, hi = lane >> 5, wid = wave;
    LAS unsigned char* L = F.lds + RING_OFF;
    LAS float* wsf = (LAS float*)(L + L_WSF) + wid * 64;
    LAS float* km = (LAS float*)(L + L_KM);
    LAS float* ost = (LAS float*)(L + L_OST) + wid * 2048;
    float gq = fabsf(F.q_norm_w[l * 64 + lane]), gk = fabsf(F.k_norm_w[l * 64 + lane]);
#pragma unroll
    for (int o = 1; o < 64; o <<= 1) { gq = fmaxf(gq, __shfl_xor(gq, o)); gk = fmaxf(gk, __shfl_xor(gk, o)); }
    gq = __builtin_bit_cast(float, __builtin_amdgcn_readfirstlane(__builtin_bit_cast(int, gq))); gk = __builtin_bit_cast(float, __builtin_amdgcn_readfirstlane(__builtin_bit_cast(int, gk)));
    const float smax2 = 8.0f * gq * gk * LOG2E * 1.02f;
    const float mhat0 = -(smax2 + 1.0f);
    gu32* qctr = F.ctl + CW_QUEUE + 64 * l;
    volatile LAS unsigned* tick = (volatile LAS unsigned*)(F.lds + EXTRA_OFF + 8192);
    if (tid == 0) tick[0] = __hip_atomic_fetch_add(qctr, 1u, RLX_AGENT);
    for (int ui = 0;; ++ui) {
        __syncthreads();
        const int it = __builtin_amdgcn_readfirstlane((int)tick[ui & 1]); if (it >= 1024) break;
        const int qb = 7 - (it >> 7), bh = it & 127;
        const int b = bh >> 3, h = bh & 7; const size_t rowbase = (size_t)b * SEQ; const int q0 = qb * 256, qrel = wid * 32 + r32, tq = q0 + qrel;
        const float sl2 = exp2f(-(float)(h + 1)) * LOG2E;
        bf16x8 qr[4];
        { const GAS bf16* Qw = (const GAS bf16*)(F.QN + (rowbase + q0 + wid * 32 + r32) * 512 + h * 64 + hi * 8);
#pragma unroll
            for (int d0 = 0; d0 < 4; ++d0) qr[d0] = *(const GAS bf16x8*)(Qw + d0 * 16); }
        LAS unsigned char* qlds = (LAS unsigned char*)ost + lane * 16;
        if (tid < qb * 64) { const GAS float* kp = (const GAS float*)(F.KPART + ((size_t)b * 8 + (tid >> 6)) * 1024 + h * 64 + (tid & 63)); km[tid] = (kp[0] + kp[512]) * (1.0f / 256.0f); }
        const unsigned koff = (unsigned)(((rowbase + lane) * 512 + h * 64 + wid * 8) * 2);
        unsigned voff; { const int vr = 8 * wid + (lane >> 3), sl = lane & 7; const int ch = ((((sl >> 2) ^ ((vr >> 1) & 1)) << 2) | (sl & 3)); voff = (unsigned)((((size_t)MTOK + rowbase + vr) * 512 + h * 64 + ch * 8) * 2); }
        const unsigned lds0 = (unsigned)(uintptr_t)L;
#define MOBA_ISSUE(t_, bufi) do { moba_glds(koff, (const void*)((const char*)F.KN + (size_t)(t_) * 65536), (unsigned)__builtin_amdgcn_readfirstlane((int)(lds0 + L_K + (bufi) * 8192 + wid * 1024))); \
            moba_glds(voff, (const void*)((const char*)F.KN + (size_t)(t_) * 65536), (unsigned)__builtin_amdgcn_readfirstlane((int)(lds0 + L_V + (bufi) * 8192 + wid * 1024))); } while (0)
        const int NT = 4 * (qb + 1);
        int t0 = 0; { const float dstar = (151.0f + 2.0f * smax2) / sl2; const float x = ((float)(q0 - 63) - dstar) * (1.0f / 64.0f); if (x > 0.f) t0 = ((int)x) & ~1; if (t0 > NT - 4) t0 = NT - 4; t0 = __builtin_amdgcn_readfirstlane(t0); }
        unsigned nticket = 0u; if (tid == 0) nticket = __hip_atomic_fetch_add(qctr, 1u, RLX_AGENT);
        MOBA_ISSUE(t0, 0); MOBA_ISSUE(t0 + 1, 1); MOBA_ISSUE(t0 + 2, 2);
        __syncthreads();
        unsigned selmask = 0;
        { float gt[7];
#pragma unroll
            for (int j = 0; j < 7; ++j) { float s = 0.f;
                if (j < qb) {
#pragma unroll
                    for (int d0 = 0; d0 < 4; ++d0)
#pragma unroll
                        for (int e = 0; e < 8; ++e) s += bf2f((unsigned short)qr[d0][e]) * km[j * 64 + d0 * 16 + hi * 8 + e];
                    auto rr = __builtin_amdgcn_permlane32_swap(__float_as_uint(s), __float_as_uint(s), false, false);
                    s = __uint_as_float(rr[0]) + __uint_as_float(rr[1]); }
                gt[j] = s; }
#pragma unroll
            for (int j = 0; j < 7; ++j) { int rank = 0;
#pragma unroll
                for (int i = 0; i < 7; ++i) if (i != j && i < qb) rank += (gt[i] > gt[j] || (gt[i] == gt[j] && i < j)) ? 1 : 0;
                if (j < qb && rank < 3) selmask |= 1u << j; } }
#pragma unroll
        for (int d0 = 0; d0 < 4; ++d0) *(LAS bf16x8*)(qlds + d0 * 1024) = qr[d0];
        float mhat = mhat0, l_reg = 0.f; f32x16 o[2]; o[0] = f32x16{}; o[1] = f32x16{};
        const int kbase = L_K + hi * 1024 + r32 * 16;
        const int g16 = lane >> 4, i16 = lane & 15, tq4 = i16 >> 2, tp4 = i16 & 3;
        const int vrow0 = 4 * hi + tq4;
        if (tid == 0) tick[(ui + 1) & 1] = nticket;
        asm volatile("s_waitcnt vmcnt(2)" ::: "memory");
        __syncthreads();
#define MOBA_KLOAD(KOFF) do { _Pragma("unroll") for (int d0 = 0; d0 < 4; ++d0) qf_[d0] = *(const LAS bf16x8*)(qlds + d0 * 1024); \
            _Pragma("unroll") for (int d0 = 0; d0 < 4; ++d0) { \
            kfr[2 * d0] = *(const LAS bf16x8*)(L + (KOFF) + kbase + d0 * 2048); kfr[2 * d0 + 1] = *(const LAS bf16x8*)(L + (KOFF) + kbase + d0 * 2048 + 512); } } while (0)
#define MOBA_VLOAD(VOFF) do { _Pragma("unroll") for (int dblk = 0; dblk < 2; ++dblk) _Pragma("unroll") for (int ks = 0; ks < 4; ++ks) { \
            const int rlo = 16 * ks + vrow0, rhi = rlo + 8; \
            vlo[dblk * 4 + ks] = vtr(L + L_V + (VOFF) + rlo * 128 + ((dblk ^ ((rlo >> 1) & 1)) * 64) + (16 * (g16 & 1) + 4 * tp4) * 2); \
            vhi[dblk * 4 + ks] = vtr(L + L_V + (VOFF) + rhi * 128 + ((dblk ^ ((rhi >> 1) & 1)) * 64) + (16 * (g16 & 1) + 4 * tp4) * 2); } } while (0)
#define MOBA_QK(TT, P0, P1) do { \
            const int blk_ = (TT) >> 2; const bool own_ = (blk_ == qb); \
            if (!(own_ && (64 * ((TT) & 3) > 32 * wid + 31))) { \
                const bool sel_ = own_ || ((selmask >> blk_) & 1u); \
                const float sc0_ = sel_ ? (-mhat - sl2 * (float)(tq - 64 * (TT) - 4 * hi)) : NEG_BIG; \
_Pragma("unroll") \
                for (int r = 0; r < 16; ++r) { P0[r] = __builtin_fmaf(sl2, (float)((r & 3) + 8 * (r >> 2)), sc0_); P1[r] = __builtin_fmaf(sl2, (float)(32 + (r & 3) + 8 * (r >> 2)), sc0_); } \
_Pragma("unroll") \
                for (int d0 = 0; d0 < 4; ++d0) { \
                    P0 = __builtin_amdgcn_mfma_f32_32x32x16_bf16(kfr[2 * d0], qf_[d0], P0, 0, 0, 0); \
                    P1 = __builtin_amdgcn_mfma_f32_32x32x16_bf16(kfr[2 * d0 + 1], qf_[d0], P1, 0, 0, 0); } \
            } } while (0)
#define MOBA_SMPV(TT, P0, P1, HAVE_NEXT, N0, N1) do { \
            const int blk = (TT) >> 2; const bool own = (blk == qb); const int jb = (TT) & 3; \
            if (!(own && (64 * jb > 32 * wid + 31))) { \
                if (own && (64 * jb + 63 > 32 * wid)) { \
_Pragma("unroll") \
                    for (int r = 0; r < 16; ++r) { const int kvl = 64 * jb + crow(r, hi); if (kvl > qrel) P0[r] = NEG_BIG; if (kvl + 32 > qrel) P1[r] = NEG_BIG; } } \
                float rm = max3f(P0[0], P1[0], P0[1]), rm2 = max3f(P1[1], P0[2], P1[2]); \
_Pragma("unroll") \
                for (int r = 3; r < 15; r += 2) { rm = max3f(rm, P0[r], P1[r]); rm2 = max3f(rm2, P0[r + 1], P1[r + 1]); } \
                rm = max3f(rm, rm2, fmaxf(P0[15], P1[15])); \
                { auto rr = __builtin_amdgcn_permlane32_swap(__float_as_uint(rm), __float_as_uint(rm), false, false); rm = fmaxf(__uint_as_float(rr[0]), __uint_as_float(rr[1])); } \
                if (__any(rm > THR)) { \
                    const float dl = fmaxf(rm, 0.f); mhat += dl; \
_Pragma("unroll") \
                    for (int r = 0; r < 16; ++r) { P0[r] -= dl; P1[r] -= dl; } \
                    if (HAVE_NEXT) { \
_Pragma("unroll") \
                        for (int r = 0; r < 16; ++r) { N0[r] -= dl; N1[r] -= dl; } } \
                    const float f = __builtin_amdgcn_exp2f(-dl); l_reg *= f; \
                    if (hi == 0) wsf[r32] = f; \
_Pragma("unroll") \
                    for (int r = 0; r < 16; ++r) { const float fr = wsf[crow(r, hi)]; o[0][r] *= fr; o[1][r] *= fr; } } \
                float sacc = 0.f, sacc2 = 0.f; \
_Pragma("unroll") \
                for (int r = 0; r < 16; ++r) { P0[r] = __builtin_amdgcn_exp2f(P0[r]); P1[r] = __builtin_amdgcn_exp2f(P1[r]); sacc += P0[r]; sacc2 += P1[r]; } \
                l_reg += sacc + sacc2; \
                bf16x8 pa[4]; \
                { v4u w; \
_Pragma("unroll") \
                    for (int ks = 0; ks < 4; ++ks) { \
_Pragma("unroll") \
                        for (int e = 0; e < 4; ++e) { const int rb = (ks & 1) * 8 + 2 * e; w[e] = (ks < 2) ? cvtpk(P0[rb], P0[rb + 1]) : cvtpk(P1[rb], P1[rb + 1]); } \
                        pa[ks] = __builtin_bit_cast(bf16x8, w); } } \
_Pragma("unroll") \
                for (int dblk = 0; dblk < 2; ++dblk) \
_Pragma("unroll") \
                    for (int ks = 0; ks < 4; ++ks) { \
                        const s16x4 lo = vlo[dblk * 4 + ks], hh = vhi[dblk * 4 + ks]; \
                        const bf16x8 vf = (bf16x8){lo[0], lo[1], lo[2], lo[3], hh[0], hh[1], hh[2], hh[3]}; \
                        o[dblk] = __builtin_amdgcn_mfma_f32_32x32x16_bf16(pa[ks], vf, o[dblk], 0, 0, 0); } \
            } } while (0)
        f32x16 pA0, pA1, pB0, pB1; bf16x8 kfr[8], qf_[4]; s16x4 vlo[8], vhi[8];
        MOBA_KLOAD(0); MOBA_QK(t0, pA0, pA1);
        int c0o = 0;
        for (int t = t0; t < NT; t += 2) {
            const int c1o = (c0o + 1) & 3, c2o = (c0o + 2) & 3, c3o = (c0o + 3) & 3;
            if (t + 3 < NT) MOBA_ISSUE(t + 3, c3o);
            MOBA_KLOAD(c1o * 8192); __builtin_amdgcn_sched_barrier(0);
            MOBA_QK(t + 1, pB0, pB1); __builtin_amdgcn_sched_barrier(0);
            MOBA_VLOAD(c0o * 8192); __builtin_amdgcn_sched_barrier(0);
            MOBA_SMPV(t, pA0, pA1, true, pB0, pB1);
            if (t + 3 < NT) asm volatile("s_waitcnt vmcnt(2)" ::: "memory"); else asm volatile("s_waitcnt vmcnt(0)" ::: "memory");
            __syncthreads();
            if (t + 4 < NT) MOBA_ISSUE(t + 4, c0o);
            if (t + 2 < NT) { MOBA_KLOAD(c2o * 8192); __builtin_amdgcn_sched_barrier(0); MOBA_QK(t + 2, pA0, pA1); __builtin_amdgcn_sched_barrier(0); }
            MOBA_VLOAD(c1o * 8192); __builtin_amdgcn_sched_barrier(0);
            MOBA_SMPV(t + 1, pB0, pB1, (t + 2 < NT), pA0, pA1);
            if (t + 4 < NT) asm volatile("s_waitcnt vmcnt(2)" ::: "memory"); else asm volatile("s_waitcnt vmcnt(0)" ::: "memory");
            __syncthreads();
            c0o = c2o;
        }
#undef MOBA_ISSUE
#undef MOBA_KLOAD
#undef MOBA_VLOAD
#undef MOBA_QK
#undef MOBA_SMPV
        v4u gwv[4];
#pragma unroll
        for (int i = 0; i < 4; ++i) gwv[i] = *(const GAS v4u*)(F.GA + (rowbase + q0 + wid * 32 + i * 8 + (lane >> 3)) * 512 + h * 64 + (lane & 7) * 8);
        { auto rr = __builtin_amdgcn_permlane32_swap(__float_as_uint(l_reg), __float_as_uint(l_reg), false, false); l_reg = __uint_as_float(rr[0]) + __uint_as_float(rr[1]); }
        if (hi == 0) wsf[r32] = 1.0f / l_reg;
#pragma unroll
        for (int r = 0; r < 16; ++r) { const float rl = wsf[crow(r, hi)]; ost[crow(r, hi) * 64 + r32] = o[0][r] * rl; ost[crow(r, hi) * 64 + 32 + r32] = o[1][r] * rl; }
#pragma unroll
        for (int i = 0; i < 4; ++i) { const int row = i * 8 + (lane >> 3), ch = lane & 7;
            const f32x4 a = *(const LAS f32x4*)(ost + row * 64 + ch * 8), c2 = *(const LAS f32x4*)(ost + row * 64 + ch * 8 + 4);
            const size_t grow = rowbase + q0 + wid * 32 + row;
            const v4u gw = gwv[i];
            v4u ow; ow.x = pk2(a[0] * bflo(gw.x), a[1] * bfhi(gw.x)); ow.y = pk2(a[2] * bflo(gw.y), a[3] * bfhi(gw.y));
            ow.z = pk2(c2[0] * bflo(gw.z), c2[1] * bfhi(gw.z)); ow.w = pk2(c2[2] * bflo(gw.w), c2[3] * bfhi(gw.w));
            *(GAS v4u*)(F.MIXED + grow * DM + 512 + h * 64 + ch * 8) = ow; }
    }
    __syncthreads();
}


namespace hg {
typedef short bf16x8 __attribute__((ext_vector_type(8)));
typedef short s16x4 __attribute__((ext_vector_type(4)));
typedef float f32x4 __attribute__((ext_vector_type(4)));
typedef unsigned u32x2 __attribute__((ext_vector_type(2)));
constexpr int SLOT = 33792, NSLOT = 4;
constexpr int L_SC = NSLOT * SLOT, L_NRM = L_SC + 4096;
constexpr int NSTEP = SEQ / 32;
__device__ __forceinline__ int fsw(int t) { return ((t & 7) << 2) | (((t >> 3) & 1) << 1); }
__device__ __forceinline__ int unit_off(int tok, int cg) { return 8 * (32 * tok + (cg ^ fsw(tok))); }
__device__ __forceinline__ s16x4 rd64(const LAS unsigned char* p) { return *(const LAS s16x4*)p; }
__device__ __forceinline__ s16x4 vtr(const LAS unsigned char* p) { return __builtin_bit_cast(s16x4, __builtin_amdgcn_ds_read_tr16_b64_v4i16((LAS s16x4*)p)); }
__device__ __forceinline__ bf16x8 cat(s16x4 a, s16x4 b) { return (bf16x8){a[0], a[1], a[2], a[3], b[0], b[1], b[2], b[3]}; }
__device__ __forceinline__ s16x4 pack4(f32x4 v) { u32x2 w; w.x = moba::cvtpk(v[0], v[1]); w.y = moba::cvtpk(v[2], v[3]); return __builtin_bit_cast(s16x4, w); }
__device__ __forceinline__ void glds16(const GAS void* gsrc, unsigned lds_dst) { unsigned keep;
    asm volatile("s_mov_b32 %0, m0\n\ts_mov_b32 m0, %2\n\ts_nop 0\n\tglobal_load_lds_dwordx4 %1, off\n\ts_mov_b32 m0, %0" : "=&s"(keep) : "v"(gsrc), "s"(lds_dst) : "memory"); }
__device__ __forceinline__ void glds16s(unsigned voff, const void* sbase, unsigned lds_dst) { unsigned keep;
    asm volatile("s_mov_b32 %0, m0\n\ts_mov_b32 m0, %3\n\ts_nop 0\n\tglobal_load_lds_dwordx4 %1, %2\n\ts_mov_b32 m0, %0" : "=&s"(keep) : "v"(voff), "s"(sbase), "s"(lds_dst) : "memory"); }
#define HG_MFMA(a, b, c) __builtin_amdgcn_mfma_f32_16x16x32_bf16((a), (b), (c), 0, 0, 0)
}

__device__ __forceinline__ void hgrn_mfma_phase(Frame& F, int l) {
    using namespace hg;
    PHASE_IDS();
    const int w = wave, c16 = lane & 15, g = lane >> 4;
    LAS unsigned char* L = F.lds + RING_OFF;
    const s16x4 z4 = (s16x4){0, 0, 0, 0};
    for (int it = (int)blockIdx.x; it < 64; it += F.G) {
        const int b = it >> 2, h = it & 3; const size_t rowbase = (size_t)b * SEQ;
        const int da = w >> 1;
        unsigned dsrc[4];
#pragma unroll
        for (int i = 0; i < 4; ++i) { const int t = 16 * (w & 1) + 4 * i + (lane >> 4); const int sc = (lane & 15) ^ (fsw(t) >> 1);
            dsrc[i] = (unsigned)((((size_t)da * MTOK + rowbase + t) * 512 + h * 128 + 8 * sc) * 2); }
        const unsigned ddec = (unsigned)((((size_t)b * NSTEP) * 512 + h * 128 + 4 * lane) * 4);
        const int ddst = da * 8192 + (w & 1) * 4096;
        const unsigned lds0 = (unsigned)(uintptr_t)(F.lds + RING_OFF);
#define HG_ISSUE(step) do { const unsigned so_ = lds0 + (unsigned)(((step) & 3) * SLOT); \
            _Pragma("unroll") for (int i = 0; i < 4; ++i) \
                glds16s(dsrc[i], (const void*)((const char*)F.QI + (size_t)(step) * (32 * 512 * 2)), (unsigned)__builtin_amdgcn_readfirstlane((int)(so_ + ddst + i * 1024))); \
            if (w == 0) glds16s(ddec, (const void*)((const char*)F.DEC + (size_t)(step) * 2048), (unsigned)__builtin_amdgcn_readfirstlane((int)(so_ + 32768))); } while (0)
        f32x4 S[8]; bf16x8 Sb[4];
#pragma unroll
        for (int tk = 0; tk < 8; ++tk) S[tk] = (f32x4){0.f, 0.f, 0.f, 0.f};
#pragma unroll
        for (int ks = 0; ks < 4; ++ks) Sb[ks] = (bf16x8){0, 0, 0, 0, 0, 0, 0, 0};
        f32x4 oprev[2]; oprev[0] = (f32x4){0.f, 0.f, 0.f, 0.f}; oprev[1] = oprev[0];
        u32x2 gprev[2]; gprev[0] = (u32x2){0u, 0u}; gprev[1] = gprev[0];
        float hw[4];
#pragma unroll
        for (int r = 0; r < 4; ++r) hw[r] = F.hg_norm_w[l * 128 + 16 * w + 4 * g + r];
        asm volatile("" : "+v"(hw[0]), "+v"(hw[1]), "+v"(hw[2]), "+v"(hw[3]));
        LAS float* nrm = (LAS float*)(L + L_NRM);
        LAS unsigned char* SC = L + L_SC;
        HG_ISSUE(0); HG_ISSUE(1); HG_ISSUE(2);
        asm volatile("s_waitcnt vmcnt(8)\n\ts_barrier" ::: "memory");
        const int trq = c16 >> 2, trp = c16 & 3;
        int ro0 = 256 * c16 + 16 * (g ^ (fsw(c16) >> 1)), ko0 = 256 * (4 * g + trq) + 16 * (trp ^ (fsw(4 * g + trq) >> 1));
#define RO(ks) (ro0 ^ (64 * (ks)))
#define KO(tk) (ko0 ^ (64 * ((tk) >> 1) + 8 * ((tk) & 1)))
        const int io_ = unit_off(4 * g + trq, 4 * w + trp), go_ = unit_off(c16, 4 * w + g);
        bf16x8 qf[2][4];
#define HG_LOADQ(slotbase) do { _Pragma("unroll") for (int tt = 0; tt < 2; ++tt) _Pragma("unroll") for (int ks = 0; ks < 4; ++ks) \
            qf[tt][ks] = *(const LAS bf16x8*)((slotbase) + RO(ks) + 4096 * tt); } while (0)
#define HG_FINAL(step, P) do { _Pragma("unroll") for (int tt = 0; tt < 2; ++tt) { \
            const float ssum = ((P[tt][0] + P[tt][1]) + (P[tt][2] + P[tt][3])) + ((P[tt][4] + P[tt][5]) + (P[tt][6] + P[tt][7])); \
            const float rstd = __builtin_amdgcn_rsqf(ssum * (1.0f / 128.0f) + NORM_EPS); \
            u32x2 wv; wv.x = moba::cvtpk(oprev[tt][0] * rstd * hw[0] * bflo(gprev[tt].x), oprev[tt][1] * rstd * hw[1] * bfhi(gprev[tt].x)); \
            wv.y = moba::cvtpk(oprev[tt][2] * rstd * hw[2] * bflo(gprev[tt].y), oprev[tt][3] * rstd * hw[3] * bfhi(gprev[tt].y)); \
            *(GAS u32x2*)(F.MIXED + (rowbase + (size_t)(step) * 32 + 16 * tt + c16) * DM + h * 128 + 16 * w + 4 * g) = wv; } } while (0)
        HG_LOADQ(L);
        for (int n = 0; n < NSTEP; ++n) {
            asm volatile("" : "+v"(ro0), "+v"(ko0));
            if (n + 3 < NSTEP) HG_ISSUE(n + 3);
            const LAS unsigned char* Qs = L + (n & 3) * SLOT; const LAS unsigned char* Ks = Qs + 8192; const LAS unsigned char* Is = Qs + 16384; const LAS unsigned char* Gs = Qs + 24576;
            const LAS float* Ds = (const LAS float*)(Qs + 32768);
            LAS unsigned char* SCn = SC + (n & 1) * 1536;
            bf16x8 kf[4];
            if (w < 3) { const int st = (w == 2) ? 1 : 0;
#pragma unroll
                for (int ks = 0; ks < 4; ++ks) kf[ks] = *(const LAS bf16x8*)(Ks + RO(ks) + 4096 * st); }
            u32x2 gcur[2];
#pragma unroll
            for (int tt = 0; tt < 2; ++tt) gcur[tt] = *(const LAS u32x2*)(Gs + go_ + 4096 * tt);
            s16x4 itr[2];
#pragma unroll
            for (int st = 0; st < 2; ++st) itr[st] = vtr(Is + io_ + 4096 * st);
            const bf16x8 i01 = cat(itr[0], itr[1]);
            bf16x8 k01[4]; f32x4 dv4[4];
#pragma unroll
            for (int tk = 0; tk < 4; ++tk) { k01[tk] = cat(vtr(Ks + KO(tk)), vtr(Ks + KO(tk) + 4096)); dv4[tk] = *(const LAS f32x4*)(Ds + 16 * tk + 4 * g); }
            f32x4 o[2];
#pragma unroll
            for (int tt = 0; tt < 2; ++tt) { f32x4 a = (f32x4){0.f, 0.f, 0.f, 0.f};
#pragma unroll
                for (int ks = 0; ks < 4; ++ks) a = HG_MFMA(Sb[ks], qf[tt][ks], a);
                o[tt] = a; }
            if (w < 3) { f32x4 sc = (f32x4){0.f, 0.f, 0.f, 0.f};
                if (w == 0) {
#pragma unroll
                    for (int ks = 0; ks < 4; ++ks) sc = HG_MFMA(kf[ks], qf[0][ks], sc);
                } else {
#pragma unroll
                    for (int ks = 0; ks < 4; ++ks) sc = HG_MFMA(kf[ks], qf[1][ks], sc); }
                if (w != 1) {
#pragma unroll
                    for (int r = 0; r < 4; ++r) if (4 * g + r > c16) sc[r] = 0.f; }
                *(LAS s16x4*)(SCn + w * 512 + lane * 8) = pack4(sc); }
#pragma unroll
            for (int tk = 0; tk < 4; ++tk) S[tk] = HG_MFMA(k01[tk], i01, S[tk]);
            asm volatile("" ::: "memory");
            { bf16x8 k2[4]; f32x4 d2[4];
#pragma unroll
                for (int tk = 0; tk < 4; ++tk) { k2[tk] = cat(vtr(Ks + KO(tk + 4)), vtr(Ks + KO(tk + 4) + 4096)); d2[tk] = *(const LAS f32x4*)(Ds + 16 * (tk + 4) + 4 * g); }
#pragma unroll
                for (int tk = 0; tk < 4; ++tk) S[tk] = S[tk] * dv4[tk];
#pragma unroll
                for (int ks = 0; ks < 2; ++ks) Sb[ks] = cat(pack4(S[2 * ks]), pack4(S[2 * ks + 1]));
#pragma unroll
                for (int tk = 0; tk < 4; ++tk) S[tk + 4] = HG_MFMA(k2[tk], i01, S[tk + 4]);
#pragma unroll
                for (int tk = 0; tk < 4; ++tk) S[tk + 4] = S[tk + 4] * d2[tk];
#pragma unroll
                for (int ks = 2; ks < 4; ++ks) Sb[ks] = cat(pack4(S[2 * ks]), pack4(S[2 * ks + 1])); }
            if (n >= NSTEP - 3) asm volatile("s_waitcnt vmcnt(0) lgkmcnt(0)\n\ts_barrier" ::: "memory");
            else if (n <= 1) asm volatile("s_waitcnt vmcnt(8) lgkmcnt(0)\n\ts_barrier" ::: "memory");
            else if (n == 2) asm volatile("s_waitcnt vmcnt(10) lgkmcnt(0)\n\ts_barrier" ::: "memory");
            else asm volatile("s_waitcnt vmcnt(12) lgkmcnt(0)\n\ts_barrier" ::: "memory");
            const s16x4 sc00 = rd64(SCn + lane * 8), sc01 = rd64(SCn + 512 + lane * 8), sc11 = rd64(SCn + 1024 + lane * 8);
            float pn[2][8];
            if (n > 0) {
#pragma unroll
                for (int tt = 0; tt < 2; ++tt)
#pragma unroll
                    for (int ww = 0; ww < 8; ++ww) pn[tt][ww] = nrm[((n - 1) & 1) * 256 + ww * 32 + 16 * tt + c16]; }
            if (n + 1 < NSTEP) HG_LOADQ(L + ((n + 1) & 3) * SLOT);
            o[0] = HG_MFMA(cat(itr[0], z4), cat(sc00, z4), o[0]);
            o[1] = HG_MFMA(i01, cat(sc01, sc11), o[1]);
            { float ss0 = (o[0][0] * o[0][0] + o[0][1] * o[0][1]) + (o[0][2] * o[0][2] + o[0][3] * o[0][3]);
              float ss1 = (o[1][0] * o[1][0] + o[1][1] * o[1][1]) + (o[1][2] * o[1][2] + o[1][3] * o[1][3]);
              { auto r0 = __builtin_amdgcn_permlane16_swap(__float_as_uint(ss0), __float_as_uint(ss0), false, false); auto r1 = __builtin_amdgcn_permlane16_swap(__float_as_uint(ss1), __float_as_uint(ss1), false, false);
                ss0 = __uint_as_float(r0[0]) + __uint_as_float(r0[1]); ss1 = __uint_as_float(r1[0]) + __uint_as_float(r1[1]); }
              { auto r0 = __builtin_amdgcn_permlane32_swap(__float_as_uint(ss0), __float_as_uint(ss0), false, false); auto r1 = __builtin_amdgcn_permlane32_swap(__float_as_uint(ss1), __float_as_uint(ss1), false, false);
                ss0 = __uint_as_float(r0[0]) + __uint_as_float(r0[1]); ss1 = __uint_as_float(r1[0]) + __uint_as_float(r1[1]); }
              if (g == 0) { nrm[(n & 1) * 256 + w * 32 + c16] = ss0; nrm[(n & 1) * 256 + w * 32 + 16 + c16] = ss1; } }
            if (n > 0) HG_FINAL(n - 1, pn);
            oprev[0] = o[0]; oprev[1] = o[1]; gprev[0] = gcur[0]; gprev[1] = gcur[1];
        }
        asm volatile("s_waitcnt vmcnt(0) lgkmcnt(0)\n\ts_barrier" ::: "memory");
        { float pn[2][8];
#pragma unroll
            for (int tt = 0; tt < 2; ++tt)
#pragma unroll
                for (int ww = 0; ww < 8; ++ww) pn[tt][ww] = nrm[((NSTEP - 1) & 1) * 256 + ww * 32 + 16 * tt + c16];
            HG_FINAL(NSTEP - 1, pn); }
        asm volatile("s_waitcnt vmcnt(0) lgkmcnt(0)\n\ts_barrier" ::: "memory");
#undef RO
#undef KO
#undef HG_LOADQ
#undef HG_FINAL
#undef HG_ISSUE
    }
}

struct Args { const float* in[8]; float* out; unsigned char* ws; int ph_lo, ph_hi, li, pad; };
__global__ void __launch_bounds__(NWAVES * 64, 2) fwd(Args args) {
    extern __shared__ __attribute__((aligned(16))) unsigned char lds[];
    Frame F;
    F.lds = (LAS unsigned char*)lds;
    F.MISC = (volatile LAS unsigned*)(F.lds + MISC_OFF);
    F.G = gridDim.x; { const int bx = blockIdx.x; F.vcu = (F.G % 8 == 0) ? (bx % 8) * (F.G / 8) + bx / 8 : bx; }
    unsigned char* ws = args.ws;
    F.ctl = (gu32*)(ws + WS_CTL);
    F.x = args.in[0]; F.norm_w = args.in[1]; F.w_in = args.in[2]; F.lb_logits = args.in[3]; F.hg_norm_w = args.in[4]; F.q_norm_w = args.in[5]; F.k_norm_w = args.in[6]; F.w_out = args.in[7];
    F.out = args.out;
    F.WIN = (bf16*)(ws + WS_WIN); F.WOUT = (bf16*)(ws + WS_WOUT); F.XB = (bf16*)(ws + WS_XB); F.MIXED = (bf16*)(ws + WS_MIXED);
    F.QI = (bf16*)(ws + WS_ARR); F.KT = (bf16*)(ws + WS_ARR + ARR_BYTES); F.HI = (bf16*)(ws + WS_ARR + 2 * ARR_BYTES); F.GH = (bf16*)(ws + WS_ARR + 3 * ARR_BYTES);
    F.QN = (bf16*)(ws + WS_ARR + 4 * ARR_BYTES); F.KN = (bf16*)(ws + WS_ARR + 5 * ARR_BYTES); F.V = (bf16*)(ws + WS_ARR + 6 * ARR_BYTES); F.GA = (bf16*)(ws + WS_ARR + 7 * ARR_BYTES);
    F.LB = (float*)(ws + WS_LB); F.KPART = (float*)(ws + WS_KPART); F.ROWSS = (float*)(ws + WS_ROWSS); F.DEC = (float*)(ws + WS_DEC);
    F.wave0 = __builtin_amdgcn_readfirstlane((int)threadIdx.x >> 6);
    for (int u = F.wave0 * 64 + lane_id_asm(); u < (LDS_BYTES - LDSCTL_OFF) / 4; u += NWAVES * 64) ((LAS unsigned*)(F.lds + LDSCTL_OFF))[u] = 0u;
    __syncthreads();
    XcdBarrier bar; bar.bar = (unsigned*)(F.ctl + CW_BAR); bar.x = 0; bar.st = nullptr; bar.wave0 = F.wave0;
    if (N_LAUNCHES == 1) bar = xcd_barrier_post((unsigned*)(F.ctl + CW_BAR), F.MISC + 8, F.wave0);
#define GRID_BAR() do { if (N_LAUNCHES == 1) xcd_barrier(bar); } while (0)
    const int lo = args.ph_lo, hi = args.ph_hi;
#define IN(k) (lo <= (k) && (k) < hi)
#define BOTH(k) (IN(k) && IN((k) + 1))

    if (IN(0)) { p0_prologue(F); if (BOTH(0)) GRID_BAR(); }
    for (int l = 0; l < DEPTH; ++l) {
        const int pb = 1 + 3 * l;
        if (IN(pb)) {
            pg8::Gemm g{F.XB + (size_t)l * MTOK * DM, F.WIN + (size_t)l * NIN * DM, MTOK, NIN, DM}; pg8::StaticOrder S; S.init(MTOK, NIN, F.G, (int)blockIdx.x);
            pg8::EpiFused E{F.QI, F.DEC, F.KPART, F.ROWSS + (size_t)l * MTOK * 16, F.LB + l * 512, F.q_norm_w + l * 64, F.k_norm_w + l * 64};
            for (int rp = 0; rp < REP_PROJ; ++rp) { if (rp) GRID_BAR(); pg8::gemm_phase<pg8::EpiFused, pg8::StaticOrder, true, true>(F.lds + RING_OFF, g, S, E, F.wave0); }
            if (BOTH(pb)) GRID_BAR();
        }
        if (IN(pb + 1)) {
            for (int rp = 0; rp < REP_HGRN; ++rp) { if (rp) GRID_BAR(); hgrn_mfma_phase(F, l); }
            for (int rp = 0; rp < REP_MOBA; ++rp) { if (rp) { GRID_BAR(); if (blockIdx.x == 0 && F.wave0 == 0 && lane_id_asm() == 0) __hip_atomic_store(F.ctl + CW_QUEUE + 64 * l, 0u, RLX_AGENT); GRID_BAR(); } moba_mfma_phase(F, l); }
            if (BOTH(pb + 1)) GRID_BAR(); }
        if (IN(pb + 2)) {
            pg8::Gemm g{F.MIXED, F.WOUT + (size_t)l * DM * DM, MTOK, DM, DM}; pg8::StaticOrder S; S.init(MTOK, DM, F.G, (int)blockIdx.x);
            pg8::EpiOut E{l == 0 ? F.x : nullptr, F.XB + (size_t)MTOK * DM, l == 0 ? nullptr : F.out, l == 0 ? F.XB + (size_t)MTOK * DM : nullptr, l == 0 ? F.ROWSS + (size_t)MTOK * 16 : nullptr};
            for (int rp = 0; rp < REP_OUT; ++rp) { if (rp) GRID_BAR(); pg8::gemm_phase<pg8::EpiOut, pg8::StaticOrder, true, true>(F.lds + RING_OFF, g, S, E, F.wave0); }
            if (pb + 2 < N_PHASES - 1 && BOTH(pb + 2)) GRID_BAR();
        }
    }
#undef IN
#undef BOTH
}

extern "C" void kernel_launch(void* const* d_in, const int* in_sizes, int n_in, void* d_out, int out_size, void* d_ws, size_t ws_size, hipStream_t stream) {
    static int grid = 0;
    if (grid == 0) {
        if (n_in != 8 || in_sizes[0] != MTOK * DM || out_size != MTOK * DM || ws_size < WS_END) { fprintf(stderr, "kernel_launch: unexpected shapes n_in %d in0 %d out %d ws %zu\n", n_in, n_in > 0 ? in_sizes[0] : -1, out_size, ws_size); grid = -1; return; }
        int dev = 0, cus = 0, per_cu = 0;
        if (hipGetDevice(&dev) != hipSuccess || hipDeviceGetAttribute(&cus, hipDeviceAttributeMultiprocessorCount, dev) != hipSuccess) { grid = -1; return; }
        if (hipFuncSetAttribute((const void*)fwd, hipFuncAttributeMaxDynamicSharedMemorySize, LDS_BYTES) != hipSuccess) { fprintf(stderr, "kernel_launch: hipFuncSetAttribute failed\n"); grid = -1; return; }
        if (hipOccupancyMaxActiveBlocksPerMultiprocessor(&per_cu, (const void*)fwd, NWAVES * 64, LDS_BYTES) != hipSuccess || per_cu < 1) fprintf(stderr, "kernel_launch: occupancy query says %d\n", per_cu);
        (void)hipGetLastError();
        if (per_cu < 1) { grid = -1; return; }
        grid = cus;
    }
    if (grid < 0) return;
    if (hipMemsetAsync((char*)d_ws + WS_CTL, 0, CTL_ZERO_BYTES, stream) != hipSuccess) return;
    Args a{};
    for (int i = 0; i < 8; ++i) a.in[i] = (const float*)d_in[i];
    a.out = (float*)d_out; a.ws = (unsigned char*)d_ws;
    for (int li = 0; li < N_LAUNCHES; ++li) {
        a.ph_lo = (N_LAUNCHES == 1) ? 0 : li; a.ph_hi = (N_LAUNCHES == 1) ? N_PHASES : li + 1; a.li = li;
        hipError_t le;
        if (N_LAUNCHES == 1) { void* kargs[] = {(void*)&a}; le = hipLaunchCooperativeKernel((const void*)fwd, dim3(grid), dim3(NWAVES * 64), kargs, LDS_BYTES, stream); }
        else { hipLaunchKernelGGL(fwd, dim3(grid), dim3(NWAVES * 64), LDS_BYTES, stream, a); le = hipPeekAtLastError(); }
        if (le != hipSuccess) { fprintf(stderr, "kernel_launch: launch %d failed: %s\n", li, hipGetErrorName(le)); break; }
    }
}
```

```cpp
#include <hip/hip_runtime.h>
#include <cstdio>
#include <cstdint>
__device__ __forceinline__ int lane_id_asm() { int l; asm volatile("v_mbcnt_lo_u32_b32 %0, -1, 0\n\tv_mbcnt_hi_u32_b32 %0, -1, %0" : "=v"(l)); return l; }
namespace pg8 {
#define PG8_LAS __attribute__((address_space(3)))
typedef unsigned short bf16_t;
typedef short bf16x8 __attribute__((ext_vector_type(8)));
typedef float f32x4 __attribute__((ext_vector_type(4)));
typedef unsigned u32x4 __attribute__((ext_vector_type(4)));
typedef unsigned u32x2 __attribute__((ext_vector_type(2)));
constexpr int BM = 256, BK = 64, HALF = 128, HTB = HALF * BK * 2  , STAGE_BYTES = 8 * HTB, NXCD = 8, WGM = 8;

__host__ __device__ __forceinline__ int lds_byte(int r, int c) { const int st = (r >> 4) * 2 + (c >> 5), rr = r & 15, cc = c & 31, ob = rr * 64 + cc * 2; return st * 1024 + (ob ^ (((ob >> 9) & 1) << 5)); }
__host__ __device__ __forceinline__ void stage_rc(int b, int& R, int& C) { const int st = b / 1024, sb = b % 1024, swz = sb ^ (((sb >> 9) & 1) << 5); R = (st >> 1) * 16 + swz / 64; C = (st & 1) * 32 + (swz % 64) / 2; }
__host__ __device__ __forceinline__ int perm32(int rho) { const int n = rho >> 4, i = rho & 15; return 8 * (i >> 2) + 4 * n + (i & 3); }

struct Unit { int pm, pn; };
struct Gemm { const bf16_t* A; const bf16_t* Bt; int M, N, K; };

struct StaticOrder {
    int nM, nN, nwg, G, c;
    __host__ __device__ void init(int M, int N, int G_, int c_) { nM = M / BM; nN = N / BM; nwg = nM * nN; G = G_; c = c_; }
    __host__ __device__ bool next(int i, Unit& u) const {
        const long L = (long)i * G + c; if (L >= nwg) return false;
        int wgid = (int)L; { const int q = nwg / NXCD, r = nwg % NXCD, xcd = wgid % NXCD, off = wgid / NXCD; wgid = (xcd < r ? xcd * (q + 1) : r * (q + 1) + (xcd - r) * q) + off; }
        const int nig = WGM * nN, gid = wgid / nig, fm = gid * WGM, gsz = (nM - fm) < WGM ? (nM - fm) : WGM;
        u.pm = fm + ((wgid % nig) % gsz); u.pn = (wgid % nig) / gsz; return true;
    }
    __device__ __forceinline__ void a_ready(const Unit&) const {}
    __device__ __forceinline__ void done(const Unit&) const {}
};

__device__ __forceinline__ unsigned cvt_pk_bf16(float lo, float hi) { unsigned r; asm volatile("v_cvt_pk_bf16_f32 %0, %1, %2" : "=v"(r) : "v"(lo), "v"(hi)); return r; }


__device__ __forceinline__ float dpp_row_shr(float v, int n) {
    const int x = __builtin_bit_cast(int, v);
    int r;
    if (n == 1) r = __builtin_amdgcn_update_dpp(0, x, 0x111, 0xf, 0xf, false);
    else if (n == 2) r = __builtin_amdgcn_update_dpp(0, x, 0x112, 0xf, 0xf, false);
    else if (n == 4) r = __builtin_amdgcn_update_dpp(0, x, 0x114, 0xf, 0xf, false);
    else r = __builtin_amdgcn_update_dpp(0, x, 0x118, 0xf, 0xf, false);
    return __builtin_bit_cast(float, r);
}
__device__ __forceinline__ float dpp_row_shr1(float v, int n) {
    const int x = __builtin_bit_cast(int, v); const int one = 0x3f800000;
    int r;
    if (n == 1) r = __builtin_amdgcn_update_dpp(one, x, 0x111, 0xf, 0xf, false);
    else if (n == 2) r = __builtin_amdgcn_update_dpp(one, x, 0x112, 0xf, 0xf, false);
    else if (n == 4) r = __builtin_amdgcn_update_dpp(one, x, 0x114, 0xf, 0xf, false);
    else r = __builtin_amdgcn_update_dpp(one, x, 0x118, 0xf, 0xf, false);
    return __builtin_bit_cast(float, r);
}
__device__ __forceinline__ float fsig(float z) { return __builtin_amdgcn_rcpf(1.0f + __expf(-z)); }
struct EpiFused {
    static constexpr bool PERM = true, AFTER_DRAIN = false;
    bf16_t* ARR; float* DEC; float* KPART; const float* rowss; const float* lb; const float* qg; const float* kg;
    static constexpr size_t AS = (size_t)32768 * 512;
    __device__ __forceinline__ float rstd_of(int row) const {
        const f32x4* rp = (const f32x4*)(rowss + (size_t)row * 16);
        const f32x4 a = rp[0], b = rp[1], c = rp[2], d = rp[3];
        const float ss = ((a[0] + a[1]) + (a[2] + a[3])) + ((b[0] + b[1]) + (b[2] + b[3])) + ((c[0] + c[1]) + (c[2] + c[3])) + ((d[0] + d[1]) + (d[2] + d[3]));
        return 1.0f / sqrtf(ss * (1.0f / 1024.0f) + 1e-6f);
    }
    static __device__ __forceinline__ u32x4 pack8(const float (&v)[8]) { u32x4 w; w.x = cvt_pk_bf16(v[0], v[1]); w.y = cvt_pk_bf16(v[2], v[3]); w.z = cvt_pk_bf16(v[4], v[5]); w.w = cvt_pk_bf16(v[6], v[7]); return w; }
    __device__ __forceinline__ void operator()(const f32x4 (&acc)[2][2][4][2], const Unit& u, int wr, int wc, int fr, int fq) const {
        const int row0 = u.pm * BM + wr * 64 + fr; const int pn = u.pn;
        if (pn < 4) {
            const int cb = pn * 128 + wc * 32 + 8 * fq;
            float lbv[8];
#pragma unroll
            for (int k = 0; k < 8; ++k) lbv[k] = lb[cb + k];
#pragma unroll
            for (int ai = 0; ai < 2; ++ai)
#pragma unroll
                for (int mp = 0; mp < 2; ++mp) { const int row1 = row0 + ai * HALF + mp * 32, row2 = row1 + 16; const float rs1 = rstd_of(row1), rs2 = rstd_of(row2);
                    float qi1[8], kt1[8], qi2[8], kt2[8], dc[8];
#pragma unroll
                    for (int k = 0; k < 8; ++k) {
                        const float zq1 = acc[ai][0][2 * mp][k >> 2][k & 3] * rs1, zf1 = acc[ai][1][2 * mp][k >> 2][k & 3] * rs1;
                        const float zq2 = acc[ai][0][2 * mp + 1][k >> 2][k & 3] * rs2, zf2 = acc[ai][1][2 * mp + 1][k >> 2][k & 3] * rs2;
                        const float f1 = lbv[k] + (1.0f - lbv[k]) * fsig(zf1), f2 = lbv[k] + (1.0f - lbv[k]) * fsig(zf2);
                        float e1 = f1, e2 = f2;
                        e1 *= dpp_row_shr1(e1, 1); e2 *= dpp_row_shr1(e2, 1); e1 *= dpp_row_shr1(e1, 2); e2 *= dpp_row_shr1(e2, 2);
                        e1 *= dpp_row_shr1(e1, 4); e2 *= dpp_row_shr1(e2, 4); e1 *= dpp_row_shr1(e1, 8); e2 *= dpp_row_shr1(e2, 8);
                        e2 *= __shfl(e1, (fq << 4) | 15);
                        qi1[k] = zq1 * fsig(zq1) * e1; kt1[k] = (1.0f - f1) * fminf(__builtin_amdgcn_rcpf(e1), 5.5406224e34f);
                        qi2[k] = zq2 * fsig(zq2) * e2; kt2[k] = (1.0f - f2) * fminf(__builtin_amdgcn_rcpf(e2), 5.5406224e34f); dc[k] = e2; }
                    { const int pc = pn * 128 + wc * 32 + 16 * (fq & 1) + 4 * (fq >> 1);
                      const u32x4 a1 = pack8(qi1), b1 = pack8(kt1), a2 = pack8(qi2), b2 = pack8(kt2);
                      bf16_t* q1 = ARR + (size_t)row1 * 512 + pc; bf16_t* q2 = ARR + (size_t)row2 * 512 + pc;
                      *(u32x2*)(q1) = (u32x2){a1.x, a1.y}; *(u32x2*)(q1 + 8) = (u32x2){a1.z, a1.w}; *(u32x2*)(q1 + AS) = (u32x2){b1.x, b1.y}; *(u32x2*)(q1 + AS + 8) = (u32x2){b1.z, b1.w};
                      *(u32x2*)(q2) = (u32x2){a2.x, a2.y}; *(u32x2*)(q2 + 8) = (u32x2){a2.z, a2.w}; *(u32x2*)(q2 + AS) = (u32x2){b2.x, b2.y}; *(u32x2*)(q2 + AS + 8) = (u32x2){b2.z, b2.w}; }
                    if (fr == 15) { float* dp = DEC + (size_t)(row1 >> 5) * 512 + cb; *(f32x4*)dp = (f32x4){dc[0], dc[1], dc[2], dc[3]}; *(f32x4*)(dp + 4) = (f32x4){dc[4], dc[5], dc[6], dc[7]}; }
                    asm volatile("" ::: "memory"); }
        } else if (pn < 8) {
            const int cb = (pn - 4) * 128 + wc * 32 + 8 * fq;
#pragma unroll
            for (int ai = 0; ai < 2; ++ai)
#pragma unroll
                for (int m = 0; m < 4; ++m) { const int row = row0 + ai * HALF + m * 16; const float rs = rstd_of(row);
                    float iv[8], gv[8];
#pragma unroll
                    for (int k = 0; k < 8; ++k) { iv[k] = acc[ai][0][m][k >> 2][k & 3] * rs; const float zg = acc[ai][1][m][k >> 2][k & 3] * rs; gv[k] = zg * fsig(zg); }
                    *(u32x4*)(ARR + 2 * AS + (size_t)row * 512 + cb) = pack8(iv); *(u32x4*)(ARR + 3 * AS + (size_t)row * 512 + cb) = pack8(gv);
                    asm volatile("" ::: "memory"); }
        } else {
            const int ty = (pn - 8) >> 1, head = 4 * ((pn - 8) & 1) + wc; const int d0 = 8 * fq;
            bf16_t* dst = ARR + (size_t)(4 + ty) * AS;
            float gain[2][8]; float csum[2][8];
#pragma unroll
            for (int bj = 0; bj < 2; ++bj)
#pragma unroll
                for (int k = 0; k < 8; ++k) { gain[bj][k] = (ty == 0) ? qg[bj * 32 + d0 + k] * (0.125f * 1.4426950408889634f) : (ty == 1) ? kg[bj * 32 + d0 + k] : 1.0f; csum[bj][k] = 0.f; }
#pragma unroll
            for (int ai = 0; ai < 2; ++ai)
#pragma unroll
                for (int m = 0; m < 4; ++m) { const int row = row0 + ai * HALF + m * 16; const float rs = rstd_of(row);
                    float v[2][8];
#pragma unroll
                    for (int bj = 0; bj < 2; ++bj)
#pragma unroll
                        for (int k = 0; k < 8; ++k) v[bj][k] = acc[ai][bj][m][k >> 2][k & 3] * rs;
                    if (ty < 2) { float ss = 0.f;
#pragma unroll
                        for (int bj = 0; bj < 2; ++bj)
#pragma unroll
                            for (int k = 0; k < 8; ++k) ss += v[bj][k] * v[bj][k];
                        ss += __shfl_xor(ss, 16); ss += __shfl_xor(ss, 32);
                        const float r2 = 1.0f / sqrtf(ss * (1.0f / 64.0f) + 1e-6f);
#pragma unroll
                        for (int bj = 0; bj < 2; ++bj)
#pragma unroll
                            for (int k = 0; k < 8; ++k) { v[bj][k] *= r2 * gain[bj][k]; csum[bj][k] += v[bj][k]; }
                    } else if (ty == 3) {
#pragma unroll
                        for (int bj = 0; bj < 2; ++bj)
#pragma unroll
                            for (int k = 0; k < 8; ++k) v[bj][k] = v[bj][k] * fsig(v[bj][k]); }
                    *(u32x4*)(dst + (size_t)row * 512 + head * 64 + d0) = pack8(v[0]); *(u32x4*)(dst + (size_t)row * 512 + head * 64 + 32 + d0) = pack8(v[1]);
                    asm volatile("" ::: "memory"); }
            if (ty == 1) {
#pragma unroll
                for (int bj = 0; bj < 2; ++bj)
#pragma unroll
                    for (int k = 0; k < 8; ++k) { float s = csum[bj][k]; s += __shfl_xor(s, 1); s += __shfl_xor(s, 2); s += __shfl_xor(s, 4); s += __shfl_xor(s, 8); csum[bj][k] = s; }
                if (fr == 0) { float* kp = KPART + ((size_t)u.pm * 2 + wr) * 512 + head * 64 + d0;
#pragma unroll
                    for (int bj = 0; bj < 2; ++bj) { *(f32x4*)(kp + bj * 32) = (f32x4){csum[bj][0], csum[bj][1], csum[bj][2], csum[bj][3]}; *(f32x4*)(kp + bj * 32 + 4) = (f32x4){csum[bj][4], csum[bj][5], csum[bj][6], csum[bj][7]}; } }
            }
        }
    }
};
struct EpiOut {
    static constexpr bool PERM = false, AFTER_DRAIN = false;
    const float* xres; const bf16_t* xres16; float* out; bf16_t* xb; float* rowss;
    __device__ __forceinline__ void operator()(const f32x4 (&acc)[2][2][4][2], const Unit& u, int wr, int wc, int fr, int fq) const {
        const int col0 = u.pn * BM + wc * 32 + 4 * fq;
#pragma unroll
        for (int ai = 0; ai < 2; ++ai)
#pragma unroll
            for (int m = 0; m < 4; ++m) {
                const int row = u.pm * BM + ai * HALF + wr * 64 + m * 16 + fr; float ss = 0.f;
#pragma unroll
                for (int bj = 0; bj < 2; ++bj)
#pragma unroll
                    for (int n = 0; n < 2; ++n) { const size_t off = (size_t)row * 1024 + col0 + bj * HALF + n * 16;
                        f32x4 v;
                        if (xres) v = *(const f32x4*)(xres + off); else { const u32x2 r = *(const u32x2*)(xres16 + off); v = (f32x4){__builtin_bit_cast(float, r.x << 16), __builtin_bit_cast(float, r.x & 0xffff0000u), __builtin_bit_cast(float, r.y << 16), __builtin_bit_cast(float, r.y & 0xffff0000u)}; }
                        v = v + acc[ai][bj][m][n];
                        if (out) *(f32x4*)(out + off) = v;
                        if (xb) { u32x2 w; w.x = cvt_pk_bf16(v[0], v[1]); w.y = cvt_pk_bf16(v[2], v[3]); *(u32x2*)(xb + off) = w; }
                        ss += (v[0] * v[0] + v[1] * v[1]) + (v[2] * v[2] + v[3] * v[3]); }
                ss += __shfl_xor(ss, 16); ss += __shfl_xor(ss, 32);
                if (fq == 0 && rowss) rowss[(size_t)row * 16 + u.pn * 4 + wc] = ss;
            }
    }
};

template <class Epi, class Sched, bool ALIGN_EPI = false, bool SP2 = false>
__device__ __forceinline__ void gemm_phase(PG8_LAS unsigned char* lds, const Gemm g, const Sched& S, const Epi& E, const int wave0) {
    int tid = wave0 * 64 + lane_id_asm(); asm volatile("" : "+v"(tid));
    const int wid = __builtin_amdgcn_readfirstlane(tid >> 6), lane = tid & 63, wr = wid >> 2, wc = wid & 3, fr = lane & 15, fq = lane >> 4;
    const int K = g.K, nt = K / BK;
    unsigned voffA[2], voffB[2];
#pragma unroll
    for (int i = 0; i < 2; ++i) { int R, C; stage_rc(tid * 16 + i * 8192, R, C); const int Rb = Epi::PERM ? ((R & ~31) + perm32(R & 31)) : R;
        voffA[i] = (unsigned)(R * K + C) * 2u; voffB[i] = (unsigned)(Rb * K + C) * 2u; }
    const size_t kstep = (size_t)(BK * 2);
    const size_t hstep = (size_t)HALF * K * 2;
    const size_t tstep = 2 * hstep;
    const unsigned ldsw = (unsigned)wid * 1024u;
    const int aoff = lds_byte(wr * 64 + fr, fq * 8), boff = lds_byte(wc * 32 + fr, fq * 8);
#define PG8_SA(b, h) (((b) * 2 + (h)) * HTB)
#define PG8_SB(b, h) ((4 + (b) * 2 + (h)) * HTB)
#define PG8_STAGE(bufoff, gbase, voff) do { _Pragma("unroll") for (int _i = 0; _i < 2; ++_i) \
        __builtin_amdgcn_global_load_lds((const unsigned*)((const char*)(gbase) + (voff)[_i]), (PG8_LAS unsigned*)(lds + (bufoff) + ldsw + _i * 8192), 16, 0, 0); } while (0)
#define PG8_LDA(dst, b, h) do { _Pragma("unroll") for (int m = 0; m < 4; ++m) _Pragma("unroll") for (int k = 0; k < 2; ++k) dst[m][k] = *(const PG8_LAS bf16x8*)(lds + PG8_SA(b, h) + aoff + m * 2048 + k * 1024); } while (0)
#define PG8_LDB(dst, b, h) do { _Pragma("unroll") for (int n = 0; n < 2; ++n) _Pragma("unroll") for (int k = 0; k < 2; ++k) dst[n][k] = *(const PG8_LAS bf16x8*)(lds + PG8_SB(b, h) + boff + n * 2048 + k * 1024); } while (0)
#define PG8_MMA(ai, bj, At, Bt) do { __builtin_amdgcn_s_setprio(1); _Pragma("unroll") for (int m = 0; m < 4; ++m) _Pragma("unroll") for (int n = 0; n < 2; ++n) _Pragma("unroll") for (int k = 0; k < 2; ++k) \
        acc[ai][bj][m][n] = __builtin_amdgcn_mfma_f32_16x16x32_bf16(Bt[n][k], At[m][k], acc[ai][bj][m][n], 0, 0, 0); __builtin_amdgcn_s_setprio(0); } while (0)
#define PG8_WAIT_V(n) asm volatile("s_waitcnt vmcnt(" #n ")" ::: "memory")
#define PG8_WAIT_L(n) asm volatile("s_waitcnt lgkmcnt(" #n ")" ::: "memory")
#define PG8_BAR __builtin_amdgcn_s_barrier()
#define PG8_SCHED __builtin_amdgcn_sched_barrier(0)
    Unit cur, nxt; int ui = 0;
    if (!S.next(0, cur)) return;
    f32x4 acc[2][2][4][2];
#pragma unroll
    for (int a = 0; a < 2; ++a)
#pragma unroll
        for (int b = 0; b < 2; ++b)
#pragma unroll
            for (int m = 0; m < 4; ++m)
#pragma unroll
                for (int n = 0; n < 2; ++n) acc[a][b][m][n] = (f32x4){0.f, 0.f, 0.f, 0.f};
    bf16x8 At[4][2], B0[2][2], B1[2][2];
    const char* cA = (const char*)g.A + (size_t)cur.pm * tstep; const char* cB = (const char*)g.Bt + (size_t)cur.pn * tstep;
    S.a_ready(cur);
    if constexpr (SP2) {
        PG8_STAGE(PG8_SB(0, 0), cB, voffB); PG8_STAGE(PG8_SB(0, 1), cB + hstep, voffB); PG8_STAGE(PG8_SA(0, 0), cA, voffA); PG8_STAGE(PG8_SA(0, 1), cA + hstep, voffA);
        if (wr == 1) PG8_BAR;
        PG8_WAIT_V(2); PG8_BAR;
        PG8_STAGE(PG8_SB(1, 0), cB + kstep, voffB); PG8_STAGE(PG8_SA(1, 0), cA + kstep, voffA); PG8_STAGE(PG8_SB(1, 1), cB + hstep + kstep, voffB);
        PG8_WAIT_V(6); PG8_BAR;
    } else {
        PG8_STAGE(PG8_SB(0, 0), cB, voffB); PG8_STAGE(PG8_SA(0, 0), cA, voffA); PG8_STAGE(PG8_SB(0, 1), cB + hstep, voffB); PG8_STAGE(PG8_SA(0, 1), cA + hstep, voffA);
        if (wr == 1) PG8_BAR;
        PG8_WAIT_V(4); PG8_BAR;
        PG8_STAGE(PG8_SB(1, 0), cB + kstep, voffB); PG8_STAGE(PG8_SA(1, 0), cA + kstep, voffA); PG8_STAGE(PG8_SB(1, 1), cB + hstep + kstep, voffB);
        PG8_WAIT_V(6); PG8_BAR;
    }
    for (;;) {
        const bool has_next = S.next(ui + 1, nxt);
        const char* nA = has_next ? (const char*)g.A + (size_t)nxt.pm * tstep : cA; const char* nB = has_next ? (const char*)g.Bt + (size_t)nxt.pn * tstep : cB;
        for (int t = 0; t < nt; t += 2) {
            const bool last = (t == nt - 2);
            const char* a1 = cA + (size_t)(t + 1) * kstep;
            const char* a2 = last ? nA : cA + (size_t)(t + 2) * kstep; const char* b2 = last ? nB : cB + (size_t)(t + 2) * kstep;
            const char* a3 = a2 + kstep; const char* b3 = b2 + kstep;
            if (last && has_next) S.a_ready(nxt);
            if constexpr (SP2) {
            PG8_LDB(B0, 0, 0); PG8_LDB(B1, 0, 1); PG8_SCHED; PG8_LDA(At, 0, 0); PG8_STAGE(PG8_SA(1, 1), a1 + hstep, voffA);
            PG8_WAIT_V(8); PG8_WAIT_L(0); PG8_BAR; PG8_MMA(0, 0, At, B0); PG8_MMA(0, 1, At, B1); PG8_BAR; PG8_SCHED;
            PG8_LDA(At, 0, 1); PG8_STAGE(PG8_SB(0, 0), b2, voffB); PG8_STAGE(PG8_SB(0, 1), b2 + hstep, voffB); PG8_STAGE(PG8_SA(0, 0), a2, voffA);
            PG8_WAIT_V(8); PG8_WAIT_L(0); PG8_BAR; PG8_MMA(1, 0, At, B0); PG8_MMA(1, 1, At, B1); PG8_BAR; PG8_SCHED;
            PG8_LDB(B0, 1, 0); PG8_LDB(B1, 1, 1); PG8_SCHED; PG8_LDA(At, 1, 0); PG8_STAGE(PG8_SA(0, 1), a2 + hstep, voffA);
            PG8_WAIT_V(8); PG8_WAIT_L(0); PG8_BAR; PG8_MMA(0, 0, At, B0); PG8_MMA(0, 1, At, B1); PG8_BAR; PG8_SCHED;
            PG8_LDA(At, 1, 1); PG8_STAGE(PG8_SB(1, 0), b3, voffB); PG8_STAGE(PG8_SB(1, 1), b3 + hstep, voffB); PG8_STAGE(PG8_SA(1, 0), a3, voffA);
            PG8_WAIT_V(8); PG8_WAIT_L(0); PG8_BAR; PG8_MMA(1, 0, At, B0); PG8_MMA(1, 1, At, B1); PG8_BAR; PG8_SCHED;
            } else {
            PG8_LDB(B0, 0, 0); PG8_SCHED; PG8_LDA(At, 0, 0); PG8_STAGE(PG8_SA(1, 1), a1 + hstep, voffA);
            PG8_WAIT_L(8); PG8_BAR; PG8_WAIT_L(0); PG8_MMA(0, 0, At, B0); PG8_BAR; PG8_SCHED;
            PG8_LDB(B1, 0, 1); PG8_STAGE(PG8_SB(0, 0), b2, voffB);
            PG8_BAR; PG8_WAIT_L(0); PG8_MMA(0, 1, At, B1); PG8_BAR;
            PG8_LDA(At, 0, 1); PG8_STAGE(PG8_SA(0, 0), a2, voffA);
            PG8_BAR; PG8_WAIT_L(0); PG8_MMA(1, 0, At, B0); PG8_BAR; PG8_SCHED;
            PG8_STAGE(PG8_SB(0, 1), b2 + hstep, voffB);
            PG8_WAIT_V(6); PG8_BAR; PG8_MMA(1, 1, At, B1); PG8_BAR;
            PG8_LDB(B0, 1, 0); PG8_SCHED; PG8_LDA(At, 1, 0); PG8_STAGE(PG8_SA(0, 1), a2 + hstep, voffA);
            PG8_WAIT_L(8); PG8_BAR; PG8_WAIT_L(0); PG8_MMA(0, 0, At, B0); PG8_BAR; PG8_SCHED;
            PG8_LDB(B1, 1, 1); PG8_STAGE(PG8_SB(1, 0), b3, voffB);
            PG8_BAR; PG8_WAIT_L(0); PG8_MMA(0, 1, At, B1); PG8_BAR;
            PG8_LDA(At, 1, 1); PG8_STAGE(PG8_SA(1, 0), a3, voffA);
            PG8_BAR; PG8_WAIT_L(0); PG8_MMA(1, 0, At, B0); PG8_BAR; PG8_SCHED;
            PG8_STAGE(PG8_SB(1, 1), b3 + hstep, voffB);
            PG8_WAIT_V(6); PG8_BAR; PG8_MMA(1, 1, At, B1); PG8_BAR;
            }
        }
        if constexpr (ALIGN_EPI) { if (wr == 0) PG8_BAR; }
        if constexpr (!Epi::AFTER_DRAIN) { E(acc, cur, wr, wc, fr, fq); S.done(cur); }
        if (!has_next) break;
#pragma unroll
        for (int a = 0; a < 2; ++a)
#pragma unroll
            for (int b = 0; b < 2; ++b)
#pragma unroll
                for (int m = 0; m < 4; ++m)
#pragma unroll
                    for (int n = 0; n < 2; ++n) acc[a][b][m][n] = (f32x4){0.f, 0.f, 0.f, 0.f};
        cur = nxt; cA = nA; cB = nB; ++ui;
        if constexpr (ALIGN_EPI) { if (wr == 1) PG8_BAR; }
    }
    PG8_WAIT_V(0);
    if constexpr (!ALIGN_EPI) { if (wr == 0) PG8_BAR; }
    PG8_BAR;
    if constexpr (Epi::AFTER_DRAIN) { E.fused(acc, cur, wr, wc, fr, fq, lds, wid, lane); S.done(cur); }
#undef PG8_SA
#undef PG8_SB
#undef PG8_STAGE
#undef PG8_LDA
#undef PG8_LDB
#undef PG8_MMA
#undef PG8_WAIT_V
#undef PG8_WAIT_L
#undef PG8_BAR
#undef PG8_SCHED
}
}


constexpr int NWAVES = 8;
#ifndef REP_PROJ
#define REP_PROJ 1
#endif
#ifndef REP_HGRN
#define REP_HGRN 1
#endif
#ifndef REP_MOBA
#define REP_MOBA 1
#endif
#ifndef REP_OUT
#define REP_OUT 1
#endif
#ifndef MK_N_LAUNCHES
#define MK_N_LAUNCHES 1
#endif
constexpr int N_PHASES = 7;
constexpr int N_LAUNCHES = MK_N_LAUNCHES;

constexpr int BATCH = 16, SEQ = 2048, DM = 1024, DEPTH = 2, MTOK = BATCH * SEQ, NIN = 4096;
constexpr int C_HQ = 0, C_HF = 512, C_HI = 1024, C_HG = 1536, C_AQ = 2048, C_AK = 2560, C_AV = 3072, C_AG = 3584;
constexpr float NORM_EPS = 1e-6f;

constexpr size_t MiB = 1u << 20;
constexpr size_t WS_CTL = 0, CTL_ZERO_BYTES = 1 * MiB;
constexpr size_t WS_WIN = 2 * MiB;
constexpr size_t WS_WOUT = 18 * MiB;
constexpr size_t WS_LB = 22 * MiB;
constexpr size_t WS_KPART = 22 * MiB + 65536;
constexpr size_t WS_ROWSS = 24 * MiB;
constexpr size_t WS_DEC = 28 * MiB;
constexpr size_t WS_XB = 32 * MiB;
constexpr size_t WS_MIXED = 160 * MiB;
constexpr size_t WS_ARR = 224 * MiB;
constexpr size_t ARR_BYTES = 32 * MiB;
constexpr size_t WS_END = 480 * MiB;
constexpr int CW_QUEUE = 1024;
constexpr int CW_BAR = 4096;

constexpr int RING_OFF = 0, RING_BYTES = 131072;
constexpr int EXTRA_OFF = RING_BYTES, EXTRA_BYTES = 16384;
constexpr int LDSCTL_OFF = EXTRA_OFF + EXTRA_BYTES, MISC_OFF = LDSCTL_OFF + 320;
constexpr int LDS_BYTES = LDSCTL_OFF + 1024;

#define GAS __attribute__((address_space(1)))
#define LAS __attribute__((address_space(3)))
typedef unsigned short bf16;
typedef unsigned v4u __attribute__((ext_vector_type(4)));
typedef float f32x4 __attribute__((ext_vector_type(4)));
typedef GAS unsigned gu32;
#define RLX_AGENT __ATOMIC_RELAXED, __HIP_MEMORY_SCOPE_AGENT
#define LDS_WAIT() asm volatile("s_waitcnt lgkmcnt(0)" ::: "memory")
#define VM_WAIT() asm volatile("s_waitcnt vmcnt(0)" ::: "memory")
__device__ __forceinline__ unsigned f2bf(float f) { unsigned u = __builtin_bit_cast(unsigned, f); return (u + 0x7fffu + ((u >> 16) & 1u)) >> 16; }
__device__ __forceinline__ unsigned pk2(float lo, float hi) { return f2bf(lo) | (f2bf(hi) << 16); }
__device__ __forceinline__ float bf2f(unsigned short b) { return __builtin_bit_cast(float, (unsigned)b << 16); }
__device__ __forceinline__ float bflo(unsigned w) { return __builtin_bit_cast(float, w << 16); }
__device__ __forceinline__ float bfhi(unsigned w) { return __builtin_bit_cast(float, w & 0xffff0000u); }
__device__ __forceinline__ float silu_f(float z) { return z / (1.0f + __expf(-z)); }
__device__ __forceinline__ float sigmoid_f(float z) { return 1.0f / (1.0f + __expf(-z)); }

#define XB_TMO      128
#define XB_XCNT(j)  (256  + 64 * (j))
#define XB_XSUB(j)  (1280 + 64 * (j))
#define XB_XGEN(j)  (2304 + 64 * (j))
#define XB_TOP      3328
#define XB_TOPGEN   3392
#define XCD_BAR_WORDS 3456
#define XB_SPIN_CAP (1u << 18)

__device__ __forceinline__ unsigned xb_ld(unsigned* p)              { return __hip_atomic_load(p, __ATOMIC_RELAXED, __HIP_MEMORY_SCOPE_AGENT); }
__device__ __forceinline__ unsigned xb_add(unsigned* p, unsigned v) { return __hip_atomic_fetch_add(p, v, __ATOMIC_RELAXED, __HIP_MEMORY_SCOPE_AGENT); }
__device__ __forceinline__ unsigned xb_xcc_id() { return (unsigned)__builtin_amdgcn_s_getreg((3 << 11) | 20) & 0xFu; }
#define XB_SPIN(cond, bar) do { unsigned _sp = 0; while (cond) { __builtin_amdgcn_s_sleep(1); \
    if ((++_sp & 255u) == 0u) { if (xb_ld(&(bar)[XB_TMO])) break; if (_sp > XB_SPIN_CAP) { atomicAdd(&(bar)[XB_TMO], 1u); break; } } } } while (0)

struct XcdBarrier {
    unsigned* bar; unsigned x; int wave0;
    volatile LAS unsigned* st;
};

#define XB_IS_T0(wv) ((wv) == 0 && lane_id_asm() == 0)
__device__ __forceinline__ XcdBarrier xcd_barrier_post(unsigned* bar, volatile LAS unsigned* st, int wave0) {
    XcdBarrier b; b.bar = bar; b.x = xb_xcc_id(); b.st = st; b.wave0 = wave0;
    if (XB_IS_T0(wave0)) (void)xb_add(&bar[XB_XCNT(b.x)], 1u);
    return b;
}
__device__ __forceinline__ void xcd_barrier_complete(unsigned* bar, unsigned x, unsigned& nloc, unsigned& nx) {
    const unsigned G = gridDim.x * gridDim.y * gridDim.z;
    unsigned sum, cnt, mine, sp = 0u;
    for (;;) {
        sum = 0u; cnt = 0u; mine = 0u;
#pragma unroll
        for (unsigned j = 0; j < 16; ++j) { const unsigned c = xb_ld(&bar[XB_XCNT(j)]); sum += c; cnt += (c > 0u) ? 1u : 0u; mine = (j == x) ? c : mine; }
        if (sum == G) break;
        __builtin_amdgcn_s_sleep(1);
        if ((++sp & 255u) == 0u) { if (xb_ld(&bar[XB_TMO])) break; if (sp > XB_SPIN_CAP) { atomicAdd(&bar[XB_TMO], 1u); break; } }
    }
    nloc = mine > 0u ? mine : 1u; nx = cnt > 0u ? cnt : 1u;
}

__device__ __forceinline__ void xcd_barrier(const XcdBarrier& b) {
    asm volatile("s_waitcnt vmcnt(0)" ::: "memory");
    __syncthreads();
    if (XB_IS_T0(b.wave0)) {
        unsigned* bar = b.bar;
        __builtin_amdgcn_s_waitcnt(0);
        unsigned nloc = b.st[0], nx = b.st[1];
        if (nloc == 0u) { xcd_barrier_complete(bar, b.x, nloc, nx); b.st[0] = nloc; b.st[1] = nx; }
        const unsigned old = xb_add(&bar[XB_XSUB(b.x)], 1u);
        const unsigned gen = old / nloc;
        if (old + 1u == (gen + 1u) * nloc) {
            __builtin_amdgcn_fence(__ATOMIC_RELEASE, "agent");
            asm volatile("s_waitcnt vmcnt(0)" ::: "memory");
            const unsigned og = xb_add(&bar[XB_TOP], 1u);
            const unsigned tg = og / nx;
            if (og + 1u == (tg + 1u) * nx) xb_add(&bar[XB_TOPGEN], 1u);
            else XB_SPIN(xb_ld(&bar[XB_TOPGEN]) == tg, bar);
            __builtin_amdgcn_fence(__ATOMIC_ACQUIRE, "agent");
            xb_add(&bar[XB_XGEN(b.x)], 1u);
            asm volatile("s_waitcnt vmcnt(0)" ::: "memory");
        } else {
            XB_SPIN(xb_ld(&bar[XB_XGEN(b.x)]) == gen, bar);
            __builtin_amdgcn_fence(__ATOMIC_ACQUIRE, "agent");
            asm volatile("s_waitcnt vmcnt(0)" ::: "memory");
        }
    }
    __syncthreads();
}


struct Frame {
    LAS unsigned char* lds;
    volatile LAS unsigned* MISC;
    int wave0;
    gu32* ctl;
    int vcu, G;
    const float* x; float* out;
    const float *norm_w, *w_in, *lb_logits, *hg_norm_w, *q_norm_w, *k_norm_w, *w_out;
    bf16 *WIN, *WOUT, *XB, *MIXED, *QI, *KT, *HI, *GH, *QN, *KN, *V, *GA;
    float *LB, *KPART, *ROWSS, *DEC;
};

__device__ __forceinline__ float wave_sum(float v) {
#pragma unroll
    for (int o = 1; o < 64; o <<= 1) v += __shfl_xor(v, o);
    return v;
}
__device__ __forceinline__ int win_dest(int oc) {
    if (oc < 2048) { const int grp = oc >> 9, hh = (oc >> 7) & 3, w = oc & 127; return 256 * (((grp >> 1) << 2) + hh) + 128 * (grp & 1) + w; }
    const int ty = (oc - 2048) >> 9, head = (oc >> 6) & 7, bj = (oc >> 5) & 1; return 256 * (8 + 2 * ty + (head >> 2)) + 128 * bj + 32 * (head & 3);
}
__device__ __forceinline__ void p0_transpose_item(const float* W, int K, int N, bf16* WT, const float* kscale, LAS float* scr, int item, int lane, bool permute) {
    const int nblk = N / 32, kb = item / nblk, nb = item % nblk, k0 = 64 * kb, n0 = 32 * nb; const int nd = permute ? win_dest(n0) : n0;
    float wv_[32];
#pragma unroll
    for (int i = 0; i < 32; ++i) wv_[i] = W[(size_t)(k0 + 2 * i + (lane >> 5)) * N + n0 + (lane & 31)];
#pragma unroll
    for (int i = 0; i < 32; ++i) { const int kk = 2 * i + (lane >> 5); const float s = kscale ? kscale[k0 + kk] : 1.0f; scr[kk * 33 + (lane & 31)] = wv_[i] * s; }
    LDS_WAIT(); asm volatile("" ::: "memory");
    const int c = lane & 7;
#pragma unroll
    for (int j = 0; j < 4; ++j) { const int n = (lane >> 3) + 8 * j; const LAS float* s = scr + (8 * c) * 33 + n;
        v4u o; o.x = pk2(s[0 * 33], s[1 * 33]); o.y = pk2(s[2 * 33], s[3 * 33]); o.z = pk2(s[4 * 33], s[5 * 33]); o.w = pk2(s[6 * 33], s[7 * 33]);
        *(GAS v4u*)(WT + (size_t)(nd + n) * K + k0 + 8 * c) = o; }
    LDS_WAIT(); asm volatile("" ::: "memory");
}
#define PHASE_IDS() int t_ = F.wave0 * 64 + lane_id_asm(); asm volatile("" : "+v"(t_)); const int tid = t_, lane = tid & 63, wave = __builtin_amdgcn_readfirstlane(tid >> 6); (void)lane; (void)wave
__device__ __forceinline__ void p0_prologue(Frame& F) {
    PHASE_IDS();
    LAS float* scr = (LAS float*)(F.lds + RING_OFF + wave * 16384);
    const int gw = F.vcu * NWAVES + wave, NGW = F.G * NWAVES;
    constexpr int I_IN = (DM / 64) * (NIN / 32), I_OUT = (DM / 64) * (DM / 32);
    constexpr int NITEMS = DEPTH * (I_IN + I_OUT);
    for (int it = gw; it < NITEMS; it += NGW) {
        int r = it;
        if (r < DEPTH * I_IN) { const int l = r / I_IN; r -= l * I_IN;
            p0_transpose_item(F.w_in + (size_t)l * DM * NIN, DM, NIN, F.WIN + (size_t)l * NIN * DM, F.norm_w + l * DM, scr, r, lane, true); continue; }
        r -= DEPTH * I_IN; { const int l = r / I_OUT; r -= l * I_OUT;
            p0_transpose_item(F.w_out + (size_t)l * DM * DM, DM, DM, F.WOUT + (size_t)l * DM * DM, nullptr, scr, r, lane, false); }
    }
    for (int m0 = gw * 4; m0 < MTOK; m0 += NGW * 4) {
        f32x4 v[4][4]; float sq[4];
#pragma unroll
        for (int r = 0; r < 4; ++r) { const GAS f32x4* xr = (const GAS f32x4*)(F.x + (size_t)(m0 + r) * DM) + lane;
#pragma unroll
            for (int j = 0; j < 4; ++j) v[r][j] = xr[64 * j]; }
#pragma unroll
        for (int r = 0; r < 4; ++r) { float a = 0.f;
#pragma unroll
            for (int j = 0; j < 4; ++j) a += (v[r][j].x * v[r][j].x + v[r][j].y * v[r][j].y) + (v[r][j].z * v[r][j].z + v[r][j].w * v[r][j].w);
            sq[r] = a; }
#pragma unroll
        for (int o = 1; o < 64; o <<= 1) {
#pragma unroll
            for (int r = 0; r < 4; ++r) sq[r] += __shfl_xor(sq[r], o); }
#pragma unroll
        for (int r = 0; r < 4; ++r) { GAS unsigned long long* o8 = (GAS unsigned long long*)(F.XB + (size_t)(m0 + r) * DM) + lane;
#pragma unroll
            for (int j = 0; j < 4; ++j) o8[64 * j] = (unsigned long long)pk2(v[r][j].x, v[r][j].y) | ((unsigned long long)pk2(v[r][j].z, v[r][j].w) << 32);
            if (lane < 16) F.ROWSS[(size_t)(m0 + r) * 16 + lane] = (lane == 0) ? sq[r] : 0.f; }
    }
    if (blockIdx.x == 0) { const int c = tid; const float a0 = F.lb_logits[c], a1 = F.lb_logits[512 + c]; const float mx = fmaxf(a0, a1);
        const float e0 = expf(a0 - mx), e1 = expf(a1 - mx); const float p0 = e0 / (e0 + e1), p1 = e1 / (e0 + e1);
        F.LB[c] = 0.f; F.LB[512 + c] = fminf(fmaxf((p0 + p1) - p0, 0.f), 1.0f - 1e-6f); }
}

constexpr float LOG2E = 1.4426950408889634f;
constexpr float QSCALE2 = 0.125f * LOG2E;
namespace moba {
typedef short bf16x8 __attribute__((ext_vector_type(8)));
typedef short s16x4 __attribute__((ext_vector_type(4)));
typedef float f32x16 __attribute__((ext_vector_type(16)));
typedef float f32x2_t __attribute__((ext_vector_type(2))); typedef __bf16 bf16x2_t __attribute__((ext_vector_type(2)));
__device__ __forceinline__ unsigned cvtpk(float lo, float hi) { f32x2_t v = {lo, hi}; bf16x2_t b = __builtin_convertvector(v, bf16x2_t); return __builtin_bit_cast(unsigned, b); }
__device__ __forceinline__ int crow(int r, int hi) { return (r & 3) + 8 * (r >> 2) + 4 * hi; }
__device__ __forceinline__ float max3f(float a, float b, float c) { float r; asm("v_max3_f32 %0, %1, %2, %3" : "=v"(r) : "v"(a), "v"(b), "v"(c)); return r; }
constexpr int L_K = 0, L_V = 32768, L_WSF = 65536, L_KM = 67584, L_OST = 69632;
constexpr float NEG_BIG = -1e30f;
constexpr float THR = 8.0f;
__device__ __forceinline__ s16x4 vtr(const LAS unsigned char* p) { return __builtin_bit_cast(s16x4, __builtin_amdgcn_ds_read_tr16_b64_v4i16((LAS s16x4*)p)); }
}

__device__ __forceinline__ void moba_glds(unsigned voff, const void* sbase, unsigned lds_dst) { unsigned keep;
    asm volatile("s_mov_b32 %0, m0\n\ts_mov_b32 m0, %3\n\ts_nop 0\n\tglobal_load_lds_dwordx4 %1, %2\n\ts_mov_b32 m0, %0" : "=&s"(keep) : "v"(voff), "s"(sbase), "s"(lds_dst) : "memory"); }
__device__ __forceinline__ void moba_mfma_phase(Frame& F, int l) {
    using namespace moba;
    PHASE_IDS();
    const int r32 = lane & 31, hi = lane >> 5, wid = wave;
    LAS unsigned char* L = F.lds + RING_OFF;
    LAS float* wsf = (LAS float*)(L + L_WSF) + wid * 64;
    LAS float* km = (LAS float*)(L + L_KM);
    LAS float* ost = (LAS float*)(L + L_OST) + wid * 2048;
    float gq = fabsf(F.q_norm_w[l * 64 + lane]), gk = fabsf(F.k_norm_w[l * 64 + lane]);
#pragma unroll
    for (int o = 1; o < 64; o <<= 1) { gq = fmaxf(gq, __shfl_xor(gq, o)); gk = fmaxf(gk, __shfl_xor(gk, o)); }
    gq = __builtin_bit_cast(float, __builtin_amdgcn_readfirstlane(__builtin_bit_cast(int, gq))); gk = __builtin_bit_cast(float, __builtin_amdgcn_readfirstlane(__builtin_bit_cast(int, gk)));
    const float smax2 = 8.0f * gq * gk * LOG2E * 1.02f;
    const float mhat0 = -(smax2 + 1.0f);
    gu32* qctr = F.ctl + CW_QUEUE + 64 * l;
    volatile LAS unsigned* tick = (volatile LAS unsigned*)(F.lds + EXTRA_OFF + 8192);
    if (tid == 0) tick[0] = __hip_atomic_fetch_add(qctr, 1u, RLX_AGENT);
    for (int ui = 0;; ++ui) {
        __syncthreads();
        const int it = __builtin_amdgcn_readfirstlane((int)tick[ui & 1]); if (it >= 1024) break;
        const int qb = 7 - (it >> 7), bh = it & 127;
        const int b = bh >> 3, h = bh & 7; const size_t rowbase = (size_t)b * SEQ; const int q0 = qb * 256, qrel = wid * 32 + r32, tq = q0 + qrel;
        const float sl2 = exp2f(-(float)(h + 1)) * LOG2E;
        bf16x8 qr[4];
        { const GAS bf16* Qw = (const GAS bf16*)(F.QN + (rowbase + q0 + wid * 32 + r32) * 512 + h * 64 + hi * 8);
#pragma unroll
            for (int d0 = 0; d0 < 4; ++d0) qr[d0] = *(const GAS bf16x8*)(Qw + d0 * 16); }
        LAS unsigned char* qlds = (LAS unsigned char*)ost + lane * 16;
        if (tid < qb * 64) { const GAS float* kp = (const GAS float*)(F.KPART + ((size_t)b * 8 + (tid >> 6)) * 1024 + h * 64 + (tid & 63)); km[tid] = (kp[0] + kp[512]) * (1.0f / 256.0f); }
        const unsigned koff = (unsigned)(((rowbase + lane) * 512 + h * 64 + wid * 8) * 2);
        unsigned voff; { const int vr = 8 * wid + (lane >> 3), sl = lane & 7; const int ch = ((((sl >> 2) ^ ((vr >> 1) & 1)) << 2) | (sl & 3)); voff = (unsigned)((((size_t)MTOK + rowbase + vr) * 512 + h * 64 + ch * 8) * 2); }
        const unsigned lds0 = (unsigned)(uintptr_t)L;
#define MOBA_ISSUE(t_, bufi) do { moba_glds(koff, (const void*)((const char*)F.KN + (size_t)(t_) * 65536), (unsigned)__builtin_amdgcn_readfirstlane((int)(lds0 + L_K + (bufi) * 8192 + wid * 1024))); \
            moba_glds(voff, (const void*)((const char*)F.KN + (size_t)(t_) * 65536), (unsigned)__builtin_amdgcn_readfirstlane((int)(lds0 + L_V + (bufi) * 8192 + wid * 1024))); } while (0)
        const int NT = 4 * (qb + 1);
        int t0 = 0; { const float dstar = (151.0f + 2.0f * smax2) / sl2; const float x = ((float)(q0 - 63) - dstar) * (1.0f / 64.0f); if (x > 0.f) t0 = ((int)x) & ~1; if (t0 > NT - 4) t0 = NT - 4; t0 = __builtin_amdgcn_readfirstlane(t0); }
        unsigned nticket = 0u; if (tid == 0) nticket = __hip_atomic_fetch_add(qctr, 1u, RLX_AGENT);
        MOBA_ISSUE(t0, 0); MOBA_ISSUE(t0 + 1, 1); MOBA_ISSUE(t0 + 2, 2);
        __syncthreads();
        unsigned selmask = 0;
        { float gt[7];
#pragma unroll
            for (int j = 0; j < 7; ++j) { float s = 0.f;
                if (j < qb) {
#pragma unroll
                    for (int d0 = 0; d0 < 4; ++d0)
#pragma unroll
                        for (int e = 0; e < 8; ++e) s += bf2f((unsigned short)qr[d0][e]) * km[j * 64 + d0 * 16 + hi * 8 + e];
                    auto rr = __builtin_amdgcn_permlane32_swap(__float_as_uint(s), __float_as_uint(s), false, false);
                    s = __uint_as_float(rr[0]) + __uint_as_float(rr[1]); }
                gt[j] = s; }
#pragma unroll
            for (int j = 0; j < 7; ++j) { int rank = 0;
#pragma unroll
                for (int i = 0; i < 7; ++i) if (i != j && i < qb) rank += (gt[i] > gt[j] || (gt[i] == gt[j] && i < j)) ? 1 : 0;
                if (j < qb && rank < 3) selmask |= 1u << j; } }
#pragma unroll
        for (int d0 = 0; d0 < 4; ++d0) *(LAS bf16x8*)(qlds + d0 * 1024) = qr[d0];
        float mhat = mhat0, l_reg = 0.f; f32x16 o[2]; o[0] = f32x16{}; o[1] = f32x16{};
        const int kbase = L_K + hi * 1024 + r32 * 16;
        const int g16 = lane >> 4, i16 = lane & 15, tq4 = i16 >> 2, tp4 = i16 & 3;
        const int vrow0 = 4 * hi + tq4;
        if (tid == 0) tick[(ui + 1) & 1] = nticket;
        asm volatile("s_waitcnt vmcnt(2)" ::: "memory");
        __syncthreads();
#define MOBA_KLOAD(KOFF) do { _Pragma("unroll") for (int d0 = 0; d0 < 4; ++d0) qf_[d0] = *(const LAS bf16x8*)(qlds + d0 * 1024); \
            _Pragma("unroll") for (int d0 = 0; d0 < 4; ++d0) { \
            kfr[2 * d0] = *(const LAS bf16x8*)(L + (KOFF) + kbase + d0 * 2048); kfr[2 * d0 + 1] = *(const LAS bf16x8*)(L + (KOFF) + kbase + d0 * 2048 + 512); } } while (0)
#define MOBA_VLOAD(VOFF) do { _Pragma("unroll") for (int dblk = 0; dblk < 2; ++dblk) _Pragma("unroll") for (int ks = 0; ks < 4; ++ks) { \
            const int rlo = 16 * ks + vrow0, rhi = rlo + 8; \
            vlo[dblk * 4 + ks] = vtr(L + L_V + (VOFF) + rlo * 128 + ((dblk ^ ((rlo >> 1) & 1)) * 64) + (16 * (g16 & 1) + 4 * tp4) * 2); \
            vhi[dblk * 4 + ks] = vtr(L + L_V + (VOFF) + rhi * 128 + ((dblk ^ ((rhi >> 1) & 1)) * 64) + (16 * (g16 & 1) + 4 * tp4) * 2); } } while (0)
#define MOBA_QK(TT, P0, P1) do { \
            const int blk_ = (TT) >> 2; const bool own_ = (blk_ == qb); \
            if (!(own_ && (64 * ((TT) & 3) > 32 * wid + 31))) { \
                const bool sel_ = own_ || ((selmask >> blk_) & 1u); \
                const float sc0_ = sel_ ? (-mhat - sl2 * (float)(tq - 64 * (TT) - 4 * hi)) : NEG_BIG; \
_Pragma("unroll") \
                for (int r = 0; r < 16; ++r) { P0[r] = __builtin_fmaf(sl2, (float)((r & 3) + 8 * (r >> 2)), sc0_); P1[r] = __builtin_fmaf(sl2, (float)(32 + (r & 3) + 8 * (r >> 2)), sc0_); } \
_Pragma("unroll") \
                for (int d0 = 0; d0 < 4; ++d0) { \
                    P0 = __builtin_amdgcn_mfma_f32_32x32x16_bf16(kfr[2 * d0], qf_[d0], P0, 0, 0, 0); \
                    P1 = __builtin_amdgcn_mfma_f32_32x32x16_bf16(kfr[2 * d0 + 1], qf_[d0], P1, 0, 0, 0); } \
            } } while (0)
#define MOBA_SMPV(TT, P0, P1, HAVE_NEXT, N0, N1) do { \
            const int blk = (TT) >> 2; const bool own = (blk == qb); const int jb = (TT) & 3; \
            if (!(own && (64 * jb > 32 * wid + 31))) { \
                if (own && (64 * jb + 63 > 32 * wid)) { \
_Pragma("unroll") \
                    for (int r = 0; r < 16; ++r) { const int kvl = 64 * jb + crow(r, hi); if (kvl > qrel) P0[r] = NEG_BIG; if (kvl + 32 > qrel) P1[r] = NEG_BIG; } } \
                float rm = max3f(P0[0], P1[0], P0[1]), rm2 = max3f(P1[1], P0[2], P1[2]); \
_Pragma("unroll") \
                for (int r = 3; r < 15; r += 2) { rm = max3f(rm, P0[r], P1[r]); rm2 = max3f(rm2, P0[r + 1], P1[r + 1]); } \
                rm = max3f(rm, rm2, fmaxf(P0[15], P1[15])); \
                { auto rr = __builtin_amdgcn_permlane32_swap(__float_as_uint(rm), __float_as_uint(rm), false, false); rm = fmaxf(__uint_as_float(rr[0]), __uint_as_float(rr[1])); } \
                if (__any(rm > THR)) { \
                    const float dl = fmaxf(rm, 0.f); mhat += dl; \
_Pragma("unroll") \
                    for (int r = 0; r < 16; ++r) { P0[r] -= dl; P1[r] -= dl; } \
                    if (HAVE_NEXT) { \
_Pragma("unroll") \
                        for (int r = 0; r < 16; ++r) { N0[r] -= dl; N1[r] -= dl; } } \
                    const float f = __builtin_amdgcn_exp2f(-dl); l_reg *= f; \
                    if (hi == 0) wsf[r32] = f; \
_Pragma("unroll") \
                    for (int r = 0; r < 16; ++r) { const float fr = wsf[crow(r, hi)]; o[0][r] *= fr; o[1][r] *= fr; } } \
                float sacc = 0.f, sacc2 = 0.f; \
_Pragma("unroll") \
                for (int r = 0; r < 16; ++r) { P0[r] = __builtin_amdgcn_exp2f(P0[r]); P1[r] = __builtin_amdgcn_exp2f(P1[r]); sacc += P0[r]; sacc2 += P1[r]; } \
                l_reg += sacc + sacc2; \
                bf16x8 pa[4]; \
                { v4u w; \
_Pragma("unroll") \
                    for (int ks = 0; ks < 4; ++ks) { \
_Pragma("unroll") \
                        for (int e = 0; e < 4; ++e) { const int rb = (ks & 1) * 8 + 2 * e; w[e] = (ks < 2) ? cvtpk(P0[rb], P0[rb + 1]) : cvtpk(P1[rb], P1[rb + 1]); } \
                        pa[ks] = __builtin_bit_cast(bf16x8, w); } } \
_Pragma("unroll") \
                for (int dblk = 0; dblk < 2; ++dblk) \
_Pragma("unroll") \
                    for (int ks = 0; ks < 4; ++ks) { \
                        const s16x4 lo = vlo[dblk * 4 + ks], hh = vhi[dblk * 4 + ks]; \
                        const bf16x8 vf = __builtin_shufflevector(lo, hh, 0, 1, 2, 3, 4, 5, 6, 7); \
                        o[dblk] = __builtin_amdgcn_mfma_f32_32x32x16_bf16(pa[ks], vf, o[dblk], 0, 0, 0); } \
            } } while (0)
        f32x16 pA0, pA1, pB0, pB1; bf16x8 kfr[8], qf_[4]; s16x4 vlo[8], vhi[8];
        MOBA_KLOAD(0); MOBA_QK(t0, pA0, pA1);
        int c0o = 0;
        for (int t = t0; t < NT; t += 2) {
            const int c1o = (c0o + 1) & 3, c2o = (c0o + 2) & 3, c3o = (c0o + 3) & 3;
            if (t + 3 < NT) MOBA_ISSUE(t + 3, c3o);
            MOBA_KLOAD(c1o * 8192); __builtin_amdgcn_sched_barrier(0);
            MOBA_QK(t + 1, pB0, pB1); __builtin_amdgcn_sched_barrier(0);
            MOBA_VLOAD(c0o * 8192); __builtin_amdgcn_sched_barrier(0);
            MOBA_SMPV(t, pA0, pA1, true, pB0, pB1);
            if (t + 3 < NT) asm volatile("s_waitcnt vmcnt(2)" ::: "memory"); else asm volatile("s_waitcnt vmcnt(0)" ::: "memory");
            __syncthreads();
            if (t + 4 < NT) MOBA_ISSUE(t + 4, c0o);
            if (t + 2 < NT) { MOBA_KLOAD(c2o * 8192); __builtin_amdgcn_sched_barrier(0); MOBA_QK(t + 2, pA0, pA1); __builtin_amdgcn_sched_barrier(0); }
            MOBA_VLOAD(c1o * 8192); __builtin_amdgcn_sched_barrier(0);
            MOBA_SMPV(t + 1, pB0, pB1, (t + 2 < NT), pA0, pA1);
            if (t + 4 < NT) asm volatile("s_waitcnt vmcnt(2)" ::: "memory"); else asm volatile("s_waitcnt vmcnt(0)" ::: "memory");
            __syncthreads();
            c0o = c2o;
        }
#undef MOBA_ISSUE
#undef MOBA_KLOAD
#undef MOBA_VLOAD
#undef MOBA_QK
#undef MOBA_SMPV
        v4u gwv[4];
#pragma unroll
        for (int i = 0; i < 4; ++i) gwv[i] = *(const GAS v4u*)(F.GA + (rowbase + q0 + wid * 32 + i * 8 + (lane >> 3)) * 512 + h * 64 + (lane & 7) * 8);
        { auto rr = __builtin_amdgcn_permlane32_swap(__float_as_uint(l_reg), __float_as_uint(l_reg), false, false); l_reg = __uint_as_float(rr[0]) + __uint_as_float(rr[1]); }
        if (hi == 0) wsf[r32] = 1.0f / l_reg;
#pragma unroll
        for (int r = 0; r < 16; ++r) { const float rl = wsf[crow(r, hi)]; ost[crow(r, hi) * 64 + r32] = o[0][r] * rl; ost[crow(r, hi) * 64 + 32 + r32] = o[1][r] * rl; }
#pragma unroll
        for (int i = 0; i < 4; ++i) { const int row = i * 8 + (lane >> 3), ch = lane & 7;
            const f32x4 a = *(const LAS f32x4*)(ost + row * 64 + ch * 8), c2 = *(const LAS f32x4*)(ost + row * 64 + ch * 8 + 4);
            const size_t grow = rowbase + q0 + wid * 32 + row;
            const v4u gw = gwv[i];
            v4u ow; ow.x = pk2(a[0] * bflo(gw.x), a[1] * bfhi(gw.x)); ow.y = pk2(a[2] * bflo(gw.y), a[3] * bfhi(gw.y));
            ow.z = pk2(c2[0] * bflo(gw.z), c2[1] * bfhi(gw.z)); ow.w = pk2(c2[2] * bflo(gw.w), c2[3] * bfhi(gw.w));
            *(GAS v4u*)(F.MIXED + grow * DM + 512 + h * 64 + ch * 8) = ow; }
    }
    __syncthreads();
}


namespace hg {
typedef short bf16x8 __attribute__((ext_vector_type(8)));
typedef short s16x4 __attribute__((ext_vector_type(4)));
typedef float f32x4 __attribute__((ext_vector_type(4)));
typedef unsigned u32x2 __attribute__((ext_vector_type(2)));
constexpr int SLOT = 33792, NSLOT = 4;
constexpr int L_SC = NSLOT * SLOT, L_NRM = L_SC + 4096;
constexpr int NSTEP = SEQ / 32;
__device__ __forceinline__ int fsw(int t) { return ((t & 7) << 2) | (((t >> 3) & 1) << 1); }
__device__ __forceinline__ int unit_off(int tok, int cg) { return 8 * (32 * tok + (cg ^ fsw(tok))); }
__device__ __forceinline__ s16x4 rd64(const LAS unsigned char* p) { return *(const LAS s16x4*)p; }
__device__ __forceinline__ s16x4 vtr(const LAS unsigned char* p) { return __builtin_bit_cast(s16x4, __builtin_amdgcn_ds_read_tr16_b64_v4i16((LAS s16x4*)p)); }
__device__ __forceinline__ bf16x8 cat(s16x4 a, s16x4 b) { return __builtin_shufflevector(a, b, 0, 1, 2, 3, 4, 5, 6, 7); }
__device__ __forceinline__ s16x4 pack4(f32x4 v) { u32x2 w; w.x = moba::cvtpk(v[0], v[1]); w.y = moba::cvtpk(v[2], v[3]); return __builtin_bit_cast(s16x4, w); }
__device__ __forceinline__ void glds16(const GAS void* gsrc, unsigned lds_dst) { unsigned keep;
    asm volatile("s_mov_b32 %0, m0\n\ts_mov_b32 m0, %2\n\ts_nop 0\n\tglobal_load_lds_dwordx4 %1, off\n\ts_mov_b32 m0, %0" : "=&s"(keep) : "v"(gsrc), "s"(lds_dst) : "memory"); }
__device__ __forceinline__ void glds16s(unsigned voff, const void* sbase, unsigned lds_dst) { unsigned keep;
    asm volatile("s_mov_b32 %0, m0\n\ts_mov_b32 m0, %3\n\ts_nop 0\n\tglobal_load_lds_dwordx4 %1, %2\n\ts_mov_b32 m0, %0" : "=&s"(keep) : "v"(voff), "s"(sbase), "s"(lds_dst) : "memory"); }
#define HG_MFMA(a, b, c) __builtin_amdgcn_mfma_f32_16x16x32_bf16((a), (b), (c), 0, 0, 0)
}

__device__ __forceinline__ void hgrn_mfma_phase(Frame& F, int l) {
    using namespace hg;
    PHASE_IDS();
    const int w = wave, c16 = lane & 15, g = lane >> 4;
    LAS unsigned char* L = F.lds + RING_OFF;
    const s16x4 z4 = (s16x4){0, 0, 0, 0};
    for (int it = (int)blockIdx.x; it < 64; it += F.G) {
        const int b = it >> 2, h = it & 3; const size_t rowbase = (size_t)b * SEQ;
        const int da = w >> 1;
        unsigned dsrc[4];
#pragma unroll
        for (int i = 0; i < 4; ++i) { const int t = 16 * (w & 1) + 4 * i + (lane >> 4); const int sc = (lane & 15) ^ (fsw(t) >> 1);
            dsrc[i] = (unsigned)((((size_t)da * MTOK + rowbase + t) * 512 + h * 128 + 8 * sc) * 2); }
        const unsigned ddec = (unsigned)((((size_t)b * NSTEP) * 512 + h * 128 + 4 * lane) * 4);
        const int ddst = da * 8192 + (w & 1) * 4096;
        const unsigned lds0 = (unsigned)(uintptr_t)(F.lds + RING_OFF);
#define HG_ISSUE(step) do { const unsigned so_ = lds0 + (unsigned)(((step) & 3) * SLOT); \
            _Pragma("unroll") for (int i = 0; i < 4; ++i) \
                glds16s(dsrc[i], (const void*)((const char*)F.QI + (size_t)(step) * (32 * 512 * 2)), (unsigned)__builtin_amdgcn_readfirstlane((int)(so_ + ddst + i * 1024))); \
            if (w == 0) glds16s(ddec, (const void*)((const char*)F.DEC + (size_t)(step) * 2048), (unsigned)__builtin_amdgcn_readfirstlane((int)(so_ + 32768))); } while (0)
        f32x4 S[8]; bf16x8 Sb[4];
#pragma unroll
        for (int tk = 0; tk < 8; ++tk) S[tk] = (f32x4){0.f, 0.f, 0.f, 0.f};
#pragma unroll
        for (int ks = 0; ks < 4; ++ks) Sb[ks] = (bf16x8){0, 0, 0, 0, 0, 0, 0, 0};
        f32x4 oprev[2]; oprev[0] = (f32x4){0.f, 0.f, 0.f, 0.f}; oprev[1] = oprev[0];
        u32x2 gprev[2]; gprev[0] = (u32x2){0u, 0u}; gprev[1] = gprev[0];
        float hw[4];
#pragma unroll
        for (int r = 0; r < 4; ++r) hw[r] = F.hg_norm_w[l * 128 + 16 * w + 4 * g + r];
        asm volatile("" : "+v"(hw[0]), "+v"(hw[1]), "+v"(hw[2]), "+v"(hw[3]));
        LAS float* nrm = (LAS float*)(L + L_NRM);
        LAS unsigned char* SC = L + L_SC;
        HG_ISSUE(0); HG_ISSUE(1); HG_ISSUE(2);
        asm volatile("s_waitcnt vmcnt(8)\n\ts_barrier" ::: "memory");
        const int trq = c16 >> 2, trp = c16 & 3;
        int ro0 = 256 * c16 + 16 * (g ^ (fsw(c16) >> 1)), ko0 = 256 * (4 * g + trq) + 16 * (trp ^ (fsw(4 * g + trq) >> 1));
#define RO(ks) (ro0 ^ (64 * (ks)))
#define KO(tk) (ko0 ^ (64 * ((tk) >> 1) + 8 * ((tk) & 1)))
        const int io_ = unit_off(4 * g + trq, 4 * w + trp), go_ = unit_off(c16, 4 * w + g);
        bf16x8 qf[2][4];
#define HG_LOADQ(slotbase) do { _Pragma("unroll") for (int tt = 0; tt < 2; ++tt) _Pragma("unroll") for (int ks = 0; ks < 4; ++ks) \
            qf[tt][ks] = *(const LAS bf16x8*)((slotbase) + RO(ks) + 4096 * tt); } while (0)
#define HG_FINAL(step, P) do { _Pragma("unroll") for (int tt = 0; tt < 2; ++tt) { \
            const float ssum = ((P[tt][0] + P[tt][1]) + (P[tt][2] + P[tt][3])) + ((P[tt][4] + P[tt][5]) + (P[tt][6] + P[tt][7])); \
            const float rstd = __builtin_amdgcn_rsqf(ssum * (1.0f / 128.0f) + NORM_EPS); \
            u32x2 wv; wv.x = moba::cvtpk(oprev[tt][0] * rstd * hw[0] * bflo(gprev[tt].x), oprev[tt][1] * rstd * hw[1] * bfhi(gprev[tt].x)); \
            wv.y = moba::cvtpk(oprev[tt][2] * rstd * hw[2] * bflo(gprev[tt].y), oprev[tt][3] * rstd * hw[3] * bfhi(gprev[tt].y)); \
            *(GAS u32x2*)(F.MIXED + (rowbase + (size_t)(step) * 32 + 16 * tt + c16) * DM + h * 128 + 16 * w + 4 * g) = wv; } } while (0)
        HG_LOADQ(L);
        for (int n = 0; n < NSTEP; ++n) {
            asm volatile("" : "+v"(ro0), "+v"(ko0));
            if (n + 3 < NSTEP) HG_ISSUE(n + 3);
            const LAS unsigned char* Qs = L + (n & 3) * SLOT; const LAS unsigned char* Ks = Qs + 8192; const LAS unsigned char* Is = Qs + 16384; const LAS unsigned char* Gs = Qs + 24576;
            const LAS float* Ds = (const LAS float*)(Qs + 32768);
            LAS unsigned char* SCn = SC + (n & 1) * 1536;
            bf16x8 kf[4];
            if (w < 3) { const int st = (w == 2) ? 1 : 0;
#pragma unroll
                for (int ks = 0; ks < 4; ++ks) kf[ks] = *(const LAS bf16x8*)(Ks + RO(ks) + 4096 * st); }
            u32x2 gcur[2];
#pragma unroll
            for (int tt = 0; tt < 2; ++tt) gcur[tt] = *(const LAS u32x2*)(Gs + go_ + 4096 * tt);
            s16x4 itr[2];
#pragma unroll
            for (int st = 0; st < 2; ++st) itr[st] = vtr(Is + io_ + 4096 * st);
            const bf16x8 i01 = cat(itr[0], itr[1]);
            bf16x8 k01[4]; f32x4 dv4[4];
#pragma unroll
            for (int tk = 0; tk < 4; ++tk) { k01[tk] = cat(vtr(Ks + KO(tk)), vtr(Ks + KO(tk) + 4096)); dv4[tk] = *(const LAS f32x4*)(Ds + 16 * tk + 4 * g); }
            f32x4 o[2];
#pragma unroll
            for (int tt = 0; tt < 2; ++tt) { f32x4 a = (f32x4){0.f, 0.f, 0.f, 0.f};
#pragma unroll
                for (int ks = 0; ks < 4; ++ks) a = HG_MFMA(Sb[ks], qf[tt][ks], a);
                o[tt] = a; }
            if (w < 3) { f32x4 sc = (f32x4){0.f, 0.f, 0.f, 0.f};
                if (w == 0) {
#pragma unroll
                    for (int ks = 0; ks < 4; ++ks) sc = HG_MFMA(kf[ks], qf[0][ks], sc);
                } else {
#pragma unroll
                    for (int ks = 0; ks < 4; ++ks) sc = HG_MFMA(kf[ks], qf[1][ks], sc); }
                if (w != 1) {
#pragma unroll
                    for (int r = 0; r < 4; ++r) if (4 * g + r > c16) sc[r] = 0.f; }
                *(LAS s16x4*)(SCn + w * 512 + lane * 8) = pack4(sc); }
#pragma unroll
            for (int tk = 0; tk < 4; ++tk) S[tk] = HG_MFMA(k01[tk], i01, S[tk]);
            asm volatile("" ::: "memory");
            { bf16x8 k2[4]; f32x4 d2[4];
#pragma unroll
                for (int tk = 0; tk < 4; ++tk) { k2[tk] = cat(vtr(Ks + KO(tk + 4)), vtr(Ks + KO(tk + 4) + 4096)); d2[tk] = *(const LAS f32x4*)(Ds + 16 * (tk + 4) + 4 * g); }
#pragma unroll
                for (int tk = 0; tk < 4; ++tk) S[tk] = S[tk] * dv4[tk];
#pragma unroll
                for (int ks = 0; ks < 2; ++ks) Sb[ks] = cat(pack4(S[2 * ks]), pack4(S[2 * ks + 1]));
#pragma unroll
                for (int tk = 0; tk < 4; ++tk) S[tk + 4] = HG_MFMA(k2[tk], i01, S[tk + 4]);
#pragma unroll
                for (int tk = 0; tk < 4; ++tk) S[tk + 4] = S[tk + 4] * d2[tk];
#pragma unroll
                for (int ks = 2; ks < 4; ++ks) Sb[ks] = cat(pack4(S[2 * ks]), pack4(S[2 * ks + 1])); }
            if (n >= NSTEP - 3) asm volatile("s_waitcnt vmcnt(0) lgkmcnt(0)\n\ts_barrier" ::: "memory");
            else if (n <= 1) asm volatile("s_waitcnt vmcnt(8) lgkmcnt(0)\n\ts_barrier" ::: "memory");
            else if (n == 2) asm volatile("s_waitcnt vmcnt(10) lgkmcnt(0)\n\ts_barrier" ::: "memory");
            else asm volatile("s_waitcnt vmcnt(12) lgkmcnt(0)\n\ts_barrier" ::: "memory");
            const s16x4 sc00 = rd64(SCn + lane * 8), sc01 = rd64(SCn + 512 + lane * 8), sc11 = rd64(SCn + 1024 + lane * 8);
            float pn[2][8];
            if (n > 0) {
#pragma unroll
                for (int tt = 0; tt < 2; ++tt)
#pragma unroll
                    for (int ww = 0; ww < 8; ++ww) pn[tt][ww] = nrm[((n - 1) & 1) * 256 + ww * 32 + 16 * tt + c16]; }
            if (n + 1 < NSTEP) HG_LOADQ(L + ((n + 1) & 3) * SLOT);
            o[0] = HG_MFMA(cat(itr[0], z4), cat(sc00, z4), o[0]);
            o[1] = HG_MFMA(i01, cat(sc01, sc11), o[1]);
            { float ss0 = (o[0][0] * o[0][0] + o[0][1] * o[0][1]) + (o[0][2] * o[0][2] + o[0][3] * o[0][3]);
              float ss1 = (o[1][0] * o[1][0] + o[1][1] * o[1][1]) + (o[1][2] * o[1][2] + o[1][3] * o[1][3]);
              { auto r0 = __builtin_amdgcn_permlane16_swap(__float_as_uint(ss0), __float_as_uint(ss0), false, false); auto r1 = __builtin_amdgcn_permlane16_swap(__float_as_uint(ss1), __float_as_uint(ss1), false, false);
                ss0 = __uint_as_float(r0[0]) + __uint_as_float(r0[1]); ss1 = __uint_as_float(r1[0]) + __uint_as_float(r1[1]); }
              { auto r0 = __builtin_amdgcn_permlane32_swap(__float_as_uint(ss0), __float_as_uint(ss0), false, false); auto r1 = __builtin_amdgcn_permlane32_swap(__float_as_uint(ss1), __float_as_uint(ss1), false, false);
                ss0 = __uint_as_float(r0[0]) + __uint_as_float(r0[1]); ss1 = __uint_as_float(r1[0]) + __uint_as_float(r1[1]); }
              if (g == 0) { nrm[(n & 1) * 256 + w * 32 + c16] = ss0; nrm[(n & 1) * 256 + w * 32 + 16 + c16] = ss1; } }
            if (n > 0) HG_FINAL(n - 1, pn);
            oprev[0] = o[0]; oprev[1] = o[1]; gprev[0] = gcur[0]; gprev[1] = gcur[1];
        }
        asm volatile("s_waitcnt vmcnt(0) lgkmcnt(0)\n\ts_barrier" ::: "memory");
        { float pn[2][8];
#pragma unroll
            for (int tt = 0; tt < 2; ++tt)
#pragma unroll
                for (int ww = 0; ww < 8; ++ww) pn[tt][ww] = nrm[((NSTEP - 1) & 1) * 256 + ww * 32 + 16 * tt + c16];
            HG_FINAL(NSTEP - 1, pn); }
        asm volatile("s_waitcnt vmcnt(0) lgkmcnt(0)\n\ts_barrier" ::: "memory");
#undef RO
#undef KO
#undef HG_LOADQ
#undef HG_FINAL
#undef HG_ISSUE
    }
}

struct Args { const float* in[8]; float* out; unsigned char* ws; int ph_lo, ph_hi, li, pad; };
__global__ void __launch_bounds__(NWAVES * 64, 2) fwd(Args args) {
    extern __shared__ __attribute__((aligned(16))) unsigned char lds[];
    Frame F;
    F.lds = (LAS unsigned char*)lds;
    F.MISC = (volatile LAS unsigned*)(F.lds + MISC_OFF);
    F.G = gridDim.x; { const int bx = blockIdx.x; F.vcu = (F.G % 8 == 0) ? (bx % 8) * (F.G / 8) + bx / 8 : bx; }
    unsigned char* ws = args.ws;
    F.ctl = (gu32*)(ws + WS_CTL);
    F.x = args.in[0]; F.norm_w = args.in[1]; F.w_in = args.in[2]; F.lb_logits = args.in[3]; F.hg_norm_w = args.in[4]; F.q_norm_w = args.in[5]; F.k_norm_w = args.in[6]; F.w_out = args.in[7];
    F.out = args.out;
    F.WIN = (bf16*)(ws + WS_WIN); F.WOUT = (bf16*)(ws + WS_WOUT); F.XB = (bf16*)(ws + WS_XB); F.MIXED = (bf16*)(ws + WS_MIXED);
    F.QI = (bf16*)(ws + WS_ARR); F.KT = (bf16*)(ws + WS_ARR + ARR_BYTES); F.HI = (bf16*)(ws + WS_ARR + 2 * ARR_BYTES); F.GH = (bf16*)(ws + WS_ARR + 3 * ARR_BYTES);
    F.QN = (bf16*)(ws + WS_ARR + 4 * ARR_BYTES); F.KN = (bf16*)(ws + WS_ARR + 5 * ARR_BYTES); F.V = (bf16*)(ws + WS_ARR + 6 * ARR_BYTES); F.GA = (bf16*)(ws + WS_ARR + 7 * ARR_BYTES);
    F.LB = (float*)(ws + WS_LB); F.KPART = (float*)(ws + WS_KPART); F.ROWSS = (float*)(ws + WS_ROWSS); F.DEC = (float*)(ws + WS_DEC);
    F.wave0 = __builtin_amdgcn_readfirstlane((int)threadIdx.x >> 6);
    for (int u = F.wave0 * 64 + lane_id_asm(); u < (LDS_BYTES - LDSCTL_OFF) / 4; u += NWAVES * 64) ((LAS unsigned*)(F.lds + LDSCTL_OFF))[u] = 0u;
    __syncthreads();
    XcdBarrier bar; bar.bar = (unsigned*)(F.ctl + CW_BAR); bar.x = 0; bar.st = nullptr; bar.wave0 = F.wave0;
    if (N_LAUNCHES == 1) bar = xcd_barrier_post((unsigned*)(F.ctl + CW_BAR), F.MISC + 8, F.wave0);
#define GRID_BAR() do { if (N_LAUNCHES == 1) xcd_barrier(bar); } while (0)
    const int lo = args.ph_lo, hi = args.ph_hi;
#define IN(k) (lo <= (k) && (k) < hi)
#define BOTH(k) (IN(k) && IN((k) + 1))

    if (IN(0)) { p0_prologue(F); if (BOTH(0)) GRID_BAR(); }
    for (int l = 0; l < DEPTH; ++l) {
        const int pb = 1 + 3 * l;
        if (IN(pb)) {
            pg8::Gemm g{F.XB + (size_t)l * MTOK * DM, F.WIN + (size_t)l * NIN * DM, MTOK, NIN, DM}; pg8::StaticOrder S; S.init(MTOK, NIN, F.G, (int)blockIdx.x);
            pg8::EpiFused E{F.QI, F.DEC, F.KPART, F.ROWSS + (size_t)l * MTOK * 16, F.LB + l * 512, F.q_norm_w + l * 64, F.k_norm_w + l * 64};
            for (int rp = 0; rp < REP_PROJ; ++rp) { if (rp) GRID_BAR(); pg8::gemm_phase<pg8::EpiFused, pg8::StaticOrder, true, true>(F.lds + RING_OFF, g, S, E, F.wave0); }
            if (BOTH(pb)) GRID_BAR();
        }
        if (IN(pb + 1)) {
            for (int rp = 0; rp < REP_HGRN; ++rp) { if (rp) GRID_BAR(); hgrn_mfma_phase(F, l); }
            for (int rp = 0; rp < REP_MOBA; ++rp) { if (rp) { GRID_BAR(); if (blockIdx.x == 0 && F.wave0 == 0 && lane_id_asm() == 0) __hip_atomic_store(F.ctl + CW_QUEUE + 64 * l, 0u, RLX_AGENT); GRID_BAR(); } moba_mfma_phase(F, l); }
            if (BOTH(pb + 1)) GRID_BAR(); }
        if (IN(pb + 2)) {
            pg8::Gemm g{F.MIXED, F.WOUT + (size_t)l * DM * DM, MTOK, DM, DM}; pg8::StaticOrder S; S.init(MTOK, DM, F.G, (int)blockIdx.x);
            pg8::EpiOut E{l == 0 ? F.x : nullptr, F.XB + (size_t)MTOK * DM, l == 0 ? nullptr : F.out, l == 0 ? F.XB + (size_t)MTOK * DM : nullptr, l == 0 ? F.ROWSS + (size_t)MTOK * 16 : nullptr};
            for (int rp = 0; rp < REP_OUT; ++rp) { if (rp) GRID_BAR(); pg8::gemm_phase<pg8::EpiOut, pg8::StaticOrder, true, true>(F.lds + RING_OFF, g, S, E, F.wave0); }
            if (pb + 2 < N_PHASES - 1 && BOTH(pb + 2)) GRID_BAR();
        }
    }
#undef IN
#undef BOTH
}

extern "C" void kernel_launch(void* const* d_in, const int* in_sizes, int n_in, void* d_out, int out_size, void* d_ws, size_t ws_size, hipStream_t stream) {
    static int grid = 0;
    if (grid == 0) {
        if (n_in != 8 || in_sizes[0] != MTOK * DM || out_size != MTOK * DM || ws_size < WS_END) { fprintf(stderr, "kernel_launch: unexpected shapes n_in %d in0 %d out %d ws %zu\n", n_in, n_in > 0 ? in_sizes[0] : -1, out_size, ws_size); grid = -1; return; }
        int dev = 0, cus = 0, per_cu = 0;
        if (hipGetDevice(&dev) != hipSuccess || hipDeviceGetAttribute(&cus, hipDeviceAttributeMultiprocessorCount, dev) != hipSuccess) { grid = -1; return; }
        if (hipFuncSetAttribute((const void*)fwd, hipFuncAttributeMaxDynamicSharedMemorySize, LDS_BYTES) != hipSuccess) { fprintf(stderr, "kernel_launch: hipFuncSetAttribute failed\n"); grid = -1; return; }
        if (hipOccupancyMaxActiveBlocksPerMultiprocessor(&per_cu, (const void*)fwd, NWAVES * 64, LDS_BYTES) != hipSuccess || per_cu < 1) fprintf(stderr, "kernel_launch: occupancy query says %d\n", per_cu);
        (void)hipGetLastError();
        if (per_cu < 1) { grid = -1; return; }
        grid = cus;
    }
    if (grid < 0) return;
    if (hipMemsetAsync((char*)d_ws + WS_CTL, 0, CTL_ZERO_BYTES, stream) != hipSuccess) return;
    Args a{};
    for (int i = 0; i < 8; ++i) a.in[i] = (const float*)d_in[i];
    a.out = (float*)d_out; a.ws = (unsigned char*)d_ws;
    for (int li = 0; li < N_LAUNCHES; ++li) {
        a.ph_lo = (N_LAUNCHES == 1) ? 0 : li; a.ph_hi = (N_LAUNCHES == 1) ? N_PHASES : li + 1; a.li = li;
        hipError_t le;
        if (N_LAUNCHES == 1) { void* kargs[] = {(void*)&a}; le = hipLaunchCooperativeKernel((const void*)fwd, dim3(grid), dim3(NWAVES * 64), kargs, LDS_BYTES, stream); }
        else { hipLaunchKernelGGL(fwd, dim3(grid), dim3(NWAVES * 64), LDS_BYTES, stream, a); le = hipPeekAtLastError(); }
        if (le != hipSuccess) { fprintf(stderr, "kernel_launch: launch %d failed: %s\n", li, hipGetErrorName(le)); break; }
    }
}
```

```cpp
#include <hip/hip_runtime.h>
#include <cstdio>
#include <cstdint>
__device__ __forceinline__ int lane_id_asm() { int l; asm volatile("v_mbcnt_lo_u32_b32 %0, -1, 0\n\tv_mbcnt_hi_u32_b32 %0, -1, %0" : "=v"(l)); return l; }
namespace pg8 {
#define PG8_LAS __attribute__((address_space(3)))
typedef unsigned short bf16_t;
typedef short bf16x8 __attribute__((ext_vector_type(8)));
typedef float f32x4 __attribute__((ext_vector_type(4)));
typedef unsigned u32x4 __attribute__((ext_vector_type(4)));
typedef unsigned u32x2 __attribute__((ext_vector_type(2)));
constexpr int BM = 256, BK = 64, HALF = 128, HTB = HALF * BK * 2  , STAGE_BYTES = 8 * HTB, NXCD = 8, WGM = 8;

__host__ __device__ __forceinline__ int lds_byte(int r, int c) { const int st = (r >> 4) * 2 + (c >> 5), rr = r & 15, cc = c & 31, ob = rr * 64 + cc * 2; return st * 1024 + (ob ^ (((ob >> 9) & 1) << 5)); }
__host__ __device__ __forceinline__ void stage_rc(int b, int& R, int& C) { const int st = b / 1024, sb = b % 1024, swz = sb ^ (((sb >> 9) & 1) << 5); R = (st >> 1) * 16 + swz / 64; C = (st & 1) * 32 + (swz % 64) / 2; }
__host__ __device__ __forceinline__ int perm32(int rho) { const int n = rho >> 4, i = rho & 15; return 8 * (i >> 2) + 4 * n + (i & 3); }

struct Unit { int pm, pn; };
struct Gemm { const bf16_t* A; const bf16_t* Bt; int M, N, K; };

struct StaticOrder {
    int nM, nN, nwg, G, c;
    __host__ __device__ void init(int M, int N, int G_, int c_) { nM = M / BM; nN = N / BM; nwg = nM * nN; G = G_; c = c_; }
    __host__ __device__ bool next(int i, Unit& u) const {
        const long L = (long)i * G + c; if (L >= nwg) return false;
        int wgid = (int)L; { const int q = nwg / NXCD, r = nwg % NXCD, xcd = wgid % NXCD, off = wgid / NXCD; wgid = (xcd < r ? xcd * (q + 1) : r * (q + 1) + (xcd - r) * q) + off; }
        const int nig = WGM * nN, gid = wgid / nig, fm = gid * WGM, gsz = (nM - fm) < WGM ? (nM - fm) : WGM;
        u.pm = fm + ((wgid % nig) % gsz); u.pn = (wgid % nig) / gsz; return true;
    }
    __device__ __forceinline__ void a_ready(const Unit&) const {}
    __device__ __forceinline__ void done(const Unit&) const {}
};

__device__ __forceinline__ unsigned cvt_pk_bf16(float lo, float hi) { unsigned r; asm volatile("v_cvt_pk_bf16_f32 %0, %1, %2" : "=v"(r) : "v"(lo), "v"(hi)); return r; }


__device__ __forceinline__ float dpp_row_shr(float v, int n) {
    const int x = __builtin_bit_cast(int, v);
    int r;
    if (n == 1) r = __builtin_amdgcn_update_dpp(0, x, 0x111, 0xf, 0xf, false);
    else if (n == 2) r = __builtin_amdgcn_update_dpp(0, x, 0x112, 0xf, 0xf, false);
    else if (n == 4) r = __builtin_amdgcn_update_dpp(0, x, 0x114, 0xf, 0xf, false);
    else r = __builtin_amdgcn_update_dpp(0, x, 0x118, 0xf, 0xf, false);
    return __builtin_bit_cast(float, r);
}
__device__ __forceinline__ float dpp_row_shr1(float v, int n) {
    const int x = __builtin_bit_cast(int, v); const int one = 0x3f800000;
    int r;
    if (n == 1) r = __builtin_amdgcn_update_dpp(one, x, 0x111, 0xf, 0xf, false);
    else if (n == 2) r = __builtin_amdgcn_update_dpp(one, x, 0x112, 0xf, 0xf, false);
    else if (n == 4) r = __builtin_amdgcn_update_dpp(one, x, 0x114, 0xf, 0xf, false);
    else r = __builtin_amdgcn_update_dpp(one, x, 0x118, 0xf, 0xf, false);
    return __builtin_bit_cast(float, r);
}
__device__ __forceinline__ float fsig(float z) { return __builtin_amdgcn_rcpf(1.0f + __expf(-z)); }
struct EpiFused {
    static constexpr bool PERM = true, AFTER_DRAIN = false;
    bf16_t* ARR; float* DEC; float* KPART; const float* rowss; const float* lb; const float* qg; const float* kg;
    static constexpr size_t AS = (size_t)32768 * 512;
    __device__ __forceinline__ float rstd_of(int row) const {
        const f32x4* rp = (const f32x4*)(rowss + (size_t)row * 16);
        const f32x4 a = rp[0], b = rp[1], c = rp[2], d = rp[3];
        const float ss = ((a[0] + a[1]) + (a[2] + a[3])) + ((b[0] + b[1]) + (b[2] + b[3])) + ((c[0] + c[1]) + (c[2] + c[3])) + ((d[0] + d[1]) + (d[2] + d[3]));
        return 1.0f / sqrtf(ss * (1.0f / 1024.0f) + 1e-6f);
    }
    static __device__ __forceinline__ u32x4 pack8(const float (&v)[8]) { u32x4 w; w.x = cvt_pk_bf16(v[0], v[1]); w.y = cvt_pk_bf16(v[2], v[3]); w.z = cvt_pk_bf16(v[4], v[5]); w.w = cvt_pk_bf16(v[6], v[7]); return w; }
    __device__ __forceinline__ void operator()(const f32x4 (&acc)[2][2][4][2], const Unit& u, int wr, int wc, int fr, int fq) const {
        const int row0 = u.pm * BM + wr * 64 + fr; const int pn = u.pn;
        if (pn < 4) {
            const int cb = pn * 128 + wc * 32 + 8 * fq;
            float lbv[8];
#pragma unroll
            for (int k = 0; k < 8; ++k) lbv[k] = lb[cb + k];
#pragma unroll
            for (int ai = 0; ai < 2; ++ai)
#pragma unroll
                for (int mp = 0; mp < 2; ++mp) { const int row1 = row0 + ai * HALF + mp * 32, row2 = row1 + 16; const float rs1 = rstd_of(row1), rs2 = rstd_of(row2);
                    float qi1[8], kt1[8], qi2[8], kt2[8], dc[8];
#pragma unroll
                    for (int k = 0; k < 8; ++k) {
                        const float zq1 = acc[ai][0][2 * mp][k >> 2][k & 3] * rs1, zf1 = acc[ai][1][2 * mp][k >> 2][k & 3] * rs1;
                        const float zq2 = acc[ai][0][2 * mp + 1][k >> 2][k & 3] * rs2, zf2 = acc[ai][1][2 * mp + 1][k >> 2][k & 3] * rs2;
                        const float f1 = lbv[k] + (1.0f - lbv[k]) * fsig(zf1), f2 = lbv[k] + (1.0f - lbv[k]) * fsig(zf2);
                        float e1 = f1, e2 = f2;
                        e1 *= dpp_row_shr1(e1, 1); e2 *= dpp_row_shr1(e2, 1); e1 *= dpp_row_shr1(e1, 2); e2 *= dpp_row_shr1(e2, 2);
                        e1 *= dpp_row_shr1(e1, 4); e2 *= dpp_row_shr1(e2, 4); e1 *= dpp_row_shr1(e1, 8); e2 *= dpp_row_shr1(e2, 8);
                        e2 *= __shfl(e1, (fq << 4) | 15);
                        qi1[k] = zq1 * fsig(zq1) * e1; kt1[k] = (1.0f - f1) * fminf(__builtin_amdgcn_rcpf(e1), 5.5406224e34f);
                        qi2[k] = zq2 * fsig(zq2) * e2; kt2[k] = (1.0f - f2) * fminf(__builtin_amdgcn_rcpf(e2), 5.5406224e34f); dc[k] = e2; }
                    { const int pc = pn * 128 + wc * 32 + 16 * (fq & 1) + 4 * (fq >> 1);
                      const u32x4 a1 = pack8(qi1), b1 = pack8(kt1), a2 = pack8(qi2), b2 = pack8(kt2);
                      bf16_t* q1 = ARR + (size_t)row1 * 512 + pc; bf16_t* q2 = ARR + (size_t)row2 * 512 + pc;
                      *(u32x2*)(q1) = (u32x2){a1.x, a1.y}; *(u32x2*)(q1 + 8) = (u32x2){a1.z, a1.w}; *(u32x2*)(q1 + AS) = (u32x2){b1.x, b1.y}; *(u32x2*)(q1 + AS + 8) = (u32x2){b1.z, b1.w};
                      *(u32x2*)(q2) = (u32x2){a2.x, a2.y}; *(u32x2*)(q2 + 8) = (u32x2){a2.z, a2.w}; *(u32x2*)(q2 + AS) = (u32x2){b2.x, b2.y}; *(u32x2*)(q2 + AS + 8) = (u32x2){b2.z, b2.w}; }
                    if (fr == 15) { float* dp = DEC + (size_t)(row1 >> 5) * 512 + cb; *(f32x4*)dp = (f32x4){dc[0], dc[1], dc[2], dc[3]}; *(f32x4*)(dp + 4) = (f32x4){dc[4], dc[5], dc[6], dc[7]}; }
                    asm volatile("" ::: "memory"); }
        } else if (pn < 8) {
            const int cb = (pn - 4) * 128 + wc * 32 + 8 * fq;
#pragma unroll
            for (int ai = 0; ai < 2; ++ai)
#pragma unroll
                for (int m = 0; m < 4; ++m) { const int row = row0 + ai * HALF + m * 16; const float rs = rstd_of(row);
                    float iv[8], gv[8];
#pragma unroll
                    for (int k = 0; k < 8; ++k) { iv[k] = acc[ai][0][m][k >> 2][k & 3] * rs; const float zg = acc[ai][1][m][k >> 2][k & 3] * rs; gv[k] = zg * fsig(zg); }
                    *(u32x4*)(ARR + 2 * AS + (size_t)row * 512 + cb) = pack8(iv); *(u32x4*)(ARR + 3 * AS + (size_t)row * 512 + cb) = pack8(gv);
                    asm volatile("" ::: "memory"); }
        } else {
            const int ty = (pn - 8) >> 1, head = 4 * ((pn - 8) & 1) + wc; const int d0 = 8 * fq;
            bf16_t* dst = ARR + (size_t)(4 + ty) * AS;
            float gain[2][8]; float csum[2][8];
#pragma unroll
            for (int bj = 0; bj < 2; ++bj)
#pragma unroll
                for (int k = 0; k < 8; ++k) { gain[bj][k] = (ty == 0) ? qg[bj * 32 + d0 + k] * (0.125f * 1.4426950408889634f) : (ty == 1) ? kg[bj * 32 + d0 + k] : 1.0f; csum[bj][k] = 0.f; }
#pragma unroll
            for (int ai = 0; ai < 2; ++ai)
#pragma unroll
                for (int m = 0; m < 4; ++m) { const int row = row0 + ai * HALF + m * 16; const float rs = rstd_of(row);
                    float v[2][8];
#pragma unroll
                    for (int bj = 0; bj < 2; ++bj)
#pragma unroll
                        for (int k = 0; k < 8; ++k) v[bj][k] = acc[ai][bj][m][k >> 2][k & 3] * rs;
                    if (ty < 2) { float ss = 0.f;
#pragma unroll
                        for (int bj = 0; bj < 2; ++bj)
#pragma unroll
                            for (int k = 0; k < 8; ++k) ss += v[bj][k] * v[bj][k];
                        ss += __shfl_xor(ss, 16); ss += __shfl_xor(ss, 32);
                        const float r2 = 1.0f / sqrtf(ss * (1.0f / 64.0f) + 1e-6f);
#pragma unroll
                        for (int bj = 0; bj < 2; ++bj)
#pragma unroll
                            for (int k = 0; k < 8; ++k) { v[bj][k] *= r2 * gain[bj][k]; csum[bj][k] += v[bj][k]; }
                    } else if (ty == 3) {
#pragma unroll
                        for (int bj = 0; bj < 2; ++bj)
#pragma unroll
                            for (int k = 0; k < 8; ++k) v[bj][k] = v[bj][k] * fsig(v[bj][k]); }
                    *(u32x4*)(dst + (size_t)row * 512 + head * 64 + d0) = pack8(v[0]); *(u32x4*)(dst + (size_t)row * 512 + head * 64 + 32 + d0) = pack8(v[1]);
                    asm volatile("" ::: "memory"); }
            if (ty == 1) {
#pragma unroll
                for (int bj = 0; bj < 2; ++bj)
#pragma unroll
                    for (int k = 0; k < 8; ++k) { float s = csum[bj][k]; s += __shfl_xor(s, 1); s += __shfl_xor(s, 2); s += __shfl_xor(s, 4); s += __shfl_xor(s, 8); csum[bj][k] = s; }
                if (fr == 0) { float* kp = KPART + ((size_t)u.pm * 2 + wr) * 512 + head * 64 + d0;
#pragma unroll
                    for (int bj = 0; bj < 2; ++bj) { *(f32x4*)(kp + bj * 32) = (f32x4){csum[bj][0], csum[bj][1], csum[bj][2], csum[bj][3]}; *(f32x4*)(kp + bj * 32 + 4) = (f32x4){csum[bj][4], csum[bj][5], csum[bj][6], csum[bj][7]}; } }
            }
        }
    }
};
struct EpiOut {
    static constexpr bool PERM = false, AFTER_DRAIN = false;
    const float* xres; const bf16_t* xres16; float* out; bf16_t* xb; float* rowss;
    __device__ __forceinline__ void operator()(const f32x4 (&acc)[2][2][4][2], const Unit& u, int wr, int wc, int fr, int fq) const {
        const int col0 = u.pn * BM + wc * 32 + 4 * fq;
#pragma unroll
        for (int ai = 0; ai < 2; ++ai)
#pragma unroll
            for (int m = 0; m < 4; ++m) {
                const int row = u.pm * BM + ai * HALF + wr * 64 + m * 16 + fr; float ss = 0.f;
#pragma unroll
                for (int bj = 0; bj < 2; ++bj)
#pragma unroll
                    for (int n = 0; n < 2; ++n) { const size_t off = (size_t)row * 1024 + col0 + bj * HALF + n * 16;
                        f32x4 v;
                        if (xres) v = *(const f32x4*)(xres + off); else { const u32x2 r = *(const u32x2*)(xres16 + off); v = (f32x4){__builtin_bit_cast(float, r.x << 16), __builtin_bit_cast(float, r.x & 0xffff0000u), __builtin_bit_cast(float, r.y << 16), __builtin_bit_cast(float, r.y & 0xffff0000u)}; }
                        v = v + acc[ai][bj][m][n];
                        if (out) *(f32x4*)(out + off) = v;
                        if (xb) { u32x2 w; w.x = cvt_pk_bf16(v[0], v[1]); w.y = cvt_pk_bf16(v[2], v[3]); *(u32x2*)(xb + off) = w; }
                        ss += (v[0] * v[0] + v[1] * v[1]) + (v[2] * v[2] + v[3] * v[3]); }
                ss += __shfl_xor(ss, 16); ss += __shfl_xor(ss, 32);
                if (fq == 0 && rowss) rowss[(size_t)row * 16 + u.pn * 4 + wc] = ss;
            }
    }
};

template <class Epi, class Sched, bool ALIGN_EPI = false, bool SP2 = false>
__device__ __forceinline__ void gemm_phase(PG8_LAS unsigned char* lds, const Gemm g, const Sched& S, const Epi& E, const int wave0) {
    int tid = wave0 * 64 + lane_id_asm(); asm volatile("" : "+v"(tid));
    const int wid = __builtin_amdgcn_readfirstlane(tid >> 6), lane = tid & 63, wr = wid >> 2, wc = wid & 3, fr = lane & 15, fq = lane >> 4;
    const int K = g.K, nt = K / BK;
    unsigned voffA[2], voffB[2];
#pragma unroll
    for (int i = 0; i < 2; ++i) { int R, C; stage_rc(tid * 16 + i * 8192, R, C); const int Rb = Epi::PERM ? ((R & ~31) + perm32(R & 31)) : R;
        voffA[i] = (unsigned)(R * K + C) * 2u; voffB[i] = (unsigned)(Rb * K + C) * 2u; }
    const size_t kstep = (size_t)(BK * 2);
    const size_t hstep = (size_t)HALF * K * 2;
    const size_t tstep = 2 * hstep;
    const unsigned ldsw = (unsigned)wid * 1024u;
    const int aoff = lds_byte(wr * 64 + fr, fq * 8), boff = lds_byte(wc * 32 + fr, fq * 8);
#define PG8_SA(b, h) (((b) * 2 + (h)) * HTB)
#define PG8_SB(b, h) ((4 + (b) * 2 + (h)) * HTB)
#define PG8_STAGE(bufoff, gbase, voff) do { _Pragma("unroll") for (int _i = 0; _i < 2; ++_i) \
        __builtin_amdgcn_global_load_lds((const unsigned*)((const char*)(gbase) + (voff)[_i]), (PG8_LAS unsigned*)(lds + (bufoff) + ldsw + _i * 8192), 16, 0, 0); } while (0)
#define PG8_LDA(dst, b, h) do { _Pragma("unroll") for (int m = 0; m < 4; ++m) _Pragma("unroll") for (int k = 0; k < 2; ++k) dst[m][k] = *(const PG8_LAS bf16x8*)(lds + PG8_SA(b, h) + aoff + m * 2048 + k * 1024); } while (0)
#define PG8_LDB(dst, b, h) do { _Pragma("unroll") for (int n = 0; n < 2; ++n) _Pragma("unroll") for (int k = 0; k < 2; ++k) dst[n][k] = *(const PG8_LAS bf16x8*)(lds + PG8_SB(b, h) + boff + n * 2048 + k * 1024); } while (0)
#define PG8_MMA(ai, bj, At, Bt) do { __builtin_amdgcn_s_setprio(1); _Pragma("unroll") for (int m = 0; m < 4; ++m) _Pragma("unroll") for (int n = 0; n < 2; ++n) _Pragma("unroll") for (int k = 0; k < 2; ++k) \
        acc[ai][bj][m][n] = __builtin_amdgcn_mfma_f32_16x16x32_bf16(Bt[n][k], At[m][k], acc[ai][bj][m][n], 0, 0, 0); __builtin_amdgcn_s_setprio(0); } while (0)
#define PG8_WAIT_V(n) asm volatile("s_waitcnt vmcnt(" #n ")" ::: "memory")
#define PG8_WAIT_L(n) asm volatile("s_waitcnt lgkmcnt(" #n ")" ::: "memory")
#define PG8_BAR __builtin_amdgcn_s_barrier()
#define PG8_SCHED __builtin_amdgcn_sched_barrier(0)
    Unit cur, nxt; int ui = 0;
    if (!S.next(0, cur)) return;
    f32x4 acc[2][2][4][2];
#pragma unroll
    for (int a = 0; a < 2; ++a)
#pragma unroll
        for (int b = 0; b < 2; ++b)
#pragma unroll
            for (int m = 0; m < 4; ++m)
#pragma unroll
                for (int n = 0; n < 2; ++n) acc[a][b][m][n] = (f32x4){0.f, 0.f, 0.f, 0.f};
    bf16x8 At[4][2], B0[2][2], B1[2][2];
    const char* cA = (const char*)g.A + (size_t)cur.pm * tstep; const char* cB = (const char*)g.Bt + (size_t)cur.pn * tstep;
    S.a_ready(cur);
    if constexpr (SP2) {
        PG8_STAGE(PG8_SB(0, 0), cB, voffB); PG8_STAGE(PG8_SB(0, 1), cB + hstep, voffB); PG8_STAGE(PG8_SA(0, 0), cA, voffA); PG8_STAGE(PG8_SA(0, 1), cA + hstep, voffA);
        if (wr == 1) PG8_BAR;
        PG8_WAIT_V(2); PG8_BAR;
        PG8_STAGE(PG8_SB(1, 0), cB + kstep, voffB); PG8_STAGE(PG8_SA(1, 0), cA + kstep, voffA); PG8_STAGE(PG8_SB(1, 1), cB + hstep + kstep, voffB);
        PG8_WAIT_V(6); PG8_BAR;
    } else {
        PG8_STAGE(PG8_SB(0, 0), cB, voffB); PG8_STAGE(PG8_SA(0, 0), cA, voffA); PG8_STAGE(PG8_SB(0, 1), cB + hstep, voffB); PG8_STAGE(PG8_SA(0, 1), cA + hstep, voffA);
        if (wr == 1) PG8_BAR;
        PG8_WAIT_V(4); PG8_BAR;
        PG8_STAGE(PG8_SB(1, 0), cB + kstep, voffB); PG8_STAGE(PG8_SA(1, 0), cA + kstep, voffA); PG8_STAGE(PG8_SB(1, 1), cB + hstep + kstep, voffB);
        PG8_WAIT_V(6); PG8_BAR;
    }
    for (;;) {
        const bool has_next = S.next(ui + 1, nxt);
        const char* nA = has_next ? (const char*)g.A + (size_t)nxt.pm * tstep : cA; const char* nB = has_next ? (const char*)g.Bt + (size_t)nxt.pn * tstep : cB;
        for (int t = 0; t < nt; t += 2) {
            const bool last = (t == nt - 2);
            const char* a1 = cA + (size_t)(t + 1) * kstep;
            const char* a2 = last ? nA : cA + (size_t)(t + 2) * kstep; const char* b2 = last ? nB : cB + (size_t)(t + 2) * kstep;
            const char* a3 = a2 + kstep; const char* b3 = b2 + kstep;
            if (last && has_next) S.a_ready(nxt);
            if constexpr (SP2) {
            PG8_LDB(B0, 0, 0); PG8_LDB(B1, 0, 1); PG8_SCHED; PG8_LDA(At, 0, 0); PG8_STAGE(PG8_SA(1, 1), a1 + hstep, voffA);
            PG8_WAIT_V(8); PG8_WAIT_L(0); PG8_BAR; PG8_MMA(0, 0, At, B0); PG8_MMA(0, 1, At, B1); PG8_BAR; PG8_SCHED;
            PG8_LDA(At, 0, 1); PG8_STAGE(PG8_SB(0, 0), b2, voffB); PG8_STAGE(PG8_SB(0, 1), b2 + hstep, voffB); PG8_STAGE(PG8_SA(0, 0), a2, voffA);
            PG8_WAIT_V(8); PG8_WAIT_L(0); PG8_BAR; PG8_MMA(1, 0, At, B0); PG8_MMA(1, 1, At, B1); PG8_BAR; PG8_SCHED;
            PG8_LDB(B0, 1, 0); PG8_LDB(B1, 1, 1); PG8_SCHED; PG8_LDA(At, 1, 0); PG8_STAGE(PG8_SA(0, 1), a2 + hstep, voffA);
            PG8_WAIT_V(8); PG8_WAIT_L(0); PG8_BAR; PG8_MMA(0, 0, At, B0); PG8_MMA(0, 1, At, B1); PG8_BAR; PG8_SCHED;
            PG8_LDA(At, 1, 1); PG8_STAGE(PG8_SB(1, 0), b3, voffB); PG8_STAGE(PG8_SB(1, 1), b3 + hstep, voffB); PG8_STAGE(PG8_SA(1, 0), a3, voffA);
            PG8_WAIT_V(8); PG8_WAIT_L(0); PG8_BAR; PG8_MMA(1, 0, At, B0); PG8_MMA(1, 1, At, B1); PG8_BAR; PG8_SCHED;
            } else {
            PG8_LDB(B0, 0, 0); PG8_SCHED; PG8_LDA(At, 0, 0); PG8_STAGE(PG8_SA(1, 1), a1 + hstep, voffA);
            PG8_WAIT_L(8); PG8_BAR; PG8_WAIT_L(0); PG8_MMA(0, 0, At, B0); PG8_BAR; PG8_SCHED;
            PG8_LDB(B1, 0, 1); PG8_STAGE(PG8_SB(0, 0), b2, voffB);
            PG8_BAR; PG8_WAIT_L(0); PG8_MMA(0, 1, At, B1); PG8_BAR;
            PG8_LDA(At, 0, 1); PG8_STAGE(PG8_SA(0, 0), a2, voffA);
            PG8_BAR; PG8_WAIT_L(0); PG8_MMA(1, 0, At, B0); PG8_BAR; PG8_SCHED;
            PG8_STAGE(PG8_SB(0, 1), b2 + hstep, voffB);
            PG8_WAIT_V(6); PG8_BAR; PG8_MMA(1, 1, At, B1); PG8_BAR;
            PG8_LDB(B0, 1, 0); PG8_SCHED; PG8_LDA(At, 1, 0); PG8_STAGE(PG8_SA(0, 1), a2 + hstep, voffA);
            PG8_WAIT_L(8); PG8_BAR; PG8_WAIT_L(0); PG8_MMA(0, 0, At, B0); PG8_BAR; PG8_SCHED;
            PG8_LDB(B1, 1, 1); PG8_STAGE(PG8_SB(1, 0), b3, voffB);
            PG8_BAR; PG8_WAIT_L(0); PG8_MMA(0, 1, At, B1); PG8_BAR;
            PG8_LDA(At, 1, 1); PG8_STAGE(PG8_SA(1, 0), a3, voffA);
            PG8_BAR; PG8_WAIT_L(0); PG8_MMA(1, 0, At, B0); PG8_BAR; PG8_SCHED;
            PG8_STAGE(PG8_SB(1, 1), b3 + hstep, voffB);
            PG8_WAIT_V(6); PG8_BAR; PG8_MMA(1, 1, At, B1); PG8_BAR;
            }
        }
        if constexpr (ALIGN_EPI) { if (wr == 0) PG8_BAR; }
        if constexpr (!Epi::AFTER_DRAIN) { E(acc, cur, wr, wc, fr, fq); S.done(cur); }
        if (!has_next) break;
#pragma unroll
        for (int a = 0; a < 2; ++a)
#pragma unroll
            for (int b = 0; b < 2; ++b)
#pragma unroll
                for (int m = 0; m < 4; ++m)
#pragma unroll
                    for (int n = 0; n < 2; ++n) acc[a][b][m][n] = (f32x4){0.f, 0.f, 0.f, 0.f};
        cur = nxt; cA = nA; cB = nB; ++ui;
        if constexpr (ALIGN_EPI) { if (wr == 1) PG8_BAR; }
    }
    PG8_WAIT_V(0);
    if constexpr (!ALIGN_EPI) { if (wr == 0) PG8_BAR; }
    PG8_BAR;
    if constexpr (Epi::AFTER_DRAIN) { E.fused(acc, cur, wr, wc, fr, fq, lds, wid, lane); S.done(cur); }
#undef PG8_SA
#undef PG8_SB
#undef PG8_STAGE
#undef PG8_LDA
#undef PG8_LDB
#undef PG8_MMA
#undef PG8_WAIT_V
#undef PG8_WAIT_L
#undef PG8_BAR
#undef PG8_SCHED
}
}


constexpr int NWAVES = 8;
#ifndef REP_PROJ
#define REP_PROJ 1
#endif
#ifndef REP_HGRN
#define REP_HGRN 1
#endif
#ifndef REP_MOBA
#define REP_MOBA 1
#endif
#ifndef REP_OUT
#define REP_OUT 1
#endif
#ifndef MK_N_LAUNCHES
#define MK_N_LAUNCHES 1
#endif
constexpr int N_PHASES = 7;
constexpr int N_LAUNCHES = MK_N_LAUNCHES;

constexpr int BATCH = 16, SEQ = 2048, DM = 1024, DEPTH = 2, MTOK = BATCH * SEQ, NIN = 4096;
constexpr int C_HQ = 0, C_HF = 512, C_HI = 1024, C_HG = 1536, C_AQ = 2048, C_AK = 2560, C_AV = 3072, C_AG = 3584;
constexpr float NORM_EPS = 1e-6f;

constexpr size_t MiB = 1u << 20;
constexpr size_t WS_CTL = 0, CTL_ZERO_BYTES = 1 * MiB;
constexpr size_t WS_WIN = 2 * MiB;
constexpr size_t WS_WOUT = 18 * MiB;
constexpr size_t WS_LB = 22 * MiB;
constexpr size_t WS_KPART = 22 * MiB + 65536;
constexpr size_t WS_ROWSS = 24 * MiB;
constexpr size_t WS_DEC = 28 * MiB;
constexpr size_t WS_XB = 32 * MiB;
constexpr size_t WS_MIXED = 160 * MiB;
constexpr size_t WS_ARR = 224 * MiB;
constexpr size_t ARR_BYTES = 32 * MiB;
constexpr size_t WS_END = 480 * MiB;
constexpr int CW_QUEUE = 1024;
constexpr int CW_BAR = 4096;

constexpr int RING_OFF = 0, RING_BYTES = 131072;
constexpr int EXTRA_OFF = RING_BYTES, EXTRA_BYTES = 16384;
constexpr int LDSCTL_OFF = EXTRA_OFF + EXTRA_BYTES, MISC_OFF = LDSCTL_OFF + 320;
constexpr int LDS_BYTES = LDSCTL_OFF + 1024;

#define GAS __attribute__((address_space(1)))
#define LAS __attribute__((address_space(3)))
typedef unsigned short bf16;
typedef unsigned v4u __attribute__((ext_vector_type(4)));
typedef float f32x4 __attribute__((ext_vector_type(4)));
typedef GAS unsigned gu32;
#define RLX_AGENT __ATOMIC_RELAXED, __HIP_MEMORY_SCOPE_AGENT
#define LDS_WAIT() asm volatile("s_waitcnt lgkmcnt(0)" ::: "memory")
#define VM_WAIT() asm volatile("s_waitcnt vmcnt(0)" ::: "memory")
__device__ __forceinline__ unsigned f2bf(float f) { unsigned u = __builtin_bit_cast(unsigned, f); return (u + 0x7fffu + ((u >> 16) & 1u)) >> 16; }
__device__ __forceinline__ unsigned pk2(float lo, float hi) { return f2bf(lo) | (f2bf(hi) << 16); }
__device__ __forceinline__ float bf2f(unsigned short b) { return __builtin_bit_cast(float, (unsigned)b << 16); }
__device__ __forceinline__ float bflo(unsigned w) { return __builtin_bit_cast(float, w << 16); }
__device__ __forceinline__ float bfhi(unsigned w) { return __builtin_bit_cast(float, w & 0xffff0000u); }
__device__ __forceinline__ float silu_f(float z) { return z / (1.0f + __expf(-z)); }
__device__ __forceinline__ float sigmoid_f(float z) { return 1.0f / (1.0f + __expf(-z)); }

#define XB_TMO      128
#define XB_XCNT(j)  (256  + 64 * (j))
#define XB_XSUB(j)  (1280 + 64 * (j))
#define XB_XGEN(j)  (2304 + 64 * (j))
#define XB_TOP      3328
#define XB_TOPGEN   3392
#define XCD_BAR_WORDS 3456
#define XB_SPIN_CAP (1u << 18)

__device__ __forceinline__ unsigned xb_ld(unsigned* p)              { return __hip_atomic_load(p, __ATOMIC_RELAXED, __HIP_MEMORY_SCOPE_AGENT); }
__device__ __forceinline__ unsigned xb_add(unsigned* p, unsigned v) { return __hip_atomic_fetch_add(p, v, __ATOMIC_RELAXED, __HIP_MEMORY_SCOPE_AGENT); }
__device__ __forceinline__ unsigned xb_xcc_id() { return (unsigned)__builtin_amdgcn_s_getreg((3 << 11) | 20) & 0xFu; }
#define XB_SPIN(cond, bar) do { unsigned _sp = 0; while (cond) { __builtin_amdgcn_s_sleep(1); \
    if ((++_sp & 255u) == 0u) { if (xb_ld(&(bar)[XB_TMO])) break; if (_sp > XB_SPIN_CAP) { atomicAdd(&(bar)[XB_TMO], 1u); break; } } } } while (0)

struct XcdBarrier {
    unsigned* bar; unsigned x; int wave0;
    volatile LAS unsigned* st;
};

#define XB_IS_T0(wv) ((wv) == 0 && lane_id_asm() == 0)
__device__ __forceinline__ XcdBarrier xcd_barrier_post(unsigned* bar, volatile LAS unsigned* st, int wave0) {
    XcdBarrier b; b.bar = bar; b.x = xb_xcc_id(); b.st = st; b.wave0 = wave0;
    if (XB_IS_T0(wave0)) (void)xb_add(&bar[XB_XCNT(b.x)], 1u);
    return b;
}
__device__ __forceinline__ void xcd_barrier_complete(unsigned* bar, unsigned x, unsigned& nloc, unsigned& nx) {
    const unsigned G = gridDim.x * gridDim.y * gridDim.z;
    unsigned sum, cnt, mine, sp = 0u;
    for (;;) {
        sum = 0u; cnt = 0u; mine = 0u;
#pragma unroll
        for (unsigned j = 0; j < 16; ++j) { const unsigned c = xb_ld(&bar[XB_XCNT(j)]); sum += c; cnt += (c > 0u) ? 1u : 0u; mine = (j == x) ? c : mine; }
        if (sum == G) break;
        __builtin_amdgcn_s_sleep(1);
        if ((++sp & 255u) == 0u) { if (xb_ld(&bar[XB_TMO])) break; if (sp > XB_SPIN_CAP) { atomicAdd(&bar[XB_TMO], 1u); break; } }
    }
    nloc = mine > 0u ? mine : 1u; nx = cnt > 0u ? cnt : 1u;
}

__device__ __forceinline__ void xcd_barrier(const XcdBarrier& b) {
    asm volatile("s_waitcnt vmcnt(0)" ::: "memory");
    __syncthreads();
    if (XB_IS_T0(b.wave0)) {
        unsigned* bar = b.bar;
        __builtin_amdgcn_s_waitcnt(0);
        unsigned nloc = b.st[0], nx = b.st[1];
        if (nloc == 0u) { xcd_barrier_complete(bar, b.x, nloc, nx); b.st[0] = nloc; b.st[1] = nx; }
        const unsigned old = xb_add(&bar[XB_XSUB(b.x)], 1u);
        const unsigned gen = old / nloc;
        if (old + 1u == (gen + 1u) * nloc) {
            __builtin_amdgcn_fence(__ATOMIC_RELEASE, "agent");
            asm volatile("s_waitcnt vmcnt(0)" ::: "memory");
            const unsigned og = xb_add(&bar[XB_TOP], 1u);
            const unsigned tg = og / nx;
            if (og + 1u == (tg + 1u) * nx) xb_add(&bar[XB_TOPGEN], 1u);
            else XB_SPIN(xb_ld(&bar[XB_TOPGEN]) == tg, bar);
            __builtin_amdgcn_fence(__ATOMIC_ACQUIRE, "agent");
            xb_add(&bar[XB_XGEN(b.x)], 1u);
            asm volatile("s_waitcnt vmcnt(0)" ::: "memory");
        } else {
            XB_SPIN(xb_ld(&bar[XB_XGEN(b.x)]) == gen, bar);
            __builtin_amdgcn_fence(__ATOMIC_ACQUIRE, "agent");
            asm volatile("s_waitcnt vmcnt(0)" ::: "memory");
        }
    }
    __syncthreads();
}


struct Frame {
    LAS unsigned char* lds;
    volatile LAS unsigned* MISC;
    int wave0;
    gu32* ctl;
    int vcu, G;
    const float* x; float* out;
    const float *norm_w, *w_in, *lb_logits, *hg_norm_w, *q_norm_w, *k_norm_w, *w_out;
    bf16 *WIN, *WOUT, *XB, *MIXED, *QI, *KT, *HI, *GH, *QN, *KN, *V, *GA;
    float *LB, *KPART, *ROWSS, *DEC;
};

__device__ __forceinline__ float wave_sum(float v) {
#pragma unroll
    for (int o = 1; o < 64; o <<= 1) v += __shfl_xor(v, o);
    return v;
}
__device__ __forceinline__ int win_dest(int oc) {
    if (oc < 2048) { const int grp = oc >> 9, hh = (oc >> 7) & 3, w = oc & 127; return 256 * (((grp >> 1) << 2) + hh) + 128 * (grp & 1) + w; }
    const int ty = (oc - 2048) >> 9, head = (oc >> 6) & 7, bj = (oc >> 5) & 1; return 256 * (8 + 2 * ty + (head >> 2)) + 128 * bj + 32 * (head & 3);
}
__device__ __forceinline__ void p0_transpose_item(const float* W, int K, int N, bf16* WT, const float* kscale, LAS float* scr, int item, int lane, bool permute) {
    const int nblk = N / 32, kb = item / nblk, nb = item % nblk, k0 = 64 * kb, n0 = 32 * nb; const int nd = permute ? win_dest(n0) : n0;
    float wv_[32];
#pragma unroll
    for (int i = 0; i < 32; ++i) wv_[i] = W[(size_t)(k0 + 2 * i + (lane >> 5)) * N + n0 + (lane & 31)];
#pragma unroll
    for (int i = 0; i < 32; ++i) { const int kk = 2 * i + (lane >> 5); const float s = kscale ? kscale[k0 + kk] : 1.0f; scr[kk * 33 + (lane & 31)] = wv_[i] * s; }
    LDS_WAIT(); asm volatile("" ::: "memory");
    const int c = lane & 7;
#pragma unroll
    for (int j = 0; j < 4; ++j) { const int n = (lane >> 3) + 8 * j; const LAS float* s = scr + (8 * c) * 33 + n;
        v4u o; o.x = pk2(s[0 * 33], s[1 * 33]); o.y = pk2(s[2 * 33], s[3 * 33]); o.z = pk2(s[4 * 33], s[5 * 33]); o.w = pk2(s[6 * 33], s[7 * 33]);
        *(GAS v4u*)(WT + (size_t)(nd + n) * K + k0 + 8 * c) = o; }
    LDS_WAIT(); asm volatile("" ::: "memory");
}
#define PHASE_IDS() int t_ = F.wave0 * 64 + lane_id_asm(); asm volatile("" : "+v"(t_)); const int tid = t_, lane = tid & 63, wave = __builtin_amdgcn_readfirstlane(tid >> 6); (void)lane; (void)wave
__device__ __forceinline__ void p0_prologue(Frame& F) {
    PHASE_IDS();
    LAS float* scr = (LAS float*)(F.lds + RING_OFF + wave * 16384);
    const int gw = F.vcu * NWAVES + wave, NGW = F.G * NWAVES;
    constexpr int I_IN = (DM / 64) * (NIN / 32), I_OUT = (DM / 64) * (DM / 32);
    constexpr int NITEMS = DEPTH * (I_IN + I_OUT);
    for (int it = gw; it < NITEMS; it += NGW) {
        int r = it;
        if (r < DEPTH * I_IN) { const int l = r / I_IN; r -= l * I_IN;
            p0_transpose_item(F.w_in + (size_t)l * DM * NIN, DM, NIN, F.WIN + (size_t)l * NIN * DM, F.norm_w + l * DM, scr, r, lane, true); continue; }
        r -= DEPTH * I_IN; { const int l = r / I_OUT; r -= l * I_OUT;
            p0_transpose_item(F.w_out + (size_t)l * DM * DM, DM, DM, F.WOUT + (size_t)l * DM * DM, nullptr, scr, r, lane, false); }
    }
    for (int m0 = gw * 4; m0 < MTOK; m0 += NGW * 4) {
        f32x4 v[4][4]; float sq[4];
#pragma unroll
        for (int r = 0; r < 4; ++r) { const GAS f32x4* xr = (const GAS f32x4*)(F.x + (size_t)(m0 + r) * DM) + lane;
#pragma unroll
            for (int j = 0; j < 4; ++j) v[r][j] = xr[64 * j]; }
#pragma unroll
        for (int r = 0; r < 4; ++r) { float a = 0.f;
#pragma unroll
            for (int j = 0; j < 4; ++j) a += (v[r][j].x * v[r][j].x + v[r][j].y * v[r][j].y) + (v[r][j].z * v[r][j].z + v[r][j].w * v[r][j].w);
            sq[r] = a; }
#pragma unroll
        for (int o = 1; o < 64; o <<= 1) {
#pragma unroll
            for (int r = 0; r < 4; ++r) sq[r] += __shfl_xor(sq[r], o); }
#pragma unroll
        for (int r = 0; r < 4; ++r) { GAS unsigned long long* o8 = (GAS unsigned long long*)(F.XB + (size_t)(m0 + r) * DM) + lane;
#pragma unroll
            for (int j = 0; j < 4; ++j) o8[64 * j] = (unsigned long long)pk2(v[r][j].x, v[r][j].y) | ((unsigned long long)pk2(v[r][j].z, v[r][j].w) << 32);
            if (lane < 16) F.ROWSS[(size_t)(m0 + r) * 16 + lane] = (lane == 0) ? sq[r] : 0.f; }
    }
    if (blockIdx.x == 0) { const int c = tid; const float a0 = F.lb_logits[c], a1 = F.lb_logits[512 + c]; const float mx = fmaxf(a0, a1);
        const float e0 = expf(a0 - mx), e1 = expf(a1 - mx); const float p0 = e0 / (e0 + e1), p1 = e1 / (e0 + e1);
        F.LB[c] = 0.f; F.LB[512 + c] = fminf(fmaxf((p0 + p1) - p0, 0.f), 1.0f - 1e-6f); }
}

constexpr float LOG2E = 1.4426950408889634f;
constexpr float QSCALE2 = 0.125f * LOG2E;
namespace moba {
typedef short bf16x8 __attribute__((ext_vector_type(8)));
typedef short s16x4 __attribute__((ext_vector_type(4)));
typedef float f32x16 __attribute__((ext_vector_type(16)));
typedef float f32x2_t __attribute__((ext_vector_type(2))); typedef __bf16 bf16x2_t __attribute__((ext_vector_type(2)));
__device__ __forceinline__ unsigned cvtpk(float lo, float hi) { f32x2_t v = {lo, hi}; bf16x2_t b = __builtin_convertvector(v, bf16x2_t); return __builtin_bit_cast(unsigned, b); }
__device__ __forceinline__ int crow(int r, int hi) { return (r & 3) + 8 * (r >> 2) + 4 * hi; }
__device__ __forceinline__ float max3f(float a, float b, float c) { float r; asm("v_max3_f32 %0, %1, %2, %3" : "=v"(r) : "v"(a), "v"(b), "v"(c)); return r; }
constexpr int L_K = 0, L_V = 32768, L_WSF = 65536, L_KM = 67584, L_OST = 69632;
constexpr float NEG_BIG = -1e30f;
constexpr float THR = 8.0f;
__device__ __forceinline__ s16x4 vtr(const LAS unsigned char* p) { return __builtin_bit_cast(s16x4, __builtin_amdgcn_ds_read_tr16_b64_v4i16((LAS s16x4*)p)); }
}

__device__ __forceinline__ void moba_glds(unsigned voff, const void* sbase, unsigned lds_dst) { unsigned keep;
    asm volatile("s_mov_b32 %0, m0\n\ts_mov_b32 m0, %3\n\ts_nop 0\n\tglobal_load_lds_dwordx4 %1, %2\n\ts_mov_b32 m0, %0" : "=&s"(keep) : "v"(voff), "s"(sbase), "s"(lds_dst) : "memory"); }
template <bool FIXREF> __device__ __forceinline__ void moba_mfma_body(Frame& F, int l) {
    using namespace moba;
    PHASE_IDS();
    const int r32 = lane & 31, hi = lane >> 5, wid = wave;
    LAS unsigned char* L = F.lds + RING_OFF;
    LAS float* wsf = (LAS float*)(L + L_WSF) + wid * 64;
    LAS float* km = (LAS float*)(L + L_KM);
    LAS float* ost = (LAS float*)(L + L_OST) + wid * 2048;
    float gq = fabsf(F.q_norm_w[l * 64 + lane]), gk = fabsf(F.k_norm_w[l * 64 + lane]);
#pragma unroll
    for (int o = 1; o < 64; o <<= 1) { gq = fmaxf(gq, __shfl_xor(gq, o)); gk = fmaxf(gk, __shfl_xor(gk, o)); }
    gq = __builtin_bit_cast(float, __builtin_amdgcn_readfirstlane(__builtin_bit_cast(int, gq))); gk = __builtin_bit_cast(float, __builtin_amdgcn_readfirstlane(__builtin_bit_cast(int, gk)));
    const float smax2 = 8.0f * gq * gk * LOG2E * 1.02f;
    const float mhat0 = -(smax2 + 1.0f);
    gu32* qctr = F.ctl + CW_QUEUE + 64 * l;
    volatile LAS unsigned* tick = (volatile LAS unsigned*)(F.lds + EXTRA_OFF + 8192);
    if (tid == 0) tick[0] = __hip_atomic_fetch_add(qctr, 1u, RLX_AGENT);
    for (int ui = 0;; ++ui) {
        __syncthreads();
        const int it = __builtin_amdgcn_readfirstlane((int)tick[ui & 1]); if (it >= 1024) break;
        const int qb = 7 - (it >> 7), bh = it & 127;
        const int b = bh >> 3, h = bh & 7; const size_t rowbase = (size_t)b * SEQ; const int q0 = qb * 256, qrel = wid * 32 + r32, tq = q0 + qrel;
        const float sl2 = exp2f(-(float)(h + 1)) * LOG2E;
        bf16x8 qr[4];
        { const GAS bf16* Qw = (const GAS bf16*)(F.QN + (rowbase + q0 + wid * 32 + r32) * 512 + h * 64 + hi * 8);
#pragma unroll
            for (int d0 = 0; d0 < 4; ++d0) qr[d0] = *(const GAS bf16x8*)(Qw + d0 * 16); }
        LAS unsigned char* qlds = (LAS unsigned char*)ost + lane * 16;
        if (tid < qb * 64) { const GAS float* kp = (const GAS float*)(F.KPART + ((size_t)b * 8 + (tid >> 6)) * 1024 + h * 64 + (tid & 63)); km[tid] = (kp[0] + kp[512]) * (1.0f / 256.0f); }
        const unsigned koff = (unsigned)(((rowbase + lane) * 512 + h * 64 + wid * 8) * 2);
        unsigned voff; { const int vr = 8 * wid + (lane >> 3), sl = lane & 7; const int ch = ((((sl >> 2) ^ ((vr >> 1) & 1)) << 2) | (sl & 3)); voff = (unsigned)((((size_t)MTOK + rowbase + vr) * 512 + h * 64 + ch * 8) * 2); }
        const unsigned lds0 = (unsigned)(uintptr_t)L;
#define MOBA_ISSUE(t_, bufi) do { moba_glds(koff, (const void*)((const char*)F.KN + (size_t)(t_) * 65536), (unsigned)__builtin_amdgcn_readfirstlane((int)(lds0 + L_K + (bufi) * 8192 + wid * 1024))); \
            moba_glds(voff, (const void*)((const char*)F.KN + (size_t)(t_) * 65536), (unsigned)__builtin_amdgcn_readfirstlane((int)(lds0 + L_V + (bufi) * 8192 + wid * 1024))); } while (0)
        const int NT = 4 * (qb + 1);
        int t0 = 0; { const float dstar = (151.0f + 2.0f * smax2) / sl2; const float x = ((float)(q0 - 63) - dstar) * (1.0f / 64.0f); if (x > 0.f) t0 = ((int)x) & ~1; if (t0 > NT - 4) t0 = NT - 4; t0 = __builtin_amdgcn_readfirstlane(t0); }
        unsigned nticket = 0u; if (tid == 0) nticket = __hip_atomic_fetch_add(qctr, 1u, RLX_AGENT);
        MOBA_ISSUE(t0, 0); MOBA_ISSUE(t0 + 1, 1); MOBA_ISSUE(t0 + 2, 2);
        __syncthreads();
        unsigned selmask = 0;
        { float gt[7];
#pragma unroll
            for (int j = 0; j < 7; ++j) { float s = 0.f;
                if (j < qb) {
#pragma unroll
                    for (int d0 = 0; d0 < 4; ++d0)
#pragma unroll
                        for (int e = 0; e < 8; ++e) s += bf2f((unsigned short)qr[d0][e]) * km[j * 64 + d0 * 16 + hi * 8 + e];
                    auto rr = __builtin_amdgcn_permlane32_swap(__float_as_uint(s), __float_as_uint(s), false, false);
                    s = __uint_as_float(rr[0]) + __uint_as_float(rr[1]); }
                gt[j] = s; }
#pragma unroll
            for (int j = 0; j < 7; ++j) { int rank = 0;
#pragma unroll
                for (int i = 0; i < 7; ++i) if (i != j && i < qb) rank += (gt[i] > gt[j] || (gt[i] == gt[j] && i < j)) ? 1 : 0;
                if (j < qb && rank < 3) selmask |= 1u << j; } }
#pragma unroll
        for (int d0 = 0; d0 < 4; ++d0) *(LAS bf16x8*)(qlds + d0 * 1024) = qr[d0];
        float mhat = mhat0, l_reg = 0.f; f32x16 o[2]; o[0] = f32x16{}; o[1] = f32x16{};
        const int kbase = L_K + hi * 1024 + r32 * 16;
        const int g16 = lane >> 4, i16 = lane & 15, tq4 = i16 >> 2, tp4 = i16 & 3;
        const int vrow0 = 4 * hi + tq4;
        if (tid == 0) tick[(ui + 1) & 1] = nticket;
        asm volatile("s_waitcnt vmcnt(2)" ::: "memory");
        __syncthreads();
#define MOBA_KLOAD(KOFF) do { _Pragma("unroll") for (int d0 = 0; d0 < 4; ++d0) qf_[d0] = *(const LAS bf16x8*)(qlds + d0 * 1024); \
            _Pragma("unroll") for (int d0 = 0; d0 < 4; ++d0) { \
            kfr[2 * d0] = *(const LAS bf16x8*)(L + (KOFF) + kbase + d0 * 2048); kfr[2 * d0 + 1] = *(const LAS bf16x8*)(L + (KOFF) + kbase + d0 * 2048 + 512); } } while (0)
#define MOBA_VLOAD(VOFF) do { _Pragma("unroll") for (int dblk = 0; dblk < 2; ++dblk) _Pragma("unroll") for (int ks = 0; ks < 4; ++ks) { \
            const int rlo = 16 * ks + vrow0, rhi = rlo + 8; \
            vlo[dblk * 4 + ks] = vtr(L + L_V + (VOFF) + rlo * 128 + ((dblk ^ ((rlo >> 1) & 1)) * 64) + (16 * (g16 & 1) + 4 * tp4) * 2); \
            vhi[dblk * 4 + ks] = vtr(L + L_V + (VOFF) + rhi * 128 + ((dblk ^ ((rhi >> 1) & 1)) * 64) + (16 * (g16 & 1) + 4 * tp4) * 2); } } while (0)
#define MOBA_QK(TT, P0, P1) do { \
            const int blk_ = (TT) >> 2; const bool own_ = (blk_ == qb); \
            if (!(own_ && (64 * ((TT) & 3) > 32 * wid + 31))) { \
                const bool sel_ = own_ || ((selmask >> blk_) & 1u); \
                const float sc0_ = sel_ ? (-mhat - sl2 * (float)(tq - 64 * (TT) - 4 * hi)) : NEG_BIG; \
_Pragma("unroll") \
                for (int r = 0; r < 16; ++r) { P0[r] = __builtin_fmaf(sl2, (float)((r & 3) + 8 * (r >> 2)), sc0_); P1[r] = __builtin_fmaf(sl2, (float)(32 + (r & 3) + 8 * (r >> 2)), sc0_); } \
_Pragma("unroll") \
                for (int d0 = 0; d0 < 4; ++d0) { \
                    P0 = __builtin_amdgcn_mfma_f32_32x32x16_bf16(kfr[2 * d0], qf_[d0], P0, 0, 0, 0); \
                    P1 = __builtin_amdgcn_mfma_f32_32x32x16_bf16(kfr[2 * d0 + 1], qf_[d0], P1, 0, 0, 0); } \
            } } while (0)
#define MOBA_SMPV(TT, P0, P1, HAVE_NEXT, N0, N1) do { \
            const int blk = (TT) >> 2; const bool own = (blk == qb); const int jb = (TT) & 3; \
            if (!(own && (64 * jb > 32 * wid + 31))) { \
                if (own && (64 * jb + 63 > 32 * wid)) { \
_Pragma("unroll") \
                    for (int r = 0; r < 16; ++r) { const int kvl = 64 * jb + crow(r, hi); if (kvl > qrel) P0[r] = NEG_BIG; if (kvl + 32 > qrel) P1[r] = NEG_BIG; } } \
                if (!FIXREF) { \
                float rm = max3f(P0[0], P1[0], P0[1]), rm2 = max3f(P1[1], P0[2], P1[2]); \
_Pragma("unroll") \
                for (int r = 3; r < 15; r += 2) { rm = max3f(rm, P0[r], P1[r]); rm2 = max3f(rm2, P0[r + 1], P1[r + 1]); } \
                rm = max3f(rm, rm2, fmaxf(P0[15], P1[15])); \
                { auto rr = __builtin_amdgcn_permlane32_swap(__float_as_uint(rm), __float_as_uint(rm), false, false); rm = fmaxf(__uint_as_float(rr[0]), __uint_as_float(rr[1])); } \
                if (__any(rm > THR)) { \
                    const float dl = fmaxf(rm, 0.f); mhat += dl; \
_Pragma("unroll") \
                    for (int r = 0; r < 16; ++r) { P0[r] -= dl; P1[r] -= dl; } \
                    if (HAVE_NEXT) { \
_Pragma("unroll") \
                        for (int r = 0; r < 16; ++r) { N0[r] -= dl; N1[r] -= dl; } } \
                    const float f = __builtin_amdgcn_exp2f(-dl); l_reg *= f; \
                    if (hi == 0) wsf[r32] = f; \
_Pragma("unroll") \
                    for (int r = 0; r < 16; ++r) { const float fr = wsf[crow(r, hi)]; o[0][r] *= fr; o[1][r] *= fr; } } \
                } \
                float sacc = 0.f, sacc2 = 0.f; \
_Pragma("unroll") \
                for (int r = 0; r < 16; ++r) { P0[r] = __builtin_amdgcn_exp2f(P0[r]); P1[r] = __builtin_amdgcn_exp2f(P1[r]); sacc += P0[r]; sacc2 += P1[r]; } \
                l_reg += sacc + sacc2; \
                bf16x8 pa[4]; \
                { v4u w; \
_Pragma("unroll") \
                    for (int ks = 0; ks < 4; ++ks) { \
_Pragma("unroll") \
                        for (int e = 0; e < 4; ++e) { const int rb = (ks & 1) * 8 + 2 * e; w[e] = (ks < 2) ? cvtpk(P0[rb], P0[rb + 1]) : cvtpk(P1[rb], P1[rb + 1]); } \
                        pa[ks] = __builtin_bit_cast(bf16x8, w); } } \
_Pragma("unroll") \
                for (int dblk = 0; dblk < 2; ++dblk) \
_Pragma("unroll") \
                    for (int ks = 0; ks < 4; ++ks) { \
                        const s16x4 lo = vlo[dblk * 4 + ks], hh = vhi[dblk * 4 + ks]; \
                        const bf16x8 vf = __builtin_shufflevector(lo, hh, 0, 1, 2, 3, 4, 5, 6, 7); \
                        o[dblk] = __builtin_amdgcn_mfma_f32_32x32x16_bf16(pa[ks], vf, o[dblk], 0, 0, 0); } \
            } } while (0)
        f32x16 pA0, pA1, pB0, pB1; bf16x8 kfr[8], qf_[4]; s16x4 vlo[8], vhi[8];
        MOBA_KLOAD(0); MOBA_QK(t0, pA0, pA1);
        int c0o = 0;
        for (int t = t0; t < NT; t += 2) {
            const int c1o = (c0o + 1) & 3, c2o = (c0o + 2) & 3, c3o = (c0o + 3) & 3;
            if (t + 3 < NT) MOBA_ISSUE(t + 3, c3o);
            MOBA_KLOAD(c1o * 8192); __builtin_amdgcn_sched_barrier(0);
            MOBA_QK(t + 1, pB0, pB1); __builtin_amdgcn_sched_barrier(0);
            MOBA_VLOAD(c0o * 8192); __builtin_amdgcn_sched_barrier(0);
            MOBA_SMPV(t, pA0, pA1, true, pB0, pB1);
            if (t + 3 < NT) asm volatile("s_waitcnt vmcnt(2)" ::: "memory"); else asm volatile("s_waitcnt vmcnt(0)" ::: "memory");
            __syncthreads();
            if (t + 4 < NT) MOBA_ISSUE(t + 4, c0o);
            if (t + 2 < NT) { MOBA_KLOAD(c2o * 8192); __builtin_amdgcn_sched_barrier(0); MOBA_QK(t + 2, pA0, pA1); __builtin_amdgcn_sched_barrier(0); }
            MOBA_VLOAD(c1o * 8192); __builtin_amdgcn_sched_barrier(0);
            MOBA_SMPV(t + 1, pB0, pB1, (t + 2 < NT), pA0, pA1);
            if (t + 4 < NT) asm volatile("s_waitcnt vmcnt(2)" ::: "memory"); else asm volatile("s_waitcnt vmcnt(0)" ::: "memory");
            __syncthreads();
            c0o = c2o;
        }
#undef MOBA_ISSUE
#undef MOBA_KLOAD
#undef MOBA_VLOAD
#undef MOBA_QK
#undef MOBA_SMPV
        v4u gwv[4];
#pragma unroll
        for (int i = 0; i < 4; ++i) gwv[i] = *(const GAS v4u*)(F.GA + (rowbase + q0 + wid * 32 + i * 8 + (lane >> 3)) * 512 + h * 64 + (lane & 7) * 8);
        { auto rr = __builtin_amdgcn_permlane32_swap(__float_as_uint(l_reg), __float_as_uint(l_reg), false, false); l_reg = __uint_as_float(rr[0]) + __uint_as_float(rr[1]); }
        if (hi == 0) wsf[r32] = 1.0f / l_reg;
#pragma unroll
        for (int r = 0; r < 16; ++r) { const float rl = wsf[crow(r, hi)]; ost[crow(r, hi) * 64 + r32] = o[0][r] * rl; ost[crow(r, hi) * 64 + 32 + r32] = o[1][r] * rl; }
#pragma unroll
        for (int i = 0; i < 4; ++i) { const int row = i * 8 + (lane >> 3), ch = lane & 7;
            const f32x4 a = *(const LAS f32x4*)(ost + row * 64 + ch * 8), c2 = *(const LAS f32x4*)(ost + row * 64 + ch * 8 + 4);
            const size_t grow = rowbase + q0 + wid * 32 + row;
            const v4u gw = gwv[i];
            v4u ow; ow.x = pk2(a[0] * bflo(gw.x), a[1] * bfhi(gw.x)); ow.y = pk2(a[2] * bflo(gw.y), a[3] * bfhi(gw.y));
            ow.z = pk2(c2[0] * bflo(gw.z), c2[1] * bfhi(gw.z)); ow.w = pk2(c2[2] * bflo(gw.w), c2[3] * bfhi(gw.w));
            *(GAS v4u*)(F.MIXED + grow * DM + 512 + h * 64 + ch * 8) = ow; }
    }
    __syncthreads();
}


__device__ __forceinline__ void moba_mfma_phase(Frame& F, int l) {
    float gq = 0.f, gk = 0.f;
    for (int i = 0; i < 64; ++i) { gq = fmaxf(gq, fabsf(F.q_norm_w[l * 64 + i])); gk = fmaxf(gk, fabsf(F.k_norm_w[l * 64 + i])); }
    if (2.0f * (8.0f * gq * gk * LOG2E * 1.02f) + 1.0f <= 100.0f) moba_mfma_body<true>(F, l); else moba_mfma_body<false>(F, l);
}

namespace hg {
typedef short bf16x8 __attribute__((ext_vector_type(8)));
typedef short s16x4 __attribute__((ext_vector_type(4)));
typedef float f32x4 __attribute__((ext_vector_type(4)));
typedef unsigned u32x2 __attribute__((ext_vector_type(2)));
constexpr int SLOT = 33792, NSLOT = 4;
constexpr int L_SC = NSLOT * SLOT, L_NRM = L_SC + 4096;
constexpr int NSTEP = SEQ / 32;
__device__ __forceinline__ int fsw(int t) { return ((t & 7) << 2) | (((t >> 3) & 1) << 1); }
__device__ __forceinline__ int unit_off(int tok, int cg) { return 8 * (32 * tok + (cg ^ fsw(tok))); }
__device__ __forceinline__ s16x4 rd64(const LAS unsigned char* p) { return *(const LAS s16x4*)p; }
__device__ __forceinline__ s16x4 vtr(const LAS unsigned char* p) { return __builtin_bit_cast(s16x4, __builtin_amdgcn_ds_read_tr16_b64_v4i16((LAS s16x4*)p)); }
__device__ __forceinline__ bf16x8 cat(s16x4 a, s16x4 b) { return __builtin_shufflevector(a, b, 0, 1, 2, 3, 4, 5, 6, 7); }
__device__ __forceinline__ s16x4 pack4(f32x4 v) { u32x2 w; w.x = moba::cvtpk(v[0], v[1]); w.y = moba::cvtpk(v[2], v[3]); return __builtin_bit_cast(s16x4, w); }
__device__ __forceinline__ void glds16(const GAS void* gsrc, unsigned lds_dst) { unsigned keep;
    asm volatile("s_mov_b32 %0, m0\n\ts_mov_b32 m0, %2\n\ts_nop 0\n\tglobal_load_lds_dwordx4 %1, off\n\ts_mov_b32 m0, %0" : "=&s"(keep) : "v"(gsrc), "s"(lds_dst) : "memory"); }
__device__ __forceinline__ void glds16s(unsigned voff, const void* sbase, unsigned lds_dst) { unsigned keep;
    asm volatile("s_mov_b32 %0, m0\n\ts_mov_b32 m0, %3\n\ts_nop 0\n\tglobal_load_lds_dwordx4 %1, %2\n\ts_mov_b32 m0, %0" : "=&s"(keep) : "v"(voff), "s"(sbase), "s"(lds_dst) : "memory"); }
#define HG_MFMA(a, b, c) __builtin_amdgcn_mfma_f32_16x16x32_bf16((a), (b), (c), 0, 0, 0)
}

__device__ __forceinline__ void hgrn_mfma_phase(Frame& F, int l) {
    using namespace hg;
    PHASE_IDS();
    const int w = wave, c16 = lane & 15, g = lane >> 4;
    LAS unsigned char* L = F.lds + RING_OFF;
    const s16x4 z4 = (s16x4){0, 0, 0, 0};
    for (int it = (int)blockIdx.x; it < 64; it += F.G) {
        const int b = it >> 2, h = it & 3; const size_t rowbase = (size_t)b * SEQ;
        const int da = w >> 1;
        unsigned dsrc[4];
#pragma unroll
        for (int i = 0; i < 4; ++i) { const int t = 16 * (w & 1) + 4 * i + (lane >> 4); const int sc = (lane & 15) ^ (fsw(t) >> 1);
            dsrc[i] = (unsigned)((((size_t)da * MTOK + rowbase + t) * 512 + h * 128 + 8 * sc) * 2); }
        const unsigned ddec = (unsigned)((((size_t)b * NSTEP) * 512 + h * 128 + 4 * lane) * 4);
        const int ddst = da * 8192 + (w & 1) * 4096;
        const unsigned lds0 = (unsigned)(uintptr_t)(F.lds + RING_OFF);
#define HG_ISSUE(step) do { const unsigned so_ = lds0 + (unsigned)(((step) & 3) * SLOT); \
            _Pragma("unroll") for (int i = 0; i < 4; ++i) \
                glds16s(dsrc[i], (const void*)((const char*)F.QI + (size_t)(step) * (32 * 512 * 2)), (unsigned)__builtin_amdgcn_readfirstlane((int)(so_ + ddst + i * 1024))); \
            if (w == 0) glds16s(ddec, (const void*)((const char*)F.DEC + (size_t)(step) * 2048), (unsigned)__builtin_amdgcn_readfirstlane((int)(so_ + 32768))); } while (0)
        f32x4 S[8]; bf16x8 Sb[4];
#pragma unroll
        for (int tk = 0; tk < 8; ++tk) S[tk] = (f32x4){0.f, 0.f, 0.f, 0.f};
#pragma unroll
        for (int ks = 0; ks < 4; ++ks) Sb[ks] = (bf16x8){0, 0, 0, 0, 0, 0, 0, 0};
        f32x4 oprev[2]; oprev[0] = (f32x4){0.f, 0.f, 0.f, 0.f}; oprev[1] = oprev[0];
        u32x2 gprev[2]; gprev[0] = (u32x2){0u, 0u}; gprev[1] = gprev[0];
        float hw[4];
#pragma unroll
        for (int r = 0; r < 4; ++r) hw[r] = F.hg_norm_w[l * 128 + 16 * w + 4 * g + r];
        asm volatile("" : "+v"(hw[0]), "+v"(hw[1]), "+v"(hw[2]), "+v"(hw[3]));
        LAS float* nrm = (LAS float*)(L + L_NRM);
        LAS unsigned char* SC = L + L_SC;
        HG_ISSUE(0); HG_ISSUE(1); HG_ISSUE(2);
        asm volatile("s_waitcnt vmcnt(8)\n\ts_barrier" ::: "memory");
        const int trq = c16 >> 2, trp = c16 & 3;
        int ro0 = 256 * c16 + 16 * (g ^ (fsw(c16) >> 1)), ko0 = 256 * (4 * g + trq) + 16 * (trp ^ (fsw(4 * g + trq) >> 1));
#define RO(ks) (ro0 ^ (64 * (ks)))
#define KO(tk) (ko0 ^ (64 * ((tk) >> 1) + 8 * ((tk) & 1)))
        const int io_ = unit_off(4 * g + trq, 4 * w + trp), go_ = unit_off(c16, 4 * w + g);
        bf16x8 qf[2][4];
#define HG_LOADQ(slotbase) do { _Pragma("unroll") for (int tt = 0; tt < 2; ++tt) _Pragma("unroll") for (int ks = 0; ks < 4; ++ks) \
            qf[tt][ks] = *(const LAS bf16x8*)((slotbase) + RO(ks) + 4096 * tt); } while (0)
#define HG_FINAL(step, P) do { _Pragma("unroll") for (int tt = 0; tt < 2; ++tt) { \
            const float ssum = ((P[tt][0] + P[tt][1]) + (P[tt][2] + P[tt][3])) + ((P[tt][4] + P[tt][5]) + (P[tt][6] + P[tt][7])); \
            const float rstd = __builtin_amdgcn_rsqf(ssum * (1.0f / 128.0f) + NORM_EPS); \
            u32x2 wv; wv.x = moba::cvtpk(oprev[tt][0] * rstd * hw[0] * bflo(gprev[tt].x), oprev[tt][1] * rstd * hw[1] * bfhi(gprev[tt].x)); \
            wv.y = moba::cvtpk(oprev[tt][2] * rstd * hw[2] * bflo(gprev[tt].y), oprev[tt][3] * rstd * hw[3] * bfhi(gprev[tt].y)); \
            *(GAS u32x2*)(F.MIXED + (rowbase + (size_t)(step) * 32 + 16 * tt + c16) * DM + h * 128 + 16 * w + 4 * g) = wv; } } while (0)
        HG_LOADQ(L);
        for (int n = 0; n < NSTEP; ++n) {
            asm volatile("" : "+v"(ro0), "+v"(ko0));
            if (n + 3 < NSTEP) HG_ISSUE(n + 3);
            const LAS unsigned char* Qs = L + (n & 3) * SLOT; const LAS unsigned char* Ks = Qs + 8192; const LAS unsigned char* Is = Qs + 16384; const LAS unsigned char* Gs = Qs + 24576;
            const LAS float* Ds = (const LAS float*)(Qs + 32768);
            LAS unsigned char* SCn = SC + (n & 1) * 1536;
            bf16x8 kf[4];
            if (w < 3) { const int st = (w == 2) ? 1 : 0;
#pragma unroll
                for (int ks = 0; ks < 4; ++ks) kf[ks] = *(const LAS bf16x8*)(Ks + RO(ks) + 4096 * st); }
            u32x2 gcur[2];
#pragma unroll
            for (int tt = 0; tt < 2; ++tt) gcur[tt] = *(const LAS u32x2*)(Gs + go_ + 4096 * tt);
            s16x4 itr[2];
#pragma unroll
            for (int st = 0; st < 2; ++st) itr[st] = vtr(Is + io_ + 4096 * st);
            const bf16x8 i01 = cat(itr[0], itr[1]);
            bf16x8 k01[4]; f32x4 dv4[4];
#pragma unroll
            for (int tk = 0; tk < 4; ++tk) { k01[tk] = cat(vtr(Ks + KO(tk)), vtr(Ks + KO(tk) + 4096)); dv4[tk] = *(const LAS f32x4*)(Ds + 16 * tk + 4 * g); }
            f32x4 o[2];
#pragma unroll
            for (int tt = 0; tt < 2; ++tt) { f32x4 a = (f32x4){0.f, 0.f, 0.f, 0.f};
#pragma unroll
                for (int ks = 0; ks < 4; ++ks) a = HG_MFMA(Sb[ks], qf[tt][ks], a);
                o[tt] = a; }
            if (w < 3) { f32x4 sc = (f32x4){0.f, 0.f, 0.f, 0.f};
                if (w == 0) {
#pragma unroll
                    for (int ks = 0; ks < 4; ++ks) sc = HG_MFMA(kf[ks], qf[0][ks], sc);
                } else {
#pragma unroll
                    for (int ks = 0; ks < 4; ++ks) sc = HG_MFMA(kf[ks], qf[1][ks], sc); }
                if (w != 1) {
#pragma unroll
                    for (int r = 0; r < 4; ++r) if (4 * g + r > c16) sc[r] = 0.f; }
                *(LAS s16x4*)(SCn + w * 512 + lane * 8) = pack4(sc); }
#pragma unroll
            for (int tk = 0; tk < 4; ++tk) S[tk] = HG_MFMA(k01[tk], i01, S[tk]);
            asm volatile("" ::: "memory");
            { bf16x8 k2[4]; f32x4 d2[4];
#pragma unroll
                for (int tk = 0; tk < 4; ++tk) { k2[tk] = cat(vtr(Ks + KO(tk + 4)), vtr(Ks + KO(tk + 4) + 4096)); d2[tk] = *(const LAS f32x4*)(Ds + 16 * (tk + 4) + 4 * g); }
#pragma unroll
                for (int tk = 0; tk < 4; ++tk) S[tk] = S[tk] * dv4[tk];
#pragma unroll
                for (int ks = 0; ks < 2; ++ks) Sb[ks] = cat(pack4(S[2 * ks]), pack4(S[2 * ks + 1]));
#pragma unroll
                for (int tk = 0; tk < 4; ++tk) S[tk + 4] = HG_MFMA(k2[tk], i01, S[tk + 4]);
#pragma unroll
                for (int tk = 0; tk < 4; ++tk) S[tk + 4] = S[tk + 4] * d2[tk];
#pragma unroll
                for (int ks = 2; ks < 4; ++ks) Sb[ks] = cat(pack4(S[2 * ks]), pack4(S[2 * ks + 1])); }
            if (n >= NSTEP - 3) asm volatile("s_waitcnt vmcnt(0) lgkmcnt(0)\n\ts_barrier" ::: "memory");
            else if (n <= 1) asm volatile("s_waitcnt vmcnt(8) lgkmcnt(0)\n\ts_barrier" ::: "memory");
            else if (n == 2) asm volatile("s_waitcnt vmcnt(10) lgkmcnt(0)\n\ts_barrier" ::: "memory");
            else asm volatile("s_waitcnt vmcnt(12) lgkmcnt(0)\n\ts_barrier" ::: "memory");
            const s16x4 sc00 = rd64(SCn + lane * 8), sc01 = rd64(SCn + 512 + lane * 8), sc11 = rd64(SCn + 1024 + lane * 8);
            float pn[2][8];
            if (n > 0) {
#pragma unroll
                for (int tt = 0; tt < 2; ++tt)
#pragma unroll
                    for (int ww = 0; ww < 8; ++ww) pn[tt][ww] = nrm[((n - 1) & 1) * 256 + ww * 32 + 16 * tt + c16]; }
            if (n + 1 < NSTEP) HG_LOADQ(L + ((n + 1) & 3) * SLOT);
            o[0] = HG_MFMA(cat(itr[0], z4), cat(sc00, z4), o[0]);
            o[1] = HG_MFMA(i01, cat(sc01, sc11), o[1]);
            { float ss0 = (o[0][0] * o[0][0] + o[0][1] * o[0][1]) + (o[0][2] * o[0][2] + o[0][3] * o[0][3]);
              float ss1 = (o[1][0] * o[1][0] + o[1][1] * o[1][1]) + (o[1][2] * o[1][2] + o[1][3] * o[1][3]);
              { auto r0 = __builtin_amdgcn_permlane16_swap(__float_as_uint(ss0), __float_as_uint(ss0), false, false); auto r1 = __builtin_amdgcn_permlane16_swap(__float_as_uint(ss1), __float_as_uint(ss1), false, false);
                ss0 = __uint_as_float(r0[0]) + __uint_as_float(r0[1]); ss1 = __uint_as_float(r1[0]) + __uint_as_float(r1[1]); }
              { auto r0 = __builtin_amdgcn_permlane32_swap(__float_as_uint(ss0), __float_as_uint(ss0), false, false); auto r1 = __builtin_amdgcn_permlane32_swap(__float_as_uint(ss1), __float_as_uint(ss1), false, false);
                ss0 = __uint_as_float(r0[0]) + __uint_as_float(r0[1]); ss1 = __uint_as_float(r1[0]) + __uint_as_float(r1[1]); }
              if (g == 0) { nrm[(n & 1) * 256 + w * 32 + c16] = ss0; nrm[(n & 1) * 256 + w * 32 + 16 + c16] = ss1; } }
            if (n > 0) HG_FINAL(n - 1, pn);
            oprev[0] = o[0]; oprev[1] = o[1]; gprev[0] = gcur[0]; gprev[1] = gcur[1];
        }
        asm volatile("s_waitcnt vmcnt(0) lgkmcnt(0)\n\ts_barrier" ::: "memory");
        { float pn[2][8];
#pragma unroll
            for (int tt = 0; tt < 2; ++tt)
#pragma unroll
                for (int ww = 0; ww < 8; ++ww) pn[tt][ww] = nrm[((NSTEP - 1) & 1) * 256 + ww * 32 + 16 * tt + c16];
            HG_FINAL(NSTEP - 1, pn); }
        asm volatile("s_waitcnt vmcnt(0) lgkmcnt(0)\n\ts_barrier" ::: "memory");
#undef RO
#undef KO
#undef HG_LOADQ
#undef HG_FINAL
#undef HG_ISSUE
    }
}

struct Args { const float* in[8]; float* out; unsigned char* ws; int ph_lo, ph_hi, li, pad; };
__global__ void __launch_bounds__(NWAVES * 64, 2) fwd(Args args) {
    extern __shared__ __attribute__((aligned(16))) unsigned char lds[];
    Frame F;
    F.lds = (LAS unsigned char*)lds;
    F.MISC = (volatile LAS unsigned*)(F.lds + MISC_OFF);
    F.G = gridDim.x; { const int bx = blockIdx.x; F.vcu = (F.G % 8 == 0) ? (bx % 8) * (F.G / 8) + bx / 8 : bx; }
    unsigned char* ws = args.ws;
    F.ctl = (gu32*)(ws + WS_CTL);
    F.x = args.in[0]; F.norm_w = args.in[1]; F.w_in = args.in[2]; F.lb_logits = args.in[3]; F.hg_norm_w = args.in[4]; F.q_norm_w = args.in[5]; F.k_norm_w = args.in[6]; F.w_out = args.in[7];
    F.out = args.out;
    F.WIN = (bf16*)(ws + WS_WIN); F.WOUT = (bf16*)(ws + WS_WOUT); F.XB = (bf16*)(ws + WS_XB); F.MIXED = (bf16*)(ws + WS_MIXED);
    F.QI = (bf16*)(ws + WS_ARR); F.KT = (bf16*)(ws + WS_ARR + ARR_BYTES); F.HI = (bf16*)(ws + WS_ARR + 2 * ARR_BYTES); F.GH = (bf16*)(ws + WS_ARR + 3 * ARR_BYTES);
    F.QN = (bf16*)(ws + WS_ARR + 4 * ARR_BYTES); F.KN = (bf16*)(ws + WS_ARR + 5 * ARR_BYTES); F.V = (bf16*)(ws + WS_ARR + 6 * ARR_BYTES); F.GA = (bf16*)(ws + WS_ARR + 7 * ARR_BYTES);
    F.LB = (float*)(ws + WS_LB); F.KPART = (float*)(ws + WS_KPART); F.ROWSS = (float*)(ws + WS_ROWSS); F.DEC = (float*)(ws + WS_DEC);
    F.wave0 = __builtin_amdgcn_readfirstlane((int)threadIdx.x >> 6);
    for (int u = F.wave0 * 64 + lane_id_asm(); u < (LDS_BYTES - LDSCTL_OFF) / 4; u += NWAVES * 64) ((LAS unsigned*)(F.lds + LDSCTL_OFF))[u] = 0u;
    __syncthreads();
    XcdBarrier bar; bar.bar = (unsigned*)(F.ctl + CW_BAR); bar.x = 0; bar.st = nullptr; bar.wave0 = F.wave0;
    if (N_LAUNCHES == 1) bar = xcd_barrier_post((unsigned*)(F.ctl + CW_BAR), F.MISC + 8, F.wave0);
#define GRID_BAR() do { if (N_LAUNCHES == 1) xcd_barrier(bar); } while (0)
    const int lo = args.ph_lo, hi = args.ph_hi;
#define IN(k) (lo <= (k) && (k) < hi)
#define BOTH(k) (IN(k) && IN((k) + 1))

    if (IN(0)) { p0_prologue(F); if (BOTH(0)) GRID_BAR(); }
    for (int l = 0; l < DEPTH; ++l) {
        const int pb = 1 + 3 * l;
        if (IN(pb)) {
            pg8::Gemm g{F.XB + (size_t)l * MTOK * DM, F.WIN + (size_t)l * NIN * DM, MTOK, NIN, DM}; pg8::StaticOrder S; S.init(MTOK, NIN, F.G, (int)blockIdx.x);
            pg8::EpiFused E{F.QI, F.DEC, F.KPART, F.ROWSS + (size_t)l * MTOK * 16, F.LB + l * 512, F.q_norm_w + l * 64, F.k_norm_w + l * 64};
            for (int rp = 0; rp < REP_PROJ; ++rp) { if (rp) GRID_BAR(); pg8::gemm_phase<pg8::EpiFused, pg8::StaticOrder, true, true>(F.lds + RING_OFF, g, S, E, F.wave0); }
            if (BOTH(pb)) GRID_BAR();
        }
        if (IN(pb + 1)) {
            for (int rp = 0; rp < REP_HGRN; ++rp) { if (rp) GRID_BAR(); hgrn_mfma_phase(F, l); }
            for (int rp = 0; rp < REP_MOBA; ++rp) { if (rp) { GRID_BAR(); if (blockIdx.x == 0 && F.wave0 == 0 && lane_id_asm() == 0) __hip_atomic_store(F.ctl + CW_QUEUE + 64 * l, 0u, RLX_AGENT); GRID_BAR(); } moba_mfma_phase(F, l); }
            if (BOTH(pb + 1)) GRID_BAR(); }
        if (IN(pb + 2)) {
            pg8::Gemm g{F.MIXED, F.WOUT + (size_t)l * DM * DM, MTOK, DM, DM}; pg8::StaticOrder S; S.init(MTOK, DM, F.G, (int)blockIdx.x);
            pg8::EpiOut E{l == 0 ? F.x : nullptr, F.XB + (size_t)MTOK * DM, l == 0 ? nullptr : F.out, l == 0 ? F.XB + (size_t)MTOK * DM : nullptr, l == 0 ? F.ROWSS + (size_t)MTOK * 16 : nullptr};
            for (int rp = 0; rp < REP_OUT; ++rp) { if (rp) GRID_BAR(); pg8::gemm_phase<pg8::EpiOut, pg8::StaticOrder, true, true>(F.lds + RING_OFF, g, S, E, F.wave0); }
            if (pb + 2 < N_PHASES - 1 && BOTH(pb + 2)) GRID_BAR();
        }
    }
#undef IN
#undef BOTH
}

extern "C" void kernel_launch(void* const* d_in, const int* in_sizes, int n_in, void* d_out, int out_size, void* d_ws, size_t ws_size, hipStream_t stream) {
    static int grid = 0;
    if (grid == 0) {
        if (n_in != 8 || in_sizes[0] != MTOK * DM || out_size != MTOK * DM || ws_size < WS_END) { fprintf(stderr, "kernel_launch: unexpected shapes n_in %d in0 %d out %d ws %zu\n", n_in, n_in > 0 ? in_sizes[0] : -1, out_size, ws_size); grid = -1; return; }
        int dev = 0, cus = 0, per_cu = 0;
        if (hipGetDevice(&dev) != hipSuccess || hipDeviceGetAttribute(&cus, hipDeviceAttributeMultiprocessorCount, dev) != hipSuccess) { grid = -1; return; }
        if (hipFuncSetAttribute((const void*)fwd, hipFuncAttributeMaxDynamicSharedMemorySize, LDS_BYTES) != hipSuccess) { fprintf(stderr, "kernel_launch: hipFuncSetAttribute failed\n"); grid = -1; return; }
        if (hipOccupancyMaxActiveBlocksPerMultiprocessor(&per_cu, (const void*)fwd, NWAVES * 64, LDS_BYTES) != hipSuccess || per_cu < 1) fprintf(stderr, "kernel_launch: occupancy query says %d\n", per_cu);
        (void)hipGetLastError();
        if (per_cu < 1) { grid = -1; return; }
        grid = cus;
    }
    if (grid < 0) return;
    if (hipMemsetAsync((char*)d_ws + WS_CTL, 0, CTL_ZERO_BYTES, stream) != hipSuccess) return;
    Args a{};
    for (int i = 0; i < 8; ++i) a.in[i] = (const float*)d_in[i];
    a.out = (float*)d_out; a.ws = (unsigned char*)d_ws;
    for (int li = 0; li < N_LAUNCHES; ++li) {
        a.ph_lo = (N_LAUNCHES == 1) ? 0 : li; a.ph_hi = (N_LAUNCHES == 1) ? N_PHASES : li + 1; a.li = li;
        hipError_t le;
        if (N_LAUNCHES == 1) { void* kargs[] = {(void*)&a}; le = hipLaunchCooperativeKernel((const void*)fwd, dim3(grid), dim3(NWAVES * 64), kargs, LDS_BYTES, stream); }
        else { hipLaunchKernelGGL(fwd, dim3(grid), dim3(NWAVES * 64), LDS_BYTES, stream, a); le = hipPeekAtLastError(); }
        if (le != hipSuccess) { fprintf(stderr, "kernel_launch: launch %d failed: %s\n", li, hipGetErrorName(le)); break; }
    }
}
```

```cpp
#include <hip/hip_runtime.h>
#include <cstdio>
#include <cstdint>
__device__ __forceinline__ int lane_id_asm() { int l; asm volatile("v_mbcnt_lo_u32_b32 %0, -1, 0\n\tv_mbcnt_hi_u32_b32 %0, -1, %0" : "=v"(l)); return l; }
namespace pg8 {
#define PG8_LAS __attribute__((address_space(3)))
typedef unsigned short bf16_t;
typedef short bf16x8 __attribute__((ext_vector_type(8)));
typedef float f32x4 __attribute__((ext_vector_type(4)));
typedef unsigned u32x4 __attribute__((ext_vector_type(4)));
typedef unsigned u32x2 __attribute__((ext_vector_type(2)));
constexpr int BM = 256, BK = 64, HALF = 128, HTB = HALF * BK * 2  , STAGE_BYTES = 8 * HTB, NXCD = 8, WGM = 8;

__host__ __device__ __forceinline__ int lds_byte(int r, int c) { const int st = (r >> 4) * 2 + (c >> 5), rr = r & 15, cc = c & 31, ob = rr * 64 + cc * 2; return st * 1024 + (ob ^ (((ob >> 9) & 1) << 5)); }
__host__ __device__ __forceinline__ void stage_rc(int b, int& R, int& C) { const int st = b / 1024, sb = b % 1024, swz = sb ^ (((sb >> 9) & 1) << 5); R = (st >> 1) * 16 + swz / 64; C = (st & 1) * 32 + (swz % 64) / 2; }
__host__ __device__ __forceinline__ int perm32(int rho) { const int n = rho >> 4, i = rho & 15; return 8 * (i >> 2) + 4 * n + (i & 3); }

struct Unit { int pm, pn; };
struct Gemm { const bf16_t* A; const bf16_t* Bt; int M, N, K; };

struct StaticOrder {
    int nM, nN, nwg, G, c, rot;
    __host__ __device__ void init(int M, int N, int G_, int c_, int rot_ = 0) { __builtin_assume(c_ >= 0 && c_ < 512);     nM = M / BM; nN = N / BM; nwg = nM * nN; G = G_; c = c_; rot = (nwg == 8 * G_) ? rot_ : 0; }
    __host__ __device__ bool next(int i, Unit& u) const {
        if ((long)i * G + c >= nwg) return false;
        const long L = (long)((i + rot) & (rot ? 7 : -1)) * G + c;
        int wgid = (int)L; { const int q = nwg / NXCD, r = nwg % NXCD, xcd = wgid % NXCD, off = wgid / NXCD; wgid = (xcd < r ? xcd * (q + 1) : r * (q + 1) + (xcd - r) * q) + off; }
        const int nig = WGM * nN, gid = wgid / nig, fm = gid * WGM, gsz = (nM - fm) < WGM ? (nM - fm) : WGM;
        u.pm = fm + ((wgid % nig) % gsz); u.pn = (wgid % nig) / gsz; return true;
    }
    __device__ __forceinline__ void a_ready(const Unit&) const {}
    __device__ __forceinline__ void done(const Unit&) const {}
};

__device__ __forceinline__ unsigned cvt_pk_bf16(float lo, float hi) { unsigned r; asm volatile("v_cvt_pk_bf16_f32 %0, %1, %2" : "=v"(r) : "v"(lo), "v"(hi)); return r; }


__device__ __forceinline__ float dpp_row_shr(float v, int n) {
    const int x = __builtin_bit_cast(int, v);
    int r;
    if (n == 1) r = __builtin_amdgcn_update_dpp(0, x, 0x111, 0xf, 0xf, false);
    else if (n == 2) r = __builtin_amdgcn_update_dpp(0, x, 0x112, 0xf, 0xf, false);
    else if (n == 4) r = __builtin_amdgcn_update_dpp(0, x, 0x114, 0xf, 0xf, false);
    else r = __builtin_amdgcn_update_dpp(0, x, 0x118, 0xf, 0xf, false);
    return __builtin_bit_cast(float, r);
}
__device__ __forceinline__ float dpp_row_shr1(float v, int n) {
    const int x = __builtin_bit_cast(int, v); const int one = 0x3f800000;
    int r;
    if (n == 1) r = __builtin_amdgcn_update_dpp(one, x, 0x111, 0xf, 0xf, false);
    else if (n == 2) r = __builtin_amdgcn_update_dpp(one, x, 0x112, 0xf, 0xf, false);
    else if (n == 4) r = __builtin_amdgcn_update_dpp(one, x, 0x114, 0xf, 0xf, false);
    else r = __builtin_amdgcn_update_dpp(one, x, 0x118, 0xf, 0xf, false);
    return __builtin_bit_cast(float, r);
}
__device__ __forceinline__ float fsig(float z) { return __builtin_amdgcn_rcpf(1.0f + __expf(-z)); }
struct EpiFused {
    static constexpr bool PERM = true, AFTER_DRAIN = false;
    bf16_t* ARR; float* DEC; float* KPART; const float* rowss; const float* lb; const float* qg; const float* kg;
    static constexpr size_t AS = (size_t)32768 * 512;
    const PG8_LAS float* rtab; int pm0;
    __device__ __forceinline__ float rstd_of(int row) const { return rtab ? rtab[(((row >> 8) == pm0) ? 0 : 256) + (row & 255)] : rstd_global(rowss, row); }
    static __device__ __forceinline__ float rstd_global(const float* rowss, int row) {
        const f32x4* rp = (const f32x4*)(rowss + (size_t)row * 16);
        const f32x4 a = rp[0], b = rp[1], c = rp[2], d = rp[3];
        const float ss = ((a[0] + a[1]) + (a[2] + a[3])) + ((b[0] + b[1]) + (b[2] + b[3])) + ((c[0] + c[1]) + (c[2] + c[3])) + ((d[0] + d[1]) + (d[2] + d[3]));
        return 1.0f / sqrtf(ss * (1.0f / 1024.0f) + 1e-6f);
    }
    static __device__ __forceinline__ u32x4 pack8(const float (&v)[8]) { u32x4 w; w.x = cvt_pk_bf16(v[0], v[1]); w.y = cvt_pk_bf16(v[2], v[3]); w.z = cvt_pk_bf16(v[4], v[5]); w.w = cvt_pk_bf16(v[6], v[7]); return w; }
    __device__ __forceinline__ void operator()(const f32x4 (&acc)[2][2][4][2], const Unit& u, int wr, int wc, int fr, int fq) const {
        const int row0 = u.pm * BM + wr * 64 + fr; const int pn = u.pn;
        if (pn < 4) {
            const int cb = pn * 128 + wc * 32 + 8 * fq;
            float lbv[8];
#pragma unroll
            for (int k = 0; k < 8; ++k) lbv[k] = lb[cb + k];
#pragma unroll
            for (int ai = 0; ai < 2; ++ai)
#pragma unroll
                for (int mp = 0; mp < 2; ++mp) { const int row1 = row0 + ai * HALF + mp * 32, row2 = row1 + 16; const float rs1 = rstd_of(row1), rs2 = rstd_of(row2);
                    float qi1[8], kt1[8], qi2[8], kt2[8], dc[8];
#pragma unroll
                    for (int k = 0; k < 8; ++k) {
                        const float zq1 = acc[ai][0][2 * mp][k >> 2][k & 3] * rs1, zf1 = acc[ai][1][2 * mp][k >> 2][k & 3] * rs1;
                        const float zq2 = acc[ai][0][2 * mp + 1][k >> 2][k & 3] * rs2, zf2 = acc[ai][1][2 * mp + 1][k >> 2][k & 3] * rs2;
                        const float f1 = lbv[k] + (1.0f - lbv[k]) * fsig(zf1), f2 = lbv[k] + (1.0f - lbv[k]) * fsig(zf2);
                        float e1 = f1, e2 = f2;
                        e1 *= dpp_row_shr1(e1, 1); e2 *= dpp_row_shr1(e2, 1); e1 *= dpp_row_shr1(e1, 2); e2 *= dpp_row_shr1(e2, 2);
                        e1 *= dpp_row_shr1(e1, 4); e2 *= dpp_row_shr1(e2, 4); e1 *= dpp_row_shr1(e1, 8); e2 *= dpp_row_shr1(e2, 8);
                        e2 *= __shfl(e1, (fq << 4) | 15);
                        qi1[k] = zq1 * fsig(zq1) * e1; kt1[k] = (1.0f - f1) * fminf(__builtin_amdgcn_rcpf(e1), 5.5406224e34f);
                        qi2[k] = zq2 * fsig(zq2) * e2; kt2[k] = (1.0f - f2) * fminf(__builtin_amdgcn_rcpf(e2), 5.5406224e34f); dc[k] = e2; }
                    { const int pc = pn * 128 + wc * 32 + 16 * (fq & 1) + 4 * (fq >> 1);
                      const u32x4 a1 = pack8(qi1), b1 = pack8(kt1), a2 = pack8(qi2), b2 = pack8(kt2);
                      bf16_t* q1 = ARR + (size_t)row1 * 512 + pc; bf16_t* q2 = ARR + (size_t)row2 * 512 + pc;
                      *(u32x2*)(q1) = (u32x2){a1.x, a1.y}; *(u32x2*)(q1 + 8) = (u32x2){a1.z, a1.w}; *(u32x2*)(q1 + AS) = (u32x2){b1.x, b1.y}; *(u32x2*)(q1 + AS + 8) = (u32x2){b1.z, b1.w};
                      *(u32x2*)(q2) = (u32x2){a2.x, a2.y}; *(u32x2*)(q2 + 8) = (u32x2){a2.z, a2.w}; *(u32x2*)(q2 + AS) = (u32x2){b2.x, b2.y}; *(u32x2*)(q2 + AS + 8) = (u32x2){b2.z, b2.w}; }
                    if (fr == 15) { float* dp = DEC + (size_t)(row1 >> 5) * 512 + cb; *(f32x4*)dp = (f32x4){dc[0], dc[1], dc[2], dc[3]}; *(f32x4*)(dp + 4) = (f32x4){dc[4], dc[5], dc[6], dc[7]}; }
                    asm volatile("" ::: "memory"); }
        } else if (pn < 8) {
            const int cb = (pn - 4) * 128 + wc * 32 + 8 * fq;
#pragma unroll
            for (int ai = 0; ai < 2; ++ai)
#pragma unroll
                for (int m = 0; m < 4; ++m) { const int row = row0 + ai * HALF + m * 16; const float rs = rstd_of(row);
                    float iv[8], gv[8];
#pragma unroll
                    for (int k = 0; k < 8; ++k) { iv[k] = acc[ai][0][m][k >> 2][k & 3] * rs; const float zg = acc[ai][1][m][k >> 2][k & 3] * rs; gv[k] = zg * fsig(zg); }
                    *(u32x4*)(ARR + 2 * AS + (size_t)row * 512 + cb) = pack8(iv); *(u32x4*)(ARR + 3 * AS + (size_t)row * 512 + cb) = pack8(gv);
                    asm volatile("" ::: "memory"); }
        } else {
            const int ty = (pn - 8) >> 1, head = 4 * ((pn - 8) & 1) + wc; const int d0 = 8 * fq;
            bf16_t* dst = ARR + (size_t)(4 + ty) * AS;
            float gain[2][8]; float csum[2][8];
#pragma unroll
            for (int bj = 0; bj < 2; ++bj)
#pragma unroll
                for (int k = 0; k < 8; ++k) { gain[bj][k] = (ty == 0) ? qg[bj * 32 + d0 + k] * (0.125f * 1.4426950408889634f) : (ty == 1) ? kg[bj * 32 + d0 + k] : 1.0f; csum[bj][k] = 0.f; }
#pragma unroll
            for (int ai = 0; ai < 2; ++ai)
#pragma unroll
                for (int m = 0; m < 4; ++m) { const int row = row0 + ai * HALF + m * 16; const float rs = rstd_of(row);
                    float v[2][8];
#pragma unroll
                    for (int bj = 0; bj < 2; ++bj)
#pragma unroll
                        for (int k = 0; k < 8; ++k) v[bj][k] = acc[ai][bj][m][k >> 2][k & 3] * rs;
                    if (ty < 2) { float ss = 0.f;
#pragma unroll
                        for (int bj = 0; bj < 2; ++bj)
#pragma unroll
                            for (int k = 0; k < 8; ++k) ss += v[bj][k] * v[bj][k];
                        ss += __shfl_xor(ss, 16); ss += __shfl_xor(ss, 32);
                        const float r2 = 1.0f / sqrtf(ss * (1.0f / 64.0f) + 1e-6f);
#pragma unroll
                        for (int bj = 0; bj < 2; ++bj)
#pragma unroll
                            for (int k = 0; k < 8; ++k) { v[bj][k] *= r2 * gain[bj][k]; csum[bj][k] += v[bj][k]; }
                    } else if (ty == 3) {
#pragma unroll
                        for (int bj = 0; bj < 2; ++bj)
#pragma unroll
                            for (int k = 0; k < 8; ++k) v[bj][k] = v[bj][k] * fsig(v[bj][k]); }
                    *(u32x4*)(dst + (size_t)row * 512 + head * 64 + d0) = pack8(v[0]); *(u32x4*)(dst + (size_t)row * 512 + head * 64 + 32 + d0) = pack8(v[1]);
                    asm volatile("" ::: "memory"); }
            if (ty == 1) {
#pragma unroll
                for (int bj = 0; bj < 2; ++bj)
#pragma unroll
                    for (int k = 0; k < 8; ++k) { float s = csum[bj][k]; s += __shfl_xor(s, 1); s += __shfl_xor(s, 2); s += __shfl_xor(s, 4); s += __shfl_xor(s, 8); csum[bj][k] = s; }
                if (fr == 0) { float* kp = KPART + ((size_t)u.pm * 2 + wr) * 512 + head * 64 + d0;
#pragma unroll
                    for (int bj = 0; bj < 2; ++bj) { *(f32x4*)(kp + bj * 32) = (f32x4){csum[bj][0], csum[bj][1], csum[bj][2], csum[bj][3]}; *(f32x4*)(kp + bj * 32 + 4) = (f32x4){csum[bj][4], csum[bj][5], csum[bj][6], csum[bj][7]}; } }
            }
        }
    }
};
struct EpiOut {
    static constexpr bool PERM = true, AFTER_DRAIN = false;
    const bf16_t* xres16; float* out; bf16_t* xb; float* rowss;
    __device__ __forceinline__ void operator()(const f32x4 (&acc)[2][2][4][2], const Unit& u, int wr, int wc, int fr, int fq) const {
        const int col0 = u.pn * BM + wc * 32 + 8 * fq;
        const size_t base = (size_t)(u.pm * BM + wr * 64 + fr) * 1024 + col0;
        u32x4 res[2][4][2];
#pragma unroll
        for (int ai = 0; ai < 2; ++ai)
#pragma unroll
            for (int m = 0; m < 4; ++m)
#pragma unroll
                for (int bj = 0; bj < 2; ++bj) res[ai][m][bj] = *(const u32x4*)(xres16 + base + (size_t)(ai * HALF + m * 16) * 1024 + bj * HALF);
#pragma unroll
        for (int ai = 0; ai < 2; ++ai)
#pragma unroll
            for (int m = 0; m < 4; ++m) {
                const int row = u.pm * BM + ai * HALF + wr * 64 + m * 16 + fr; float ss = 0.f;
#pragma unroll
                for (int bj = 0; bj < 2; ++bj) { const size_t off = (size_t)row * 1024 + col0 + bj * HALF;
                    const u32x4 r = res[ai][m][bj];
                    f32x4 v0 = (f32x4){__builtin_bit_cast(float, r.x << 16), __builtin_bit_cast(float, r.x & 0xffff0000u), __builtin_bit_cast(float, r.y << 16), __builtin_bit_cast(float, r.y & 0xffff0000u)};
                    f32x4 v1 = (f32x4){__builtin_bit_cast(float, r.z << 16), __builtin_bit_cast(float, r.z & 0xffff0000u), __builtin_bit_cast(float, r.w << 16), __builtin_bit_cast(float, r.w & 0xffff0000u)};
                    v0 = v0 + acc[ai][bj][m][0]; v1 = v1 + acc[ai][bj][m][1];
                    if (out) { *(f32x4*)(out + off) = v0; *(f32x4*)(out + off + 4) = v1; }
                    if (xb) { u32x4 w; w.x = cvt_pk_bf16(v0[0], v0[1]); w.y = cvt_pk_bf16(v0[2], v0[3]); w.z = cvt_pk_bf16(v1[0], v1[1]); w.w = cvt_pk_bf16(v1[2], v1[3]); *(u32x4*)(xb + off) = w; }
                    ss += ((v0[0] * v0[0] + v0[1] * v0[1]) + (v0[2] * v0[2] + v0[3] * v0[3])) + ((v1[0] * v1[0] + v1[1] * v1[1]) + (v1[2] * v1[2] + v1[3] * v1[3])); }
                ss += __shfl_xor(ss, 16); ss += __shfl_xor(ss, 32);
                if (fq == 0 && rowss) rowss[(size_t)row * 16 + u.pn * 4 + wc] = ss;
            }
    }
};

template <class Epi, class Sched, bool ALIGN_EPI = false, bool SP2 = false>
__device__ __forceinline__ void gemm_phase(PG8_LAS unsigned char* lds, const Gemm g, const Sched& S, const Epi& E, const int wave0) {
    int tid = wave0 * 64 + lane_id_asm(); asm volatile("" : "+v"(tid));
    const int wid = __builtin_amdgcn_readfirstlane(tid >> 6), lane = tid & 63, wr = wid >> 2, wc = wid & 3, fr = lane & 15, fq = lane >> 4;
    const int K = g.K, nt = K / BK;
    unsigned voffA[2], voffB[2];
#pragma unroll
    for (int i = 0; i < 2; ++i) { int R, C; stage_rc(tid * 16 + i * 8192, R, C); const int Rb = Epi::PERM ? ((R & ~31) + perm32(R & 31)) : R;
        voffA[i] = (unsigned)(R * K + C) * 2u; voffB[i] = (unsigned)(Rb * K + C) * 2u; }
    const size_t kstep = (size_t)(BK * 2);
    const size_t hstep = (size_t)HALF * K * 2;
    const size_t tstep = 2 * hstep;
    const unsigned ldsw = (unsigned)wid * 1024u;
    const int aoff = lds_byte(wr * 64 + fr, fq * 8), boff = lds_byte(wc * 32 + fr, fq * 8);
#define PG8_SA(b, h) (((b) * 2 + (h)) * HTB)
#define PG8_SB(b, h) ((4 + (b) * 2 + (h)) * HTB)
#define PG8_STAGE(bufoff, gbase, voff) do { _Pragma("unroll") for (int _i = 0; _i < 2; ++_i) \
        __builtin_amdgcn_global_load_lds((const unsigned*)((const char*)(gbase) + (voff)[_i]), (PG8_LAS unsigned*)(lds + (bufoff) + ldsw + _i * 8192), 16, 0, 0); } while (0)
#define PG8_LDA(dst, b, h) do { _Pragma("unroll") for (int m = 0; m < 4; ++m) _Pragma("unroll") for (int k = 0; k < 2; ++k) dst[m][k] = *(const PG8_LAS bf16x8*)(lds + PG8_SA(b, h) + aoff + m * 2048 + k * 1024); } while (0)
#define PG8_LDB(dst, b, h) do { _Pragma("unroll") for (int n = 0; n < 2; ++n) _Pragma("unroll") for (int k = 0; k < 2; ++k) dst[n][k] = *(const PG8_LAS bf16x8*)(lds + PG8_SB(b, h) + boff + n * 2048 + k * 1024); } while (0)
#define PG8_MMA(ai, bj, At, Bt) do { __builtin_amdgcn_s_setprio(1); _Pragma("unroll") for (int m = 0; m < 4; ++m) _Pragma("unroll") for (int n = 0; n < 2; ++n) _Pragma("unroll") for (int k = 0; k < 2; ++k) \
        acc[ai][bj][m][n] = __builtin_amdgcn_mfma_f32_16x16x32_bf16(Bt[n][k], At[m][k], acc[ai][bj][m][n], 0, 0, 0); __builtin_amdgcn_s_setprio(0); } while (0)
#define PG8_WAIT_V(n) asm volatile("s_waitcnt vmcnt(" #n ")" ::: "memory")
#define PG8_WAIT_L(n) asm volatile("s_waitcnt lgkmcnt(" #n ")" ::: "memory")
#define PG8_BAR __builtin_amdgcn_s_barrier()
#define PG8_SCHED __builtin_amdgcn_sched_barrier(0)
    Unit cur, nxt; int ui = 0;
    if (!S.next(0, cur)) return;
    f32x4 acc[2][2][4][2];
#pragma unroll
    for (int a = 0; a < 2; ++a)
#pragma unroll
        for (int b = 0; b < 2; ++b)
#pragma unroll
            for (int m = 0; m < 4; ++m)
#pragma unroll
                for (int n = 0; n < 2; ++n) acc[a][b][m][n] = (f32x4){0.f, 0.f, 0.f, 0.f};
    bf16x8 At[4][2], B0[2][2], B1[2][2];
    const char* cA = (const char*)g.A + (size_t)cur.pm * tstep; const char* cB = (const char*)g.Bt + (size_t)cur.pn * tstep;
    S.a_ready(cur);
    if constexpr (SP2) {
        PG8_STAGE(PG8_SB(0, 0), cB, voffB); PG8_STAGE(PG8_SB(0, 1), cB + hstep, voffB); PG8_STAGE(PG8_SA(0, 0), cA, voffA); PG8_STAGE(PG8_SA(0, 1), cA + hstep, voffA);
        if (wr == 1) PG8_BAR;
        PG8_WAIT_V(2); PG8_BAR;
        PG8_STAGE(PG8_SB(1, 0), cB + kstep, voffB); PG8_STAGE(PG8_SA(1, 0), cA + kstep, voffA); PG8_STAGE(PG8_SB(1, 1), cB + hstep + kstep, voffB);
        PG8_WAIT_V(6); PG8_BAR;
    } else {
        PG8_STAGE(PG8_SB(0, 0), cB, voffB); PG8_STAGE(PG8_SA(0, 0), cA, voffA); PG8_STAGE(PG8_SB(0, 1), cB + hstep, voffB); PG8_STAGE(PG8_SA(0, 1), cA + hstep, voffA);
        if (wr == 1) PG8_BAR;
        PG8_WAIT_V(4); PG8_BAR;
        PG8_STAGE(PG8_SB(1, 0), cB + kstep, voffB); PG8_STAGE(PG8_SA(1, 0), cA + kstep, voffA); PG8_STAGE(PG8_SB(1, 1), cB + hstep + kstep, voffB);
        PG8_WAIT_V(6); PG8_BAR;
    }
    for (;;) {
        const bool has_next = S.next(ui + 1, nxt);
        const char* nA = has_next ? (const char*)g.A + (size_t)nxt.pm * tstep : cA; const char* nB = has_next ? (const char*)g.Bt + (size_t)nxt.pn * tstep : cB;
        for (int t = 0; t < nt; t += 2) {
            const bool last = (t == nt - 2);
            const char* a1 = cA + (size_t)(t + 1) * kstep;
            const char* a2 = last ? nA : cA + (size_t)(t + 2) * kstep; const char* b2 = last ? nB : cB + (size_t)(t + 2) * kstep;
            const char* a3 = a2 + kstep; const char* b3 = b2 + kstep;
            if (last && has_next) S.a_ready(nxt);
            if constexpr (SP2) {
            PG8_LDB(B0, 0, 0); PG8_LDB(B1, 0, 1); PG8_SCHED; PG8_LDA(At, 0, 0); PG8_STAGE(PG8_SA(1, 1), a1 + hstep, voffA);
            PG8_WAIT_V(8); PG8_WAIT_L(0); PG8_BAR; PG8_MMA(0, 0, At, B0); PG8_MMA(0, 1, At, B1); PG8_BAR; PG8_SCHED;
            PG8_LDA(At, 0, 1); PG8_STAGE(PG8_SB(0, 0), b2, voffB); PG8_STAGE(PG8_SB(0, 1), b2 + hstep, voffB); PG8_STAGE(PG8_SA(0, 0), a2, voffA);
            PG8_WAIT_V(8); PG8_WAIT_L(0); PG8_BAR; PG8_MMA(1, 0, At, B0); PG8_MMA(1, 1, At, B1); PG8_BAR; PG8_SCHED;
            PG8_LDB(B0, 1, 0); PG8_LDB(B1, 1, 1); PG8_SCHED; PG8_LDA(At, 1, 0); PG8_STAGE(PG8_SA(0, 1), a2 + hstep, voffA);
            PG8_WAIT_V(8); PG8_WAIT_L(0); PG8_BAR; PG8_MMA(0, 0, At, B0); PG8_MMA(0, 1, At, B1); PG8_BAR; PG8_SCHED;
            PG8_LDA(At, 1, 1); PG8_STAGE(PG8_SB(1, 0), b3, voffB); PG8_STAGE(PG8_SB(1, 1), b3 + hstep, voffB); PG8_STAGE(PG8_SA(1, 0), a3, voffA);
            PG8_WAIT_V(8); PG8_WAIT_L(0); PG8_BAR; PG8_MMA(1, 0, At, B0); PG8_MMA(1, 1, At, B1); PG8_BAR; PG8_SCHED;
            } else {
            PG8_LDB(B0, 0, 0); PG8_SCHED; PG8_LDA(At, 0, 0); PG8_STAGE(PG8_SA(1, 1), a1 + hstep, voffA);
            PG8_WAIT_L(8); PG8_BAR; PG8_WAIT_L(0); PG8_MMA(0, 0, At, B0); PG8_BAR; PG8_SCHED;
            PG8_LDB(B1, 0, 1); PG8_STAGE(PG8_SB(0, 0), b2, voffB);
            PG8_BAR; PG8_WAIT_L(0); PG8_MMA(0, 1, At, B1); PG8_BAR;
            PG8_LDA(At, 0, 1); PG8_STAGE(PG8_SA(0, 0), a2, voffA);
            PG8_BAR; PG8_WAIT_L(0); PG8_MMA(1, 0, At, B0); PG8_BAR; PG8_SCHED;
            PG8_STAGE(PG8_SB(0, 1), b2 + hstep, voffB);
            PG8_WAIT_V(6); PG8_BAR; PG8_MMA(1, 1, At, B1); PG8_BAR;
            PG8_LDB(B0, 1, 0); PG8_SCHED; PG8_LDA(At, 1, 0); PG8_STAGE(PG8_SA(0, 1), a2 + hstep, voffA);
            PG8_WAIT_L(8); PG8_BAR; PG8_WAIT_L(0); PG8_MMA(0, 0, At, B0); PG8_BAR; PG8_SCHED;
            PG8_LDB(B1, 1, 1); PG8_STAGE(PG8_SB(1, 0), b3, voffB);
            PG8_BAR; PG8_WAIT_L(0); PG8_MMA(0, 1, At, B1); PG8_BAR;
            PG8_LDA(At, 1, 1); PG8_STAGE(PG8_SA(1, 0), a3, voffA);
            PG8_BAR; PG8_WAIT_L(0); PG8_MMA(1, 0, At, B0); PG8_BAR; PG8_SCHED;
            PG8_STAGE(PG8_SB(1, 1), b3 + hstep, voffB);
            PG8_WAIT_V(6); PG8_BAR; PG8_MMA(1, 1, At, B1); PG8_BAR;
            }
        }
        if constexpr (ALIGN_EPI) { if (wr == 0) PG8_BAR; }
        if constexpr (!Epi::AFTER_DRAIN) { E(acc, cur, wr, wc, fr, fq); S.done(cur); }
        if (!has_next) break;
#pragma unroll
        for (int a = 0; a < 2; ++a)
#pragma unroll
            for (int b = 0; b < 2; ++b)
#pragma unroll
                for (int m = 0; m < 4; ++m)
#pragma unroll
                    for (int n = 0; n < 2; ++n) acc[a][b][m][n] = (f32x4){0.f, 0.f, 0.f, 0.f};
        cur = nxt; cA = nA; cB = nB; ++ui;
        if constexpr (ALIGN_EPI) { if (wr == 1) PG8_BAR; }
    }
    PG8_WAIT_V(0);
    if constexpr (!ALIGN_EPI) { if (wr == 0) PG8_BAR; }
    PG8_BAR;
    if constexpr (Epi::AFTER_DRAIN) { E.fused(acc, cur, wr, wc, fr, fq, lds, wid, lane); S.done(cur); }
#undef PG8_SA
#undef PG8_SB
#undef PG8_STAGE
#undef PG8_LDA
#undef PG8_LDB
#undef PG8_MMA
#undef PG8_WAIT_V
#undef PG8_WAIT_L
#undef PG8_BAR
#undef PG8_SCHED
}
}


constexpr int NWAVES = 8;
#ifndef REP_PROJ
#define REP_PROJ 1
#endif
#ifndef REP_HGRN
#define REP_HGRN 1
#endif
#ifndef REP_MOBA
#define REP_MOBA 1
#endif
#ifndef REP_OUT
#define REP_OUT 1
#endif
#ifndef MK_N_LAUNCHES
#define MK_N_LAUNCHES 1
#endif
constexpr int N_PHASES = 7;
constexpr int N_LAUNCHES = MK_N_LAUNCHES;

constexpr int BATCH = 16, SEQ = 2048, DM = 1024, DEPTH = 2, MTOK = BATCH * SEQ, NIN = 4096;
constexpr int C_HQ = 0, C_HF = 512, C_HI = 1024, C_HG = 1536, C_AQ = 2048, C_AK = 2560, C_AV = 3072, C_AG = 3584;
constexpr float NORM_EPS = 1e-6f;

constexpr size_t MiB = 1u << 20;
constexpr size_t WS_CTL = 0, CTL_ZERO_BYTES = 32768;
constexpr size_t WS_WIN = 2 * MiB;
constexpr size_t WS_WOUT = 18 * MiB;
constexpr size_t WS_LB = 22 * MiB;
constexpr size_t WS_KPART = 22 * MiB + 65536;
constexpr size_t WS_ROWSS = 24 * MiB;
constexpr size_t WS_DEC = 28 * MiB;
constexpr size_t WS_XB = 32 * MiB;
constexpr size_t WS_MIXED = 160 * MiB;
constexpr size_t WS_ARR = 224 * MiB;
constexpr size_t ARR_BYTES = 32 * MiB;
constexpr size_t WS_END = 480 * MiB;
constexpr int CW_QUEUE = 1024;
constexpr int CW_BAR = 4096;

constexpr int RING_OFF = 0, RING_BYTES = 131072;
constexpr int EXTRA_OFF = RING_BYTES, EXTRA_BYTES = 16384;
constexpr int LDSCTL_OFF = EXTRA_OFF + EXTRA_BYTES, MISC_OFF = LDSCTL_OFF + 320;
constexpr int LDS_BYTES = LDSCTL_OFF + 1024;

#define GAS __attribute__((address_space(1)))
#define LAS __attribute__((address_space(3)))
typedef unsigned short bf16;
typedef unsigned v4u __attribute__((ext_vector_type(4)));
typedef float f32x4 __attribute__((ext_vector_type(4)));
typedef GAS unsigned gu32;
#define RLX_AGENT __ATOMIC_RELAXED, __HIP_MEMORY_SCOPE_AGENT
#define LDS_WAIT() asm volatile("s_waitcnt lgkmcnt(0)" ::: "memory")
#define VM_WAIT() asm volatile("s_waitcnt vmcnt(0)" ::: "memory")
__device__ __forceinline__ unsigned f2bf(float f) { unsigned u = __builtin_bit_cast(unsigned, f); return (u + 0x7fffu + ((u >> 16) & 1u)) >> 16; }
__device__ __forceinline__ unsigned pk2(float lo, float hi) { return f2bf(lo) | (f2bf(hi) << 16); }
__device__ __forceinline__ float bf2f(unsigned short b) { return __builtin_bit_cast(float, (unsigned)b << 16); }
__device__ __forceinline__ float bflo(unsigned w) { return __builtin_bit_cast(float, w << 16); }
__device__ __forceinline__ float bfhi(unsigned w) { return __builtin_bit_cast(float, w & 0xffff0000u); }
__device__ __forceinline__ float silu_f(float z) { return z / (1.0f + __expf(-z)); }
__device__ __forceinline__ float sigmoid_f(float z) { return 1.0f / (1.0f + __expf(-z)); }

#define XB_TMO      128
#define XB_XCNT(j)  (256  + 64 * (j))
#define XB_XSUB(j)  (1280 + 64 * (j))
#define XB_XGEN(j)  (2304 + 64 * (j))
#define XB_TOP      3328
#define XB_TOPGEN   3392
#define XCD_BAR_WORDS 3456
#define XB_SPIN_CAP (1u << 18)

__device__ __forceinline__ unsigned xb_ld(unsigned* p)              { return __hip_atomic_load(p, __ATOMIC_RELAXED, __HIP_MEMORY_SCOPE_AGENT); }
__device__ __forceinline__ unsigned xb_add(unsigned* p, unsigned v) { return __hip_atomic_fetch_add(p, v, __ATOMIC_RELAXED, __HIP_MEMORY_SCOPE_AGENT); }
__device__ __forceinline__ unsigned xb_xcc_id() { return (unsigned)__builtin_amdgcn_s_getreg((3 << 11) | 20) & 0xFu; }
#define XB_SPIN(cond, bar) do { unsigned _sp = 0; while (cond) { __builtin_amdgcn_s_sleep(1); \
    if ((++_sp & 255u) == 0u) { if (xb_ld(&(bar)[XB_TMO])) break; if (_sp > XB_SPIN_CAP) { atomicAdd(&(bar)[XB_TMO], 1u); break; } } } } while (0)

struct XcdBarrier {
    unsigned* bar; unsigned x; int wave0;
    volatile LAS unsigned* st;
};

#define XB_IS_T0(wv) ((wv) == 0 && lane_id_asm() == 0)
__device__ __forceinline__ XcdBarrier xcd_barrier_post(unsigned* bar, volatile LAS unsigned* st, int wave0) {
    XcdBarrier b; b.bar = bar; b.x = xb_xcc_id(); b.st = st; b.wave0 = wave0;
    if (XB_IS_T0(wave0)) (void)xb_add(&bar[XB_XCNT(b.x)], 1u);
    return b;
}
__device__ __forceinline__ void xcd_barrier_complete(unsigned* bar, unsigned x, unsigned& nloc, unsigned& nx) {
    const unsigned G = gridDim.x * gridDim.y * gridDim.z;
    unsigned sum, cnt, mine, sp = 0u;
    for (;;) {
        sum = 0u; cnt = 0u; mine = 0u;
#pragma unroll
        for (unsigned j = 0; j < 16; ++j) { const unsigned c = xb_ld(&bar[XB_XCNT(j)]); sum += c; cnt += (c > 0u) ? 1u : 0u; mine = (j == x) ? c : mine; }
        if (sum == G) break;
        __builtin_amdgcn_s_sleep(1);
        if ((++sp & 255u) == 0u) { if (xb_ld(&bar[XB_TMO])) break; if (sp > XB_SPIN_CAP) { atomicAdd(&bar[XB_TMO], 1u); break; } }
    }
    nloc = mine > 0u ? mine : 1u; nx = cnt > 0u ? cnt : 1u;
}

__device__ __forceinline__ void xcd_barrier(const XcdBarrier& b) {
    asm volatile("s_waitcnt vmcnt(0)" ::: "memory");
    __syncthreads();
    if (XB_IS_T0(b.wave0)) {
        unsigned* bar = b.bar;
        __builtin_amdgcn_s_waitcnt(0);
        unsigned nloc = b.st[0], nx = b.st[1];
        if (nloc == 0u) { xcd_barrier_complete(bar, b.x, nloc, nx); b.st[0] = nloc; b.st[1] = nx; }
        const unsigned old = xb_add(&bar[XB_XSUB(b.x)], 1u);
        const unsigned gen = old / nloc;
        if (old + 1u == (gen + 1u) * nloc) {
            __builtin_amdgcn_fence(__ATOMIC_RELEASE, "agent");
            asm volatile("s_waitcnt vmcnt(0)" ::: "memory");
            const unsigned og = xb_add(&bar[XB_TOP], 1u);
            const unsigned tg = og / nx;
            if (og + 1u == (tg + 1u) * nx) xb_add(&bar[XB_TOPGEN], 1u);
            else XB_SPIN(xb_ld(&bar[XB_TOPGEN]) == tg, bar);
            __builtin_amdgcn_fence(__ATOMIC_ACQUIRE, "agent");
            xb_add(&bar[XB_XGEN(b.x)], 1u);
            asm volatile("s_waitcnt vmcnt(0)" ::: "memory");
        } else {
            XB_SPIN(xb_ld(&bar[XB_XGEN(b.x)]) == gen, bar);
            __builtin_amdgcn_fence(__ATOMIC_ACQUIRE, "agent");
            asm volatile("s_waitcnt vmcnt(0)" ::: "memory");
        }
    }
    __syncthreads();
}


struct Frame {
    LAS unsigned char* lds;
    volatile LAS unsigned* MISC;
    int wave0;
    gu32* ctl;
    int vcu, G;
    const float* x; float* out;
    const float *norm_w, *w_in, *lb_logits, *hg_norm_w, *q_norm_w, *k_norm_w, *w_out;
    bf16 *WIN, *WOUT, *XB, *MIXED, *QI, *KT, *HI, *GH, *QN, *KN, *V, *GA;
    float *LB, *KPART, *ROWSS, *DEC;
};

__device__ __forceinline__ float wave_sum(float v) {
#pragma unroll
    for (int o = 1; o < 64; o <<= 1) v += __shfl_xor(v, o);
    return v;
}
__device__ __forceinline__ int win_dest(int oc) {
    if (oc < 2048) { const int grp = oc >> 9, hh = (oc >> 7) & 3, w = oc & 127; return 256 * (((grp >> 1) << 2) + hh) + 128 * (grp & 1) + w; }
    const int ty = (oc - 2048) >> 9, head = (oc >> 6) & 7, bj = (oc >> 5) & 1; return 256 * (8 + 2 * ty + (head >> 2)) + 128 * bj + 32 * (head & 3);
}
__device__ __forceinline__ void p0_transpose_item(const float* W, int K, int N, bf16* WT, const float* kscale, LAS float* scr, int item, int lane, bool permute) {
    const int nblk = N / 32, kb = item / nblk, nb = item % nblk, k0 = 64 * kb, n0 = 32 * nb; const int nd = permute ? win_dest(n0) : n0;
    float wv_[32];
#pragma unroll
    for (int i = 0; i < 32; ++i) wv_[i] = W[(size_t)(k0 + 2 * i + (lane >> 5)) * N + n0 + (lane & 31)];
#pragma unroll
    for (int i = 0; i < 32; ++i) { const int kk = 2 * i + (lane >> 5); const float s = kscale ? kscale[k0 + kk] : 1.0f; scr[kk * 33 + (lane & 31)] = wv_[i] * s; }
    LDS_WAIT(); asm volatile("" ::: "memory");
    const int c = lane & 7;
#pragma unroll
    for (int j = 0; j < 4; ++j) { const int n = (lane >> 3) + 8 * j; const LAS float* s = scr + (8 * c) * 33 + n;
        v4u o; o.x = pk2(s[0 * 33], s[1 * 33]); o.y = pk2(s[2 * 33], s[3 * 33]); o.z = pk2(s[4 * 33], s[5 * 33]); o.w = pk2(s[6 * 33], s[7 * 33]);
        *(GAS v4u*)(WT + (size_t)(nd + n) * K + k0 + 8 * c) = o; }
    LDS_WAIT(); asm volatile("" ::: "memory");
}
#define PHASE_IDS() int t_ = F.wave0 * 64 + lane_id_asm(); asm volatile("" : "+v"(t_)); const int tid = t_, lane = tid & 63, wave = __builtin_amdgcn_readfirstlane(tid >> 6); (void)lane; (void)wave
__device__ __forceinline__ void p0_prologue(Frame& F) {
    PHASE_IDS();
    LAS float* scr = (LAS float*)(F.lds + RING_OFF + wave * 16384);
    const int gw = F.vcu * NWAVES + wave, NGW = F.G * NWAVES;
    constexpr int I_IN = (DM / 64) * (NIN / 32), I_OUT = (DM / 64) * (DM / 32);
    (void)I_OUT;
    for (int it = gw; it < I_IN; it += NGW)
        p0_transpose_item(F.w_in, DM, NIN, F.WIN, F.norm_w, scr, it, lane, true);
    for (int m0 = gw * 4; m0 < MTOK; m0 += NGW * 4) {
        f32x4 v[4][4]; float sq[4];
#pragma unroll
        for (int r = 0; r < 4; ++r) { const GAS f32x4* xr = (const GAS f32x4*)(F.x + (size_t)(m0 + r) * DM) + lane;
#pragma unroll
            for (int j = 0; j < 4; ++j) v[r][j] = xr[64 * j]; }
#pragma unroll
        for (int r = 0; r < 4; ++r) { float a = 0.f;
#pragma unroll
            for (int j = 0; j < 4; ++j) a += (v[r][j].x * v[r][j].x + v[r][j].y * v[r][j].y) + (v[r][j].z * v[r][j].z + v[r][j].w * v[r][j].w);
            sq[r] = a; }
#pragma unroll
        for (int o = 1; o < 64; o <<= 1) {
#pragma unroll
            for (int r = 0; r < 4; ++r) sq[r] += __shfl_xor(sq[r], o); }
#pragma unroll
        for (int r = 0; r < 4; ++r) { GAS unsigned long long* o8 = (GAS unsigned long long*)(F.XB + (size_t)(m0 + r) * DM) + lane;
#pragma unroll
            for (int j = 0; j < 4; ++j) o8[64 * j] = (unsigned long long)pk2(v[r][j].x, v[r][j].y) | ((unsigned long long)pk2(v[r][j].z, v[r][j].w) << 32);
            if (lane < 16) F.ROWSS[(size_t)(m0 + r) * 16 + lane] = (lane == 0) ? sq[r] : 0.f; }
    }
    if (blockIdx.x == 0) { const int c = tid; const float a0 = F.lb_logits[c], a1 = F.lb_logits[512 + c]; const float mx = fmaxf(a0, a1);
        const float e0 = expf(a0 - mx), e1 = expf(a1 - mx); const float p0 = e0 / (e0 + e1), p1 = e1 / (e0 + e1);
        F.LB[c] = 0.f; F.LB[512 + c] = fminf(fmaxf((p0 + p1) - p0, 0.f), 1.0f - 1e-6f); }
}
__device__ __forceinline__ void p0_deferred(Frame& F) {
    PHASE_IDS();
    LAS float* scr = (LAS float*)(F.lds + RING_OFF + wave * 16384);
    const int gw = F.vcu * NWAVES + wave, NGW = F.G * NWAVES;
    constexpr int I_IN = (DM / 64) * (NIN / 32), I_OUT = (DM / 64) * (DM / 32);
    for (int it = gw; it < I_IN + 2 * I_OUT; it += NGW) {
        if (it < 2 * I_OUT) { const int l = it / I_OUT, r = it - l * I_OUT;
            p0_transpose_item(F.w_out + (size_t)l * DM * DM, DM, DM, F.WOUT + (size_t)l * DM * DM, nullptr, scr, r, lane, false); }
        else p0_transpose_item(F.w_in + (size_t)DM * NIN, DM, NIN, F.WIN + (size_t)NIN * DM, F.norm_w + DM, scr, it - 2 * I_OUT, lane, true);
    }
}

constexpr float LOG2E = 1.4426950408889634f;
constexpr float QSCALE2 = 0.125f * LOG2E;
namespace moba {
typedef short bf16x8 __attribute__((ext_vector_type(8)));
typedef short s16x4 __attribute__((ext_vector_type(4)));
typedef float f32x16 __attribute__((ext_vector_type(16)));
typedef float f32x2_t __attribute__((ext_vector_type(2))); typedef __bf16 bf16x2_t __attribute__((ext_vector_type(2)));
__device__ __forceinline__ unsigned cvtpk(float lo, float hi) { f32x2_t v = {lo, hi}; bf16x2_t b = __builtin_convertvector(v, bf16x2_t); return __builtin_bit_cast(unsigned, b); }
__device__ __forceinline__ int crow(int r, int hi) { return (r & 3) + 8 * (r >> 2) + 4 * hi; }
__device__ __forceinline__ float max3f(float a, float b, float c) { float r; asm("v_max3_f32 %0, %1, %2, %3" : "=v"(r) : "v"(a), "v"(b), "v"(c)); return r; }
constexpr int L_K = 0, L_V = 32768, L_WSF = 65536, L_KM = 67584, L_OST = 69632;
constexpr float NEG_BIG = -1e30f;
constexpr float THR = 8.0f;
__device__ __forceinline__ s16x4 vtr(const LAS unsigned char* p) { return __builtin_bit_cast(s16x4, __builtin_amdgcn_ds_read_tr16_b64_v4i16((LAS s16x4*)p)); }
}

__device__ __forceinline__ void moba_glds(unsigned voff, const void* sbase, unsigned lds_dst) { unsigned keep;
    asm volatile("s_mov_b32 %0, m0\n\ts_mov_b32 m0, %3\n\ts_nop 0\n\tglobal_load_lds_dwordx4 %1, %2\n\ts_mov_b32 m0, %0" : "=&s"(keep) : "v"(voff), "s"(sbase), "s"(lds_dst) : "memory"); }
template <bool FIXREF> __device__ __forceinline__ void moba_mfma_body(Frame& F, int l) {
    using namespace moba;
    PHASE_IDS();
    const int r32 = lane & 31, hi = lane >> 5, wid = wave;
    LAS unsigned char* L = F.lds + RING_OFF;
    LAS float* wsf = (LAS float*)(L + L_WSF) + wid * 64;
    LAS float* km = (LAS float*)(L + L_KM);
    LAS float* ost = (LAS float*)(L + L_OST) + wid * 2048;
    float gq = fabsf(F.q_norm_w[l * 64 + lane]), gk = fabsf(F.k_norm_w[l * 64 + lane]);
#pragma unroll
    for (int o = 1; o < 64; o <<= 1) { gq = fmaxf(gq, __shfl_xor(gq, o)); gk = fmaxf(gk, __shfl_xor(gk, o)); }
    gq = __builtin_bit_cast(float, __builtin_amdgcn_readfirstlane(__builtin_bit_cast(int, gq))); gk = __builtin_bit_cast(float, __builtin_amdgcn_readfirstlane(__builtin_bit_cast(int, gk)));
    const float smax2 = 8.0f * gq * gk * LOG2E * 1.02f;
    const float mhat0 = -(smax2 + 1.0f);
    gu32* qctr = F.ctl + CW_QUEUE + 64 * l;
    volatile LAS unsigned* tick = (volatile LAS unsigned*)(F.lds + EXTRA_OFF + 8192);
    if (tid == 0) tick[0] = __hip_atomic_fetch_add(qctr, 1u, RLX_AGENT);
    for (int ui = 0;; ++ui) {
        __syncthreads();
        const int it = __builtin_amdgcn_readfirstlane((int)tick[ui & 1]); if (it >= 1024) break;
        const int qb = 7 - (it >> 7), bh = it & 127;
        const int b = bh >> 3, h = bh & 7; const size_t rowbase = (size_t)b * SEQ; const int q0 = qb * 256, qrel = wid * 32 + r32, tq = q0 + qrel;
        const float sl2 = exp2f(-(float)(h + 1)) * LOG2E;
        bf16x8 qr[4];
        { const GAS bf16* Qw = (const GAS bf16*)(F.QN + (rowbase + q0 + wid * 32 + r32) * 512 + h * 64 + hi * 8);
#pragma unroll
            for (int d0 = 0; d0 < 4; ++d0) qr[d0] = *(const GAS bf16x8*)(Qw + d0 * 16); }
        LAS unsigned char* qlds = (LAS unsigned char*)ost + lane * 16;
        { int tid_u = tid; asm volatile("" : "+v"(tid_u));
          if (tid_u < qb * 64) { const GAS float* kp = (const GAS float*)(F.KPART + ((size_t)b * 8 + (tid_u >> 6)) * 1024 + h * 64 + (tid_u & 63)); km[tid_u] = (kp[0] + kp[512]) * (1.0f / 256.0f); } }
        const unsigned koff = (unsigned)(((rowbase + lane) * 512 + h * 64 + wid * 8) * 2);
        unsigned voff; { const int vr = 8 * wid + (lane >> 3), sl = lane & 7; const int ch = ((((sl >> 2) ^ ((vr >> 1) & 1)) << 2) | (sl & 3)); voff = (unsigned)((((size_t)MTOK + rowbase + vr) * 512 + h * 64 + ch * 8) * 2); }
        const unsigned lds0 = (unsigned)(uintptr_t)L;
#define MOBA_ISSUE(t_, bufi) do { moba_glds(koff, (const void*)((const char*)F.KN + (size_t)(t_) * 65536), (unsigned)__builtin_amdgcn_readfirstlane((int)(lds0 + L_K + (bufi) * 8192 + wid * 1024))); \
            moba_glds(voff, (const void*)((const char*)F.KN + (size_t)(t_) * 65536), (unsigned)__builtin_amdgcn_readfirstlane((int)(lds0 + L_V + (bufi) * 8192 + wid * 1024))); } while (0)
        const int NT = 4 * (qb + 1);
        int t0 = 0; { const float dstar = (151.0f + 2.0f * smax2) / sl2; const float x = ((float)(q0 - 63) - dstar) * (1.0f / 64.0f); if (x > 0.f) t0 = ((int)x) & ~1; if (t0 > NT - 4) t0 = NT - 4; t0 = __builtin_amdgcn_readfirstlane(t0); }
        unsigned nticket = 0u; if (tid == 0) nticket = __hip_atomic_fetch_add(qctr, 1u, RLX_AGENT);
        MOBA_ISSUE(t0, 0); MOBA_ISSUE(t0 + 1, 1); MOBA_ISSUE(t0 + 2, 2);
        __syncthreads();
        unsigned selmask = 0;
        { float gt[7]; float qf32[32];
#pragma unroll
            for (int d0 = 0; d0 < 4; ++d0)
#pragma unroll
                for (int e = 0; e < 8; ++e) qf32[d0 * 8 + e] = bf2f((unsigned short)qr[d0][e]);
#pragma unroll
            for (int i = 0; i < 32; ++i) asm volatile("" : "+v"(qf32[i]));
#pragma unroll
            for (int j = 0; j < 7; ++j) { float s = 0.f;
                if (j < qb) {
#pragma unroll
                    for (int d0 = 0; d0 < 4; ++d0)
#pragma unroll
                        for (int e = 0; e < 8; ++e) s += qf32[d0 * 8 + e] * km[j * 64 + d0 * 16 + hi * 8 + e];
                    auto rr = __builtin_amdgcn_permlane32_swap(__float_as_uint(s), __float_as_uint(s), false, false);
                    s = __uint_as_float(rr[0]) + __uint_as_float(rr[1]); }
                gt[j] = s; }
#pragma unroll
            for (int j = 0; j < 7; ++j) { int rank = 0;
#pragma unroll
                for (int i = 0; i < 7; ++i) if (i != j && i < qb) rank += (gt[i] > gt[j] || (gt[i] == gt[j] && i < j)) ? 1 : 0;
                if (j < qb && rank < 3) selmask |= 1u << j; }
            selmask |= 1u << qb; }
        if (!FIXREF) {
#pragma unroll
            for (int d0 = 0; d0 < 4; ++d0) *(LAS bf16x8*)(qlds + d0 * 1024) = qr[d0]; }
        float mhat = mhat0, l_reg = 0.f; f32x16 o[2]; o[0] = f32x16{}; o[1] = f32x16{};
        const int kbase = L_K + hi * 1024 + r32 * 16;
        const int g16 = lane >> 4, i16 = lane & 15, tq4 = i16 >> 2, tp4 = i16 & 3;
        const int vrow0 = 4 * hi + tq4;
        if (tid == 0) tick[(ui + 1) & 1] = nticket;
        asm volatile("s_waitcnt vmcnt(2)" ::: "memory");
        __syncthreads();
#define MOBA_KLOAD(KOFF) do { if (!FIXREF) { _Pragma("unroll") for (int d0 = 0; d0 < 4; ++d0) qf_[d0] = *(const LAS bf16x8*)(qlds + d0 * 1024); } \
            _Pragma("unroll") for (int d0 = 0; d0 < 4; ++d0) { \
            kfr[2 * d0] = *(const LAS bf16x8*)(L + (KOFF) + kbase + d0 * 2048); kfr[2 * d0 + 1] = *(const LAS bf16x8*)(L + (KOFF) + kbase + d0 * 2048 + 512); } } while (0)
#define MOBA_KLOADH(KOFF, H) do { _Pragma("unroll") for (int d0 = 2 * (H); d0 < 2 * (H) + 2; ++d0) { \
            kfr[2 * d0] = *(const LAS bf16x8*)(L + (KOFF) + kbase + d0 * 2048); kfr[2 * d0 + 1] = *(const LAS bf16x8*)(L + (KOFF) + kbase + d0 * 2048 + 512); } } while (0)
#define MOBA_VLOAD(VOFF) do { _Pragma("unroll") for (int dblk = 0; dblk < 2; ++dblk) _Pragma("unroll") for (int ks = 0; ks < 4; ++ks) { \
            const int rlo = 16 * ks + vrow0, rhi = rlo + 8; \
            vlo[dblk * 4 + ks] = vtr(L + L_V + (VOFF) + rlo * 128 + ((dblk ^ ((rlo >> 1) & 1)) * 64) + (16 * (g16 & 1) + 4 * tp4) * 2); \
            vhi[dblk * 4 + ks] = vtr(L + L_V + (VOFF) + rhi * 128 + ((dblk ^ ((rhi >> 1) & 1)) * 64) + (16 * (g16 & 1) + 4 * tp4) * 2); } } while (0)
#define MOBA_VLOADH(VOFF, DB) do { _Pragma("unroll") for (int ks = 0; ks < 4; ++ks) { \
            const int rlo = 16 * ks + vrow0, rhi = rlo + 8; \
            vlo[(DB) * 4 + ks] = vtr(L + L_V + (VOFF) + rlo * 128 + (((DB) ^ ((rlo >> 1) & 1)) * 64) + (16 * (g16 & 1) + 4 * tp4) * 2); \
            vhi[(DB) * 4 + ks] = vtr(L + L_V + (VOFF) + rhi * 128 + (((DB) ^ ((rhi >> 1) & 1)) * 64) + (16 * (g16 & 1) + 4 * tp4) * 2); } } while (0)
#define MOBA_QK(CANSKIP, TT, P0, P1) do { \
            const int blk_ = (TT) >> 2; \
            if (!((CANSKIP) && (blk_ == qb) && (64 * ((TT) & 3) > 32 * wid + 31))) { \
                const bool sel_ = ((selmask >> blk_) & 1u); \
                float sc0_ = sel_ ? (-mhat - sl2 * (float)(tq - 64 * (TT) - 4 * hi)) : NEG_BIG; asm volatile("" : "+v"(sc0_)); \
_Pragma("unroll") \
                for (int r = 0; r < 16; ++r) { P0[r] = __builtin_fmaf(sl2, (float)((r & 3) + 8 * (r >> 2)), sc0_); P1[r] = __builtin_fmaf(sl2, (float)(32 + (r & 3) + 8 * (r >> 2)), sc0_); } \
_Pragma("unroll") \
                for (int d0 = 0; d0 < 4; ++d0) { \
                    P0 = __builtin_amdgcn_mfma_f32_32x32x16_bf16(kfr[2 * d0], FIXREF ? qr[d0] : qf_[d0], P0, 0, 0, 0); \
                    P1 = __builtin_amdgcn_mfma_f32_32x32x16_bf16(kfr[2 * d0 + 1], FIXREF ? qr[d0] : qf_[d0], P1, 0, 0, 0); } \
            } } while (0)
#define MOBA_SM(OWNP, TT, P0, P1, HAVE_NEXT, N0, N1) do { \
            const bool own = (OWNP); const int jb = (TT) & 3; \
            if (!(own && (64 * jb > 32 * wid + 31))) { \
                if (own && (64 * jb + 63 > 32 * wid)) { \
_Pragma("unroll") \
                    for (int r = 0; r < 16; ++r) { const int kvl = 64 * jb + crow(r, hi); if (kvl > qrel) P0[r] = NEG_BIG; if (kvl + 32 > qrel) P1[r] = NEG_BIG; } } \
                if (!FIXREF) { \
                float rm = max3f(P0[0], P1[0], P0[1]), rm2 = max3f(P1[1], P0[2], P1[2]); \
_Pragma("unroll") \
                for (int r = 3; r < 15; r += 2) { rm = max3f(rm, P0[r], P1[r]); rm2 = max3f(rm2, P0[r + 1], P1[r + 1]); } \
                rm = max3f(rm, rm2, fmaxf(P0[15], P1[15])); \
                { auto rr = __builtin_amdgcn_permlane32_swap(__float_as_uint(rm), __float_as_uint(rm), false, false); rm = fmaxf(__uint_as_float(rr[0]), __uint_as_float(rr[1])); } \
                if (__any(rm > THR)) { \
                    const float dl = fmaxf(rm, 0.f); mhat += dl; \
_Pragma("unroll") \
                    for (int r = 0; r < 16; ++r) { P0[r] -= dl; P1[r] -= dl; } \
                    if (HAVE_NEXT) { \
_Pragma("unroll") \
                        for (int r = 0; r < 16; ++r) { N0[r] -= dl; N1[r] -= dl; } } \
                    const float f = __builtin_amdgcn_exp2f(-dl); l_reg *= f; \
                    if (hi == 0) wsf[r32] = f; \
_Pragma("unroll") \
                    for (int r = 0; r < 16; ++r) { const float fr = wsf[crow(r, hi)]; o[0][r] *= fr; o[1][r] *= fr; } } \
                } \
                float sacc = 0.f, sacc2 = 0.f; \
_Pragma("unroll") \
                for (int r = 0; r < 16; ++r) { P0[r] = __builtin_amdgcn_exp2f(P0[r]); P1[r] = __builtin_amdgcn_exp2f(P1[r]); sacc += P0[r]; sacc2 += P1[r]; } \
                l_reg += sacc + sacc2; \
                { v4u w; \
_Pragma("unroll") \
                    for (int ks = 0; ks < 4; ++ks) { \
_Pragma("unroll") \
                        for (int e = 0; e < 4; ++e) { const int rb = (ks & 1) * 8 + 2 * e; w[e] = (ks < 2) ? cvtpk(P0[rb], P0[rb + 1]) : cvtpk(P1[rb], P1[rb + 1]); } \
                        pa[ks] = __builtin_bit_cast(bf16x8, w); } } \
            } } while (0)
#define MOBA_PV(OWNP, TT) do { \
            if (!((OWNP) && (64 * ((TT) & 3) > 32 * wid + 31))) { \
_Pragma("unroll") \
                for (int dblk = 0; dblk < 2; ++dblk) \
_Pragma("unroll") \
                    for (int ks = 0; ks < 4; ++ks) { \
                        const s16x4 lo = vlo[dblk * 4 + ks], hh = vhi[dblk * 4 + ks]; \
                        const bf16x8 vf = __builtin_shufflevector(lo, hh, 0, 1, 2, 3, 4, 5, 6, 7); \
                        o[dblk] = __builtin_amdgcn_mfma_f32_32x32x16_bf16(pa[ks], vf, o[dblk], 0, 0, 0); } \
            } } while (0)
        f32x16 pA0, pA1, pB0, pB1; bf16x8 kfr[8], qf_[4], pa[4]; s16x4 vlo[8], vhi[8];
        MOBA_KLOAD(0); MOBA_QK(true, t0, pA0, pA1);
        int c0o = 0;
#define MOBA_ILV() do { __builtin_amdgcn_sched_group_barrier(0x002, 16, 0); \
_Pragma("unroll") \
            for (int g_ = 0; g_ < 8; ++g_) { __builtin_amdgcn_sched_group_barrier(0x008, 1, 0); __builtin_amdgcn_sched_group_barrier(0x002, 12, 0); } } while (0)
#define MOBA_STEP2(OWNP) do { \
            const int c1o = (c0o + 1) & 3, c2o = (c0o + 2) & 3, c3o = (c0o + 3) & 3; \
            if (!(OWNP) || t + 3 < NT) MOBA_ISSUE(t + 3, c3o); \
            if (FIXREF) { MOBA_KLOAD(c1o * 8192); __builtin_amdgcn_sched_barrier(0); \
                MOBA_QK(OWNP, t + 1, pB0, pB1); MOBA_SM(OWNP, t, pA0, pA1, false, pB0, pB1); if (!(OWNP)) MOBA_ILV(); __builtin_amdgcn_sched_barrier(0); \
                MOBA_VLOAD(c0o * 8192); __builtin_amdgcn_sched_barrier(0); MOBA_PV(OWNP, t); } \
            else { MOBA_KLOAD(c1o * 8192); __builtin_amdgcn_sched_barrier(0); MOBA_QK(true, t + 1, pB0, pB1); __builtin_amdgcn_sched_barrier(0); \
                MOBA_VLOAD(c0o * 8192); __builtin_amdgcn_sched_barrier(0); MOBA_SM(OWNP, t, pA0, pA1, true, pB0, pB1); MOBA_PV(OWNP, t); } \
            if (!(OWNP) || t + 3 < NT) asm volatile("s_waitcnt vmcnt(2)" ::: "memory"); else asm volatile("s_waitcnt vmcnt(0)" ::: "memory"); \
            __syncthreads(); \
            if (!(OWNP) || t + 4 < NT) MOBA_ISSUE(t + 4, c0o); \
            if (FIXREF) { if (!(OWNP) || t + 2 < NT) MOBA_KLOAD(c2o * 8192); __builtin_amdgcn_sched_barrier(0); \
                if (!(OWNP) || t + 2 < NT) MOBA_QK(OWNP, t + 2, pA0, pA1); MOBA_SM(OWNP, t + 1, pB0, pB1, false, pA0, pA1); if (!(OWNP)) MOBA_ILV(); __builtin_amdgcn_sched_barrier(0); \
                MOBA_VLOAD(c1o * 8192); __builtin_amdgcn_sched_barrier(0); MOBA_PV(OWNP, t + 1); } \
            else { if (t + 2 < NT) { MOBA_KLOAD(c2o * 8192); __builtin_amdgcn_sched_barrier(0); MOBA_QK(true, t + 2, pA0, pA1); __builtin_amdgcn_sched_barrier(0); } \
                MOBA_VLOAD(c1o * 8192); __builtin_amdgcn_sched_barrier(0); MOBA_SM(OWNP, t + 1, pB0, pB1, (t + 2 < NT), pA0, pA1); MOBA_PV(OWNP, t + 1); } \
            if (!(OWNP) || t + 4 < NT) asm volatile("s_waitcnt vmcnt(2)" ::: "memory"); else asm volatile("s_waitcnt vmcnt(0)" ::: "memory"); \
            __syncthreads(); \
            c0o = c2o; } while (0)
        int t = t0;
        for (; t < NT - 4; t += 2) MOBA_STEP2(false);
        for (; t < NT; t += 2) MOBA_STEP2(true);
#undef MOBA_STEP2
#undef MOBA_ISSUE
#undef MOBA_KLOAD
#undef MOBA_KLOADH
#undef MOBA_VLOAD
#undef MOBA_VLOADH
#undef MOBA_QK
#undef MOBA_SM
#undef MOBA_PV
        int lane_e = lane; asm volatile("" : "+v"(lane_e));
        const int r32e = lane_e & 31, hie = lane_e >> 5;
        v4u gwv[4];
#pragma unroll
        for (int i = 0; i < 4; ++i) gwv[i] = *(const GAS v4u*)(F.GA + (rowbase + q0 + wid * 32 + i * 8 + (lane_e >> 3)) * 512 + h * 64 + (lane_e & 7) * 8);
        { auto rr = __builtin_amdgcn_permlane32_swap(__float_as_uint(l_reg), __float_as_uint(l_reg), false, false); l_reg = __uint_as_float(rr[0]) + __uint_as_float(rr[1]); }
        if (hie == 0) wsf[r32e] = 1.0f / l_reg;
#pragma unroll
        for (int r = 0; r < 16; ++r) { const float rl = wsf[crow(r, hie)]; ost[crow(r, hie) * 64 + r32e] = o[0][r] * rl; ost[crow(r, hie) * 64 + 32 + r32e] = o[1][r] * rl; }
#pragma unroll
        for (int i = 0; i < 4; ++i) { const int row = i * 8 + (lane_e >> 3), ch = lane_e & 7;
            const f32x4 a = *(const LAS f32x4*)(ost + row * 64 + ch * 8), c2 = *(const LAS f32x4*)(ost + row * 64 + ch * 8 + 4);
            const size_t grow = rowbase + q0 + wid * 32 + row;
            const v4u gw = gwv[i];
            v4u ow; ow.x = pk2(a[0] * bflo(gw.x), a[1] * bfhi(gw.x)); ow.y = pk2(a[2] * bflo(gw.y), a[3] * bfhi(gw.y));
            ow.z = pk2(c2[0] * bflo(gw.z), c2[1] * bfhi(gw.z)); ow.w = pk2(c2[2] * bflo(gw.w), c2[3] * bfhi(gw.w));
            *(GAS v4u*)(F.MIXED + grow * DM + 512 + h * 64 + ch * 8) = ow; }
    }
    __syncthreads();
}


__device__ __forceinline__ void moba_mfma_phase(Frame& F, int l) {
    float gq = 0.f, gk = 0.f;
    for (int i = 0; i < 64; ++i) { gq = fmaxf(gq, fabsf(F.q_norm_w[l * 64 + i])); gk = fmaxf(gk, fabsf(F.k_norm_w[l * 64 + i])); }
    if (2.0f * (8.0f * gq * gk * LOG2E * 1.02f) + 1.0f <= 100.0f) moba_mfma_body<true>(F, l); else moba_mfma_body<false>(F, l);
}

namespace hg {
typedef short bf16x8 __attribute__((ext_vector_type(8)));
typedef short s16x4 __attribute__((ext_vector_type(4)));
typedef float f32x4 __attribute__((ext_vector_type(4)));
typedef unsigned u32x2 __attribute__((ext_vector_type(2)));
constexpr int SLOT = 33792, NSLOT = 4;
constexpr int L_SC = NSLOT * SLOT, L_NRM = L_SC + 4096;
constexpr int NSTEP = SEQ / 32;
__device__ __forceinline__ int fsw(int t) { return ((t & 7) << 2) | (((t >> 3) & 1) << 1); }
__device__ __forceinline__ int unit_off(int tok, int cg) { return 8 * (32 * tok + (cg ^ fsw(tok))); }
__device__ __forceinline__ s16x4 rd64(const LAS unsigned char* p) { return *(const LAS s16x4*)p; }
__device__ __forceinline__ s16x4 vtr(const LAS unsigned char* p) { return __builtin_bit_cast(s16x4, __builtin_amdgcn_ds_read_tr16_b64_v4i16((LAS s16x4*)p)); }
__device__ __forceinline__ bf16x8 cat(s16x4 a, s16x4 b) { return __builtin_shufflevector(a, b, 0, 1, 2, 3, 4, 5, 6, 7); }
__device__ __forceinline__ s16x4 pack4(f32x4 v) { u32x2 w; w.x = moba::cvtpk(v[0], v[1]); w.y = moba::cvtpk(v[2], v[3]); return __builtin_bit_cast(s16x4, w); }
__device__ __forceinline__ void glds16(const GAS void* gsrc, unsigned lds_dst) { unsigned keep;
    asm volatile("s_mov_b32 %0, m0\n\ts_mov_b32 m0, %2\n\ts_nop 0\n\tglobal_load_lds_dwordx4 %1, off\n\ts_mov_b32 m0, %0" : "=&s"(keep) : "v"(gsrc), "s"(lds_dst) : "memory"); }
__device__ __forceinline__ void glds16s(unsigned voff, const void* sbase, unsigned lds_dst) { unsigned keep;
    asm volatile("s_mov_b32 %0, m0\n\ts_mov_b32 m0, %3\n\ts_nop 0\n\tglobal_load_lds_dwordx4 %1, %2\n\ts_mov_b32 m0, %0" : "=&s"(keep) : "v"(voff), "s"(sbase), "s"(lds_dst) : "memory"); }
#define HG_MFMA(a, b, c) __builtin_amdgcn_mfma_f32_16x16x32_bf16((a), (b), (c), 0, 0, 0)
}

__device__ __forceinline__ void hgrn_mfma_phase(Frame& F, int l) {
    using namespace hg;
    PHASE_IDS();
    const int w = wave, c16 = lane & 15, g = lane >> 4;
    LAS unsigned char* L = F.lds + RING_OFF;
    const s16x4 z4 = (s16x4){0, 0, 0, 0};
    for (int it = (int)blockIdx.x; it < 64; it += F.G) {
        const int b = it >> 2, h = it & 3; const size_t rowbase = (size_t)b * SEQ;
        const int da = w >> 1;
        unsigned dsrc[4];
#pragma unroll
        for (int i = 0; i < 4; ++i) { const int t = 16 * (w & 1) + 4 * i + (lane >> 4); const int sc = (lane & 15) ^ (fsw(t) >> 1);
            dsrc[i] = (unsigned)((((size_t)da * MTOK + rowbase + t) * 512 + h * 128 + 8 * sc) * 2); }
        const unsigned ddec = (unsigned)((((size_t)b * NSTEP) * 512 + h * 128 + 4 * lane) * 4);
        const int ddst = da * 8192 + (w & 1) * 4096;
        const unsigned lds0 = (unsigned)(uintptr_t)(F.lds + RING_OFF);
#define HG_ISSUE(step) do { const unsigned so_ = lds0 + (unsigned)(((step) & 3) * SLOT); \
            _Pragma("unroll") for (int i = 0; i < 4; ++i) \
                glds16s(dsrc[i], (const void*)((const char*)F.QI + (size_t)(step) * (32 * 512 * 2)), (unsigned)__builtin_amdgcn_readfirstlane((int)(so_ + ddst + i * 1024))); \
            if (w == 0) glds16s(ddec, (const void*)((const char*)F.DEC + (size_t)(step) * 2048), (unsigned)__builtin_amdgcn_readfirstlane((int)(so_ + 32768))); } while (0)
        f32x4 S[8]; bf16x8 Sb[4];
#pragma unroll
        for (int tk = 0; tk < 8; ++tk) S[tk] = (f32x4){0.f, 0.f, 0.f, 0.f};
#pragma unroll
        for (int ks = 0; ks < 4; ++ks) Sb[ks] = (bf16x8){0, 0, 0, 0, 0, 0, 0, 0};
        f32x4 oprev[2]; oprev[0] = (f32x4){0.f, 0.f, 0.f, 0.f}; oprev[1] = oprev[0];
        u32x2 gprev[2]; gprev[0] = (u32x2){0u, 0u}; gprev[1] = gprev[0];
        float hw[4];
#pragma unroll
        for (int r = 0; r < 4; ++r) hw[r] = F.hg_norm_w[l * 128 + 16 * w + 4 * g + r];
        asm volatile("" : "+v"(hw[0]), "+v"(hw[1]), "+v"(hw[2]), "+v"(hw[3]));
        LAS float* nrm = (LAS float*)(L + L_NRM);
        LAS unsigned char* SC = L + L_SC;
        HG_ISSUE(0); HG_ISSUE(1); HG_ISSUE(2);
        asm volatile("s_waitcnt vmcnt(8)\n\ts_barrier" ::: "memory");
        const int trq = c16 >> 2, trp = c16 & 3;
        int ro0 = 256 * c16 + 16 * (g ^ (fsw(c16) >> 1)), ko0 = 256 * (4 * g + trq) + 16 * (trp ^ (fsw(4 * g + trq) >> 1));
#define RO(ks) (ro0 ^ (64 * (ks)))
#define KO(tk) (ko0 ^ (64 * ((tk) >> 1) + 8 * ((tk) & 1)))
        const int io_ = unit_off(4 * g + trq, 4 * w + trp), go_ = unit_off(c16, 4 * w + g);
        bf16x8 qf[2][4];
#define HG_LOADQ(slotbase) do { _Pragma("unroll") for (int tt = 0; tt < 2; ++tt) _Pragma("unroll") for (int ks = 0; ks < 4; ++ks) \
            qf[tt][ks] = *(const LAS bf16x8*)((slotbase) + RO(ks) + 4096 * tt); } while (0)
#define HG_FINAL(step, P) do { _Pragma("unroll") for (int tt = 0; tt < 2; ++tt) { \
            const float ssum = ((P[tt][0] + P[tt][1]) + (P[tt][2] + P[tt][3])) + ((P[tt][4] + P[tt][5]) + (P[tt][6] + P[tt][7])); \
            const float rstd = __builtin_amdgcn_rsqf(ssum * (1.0f / 128.0f) + NORM_EPS); \
            u32x2 wv; wv.x = moba::cvtpk(oprev[tt][0] * rstd * hw[0] * bflo(gprev[tt].x), oprev[tt][1] * rstd * hw[1] * bfhi(gprev[tt].x)); \
            wv.y = moba::cvtpk(oprev[tt][2] * rstd * hw[2] * bflo(gprev[tt].y), oprev[tt][3] * rstd * hw[3] * bfhi(gprev[tt].y)); \
            *(GAS u32x2*)(F.MIXED + (rowbase + (size_t)(step) * 32 + 16 * tt + c16) * DM + h * 128 + 16 * w + 4 * g) = wv; } } while (0)
        HG_LOADQ(L);
        for (int n = 0; n < NSTEP; ++n) {
            asm volatile("" : "+v"(ro0), "+v"(ko0));
            if (n + 3 < NSTEP) HG_ISSUE(n + 3);
            const LAS unsigned char* Qs = L + (n & 3) * SLOT; const LAS unsigned char* Ks = Qs + 8192; const LAS unsigned char* Is = Qs + 16384; const LAS unsigned char* Gs = Qs + 24576;
            const LAS float* Ds = (const LAS float*)(Qs + 32768);
            LAS unsigned char* SCn = SC + (n & 1) * 1536;
            bf16x8 kf[4];
            if (w < 3) { const int st = (w == 2) ? 1 : 0;
#pragma unroll
                for (int ks = 0; ks < 4; ++ks) kf[ks] = *(const LAS bf16x8*)(Ks + RO(ks) + 4096 * st); }
            u32x2 gcur[2];
#pragma unroll
            for (int tt = 0; tt < 2; ++tt) gcur[tt] = *(const LAS u32x2*)(Gs + go_ + 4096 * tt);
            s16x4 itr[2];
#pragma unroll
            for (int st = 0; st < 2; ++st) itr[st] = vtr(Is + io_ + 4096 * st);
            const bf16x8 i01 = cat(itr[0], itr[1]);
            bf16x8 k01[4]; f32x4 dv4[4];
#pragma unroll
            for (int tk = 0; tk < 4; ++tk) { k01[tk] = cat(vtr(Ks + KO(tk)), vtr(Ks + KO(tk) + 4096)); dv4[tk] = *(const LAS f32x4*)(Ds + 16 * tk + 4 * g); }
            f32x4 o[2];
#pragma unroll
            for (int tt = 0; tt < 2; ++tt) { f32x4 a = (f32x4){0.f, 0.f, 0.f, 0.f};
#pragma unroll
                for (int ks = 0; ks < 4; ++ks) a = HG_MFMA(Sb[ks], qf[tt][ks], a);
                o[tt] = a; }
            if (w < 3) { f32x4 sc = (f32x4){0.f, 0.f, 0.f, 0.f};
                if (w == 0) {
#pragma unroll
                    for (int ks = 0; ks < 4; ++ks) sc = HG_MFMA(kf[ks], qf[0][ks], sc);
                } else {
#pragma unroll
                    for (int ks = 0; ks < 4; ++ks) sc = HG_MFMA(kf[ks], qf[1][ks], sc); }
                if (w != 1) {
#pragma unroll
                    for (int r = 0; r < 4; ++r) if (4 * g + r > c16) sc[r] = 0.f; }
                *(LAS s16x4*)(SCn + w * 512 + lane * 8) = pack4(sc); }
#pragma unroll
            for (int tk = 0; tk < 4; ++tk) S[tk] = HG_MFMA(k01[tk], i01, S[tk]);
            asm volatile("" ::: "memory");
            { bf16x8 k2[4]; f32x4 d2[4];
#pragma unroll
                for (int tk = 0; tk < 4; ++tk) { k2[tk] = cat(vtr(Ks + KO(tk + 4)), vtr(Ks + KO(tk + 4) + 4096)); d2[tk] = *(const LAS f32x4*)(Ds + 16 * (tk + 4) + 4 * g); }
#pragma unroll
                for (int tk = 0; tk < 4; ++tk) S[tk] = S[tk] * dv4[tk];
#pragma unroll
                for (int ks = 0; ks < 2; ++ks) Sb[ks] = cat(pack4(S[2 * ks]), pack4(S[2 * ks + 1]));
#pragma unroll
                for (int tk = 0; tk < 4; ++tk) S[tk + 4] = HG_MFMA(k2[tk], i01, S[tk + 4]);
#pragma unroll
                for (int tk = 0; tk < 4; ++tk) S[tk + 4] = S[tk + 4] * d2[tk];
#pragma unroll
                for (int ks = 2; ks < 4; ++ks) Sb[ks] = cat(pack4(S[2 * ks]), pack4(S[2 * ks + 1])); }
            if (n >= NSTEP - 3) asm volatile("s_waitcnt vmcnt(0) lgkmcnt(0)\n\ts_barrier" ::: "memory");
            else if (n <= 1) asm volatile("s_waitcnt vmcnt(8) lgkmcnt(0)\n\ts_barrier" ::: "memory");
            else if (n == 2) asm volatile("s_waitcnt vmcnt(10) lgkmcnt(0)\n\ts_barrier" ::: "memory");
            else asm volatile("s_waitcnt vmcnt(12) lgkmcnt(0)\n\ts_barrier" ::: "memory");
            const s16x4 sc00 = rd64(SCn + lane * 8), sc01 = rd64(SCn + 512 + lane * 8), sc11 = rd64(SCn + 1024 + lane * 8);
            float pn[2][8];
            if (n > 0) {
#pragma unroll
                for (int tt = 0; tt < 2; ++tt)
#pragma unroll
                    for (int ww = 0; ww < 8; ++ww) pn[tt][ww] = nrm[((n - 1) & 1) * 256 + ww * 32 + 16 * tt + c16]; }
            if (n + 1 < NSTEP) HG_LOADQ(L + ((n + 1) & 3) * SLOT);
            o[0] = HG_MFMA(cat(itr[0], z4), cat(sc00, z4), o[0]);
            o[1] = HG_MFMA(i01, cat(sc01, sc11), o[1]);
            { float ss0 = (o[0][0] * o[0][0] + o[0][1] * o[0][1]) + (o[0][2] * o[0][2] + o[0][3] * o[0][3]);
              float ss1 = (o[1][0] * o[1][0] + o[1][1] * o[1][1]) + (o[1][2] * o[1][2] + o[1][3] * o[1][3]);
              { auto r0 = __builtin_amdgcn_permlane16_swap(__float_as_uint(ss0), __float_as_uint(ss0), false, false); auto r1 = __builtin_amdgcn_permlane16_swap(__float_as_uint(ss1), __float_as_uint(ss1), false, false);
                ss0 = __uint_as_float(r0[0]) + __uint_as_float(r0[1]); ss1 = __uint_as_float(r1[0]) + __uint_as_float(r1[1]); }
              { auto r0 = __builtin_amdgcn_permlane32_swap(__float_as_uint(ss0), __float_as_uint(ss0), false, false); auto r1 = __builtin_amdgcn_permlane32_swap(__float_as_uint(ss1), __float_as_uint(ss1), false, false);
                ss0 = __uint_as_float(r0[0]) + __uint_as_float(r0[1]); ss1 = __uint_as_float(r1[0]) + __uint_as_float(r1[1]); }
              if (g == 0) { nrm[(n & 1) * 256 + w * 32 + c16] = ss0; nrm[(n & 1) * 256 + w * 32 + 16 + c16] = ss1; } }
            if (n > 0) HG_FINAL(n - 1, pn);
            oprev[0] = o[0]; oprev[1] = o[1]; gprev[0] = gcur[0]; gprev[1] = gcur[1];
        }
        asm volatile("s_waitcnt vmcnt(0) lgkmcnt(0)\n\ts_barrier" ::: "memory");
        { float pn[2][8];
#pragma unroll
            for (int tt = 0; tt < 2; ++tt)
#pragma unroll
                for (int ww = 0; ww < 8; ++ww) pn[tt][ww] = nrm[((NSTEP - 1) & 1) * 256 + ww * 32 + 16 * tt + c16];
            HG_FINAL(NSTEP - 1, pn); }
        asm volatile("s_waitcnt vmcnt(0) lgkmcnt(0)\n\ts_barrier" ::: "memory");
#undef RO
#undef KO
#undef HG_LOADQ
#undef HG_FINAL
#undef HG_ISSUE
    }
}

struct Args { const float* in[8]; float* out; unsigned char* ws; int ph_lo, ph_hi, li, pad; };
__global__ void __launch_bounds__(NWAVES * 64, 2) fwd(Args args) {
    extern __shared__ __attribute__((aligned(16))) unsigned char lds[];
    Frame F;
    F.lds = (LAS unsigned char*)lds;
    F.MISC = (volatile LAS unsigned*)(F.lds + MISC_OFF);
    F.G = gridDim.x; { const int bx = blockIdx.x; F.vcu = (F.G % 8 == 0) ? (bx % 8) * (F.G / 8) + bx / 8 : bx; }
    unsigned char* ws = args.ws;
    F.ctl = (gu32*)(ws + WS_CTL);
    F.x = args.in[0]; F.norm_w = args.in[1]; F.w_in = args.in[2]; F.lb_logits = args.in[3]; F.hg_norm_w = args.in[4]; F.q_norm_w = args.in[5]; F.k_norm_w = args.in[6]; F.w_out = args.in[7];
    F.out = args.out;
    F.WIN = (bf16*)(ws + WS_WIN); F.WOUT = (bf16*)(ws + WS_WOUT); F.XB = (bf16*)(ws + WS_XB); F.MIXED = (bf16*)(ws + WS_MIXED);
    F.QI = (bf16*)(ws + WS_ARR); F.KT = (bf16*)(ws + WS_ARR + ARR_BYTES); F.HI = (bf16*)(ws + WS_ARR + 2 * ARR_BYTES); F.GH = (bf16*)(ws + WS_ARR + 3 * ARR_BYTES);
    F.QN = (bf16*)(ws + WS_ARR + 4 * ARR_BYTES); F.KN = (bf16*)(ws + WS_ARR + 5 * ARR_BYTES); F.V = (bf16*)(ws + WS_ARR + 6 * ARR_BYTES); F.GA = (bf16*)(ws + WS_ARR + 7 * ARR_BYTES);
    F.LB = (float*)(ws + WS_LB); F.KPART = (float*)(ws + WS_KPART); F.ROWSS = (float*)(ws + WS_ROWSS); F.DEC = (float*)(ws + WS_DEC);
    F.wave0 = __builtin_amdgcn_readfirstlane((int)threadIdx.x >> 6);
    for (int u = F.wave0 * 64 + lane_id_asm(); u < (LDS_BYTES - LDSCTL_OFF) / 4; u += NWAVES * 64) ((LAS unsigned*)(F.lds + LDSCTL_OFF))[u] = 0u;
    __syncthreads();
    XcdBarrier bar; bar.bar = (unsigned*)(F.ctl + CW_BAR); bar.x = 0; bar.st = nullptr; bar.wave0 = F.wave0;
    if (N_LAUNCHES == 1) bar = xcd_barrier_post((unsigned*)(F.ctl + CW_BAR), F.MISC + 8, F.wave0);
#define GRID_BAR() do { if (N_LAUNCHES == 1) xcd_barrier(bar); } while (0)
    const int lo = (N_LAUNCHES == 1) ? 0 : args.ph_lo, hi = (N_LAUNCHES == 1) ? N_PHASES : args.ph_hi;
#define IN(k) (lo <= (k) && (k) < hi)
#define BOTH(k) (IN(k) && IN((k) + 1))

    if (IN(0)) { p0_prologue(F); if (BOTH(0)) GRID_BAR(); }
    for (int l = 0; l < DEPTH; ++l) {
        const int pb = 1 + 3 * l;
        if (IN(pb)) {
            pg8::Gemm g{F.XB + (size_t)l * MTOK * DM, F.WIN + (size_t)l * NIN * DM, MTOK, NIN, DM}; pg8::StaticOrder S; S.init(MTOK, NIN, F.G, (int)blockIdx.x, (int)(blockIdx.x & 7));
            pg8::EpiFused E{F.QI, F.DEC, F.KPART, F.ROWSS + (size_t)l * MTOK * 16, F.LB + l * 512, F.q_norm_w + l * 64, F.k_norm_w + l * 64, nullptr, 0};
            {
                pg8::Unit u0{0, 0}, u4{0, 0}, ut; bool two = S.next(0, u0) && S.next(4, u4);
                for (int i = 0; two && S.next(i, ut); ++i) two = (ut.pm == u0.pm || ut.pm == u4.pm);
                if (two) { LAS float* rt = (LAS float*)(F.lds + EXTRA_OFF); int t_ = F.wave0 * 64 + lane_id_asm(); asm volatile("" : "+v"(t_));
                    rt[t_] = pg8::EpiFused::rstd_global(E.rowss, ((t_ >> 8) ? u4.pm : u0.pm) * 256 + (t_ & 255));
                    E.rtab = rt; E.pm0 = u0.pm; __syncthreads(); } }
            for (int rp = 0; rp < REP_PROJ; ++rp) { if (rp) GRID_BAR(); pg8::gemm_phase<pg8::EpiFused, pg8::StaticOrder, true, true>(F.lds + RING_OFF, g, S, E, F.wave0); }
            if (BOTH(pb)) GRID_BAR();
        }
        if (IN(pb + 1)) {
            for (int rp = 0; rp < REP_HGRN; ++rp) { if (rp) GRID_BAR(); hgrn_mfma_phase(F, l); }
            for (int rp = 0; rp < REP_MOBA; ++rp) { if (rp) { GRID_BAR(); if (blockIdx.x == 0 && F.wave0 == 0 && lane_id_asm() == 0) __hip_atomic_store(F.ctl + CW_QUEUE + 64 * l, 0u, RLX_AGENT); GRID_BAR(); } moba_mfma_phase(F, l); }
            if (l == 0) p0_deferred(F);
            if (BOTH(pb + 1)) GRID_BAR(); }
        if (IN(pb + 2)) {
            pg8::Gemm g{F.MIXED, F.WOUT + (size_t)l * DM * DM, MTOK, DM, DM}; pg8::StaticOrder S; S.init(MTOK, DM, F.G, (int)blockIdx.x);
            pg8::EpiOut E{l == 0 ? F.XB : F.XB + (size_t)MTOK * DM, l == 0 ? nullptr : F.out, l == 0 ? F.XB + (size_t)MTOK * DM : nullptr, l == 0 ? F.ROWSS + (size_t)MTOK * 16 : nullptr};
            for (int rp = 0; rp < REP_OUT; ++rp) { if (rp) GRID_BAR(); pg8::gemm_phase<pg8::EpiOut, pg8::StaticOrder, true, true>(F.lds + RING_OFF, g, S, E, F.wave0); }
            if (pb + 2 < N_PHASES - 1 && BOTH(pb + 2)) GRID_BAR();
        }
    }
#undef IN
#undef BOTH
}

extern "C" void kernel_launch(void* const* d_in, const int* in_sizes, int n_in, void* d_out, int out_size, void* d_ws, size_t ws_size, hipStream_t stream) {
    static int grid = 0;
    if (grid == 0) {
        if (n_in != 8 || in_sizes[0] != MTOK * DM || out_size != MTOK * DM || ws_size < WS_END) { fprintf(stderr, "kernel_launch: unexpected shapes n_in %d in0 %d out %d ws %zu\n", n_in, n_in > 0 ? in_sizes[0] : -1, out_size, ws_size); grid = -1; return; }
        int dev = 0, cus = 0, per_cu = 0;
        if (hipGetDevice(&dev) != hipSuccess || hipDeviceGetAttribute(&cus, hipDeviceAttributeMultiprocessorCount, dev) != hipSuccess) { grid = -1; return; }
        if (hipFuncSetAttribute((const void*)fwd, hipFuncAttributeMaxDynamicSharedMemorySize, LDS_BYTES) != hipSuccess) { fprintf(stderr, "kernel_launch: hipFuncSetAttribute failed\n"); grid = -1; return; }
        if (hipOccupancyMaxActiveBlocksPerMultiprocessor(&per_cu, (const void*)fwd, NWAVES * 64, LDS_BYTES) != hipSuccess || per_cu < 1) fprintf(stderr, "kernel_launch: occupancy query says %d\n", per_cu);
        (void)hipGetLastError();
        if (per_cu < 1) { grid = -1; return; }
        grid = cus < 512 ? cus : 512;
    }
    if (grid < 0) return;
    if (hipMemsetAsync((char*)d_ws + WS_CTL, 0, CTL_ZERO_BYTES, stream) != hipSuccess) return;
    Args a{};
    for (int i = 0; i < 8; ++i) a.in[i] = (const float*)d_in[i];
    a.out = (float*)d_out; a.ws = (unsigned char*)d_ws;
    for (int li = 0; li < N_LAUNCHES; ++li) {
        a.ph_lo = (N_LAUNCHES == 1) ? 0 : li; a.ph_hi = (N_LAUNCHES == 1) ? N_PHASES : li + 1; a.li = li;
        hipError_t le;
        if (N_LAUNCHES == 1) { void* kargs[] = {(void*)&a}; le = hipLaunchCooperativeKernel((const void*)fwd, dim3(grid), dim3(NWAVES * 64), kargs, LDS_BYTES, stream); }
        else { hipLaunchKernelGGL(fwd, dim3(grid), dim3(NWAVES * 64), LDS_BYTES, stream, a); le = hipPeekAtLastError(); }
        if (le != hipSuccess) { fprintf(stderr, "kernel_launch: launch %d failed: %s\n", li, hipGetErrorName(le)); break; }
    }
}
```

```cpp
#include <hip/hip_runtime.h>
#include <cstdio>
#include <cstdint>
__device__ __forceinline__ int lane_id_asm() { int l; asm volatile("v_mbcnt_lo_u32_b32 %0, -1, 0\n\tv_mbcnt_hi_u32_b32 %0, -1, %0" : "=v"(l)); return l; }
namespace pg8 {
#define PG8_LAS __attribute__((address_space(3)))
typedef unsigned short bf16_t;
typedef short bf16x8 __attribute__((ext_vector_type(8)));
typedef float f32x4 __attribute__((ext_vector_type(4)));
typedef unsigned u32x4 __attribute__((ext_vector_type(4)));
typedef unsigned u32x2 __attribute__((ext_vector_type(2)));
constexpr int BM = 256, BK = 64, HALF = 128, HTB = HALF * BK * 2  , STAGE_BYTES = 8 * HTB, NXCD = 8, WGM = 8;

__host__ __device__ __forceinline__ int lds_byte(int r, int c) { const int st = (r >> 4) * 2 + (c >> 5), rr = r & 15, cc = c & 31, ob = rr * 64 + cc * 2; return st * 1024 + (ob ^ (((ob >> 9) & 1) << 5)); }
__host__ __device__ __forceinline__ void stage_rc(int b, int& R, int& C) { const int st = b / 1024, sb = b % 1024, swz = sb ^ (((sb >> 9) & 1) << 5); R = (st >> 1) * 16 + swz / 64; C = (st & 1) * 32 + (swz % 64) / 2; }
__host__ __device__ __forceinline__ int perm32(int rho) { const int n = rho >> 4, i = rho & 15; return 8 * (i >> 2) + 4 * n + (i & 3); }

struct Unit { int pm, pn; };
struct Gemm { const bf16_t* A; const bf16_t* Bt; int M, N, K; };

struct StaticOrder {
    int nM, nN, nwg, G, c, rot;
    __host__ __device__ void init(int M, int N, int G_, int c_, int rot_ = 0) { __builtin_assume(c_ >= 0 && c_ < 512);     nM = M / BM; nN = N / BM; nwg = nM * nN; G = G_; c = c_; rot = (nwg == 8 * G_) ? rot_ : 0; }
    __host__ __device__ bool next(int i, Unit& u) const {
        if ((long)i * G + c >= nwg) return false;
        const long L = (long)((i + rot) & (rot ? 7 : -1)) * G + c;
        int wgid = (int)L; { const int q = nwg / NXCD, r = nwg % NXCD, xcd = wgid % NXCD, off = wgid / NXCD; wgid = (xcd < r ? xcd * (q + 1) : r * (q + 1) + (xcd - r) * q) + off; }
        const int nig = WGM * nN, gid = wgid / nig, fm = gid * WGM, gsz = (nM - fm) < WGM ? (nM - fm) : WGM;
        u.pm = fm + ((wgid % nig) % gsz); u.pn = (wgid % nig) / gsz; return true;
    }
    __device__ __forceinline__ void a_ready(const Unit&) const {}
    __device__ __forceinline__ void done(const Unit&) const {}
};

__device__ __forceinline__ unsigned cvt_pk_bf16(float lo, float hi) { unsigned r; asm volatile("v_cvt_pk_bf16_f32 %0, %1, %2" : "=v"(r) : "v"(lo), "v"(hi)); return r; }


__device__ __forceinline__ float dpp_row_shr(float v, int n) {
    const int x = __builtin_bit_cast(int, v);
    int r;
    if (n == 1) r = __builtin_amdgcn_update_dpp(0, x, 0x111, 0xf, 0xf, false);
    else if (n == 2) r = __builtin_amdgcn_update_dpp(0, x, 0x112, 0xf, 0xf, false);
    else if (n == 4) r = __builtin_amdgcn_update_dpp(0, x, 0x114, 0xf, 0xf, false);
    else r = __builtin_amdgcn_update_dpp(0, x, 0x118, 0xf, 0xf, false);
    return __builtin_bit_cast(float, r);
}
__device__ __forceinline__ float dpp_row_shr1(float v, int n) {
    const int x = __builtin_bit_cast(int, v); const int one = 0x3f800000;
    int r;
    if (n == 1) r = __builtin_amdgcn_update_dpp(one, x, 0x111, 0xf, 0xf, false);
    else if (n == 2) r = __builtin_amdgcn_update_dpp(one, x, 0x112, 0xf, 0xf, false);
    else if (n == 4) r = __builtin_amdgcn_update_dpp(one, x, 0x114, 0xf, 0xf, false);
    else r = __builtin_amdgcn_update_dpp(one, x, 0x118, 0xf, 0xf, false);
    return __builtin_bit_cast(float, r);
}
__device__ __forceinline__ float fsig(float z) { return __builtin_amdgcn_rcpf(1.0f + __expf(-z)); }
struct EpiFused {
    static constexpr bool PERM = true, AFTER_DRAIN = false;
    bf16_t* ARR; float* DEC; float* KPART; const float* rowss; const float* lb; const float* qg; const float* kg;
    static constexpr size_t AS = (size_t)32768 * 512;
    const PG8_LAS float* rtab; int pm0;
    __device__ __forceinline__ float rstd_of(int row) const { return rtab ? rtab[(((row >> 8) == pm0) ? 0 : 256) + (row & 255)] : rstd_global(rowss, row); }
    static __device__ __forceinline__ float rstd_global(const float* rowss, int row) {
        const f32x4* rp = (const f32x4*)(rowss + (size_t)row * 16);
        const f32x4 a = rp[0], b = rp[1], c = rp[2], d = rp[3];
        const float ss = ((a[0] + a[1]) + (a[2] + a[3])) + ((b[0] + b[1]) + (b[2] + b[3])) + ((c[0] + c[1]) + (c[2] + c[3])) + ((d[0] + d[1]) + (d[2] + d[3]));
        return 1.0f / sqrtf(ss * (1.0f / 1024.0f) + 1e-6f);
    }
    static __device__ __forceinline__ u32x4 pack8(const float (&v)[8]) { u32x4 w; w.x = cvt_pk_bf16(v[0], v[1]); w.y = cvt_pk_bf16(v[2], v[3]); w.z = cvt_pk_bf16(v[4], v[5]); w.w = cvt_pk_bf16(v[6], v[7]); return w; }
    __device__ __forceinline__ void operator()(const f32x4 (&acc)[2][2][4][2], const Unit& u, int wr, int wc, int fr, int fq) const {
        const int row0 = u.pm * BM + wr * 64 + fr; const int pn = u.pn;
        if (pn < 4) {
            const int cb = pn * 128 + wc * 32 + 8 * fq;
            float lbv[8];
#pragma unroll
            for (int k = 0; k < 8; ++k) lbv[k] = lb[cb + k];
#pragma unroll
            for (int ai = 0; ai < 2; ++ai)
#pragma unroll
                for (int mp = 0; mp < 2; ++mp) { const int row1 = row0 + ai * HALF + mp * 32, row2 = row1 + 16; const float rs1 = rstd_of(row1), rs2 = rstd_of(row2);
                    float qi1[8], kt1[8], qi2[8], kt2[8], dc[8];
#pragma unroll
                    for (int k = 0; k < 8; ++k) {
                        const float zq1 = acc[ai][0][2 * mp][k >> 2][k & 3] * rs1, zf1 = acc[ai][1][2 * mp][k >> 2][k & 3] * rs1;
                        const float zq2 = acc[ai][0][2 * mp + 1][k >> 2][k & 3] * rs2, zf2 = acc[ai][1][2 * mp + 1][k >> 2][k & 3] * rs2;
                        const float f1 = lbv[k] + (1.0f - lbv[k]) * fsig(zf1), f2 = lbv[k] + (1.0f - lbv[k]) * fsig(zf2);
                        float e1 = f1, e2 = f2;
                        e1 *= dpp_row_shr1(e1, 1); e2 *= dpp_row_shr1(e2, 1); e1 *= dpp_row_shr1(e1, 2); e2 *= dpp_row_shr1(e2, 2);
                        e1 *= dpp_row_shr1(e1, 4); e2 *= dpp_row_shr1(e2, 4); e1 *= dpp_row_shr1(e1, 8); e2 *= dpp_row_shr1(e2, 8);
                        e2 *= __shfl(e1, (fq << 4) | 15);
                        qi1[k] = zq1 * fsig(zq1) * e1; kt1[k] = (1.0f - f1) * fminf(__builtin_amdgcn_rcpf(e1), 5.5406224e34f);
                        qi2[k] = zq2 * fsig(zq2) * e2; kt2[k] = (1.0f - f2) * fminf(__builtin_amdgcn_rcpf(e2), 5.5406224e34f); dc[k] = e2; }
                    { const int pc = pn * 128 + wc * 32 + 16 * (fq & 1) + 4 * (fq >> 1);
                      const u32x4 a1 = pack8(qi1), b1 = pack8(kt1), a2 = pack8(qi2), b2 = pack8(kt2);
                      bf16_t* q1 = ARR + (size_t)row1 * 512 + pc; bf16_t* q2 = ARR + (size_t)row2 * 512 + pc;
                      *(u32x2*)(q1) = (u32x2){a1.x, a1.y}; *(u32x2*)(q1 + 8) = (u32x2){a1.z, a1.w}; *(u32x2*)(q1 + AS) = (u32x2){b1.x, b1.y}; *(u32x2*)(q1 + AS + 8) = (u32x2){b1.z, b1.w};
                      *(u32x2*)(q2) = (u32x2){a2.x, a2.y}; *(u32x2*)(q2 + 8) = (u32x2){a2.z, a2.w}; *(u32x2*)(q2 + AS) = (u32x2){b2.x, b2.y}; *(u32x2*)(q2 + AS + 8) = (u32x2){b2.z, b2.w}; }
                    if (fr == 15) { float* dp = DEC + (size_t)(row1 >> 5) * 512 + cb; *(f32x4*)dp = (f32x4){dc[0], dc[1], dc[2], dc[3]}; *(f32x4*)(dp + 4) = (f32x4){dc[4], dc[5], dc[6], dc[7]}; }
                    asm volatile("" ::: "memory"); }
        } else if (pn < 8) {
            const int cb = (pn - 4) * 128 + wc * 32 + 8 * fq;
#pragma unroll
            for (int ai = 0; ai < 2; ++ai)
#pragma unroll
                for (int m = 0; m < 4; ++m) { const int row = row0 + ai * HALF + m * 16; const float rs = rstd_of(row);
                    float iv[8], gv[8];
#pragma unroll
                    for (int k = 0; k < 8; ++k) { iv[k] = acc[ai][0][m][k >> 2][k & 3] * rs; const float zg = acc[ai][1][m][k >> 2][k & 3] * rs; gv[k] = zg * fsig(zg); }
                    *(u32x4*)(ARR + 2 * AS + (size_t)row * 512 + cb) = pack8(iv); *(u32x4*)(ARR + 3 * AS + (size_t)row * 512 + cb) = pack8(gv);
                    asm volatile("" ::: "memory"); }
        } else {
            const int ty = (pn - 8) >> 1, head = 4 * ((pn - 8) & 1) + wc; const int d0 = 8 * fq;
            bf16_t* dst = ARR + (size_t)(4 + ty) * AS;
            float gain[2][8]; float csum[2][8];
#pragma unroll
            for (int bj = 0; bj < 2; ++bj)
#pragma unroll
                for (int k = 0; k < 8; ++k) { gain[bj][k] = (ty == 0) ? qg[bj * 32 + d0 + k] * (0.125f * 1.4426950408889634f) : (ty == 1) ? kg[bj * 32 + d0 + k] : 1.0f; csum[bj][k] = 0.f; }
#pragma unroll
            for (int ai = 0; ai < 2; ++ai)
#pragma unroll
                for (int m = 0; m < 4; ++m) { const int row = row0 + ai * HALF + m * 16; const float rs = rstd_of(row);
                    float v[2][8];
#pragma unroll
                    for (int bj = 0; bj < 2; ++bj)
#pragma unroll
                        for (int k = 0; k < 8; ++k) v[bj][k] = acc[ai][bj][m][k >> 2][k & 3] * rs;
                    if (ty < 2) { float ss = 0.f;
#pragma unroll
                        for (int bj = 0; bj < 2; ++bj)
#pragma unroll
                            for (int k = 0; k < 8; ++k) ss += v[bj][k] * v[bj][k];
                        ss += __shfl_xor(ss, 16); ss += __shfl_xor(ss, 32);
                        const float r2 = 1.0f / sqrtf(ss * (1.0f / 64.0f) + 1e-6f);
#pragma unroll
                        for (int bj = 0; bj < 2; ++bj)
#pragma unroll
                            for (int k = 0; k < 8; ++k) { v[bj][k] *= r2 * gain[bj][k]; csum[bj][k] += v[bj][k]; }
                    } else if (ty == 3) {
#pragma unroll
                        for (int bj = 0; bj < 2; ++bj)
#pragma unroll
                            for (int k = 0; k < 8; ++k) v[bj][k] = v[bj][k] * fsig(v[bj][k]); }
                    *(u32x4*)(dst + (size_t)row * 512 + head * 64 + d0) = pack8(v[0]); *(u32x4*)(dst + (size_t)row * 512 + head * 64 + 32 + d0) = pack8(v[1]);
                    asm volatile("" ::: "memory"); }
            if (ty == 1) {
#pragma unroll
                for (int bj = 0; bj < 2; ++bj)
#pragma unroll
                    for (int k = 0; k < 8; ++k) { float s = csum[bj][k]; s += __shfl_xor(s, 1); s += __shfl_xor(s, 2); s += __shfl_xor(s, 4); s += __shfl_xor(s, 8); csum[bj][k] = s; }
                if (fr == 0) { float* kp = KPART + ((size_t)u.pm * 2 + wr) * 512 + head * 64 + d0;
#pragma unroll
                    for (int bj = 0; bj < 2; ++bj) { *(f32x4*)(kp + bj * 32) = (f32x4){csum[bj][0], csum[bj][1], csum[bj][2], csum[bj][3]}; *(f32x4*)(kp + bj * 32 + 4) = (f32x4){csum[bj][4], csum[bj][5], csum[bj][6], csum[bj][7]}; } }
            }
        }
    }
};
struct EpiOut {
    static constexpr bool PERM = true, AFTER_DRAIN = false;
    const bf16_t* xres16; float* out; bf16_t* xb; float* rowss;
    __device__ __forceinline__ void operator()(const f32x4 (&acc)[2][2][4][2], const Unit& u, int wr, int wc, int fr, int fq) const {
        const int col0 = u.pn * BM + wc * 32 + 8 * fq;
        const size_t base = (size_t)(u.pm * BM + wr * 64 + fr) * 1024 + col0;
        u32x4 res[2][4][2];
#pragma unroll
        for (int ai = 0; ai < 2; ++ai)
#pragma unroll
            for (int m = 0; m < 4; ++m)
#pragma unroll
                for (int bj = 0; bj < 2; ++bj) res[ai][m][bj] = *(const u32x4*)(xres16 + base + (size_t)(ai * HALF + m * 16) * 1024 + bj * HALF);
#pragma unroll
        for (int ai = 0; ai < 2; ++ai)
#pragma unroll
            for (int m = 0; m < 4; ++m) {
                const int row = u.pm * BM + ai * HALF + wr * 64 + m * 16 + fr; float ss = 0.f;
#pragma unroll
                for (int bj = 0; bj < 2; ++bj) { const size_t off = (size_t)row * 1024 + col0 + bj * HALF;
                    const u32x4 r = res[ai][m][bj];
                    f32x4 v0 = (f32x4){__builtin_bit_cast(float, r.x << 16), __builtin_bit_cast(float, r.x & 0xffff0000u), __builtin_bit_cast(float, r.y << 16), __builtin_bit_cast(float, r.y & 0xffff0000u)};
                    f32x4 v1 = (f32x4){__builtin_bit_cast(float, r.z << 16), __builtin_bit_cast(float, r.z & 0xffff0000u), __builtin_bit_cast(float, r.w << 16), __builtin_bit_cast(float, r.w & 0xffff0000u)};
                    v0 = v0 + acc[ai][bj][m][0]; v1 = v1 + acc[ai][bj][m][1];
                    if (out) { *(f32x4*)(out + off) = v0; *(f32x4*)(out + off + 4) = v1; }
                    if (xb) { u32x4 w; w.x = cvt_pk_bf16(v0[0], v0[1]); w.y = cvt_pk_bf16(v0[2], v0[3]); w.z = cvt_pk_bf16(v1[0], v1[1]); w.w = cvt_pk_bf16(v1[2], v1[3]); *(u32x4*)(xb + off) = w; }
                    ss += ((v0[0] * v0[0] + v0[1] * v0[1]) + (v0[2] * v0[2] + v0[3] * v0[3])) + ((v1[0] * v1[0] + v1[1] * v1[1]) + (v1[2] * v1[2] + v1[3] * v1[3])); }
                ss += __shfl_xor(ss, 16); ss += __shfl_xor(ss, 32);
                if (fq == 0 && rowss) rowss[(size_t)row * 16 + u.pn * 4 + wc] = ss;
            }
    }
};

template <class Epi, class Sched, bool ALIGN_EPI = false, bool SP2 = false>
__device__ __forceinline__ void gemm_phase(PG8_LAS unsigned char* lds, const Gemm g, const Sched& S, const Epi& E, const int wave0) {
    int tid = wave0 * 64 + lane_id_asm(); asm volatile("" : "+v"(tid));
    const int wid = __builtin_amdgcn_readfirstlane(tid >> 6), lane = tid & 63, wr = wid >> 2, wc = wid & 3, fr = lane & 15, fq = lane >> 4;
    const int K = g.K, nt = K / BK;
    unsigned voffA[2], voffB[2];
#pragma unroll
    for (int i = 0; i < 2; ++i) { int R, C; stage_rc(tid * 16 + i * 8192, R, C); const int Rb = Epi::PERM ? ((R & ~31) + perm32(R & 31)) : R;
        voffA[i] = (unsigned)(R * K + C) * 2u; voffB[i] = (unsigned)(Rb * K + C) * 2u; }
    const size_t kstep = (size_t)(BK * 2);
    const size_t hstep = (size_t)HALF * K * 2;
    const size_t tstep = 2 * hstep;
    const unsigned ldsw = (unsigned)wid * 1024u;
    const int aoff = lds_byte(wr * 64 + fr, fq * 8), boff = lds_byte(wc * 32 + fr, fq * 8);
#define PG8_SA(b, h) (((b) * 2 + (h)) * HTB)
#define PG8_SB(b, h) ((4 + (b) * 2 + (h)) * HTB)
#define PG8_STAGE(bufoff, gbase, voff) do { _Pragma("unroll") for (int _i = 0; _i < 2; ++_i) \
        __builtin_amdgcn_global_load_lds((const unsigned*)((const char*)(gbase) + (voff)[_i]), (PG8_LAS unsigned*)(lds + (bufoff) + ldsw + _i * 8192), 16, 0, 0); } while (0)
#define PG8_LDA(dst, b, h) do { _Pragma("unroll") for (int m = 0; m < 4; ++m) _Pragma("unroll") for (int k = 0; k < 2; ++k) dst[m][k] = *(const PG8_LAS bf16x8*)(lds + PG8_SA(b, h) + aoff + m * 2048 + k * 1024); } while (0)
#define PG8_LDB(dst, b, h) do { _Pragma("unroll") for (int n = 0; n < 2; ++n) _Pragma("unroll") for (int k = 0; k < 2; ++k) dst[n][k] = *(const PG8_LAS bf16x8*)(lds + PG8_SB(b, h) + boff + n * 2048 + k * 1024); } while (0)
#define PG8_MMA(ai, bj, At, Bt) do { __builtin_amdgcn_s_setprio(1); _Pragma("unroll") for (int m = 0; m < 4; ++m) _Pragma("unroll") for (int n = 0; n < 2; ++n) _Pragma("unroll") for (int k = 0; k < 2; ++k) \
        acc[ai][bj][m][n] = __builtin_amdgcn_mfma_f32_16x16x32_bf16(Bt[n][k], At[m][k], acc[ai][bj][m][n], 0, 0, 0); __builtin_amdgcn_s_setprio(0); } while (0)
#define PG8_WAIT_V(n) asm volatile("s_waitcnt vmcnt(" #n ")" ::: "memory")
#define PG8_WAIT_L(n) asm volatile("s_waitcnt lgkmcnt(" #n ")" ::: "memory")
#define PG8_BAR __builtin_amdgcn_s_barrier()
#define PG8_SCHED __builtin_amdgcn_sched_barrier(0)
    Unit cur, nxt; int ui = 0;
    if (!S.next(0, cur)) return;
    f32x4 acc[2][2][4][2];
#pragma unroll
    for (int a = 0; a < 2; ++a)
#pragma unroll
        for (int b = 0; b < 2; ++b)
#pragma unroll
            for (int m = 0; m < 4; ++m)
#pragma unroll
                for (int n = 0; n < 2; ++n) acc[a][b][m][n] = (f32x4){0.f, 0.f, 0.f, 0.f};
    bf16x8 At[4][2], B0[2][2], B1[2][2];
    const char* cA = (const char*)g.A + (size_t)cur.pm * tstep; const char* cB = (const char*)g.Bt + (size_t)cur.pn * tstep;
    S.a_ready(cur);
    if constexpr (SP2) {
        PG8_STAGE(PG8_SB(0, 0), cB, voffB); PG8_STAGE(PG8_SB(0, 1), cB + hstep, voffB); PG8_STAGE(PG8_SA(0, 0), cA, voffA); PG8_STAGE(PG8_SA(0, 1), cA + hstep, voffA);
        if (wr == 1) PG8_BAR;
        PG8_WAIT_V(2); PG8_BAR;
        PG8_STAGE(PG8_SB(1, 0), cB + kstep, voffB); PG8_STAGE(PG8_SA(1, 0), cA + kstep, voffA); PG8_STAGE(PG8_SB(1, 1), cB + hstep + kstep, voffB);
        PG8_WAIT_V(6); PG8_BAR;
    } else {
        PG8_STAGE(PG8_SB(0, 0), cB, voffB); PG8_STAGE(PG8_SA(0, 0), cA, voffA); PG8_STAGE(PG8_SB(0, 1), cB + hstep, voffB); PG8_STAGE(PG8_SA(0, 1), cA + hstep, voffA);
        if (wr == 1) PG8_BAR;
        PG8_WAIT_V(4); PG8_BAR;
        PG8_STAGE(PG8_SB(1, 0), cB + kstep, voffB); PG8_STAGE(PG8_SA(1, 0), cA + kstep, voffA); PG8_STAGE(PG8_SB(1, 1), cB + hstep + kstep, voffB);
        PG8_WAIT_V(6); PG8_BAR;
    }
    for (;;) {
        const bool has_next = S.next(ui + 1, nxt);
        const char* nA = has_next ? (const char*)g.A + (size_t)nxt.pm * tstep : cA; const char* nB = has_next ? (const char*)g.Bt + (size_t)nxt.pn * tstep : cB;
        for (int t = 0; t < nt; t += 2) {
            const bool last = (t == nt - 2);
            const char* a1 = cA + (size_t)(t + 1) * kstep;
            const char* a2 = last ? nA : cA + (size_t)(t + 2) * kstep; const char* b2 = last ? nB : cB + (size_t)(t + 2) * kstep;
            const char* a3 = a2 + kstep; const char* b3 = b2 + kstep;
            if (last && has_next) S.a_ready(nxt);
            if constexpr (SP2) {
            PG8_LDB(B0, 0, 0); PG8_LDB(B1, 0, 1); PG8_SCHED; PG8_LDA(At, 0, 0); PG8_STAGE(PG8_SA(1, 1), a1 + hstep, voffA);
            PG8_WAIT_V(8); PG8_WAIT_L(0); PG8_BAR; PG8_MMA(0, 0, At, B0); PG8_MMA(0, 1, At, B1); PG8_BAR; PG8_SCHED;
            PG8_LDA(At, 0, 1); PG8_STAGE(PG8_SB(0, 0), b2, voffB); PG8_STAGE(PG8_SB(0, 1), b2 + hstep, voffB); PG8_STAGE(PG8_SA(0, 0), a2, voffA);
            PG8_WAIT_V(8); PG8_WAIT_L(0); PG8_BAR; PG8_MMA(1, 0, At, B0); PG8_MMA(1, 1, At, B1); PG8_BAR; PG8_SCHED;
            PG8_LDB(B0, 1, 0); PG8_LDB(B1, 1, 1); PG8_SCHED; PG8_LDA(At, 1, 0); PG8_STAGE(PG8_SA(0, 1), a2 + hstep, voffA);
            PG8_WAIT_V(8); PG8_WAIT_L(0); PG8_BAR; PG8_MMA(0, 0, At, B0); PG8_MMA(0, 1, At, B1); PG8_BAR; PG8_SCHED;
            PG8_LDA(At, 1, 1); PG8_STAGE(PG8_SB(1, 0), b3, voffB); PG8_STAGE(PG8_SB(1, 1), b3 + hstep, voffB); PG8_STAGE(PG8_SA(1, 0), a3, voffA);
            PG8_WAIT_V(8); PG8_WAIT_L(0); PG8_BAR; PG8_MMA(1, 0, At, B0); PG8_MMA(1, 1, At, B1); PG8_BAR; PG8_SCHED;
            } else {
            PG8_LDB(B0, 0, 0); PG8_SCHED; PG8_LDA(At, 0, 0); PG8_STAGE(PG8_SA(1, 1), a1 + hstep, voffA);
            PG8_WAIT_L(8); PG8_BAR; PG8_WAIT_L(0); PG8_MMA(0, 0, At, B0); PG8_BAR; PG8_SCHED;
            PG8_LDB(B1, 0, 1); PG8_STAGE(PG8_SB(0, 0), b2, voffB);
            PG8_BAR; PG8_WAIT_L(0); PG8_MMA(0, 1, At, B1); PG8_BAR;
            PG8_LDA(At, 0, 1); PG8_STAGE(PG8_SA(0, 0), a2, voffA);
            PG8_BAR; PG8_WAIT_L(0); PG8_MMA(1, 0, At, B0); PG8_BAR; PG8_SCHED;
            PG8_STAGE(PG8_SB(0, 1), b2 + hstep, voffB);
            PG8_WAIT_V(6); PG8_BAR; PG8_MMA(1, 1, At, B1); PG8_BAR;
            PG8_LDB(B0, 1, 0); PG8_SCHED; PG8_LDA(At, 1, 0); PG8_STAGE(PG8_SA(0, 1), a2 + hstep, voffA);
            PG8_WAIT_L(8); PG8_BAR; PG8_WAIT_L(0); PG8_MMA(0, 0, At, B0); PG8_BAR; PG8_SCHED;
            PG8_LDB(B1, 1, 1); PG8_STAGE(PG8_SB(1, 0), b3, voffB);
            PG8_BAR; PG8_WAIT_L(0); PG8_MMA(0, 1, At, B1); PG8_BAR;
            PG8_LDA(At, 1, 1); PG8_STAGE(PG8_SA(1, 0), a3, voffA);
            PG8_BAR; PG8_WAIT_L(0); PG8_MMA(1, 0, At, B0); PG8_BAR; PG8_SCHED;
            PG8_STAGE(PG8_SB(1, 1), b3 + hstep, voffB);
            PG8_WAIT_V(6); PG8_BAR; PG8_MMA(1, 1, At, B1); PG8_BAR;
            }
        }
        if constexpr (ALIGN_EPI) { if (wr == 0) PG8_BAR; }
        if constexpr (!Epi::AFTER_DRAIN) { E(acc, cur, wr, wc, fr, fq); S.done(cur); }
        if (!has_next) break;
#pragma unroll
        for (int a = 0; a < 2; ++a)
#pragma unroll
            for (int b = 0; b < 2; ++b)
#pragma unroll
                for (int m = 0; m < 4; ++m)
#pragma unroll
                    for (int n = 0; n < 2; ++n) acc[a][b][m][n] = (f32x4){0.f, 0.f, 0.f, 0.f};
        cur = nxt; cA = nA; cB = nB; ++ui;
        if constexpr (ALIGN_EPI) { if (wr == 1) PG8_BAR; }
    }
    PG8_WAIT_V(0);
    if constexpr (!ALIGN_EPI) { if (wr == 0) PG8_BAR; }
    PG8_BAR;
    if constexpr (Epi::AFTER_DRAIN) { E.fused(acc, cur, wr, wc, fr, fq, lds, wid, lane); S.done(cur); }
#undef PG8_SA
#undef PG8_SB
#undef PG8_STAGE
#undef PG8_LDA
#undef PG8_LDB
#undef PG8_MMA
#undef PG8_WAIT_V
#undef PG8_WAIT_L
#undef PG8_BAR
#undef PG8_SCHED
}
}


constexpr int NWAVES = 8;
#ifndef REP_PROJ
#define REP_PROJ 1
#endif
#ifndef REP_HGRN
#define REP_HGRN 1
#endif
#ifndef REP_MOBA
#define REP_MOBA 1
#endif
#ifndef REP_OUT
#define REP_OUT 1
#endif
#ifndef MK_N_LAUNCHES
#define MK_N_LAUNCHES 1
#endif
constexpr int N_PHASES = 7;
constexpr int N_LAUNCHES = MK_N_LAUNCHES;

constexpr int BATCH = 16, SEQ = 2048, DM = 1024, DEPTH = 2, MTOK = BATCH * SEQ, NIN = 4096;
constexpr int C_HQ = 0, C_HF = 512, C_HI = 1024, C_HG = 1536, C_AQ = 2048, C_AK = 2560, C_AV = 3072, C_AG = 3584;
constexpr float NORM_EPS = 1e-6f;

constexpr size_t MiB = 1u << 20;
constexpr size_t WS_CTL = 0, CTL_ZERO_BYTES = 32768;
constexpr size_t WS_WIN = 2 * MiB;
constexpr size_t WS_WOUT = 18 * MiB;
constexpr size_t WS_LB = 22 * MiB;
constexpr size_t WS_KPART = 22 * MiB + 65536;
constexpr size_t WS_ROWSS = 24 * MiB;
constexpr size_t WS_DEC = 28 * MiB;
constexpr size_t WS_XB = 32 * MiB;
constexpr size_t WS_MIXED = 160 * MiB;
constexpr size_t WS_ARR = 224 * MiB;
constexpr size_t ARR_BYTES = 32 * MiB;
constexpr size_t WS_END = 480 * MiB;
constexpr int CW_QUEUE = 1024;
constexpr int CW_BAR = 4096;

constexpr int RING_OFF = 0, RING_BYTES = 131072;
constexpr int EXTRA_OFF = RING_BYTES, EXTRA_BYTES = 16384;
constexpr int LDSCTL_OFF = EXTRA_OFF + EXTRA_BYTES, MISC_OFF = LDSCTL_OFF + 320;
constexpr int LDS_BYTES = LDSCTL_OFF + 1024;

#define GAS __attribute__((address_space(1)))
#define LAS __attribute__((address_space(3)))
typedef unsigned short bf16;
typedef unsigned v4u __attribute__((ext_vector_type(4)));
typedef float f32x4 __attribute__((ext_vector_type(4)));
typedef GAS unsigned gu32;
#define RLX_AGENT __ATOMIC_RELAXED, __HIP_MEMORY_SCOPE_AGENT
#define LDS_WAIT() asm volatile("s_waitcnt lgkmcnt(0)" ::: "memory")
#define VM_WAIT() asm volatile("s_waitcnt vmcnt(0)" ::: "memory")
__device__ __forceinline__ unsigned f2bf(float f) { unsigned u = __builtin_bit_cast(unsigned, f); return (u + 0x7fffu + ((u >> 16) & 1u)) >> 16; }
__device__ __forceinline__ unsigned pk2(float lo, float hi) { return f2bf(lo) | (f2bf(hi) << 16); }
__device__ __forceinline__ float bf2f(unsigned short b) { return __builtin_bit_cast(float, (unsigned)b << 16); }
__device__ __forceinline__ float bflo(unsigned w) { return __builtin_bit_cast(float, w << 16); }
__device__ __forceinline__ float bfhi(unsigned w) { return __builtin_bit_cast(float, w & 0xffff0000u); }
__device__ __forceinline__ float silu_f(float z) { return z / (1.0f + __expf(-z)); }
__device__ __forceinline__ float sigmoid_f(float z) { return 1.0f / (1.0f + __expf(-z)); }

#define XB_TMO      128
#define XB_XCNT(j)  (256  + 64 * (j))
#define XB_XSUB(j)  (1280 + 64 * (j))
#define XB_XGEN(j)  (2304 + 64 * (j))
#define XB_TOP      3328
#define XB_TOPGEN   3392
#define XCD_BAR_WORDS 3456
#define XB_SPIN_CAP (1u << 18)

__device__ __forceinline__ unsigned xb_ld(unsigned* p)              { return __hip_atomic_load(p, __ATOMIC_RELAXED, __HIP_MEMORY_SCOPE_AGENT); }
__device__ __forceinline__ unsigned xb_add(unsigned* p, unsigned v) { return __hip_atomic_fetch_add(p, v, __ATOMIC_RELAXED, __HIP_MEMORY_SCOPE_AGENT); }
__device__ __forceinline__ unsigned xb_xcc_id() { return (unsigned)__builtin_amdgcn_s_getreg((3 << 11) | 20) & 0xFu; }
#define XB_SPIN(cond, bar) do { unsigned _sp = 0; while (cond) { __builtin_amdgcn_s_sleep(1); \
    if ((++_sp & 255u) == 0u) { if (xb_ld(&(bar)[XB_TMO])) break; if (_sp > XB_SPIN_CAP) { atomicAdd(&(bar)[XB_TMO], 1u); break; } } } } while (0)

struct XcdBarrier {
    unsigned* bar; unsigned x; int wave0;
    volatile LAS unsigned* st;
};

#define XB_IS_T0(wv) ((wv) == 0 && lane_id_asm() == 0)
__device__ __forceinline__ XcdBarrier xcd_barrier_post(unsigned* bar, volatile LAS unsigned* st, int wave0) {
    XcdBarrier b; b.bar = bar; b.x = xb_xcc_id(); b.st = st; b.wave0 = wave0;
    if (XB_IS_T0(wave0)) (void)xb_add(&bar[XB_XCNT(b.x)], 1u);
    return b;
}
__device__ __forceinline__ void xcd_barrier_complete(unsigned* bar, unsigned x, unsigned& nloc, unsigned& nx) {
    const unsigned G = gridDim.x * gridDim.y * gridDim.z;
    unsigned sum, cnt, mine, sp = 0u;
    for (;;) {
        sum = 0u; cnt = 0u; mine = 0u;
#pragma unroll
        for (unsigned j = 0; j < 16; ++j) { const unsigned c = xb_ld(&bar[XB_XCNT(j)]); sum += c; cnt += (c > 0u) ? 1u : 0u; mine = (j == x) ? c : mine; }
        if (sum == G) break;
        __builtin_amdgcn_s_sleep(1);
        if ((++sp & 255u) == 0u) { if (xb_ld(&bar[XB_TMO])) break; if (sp > XB_SPIN_CAP) { atomicAdd(&bar[XB_TMO], 1u); break; } }
    }
    nloc = mine > 0u ? mine : 1u; nx = cnt > 0u ? cnt : 1u;
}

__device__ __forceinline__ void xcd_barrier(const XcdBarrier& b) {
    asm volatile("s_waitcnt vmcnt(0)" ::: "memory");
    __syncthreads();
    if (XB_IS_T0(b.wave0)) {
        unsigned* bar = b.bar;
        __builtin_amdgcn_s_waitcnt(0);
        unsigned nloc = b.st[0], nx = b.st[1];
        if (nloc == 0u) { xcd_barrier_complete(bar, b.x, nloc, nx); b.st[0] = nloc; b.st[1] = nx; }
        const unsigned old = xb_add(&bar[XB_XSUB(b.x)], 1u);
        const unsigned gen = old / nloc;
        if (old + 1u == (gen + 1u) * nloc) {
            __builtin_amdgcn_fence(__ATOMIC_RELEASE, "agent");
            asm volatile("s_waitcnt vmcnt(0)" ::: "memory");
            const unsigned og = xb_add(&bar[XB_TOP], 1u);
            const unsigned tg = og / nx;
            if (og + 1u == (tg + 1u) * nx) xb_add(&bar[XB_TOPGEN], 1u);
            else XB_SPIN(xb_ld(&bar[XB_TOPGEN]) == tg, bar);
            __builtin_amdgcn_fence(__ATOMIC_ACQUIRE, "agent");
            xb_add(&bar[XB_XGEN(b.x)], 1u);
            asm volatile("s_waitcnt vmcnt(0)" ::: "memory");
        } else {
            XB_SPIN(xb_ld(&bar[XB_XGEN(b.x)]) == gen, bar);
            __builtin_amdgcn_fence(__ATOMIC_ACQUIRE, "agent");
            asm volatile("s_waitcnt vmcnt(0)" ::: "memory");
        }
    }
    __syncthreads();
}


struct Frame {
    LAS unsigned char* lds;
    volatile LAS unsigned* MISC;
    int wave0;
    gu32* ctl;
    int vcu, G;
    const float* x; float* out;
    const float *norm_w, *w_in, *lb_logits, *hg_norm_w, *q_norm_w, *k_norm_w, *w_out;
    bf16 *WIN, *WOUT, *XB, *MIXED, *QI, *KT, *HI, *GH, *QN, *KN, *V, *GA;
    float *LB, *KPART, *ROWSS, *DEC;
};

__device__ __forceinline__ float wave_sum(float v) {
#pragma unroll
    for (int o = 1; o < 64; o <<= 1) v += __shfl_xor(v, o);
    return v;
}
__device__ __forceinline__ int win_dest(int oc) {
    if (oc < 2048) { const int grp = oc >> 9, hh = (oc >> 7) & 3, w = oc & 127; return 256 * (((grp >> 1) << 2) + hh) + 128 * (grp & 1) + w; }
    const int ty = (oc - 2048) >> 9, head = (oc >> 6) & 7, bj = (oc >> 5) & 1; return 256 * (8 + 2 * ty + (head >> 2)) + 128 * bj + 32 * (head & 3);
}
__device__ __forceinline__ void p0_transpose_item(const float* W, int K, int N, bf16* WT, const float* kscale, LAS float* scr, int item, int lane, bool permute) {
    const int nblk = N / 32, kb = item / nblk, nb = item % nblk, k0 = 64 * kb, n0 = 32 * nb; const int nd = permute ? win_dest(n0) : n0;
    float wv_[32];
#pragma unroll
    for (int i = 0; i < 32; ++i) wv_[i] = W[(size_t)(k0 + 2 * i + (lane >> 5)) * N + n0 + (lane & 31)];
#pragma unroll
    for (int i = 0; i < 32; ++i) { const int kk = 2 * i + (lane >> 5); const float s = kscale ? kscale[k0 + kk] : 1.0f; scr[kk * 33 + (lane & 31)] = wv_[i] * s; }
    LDS_WAIT(); asm volatile("" ::: "memory");
    const int c = lane & 7;
#pragma unroll
    for (int j = 0; j < 4; ++j) { const int n = (lane >> 3) + 8 * j; const LAS float* s = scr + (8 * c) * 33 + n;
        v4u o; o.x = pk2(s[0 * 33], s[1 * 33]); o.y = pk2(s[2 * 33], s[3 * 33]); o.z = pk2(s[4 * 33], s[5 * 33]); o.w = pk2(s[6 * 33], s[7 * 33]);
        *(GAS v4u*)(WT + (size_t)(nd + n) * K + k0 + 8 * c) = o; }
    LDS_WAIT(); asm volatile("" ::: "memory");
}
#define PHASE_IDS() int t_ = F.wave0 * 64 + lane_id_asm(); asm volatile("" : "+v"(t_)); const int tid = t_, lane = tid & 63, wave = __builtin_amdgcn_readfirstlane(tid >> 6); (void)lane; (void)wave
__device__ __forceinline__ void p0_prologue(Frame& F) {
    PHASE_IDS();
    LAS float* scr = (LAS float*)(F.lds + RING_OFF + wave * 16384);
    const int gw = F.vcu * NWAVES + wave, NGW = F.G * NWAVES;
    constexpr int I_IN = (DM / 64) * (NIN / 32), I_OUT = (DM / 64) * (DM / 32);
    constexpr int NITEMS = DEPTH * (I_IN + I_OUT);
    for (int it = gw; it < NITEMS; it += NGW) {
        int r = it;
        if (r < DEPTH * I_IN) { const int l = r / I_IN; r -= l * I_IN;
            p0_transpose_item(F.w_in + (size_t)l * DM * NIN, DM, NIN, F.WIN + (size_t)l * NIN * DM, F.norm_w + l * DM, scr, r, lane, true); continue; }
        r -= DEPTH * I_IN; { const int l = r / I_OUT; r -= l * I_OUT;
            p0_transpose_item(F.w_out + (size_t)l * DM * DM, DM, DM, F.WOUT + (size_t)l * DM * DM, nullptr, scr, r, lane, false); }
    }
    for (int m0 = gw * 4; m0 < MTOK; m0 += NGW * 4) {
        f32x4 v[4][4]; float sq[4];
#pragma unroll
        for (int r = 0; r < 4; ++r) { const GAS f32x4* xr = (const GAS f32x4*)(F.x + (size_t)(m0 + r) * DM) + lane;
#pragma unroll
            for (int j = 0; j < 4; ++j) v[r][j] = __builtin_nontemporal_load(xr + 64 * j); }
#pragma unroll
        for (int r = 0; r < 4; ++r) { float a = 0.f;
#pragma unroll
            for (int j = 0; j < 4; ++j) a += (v[r][j].x * v[r][j].x + v[r][j].y * v[r][j].y) + (v[r][j].z * v[r][j].z + v[r][j].w * v[r][j].w);
            sq[r] = a; }
#pragma unroll
        for (int o = 1; o < 64; o <<= 1) {
#pragma unroll
            for (int r = 0; r < 4; ++r) sq[r] += __shfl_xor(sq[r], o); }
#pragma unroll
        for (int r = 0; r < 4; ++r) { GAS unsigned long long* o8 = (GAS unsigned long long*)(F.XB + (size_t)(m0 + r) * DM) + lane;
#pragma unroll
            for (int j = 0; j < 4; ++j) o8[64 * j] = (unsigned long long)pk2(v[r][j].x, v[r][j].y) | ((unsigned long long)pk2(v[r][j].z, v[r][j].w) << 32);
            if (lane < 16) F.ROWSS[(size_t)(m0 + r) * 16 + lane] = (lane == 0) ? sq[r] : 0.f; }
    }
    if (blockIdx.x == 0) { const int c = tid; const float a0 = F.lb_logits[c], a1 = F.lb_logits[512 + c]; const float mx = fmaxf(a0, a1);
        const float e0 = expf(a0 - mx), e1 = expf(a1 - mx); const float p0 = e0 / (e0 + e1), p1 = e1 / (e0 + e1);
        F.LB[c] = 0.f; F.LB[512 + c] = fminf(fmaxf((p0 + p1) - p0, 0.f), 1.0f - 1e-6f); }
}

constexpr float LOG2E = 1.4426950408889634f;
constexpr float QSCALE2 = 0.125f * LOG2E;
namespace moba {
typedef short bf16x8 __attribute__((ext_vector_type(8)));
typedef short s16x4 __attribute__((ext_vector_type(4)));
typedef float f32x16 __attribute__((ext_vector_type(16)));
typedef float f32x2_t __attribute__((ext_vector_type(2))); typedef __bf16 bf16x2_t __attribute__((ext_vector_type(2)));
__device__ __forceinline__ unsigned cvtpk(float lo, float hi) { f32x2_t v = {lo, hi}; bf16x2_t b = __builtin_convertvector(v, bf16x2_t); return __builtin_bit_cast(unsigned, b); }
__device__ __forceinline__ int crow(int r, int hi) { return (r & 3) + 8 * (r >> 2) + 4 * hi; }
__device__ __forceinline__ float max3f(float a, float b, float c) { float r; asm("v_max3_f32 %0, %1, %2, %3" : "=v"(r) : "v"(a), "v"(b), "v"(c)); return r; }
constexpr int L_K = 0, L_V = 32768, L_WSF = 65536, L_KM = 67584, L_OST = 69632;
constexpr float NEG_BIG = -1e30f;
constexpr float THR = 8.0f;
__device__ __forceinline__ s16x4 vtr(const LAS unsigned char* p) { return __builtin_bit_cast(s16x4, __builtin_amdgcn_ds_read_tr16_b64_v4i16((LAS s16x4*)p)); }
}

__device__ __forceinline__ void moba_glds(unsigned voff, const void* sbase, unsigned lds_dst) { unsigned keep;
    asm volatile("s_mov_b32 %0, m0\n\ts_mov_b32 m0, %3\n\ts_nop 0\n\tglobal_load_lds_dwordx4 %1, %2\n\ts_mov_b32 m0, %0" : "=&s"(keep) : "v"(voff), "s"(sbase), "s"(lds_dst) : "memory"); }
template <bool FIXREF> __device__ __forceinline__ void moba_mfma_body(Frame& F, int l) {
    using namespace moba;
    PHASE_IDS();
    const int r32 = lane & 31, hi = lane >> 5, wid = wave;
    LAS unsigned char* L = F.lds + RING_OFF;
    LAS float* wsf = (LAS float*)(L + L_WSF) + wid * 64;
    LAS float* km = (LAS float*)(L + L_KM);
    LAS float* ost = (LAS float*)(L + L_OST) + wid * 2048;
    float gq = fabsf(F.q_norm_w[l * 64 + lane]), gk = fabsf(F.k_norm_w[l * 64 + lane]);
#pragma unroll
    for (int o = 1; o < 64; o <<= 1) { gq = fmaxf(gq, __shfl_xor(gq, o)); gk = fmaxf(gk, __shfl_xor(gk, o)); }
    gq = __builtin_bit_cast(float, __builtin_amdgcn_readfirstlane(__builtin_bit_cast(int, gq))); gk = __builtin_bit_cast(float, __builtin_amdgcn_readfirstlane(__builtin_bit_cast(int, gk)));
    const float smax2 = 8.0f * gq * gk * LOG2E * 1.02f;
    const float mhat0 = -(smax2 + 1.0f);
    gu32* qctr = F.ctl + CW_QUEUE + 64 * l;
    volatile LAS unsigned* tick = (volatile LAS unsigned*)(F.lds + EXTRA_OFF + 8192);
    if (tid == 0) tick[0] = __hip_atomic_fetch_add(qctr, 1u, RLX_AGENT);
    for (int ui = 0;; ++ui) {
        __syncthreads();
        const int it = __builtin_amdgcn_readfirstlane((int)tick[ui & 1]); if (it >= 1024) break;
        const int qb = 7 - (it >> 7), bh = it & 127;
        const int b = bh >> 3, h = bh & 7; const size_t rowbase = (size_t)b * SEQ; const int q0 = qb * 256, qrel = wid * 32 + r32, tq = q0 + qrel;
        const float sl2 = exp2f(-(float)(h + 1)) * LOG2E;
        bf16x8 qr[4];
        { const GAS bf16* Qw = (const GAS bf16*)(F.QN + (rowbase + q0 + wid * 32 + r32) * 512 + h * 64 + hi * 8);
#pragma unroll
            for (int d0 = 0; d0 < 4; ++d0) qr[d0] = *(const GAS bf16x8*)(Qw + d0 * 16); }
        LAS unsigned char* qlds = (LAS unsigned char*)ost + lane * 16;
        { int tid_u = tid; asm volatile("" : "+v"(tid_u));
          if (tid_u < qb * 64) { const GAS float* kp = (const GAS float*)(F.KPART + ((size_t)b * 8 + (tid_u >> 6)) * 1024 + h * 64 + (tid_u & 63)); km[tid_u] = (kp[0] + kp[512]) * (1.0f / 256.0f); } }
        const unsigned koff = (unsigned)(((rowbase + lane) * 512 + h * 64 + wid * 8) * 2);
        unsigned voff; { const int vr = 8 * wid + (lane >> 3), sl = lane & 7; const int ch = ((((sl >> 2) ^ ((vr >> 1) & 1)) << 2) | (sl & 3)); voff = (unsigned)((((size_t)MTOK + rowbase + vr) * 512 + h * 64 + ch * 8) * 2); }
        const unsigned lds0 = (unsigned)(uintptr_t)L;
#define MOBA_ISSUE(t_, bufi) do { moba_glds(koff, (const void*)((const char*)F.KN + (size_t)(t_) * 65536), (unsigned)__builtin_amdgcn_readfirstlane((int)(lds0 + L_K + (bufi) * 8192 + wid * 1024))); \
            moba_glds(voff, (const void*)((const char*)F.KN + (size_t)(t_) * 65536), (unsigned)__builtin_amdgcn_readfirstlane((int)(lds0 + L_V + (bufi) * 8192 + wid * 1024))); } while (0)
        const int NT = 4 * (qb + 1);
        int t0 = 0; { const float dstar = (151.0f + 2.0f * smax2) / sl2; const float x = ((float)(q0 - 63) - dstar) * (1.0f / 64.0f); if (x > 0.f) t0 = ((int)x) & ~1; if (t0 > NT - 4) t0 = NT - 4; t0 = __builtin_amdgcn_readfirstlane(t0); }
        unsigned nticket = 0u; if (tid == 0) nticket = __hip_atomic_fetch_add(qctr, 1u, RLX_AGENT);
        MOBA_ISSUE(t0, 0); MOBA_ISSUE(t0 + 1, 1); MOBA_ISSUE(t0 + 2, 2);
        __syncthreads();
        unsigned selmask = 0;
        { float gt[7]; float qf32[32];
#pragma unroll
            for (int d0 = 0; d0 < 4; ++d0)
#pragma unroll
                for (int e = 0; e < 8; ++e) qf32[d0 * 8 + e] = bf2f((unsigned short)qr[d0][e]);
#pragma unroll
            for (int i = 0; i < 32; ++i) asm volatile("" : "+v"(qf32[i]));
#pragma unroll
            for (int j = 0; j < 7; ++j) { float s = 0.f;
                if (j < qb) {
#pragma unroll
                    for (int d0 = 0; d0 < 4; ++d0)
#pragma unroll
                        for (int e = 0; e < 8; ++e) s += qf32[d0 * 8 + e] * km[j * 64 + d0 * 16 + hi * 8 + e];
                    auto rr = __builtin_amdgcn_permlane32_swap(__float_as_uint(s), __float_as_uint(s), false, false);
                    s = __uint_as_float(rr[0]) + __uint_as_float(rr[1]); }
                gt[j] = s; }
#pragma unroll
            for (int j = 0; j < 7; ++j) { int rank = 0;
#pragma unroll
                for (int i = 0; i < 7; ++i) if (i != j && i < qb) rank += (gt[i] > gt[j] || (gt[i] == gt[j] && i < j)) ? 1 : 0;
                if (j < qb && rank < 3) selmask |= 1u << j; }
            selmask |= 1u << qb; }
        if (!FIXREF) {
#pragma unroll
            for (int d0 = 0; d0 < 4; ++d0) *(LAS bf16x8*)(qlds + d0 * 1024) = qr[d0]; }
        float mhat = mhat0, l_reg = 0.f; f32x16 o[2]; o[0] = f32x16{}; o[1] = f32x16{};
        const int kbase = L_K + hi * 1024 + r32 * 16;
        const int g16 = lane >> 4, i16 = lane & 15, tq4 = i16 >> 2, tp4 = i16 & 3;
        const int vrow0 = 4 * hi + tq4;
        if (tid == 0) tick[(ui + 1) & 1] = nticket;
        asm volatile("s_waitcnt vmcnt(2)" ::: "memory");
        __syncthreads();
#define MOBA_KLOAD(KOFF) do { if (!FIXREF) { _Pragma("unroll") for (int d0 = 0; d0 < 4; ++d0) qf_[d0] = *(const LAS bf16x8*)(qlds + d0 * 1024); } \
            _Pragma("unroll") for (int d0 = 0; d0 < 4; ++d0) { \
            kfr[2 * d0] = *(const LAS bf16x8*)(L + (KOFF) + kbase + d0 * 2048); kfr[2 * d0 + 1] = *(const LAS bf16x8*)(L + (KOFF) + kbase + d0 * 2048 + 512); } } while (0)
#define MOBA_KLOADH(KOFF, H) do { _Pragma("unroll") for (int d0 = 2 * (H); d0 < 2 * (H) + 2; ++d0) { \
            kfr[2 * d0] = *(const LAS bf16x8*)(L + (KOFF) + kbase + d0 * 2048); kfr[2 * d0 + 1] = *(const LAS bf16x8*)(L + (KOFF) + kbase + d0 * 2048 + 512); } } while (0)
#define MOBA_VLOAD(VOFF) do { _Pragma("unroll") for (int dblk = 0; dblk < 2; ++dblk) _Pragma("unroll") for (int ks = 0; ks < 4; ++ks) { \
            const int rlo = 16 * ks + vrow0, rhi = rlo + 8; \
            vlo[dblk * 4 + ks] = vtr(L + L_V + (VOFF) + rlo * 128 + ((dblk ^ ((rlo >> 1) & 1)) * 64) + (16 * (g16 & 1) + 4 * tp4) * 2); \
            vhi[dblk * 4 + ks] = vtr(L + L_V + (VOFF) + rhi * 128 + ((dblk ^ ((rhi >> 1) & 1)) * 64) + (16 * (g16 & 1) + 4 * tp4) * 2); } } while (0)
#define MOBA_VLOADH(VOFF, DB) do { _Pragma("unroll") for (int ks = 0; ks < 4; ++ks) { \
            const int rlo = 16 * ks + vrow0, rhi = rlo + 8; \
            vlo[(DB) * 4 + ks] = vtr(L + L_V + (VOFF) + rlo * 128 + (((DB) ^ ((rlo >> 1) & 1)) * 64) + (16 * (g16 & 1) + 4 * tp4) * 2); \
            vhi[(DB) * 4 + ks] = vtr(L + L_V + (VOFF) + rhi * 128 + (((DB) ^ ((rhi >> 1) & 1)) * 64) + (16 * (g16 & 1) + 4 * tp4) * 2); } } while (0)
#define MOBA_QK(CANSKIP, TT, P0, P1) do { \
            const int blk_ = (TT) >> 2; \
            if (!((CANSKIP) && (blk_ == qb) && (64 * ((TT) & 3) > 32 * wid + 31))) { \
                const bool sel_ = ((selmask >> blk_) & 1u); \
                float sc0_ = sel_ ? (-mhat - sl2 * (float)(tq - 64 * (TT) - 4 * hi)) : NEG_BIG; asm volatile("" : "+v"(sc0_)); \
_Pragma("unroll") \
                for (int r = 0; r < 16; ++r) { P0[r] = __builtin_fmaf(sl2, (float)((r & 3) + 8 * (r >> 2)), sc0_); P1[r] = __builtin_fmaf(sl2, (float)(32 + (r & 3) + 8 * (r >> 2)), sc0_); } \
_Pragma("unroll") \
                for (int d0 = 0; d0 < 4; ++d0) { \
                    P0 = __builtin_amdgcn_mfma_f32_32x32x16_bf16(kfr[2 * d0], FIXREF ? qr[d0] : qf_[d0], P0, 0, 0, 0); \
                    P1 = __builtin_amdgcn_mfma_f32_32x32x16_bf16(kfr[2 * d0 + 1], FIXREF ? qr[d0] : qf_[d0], P1, 0, 0, 0); } \
            } } while (0)
#define MOBA_SM(OWNP, TT, P0, P1, HAVE_NEXT, N0, N1) do { \
            const bool own = (OWNP); const int jb = (TT) & 3; \
            if (!(own && (64 * jb > 32 * wid + 31))) { \
                if (own && (64 * jb + 63 > 32 * wid)) { \
_Pragma("unroll") \
                    for (int r = 0; r < 16; ++r) { const int kvl = 64 * jb + crow(r, hi); if (kvl > qrel) P0[r] = NEG_BIG; if (kvl + 32 > qrel) P1[r] = NEG_BIG; } } \
                if (!FIXREF) { \
                float rm = max3f(P0[0], P1[0], P0[1]), rm2 = max3f(P1[1], P0[2], P1[2]); \
_Pragma("unroll") \
                for (int r = 3; r < 15; r += 2) { rm = max3f(rm, P0[r], P1[r]); rm2 = max3f(rm2, P0[r + 1], P1[r + 1]); } \
                rm = max3f(rm, rm2, fmaxf(P0[15], P1[15])); \
                { auto rr = __builtin_amdgcn_permlane32_swap(__float_as_uint(rm), __float_as_uint(rm), false, false); rm = fmaxf(__uint_as_float(rr[0]), __uint_as_float(rr[1])); } \
                if (__any(rm > THR)) { \
                    const float dl = fmaxf(rm, 0.f); mhat += dl; \
_Pragma("unroll") \
                    for (int r = 0; r < 16; ++r) { P0[r] -= dl; P1[r] -= dl; } \
                    if (HAVE_NEXT) { \
_Pragma("unroll") \
                        for (int r = 0; r < 16; ++r) { N0[r] -= dl; N1[r] -= dl; } } \
                    const float f = __builtin_amdgcn_exp2f(-dl); l_reg *= f; \
                    if (hi == 0) wsf[r32] = f; \
_Pragma("unroll") \
                    for (int r = 0; r < 16; ++r) { const float fr = wsf[crow(r, hi)]; o[0][r] *= fr; o[1][r] *= fr; } } \
                } \
                float sacc = 0.f, sacc2 = 0.f; \
_Pragma("unroll") \
                for (int r = 0; r < 16; ++r) { P0[r] = __builtin_amdgcn_exp2f(P0[r]); P1[r] = __builtin_amdgcn_exp2f(P1[r]); sacc += P0[r]; sacc2 += P1[r]; } \
                l_reg += sacc + sacc2; \
                { v4u w; \
_Pragma("unroll") \
                    for (int ks = 0; ks < 4; ++ks) { \
_Pragma("unroll") \
                        for (int e = 0; e < 4; ++e) { const int rb = (ks & 1) * 8 + 2 * e; w[e] = (ks < 2) ? cvtpk(P0[rb], P0[rb + 1]) : cvtpk(P1[rb], P1[rb + 1]); } \
                        pa[ks] = __builtin_bit_cast(bf16x8, w); } } \
            } } while (0)
#define MOBA_PV(OWNP, TT) do { \
            if (!((OWNP) && (64 * ((TT) & 3) > 32 * wid + 31))) { \
_Pragma("unroll") \
                for (int dblk = 0; dblk < 2; ++dblk) \
_Pragma("unroll") \
                    for (int ks = 0; ks < 4; ++ks) { \
                        const s16x4 lo = vlo[dblk * 4 + ks], hh = vhi[dblk * 4 + ks]; \
                        const bf16x8 vf = __builtin_shufflevector(lo, hh, 0, 1, 2, 3, 4, 5, 6, 7); \
                        o[dblk] = __builtin_amdgcn_mfma_f32_32x32x16_bf16(pa[ks], vf, o[dblk], 0, 0, 0); } \
            } } while (0)
        f32x16 pA0, pA1, pB0, pB1; bf16x8 kfr[8], qf_[4], pa[4]; s16x4 vlo[8], vhi[8];
        MOBA_KLOAD(0); MOBA_QK(true, t0, pA0, pA1);
        int c0o = 0;
#define MOBA_ILV() do { __builtin_amdgcn_sched_group_barrier(0x002, 16, 0); \
_Pragma("unroll") \
            for (int g_ = 0; g_ < 8; ++g_) { __builtin_amdgcn_sched_group_barrier(0x008, 1, 0); __builtin_amdgcn_sched_group_barrier(0x002, 12, 0); } } while (0)
#define MOBA_STEP2(OWNP) do { \
            const int c1o = (c0o + 1) & 3, c2o = (c0o + 2) & 3, c3o = (c0o + 3) & 3; \
            if (!(OWNP) || t + 3 < NT) MOBA_ISSUE(t + 3, c3o); \
            if (FIXREF) { MOBA_KLOAD(c1o * 8192); __builtin_amdgcn_sched_barrier(0); \
                MOBA_QK(OWNP, t + 1, pB0, pB1); MOBA_SM(OWNP, t, pA0, pA1, false, pB0, pB1); if (!(OWNP)) MOBA_ILV(); __builtin_amdgcn_sched_barrier(0); \
                MOBA_VLOAD(c0o * 8192); __builtin_amdgcn_sched_barrier(0); MOBA_PV(OWNP, t); } \
            else { MOBA_KLOAD(c1o * 8192); __builtin_amdgcn_sched_barrier(0); MOBA_QK(true, t + 1, pB0, pB1); __builtin_amdgcn_sched_barrier(0); \
                MOBA_VLOAD(c0o * 8192); __builtin_amdgcn_sched_barrier(0); MOBA_SM(OWNP, t, pA0, pA1, true, pB0, pB1); MOBA_PV(OWNP, t); } \
            if (!(OWNP) || t + 3 < NT) asm volatile("s_waitcnt vmcnt(2)" ::: "memory"); else asm volatile("s_waitcnt vmcnt(0)" ::: "memory"); \
            __syncthreads(); \
            if (!(OWNP) || t + 4 < NT) MOBA_ISSUE(t + 4, c0o); \
            if (FIXREF) { if (!(OWNP) || t + 2 < NT) MOBA_KLOAD(c2o * 8192); __builtin_amdgcn_sched_barrier(0); \
                if (!(OWNP) || t + 2 < NT) MOBA_QK(OWNP, t + 2, pA0, pA1); MOBA_SM(OWNP, t + 1, pB0, pB1, false, pA0, pA1); if (!(OWNP)) MOBA_ILV(); __builtin_amdgcn_sched_barrier(0); \
                MOBA_VLOAD(c1o * 8192); __builtin_amdgcn_sched_barrier(0); MOBA_PV(OWNP, t + 1); } \
            else { if (t + 2 < NT) { MOBA_KLOAD(c2o * 8192); __builtin_amdgcn_sched_barrier(0); MOBA_QK(true, t + 2, pA0, pA1); __builtin_amdgcn_sched_barrier(0); } \
                MOBA_VLOAD(c1o * 8192); __builtin_amdgcn_sched_barrier(0); MOBA_SM(OWNP, t + 1, pB0, pB1, (t + 2 < NT), pA0, pA1); MOBA_PV(OWNP, t + 1); } \
            if (!(OWNP) || t + 4 < NT) asm volatile("s_waitcnt vmcnt(2)" ::: "memory"); else asm volatile("s_waitcnt vmcnt(0)" ::: "memory"); \
            __syncthreads(); \
            c0o = c2o; } while (0)
        int t = t0;
        for (; t < NT - 4; t += 2) MOBA_STEP2(false);
        for (; t < NT; t += 2) MOBA_STEP2(true);
#undef MOBA_STEP2
#undef MOBA_ISSUE
#undef MOBA_KLOAD
#undef MOBA_KLOADH
#undef MOBA_VLOAD
#undef MOBA_VLOADH
#undef MOBA_QK
#undef MOBA_SM
#undef MOBA_PV
        int lane_e = lane; asm volatile("" : "+v"(lane_e));
        const int r32e = lane_e & 31, hie = lane_e >> 5;
        v4u gwv[4];
#pragma unroll
        for (int i = 0; i < 4; ++i) gwv[i] = *(const GAS v4u*)(F.GA + (rowbase + q0 + wid * 32 + i * 8 + (lane_e >> 3)) * 512 + h * 64 + (lane_e & 7) * 8);
        { auto rr = __builtin_amdgcn_permlane32_swap(__float_as_uint(l_reg), __float_as_uint(l_reg), false, false); l_reg = __uint_as_float(rr[0]) + __uint_as_float(rr[1]); }
        if (hie == 0) wsf[r32e] = 1.0f / l_reg;
#pragma unroll
        for (int r = 0; r < 16; ++r) { const float rl = wsf[crow(r, hie)]; ost[crow(r, hie) * 64 + r32e] = o[0][r] * rl; ost[crow(r, hie) * 64 + 32 + r32e] = o[1][r] * rl; }
#pragma unroll
        for (int i = 0; i < 4; ++i) { const int row = i * 8 + (lane_e >> 3), ch = lane_e & 7;
            const f32x4 a = *(const LAS f32x4*)(ost + row * 64 + ch * 8), c2 = *(const LAS f32x4*)(ost + row * 64 + ch * 8 + 4);
            const size_t grow = rowbase + q0 + wid * 32 + row;
            const v4u gw = gwv[i];
            v4u ow; ow.x = pk2(a[0] * bflo(gw.x), a[1] * bfhi(gw.x)); ow.y = pk2(a[2] * bflo(gw.y), a[3] * bfhi(gw.y));
            ow.z = pk2(c2[0] * bflo(gw.z), c2[1] * bfhi(gw.z)); ow.w = pk2(c2[2] * bflo(gw.w), c2[3] * bfhi(gw.w));
            *(GAS v4u*)(F.MIXED + grow * DM + 512 + h * 64 + ch * 8) = ow; }
    }
    __syncthreads();
}


__device__ __forceinline__ void moba_mfma_phase(Frame& F, int l) {
    float gq = 0.f, gk = 0.f;
    for (int i = 0; i < 64; ++i) { gq = fmaxf(gq, fabsf(F.q_norm_w[l * 64 + i])); gk = fmaxf(gk, fabsf(F.k_norm_w[l * 64 + i])); }
    if (2.0f * (8.0f * gq * gk * LOG2E * 1.02f) + 1.0f <= 100.0f) moba_mfma_body<true>(F, l); else moba_mfma_body<false>(F, l);
}

namespace hg {
typedef short bf16x8 __attribute__((ext_vector_type(8)));
typedef short s16x4 __attribute__((ext_vector_type(4)));
typedef float f32x4 __attribute__((ext_vector_type(4)));
typedef unsigned u32x2 __attribute__((ext_vector_type(2)));
constexpr int SLOT = 33792, NSLOT = 4;
constexpr int L_SC = NSLOT * SLOT, L_NRM = L_SC + 4096;
constexpr int NSTEP = SEQ / 32;
__device__ __forceinline__ int fsw(int t) { return ((t & 7) << 2) | (((t >> 3) & 1) << 1); }
__device__ __forceinline__ int unit_off(int tok, int cg) { return 8 * (32 * tok + (cg ^ fsw(tok))); }
__device__ __forceinline__ s16x4 rd64(const LAS unsigned char* p) { return *(const LAS s16x4*)p; }
__device__ __forceinline__ s16x4 vtr(const LAS unsigned char* p) { return __builtin_bit_cast(s16x4, __builtin_amdgcn_ds_read_tr16_b64_v4i16((LAS s16x4*)p)); }
__device__ __forceinline__ bf16x8 cat(s16x4 a, s16x4 b) { return __builtin_shufflevector(a, b, 0, 1, 2, 3, 4, 5, 6, 7); }
__device__ __forceinline__ s16x4 pack4(f32x4 v) { u32x2 w; w.x = moba::cvtpk(v[0], v[1]); w.y = moba::cvtpk(v[2], v[3]); return __builtin_bit_cast(s16x4, w); }
__device__ __forceinline__ void glds16(const GAS void* gsrc, unsigned lds_dst) { unsigned keep;
    asm volatile("s_mov_b32 %0, m0\n\ts_mov_b32 m0, %2\n\ts_nop 0\n\tglobal_load_lds_dwordx4 %1, off\n\ts_mov_b32 m0, %0" : "=&s"(keep) : "v"(gsrc), "s"(lds_dst) : "memory"); }
__device__ __forceinline__ void glds16s(unsigned voff, const void* sbase, unsigned lds_dst) { unsigned keep;
    asm volatile("s_mov_b32 %0, m0\n\ts_mov_b32 m0, %3\n\ts_nop 0\n\tglobal_load_lds_dwordx4 %1, %2\n\ts_mov_b32 m0, %0" : "=&s"(keep) : "v"(voff), "s"(sbase), "s"(lds_dst) : "memory"); }
#define HG_MFMA(a, b, c) __builtin_amdgcn_mfma_f32_16x16x32_bf16((a), (b), (c), 0, 0, 0)
}

__device__ __forceinline__ void hgrn_mfma_phase(Frame& F, int l) {
    using namespace hg;
    PHASE_IDS();
    const int w = wave, c16 = lane & 15, g = lane >> 4;
    LAS unsigned char* L = F.lds + RING_OFF;
    const s16x4 z4 = (s16x4){0, 0, 0, 0};
    for (int it = (int)blockIdx.x; it < 64; it += F.G) {
        const int b = it >> 2, h = it & 3; const size_t rowbase = (size_t)b * SEQ;
        const int da = w >> 1;
        unsigned dsrc[4];
#pragma unroll
        for (int i = 0; i < 4; ++i) { const int t = 16 * (w & 1) + 4 * i + (lane >> 4); const int sc = (lane & 15) ^ (fsw(t) >> 1);
            dsrc[i] = (unsigned)((((size_t)da * MTOK + rowbase + t) * 512 + h * 128 + 8 * sc) * 2); }
        const unsigned ddec = (unsigned)((((size_t)b * NSTEP) * 512 + h * 128 + 4 * lane) * 4);
        const int ddst = da * 8192 + (w & 1) * 4096;
        const unsigned lds0 = (unsigned)(uintptr_t)(F.lds + RING_OFF);
#define HG_ISSUE(step) do { const unsigned so_ = lds0 + (unsigned)(((step) & 3) * SLOT); \
            _Pragma("unroll") for (int i = 0; i < 4; ++i) \
                glds16s(dsrc[i], (const void*)((const char*)F.QI + (size_t)(step) * (32 * 512 * 2)), (unsigned)__builtin_amdgcn_readfirstlane((int)(so_ + ddst + i * 1024))); \
            if (w == 0) glds16s(ddec, (const void*)((const char*)F.DEC + (size_t)(step) * 2048), (unsigned)__builtin_amdgcn_readfirstlane((int)(so_ + 32768))); } while (0)
        f32x4 S[8]; bf16x8 Sb[4];
#pragma unroll
        for (int tk = 0; tk < 8; ++tk) S[tk] = (f32x4){0.f, 0.f, 0.f, 0.f};
#pragma unroll
        for (int ks = 0; ks < 4; ++ks) Sb[ks] = (bf16x8){0, 0, 0, 0, 0, 0, 0, 0};
        f32x4 oprev[2]; oprev[0] = (f32x4){0.f, 0.f, 0.f, 0.f}; oprev[1] = oprev[0];
        u32x2 gprev[2]; gprev[0] = (u32x2){0u, 0u}; gprev[1] = gprev[0];
        float hw[4];
#pragma unroll
        for (int r = 0; r < 4; ++r) hw[r] = F.hg_norm_w[l * 128 + 16 * w + 4 * g + r];
        asm volatile("" : "+v"(hw[0]), "+v"(hw[1]), "+v"(hw[2]), "+v"(hw[3]));
        LAS float* nrm = (LAS float*)(L + L_NRM);
        LAS unsigned char* SC = L + L_SC;
        HG_ISSUE(0); HG_ISSUE(1); HG_ISSUE(2);
        asm volatile("s_waitcnt vmcnt(8)\n\ts_barrier" ::: "memory");
        const int trq = c16 >> 2, trp = c16 & 3;
        int ro0 = 256 * c16 + 16 * (g ^ (fsw(c16) >> 1)), ko0 = 256 * (4 * g + trq) + 16 * (trp ^ (fsw(4 * g + trq) >> 1));
#define RO(ks) (ro0 ^ (64 * (ks)))
#define KO(tk) (ko0 ^ (64 * ((tk) >> 1) + 8 * ((tk) & 1)))
        const int io_ = unit_off(4 * g + trq, 4 * w + trp), go_ = unit_off(c16, 4 * w + g);
        bf16x8 qf[2][4];
#define HG_LOADQ(slotbase) do { _Pragma("unroll") for (int tt = 0; tt < 2; ++tt) _Pragma("unroll") for (int ks = 0; ks < 4; ++ks) \
            qf[tt][ks] = *(const LAS bf16x8*)((slotbase) + RO(ks) + 4096 * tt); } while (0)
#define HG_FINAL(step, P) do { _Pragma("unroll") for (int tt = 0; tt < 2; ++tt) { \
            const float ssum = ((P[tt][0] + P[tt][1]) + (P[tt][2] + P[tt][3])) + ((P[tt][4] + P[tt][5]) + (P[tt][6] + P[tt][7])); \
            const float rstd = __builtin_amdgcn_rsqf(ssum * (1.0f / 128.0f) + NORM_EPS); \
            u32x2 wv; wv.x = moba::cvtpk(oprev[tt][0] * rstd * hw[0] * bflo(gprev[tt].x), oprev[tt][1] * rstd * hw[1] * bfhi(gprev[tt].x)); \
            wv.y = moba::cvtpk(oprev[tt][2] * rstd * hw[2] * bflo(gprev[tt].y), oprev[tt][3] * rstd * hw[3] * bfhi(gprev[tt].y)); \
            *(GAS u32x2*)(F.MIXED + (rowbase + (size_t)(step) * 32 + 16 * tt + c16) * DM + h * 128 + 16 * w + 4 * g) = wv; } } while (0)
        HG_LOADQ(L);
        for (int n = 0; n < NSTEP; ++n) {
            asm volatile("" : "+v"(ro0), "+v"(ko0));
            if (n + 3 < NSTEP) HG_ISSUE(n + 3);
            const LAS unsigned char* Qs = L + (n & 3) * SLOT; const LAS unsigned char* Ks = Qs + 8192; const LAS unsigned char* Is = Qs + 16384; const LAS unsigned char* Gs = Qs + 24576;
            const LAS float* Ds = (const LAS float*)(Qs + 32768);
            LAS unsigned char* SCn = SC + (n & 1) * 1536;
            bf16x8 kf[4];
            if (w < 3) { const int st = (w == 2) ? 1 : 0;
#pragma unroll
                for (int ks = 0; ks < 4; ++ks) kf[ks] = *(const LAS bf16x8*)(Ks + RO(ks) + 4096 * st); }
            u32x2 gcur[2];
#pragma unroll
            for (int tt = 0; tt < 2; ++tt) gcur[tt] = *(const LAS u32x2*)(Gs + go_ + 4096 * tt);
            s16x4 itr[2];
#pragma unroll
            for (int st = 0; st < 2; ++st) itr[st] = vtr(Is + io_ + 4096 * st);
            const bf16x8 i01 = cat(itr[0], itr[1]);
            bf16x8 k01[4]; f32x4 dv4[4];
#pragma unroll
            for (int tk = 0; tk < 4; ++tk) { k01[tk] = cat(vtr(Ks + KO(tk)), vtr(Ks + KO(tk) + 4096)); dv4[tk] = *(const LAS f32x4*)(Ds + 16 * tk + 4 * g); }
            f32x4 o[2];
#pragma unroll
            for (int tt = 0; tt < 2; ++tt) { f32x4 a = (f32x4){0.f, 0.f, 0.f, 0.f};
#pragma unroll
                for (int ks = 0; ks < 4; ++ks) a = HG_MFMA(Sb[ks], qf[tt][ks], a);
                o[tt] = a; }
            if (w < 3) { f32x4 sc = (f32x4){0.f, 0.f, 0.f, 0.f};
                if (w == 0) {
#pragma unroll
                    for (int ks = 0; ks < 4; ++ks) sc = HG_MFMA(kf[ks], qf[0][ks], sc);
                } else {
#pragma unroll
                    for (int ks = 0; ks < 4; ++ks) sc = HG_MFMA(kf[ks], qf[1][ks], sc); }
                if (w != 1) {
#pragma unroll
                    for (int r = 0; r < 4; ++r) if (4 * g + r > c16) sc[r] = 0.f; }
                *(LAS s16x4*)(SCn + w * 512 + lane * 8) = pack4(sc); }
#pragma unroll
            for (int tk = 0; tk < 4; ++tk) S[tk] = HG_MFMA(k01[tk], i01, S[tk]);
            asm volatile("" ::: "memory");
            { bf16x8 k2[4]; f32x4 d2[4];
#pragma unroll
                for (int tk = 0; tk < 4; ++tk) { k2[tk] = cat(vtr(Ks + KO(tk + 4)), vtr(Ks + KO(tk + 4) + 4096)); d2[tk] = *(const LAS f32x4*)(Ds + 16 * (tk + 4) + 4 * g); }
#pragma unroll
                for (int tk = 0; tk < 4; ++tk) S[tk] = S[tk] * dv4[tk];
#pragma unroll
                for (int ks = 0; ks < 2; ++ks) Sb[ks] = cat(pack4(S[2 * ks]), pack4(S[2 * ks + 1]));
#pragma unroll
                for (int tk = 0; tk < 4; ++tk) S[tk + 4] = HG_MFMA(k2[tk], i01, S[tk + 4]);
#pragma unroll
                for (int tk = 0; tk < 4; ++tk) S[tk + 4] = S[tk + 4] * d2[tk];
#pragma unroll
                for (int ks = 2; ks < 4; ++ks) Sb[ks] = cat(pack4(S[2 * ks]), pack4(S[2 * ks + 1])); }
            if (n >= NSTEP - 3) asm volatile("s_waitcnt vmcnt(0) lgkmcnt(0)\n\ts_barrier" ::: "memory");
            else if (n <= 1) asm volatile("s_waitcnt vmcnt(8) lgkmcnt(0)\n\ts_barrier" ::: "memory");
            else if (n == 2) asm volatile("s_waitcnt vmcnt(10) lgkmcnt(0)\n\ts_barrier" ::: "memory");
            else asm volatile("s_waitcnt vmcnt(12) lgkmcnt(0)\n\ts_barrier" ::: "memory");
            const s16x4 sc00 = rd64(SCn + lane * 8), sc01 = rd64(SCn + 512 + lane * 8), sc11 = rd64(SCn + 1024 + lane * 8);
            float pn[2][8];
            if (n > 0) {
#pragma unroll
                for (int tt = 0; tt < 2; ++tt)
#pragma unroll
                    for (int ww = 0; ww < 8; ++ww) pn[tt][ww] = nrm[((n - 1) & 1) * 256 + ww * 32 + 16 * tt + c16]; }
            if (n + 1 < NSTEP) HG_LOADQ(L + ((n + 1) & 3) * SLOT);
            o[0] = HG_MFMA(cat(itr[0], z4), cat(sc00, z4), o[0]);
            o[1] = HG_MFMA(i01, cat(sc01, sc11), o[1]);
            { float ss0 = (o[0][0] * o[0][0] + o[0][1] * o[0][1]) + (o[0][2] * o[0][2] + o[0][3] * o[0][3]);
              float ss1 = (o[1][0] * o[1][0] + o[1][1] * o[1][1]) + (o[1][2] * o[1][2] + o[1][3] * o[1][3]);
              { auto r0 = __builtin_amdgcn_permlane16_swap(__float_as_uint(ss0), __float_as_uint(ss0), false, false); auto r1 = __builtin_amdgcn_permlane16_swap(__float_as_uint(ss1), __float_as_uint(ss1), false, false);
                ss0 = __uint_as_float(r0[0]) + __uint_as_float(r0[1]); ss1 = __uint_as_float(r1[0]) + __uint_as_float(r1[1]); }
              { auto r0 = __builtin_amdgcn_permlane32_swap(__float_as_uint(ss0), __float_as_uint(ss0), false, false); auto r1 = __builtin_amdgcn_permlane32_swap(__float_as_uint(ss1), __float_as_uint(ss1), false, false);
                ss0 = __uint_as_float(r0[0]) + __uint_as_float(r0[1]); ss1 = __uint_as_float(r1[0]) + __uint_as_float(r1[1]); }
              if (g == 0) { nrm[(n & 1) * 256 + w * 32 + c16] = ss0; nrm[(n & 1) * 256 + w * 32 + 16 + c16] = ss1; } }
            if (n > 0) HG_FINAL(n - 1, pn);
            oprev[0] = o[0]; oprev[1] = o[1]; gprev[0] = gcur[0]; gprev[1] = gcur[1];
        }
        asm volatile("s_waitcnt vmcnt(0) lgkmcnt(0)\n\ts_barrier" ::: "memory");
        { float pn[2][8];
#pragma unroll
            for (int tt = 0; tt < 2; ++tt)
#pragma unroll
                for (int ww = 0; ww < 8; ++ww) pn[tt][ww] = nrm[((NSTEP - 1) & 1) * 256 + ww * 32 + 16 * tt + c16];
            HG_FINAL(NSTEP - 1, pn); }
        asm volatile("s_waitcnt vmcnt(0) lgkmcnt(0)\n\ts_barrier" ::: "memory");
#undef RO
#undef KO
#undef HG_LOADQ
#undef HG_FINAL
#undef HG_ISSUE
    }
}

struct Args { const float* in[8]; float* out; unsigned char* ws; int ph_lo, ph_hi, li, pad; };
__global__ void __launch_bounds__(NWAVES * 64, 2) fwd(Args args) {
    extern __shared__ __attribute__((aligned(16))) unsigned char lds[];
    Frame F;
    F.lds = (LAS unsigned char*)lds;
    F.MISC = (volatile LAS unsigned*)(F.lds + MISC_OFF);
    F.G = gridDim.x; { const int bx = blockIdx.x; F.vcu = (F.G % 8 == 0) ? (bx % 8) * (F.G / 8) + bx / 8 : bx; }
    unsigned char* ws = args.ws;
    F.ctl = (gu32*)(ws + WS_CTL);
    F.x = args.in[0]; F.norm_w = args.in[1]; F.w_in = args.in[2]; F.lb_logits = args.in[3]; F.hg_norm_w = args.in[4]; F.q_norm_w = args.in[5]; F.k_norm_w = args.in[6]; F.w_out = args.in[7];
    F.out = args.out;
    F.WIN = (bf16*)(ws + WS_WIN); F.WOUT = (bf16*)(ws + WS_WOUT); F.XB = (bf16*)(ws + WS_XB); F.MIXED = (bf16*)(ws + WS_MIXED);
    F.QI = (bf16*)(ws + WS_ARR); F.KT = (bf16*)(ws + WS_ARR + ARR_BYTES); F.HI = (bf16*)(ws + WS_ARR + 2 * ARR_BYTES); F.GH = (bf16*)(ws + WS_ARR + 3 * ARR_BYTES);
    F.QN = (bf16*)(ws + WS_ARR + 4 * ARR_BYTES); F.KN = (bf16*)(ws + WS_ARR + 5 * ARR_BYTES); F.V = (bf16*)(ws + WS_ARR + 6 * ARR_BYTES); F.GA = (bf16*)(ws + WS_ARR + 7 * ARR_BYTES);
    F.LB = (float*)(ws + WS_LB); F.KPART = (float*)(ws + WS_KPART); F.ROWSS = (float*)(ws + WS_ROWSS); F.DEC = (float*)(ws + WS_DEC);
    F.wave0 = __builtin_amdgcn_readfirstlane((int)threadIdx.x >> 6);
    for (int u = F.wave0 * 64 + lane_id_asm(); u < (LDS_BYTES - LDSCTL_OFF) / 4; u += NWAVES * 64) ((LAS unsigned*)(F.lds + LDSCTL_OFF))[u] = 0u;
    __syncthreads();
    XcdBarrier bar; bar.bar = (unsigned*)(F.ctl + CW_BAR); bar.x = 0; bar.st = nullptr; bar.wave0 = F.wave0;
    if (N_LAUNCHES == 1) bar = xcd_barrier_post((unsigned*)(F.ctl + CW_BAR), F.MISC + 8, F.wave0);
#define GRID_BAR() do { if (N_LAUNCHES == 1) xcd_barrier(bar); } while (0)
    const int lo = (N_LAUNCHES == 1) ? 0 : args.ph_lo, hi = (N_LAUNCHES == 1) ? N_PHASES : args.ph_hi;
#define IN(k) (lo <= (k) && (k) < hi)
#define BOTH(k) (IN(k) && IN((k) + 1))

    if (IN(0)) { p0_prologue(F); if (BOTH(0)) GRID_BAR(); }
    for (int l = 0; l < DEPTH; ++l) {
        const int pb = 1 + 3 * l;
        if (IN(pb)) {
            pg8::Gemm g{F.XB + (size_t)l * MTOK * DM, F.WIN + (size_t)l * NIN * DM, MTOK, NIN, DM}; pg8::StaticOrder S; S.init(MTOK, NIN, F.G, (int)blockIdx.x, (int)(blockIdx.x & 7));
            pg8::EpiFused E{F.QI, F.DEC, F.KPART, F.ROWSS + (size_t)l * MTOK * 16, F.LB + l * 512, F.q_norm_w + l * 64, F.k_norm_w + l * 64, nullptr, 0};
            {
                pg8::Unit u0{0, 0}, u4{0, 0}, ut; bool two = S.next(0, u0) && S.next(4, u4);
                for (int i = 0; two && S.next(i, ut); ++i) two = (ut.pm == u0.pm || ut.pm == u4.pm);
                if (two) { LAS float* rt = (LAS float*)(F.lds + EXTRA_OFF); int t_ = F.wave0 * 64 + lane_id_asm(); asm volatile("" : "+v"(t_));
                    rt[t_] = pg8::EpiFused::rstd_global(E.rowss, ((t_ >> 8) ? u4.pm : u0.pm) * 256 + (t_ & 255));
                    E.rtab = rt; E.pm0 = u0.pm; __syncthreads(); } }
            for (int rp = 0; rp < REP_PROJ; ++rp) { if (rp) GRID_BAR(); pg8::gemm_phase<pg8::EpiFused, pg8::StaticOrder, true, true>(F.lds + RING_OFF, g, S, E, F.wave0); }
            if (BOTH(pb)) GRID_BAR();
        }
        if (IN(pb + 1)) {
            for (int rp = 0; rp < REP_HGRN; ++rp) { if (rp) GRID_BAR(); hgrn_mfma_phase(F, l); }
            for (int rp = 0; rp < REP_MOBA; ++rp) { if (rp) { GRID_BAR(); if (blockIdx.x == 0 && F.wave0 == 0 && lane_id_asm() == 0) __hip_atomic_store(F.ctl + CW_QUEUE + 64 * l, 0u, RLX_AGENT); GRID_BAR(); } moba_mfma_phase(F, l); }
            if (BOTH(pb + 1)) GRID_BAR(); }
        if (IN(pb + 2)) {
            pg8::Gemm g{F.MIXED, F.WOUT + (size_t)l * DM * DM, MTOK, DM, DM}; pg8::StaticOrder S; S.init(MTOK, DM, F.G, (int)blockIdx.x);
            pg8::EpiOut E{l == 0 ? F.XB : F.XB + (size_t)MTOK * DM, l == 0 ? nullptr : F.out, l == 0 ? F.XB + (size_t)MTOK * DM : nullptr, l == 0 ? F.ROWSS + (size_t)MTOK * 16 : nullptr};
            for (int rp = 0; rp < REP_OUT; ++rp) { if (rp) GRID_BAR(); pg8::gemm_phase<pg8::EpiOut, pg8::StaticOrder, true, true>(F.lds + RING_OFF, g, S, E, F.wave0); }
            if (pb + 2 < N_PHASES - 1 && BOTH(pb + 2)) GRID_BAR();
        }
    }
#undef IN
#undef BOTH
}

extern "C" void kernel_launch(void* const* d_in, const int* in_sizes, int n_in, void* d_out, int out_size, void* d_ws, size_t ws_size, hipStream_t stream) {
    static int grid = 0;
    if (grid == 0) {
        if (n_in != 8 || in_sizes[0] != MTOK * DM || out_size != MTOK * DM || ws_size < WS_END) { fprintf(stderr, "kernel_launch: unexpected shapes n_in %d in0 %d out %d ws %zu\n", n_in, n_in > 0 ? in_sizes[0] : -1, out_size, ws_size); grid = -1; return; }
        int dev = 0, cus = 0, per_cu = 0;
        if (hipGetDevice(&dev) != hipSuccess || hipDeviceGetAttribute(&cus, hipDeviceAttributeMultiprocessorCount, dev) != hipSuccess) { grid = -1; return; }
        if (hipFuncSetAttribute((const void*)fwd, hipFuncAttributeMaxDynamicSharedMemorySize, LDS_BYTES) != hipSuccess) { fprintf(stderr, "kernel_launch: hipFuncSetAttribute failed\n"); grid = -1; return; }
        if (hipOccupancyMaxActiveBlocksPerMultiprocessor(&per_cu, (const void*)fwd, NWAVES * 64, LDS_BYTES) != hipSuccess || per_cu < 1) fprintf(stderr, "kernel_launch: occupancy query says %d\n", per_cu);
        (void)hipGetLastError();
        if (per_cu < 1) { grid = -1; return; }
        grid = cus < 512 ? cus : 512;
    }
    if (grid < 0) return;
    if (hipMemsetAsync((char*)d_ws + WS_CTL, 0, CTL_ZERO_BYTES, stream) != hipSuccess) return;
    Args a{};
    for (int i = 0; i < 8; ++i) a.in[i] = (const float*)d_in[i];
    a.out = (float*)d_out; a.ws = (unsigned char*)d_ws;
    for (int li = 0; li < N_LAUNCHES; ++li) {
        a.ph_lo = (N_LAUNCHES == 1) ? 0 : li; a.ph_hi = (N_LAUNCHES == 1) ? N_PHASES : li + 1; a.li = li;
        hipError_t le;
        if (N_LAUNCHES == 1) { void* kargs[] = {(void*)&a}; le = hipLaunchCooperativeKernel((const void*)fwd, dim3(grid), dim3(NWAVES * 64), kargs, LDS_BYTES, stream); }
        else { hipLaunchKernelGGL(fwd, dim3(grid), dim3(NWAVES * 64), LDS_BYTES, stream, a); le = hipPeekAtLastError(); }
        if (le != hipSuccess) { fprintf(stderr, "kernel_launch: launch %d failed: %s\n", li, hipGetErrorName(le)); break; }
    }
}
```

```cpp
#include <hip/hip_runtime.h>
#include <cstdio>
#include <cstdint>
__device__ __forceinline__ int lane_id_asm() { int l; asm volatile("v_mbcnt_lo_u32_b32 %0, -1, 0\n\tv_mbcnt_hi_u32_b32 %0, -1, %0" : "=v"(l)); return l; }
namespace pg8 {
#define PG8_LAS __attribute__((address_space(3)))
typedef unsigned short bf16_t;
typedef short bf16x8 __attribute__((ext_vector_type(8)));
typedef float f32x4 __attribute__((ext_vector_type(4)));
typedef unsigned u32x4 __attribute__((ext_vector_type(4)));
typedef unsigned u32x2 __attribute__((ext_vector_type(2)));
constexpr int BM = 256, BK = 64, HALF = 128, HTB = HALF * BK * 2  , STAGE_BYTES = 8 * HTB, NXCD = 8, WGM = 8;

__host__ __device__ __forceinline__ int lds_byte(int r, int c) { const int st = (r >> 4) * 2 + (c >> 5), rr = r & 15, cc = c & 31, ob = rr * 64 + cc * 2; return st * 1024 + (ob ^ (((ob >> 9) & 1) << 5)); }
__host__ __device__ __forceinline__ void stage_rc(int b, int& R, int& C) { const int st = b / 1024, sb = b % 1024, swz = sb ^ (((sb >> 9) & 1) << 5); R = (st >> 1) * 16 + swz / 64; C = (st & 1) * 32 + (swz % 64) / 2; }
__host__ __device__ __forceinline__ int perm32(int rho) { const int n = rho >> 4, i = rho & 15; return 8 * (i >> 2) + 4 * n + (i & 3); }

struct Unit { int pm, pn; };
struct Gemm { const bf16_t* A; const bf16_t* Bt; int M, N, K; };

struct StaticOrder {
    int nM, nN, nwg, G, c, rot;
    __host__ __device__ void init(int M, int N, int G_, int c_, int rot_ = 0) { __builtin_assume(c_ >= 0 && c_ < 512);     nM = M / BM; nN = N / BM; nwg = nM * nN; G = G_; c = c_; rot = (nwg == 8 * G_) ? rot_ : 0; }
    __host__ __device__ bool next(int i, Unit& u) const {
        if ((long)i * G + c >= nwg) return false;
        const long L = (long)((i + rot) & (rot ? 7 : -1)) * G + c;
        int wgid = (int)L; { const int q = nwg / NXCD, r = nwg % NXCD, xcd = wgid % NXCD, off = wgid / NXCD; wgid = (xcd < r ? xcd * (q + 1) : r * (q + 1) + (xcd - r) * q) + off; }
        const int nig = WGM * nN, gid = wgid / nig, fm = gid * WGM, gsz = (nM - fm) < WGM ? (nM - fm) : WGM;
        u.pm = fm + ((wgid % nig) % gsz); u.pn = (wgid % nig) / gsz; return true;
    }
    __device__ __forceinline__ void a_ready(const Unit&) const {}
    __device__ __forceinline__ void done(const Unit&) const {}
};

__device__ __forceinline__ unsigned cvt_pk_bf16(float lo, float hi) { unsigned r; asm volatile("v_cvt_pk_bf16_f32 %0, %1, %2" : "=v"(r) : "v"(lo), "v"(hi)); return r; }


__device__ __forceinline__ float dpp_row_shr(float v, int n) {
    const int x = __builtin_bit_cast(int, v);
    int r;
    if (n == 1) r = __builtin_amdgcn_update_dpp(0, x, 0x111, 0xf, 0xf, false);
    else if (n == 2) r = __builtin_amdgcn_update_dpp(0, x, 0x112, 0xf, 0xf, false);
    else if (n == 4) r = __builtin_amdgcn_update_dpp(0, x, 0x114, 0xf, 0xf, false);
    else r = __builtin_amdgcn_update_dpp(0, x, 0x118, 0xf, 0xf, false);
    return __builtin_bit_cast(float, r);
}
__device__ __forceinline__ float dpp_row_shr1(float v, int n) {
    const int x = __builtin_bit_cast(int, v); const int one = 0x3f800000;
    int r;
    if (n == 1) r = __builtin_amdgcn_update_dpp(one, x, 0x111, 0xf, 0xf, false);
    else if (n == 2) r = __builtin_amdgcn_update_dpp(one, x, 0x112, 0xf, 0xf, false);
    else if (n == 4) r = __builtin_amdgcn_update_dpp(one, x, 0x114, 0xf, 0xf, false);
    else r = __builtin_amdgcn_update_dpp(one, x, 0x118, 0xf, 0xf, false);
    return __builtin_bit_cast(float, r);
}
__device__ __forceinline__ float fsig(float z) { return __builtin_amdgcn_rcpf(1.0f + __expf(-z)); }
struct EpiFused {
    static constexpr bool PERM = true, AFTER_DRAIN = false;
    bf16_t* ARR; float* DEC; float* KPART; const float* rowss; const float* lb; const float* qg; const float* kg;
    static constexpr size_t AS = (size_t)32768 * 512;
    const PG8_LAS float* rtab; int pm0;
    __device__ __forceinline__ float rstd_of(int row) const { return rtab ? rtab[(((row >> 8) == pm0) ? 0 : 256) + (row & 255)] : rstd_global(rowss, row); }
    static __device__ __forceinline__ float rstd_global(const float* rowss, int row) {
        const f32x4* rp = (const f32x4*)(rowss + (size_t)row * 16);
        const f32x4 a = rp[0], b = rp[1], c = rp[2], d = rp[3];
        const float ss = ((a[0] + a[1]) + (a[2] + a[3])) + ((b[0] + b[1]) + (b[2] + b[3])) + ((c[0] + c[1]) + (c[2] + c[3])) + ((d[0] + d[1]) + (d[2] + d[3]));
        return 1.0f / sqrtf(ss * (1.0f / 1024.0f) + 1e-6f);
    }
    static __device__ __forceinline__ u32x4 pack8(const float (&v)[8]) { u32x4 w; w.x = cvt_pk_bf16(v[0], v[1]); w.y = cvt_pk_bf16(v[2], v[3]); w.z = cvt_pk_bf16(v[4], v[5]); w.w = cvt_pk_bf16(v[6], v[7]); return w; }
    __device__ __forceinline__ void operator()(const f32x4 (&acc)[2][2][4][2], const Unit& u, int wr, int wc, int fr, int fq) const {
        const int row0 = u.pm * BM + wr * 64 + fr; const int pn = u.pn;
        if (pn < 4) {
            const int cb = pn * 128 + wc * 32 + 8 * fq;
            float lbv[8];
#pragma unroll
            for (int k = 0; k < 8; ++k) lbv[k] = lb[cb + k];
#pragma unroll
            for (int ai = 0; ai < 2; ++ai)
#pragma unroll
                for (int mp = 0; mp < 2; ++mp) { const int row1 = row0 + ai * HALF + mp * 32, row2 = row1 + 16; const float rs1 = rstd_of(row1), rs2 = rstd_of(row2);
                    float qi1[8], kt1[8], qi2[8], kt2[8], dc[8];
#pragma unroll
                    for (int k = 0; k < 8; ++k) {
                        const float zq1 = acc[ai][0][2 * mp][k >> 2][k & 3] * rs1, zf1 = acc[ai][1][2 * mp][k >> 2][k & 3] * rs1;
                        const float zq2 = acc[ai][0][2 * mp + 1][k >> 2][k & 3] * rs2, zf2 = acc[ai][1][2 * mp + 1][k >> 2][k & 3] * rs2;
                        const float f1 = lbv[k] + (1.0f - lbv[k]) * fsig(zf1), f2 = lbv[k] + (1.0f - lbv[k]) * fsig(zf2);
                        float e1 = f1, e2 = f2;
                        e1 *= dpp_row_shr1(e1, 1); e2 *= dpp_row_shr1(e2, 1); e1 *= dpp_row_shr1(e1, 2); e2 *= dpp_row_shr1(e2, 2);
                        e1 *= dpp_row_shr1(e1, 4); e2 *= dpp_row_shr1(e2, 4); e1 *= dpp_row_shr1(e1, 8); e2 *= dpp_row_shr1(e2, 8);
                        e2 *= __shfl(e1, (fq << 4) | 15);
                        qi1[k] = zq1 * fsig(zq1) * e1; kt1[k] = (1.0f - f1) * fminf(__builtin_amdgcn_rcpf(e1), 5.5406224e34f);
                        qi2[k] = zq2 * fsig(zq2) * e2; kt2[k] = (1.0f - f2) * fminf(__builtin_amdgcn_rcpf(e2), 5.5406224e34f); dc[k] = e2; }
                    { const int pc = pn * 128 + wc * 32 + 16 * (fq & 1) + 4 * (fq >> 1);
                      const u32x4 a1 = pack8(qi1), b1 = pack8(kt1), a2 = pack8(qi2), b2 = pack8(kt2);
                      bf16_t* q1 = ARR + (size_t)row1 * 512 + pc; bf16_t* q2 = ARR + (size_t)row2 * 512 + pc;
                      *(u32x2*)(q1) = (u32x2){a1.x, a1.y}; *(u32x2*)(q1 + 8) = (u32x2){a1.z, a1.w}; *(u32x2*)(q1 + AS) = (u32x2){b1.x, b1.y}; *(u32x2*)(q1 + AS + 8) = (u32x2){b1.z, b1.w};
                      *(u32x2*)(q2) = (u32x2){a2.x, a2.y}; *(u32x2*)(q2 + 8) = (u32x2){a2.z, a2.w}; *(u32x2*)(q2 + AS) = (u32x2){b2.x, b2.y}; *(u32x2*)(q2 + AS + 8) = (u32x2){b2.z, b2.w}; }
                    if (fr == 15) { float* dp = DEC + (size_t)(row1 >> 5) * 512 + cb; *(f32x4*)dp = (f32x4){dc[0], dc[1], dc[2], dc[3]}; *(f32x4*)(dp + 4) = (f32x4){dc[4], dc[5], dc[6], dc[7]}; }
                    asm volatile("" ::: "memory"); }
        } else if (pn < 8) {
            const int cb = (pn - 4) * 128 + wc * 32 + 8 * fq;
#pragma unroll
            for (int ai = 0; ai < 2; ++ai)
#pragma unroll
                for (int m = 0; m < 4; ++m) { const int row = row0 + ai * HALF + m * 16; const float rs = rstd_of(row);
                    float iv[8], gv[8];
#pragma unroll
                    for (int k = 0; k < 8; ++k) { iv[k] = acc[ai][0][m][k >> 2][k & 3] * rs; const float zg = acc[ai][1][m][k >> 2][k & 3] * rs; gv[k] = zg * fsig(zg); }
                    *(u32x4*)(ARR + 2 * AS + (size_t)row * 512 + cb) = pack8(iv); *(u32x4*)(ARR + 3 * AS + (size_t)row * 512 + cb) = pack8(gv);
                    asm volatile("" ::: "memory"); }
        } else {
            const int ty = (pn - 8) >> 1, head = 4 * ((pn - 8) & 1) + wc; const int d0 = 8 * fq;
            bf16_t* dst = ARR + (size_t)(4 + ty) * AS;
            float gain[2][8]; float csum[2][8];
#pragma unroll
            for (int bj = 0; bj < 2; ++bj)
#pragma unroll
                for (int k = 0; k < 8; ++k) { gain[bj][k] = (ty == 0) ? qg[bj * 32 + d0 + k] * (0.125f * 1.4426950408889634f) : (ty == 1) ? kg[bj * 32 + d0 + k] : 1.0f; csum[bj][k] = 0.f; }
#pragma unroll
            for (int ai = 0; ai < 2; ++ai)
#pragma unroll
                for (int m = 0; m < 4; ++m) { const int row = row0 + ai * HALF + m * 16; const float rs = rstd_of(row);
                    float v[2][8];
#pragma unroll
                    for (int bj = 0; bj < 2; ++bj)
#pragma unroll
                        for (int k = 0; k < 8; ++k) v[bj][k] = acc[ai][bj][m][k >> 2][k & 3] * rs;
                    if (ty < 2) { float ss = 0.f;
#pragma unroll
                        for (int bj = 0; bj < 2; ++bj)
#pragma unroll
                            for (int k = 0; k < 8; ++k) ss += v[bj][k] * v[bj][k];
                        ss += __shfl_xor(ss, 16); ss += __shfl_xor(ss, 32);
                        const float r2 = 1.0f / sqrtf(ss * (1.0f / 64.0f) + 1e-6f);
#pragma unroll
                        for (int bj = 0; bj < 2; ++bj)
#pragma unroll
                            for (int k = 0; k < 8; ++k) { v[bj][k] *= r2 * gain[bj][k]; csum[bj][k] += v[bj][k]; }
                    } else if (ty == 3) {
#pragma unroll
                        for (int bj = 0; bj < 2; ++bj)
#pragma unroll
                            for (int k = 0; k < 8; ++k) v[bj][k] = v[bj][k] * fsig(v[bj][k]); }
                    *(u32x4*)(dst + (size_t)row * 512 + head * 64 + d0) = pack8(v[0]); *(u32x4*)(dst + (size_t)row * 512 + head * 64 + 32 + d0) = pack8(v[1]);
                    asm volatile("" ::: "memory"); }
            if (ty == 1) {
#pragma unroll
                for (int bj = 0; bj < 2; ++bj)
#pragma unroll
                    for (int k = 0; k < 8; ++k) { float s = csum[bj][k]; s += __shfl_xor(s, 1); s += __shfl_xor(s, 2); s += __shfl_xor(s, 4); s += __shfl_xor(s, 8); csum[bj][k] = s; }
                if (fr == 0) { float* kp = KPART + ((size_t)u.pm * 2 + wr) * 512 + head * 64 + d0;
#pragma unroll
                    for (int bj = 0; bj < 2; ++bj) { *(f32x4*)(kp + bj * 32) = (f32x4){csum[bj][0], csum[bj][1], csum[bj][2], csum[bj][3]}; *(f32x4*)(kp + bj * 32 + 4) = (f32x4){csum[bj][4], csum[bj][5], csum[bj][6], csum[bj][7]}; } }
            }
        }
    }
};
struct EpiOut {
    static constexpr bool PERM = true, AFTER_DRAIN = false;
    const bf16_t* xres16; float* out; bf16_t* xb; float* rowss;
    __device__ __forceinline__ void operator()(const f32x4 (&acc)[2][2][4][2], const Unit& u, int wr, int wc, int fr, int fq) const {
        const int col0 = u.pn * BM + wc * 32 + 8 * fq;
        const size_t base = (size_t)(u.pm * BM + wr * 64 + fr) * 1024 + col0;
        u32x4 res[2][4][2];
#pragma unroll
        for (int ai = 0; ai < 2; ++ai)
#pragma unroll
            for (int m = 0; m < 4; ++m)
#pragma unroll
                for (int bj = 0; bj < 2; ++bj) res[ai][m][bj] = *(const u32x4*)(xres16 + base + (size_t)(ai * HALF + m * 16) * 1024 + bj * HALF);
#pragma unroll
        for (int ai = 0; ai < 2; ++ai)
#pragma unroll
            for (int m = 0; m < 4; ++m) {
                const int row = u.pm * BM + ai * HALF + wr * 64 + m * 16 + fr; float ss = 0.f;
#pragma unroll
                for (int bj = 0; bj < 2; ++bj) { const size_t off = (size_t)row * 1024 + col0 + bj * HALF;
                    const u32x4 r = res[ai][m][bj];
                    f32x4 v0 = (f32x4){__builtin_bit_cast(float, r.x << 16), __builtin_bit_cast(float, r.x & 0xffff0000u), __builtin_bit_cast(float, r.y << 16), __builtin_bit_cast(float, r.y & 0xffff0000u)};
                    f32x4 v1 = (f32x4){__builtin_bit_cast(float, r.z << 16), __builtin_bit_cast(float, r.z & 0xffff0000u), __builtin_bit_cast(float, r.w << 16), __builtin_bit_cast(float, r.w & 0xffff0000u)};
                    v0 = v0 + acc[ai][bj][m][0]; v1 = v1 + acc[ai][bj][m][1];
                    if (out) { *(f32x4*)(out + off) = v0; *(f32x4*)(out + off + 4) = v1; }
                    if (xb) { u32x4 w; w.x = cvt_pk_bf16(v0[0], v0[1]); w.y = cvt_pk_bf16(v0[2], v0[3]); w.z = cvt_pk_bf16(v1[0], v1[1]); w.w = cvt_pk_bf16(v1[2], v1[3]); *(u32x4*)(xb + off) = w; }
                    ss += ((v0[0] * v0[0] + v0[1] * v0[1]) + (v0[2] * v0[2] + v0[3] * v0[3])) + ((v1[0] * v1[0] + v1[1] * v1[1]) + (v1[2] * v1[2] + v1[3] * v1[3])); }
                ss += __shfl_xor(ss, 16); ss += __shfl_xor(ss, 32);
                if (fq == 0 && rowss) rowss[(size_t)row * 16 + u.pn * 4 + wc] = ss;
            }
    }
};

template <class Epi, class Sched, bool ALIGN_EPI = false, bool SP2 = false>
__device__ __forceinline__ void gemm_phase(PG8_LAS unsigned char* lds, const Gemm g, const Sched& S, const Epi& E, const int wave0) {
    int tid = wave0 * 64 + lane_id_asm(); asm volatile("" : "+v"(tid));
    const int wid = __builtin_amdgcn_readfirstlane(tid >> 6), lane = tid & 63, wr = wid >> 2, wc = wid & 3, fr = lane & 15, fq = lane >> 4;
    const int K = g.K, nt = K / BK;
    unsigned voffA[2], voffB[2];
#pragma unroll
    for (int i = 0; i < 2; ++i) { int R, C; stage_rc(tid * 16 + i * 8192, R, C); const int Rb = Epi::PERM ? ((R & ~31) + perm32(R & 31)) : R;
        voffA[i] = (unsigned)(R * K + C) * 2u; voffB[i] = (unsigned)(Rb * K + C) * 2u; }
    const size_t kstep = (size_t)(BK * 2);
    const size_t hstep = (size_t)HALF * K * 2;
    const size_t tstep = 2 * hstep;
    const unsigned ldsw = (unsigned)wid * 1024u;
    const int aoff = lds_byte(wr * 64 + fr, fq * 8), boff = lds_byte(wc * 32 + fr, fq * 8);
#define PG8_SA(b, h) (((b) * 2 + (h)) * HTB)
#define PG8_SB(b, h) ((4 + (b) * 2 + (h)) * HTB)
#define PG8_STAGE(bufoff, gbase, voff) do { _Pragma("unroll") for (int _i = 0; _i < 2; ++_i) \
        __builtin_amdgcn_global_load_lds((const unsigned*)((const char*)(gbase) + (voff)[_i]), (PG8_LAS unsigned*)(lds + (bufoff) + ldsw + _i * 8192), 16, 0, 0); } while (0)
#define PG8_LDA(dst, b, h) do { _Pragma("unroll") for (int m = 0; m < 4; ++m) _Pragma("unroll") for (int k = 0; k < 2; ++k) dst[m][k] = *(const PG8_LAS bf16x8*)(lds + PG8_SA(b, h) + aoff + m * 2048 + k * 1024); } while (0)
#define PG8_LDB(dst, b, h) do { _Pragma("unroll") for (int n = 0; n < 2; ++n) _Pragma("unroll") for (int k = 0; k < 2; ++k) dst[n][k] = *(const PG8_LAS bf16x8*)(lds + PG8_SB(b, h) + boff + n * 2048 + k * 1024); } while (0)
#define PG8_MMA(ai, bj, At, Bt) do { __builtin_amdgcn_s_setprio(1); _Pragma("unroll") for (int m = 0; m < 4; ++m) _Pragma("unroll") for (int n = 0; n < 2; ++n) _Pragma("unroll") for (int k = 0; k < 2; ++k) \
        acc[ai][bj][m][n] = __builtin_amdgcn_mfma_f32_16x16x32_bf16(Bt[n][k], At[m][k], acc[ai][bj][m][n], 0, 0, 0); __builtin_amdgcn_s_setprio(0); } while (0)
#define PG8_WAIT_V(n) asm volatile("s_waitcnt vmcnt(" #n ")" ::: "memory")
#define PG8_WAIT_L(n) asm volatile("s_waitcnt lgkmcnt(" #n ")" ::: "memory")
#define PG8_BAR __builtin_amdgcn_s_barrier()
#define PG8_SCHED __builtin_amdgcn_sched_barrier(0)
    Unit cur, nxt; int ui = 0;
    if (!S.next(0, cur)) return;
    f32x4 acc[2][2][4][2];
#pragma unroll
    for (int a = 0; a < 2; ++a)
#pragma unroll
        for (int b = 0; b < 2; ++b)
#pragma unroll
            for (int m = 0; m < 4; ++m)
#pragma unroll
                for (int n = 0; n < 2; ++n) acc[a][b][m][n] = (f32x4){0.f, 0.f, 0.f, 0.f};
    bf16x8 At[4][2], B0[2][2], B1[2][2];
    const char* cA = (const char*)g.A + (size_t)cur.pm * tstep; const char* cB = (const char*)g.Bt + (size_t)cur.pn * tstep;
    S.a_ready(cur);
    if constexpr (SP2) {
        PG8_STAGE(PG8_SB(0, 0), cB, voffB); PG8_STAGE(PG8_SB(0, 1), cB + hstep, voffB); PG8_STAGE(PG8_SA(0, 0), cA, voffA); PG8_STAGE(PG8_SA(0, 1), cA + hstep, voffA);
        if (wr == 1) PG8_BAR;
        PG8_WAIT_V(2); PG8_BAR;
        PG8_STAGE(PG8_SB(1, 0), cB + kstep, voffB); PG8_STAGE(PG8_SA(1, 0), cA + kstep, voffA); PG8_STAGE(PG8_SB(1, 1), cB + hstep + kstep, voffB);
        PG8_WAIT_V(6); PG8_BAR;
    } else {
        PG8_STAGE(PG8_SB(0, 0), cB, voffB); PG8_STAGE(PG8_SA(0, 0), cA, voffA); PG8_STAGE(PG8_SB(0, 1), cB + hstep, voffB); PG8_STAGE(PG8_SA(0, 1), cA + hstep, voffA);
        if (wr == 1) PG8_BAR;
        PG8_WAIT_V(4); PG8_BAR;
        PG8_STAGE(PG8_SB(1, 0), cB + kstep, voffB); PG8_STAGE(PG8_SA(1, 0), cA + kstep, voffA); PG8_STAGE(PG8_SB(1, 1), cB + hstep + kstep, voffB);
        PG8_WAIT_V(6); PG8_BAR;
    }
    for (;;) {
        const bool has_next = S.next(ui + 1, nxt);
        const char* nA = has_next ? (const char*)g.A + (size_t)nxt.pm * tstep : cA; const char* nB = has_next ? (const char*)g.Bt + (size_t)nxt.pn * tstep : cB;
        for (int t = 0; t < nt; t += 2) {
            const bool last = (t == nt - 2);
            const char* a1 = cA + (size_t)(t + 1) * kstep;
            const char* a2 = last ? nA : cA + (size_t)(t + 2) * kstep; const char* b2 = last ? nB : cB + (size_t)(t + 2) * kstep;
            const char* a3 = a2 + kstep; const char* b3 = b2 + kstep;
            if (last && has_next) S.a_ready(nxt);
            if constexpr (SP2) {
            PG8_LDB(B0, 0, 0); PG8_LDB(B1, 0, 1); PG8_SCHED; PG8_LDA(At, 0, 0); PG8_STAGE(PG8_SA(1, 1), a1 + hstep, voffA);
            PG8_WAIT_V(8); PG8_WAIT_L(0); PG8_BAR; PG8_MMA(0, 0, At, B0); PG8_MMA(0, 1, At, B1); PG8_BAR; PG8_SCHED;
            PG8_LDA(At, 0, 1); PG8_STAGE(PG8_SB(0, 0), b2, voffB); PG8_STAGE(PG8_SB(0, 1), b2 + hstep, voffB); PG8_STAGE(PG8_SA(0, 0), a2, voffA);
            PG8_WAIT_V(8); PG8_WAIT_L(0); PG8_BAR; PG8_MMA(1, 0, At, B0); PG8_MMA(1, 1, At, B1); PG8_BAR; PG8_SCHED;
            PG8_LDB(B0, 1, 0); PG8_LDB(B1, 1, 1); PG8_SCHED; PG8_LDA(At, 1, 0); PG8_STAGE(PG8_SA(0, 1), a2 + hstep, voffA);
            PG8_WAIT_V(8); PG8_WAIT_L(0); PG8_BAR; PG8_MMA(0, 0, At, B0); PG8_MMA(0, 1, At, B1); PG8_BAR; PG8_SCHED;
            PG8_LDA(At, 1, 1); PG8_STAGE(PG8_SB(1, 0), b3, voffB); PG8_STAGE(PG8_SB(1, 1), b3 + hstep, voffB); PG8_STAGE(PG8_SA(1, 0), a3, voffA);
            PG8_WAIT_V(8); PG8_WAIT_L(0); PG8_BAR; PG8_MMA(1, 0, At, B0); PG8_MMA(1, 1, At, B1); PG8_BAR; PG8_SCHED;
            } else {
            PG8_LDB(B0, 0, 0); PG8_SCHED; PG8_LDA(At, 0, 0); PG8_STAGE(PG8_SA(1, 1), a1 + hstep, voffA);
            PG8_WAIT_L(8); PG8_BAR; PG8_WAIT_L(0); PG8_MMA(0, 0, At, B0); PG8_BAR; PG8_SCHED;
            PG8_LDB(B1, 0, 1); PG8_STAGE(PG8_SB(0, 0), b2, voffB);
            PG8_BAR; PG8_WAIT_L(0); PG8_MMA(0, 1, At, B1); PG8_BAR;
            PG8_LDA(At, 0, 1); PG8_STAGE(PG8_SA(0, 0), a2, voffA);
            PG8_BAR; PG8_WAIT_L(0); PG8_MMA(1, 0, At, B0); PG8_BAR; PG8_SCHED;
            PG8_STAGE(PG8_SB(0, 1), b2 + hstep, voffB);
            PG8_WAIT_V(6); PG8_BAR; PG8_MMA(1, 1, At, B1); PG8_BAR;
            PG8_LDB(B0, 1, 0); PG8_SCHED; PG8_LDA(At, 1, 0); PG8_STAGE(PG8_SA(0, 1), a2 + hstep, voffA);
            PG8_WAIT_L(8); PG8_BAR; PG8_WAIT_L(0); PG8_MMA(0, 0, At, B0); PG8_BAR; PG8_SCHED;
            PG8_LDB(B1, 1, 1); PG8_STAGE(PG8_SB(1, 0), b3, voffB);
            PG8_BAR; PG8_WAIT_L(0); PG8_MMA(0, 1, At, B1); PG8_BAR;
            PG8_LDA(At, 1, 1); PG8_STAGE(PG8_SA(1, 0), a3, voffA);
            PG8_BAR; PG8_WAIT_L(0); PG8_MMA(1, 0, At, B0); PG8_BAR; PG8_SCHED;
            PG8_STAGE(PG8_SB(1, 1), b3 + hstep, voffB);
            PG8_WAIT_V(6); PG8_BAR; PG8_MMA(1, 1, At, B1); PG8_BAR;
            }
        }
        if constexpr (ALIGN_EPI) { if (wr == 0) PG8_BAR; }
        if constexpr (!Epi::AFTER_DRAIN) { E(acc, cur, wr, wc, fr, fq); S.done(cur); }
        if (!has_next) break;
#pragma unroll
        for (int a = 0; a < 2; ++a)
#pragma unroll
            for (int b = 0; b < 2; ++b)
#pragma unroll
                for (int m = 0; m < 4; ++m)
#pragma unroll
                    for (int n = 0; n < 2; ++n) acc[a][b][m][n] = (f32x4){0.f, 0.f, 0.f, 0.f};
        cur = nxt; cA = nA; cB = nB; ++ui;
        if constexpr (ALIGN_EPI) { if (wr == 1) PG8_BAR; }
    }
    PG8_WAIT_V(0);
    if constexpr (!ALIGN_EPI) { if (wr == 0) PG8_BAR; }
    PG8_BAR;
    if constexpr (Epi::AFTER_DRAIN) { E.fused(acc, cur, wr, wc, fr, fq, lds, wid, lane); S.done(cur); }
#undef PG8_SA
#undef PG8_SB
#undef PG8_STAGE
#undef PG8_LDA
#undef PG8_LDB
#undef PG8_MMA
#undef PG8_WAIT_V
#undef PG8_WAIT_L
#undef PG8_BAR
#undef PG8_SCHED
}
}


constexpr int NWAVES = 8;
#ifndef REP_PROJ
#define REP_PROJ 1
#endif
#ifndef REP_HGRN
#define REP_HGRN 1
#endif
#ifndef REP_MOBA
#define REP_MOBA 1
#endif
#ifndef REP_OUT
#define REP_OUT 1
#endif
#ifndef MK_N_LAUNCHES
#define MK_N_LAUNCHES 1
#endif
constexpr int N_PHASES = 7;
constexpr int N_LAUNCHES = MK_N_LAUNCHES;

constexpr int BATCH = 16, SEQ = 2048, DM = 1024, DEPTH = 2, MTOK = BATCH * SEQ, NIN = 4096;
constexpr int C_HQ = 0, C_HF = 512, C_HI = 1024, C_HG = 1536, C_AQ = 2048, C_AK = 2560, C_AV = 3072, C_AG = 3584;
constexpr float NORM_EPS = 1e-6f;

constexpr size_t MiB = 1u << 20;
constexpr size_t WS_CTL = 0, CTL_ZERO_BYTES = 32768;
constexpr size_t WS_WIN = 2 * MiB;
constexpr size_t WS_WOUT = 18 * MiB;
constexpr size_t WS_LB = 22 * MiB;
constexpr size_t WS_KPART = 22 * MiB + 65536;
constexpr size_t WS_ROWSS = 24 * MiB;
constexpr size_t WS_DEC = 28 * MiB;
constexpr size_t WS_XB = 32 * MiB;
constexpr size_t WS_MIXED = 160 * MiB;
constexpr size_t WS_ARR = 224 * MiB;
constexpr size_t ARR_BYTES = 32 * MiB;
constexpr size_t WS_END = 480 * MiB;
constexpr int CW_QUEUE = 1024;
constexpr int CW_BAR = 4096;

constexpr int RING_OFF = 0, RING_BYTES = 131072;
constexpr int EXTRA_OFF = RING_BYTES, EXTRA_BYTES = 16384;
constexpr int LDSCTL_OFF = EXTRA_OFF + EXTRA_BYTES, MISC_OFF = LDSCTL_OFF + 320;
constexpr int LDS_BYTES = LDSCTL_OFF + 1024;

#define GAS __attribute__((address_space(1)))
#define LAS __attribute__((address_space(3)))
typedef unsigned short bf16;
typedef unsigned v4u __attribute__((ext_vector_type(4)));
typedef float f32x4 __attribute__((ext_vector_type(4)));
typedef GAS unsigned gu32;
#define RLX_AGENT __ATOMIC_RELAXED, __HIP_MEMORY_SCOPE_AGENT
#define LDS_WAIT() asm volatile("s_waitcnt lgkmcnt(0)" ::: "memory")
#define VM_WAIT() asm volatile("s_waitcnt vmcnt(0)" ::: "memory")
__device__ __forceinline__ unsigned f2bf(float f) { unsigned u = __builtin_bit_cast(unsigned, f); return (u + 0x7fffu + ((u >> 16) & 1u)) >> 16; }
__device__ __forceinline__ unsigned pk2(float lo, float hi) { return f2bf(lo) | (f2bf(hi) << 16); }
__device__ __forceinline__ float bf2f(unsigned short b) { return __builtin_bit_cast(float, (unsigned)b << 16); }
__device__ __forceinline__ float bflo(unsigned w) { return __builtin_bit_cast(float, w << 16); }
__device__ __forceinline__ float bfhi(unsigned w) { return __builtin_bit_cast(float, w & 0xffff0000u); }
__device__ __forceinline__ float silu_f(float z) { return z / (1.0f + __expf(-z)); }
__device__ __forceinline__ float sigmoid_f(float z) { return 1.0f / (1.0f + __expf(-z)); }

#define XB_TMO      128
#define XB_XCNT(j)  (256  + 64 * (j))
#define XB_XSUB(j)  (1280 + 64 * (j))
#define XB_XGEN(j)  (2304 + 64 * (j))
#define XB_TOP      3328
#define XB_TOPGEN   3392
#define XCD_BAR_WORDS 3456
#define XB_SPIN_CAP (1u << 18)

__device__ __forceinline__ unsigned xb_ld(unsigned* p)              { return __hip_atomic_load(p, __ATOMIC_RELAXED, __HIP_MEMORY_SCOPE_AGENT); }
__device__ __forceinline__ unsigned xb_add(unsigned* p, unsigned v) { return __hip_atomic_fetch_add(p, v, __ATOMIC_RELAXED, __HIP_MEMORY_SCOPE_AGENT); }
__device__ __forceinline__ unsigned xb_xcc_id() { return (unsigned)__builtin_amdgcn_s_getreg((3 << 11) | 20) & 0xFu; }
#define XB_SPIN(cond, bar) do { unsigned _sp = 0; while (cond) { __builtin_amdgcn_s_sleep(1); \
    if ((++_sp & 255u) == 0u) { if (xb_ld(&(bar)[XB_TMO])) break; if (_sp > XB_SPIN_CAP) { atomicAdd(&(bar)[XB_TMO], 1u); break; } } } } while (0)

struct XcdBarrier {
    unsigned* bar; unsigned x; int wave0;
    volatile LAS unsigned* st;
};

#define XB_IS_T0(wv) ((wv) == 0 && lane_id_asm() == 0)
__device__ __forceinline__ XcdBarrier xcd_barrier_post(unsigned* bar, volatile LAS unsigned* st, int wave0) {
    XcdBarrier b; b.bar = bar; b.x = xb_xcc_id(); b.st = st; b.wave0 = wave0;
    if (XB_IS_T0(wave0)) (void)xb_add(&bar[XB_XCNT(b.x)], 1u);
    return b;
}
__device__ __forceinline__ void xcd_barrier_complete(unsigned* bar, unsigned x, unsigned& nloc, unsigned& nx) {
    const unsigned G = gridDim.x * gridDim.y * gridDim.z;
    unsigned sum, cnt, mine, sp = 0u;
    for (;;) {
        sum = 0u; cnt = 0u; mine = 0u;
#pragma unroll
        for (unsigned j = 0; j < 16; ++j) { const unsigned c = xb_ld(&bar[XB_XCNT(j)]); sum += c; cnt += (c > 0u) ? 1u : 0u; mine = (j == x) ? c : mine; }
        if (sum == G) break;
        __builtin_amdgcn_s_sleep(1);
        if ((++sp & 255u) == 0u) { if (xb_ld(&bar[XB_TMO])) break; if (sp > XB_SPIN_CAP) { atomicAdd(&bar[XB_TMO], 1u); break; } }
    }
    nloc = mine > 0u ? mine : 1u; nx = cnt > 0u ? cnt : 1u;
}

__device__ __forceinline__ void xcd_barrier(const XcdBarrier& b) {
    asm volatile("s_waitcnt vmcnt(0)" ::: "memory");
    __syncthreads();
    if (XB_IS_T0(b.wave0)) {
        unsigned* bar = b.bar;
        __builtin_amdgcn_s_waitcnt(0);
        unsigned nloc = b.st[0], nx = b.st[1];
        if (nloc == 0u) { xcd_barrier_complete(bar, b.x, nloc, nx); b.st[0] = nloc; b.st[1] = nx; }
        const unsigned old = xb_add(&bar[XB_XSUB(b.x)], 1u);
        const unsigned gen = old / nloc;
        if (old + 1u == (gen + 1u) * nloc) {
            __builtin_amdgcn_fence(__ATOMIC_RELEASE, "agent");
            asm volatile("s_waitcnt vmcnt(0)" ::: "memory");
            const unsigned og = xb_add(&bar[XB_TOP], 1u);
            const unsigned tg = og / nx;
            if (og + 1u == (tg + 1u) * nx) xb_add(&bar[XB_TOPGEN], 1u);
            else XB_SPIN(xb_ld(&bar[XB_TOPGEN]) == tg, bar);
            __builtin_amdgcn_fence(__ATOMIC_ACQUIRE, "agent");
            xb_add(&bar[XB_XGEN(b.x)], 1u);
            asm volatile("s_waitcnt vmcnt(0)" ::: "memory");
        } else {
            XB_SPIN(xb_ld(&bar[XB_XGEN(b.x)]) == gen, bar);
            __builtin_amdgcn_fence(__ATOMIC_ACQUIRE, "agent");
            asm volatile("s_waitcnt vmcnt(0)" ::: "memory");
        }
    }
    __syncthreads();
}


struct Frame {
    LAS unsigned char* lds;
    volatile LAS unsigned* MISC;
    int wave0;
    gu32* ctl;
    int vcu, G;
    const float* x; float* out;
    const float *norm_w, *w_in, *lb_logits, *hg_norm_w, *q_norm_w, *k_norm_w, *w_out;
    bf16 *WIN, *WOUT, *XB, *MIXED, *QI, *KT, *HI, *GH, *QN, *KN, *V, *GA;
    float *LB, *KPART, *ROWSS, *DEC;
};

__device__ __forceinline__ float wave_sum(float v) {
#pragma unroll
    for (int o = 1; o < 64; o <<= 1) v += __shfl_xor(v, o);
    return v;
}
__device__ __forceinline__ int win_dest(int oc) {
    if (oc < 2048) { const int grp = oc >> 9, hh = (oc >> 7) & 3, w = oc & 127; return 256 * (((grp >> 1) << 2) + hh) + 128 * (grp & 1) + w; }
    const int ty = (oc - 2048) >> 9, head = (oc >> 6) & 7, bj = (oc >> 5) & 1; return 256 * (8 + 2 * ty + (head >> 2)) + 128 * bj + 32 * (head & 3);
}
__device__ __forceinline__ void p0_transpose_item(const float* W, int K, int N, bf16* WT, const float* kscale, LAS float* scr, int item, int lane, bool permute) {
    const int nblk = N / 32, kb = item / nblk, nb = item % nblk, k0 = 64 * kb, n0 = 32 * nb; const int nd = permute ? win_dest(n0) : n0;
    float wv_[32];
#pragma unroll
    for (int i = 0; i < 32; ++i) wv_[i] = __builtin_nontemporal_load(W + (size_t)(k0 + 2 * i + (lane >> 5)) * N + n0 + (lane & 31));
#pragma unroll
    for (int i = 0; i < 32; ++i) { const int kk = 2 * i + (lane >> 5); const float s = kscale ? kscale[k0 + kk] : 1.0f; scr[kk * 33 + (lane & 31)] = wv_[i] * s; }
    LDS_WAIT(); asm volatile("" ::: "memory");
    const int c = lane & 7;
#pragma unroll
    for (int j = 0; j < 4; ++j) { const int n = (lane >> 3) + 8 * j; const LAS float* s = scr + (8 * c) * 33 + n;
        v4u o; o.x = pk2(s[0 * 33], s[1 * 33]); o.y = pk2(s[2 * 33], s[3 * 33]); o.z = pk2(s[4 * 33], s[5 * 33]); o.w = pk2(s[6 * 33], s[7 * 33]);
        *(GAS v4u*)(WT + (size_t)(nd + n) * K + k0 + 8 * c) = o; }
    LDS_WAIT(); asm volatile("" ::: "memory");
}
#define PHASE_IDS() int t_ = F.wave0 * 64 + lane_id_asm(); asm volatile("" : "+v"(t_)); const int tid = t_, lane = tid & 63, wave = __builtin_amdgcn_readfirstlane(tid >> 6); (void)lane; (void)wave
__device__ __forceinline__ void p0_prologue(Frame& F) {
    PHASE_IDS();
    LAS float* scr = (LAS float*)(F.lds + RING_OFF + wave * 16384);
    const int gw = F.vcu * NWAVES + wave, NGW = F.G * NWAVES;
    constexpr int I_IN = (DM / 64) * (NIN / 32), I_OUT = (DM / 64) * (DM / 32);
    constexpr int NITEMS = DEPTH * (I_IN + I_OUT);
    for (int it = gw; it < NITEMS; it += NGW) {
        int r = it;
        if (r < DEPTH * I_IN) { const int l = r / I_IN; r -= l * I_IN;
            p0_transpose_item(F.w_in + (size_t)l * DM * NIN, DM, NIN, F.WIN + (size_t)l * NIN * DM, F.norm_w + l * DM, scr, r, lane, true); continue; }
        r -= DEPTH * I_IN; { const int l = r / I_OUT; r -= l * I_OUT;
            p0_transpose_item(F.w_out + (size_t)l * DM * DM, DM, DM, F.WOUT + (size_t)l * DM * DM, nullptr, scr, r, lane, false); }
    }
    for (int m0 = gw * 4; m0 < MTOK; m0 += NGW * 4) {
        f32x4 v[4][4]; float sq[4];
#pragma unroll
        for (int r = 0; r < 4; ++r) { const GAS f32x4* xr = (const GAS f32x4*)(F.x + (size_t)(m0 + r) * DM) + lane;
#pragma unroll
            for (int j = 0; j < 4; ++j) v[r][j] = __builtin_nontemporal_load(xr + 64 * j); }
#pragma unroll
        for (int r = 0; r < 4; ++r) { float a = 0.f;
#pragma unroll
            for (int j = 0; j < 4; ++j) a += (v[r][j].x * v[r][j].x + v[r][j].y * v[r][j].y) + (v[r][j].z * v[r][j].z + v[r][j].w * v[r][j].w);
            sq[r] = a; }
#pragma unroll
        for (int o = 1; o < 64; o <<= 1) {
#pragma unroll
            for (int r = 0; r < 4; ++r) sq[r] += __shfl_xor(sq[r], o); }
#pragma unroll
        for (int r = 0; r < 4; ++r) { GAS unsigned long long* o8 = (GAS unsigned long long*)(F.XB + (size_t)(m0 + r) * DM) + lane;
#pragma unroll
            for (int j = 0; j < 4; ++j) o8[64 * j] = (unsigned long long)pk2(v[r][j].x, v[r][j].y) | ((unsigned long long)pk2(v[r][j].z, v[r][j].w) << 32);
            if (lane < 16) F.ROWSS[(size_t)(m0 + r) * 16 + lane] = (lane == 0) ? sq[r] : 0.f; }
    }
    if (blockIdx.x == 0) { const int c = tid; const float a0 = F.lb_logits[c], a1 = F.lb_logits[512 + c]; const float mx = fmaxf(a0, a1);
        const float e0 = expf(a0 - mx), e1 = expf(a1 - mx); const float p0 = e0 / (e0 + e1), p1 = e1 / (e0 + e1);
        F.LB[c] = 0.f; F.LB[512 + c] = fminf(fmaxf((p0 + p1) - p0, 0.f), 1.0f - 1e-6f); }
}

constexpr float LOG2E = 1.4426950408889634f;
constexpr float QSCALE2 = 0.125f * LOG2E;
namespace moba {
typedef short bf16x8 __attribute__((ext_vector_type(8)));
typedef short s16x4 __attribute__((ext_vector_type(4)));
typedef float f32x16 __attribute__((ext_vector_type(16)));
typedef float f32x2_t __attribute__((ext_vector_type(2))); typedef __bf16 bf16x2_t __attribute__((ext_vector_type(2)));
__device__ __forceinline__ unsigned cvtpk(float lo, float hi) { f32x2_t v = {lo, hi}; bf16x2_t b = __builtin_convertvector(v, bf16x2_t); return __builtin_bit_cast(unsigned, b); }
__device__ __forceinline__ int crow(int r, int hi) { return (r & 3) + 8 * (r >> 2) + 4 * hi; }
__device__ __forceinline__ float max3f(float a, float b, float c) { float r; asm("v_max3_f32 %0, %1, %2, %3" : "=v"(r) : "v"(a), "v"(b), "v"(c)); return r; }
constexpr int L_K = 0, L_V = 32768, L_WSF = 65536, L_KM = 67584, L_OST = 69632;
constexpr float NEG_BIG = -1e30f;
constexpr float THR = 8.0f;
__device__ __forceinline__ s16x4 vtr(const LAS unsigned char* p) { return __builtin_bit_cast(s16x4, __builtin_amdgcn_ds_read_tr16_b64_v4i16((LAS s16x4*)p)); }
}

__device__ __forceinline__ void moba_glds(unsigned voff, const void* sbase, unsigned lds_dst) { unsigned keep;
    asm volatile("s_mov_b32 %0, m0\n\ts_mov_b32 m0, %3\n\ts_nop 0\n\tglobal_load_lds_dwordx4 %1, %2\n\ts_mov_b32 m0, %0" : "=&s"(keep) : "v"(voff), "s"(sbase), "s"(lds_dst) : "memory"); }
template <bool FIXREF> __device__ __forceinline__ void moba_mfma_body(Frame& F, int l) {
    using namespace moba;
    PHASE_IDS();
    const int r32 = lane & 31, hi = lane >> 5, wid = wave;
    LAS unsigned char* L = F.lds + RING_OFF;
    LAS float* wsf = (LAS float*)(L + L_WSF) + wid * 64;
    LAS float* km = (LAS float*)(L + L_KM);
    LAS float* ost = (LAS float*)(L + L_OST) + wid * 2048;
    float gq = fabsf(F.q_norm_w[l * 64 + lane]), gk = fabsf(F.k_norm_w[l * 64 + lane]);
#pragma unroll
    for (int o = 1; o < 64; o <<= 1) { gq = fmaxf(gq, __shfl_xor(gq, o)); gk = fmaxf(gk, __shfl_xor(gk, o)); }
    gq = __builtin_bit_cast(float, __builtin_amdgcn_readfirstlane(__builtin_bit_cast(int, gq))); gk = __builtin_bit_cast(float, __builtin_amdgcn_readfirstlane(__builtin_bit_cast(int, gk)));
    const float smax2 = 8.0f * gq * gk * LOG2E * 1.02f;
    const float mhat0 = -(smax2 + 1.0f);
    gu32* qctr = F.ctl + CW_QUEUE + 64 * l;
    volatile LAS unsigned* tick = (volatile LAS unsigned*)(F.lds + EXTRA_OFF + 8192);
    if (tid == 0) tick[0] = __hip_atomic_fetch_add(qctr, 1u, RLX_AGENT);
    for (int ui = 0;; ++ui) {
        __syncthreads();
        const int it = __builtin_amdgcn_readfirstlane((int)tick[ui & 1]); if (it >= 1024) break;
        const int qb = 7 - (it >> 7), bh = it & 127;
        const int b = bh >> 3, h = bh & 7; const size_t rowbase = (size_t)b * SEQ; const int q0 = qb * 256, qrel = wid * 32 + r32, tq = q0 + qrel;
        const float sl2 = exp2f(-(float)(h + 1)) * LOG2E;
        bf16x8 qr[4];
        { const GAS bf16* Qw = (const GAS bf16*)(F.QN + (rowbase + q0 + wid * 32 + r32) * 512 + h * 64 + hi * 8);
#pragma unroll
            for (int d0 = 0; d0 < 4; ++d0) qr[d0] = *(const GAS bf16x8*)(Qw + d0 * 16); }
        LAS unsigned char* qlds = (LAS unsigned char*)ost + lane * 16;
        { int tid_u = tid; asm volatile("" : "+v"(tid_u));
          if (tid_u < qb * 64) { const GAS float* kp = (const GAS float*)(F.KPART + ((size_t)b * 8 + (tid_u >> 6)) * 1024 + h * 64 + (tid_u & 63)); km[tid_u] = (kp[0] + kp[512]) * (1.0f / 256.0f); } }
        const unsigned koff = (unsigned)(((rowbase + lane) * 512 + h * 64 + wid * 8) * 2);
        unsigned voff; { const int vr = 8 * wid + (lane >> 3), sl = lane & 7; const int ch = ((((sl >> 2) ^ ((vr >> 1) & 1)) << 2) | (sl & 3)); voff = (unsigned)((((size_t)MTOK + rowbase + vr) * 512 + h * 64 + ch * 8) * 2); }
        const unsigned lds0 = (unsigned)(uintptr_t)L;
#define MOBA_ISSUE(t_, bufi) do { moba_glds(koff, (const void*)((const char*)F.KN + (size_t)(t_) * 65536), (unsigned)__builtin_amdgcn_readfirstlane((int)(lds0 + L_K + (bufi) * 8192 + wid * 1024))); \
            moba_glds(voff, (const void*)((const char*)F.KN + (size_t)(t_) * 65536), (unsigned)__builtin_amdgcn_readfirstlane((int)(lds0 + L_V + (bufi) * 8192 + wid * 1024))); } while (0)
        const int NT = 4 * (qb + 1);
        int t0 = 0; { const float dstar = (151.0f + 2.0f * smax2) / sl2; const float x = ((float)(q0 - 63) - dstar) * (1.0f / 64.0f); if (x > 0.f) t0 = ((int)x) & ~1; if (t0 > NT - 4) t0 = NT - 4; t0 = __builtin_amdgcn_readfirstlane(t0); }
        unsigned nticket = 0u; if (tid == 0) nticket = __hip_atomic_fetch_add(qctr, 1u, RLX_AGENT);
        MOBA_ISSUE(t0, 0); MOBA_ISSUE(t0 + 1, 1); MOBA_ISSUE(t0 + 2, 2);
        __syncthreads();
        unsigned selmask = 0;
        { float gt[7]; float qf32[32];
#pragma unroll
            for (int d0 = 0; d0 < 4; ++d0)
#pragma unroll
                for (int e = 0; e < 8; ++e) qf32[d0 * 8 + e] = bf2f((unsigned short)qr[d0][e]);
#pragma unroll
            for (int i = 0; i < 32; ++i) asm volatile("" : "+v"(qf32[i]));
#pragma unroll
            for (int j = 0; j < 7; ++j) { float s = 0.f;
                if (j < qb) {
#pragma unroll
                    for (int d0 = 0; d0 < 4; ++d0)
#pragma unroll
                        for (int e = 0; e < 8; ++e) s += qf32[d0 * 8 + e] * km[j * 64 + d0 * 16 + hi * 8 + e];
                    auto rr = __builtin_amdgcn_permlane32_swap(__float_as_uint(s), __float_as_uint(s), false, false);
                    s = __uint_as_float(rr[0]) + __uint_as_float(rr[1]); }
                gt[j] = s; }
#pragma unroll
            for (int j = 0; j < 7; ++j) { int rank = 0;
#pragma unroll
                for (int i = 0; i < 7; ++i) if (i != j && i < qb) rank += (gt[i] > gt[j] || (gt[i] == gt[j] && i < j)) ? 1 : 0;
                if (j < qb && rank < 3) selmask |= 1u << j; }
            selmask |= 1u << qb; }
        if (!FIXREF) {
#pragma unroll
            for (int d0 = 0; d0 < 4; ++d0) *(LAS bf16x8*)(qlds + d0 * 1024) = qr[d0]; }
        float mhat = mhat0, l_reg = 0.f; f32x16 o[2]; o[0] = f32x16{}; o[1] = f32x16{};
        const int kbase = L_K + hi * 1024 + r32 * 16;
        const int g16 = lane >> 4, i16 = lane & 15, tq4 = i16 >> 2, tp4 = i16 & 3;
        const int vrow0 = 4 * hi + tq4;
        if (tid == 0) tick[(ui + 1) & 1] = nticket;
        asm volatile("s_waitcnt vmcnt(2)" ::: "memory");
        __syncthreads();
#define MOBA_KLOAD(KOFF) do { if (!FIXREF) { _Pragma("unroll") for (int d0 = 0; d0 < 4; ++d0) qf_[d0] = *(const LAS bf16x8*)(qlds + d0 * 1024); } \
            _Pragma("unroll") for (int d0 = 0; d0 < 4; ++d0) { \
            kfr[2 * d0] = *(const LAS bf16x8*)(L + (KOFF) + kbase + d0 * 2048); kfr[2 * d0 + 1] = *(const LAS bf16x8*)(L + (KOFF) + kbase + d0 * 2048 + 512); } } while (0)
#define MOBA_KLOADH(KOFF, H) do { _Pragma("unroll") for (int d0 = 2 * (H); d0 < 2 * (H) + 2; ++d0) { \
            kfr[2 * d0] = *(const LAS bf16x8*)(L + (KOFF) + kbase + d0 * 2048); kfr[2 * d0 + 1] = *(const LAS bf16x8*)(L + (KOFF) + kbase + d0 * 2048 + 512); } } while (0)
#define MOBA_VLOAD(VOFF) do { _Pragma("unroll") for (int dblk = 0; dblk < 2; ++dblk) _Pragma("unroll") for (int ks = 0; ks < 4; ++ks) { \
            const int rlo = 16 * ks + vrow0, rhi = rlo + 8; \
            vlo[dblk * 4 + ks] = vtr(L + L_V + (VOFF) + rlo * 128 + ((dblk ^ ((rlo >> 1) & 1)) * 64) + (16 * (g16 & 1) + 4 * tp4) * 2); \
            vhi[dblk * 4 + ks] = vtr(L + L_V + (VOFF) + rhi * 128 + ((dblk ^ ((rhi >> 1) & 1)) * 64) + (16 * (g16 & 1) + 4 * tp4) * 2); } } while (0)
#define MOBA_VLOADH(VOFF, DB) do { _Pragma("unroll") for (int ks = 0; ks < 4; ++ks) { \
            const int rlo = 16 * ks + vrow0, rhi = rlo + 8; \
            vlo[(DB) * 4 + ks] = vtr(L + L_V + (VOFF) + rlo * 128 + (((DB) ^ ((rlo >> 1) & 1)) * 64) + (16 * (g16 & 1) + 4 * tp4) * 2); \
            vhi[(DB) * 4 + ks] = vtr(L + L_V + (VOFF) + rhi * 128 + (((DB) ^ ((rhi >> 1) & 1)) * 64) + (16 * (g16 & 1) + 4 * tp4) * 2); } } while (0)
#define MOBA_QK(CANSKIP, TT, P0, P1) do { \
            const int blk_ = (TT) >> 2; \
            if (!((CANSKIP) && (blk_ == qb) && (64 * ((TT) & 3) > 32 * wid + 31))) { \
                const bool sel_ = ((selmask >> blk_) & 1u); \
                float sc0_ = sel_ ? (-mhat - sl2 * (float)(tq - 64 * (TT) - 4 * hi)) : NEG_BIG; asm volatile("" : "+v"(sc0_)); \
_Pragma("unroll") \
                for (int r = 0; r < 16; ++r) { P0[r] = __builtin_fmaf(sl2, (float)((r & 3) + 8 * (r >> 2)), sc0_); P1[r] = __builtin_fmaf(sl2, (float)(32 + (r & 3) + 8 * (r >> 2)), sc0_); } \
_Pragma("unroll") \
                for (int d0 = 0; d0 < 4; ++d0) { \
                    P0 = __builtin_amdgcn_mfma_f32_32x32x16_bf16(kfr[2 * d0], FIXREF ? qr[d0] : qf_[d0], P0, 0, 0, 0); \
                    P1 = __builtin_amdgcn_mfma_f32_32x32x16_bf16(kfr[2 * d0 + 1], FIXREF ? qr[d0] : qf_[d0], P1, 0, 0, 0); } \
            } } while (0)
#define MOBA_SM(OWNP, TT, P0, P1, HAVE_NEXT, N0, N1) do { \
            const bool own = (OWNP); const int jb = (TT) & 3; \
            if (!(own && (64 * jb > 32 * wid + 31))) { \
                if (own && (64 * jb + 63 > 32 * wid)) { \
_Pragma("unroll") \
                    for (int r = 0; r < 16; ++r) { const int kvl = 64 * jb + crow(r, hi); if (kvl > qrel) P0[r] = NEG_BIG; if (kvl + 32 > qrel) P1[r] = NEG_BIG; } } \
                if (!FIXREF) { \
                float rm = max3f(P0[0], P1[0], P0[1]), rm2 = max3f(P1[1], P0[2], P1[2]); \
_Pragma("unroll") \
                for (int r = 3; r < 15; r += 2) { rm = max3f(rm, P0[r], P1[r]); rm2 = max3f(rm2, P0[r + 1], P1[r + 1]); } \
                rm = max3f(rm, rm2, fmaxf(P0[15], P1[15])); \
                { auto rr = __builtin_amdgcn_permlane32_swap(__float_as_uint(rm), __float_as_uint(rm), false, false); rm = fmaxf(__uint_as_float(rr[0]), __uint_as_float(rr[1])); } \
                if (__any(rm > THR)) { \
                    const float dl = fmaxf(rm, 0.f); mhat += dl; \
_Pragma("unroll") \
                    for (int r = 0; r < 16; ++r) { P0[r] -= dl; P1[r] -= dl; } \
                    if (HAVE_NEXT) { \
_Pragma("unroll") \
                        for (int r = 0; r < 16; ++r) { N0[r] -= dl; N1[r] -= dl; } } \
                    const float f = __builtin_amdgcn_exp2f(-dl); l_reg *= f; \
                    if (hi == 0) wsf[r32] = f; \
_Pragma("unroll") \
                    for (int r = 0; r < 16; ++r) { const float fr = wsf[crow(r, hi)]; o[0][r] *= fr; o[1][r] *= fr; } } \
                } \
                float sacc = 0.f, sacc2 = 0.f; \
_Pragma("unroll") \
                for (int r = 0; r < 16; ++r) { P0[r] = __builtin_amdgcn_exp2f(P0[r]); P1[r] = __builtin_amdgcn_exp2f(P1[r]); sacc += P0[r]; sacc2 += P1[r]; } \
                l_reg += sacc + sacc2; \
                { v4u w; \
_Pragma("unroll") \
                    for (int ks = 0; ks < 4; ++ks) { \
_Pragma("unroll") \
                        for (int e = 0; e < 4; ++e) { const int rb = (ks & 1) * 8 + 2 * e; w[e] = (ks < 2) ? cvtpk(P0[rb], P0[rb + 1]) : cvtpk(P1[rb], P1[rb + 1]); } \
                        pa[ks] = __builtin_bit_cast(bf16x8, w); } } \
            } } while (0)
#define MOBA_PV(OWNP, TT) do { \
            if (!((OWNP) && (64 * ((TT) & 3) > 32 * wid + 31))) { \
_Pragma("unroll") \
                for (int dblk = 0; dblk < 2; ++dblk) \
_Pragma("unroll") \
                    for (int ks = 0; ks < 4; ++ks) { \
                        const s16x4 lo = vlo[dblk * 4 + ks], hh = vhi[dblk * 4 + ks]; \
                        const bf16x8 vf = __builtin_shufflevector(lo, hh, 0, 1, 2, 3, 4, 5, 6, 7); \
                        o[dblk] = __builtin_amdgcn_mfma_f32_32x32x16_bf16(pa[ks], vf, o[dblk], 0, 0, 0); } \
            } } while (0)
        f32x16 pA0, pA1, pB0, pB1; bf16x8 kfr[8], qf_[4], pa[4]; s16x4 vlo[8], vhi[8];
        MOBA_KLOAD(0); MOBA_QK(true, t0, pA0, pA1);
        int c0o = 0;
#define MOBA_ILV() do { __builtin_amdgcn_sched_group_barrier(0x002, 16, 0); \
_Pragma("unroll") \
            for (int g_ = 0; g_ < 8; ++g_) { __builtin_amdgcn_sched_group_barrier(0x008, 1, 0); __builtin_amdgcn_sched_group_barrier(0x002, 12, 0); } } while (0)
#define MOBA_STEP2(OWNP) do { \
            const int c1o = (c0o + 1) & 3, c2o = (c0o + 2) & 3, c3o = (c0o + 3) & 3; \
            if (!(OWNP) || t + 3 < NT) MOBA_ISSUE(t + 3, c3o); \
            if (FIXREF) { MOBA_KLOAD(c1o * 8192); __builtin_amdgcn_sched_barrier(0); \
                MOBA_QK(OWNP, t + 1, pB0, pB1); MOBA_SM(OWNP, t, pA0, pA1, false, pB0, pB1); if (!(OWNP)) MOBA_ILV(); __builtin_amdgcn_sched_barrier(0); \
                MOBA_VLOAD(c0o * 8192); __builtin_amdgcn_sched_barrier(0); MOBA_PV(OWNP, t); } \
            else { MOBA_KLOAD(c1o * 8192); __builtin_amdgcn_sched_barrier(0); MOBA_QK(true, t + 1, pB0, pB1); __builtin_amdgcn_sched_barrier(0); \
                MOBA_VLOAD(c0o * 8192); __builtin_amdgcn_sched_barrier(0); MOBA_SM(OWNP, t, pA0, pA1, true, pB0, pB1); MOBA_PV(OWNP, t); } \
            if (!(OWNP) || t + 3 < NT) asm volatile("s_waitcnt vmcnt(2)" ::: "memory"); else asm volatile("s_waitcnt vmcnt(0)" ::: "memory"); \
            __syncthreads(); \
            if (!(OWNP) || t + 4 < NT) MOBA_ISSUE(t + 4, c0o); \
            if (FIXREF) { if (!(OWNP) || t + 2 < NT) MOBA_KLOAD(c2o * 8192); __builtin_amdgcn_sched_barrier(0); \
                if (!(OWNP) || t + 2 < NT) MOBA_QK(OWNP, t + 2, pA0, pA1); MOBA_SM(OWNP, t + 1, pB0, pB1, false, pA0, pA1); if (!(OWNP)) MOBA_ILV(); __builtin_amdgcn_sched_barrier(0); \
                MOBA_VLOAD(c1o * 8192); __builtin_amdgcn_sched_barrier(0); MOBA_PV(OWNP, t + 1); } \
            else { if (t + 2 < NT) { MOBA_KLOAD(c2o * 8192); __builtin_amdgcn_sched_barrier(0); MOBA_QK(true, t + 2, pA0, pA1); __builtin_amdgcn_sched_barrier(0); } \
                MOBA_VLOAD(c1o * 8192); __builtin_amdgcn_sched_barrier(0); MOBA_SM(OWNP, t + 1, pB0, pB1, (t + 2 < NT), pA0, pA1); MOBA_PV(OWNP, t + 1); } \
            if (!(OWNP) || t + 4 < NT) asm volatile("s_waitcnt vmcnt(2)" ::: "memory"); else asm volatile("s_waitcnt vmcnt(0)" ::: "memory"); \
            __syncthreads(); \
            c0o = c2o; } while (0)
        int t = t0;
        for (; t < NT - 4; t += 2) MOBA_STEP2(false);
        for (; t < NT; t += 2) MOBA_STEP2(true);
#undef MOBA_STEP2
#undef MOBA_ISSUE
#undef MOBA_KLOAD
#undef MOBA_KLOADH
#undef MOBA_VLOAD
#undef MOBA_VLOADH
#undef MOBA_QK
#undef MOBA_SM
#undef MOBA_PV
        int lane_e = lane; asm volatile("" : "+v"(lane_e));
        const int r32e = lane_e & 31, hie = lane_e >> 5;
        v4u gwv[4];
#pragma unroll
        for (int i = 0; i < 4; ++i) gwv[i] = *(const GAS v4u*)(F.GA + (rowbase + q0 + wid * 32 + i * 8 + (lane_e >> 3)) * 512 + h * 64 + (lane_e & 7) * 8);
        { auto rr = __builtin_amdgcn_permlane32_swap(__float_as_uint(l_reg), __float_as_uint(l_reg), false, false); l_reg = __uint_as_float(rr[0]) + __uint_as_float(rr[1]); }
        if (hie == 0) wsf[r32e] = 1.0f / l_reg;
#pragma unroll
        for (int r = 0; r < 16; ++r) { const float rl = wsf[crow(r, hie)]; ost[crow(r, hie) * 64 + r32e] = o[0][r] * rl; ost[crow(r, hie) * 64 + 32 + r32e] = o[1][r] * rl; }
#pragma unroll
        for (int i = 0; i < 4; ++i) { const int row = i * 8 + (lane_e >> 3), ch = lane_e & 7;
            const f32x4 a = *(const LAS f32x4*)(ost + row * 64 + ch * 8), c2 = *(const LAS f32x4*)(ost + row * 64 + ch * 8 + 4);
            const size_t grow = rowbase + q0 + wid * 32 + row;
            const v4u gw = gwv[i];
            v4u ow; ow.x = pk2(a[0] * bflo(gw.x), a[1] * bfhi(gw.x)); ow.y = pk2(a[2] * bflo(gw.y), a[3] * bfhi(gw.y));
            ow.z = pk2(c2[0] * bflo(gw.z), c2[1] * bfhi(gw.z)); ow.w = pk2(c2[2] * bflo(gw.w), c2[3] * bfhi(gw.w));
            *(GAS v4u*)(F.MIXED + grow * DM + 512 + h * 64 + ch * 8) = ow; }
    }
    __syncthreads();
}


__device__ __forceinline__ void moba_mfma_phase(Frame& F, int l) {
    float gq = 0.f, gk = 0.f;
    for (int i = 0; i < 64; ++i) { gq = fmaxf(gq, fabsf(F.q_norm_w[l * 64 + i])); gk = fmaxf(gk, fabsf(F.k_norm_w[l * 64 + i])); }
    if (2.0f * (8.0f * gq * gk * LOG2E * 1.02f) + 1.0f <= 100.0f) moba_mfma_body<true>(F, l); else moba_mfma_body<false>(F, l);
}

namespace hg {
typedef short bf16x8 __attribute__((ext_vector_type(8)));
typedef short s16x4 __attribute__((ext_vector_type(4)));
typedef float f32x4 __attribute__((ext_vector_type(4)));
typedef unsigned u32x2 __attribute__((ext_vector_type(2)));
constexpr int SLOT = 33792, NSLOT = 4;
constexpr int L_SC = NSLOT * SLOT, L_NRM = L_SC + 4096;
constexpr int NSTEP = SEQ / 32;
__device__ __forceinline__ int fsw(int t) { return ((t & 7) << 2) | (((t >> 3) & 1) << 1); }
__device__ __forceinline__ int unit_off(int tok, int cg) { return 8 * (32 * tok + (cg ^ fsw(tok))); }
__device__ __forceinline__ s16x4 rd64(const LAS unsigned char* p) { return *(const LAS s16x4*)p; }
__device__ __forceinline__ s16x4 vtr(const LAS unsigned char* p) { return __builtin_bit_cast(s16x4, __builtin_amdgcn_ds_read_tr16_b64_v4i16((LAS s16x4*)p)); }
__device__ __forceinline__ bf16x8 cat(s16x4 a, s16x4 b) { return __builtin_shufflevector(a, b, 0, 1, 2, 3, 4, 5, 6, 7); }
__device__ __forceinline__ s16x4 pack4(f32x4 v) { u32x2 w; w.x = moba::cvtpk(v[0], v[1]); w.y = moba::cvtpk(v[2], v[3]); return __builtin_bit_cast(s16x4, w); }
__device__ __forceinline__ void glds16(const GAS void* gsrc, unsigned lds_dst) { unsigned keep;
    asm volatile("s_mov_b32 %0, m0\n\ts_mov_b32 m0, %2\n\ts_nop 0\n\tglobal_load_lds_dwordx4 %1, off\n\ts_mov_b32 m0, %0" : "=&s"(keep) : "v"(gsrc), "s"(lds_dst) : "memory"); }
__device__ __forceinline__ void glds16s(unsigned voff, const void* sbase, unsigned lds_dst) { unsigned keep;
    asm volatile("s_mov_b32 %0, m0\n\ts_mov_b32 m0, %3\n\ts_nop 0\n\tglobal_load_lds_dwordx4 %1, %2\n\ts_mov_b32 m0, %0" : "=&s"(keep) : "v"(voff), "s"(sbase), "s"(lds_dst) : "memory"); }
#define HG_MFMA(a, b, c) __builtin_amdgcn_mfma_f32_16x16x32_bf16((a), (b), (c), 0, 0, 0)
}

__device__ __forceinline__ void hgrn_mfma_phase(Frame& F, int l) {
    using namespace hg;
    PHASE_IDS();
    const int w = wave, c16 = lane & 15, g = lane >> 4;
    LAS unsigned char* L = F.lds + RING_OFF;
    const s16x4 z4 = (s16x4){0, 0, 0, 0};
    for (int it = (int)blockIdx.x; it < 64; it += F.G) {
        const int b = it >> 2, h = it & 3; const size_t rowbase = (size_t)b * SEQ;
        const int da = w >> 1;
        unsigned dsrc[4];
#pragma unroll
        for (int i = 0; i < 4; ++i) { const int t = 16 * (w & 1) + 4 * i + (lane >> 4); const int sc = (lane & 15) ^ (fsw(t) >> 1);
            dsrc[i] = (unsigned)((((size_t)da * MTOK + rowbase + t) * 512 + h * 128 + 8 * sc) * 2); }
        const unsigned ddec = (unsigned)((((size_t)b * NSTEP) * 512 + h * 128 + 4 * lane) * 4);
        const int ddst = da * 8192 + (w & 1) * 4096;
        const unsigned lds0 = (unsigned)(uintptr_t)(F.lds + RING_OFF);
#define HG_ISSUE(step) do { const unsigned so_ = lds0 + (unsigned)(((step) & 3) * SLOT); \
            _Pragma("unroll") for (int i = 0; i < 4; ++i) \
                glds16s(dsrc[i], (const void*)((const char*)F.QI + (size_t)(step) * (32 * 512 * 2)), (unsigned)__builtin_amdgcn_readfirstlane((int)(so_ + ddst + i * 1024))); \
            if (w == 0) glds16s(ddec, (const void*)((const char*)F.DEC + (size_t)(step) * 2048), (unsigned)__builtin_amdgcn_readfirstlane((int)(so_ + 32768))); } while (0)
        f32x4 S[8]; bf16x8 Sb[4];
#pragma unroll
        for (int tk = 0; tk < 8; ++tk) S[tk] = (f32x4){0.f, 0.f, 0.f, 0.f};
#pragma unroll
        for (int ks = 0; ks < 4; ++ks) Sb[ks] = (bf16x8){0, 0, 0, 0, 0, 0, 0, 0};
        f32x4 oprev[2]; oprev[0] = (f32x4){0.f, 0.f, 0.f, 0.f}; oprev[1] = oprev[0];
        u32x2 gprev[2]; gprev[0] = (u32x2){0u, 0u}; gprev[1] = gprev[0];
        float hw[4];
#pragma unroll
        for (int r = 0; r < 4; ++r) hw[r] = F.hg_norm_w[l * 128 + 16 * w + 4 * g + r];
        asm volatile("" : "+v"(hw[0]), "+v"(hw[1]), "+v"(hw[2]), "+v"(hw[3]));
        LAS float* nrm = (LAS float*)(L + L_NRM);
        LAS unsigned char* SC = L + L_SC;
        HG_ISSUE(0); HG_ISSUE(1); HG_ISSUE(2);
        asm volatile("s_waitcnt vmcnt(8)\n\ts_barrier" ::: "memory");
        const int trq = c16 >> 2, trp = c16 & 3;
        int ro0 = 256 * c16 + 16 * (g ^ (fsw(c16) >> 1)), ko0 = 256 * (4 * g + trq) + 16 * (trp ^ (fsw(4 * g + trq) >> 1));
#define RO(ks) (ro0 ^ (64 * (ks)))
#define KO(tk) (ko0 ^ (64 * ((tk) >> 1) + 8 * ((tk) & 1)))
        const int io_ = unit_off(4 * g + trq, 4 * w + trp), go_ = unit_off(c16, 4 * w + g);
        bf16x8 qf[2][4];
#define HG_LOADQ(slotbase) do { _Pragma("unroll") for (int tt = 0; tt < 2; ++tt) _Pragma("unroll") for (int ks = 0; ks < 4; ++ks) \
            qf[tt][ks] = *(const LAS bf16x8*)((slotbase) + RO(ks) + 4096 * tt); } while (0)
#define HG_FINAL(step, P) do { _Pragma("unroll") for (int tt = 0; tt < 2; ++tt) { \
            const float ssum = ((P[tt][0] + P[tt][1]) + (P[tt][2] + P[tt][3])) + ((P[tt][4] + P[tt][5]) + (P[tt][6] + P[tt][7])); \
            const float rstd = __builtin_amdgcn_rsqf(ssum * (1.0f / 128.0f) + NORM_EPS); \
            u32x2 wv; wv.x = moba::cvtpk(oprev[tt][0] * rstd * hw[0] * bflo(gprev[tt].x), oprev[tt][1] * rstd * hw[1] * bfhi(gprev[tt].x)); \
            wv.y = moba::cvtpk(oprev[tt][2] * rstd * hw[2] * bflo(gprev[tt].y), oprev[tt][3] * rstd * hw[3] * bfhi(gprev[tt].y)); \
            *(GAS u32x2*)(F.MIXED + (rowbase + (size_t)(step) * 32 + 16 * tt + c16) * DM + h * 128 + 16 * w + 4 * g) = wv; } } while (0)
        HG_LOADQ(L);
        for (int n = 0; n < NSTEP; ++n) {
            asm volatile("" : "+v"(ro0), "+v"(ko0));
            if (n + 3 < NSTEP) HG_ISSUE(n + 3);
            const LAS unsigned char* Qs = L + (n & 3) * SLOT; const LAS unsigned char* Ks = Qs + 8192; const LAS unsigned char* Is = Qs + 16384; const LAS unsigned char* Gs = Qs + 24576;
            const LAS float* Ds = (const LAS float*)(Qs + 32768);
            LAS unsigned char* SCn = SC + (n & 1) * 1536;
            bf16x8 kf[4];
            if (w < 3) { const int st = (w == 2) ? 1 : 0;
#pragma unroll
                for (int ks = 0; ks < 4; ++ks) kf[ks] = *(const LAS bf16x8*)(Ks + RO(ks) + 4096 * st); }
            u32x2 gcur[2];
#pragma unroll
            for (int tt = 0; tt < 2; ++tt) gcur[tt] = *(const LAS u32x2*)(Gs + go_ + 4096 * tt);
            s16x4 itr[2];
#pragma unroll
            for (int st = 0; st < 2; ++st) itr[st] = vtr(Is + io_ + 4096 * st);
            const bf16x8 i01 = cat(itr[0], itr[1]);
            bf16x8 k01[4]; f32x4 dv4[4];
#pragma unroll
            for (int tk = 0; tk < 4; ++tk) { k01[tk] = cat(vtr(Ks + KO(tk)), vtr(Ks + KO(tk) + 4096)); dv4[tk] = *(const LAS f32x4*)(Ds + 16 * tk + 4 * g); }
            f32x4 o[2];
#pragma unroll
            for (int tt = 0; tt < 2; ++tt) { f32x4 a = (f32x4){0.f, 0.f, 0.f, 0.f};
#pragma unroll
                for (int ks = 0; ks < 4; ++ks) a = HG_MFMA(Sb[ks], qf[tt][ks], a);
                o[tt] = a; }
            if (w < 3) { f32x4 sc = (f32x4){0.f, 0.f, 0.f, 0.f};
                if (w == 0) {
#pragma unroll
                    for (int ks = 0; ks < 4; ++ks) sc = HG_MFMA(kf[ks], qf[0][ks], sc);
                } else {
#pragma unroll
                    for (int ks = 0; ks < 4; ++ks) sc = HG_MFMA(kf[ks], qf[1][ks], sc); }
                if (w != 1) {
#pragma unroll
                    for (int r = 0; r < 4; ++r) if (4 * g + r > c16) sc[r] = 0.f; }
                *(LAS s16x4*)(SCn + w * 512 + lane * 8) = pack4(sc); }
#pragma unroll
            for (int tk = 0; tk < 4; ++tk) S[tk] = HG_MFMA(k01[tk], i01, S[tk]);
            asm volatile("" ::: "memory");
            { bf16x8 k2[4]; f32x4 d2[4];
#pragma unroll
                for (int tk = 0; tk < 4; ++tk) { k2[tk] = cat(vtr(Ks + KO(tk + 4)), vtr(Ks + KO(tk + 4) + 4096)); d2[tk] = *(const LAS f32x4*)(Ds + 16 * (tk + 4) + 4 * g); }
#pragma unroll
                for (int tk = 0; tk < 4; ++tk) S[tk] = S[tk] * dv4[tk];
#pragma unroll
                for (int ks = 0; ks < 2; ++ks) Sb[ks] = cat(pack4(S[2 * ks]), pack4(S[2 * ks + 1]));
#pragma unroll
                for (int tk = 0; tk < 4; ++tk) S[tk + 4] = HG_MFMA(k2[tk], i01, S[tk + 4]);
#pragma unroll
                for (int tk = 0; tk < 4; ++tk) S[tk + 4] = S[tk + 4] * d2[tk];
#pragma unroll
                for (int ks = 2; ks < 4; ++ks) Sb[ks] = cat(pack4(S[2 * ks]), pack4(S[2 * ks + 1])); }
            if (n >= NSTEP - 3) asm volatile("s_waitcnt vmcnt(0) lgkmcnt(0)\n\ts_barrier" ::: "memory");
            else if (n <= 1) asm volatile("s_waitcnt vmcnt(8) lgkmcnt(0)\n\ts_barrier" ::: "memory");
            else if (n == 2) asm volatile("s_waitcnt vmcnt(10) lgkmcnt(0)\n\ts_barrier" ::: "memory");
            else asm volatile("s_waitcnt vmcnt(12) lgkmcnt(0)\n\ts_barrier" ::: "memory");
            const s16x4 sc00 = rd64(SCn + lane * 8), sc01 = rd64(SCn + 512 + lane * 8), sc11 = rd64(SCn + 1024 + lane * 8);
            float pn[2][8];
            if (n > 0) {
#pragma unroll
                for (int tt = 0; tt < 2; ++tt)
#pragma unroll
                    for (int ww = 0; ww < 8; ++ww) pn[tt][ww] = nrm[((n - 1) & 1) * 256 + ww * 32 + 16 * tt + c16]; }
            if (n + 1 < NSTEP) HG_LOADQ(L + ((n + 1) & 3) * SLOT);
            o[0] = HG_MFMA(cat(itr[0], z4), cat(sc00, z4), o[0]);
            o[1] = HG_MFMA(i01, cat(sc01, sc11), o[1]);
            { float ss0 = (o[0][0] * o[0][0] + o[0][1] * o[0][1]) + (o[0][2] * o[0][2] + o[0][3] * o[0][3]);
              float ss1 = (o[1][0] * o[1][0] + o[1][1] * o[1][1]) + (o[1][2] * o[1][2] + o[1][3] * o[1][3]);
              { auto r0 = __builtin_amdgcn_permlane16_swap(__float_as_uint(ss0), __float_as_uint(ss0), false, false); auto r1 = __builtin_amdgcn_permlane16_swap(__float_as_uint(ss1), __float_as_uint(ss1), false, false);
                ss0 = __uint_as_float(r0[0]) + __uint_as_float(r0[1]); ss1 = __uint_as_float(r1[0]) + __uint_as_float(r1[1]); }
              { auto r0 = __builtin_amdgcn_permlane32_swap(__float_as_uint(ss0), __float_as_uint(ss0), false, false); auto r1 = __builtin_amdgcn_permlane32_swap(__float_as_uint(ss1), __float_as_uint(ss1), false, false);
                ss0 = __uint_as_float(r0[0]) + __uint_as_float(r0[1]); ss1 = __uint_as_float(r1[0]) + __uint_as_float(r1[1]); }
              if (g == 0) { nrm[(n & 1) * 256 + w * 32 + c16] = ss0; nrm[(n & 1) * 256 + w * 32 + 16 + c16] = ss1; } }
            if (n > 0) HG_FINAL(n - 1, pn);
            oprev[0] = o[0]; oprev[1] = o[1]; gprev[0] = gcur[0]; gprev[1] = gcur[1];
        }
        asm volatile("s_waitcnt vmcnt(0) lgkmcnt(0)\n\ts_barrier" ::: "memory");
        { float pn[2][8];
#pragma unroll
            for (int tt = 0; tt < 2; ++tt)
#pragma unroll
                for (int ww = 0; ww < 8; ++ww) pn[tt][ww] = nrm[((NSTEP - 1) & 1) * 256 + ww * 32 + 16 * tt + c16];
            HG_FINAL(NSTEP - 1, pn); }
        asm volatile("s_waitcnt vmcnt(0) lgkmcnt(0)\n\ts_barrier" ::: "memory");
#undef RO
#undef KO
#undef HG_LOADQ
#undef HG_FINAL
#undef HG_ISSUE
    }
}

struct Args { const float* in[8]; float* out; unsigned char* ws; int ph_lo, ph_hi, li, pad; };
__global__ void __launch_bounds__(NWAVES * 64, 2) fwd(Args args) {
    extern __shared__ __attribute__((aligned(16))) unsigned char lds[];
    Frame F;
    F.lds = (LAS unsigned char*)lds;
    F.MISC = (volatile LAS unsigned*)(F.lds + MISC_OFF);
    F.G = gridDim.x; { const int bx = blockIdx.x; F.vcu = (F.G % 8 == 0) ? (bx % 8) * (F.G / 8) + bx / 8 : bx; }
    unsigned char* ws = args.ws;
    F.ctl = (gu32*)(ws + WS_CTL);
    F.x = args.in[0]; F.norm_w = args.in[1]; F.w_in = args.in[2]; F.lb_logits = args.in[3]; F.hg_norm_w = args.in[4]; F.q_norm_w = args.in[5]; F.k_norm_w = args.in[6]; F.w_out = args.in[7];
    F.out = args.out;
    F.WIN = (bf16*)(ws + WS_WIN); F.WOUT = (bf16*)(ws + WS_WOUT); F.XB = (bf16*)(ws + WS_XB); F.MIXED = (bf16*)(ws + WS_MIXED);
    F.QI = (bf16*)(ws + WS_ARR); F.KT = (bf16*)(ws + WS_ARR + ARR_BYTES); F.HI = (bf16*)(ws + WS_ARR + 2 * ARR_BYTES); F.GH = (bf16*)(ws + WS_ARR + 3 * ARR_BYTES);
    F.QN = (bf16*)(ws + WS_ARR + 4 * ARR_BYTES); F.KN = (bf16*)(ws + WS_ARR + 5 * ARR_BYTES); F.V = (bf16*)(ws + WS_ARR + 6 * ARR_BYTES); F.GA = (bf16*)(ws + WS_ARR + 7 * ARR_BYTES);
    F.LB = (float*)(ws + WS_LB); F.KPART = (float*)(ws + WS_KPART); F.ROWSS = (float*)(ws + WS_ROWSS); F.DEC = (float*)(ws + WS_DEC);
    F.wave0 = __builtin_amdgcn_readfirstlane((int)threadIdx.x >> 6);
    for (int u = F.wave0 * 64 + lane_id_asm(); u < (LDS_BYTES - LDSCTL_OFF) / 4; u += NWAVES * 64) ((LAS unsigned*)(F.lds + LDSCTL_OFF))[u] = 0u;
    __syncthreads();
    XcdBarrier bar; bar.bar = (unsigned*)(F.ctl + CW_BAR); bar.x = 0; bar.st = nullptr; bar.wave0 = F.wave0;
    if (N_LAUNCHES == 1) bar = xcd_barrier_post((unsigned*)(F.ctl + CW_BAR), F.MISC + 8, F.wave0);
#define GRID_BAR() do { if (N_LAUNCHES == 1) xcd_barrier(bar); } while (0)
    const int lo = (N_LAUNCHES == 1) ? 0 : args.ph_lo, hi = (N_LAUNCHES == 1) ? N_PHASES : args.ph_hi;
#define IN(k) (lo <= (k) && (k) < hi)
#define BOTH(k) (IN(k) && IN((k) + 1))

    if (IN(0)) { p0_prologue(F); if (BOTH(0)) GRID_BAR(); }
    for (int l = 0; l < DEPTH; ++l) {
        const int pb = 1 + 3 * l;
        if (IN(pb)) {
            pg8::Gemm g{F.XB + (size_t)l * MTOK * DM, F.WIN + (size_t)l * NIN * DM, MTOK, NIN, DM}; pg8::StaticOrder S; S.init(MTOK, NIN, F.G, (int)blockIdx.x, (int)(blockIdx.x & 7));
            pg8::EpiFused E{F.QI, F.DEC, F.KPART, F.ROWSS + (size_t)l * MTOK * 16, F.LB + l * 512, F.q_norm_w + l * 64, F.k_norm_w + l * 64, nullptr, 0};
            {
                pg8::Unit u0{0, 0}, u4{0, 0}, ut; bool two = S.next(0, u0) && S.next(4, u4);
                for (int i = 0; two && S.next(i, ut); ++i) two = (ut.pm == u0.pm || ut.pm == u4.pm);
                if (two) { LAS float* rt = (LAS float*)(F.lds + EXTRA_OFF); int t_ = F.wave0 * 64 + lane_id_asm(); asm volatile("" : "+v"(t_));
                    rt[t_] = pg8::EpiFused::rstd_global(E.rowss, ((t_ >> 8) ? u4.pm : u0.pm) * 256 + (t_ & 255));
                    E.rtab = rt; E.pm0 = u0.pm; __syncthreads(); } }
            for (int rp = 0; rp < REP_PROJ; ++rp) { if (rp) GRID_BAR(); pg8::gemm_phase<pg8::EpiFused, pg8::StaticOrder, true, true>(F.lds + RING_OFF, g, S, E, F.wave0); }
            if (BOTH(pb)) GRID_BAR();
        }
        if (IN(pb + 1)) {
            for (int rp = 0; rp < REP_HGRN; ++rp) { if (rp) GRID_BAR(); hgrn_mfma_phase(F, l); }
            for (int rp = 0; rp < REP_MOBA; ++rp) { if (rp) { GRID_BAR(); if (blockIdx.x == 0 && F.wave0 == 0 && lane_id_asm() == 0) __hip_atomic_store(F.ctl + CW_QUEUE + 64 * l, 0u, RLX_AGENT); GRID_BAR(); } moba_mfma_phase(F, l); }
            if (BOTH(pb + 1)) GRID_BAR(); }
        if (IN(pb + 2)) {
            pg8::Gemm g{F.MIXED, F.WOUT + (size_t)l * DM * DM, MTOK, DM, DM}; pg8::StaticOrder S; S.init(MTOK, DM, F.G, (int)blockIdx.x);
            pg8::EpiOut E{l == 0 ? F.XB : F.XB + (size_t)MTOK * DM, l == 0 ? nullptr : F.out, l == 0 ? F.XB + (size_t)MTOK * DM : nullptr, l == 0 ? F.ROWSS + (size_t)MTOK * 16 : nullptr};
            for (int rp = 0; rp < REP_OUT; ++rp) { if (rp) GRID_BAR(); pg8::gemm_phase<pg8::EpiOut, pg8::StaticOrder, true, true>(F.lds + RING_OFF, g, S, E, F.wave0); }
            if (pb + 2 < N_PHASES - 1 && BOTH(pb + 2)) GRID_BAR();
        }
    }
#undef IN
#undef BOTH
}

extern "C" void kernel_launch(void* const* d_in, const int* in_sizes, int n_in, void* d_out, int out_size, void* d_ws, size_t ws_size, hipStream_t stream) {
    static int grid = 0;
    if (grid == 0) {
        if (n_in != 8 || in_sizes[0] != MTOK * DM || out_size != MTOK * DM || ws_size < WS_END) { fprintf(stderr, "kernel_launch: unexpected shapes n_in %d in0 %d out %d ws %zu\n", n_in, n_in > 0 ? in_sizes[0] : -1, out_size, ws_size); grid = -1; return; }
        int dev = 0, cus = 0, per_cu = 0;
        if (hipGetDevice(&dev) != hipSuccess || hipDeviceGetAttribute(&cus, hipDeviceAttributeMultiprocessorCount, dev) != hipSuccess) { grid = -1; return; }
        if (hipFuncSetAttribute((const void*)fwd, hipFuncAttributeMaxDynamicSharedMemorySize, LDS_BYTES) != hipSuccess) { fprintf(stderr, "kernel_launch: hipFuncSetAttribute failed\n"); grid = -1; return; }
        if (hipOccupancyMaxActiveBlocksPerMultiprocessor(&per_cu, (const void*)fwd, NWAVES * 64, LDS_BYTES) != hipSuccess || per_cu < 1) fprintf(stderr, "kernel_launch: occupancy query says %d\n", per_cu);
        (void)hipGetLastError();
        if (per_cu < 1) { grid = -1; return; }
        grid = cus < 512 ? cus : 512;
    }
    if (grid < 0) return;
    if (hipMemsetAsync((char*)d_ws + WS_CTL, 0, CTL_ZERO_BYTES, stream) != hipSuccess) return;
    Args a{};
    for (int i = 0; i < 8; ++i) a.in[i] = (const float*)d_in[i];
    a.out = (float*)d_out; a.ws = (unsigned char*)d_ws;
    for (int li = 0; li < N_LAUNCHES; ++li) {
        a.ph_lo = (N_LAUNCHES == 1) ? 0 : li; a.ph_hi = (N_LAUNCHES == 1) ? N_PHASES : li + 1; a.li = li;
        hipError_t le;
        if (N_LAUNCHES == 1) { void* kargs[] = {(void*)&a}; le = hipLaunchCooperativeKernel((const void*)fwd, dim3(grid), dim3(NWAVES * 64), kargs, LDS_BYTES, stream); }
        else { hipLaunchKernelGGL(fwd, dim3(grid), dim3(NWAVES * 64), LDS_BYTES, stream, a); le = hipPeekAtLastError(); }
        if (le != hipSuccess) { fprintf(stderr, "kernel_launch: launch %d failed: %s\n", li, hipGetErrorName(le)); break; }
    }
}
```

```cpp
#include <hip/hip_runtime.h>
#include <cstdio>
#include <cstdint>
__device__ __forceinline__ int lane_id_asm() { int l; asm volatile("v_mbcnt_lo_u32_b32 %0, -1, 0\n\tv_mbcnt_hi_u32_b32 %0, -1, %0" : "=v"(l)); return l; }
namespace pg8 {
#define PG8_LAS __attribute__((address_space(3)))
typedef unsigned short bf16_t;
typedef short bf16x8 __attribute__((ext_vector_type(8)));
typedef float f32x4 __attribute__((ext_vector_type(4)));
typedef unsigned u32x4 __attribute__((ext_vector_type(4)));
typedef unsigned u32x2 __attribute__((ext_vector_type(2)));
constexpr int BM = 256, BK = 64, HALF = 128, HTB = HALF * BK * 2  , STAGE_BYTES = 8 * HTB, NXCD = 8, WGM = 8;

__host__ __device__ __forceinline__ int lds_byte(int r, int c) { const int st = (r >> 4) * 2 + (c >> 5), rr = r & 15, cc = c & 31, ob = rr * 64 + cc * 2; return st * 1024 + (ob ^ (((ob >> 9) & 1) << 5)); }
__host__ __device__ __forceinline__ void stage_rc(int b, int& R, int& C) { const int st = b / 1024, sb = b % 1024, swz = sb ^ (((sb >> 9) & 1) << 5); R = (st >> 1) * 16 + swz / 64; C = (st & 1) * 32 + (swz % 64) / 2; }
__host__ __device__ __forceinline__ int perm32(int rho) { const int n = rho >> 4, i = rho & 15; return 8 * (i >> 2) + 4 * n + (i & 3); }

struct Unit { int pm, pn; };
struct Gemm { const bf16_t* A; const bf16_t* Bt; int M, N, K; };

struct StaticOrder {
    int nM, nN, nwg, G, c, rot;
    __host__ __device__ void init(int M, int N, int G_, int c_, int rot_ = 0) { __builtin_assume(c_ >= 0 && c_ < 512);     nM = M / BM; nN = N / BM; nwg = nM * nN; G = G_; c = c_; rot = (nwg == 8 * G_) ? rot_ : 0; }
    __host__ __device__ bool next(int i, Unit& u) const {
        if ((long)i * G + c >= nwg) return false;
        const long L = (long)((i + rot) & (rot ? 7 : -1)) * G + c;
        int wgid = (int)L; { const int q = nwg / NXCD, r = nwg % NXCD, xcd = wgid % NXCD, off = wgid / NXCD; wgid = (xcd < r ? xcd * (q + 1) : r * (q + 1) + (xcd - r) * q) + off; }
        const int nig = WGM * nN, gid = wgid / nig, fm = gid * WGM, gsz = (nM - fm) < WGM ? (nM - fm) : WGM;
        u.pm = fm + ((wgid % nig) % gsz); u.pn = (wgid % nig) / gsz; return true;
    }
    __device__ __forceinline__ void a_ready(const Unit&) const {}
    __device__ __forceinline__ void done(const Unit&) const {}
};

__device__ __forceinline__ unsigned cvt_pk_bf16(float lo, float hi) { unsigned r; asm volatile("v_cvt_pk_bf16_f32 %0, %1, %2" : "=v"(r) : "v"(lo), "v"(hi)); return r; }


__device__ __forceinline__ float dpp_row_shr(float v, int n) {
    const int x = __builtin_bit_cast(int, v);
    int r;
    if (n == 1) r = __builtin_amdgcn_update_dpp(0, x, 0x111, 0xf, 0xf, false);
    else if (n == 2) r = __builtin_amdgcn_update_dpp(0, x, 0x112, 0xf, 0xf, false);
    else if (n == 4) r = __builtin_amdgcn_update_dpp(0, x, 0x114, 0xf, 0xf, false);
    else r = __builtin_amdgcn_update_dpp(0, x, 0x118, 0xf, 0xf, false);
    return __builtin_bit_cast(float, r);
}
__device__ __forceinline__ float dpp_row_shr1(float v, int n) {
    const int x = __builtin_bit_cast(int, v); const int one = 0x3f800000;
    int r;
    if (n == 1) r = __builtin_amdgcn_update_dpp(one, x, 0x111, 0xf, 0xf, false);
    else if (n == 2) r = __builtin_amdgcn_update_dpp(one, x, 0x112, 0xf, 0xf, false);
    else if (n == 4) r = __builtin_amdgcn_update_dpp(one, x, 0x114, 0xf, 0xf, false);
    else r = __builtin_amdgcn_update_dpp(one, x, 0x118, 0xf, 0xf, false);
    return __builtin_bit_cast(float, r);
}
__device__ __forceinline__ float fsig(float z) { return __builtin_amdgcn_rcpf(1.0f + __expf(-z)); }
struct EpiFused {
    static constexpr bool PERM = true, AFTER_DRAIN = false;
    bf16_t* ARR; float* DEC; float* KPART; const float* rowss; const float* lb; const float* qg; const float* kg;
    static constexpr size_t AS = (size_t)32768 * 512;
    const PG8_LAS float* rtab; int pm0;
    __device__ __forceinline__ float rstd_of(int row) const { return rtab ? rtab[(((row >> 8) == pm0) ? 0 : 256) + (row & 255)] : rstd_global(rowss, row); }
    static __device__ __forceinline__ float rstd_global(const float* rowss, int row) {
        const f32x4* rp = (const f32x4*)(rowss + (size_t)row * 16);
        const f32x4 a = rp[0], b = rp[1], c = rp[2], d = rp[3];
        const float ss = ((a[0] + a[1]) + (a[2] + a[3])) + ((b[0] + b[1]) + (b[2] + b[3])) + ((c[0] + c[1]) + (c[2] + c[3])) + ((d[0] + d[1]) + (d[2] + d[3]));
        return 1.0f / sqrtf(ss * (1.0f / 1024.0f) + 1e-6f);
    }
    static __device__ __forceinline__ u32x4 pack8(const float (&v)[8]) { u32x4 w; w.x = cvt_pk_bf16(v[0], v[1]); w.y = cvt_pk_bf16(v[2], v[3]); w.z = cvt_pk_bf16(v[4], v[5]); w.w = cvt_pk_bf16(v[6], v[7]); return w; }
    __device__ __forceinline__ void operator()(const f32x4 (&acc)[2][2][4][2], const Unit& u, int wr, int wc, int fr, int fq) const {
        const int row0 = u.pm * BM + wr * 64 + fr; const int pn = u.pn;
        if (pn < 4) {
            const int cb = pn * 128 + wc * 32 + 8 * fq;
            float lbv[8];
#pragma unroll
            for (int k = 0; k < 8; ++k) lbv[k] = lb[cb + k];
#pragma unroll
            for (int ai = 0; ai < 2; ++ai)
#pragma unroll
                for (int mp = 0; mp < 2; ++mp) { const int row1 = row0 + ai * HALF + mp * 32, row2 = row1 + 16; const float rs1 = rstd_of(row1), rs2 = rstd_of(row2);
                    float qi1[8], kt1[8], qi2[8], kt2[8], dc[8];
#pragma unroll
                    for (int k = 0; k < 8; ++k) {
                        const float zq1 = acc[ai][0][2 * mp][k >> 2][k & 3] * rs1, zf1 = acc[ai][1][2 * mp][k >> 2][k & 3] * rs1;
                        const float zq2 = acc[ai][0][2 * mp + 1][k >> 2][k & 3] * rs2, zf2 = acc[ai][1][2 * mp + 1][k >> 2][k & 3] * rs2;
                        const float f1 = lbv[k] + (1.0f - lbv[k]) * fsig(zf1), f2 = lbv[k] + (1.0f - lbv[k]) * fsig(zf2);
                        float e1 = f1, e2 = f2;
                        e1 *= dpp_row_shr1(e1, 1); e2 *= dpp_row_shr1(e2, 1); e1 *= dpp_row_shr1(e1, 2); e2 *= dpp_row_shr1(e2, 2);
                        e1 *= dpp_row_shr1(e1, 4); e2 *= dpp_row_shr1(e2, 4); e1 *= dpp_row_shr1(e1, 8); e2 *= dpp_row_shr1(e2, 8);
                        e2 *= __shfl(e1, (fq << 4) | 15);
                        qi1[k] = zq1 * fsig(zq1) * e1; kt1[k] = (1.0f - f1) * fminf(__builtin_amdgcn_rcpf(e1), 5.5406224e34f);
                        qi2[k] = zq2 * fsig(zq2) * e2; kt2[k] = (1.0f - f2) * fminf(__builtin_amdgcn_rcpf(e2), 5.5406224e34f); dc[k] = e2; }
                    { const int pc = pn * 128 + wc * 32 + 16 * (fq & 1) + 4 * (fq >> 1);
                      const u32x4 a1 = pack8(qi1), b1 = pack8(kt1), a2 = pack8(qi2), b2 = pack8(kt2);
                      bf16_t* q1 = ARR + (size_t)row1 * 512 + pc; bf16_t* q2 = ARR + (size_t)row2 * 512 + pc;
                      *(u32x2*)(q1) = (u32x2){a1.x, a1.y}; *(u32x2*)(q1 + 8) = (u32x2){a1.z, a1.w}; *(u32x2*)(q1 + AS) = (u32x2){b1.x, b1.y}; *(u32x2*)(q1 + AS + 8) = (u32x2){b1.z, b1.w};
                      *(u32x2*)(q2) = (u32x2){a2.x, a2.y}; *(u32x2*)(q2 + 8) = (u32x2){a2.z, a2.w}; *(u32x2*)(q2 + AS) = (u32x2){b2.x, b2.y}; *(u32x2*)(q2 + AS + 8) = (u32x2){b2.z, b2.w}; }
                    if (fr == 15) { float* dp = DEC + (size_t)(row1 >> 5) * 512 + cb; *(f32x4*)dp = (f32x4){dc[0], dc[1], dc[2], dc[3]}; *(f32x4*)(dp + 4) = (f32x4){dc[4], dc[5], dc[6], dc[7]}; }
                    asm volatile("" ::: "memory"); }
        } else if (pn < 8) {
            const int cb = (pn - 4) * 128 + wc * 32 + 8 * fq;
#pragma unroll
            for (int ai = 0; ai < 2; ++ai)
#pragma unroll
                for (int m = 0; m < 4; ++m) { const int row = row0 + ai * HALF + m * 16; const float rs = rstd_of(row);
                    float iv[8], gv[8];
#pragma unroll
                    for (int k = 0; k < 8; ++k) { iv[k] = acc[ai][0][m][k >> 2][k & 3] * rs; const float zg = acc[ai][1][m][k >> 2][k & 3] * rs; gv[k] = zg * fsig(zg); }
                    *(u32x4*)(ARR + 2 * AS + (size_t)row * 512 + cb) = pack8(iv); *(u32x4*)(ARR + 3 * AS + (size_t)row * 512 + cb) = pack8(gv);
                    asm volatile("" ::: "memory"); }
        } else {
            const int ty = (pn - 8) >> 1, head = 4 * ((pn - 8) & 1) + wc; const int d0 = 8 * fq;
            bf16_t* dst = ARR + (size_t)(4 + ty) * AS;
            float gain[2][8]; float csum[2][8];
#pragma unroll
            for (int bj = 0; bj < 2; ++bj)
#pragma unroll
                for (int k = 0; k < 8; ++k) { gain[bj][k] = (ty == 0) ? qg[bj * 32 + d0 + k] * (0.125f * 1.4426950408889634f) : (ty == 1) ? kg[bj * 32 + d0 + k] : 1.0f; csum[bj][k] = 0.f; }
#pragma unroll
            for (int ai = 0; ai < 2; ++ai)
#pragma unroll
                for (int m = 0; m < 4; ++m) { const int row = row0 + ai * HALF + m * 16; const float rs = rstd_of(row);
                    float v[2][8];
#pragma unroll
                    for (int bj = 0; bj < 2; ++bj)
#pragma unroll
                        for (int k = 0; k < 8; ++k) v[bj][k] = acc[ai][bj][m][k >> 2][k & 3] * rs;
                    if (ty < 2) { float ss = 0.f;
#pragma unroll
                        for (int bj = 0; bj < 2; ++bj)
#pragma unroll
                            for (int k = 0; k < 8; ++k) ss += v[bj][k] * v[bj][k];
                        ss += __shfl_xor(ss, 16); ss += __shfl_xor(ss, 32);
                        const float r2 = 1.0f / sqrtf(ss * (1.0f / 64.0f) + 1e-6f);
#pragma unroll
                        for (int bj = 0; bj < 2; ++bj)
#pragma unroll
                            for (int k = 0; k < 8; ++k) { v[bj][k] *= r2 * gain[bj][k]; csum[bj][k] += v[bj][k]; }
                    } else if (ty == 3) {
#pragma unroll
                        for (int bj = 0; bj < 2; ++bj)
#pragma unroll
                            for (int k = 0; k < 8; ++k) v[bj][k] = v[bj][k] * fsig(v[bj][k]); }
                    *(u32x4*)(dst + (size_t)row * 512 + head * 64 + d0) = pack8(v[0]); *(u32x4*)(dst + (size_t)row * 512 + head * 64 + 32 + d0) = pack8(v[1]);
                    asm volatile("" ::: "memory"); }
            if (ty == 1) {
#pragma unroll
                for (int bj = 0; bj < 2; ++bj)
#pragma unroll
                    for (int k = 0; k < 8; ++k) { float s = csum[bj][k]; s += __shfl_xor(s, 1); s += __shfl_xor(s, 2); s += __shfl_xor(s, 4); s += __shfl_xor(s, 8); csum[bj][k] = s; }
                if (fr == 0) { float* kp = KPART + ((size_t)u.pm * 2 + wr) * 512 + head * 64 + d0;
#pragma unroll
                    for (int bj = 0; bj < 2; ++bj) { *(f32x4*)(kp + bj * 32) = (f32x4){csum[bj][0], csum[bj][1], csum[bj][2], csum[bj][3]}; *(f32x4*)(kp + bj * 32 + 4) = (f32x4){csum[bj][4], csum[bj][5], csum[bj][6], csum[bj][7]}; } }
            }
        }
    }
};
struct EpiOut {
    static constexpr bool PERM = true, AFTER_DRAIN = false;
    const bf16_t* xres16; float* out; bf16_t* xb; float* rowss;
    __device__ __forceinline__ void operator()(const f32x4 (&acc)[2][2][4][2], const Unit& u, int wr, int wc, int fr, int fq) const {
        const int col0 = u.pn * BM + wc * 32 + 8 * fq;
        const size_t base = (size_t)(u.pm * BM + wr * 64 + fr) * 1024 + col0;
        u32x4 res[2][4][2];
#pragma unroll
        for (int ai = 0; ai < 2; ++ai)
#pragma unroll
            for (int m = 0; m < 4; ++m)
#pragma unroll
                for (int bj = 0; bj < 2; ++bj) res[ai][m][bj] = *(const u32x4*)(xres16 + base + (size_t)(ai * HALF + m * 16) * 1024 + bj * HALF);
#pragma unroll
        for (int ai = 0; ai < 2; ++ai)
#pragma unroll
            for (int m = 0; m < 4; ++m) {
                const int row = u.pm * BM + ai * HALF + wr * 64 + m * 16 + fr; float ss = 0.f;
#pragma unroll
                for (int bj = 0; bj < 2; ++bj) { const size_t off = (size_t)row * 1024 + col0 + bj * HALF;
                    const u32x4 r = res[ai][m][bj];
                    f32x4 v0 = (f32x4){__builtin_bit_cast(float, r.x << 16), __builtin_bit_cast(float, r.x & 0xffff0000u), __builtin_bit_cast(float, r.y << 16), __builtin_bit_cast(float, r.y & 0xffff0000u)};
                    f32x4 v1 = (f32x4){__builtin_bit_cast(float, r.z << 16), __builtin_bit_cast(float, r.z & 0xffff0000u), __builtin_bit_cast(float, r.w << 16), __builtin_bit_cast(float, r.w & 0xffff0000u)};
                    v0 = v0 + acc[ai][bj][m][0]; v1 = v1 + acc[ai][bj][m][1];
                    if (out) { *(f32x4*)(out + off) = v0; *(f32x4*)(out + off + 4) = v1; }
                    if (xb) { u32x4 w; w.x = cvt_pk_bf16(v0[0], v0[1]); w.y = cvt_pk_bf16(v0[2], v0[3]); w.z = cvt_pk_bf16(v1[0], v1[1]); w.w = cvt_pk_bf16(v1[2], v1[3]); *(u32x4*)(xb + off) = w; }
                    ss += ((v0[0] * v0[0] + v0[1] * v0[1]) + (v0[2] * v0[2] + v0[3] * v0[3])) + ((v1[0] * v1[0] + v1[1] * v1[1]) + (v1[2] * v1[2] + v1[3] * v1[3])); }
                ss += __shfl_xor(ss, 16); ss += __shfl_xor(ss, 32);
                if (fq == 0 && rowss) rowss[(size_t)row * 16 + u.pn * 4 + wc] = ss;
            }
    }
};

template <class Epi, class Sched, bool ALIGN_EPI = false, bool SP2 = false>
__device__ __forceinline__ void gemm_phase(PG8_LAS unsigned char* lds, const Gemm g, const Sched& S, const Epi& E, const int wave0) {
    int tid = wave0 * 64 + lane_id_asm(); asm volatile("" : "+v"(tid));
    const int wid = __builtin_amdgcn_readfirstlane(tid >> 6), lane = tid & 63, wr = wid >> 2, wc = wid & 3, fr = lane & 15, fq = lane >> 4;
    const int K = g.K, nt = K / BK;
    unsigned voffA[2], voffB[2];
#pragma unroll
    for (int i = 0; i < 2; ++i) { int R, C; stage_rc(tid * 16 + i * 8192, R, C); const int Rb = Epi::PERM ? ((R & ~31) + perm32(R & 31)) : R;
        voffA[i] = (unsigned)(R * K + C) * 2u; voffB[i] = (unsigned)(Rb * K + C) * 2u; }
    const size_t kstep = (size_t)(BK * 2);
    const size_t hstep = (size_t)HALF * K * 2;
    const size_t tstep = 2 * hstep;
    const unsigned ldsw = (unsigned)wid * 1024u;
    const int aoff = lds_byte(wr * 64 + fr, fq * 8), boff = lds_byte(wc * 32 + fr, fq * 8);
#define PG8_SA(b, h) (((b) * 2 + (h)) * HTB)
#define PG8_SB(b, h) ((4 + (b) * 2 + (h)) * HTB)
#define PG8_STAGE(bufoff, gbase, voff) do { _Pragma("unroll") for (int _i = 0; _i < 2; ++_i) \
        __builtin_amdgcn_global_load_lds((const unsigned*)((const char*)(gbase) + (voff)[_i]), (PG8_LAS unsigned*)(lds + (bufoff) + ldsw + _i * 8192), 16, 0, 0); } while (0)
#define PG8_LDA(dst, b, h) do { _Pragma("unroll") for (int m = 0; m < 4; ++m) _Pragma("unroll") for (int k = 0; k < 2; ++k) dst[m][k] = *(const PG8_LAS bf16x8*)(lds + PG8_SA(b, h) + aoff + m * 2048 + k * 1024); } while (0)
#define PG8_LDB(dst, b, h) do { _Pragma("unroll") for (int n = 0; n < 2; ++n) _Pragma("unroll") for (int k = 0; k < 2; ++k) dst[n][k] = *(const PG8_LAS bf16x8*)(lds + PG8_SB(b, h) + boff + n * 2048 + k * 1024); } while (0)
#define PG8_MMA(ai, bj, At, Bt) do { __builtin_amdgcn_s_setprio(1); _Pragma("unroll") for (int m = 0; m < 4; ++m) _Pragma("unroll") for (int n = 0; n < 2; ++n) _Pragma("unroll") for (int k = 0; k < 2; ++k) \
        acc[ai][bj][m][n] = __builtin_amdgcn_mfma_f32_16x16x32_bf16(Bt[n][k], At[m][k], acc[ai][bj][m][n], 0, 0, 0); __builtin_amdgcn_s_setprio(0); } while (0)
#define PG8_WAIT_V(n) asm volatile("s_waitcnt vmcnt(" #n ")" ::: "memory")
#define PG8_WAIT_L(n) asm volatile("s_waitcnt lgkmcnt(" #n ")" ::: "memory")
#define PG8_BAR __builtin_amdgcn_s_barrier()
#define PG8_SCHED __builtin_amdgcn_sched_barrier(0)
    Unit cur, nxt; int ui = 0;
    if (!S.next(0, cur)) return;
    f32x4 acc[2][2][4][2];
#pragma unroll
    for (int a = 0; a < 2; ++a)
#pragma unroll
        for (int b = 0; b < 2; ++b)
#pragma unroll
            for (int m = 0; m < 4; ++m)
#pragma unroll
                for (int n = 0; n < 2; ++n) acc[a][b][m][n] = (f32x4){0.f, 0.f, 0.f, 0.f};
    bf16x8 At[4][2], B0[2][2], B1[2][2];
    const char* cA = (const char*)g.A + (size_t)cur.pm * tstep; const char* cB = (const char*)g.Bt + (size_t)cur.pn * tstep;
    S.a_ready(cur);
    if constexpr (SP2) {
        PG8_STAGE(PG8_SB(0, 0), cB, voffB); PG8_STAGE(PG8_SB(0, 1), cB + hstep, voffB); PG8_STAGE(PG8_SA(0, 0), cA, voffA); PG8_STAGE(PG8_SA(0, 1), cA + hstep, voffA);
        if (wr == 1) PG8_BAR;
        PG8_WAIT_V(2); PG8_BAR;
        PG8_STAGE(PG8_SB(1, 0), cB + kstep, voffB); PG8_STAGE(PG8_SA(1, 0), cA + kstep, voffA); PG8_STAGE(PG8_SB(1, 1), cB + hstep + kstep, voffB);
        PG8_WAIT_V(6); PG8_BAR;
    } else {
        PG8_STAGE(PG8_SB(0, 0), cB, voffB); PG8_STAGE(PG8_SA(0, 0), cA, voffA); PG8_STAGE(PG8_SB(0, 1), cB + hstep, voffB); PG8_STAGE(PG8_SA(0, 1), cA + hstep, voffA);
        if (wr == 1) PG8_BAR;
        PG8_WAIT_V(4); PG8_BAR;
        PG8_STAGE(PG8_SB(1, 0), cB + kstep, voffB); PG8_STAGE(PG8_SA(1, 0), cA + kstep, voffA); PG8_STAGE(PG8_SB(1, 1), cB + hstep + kstep, voffB);
        PG8_WAIT_V(6); PG8_BAR;
    }
    for (;;) {
        const bool has_next = S.next(ui + 1, nxt);
        const char* nA = has_next ? (const char*)g.A + (size_t)nxt.pm * tstep : cA; const char* nB = has_next ? (const char*)g.Bt + (size_t)nxt.pn * tstep : cB;
        for (int t = 0; t < nt; t += 2) {
            const bool last = (t == nt - 2);
            const char* a1 = cA + (size_t)(t + 1) * kstep;
            const char* a2 = last ? nA : cA + (size_t)(t + 2) * kstep; const char* b2 = last ? nB : cB + (size_t)(t + 2) * kstep;
            const char* a3 = a2 + kstep; const char* b3 = b2 + kstep;
            if (last && has_next) S.a_ready(nxt);
            if constexpr (SP2) {
            PG8_LDB(B0, 0, 0); PG8_LDB(B1, 0, 1); PG8_SCHED; PG8_LDA(At, 0, 0); PG8_STAGE(PG8_SA(1, 1), a1 + hstep, voffA);
            PG8_WAIT_V(8); PG8_WAIT_L(0); PG8_BAR; PG8_MMA(0, 0, At, B0); PG8_MMA(0, 1, At, B1); PG8_BAR; PG8_SCHED;
            PG8_LDA(At, 0, 1); PG8_STAGE(PG8_SB(0, 0), b2, voffB); PG8_STAGE(PG8_SB(0, 1), b2 + hstep, voffB); PG8_STAGE(PG8_SA(0, 0), a2, voffA);
            PG8_WAIT_V(8); PG8_WAIT_L(0); PG8_BAR; PG8_MMA(1, 0, At, B0); PG8_MMA(1, 1, At, B1); PG8_BAR; PG8_SCHED;
            PG8_LDB(B0, 1, 0); PG8_LDB(B1, 1, 1); PG8_SCHED; PG8_LDA(At, 1, 0); PG8_STAGE(PG8_SA(0, 1), a2 + hstep, voffA);
            PG8_WAIT_V(8); PG8_WAIT_L(0); PG8_BAR; PG8_MMA(0, 0, At, B0); PG8_MMA(0, 1, At, B1); PG8_BAR; PG8_SCHED;
            PG8_LDA(At, 1, 1); PG8_STAGE(PG8_SB(1, 0), b3, voffB); PG8_STAGE(PG8_SB(1, 1), b3 + hstep, voffB); PG8_STAGE(PG8_SA(1, 0), a3, voffA);
            PG8_WAIT_V(8); PG8_WAIT_L(0); PG8_BAR; PG8_MMA(1, 0, At, B0); PG8_MMA(1, 1, At, B1); PG8_BAR; PG8_SCHED;
            } else {
            PG8_LDB(B0, 0, 0); PG8_SCHED; PG8_LDA(At, 0, 0); PG8_STAGE(PG8_SA(1, 1), a1 + hstep, voffA);
            PG8_WAIT_L(8); PG8_BAR; PG8_WAIT_L(0); PG8_MMA(0, 0, At, B0); PG8_BAR; PG8_SCHED;
            PG8_LDB(B1, 0, 1); PG8_STAGE(PG8_SB(0, 0), b2, voffB);
            PG8_BAR; PG8_WAIT_L(0); PG8_MMA(0, 1, At, B1); PG8_BAR;
            PG8_LDA(At, 0, 1); PG8_STAGE(PG8_SA(0, 0), a2, voffA);
            PG8_BAR; PG8_WAIT_L(0); PG8_MMA(1, 0, At, B0); PG8_BAR; PG8_SCHED;
            PG8_STAGE(PG8_SB(0, 1), b2 + hstep, voffB);
            PG8_WAIT_V(6); PG8_BAR; PG8_MMA(1, 1, At, B1); PG8_BAR;
            PG8_LDB(B0, 1, 0); PG8_SCHED; PG8_LDA(At, 1, 0); PG8_STAGE(PG8_SA(0, 1), a2 + hstep, voffA);
            PG8_WAIT_L(8); PG8_BAR; PG8_WAIT_L(0); PG8_MMA(0, 0, At, B0); PG8_BAR; PG8_SCHED;
            PG8_LDB(B1, 1, 1); PG8_STAGE(PG8_SB(1, 0), b3, voffB);
            PG8_BAR; PG8_WAIT_L(0); PG8_MMA(0, 1, At, B1); PG8_BAR;
            PG8_LDA(At, 1, 1); PG8_STAGE(PG8_SA(1, 0), a3, voffA);
            PG8_BAR; PG8_WAIT_L(0); PG8_MMA(1, 0, At, B0); PG8_BAR; PG8_SCHED;
            PG8_STAGE(PG8_SB(1, 1), b3 + hstep, voffB);
            PG8_WAIT_V(6); PG8_BAR; PG8_MMA(1, 1, At, B1); PG8_BAR;
            }
        }
        if constexpr (ALIGN_EPI) { if (wr == 0) PG8_BAR; }
        if constexpr (!Epi::AFTER_DRAIN) { E(acc, cur, wr, wc, fr, fq); S.done(cur); }
        if (!has_next) break;
#pragma unroll
        for (int a = 0; a < 2; ++a)
#pragma unroll
            for (int b = 0; b < 2; ++b)
#pragma unroll
                for (int m = 0; m < 4; ++m)
#pragma unroll
                    for (int n = 0; n < 2; ++n) acc[a][b][m][n] = (f32x4){0.f, 0.f, 0.f, 0.f};
        cur = nxt; cA = nA; cB = nB; ++ui;
        if constexpr (ALIGN_EPI) { if (wr == 1) PG8_BAR; }
    }
    PG8_WAIT_V(0);
    if constexpr (!ALIGN_EPI) { if (wr == 0) PG8_BAR; }
    PG8_BAR;
    if constexpr (Epi::AFTER_DRAIN) { E.fused(acc, cur, wr, wc, fr, fq, lds, wid, lane); S.done(cur); }
#undef PG8_SA
#undef PG8_SB
#undef PG8_STAGE
#undef PG8_LDA
#undef PG8_LDB
#undef PG8_MMA
#undef PG8_WAIT_V
#undef PG8_WAIT_L
#undef PG8_BAR
#undef PG8_SCHED
}
}


constexpr int NWAVES = 8;
#ifndef REP_PROJ
#define REP_PROJ 1
#endif
#ifndef REP_HGRN
#define REP_HGRN 1
#endif
#ifndef REP_MOBA
#define REP_MOBA 1
#endif
#ifndef REP_OUT
#define REP_OUT 1
#endif
#ifndef MK_N_LAUNCHES
#define MK_N_LAUNCHES 1
#endif
constexpr int N_PHASES = 7;
constexpr int N_LAUNCHES = MK_N_LAUNCHES;

constexpr int BATCH = 16, SEQ = 2048, DM = 1024, DEPTH = 2, MTOK = BATCH * SEQ, NIN = 4096;
constexpr int C_HQ = 0, C_HF = 512, C_HI = 1024, C_HG = 1536, C_AQ = 2048, C_AK = 2560, C_AV = 3072, C_AG = 3584;
constexpr float NORM_EPS = 1e-6f;

constexpr size_t MiB = 1u << 20;
constexpr size_t WS_CTL = 0, CTL_ZERO_BYTES = 32768;
constexpr size_t WS_WIN = 2 * MiB;
constexpr size_t WS_WOUT = 18 * MiB;
constexpr size_t WS_LB = 22 * MiB;
constexpr size_t WS_KPART = 22 * MiB + 65536;
constexpr size_t WS_ROWSS = 24 * MiB;
constexpr size_t WS_DEC = 28 * MiB;
constexpr size_t WS_XB = 32 * MiB;
constexpr size_t WS_MIXED = 160 * MiB;
constexpr size_t WS_ARR = 224 * MiB;
constexpr size_t ARR_BYTES = 32 * MiB;
constexpr size_t WS_END = 480 * MiB;
constexpr int CW_QUEUE = 1024;
constexpr int CW_BAR = 4096;

constexpr int RING_OFF = 0, RING_BYTES = 131072;
constexpr int EXTRA_OFF = RING_BYTES, EXTRA_BYTES = 16384;
constexpr int LDSCTL_OFF = EXTRA_OFF + EXTRA_BYTES, MISC_OFF = LDSCTL_OFF + 320;
constexpr int LDS_BYTES = LDSCTL_OFF + 1024;

#define GAS __attribute__((address_space(1)))
#define LAS __attribute__((address_space(3)))
typedef unsigned short bf16;
typedef unsigned v4u __attribute__((ext_vector_type(4)));
typedef float f32x4 __attribute__((ext_vector_type(4)));
typedef GAS unsigned gu32;
#define RLX_AGENT __ATOMIC_RELAXED, __HIP_MEMORY_SCOPE_AGENT
#define LDS_WAIT() asm volatile("s_waitcnt lgkmcnt(0)" ::: "memory")
#define VM_WAIT() asm volatile("s_waitcnt vmcnt(0)" ::: "memory")
__device__ __forceinline__ unsigned f2bf(float f) { unsigned u = __builtin_bit_cast(unsigned, f); return (u + 0x7fffu + ((u >> 16) & 1u)) >> 16; }
__device__ __forceinline__ unsigned pk2(float lo, float hi) { return f2bf(lo) | (f2bf(hi) << 16); }
__device__ __forceinline__ float bf2f(unsigned short b) { return __builtin_bit_cast(float, (unsigned)b << 16); }
__device__ __forceinline__ float bflo(unsigned w) { return __builtin_bit_cast(float, w << 16); }
__device__ __forceinline__ float bfhi(unsigned w) { return __builtin_bit_cast(float, w & 0xffff0000u); }
__device__ __forceinline__ float silu_f(float z) { return z / (1.0f + __expf(-z)); }
__device__ __forceinline__ float sigmoid_f(float z) { return 1.0f / (1.0f + __expf(-z)); }

#define XB_TMO      128
#define XB_XCNT(j)  (256  + 64 * (j))
#define XB_XSUB(j)  (1280 + 64 * (j))
#define XB_XGEN(j)  (2304 + 64 * (j))
#define XB_TOP      3328
#define XB_TOPGEN   3392
#define XCD_BAR_WORDS 3456
#define XB_SPIN_CAP (1u << 18)

__device__ __forceinline__ unsigned xb_ld(unsigned* p)              { return __hip_atomic_load(p, __ATOMIC_RELAXED, __HIP_MEMORY_SCOPE_AGENT); }
__device__ __forceinline__ unsigned xb_add(unsigned* p, unsigned v) { return __hip_atomic_fetch_add(p, v, __ATOMIC_RELAXED, __HIP_MEMORY_SCOPE_AGENT); }
__device__ __forceinline__ unsigned xb_xcc_id() { return (unsigned)__builtin_amdgcn_s_getreg((3 << 11) | 20) & 0xFu; }
#define XB_SPIN(cond, bar) do { unsigned _sp = 0; while (cond) { __builtin_amdgcn_s_sleep(1); \
    if ((++_sp & 255u) == 0u) { if (xb_ld(&(bar)[XB_TMO])) break; if (_sp > XB_SPIN_CAP) { atomicAdd(&(bar)[XB_TMO], 1u); break; } } } } while (0)

struct XcdBarrier {
    unsigned* bar; unsigned x; int wave0;
    volatile LAS unsigned* st;
};

#define XB_IS_T0(wv) ((wv) == 0 && lane_id_asm() == 0)
__device__ __forceinline__ XcdBarrier xcd_barrier_post(unsigned* bar, volatile LAS unsigned* st, int wave0) {
    XcdBarrier b; b.bar = bar; b.x = xb_xcc_id(); b.st = st; b.wave0 = wave0;
    if (XB_IS_T0(wave0)) (void)xb_add(&bar[XB_XCNT(b.x)], 1u);
    return b;
}
__device__ __forceinline__ void xcd_barrier_complete(unsigned* bar, unsigned x, unsigned& nloc, unsigned& nx) {
    const unsigned G = gridDim.x * gridDim.y * gridDim.z;
    unsigned sum, cnt, mine, sp = 0u;
    for (;;) {
        sum = 0u; cnt = 0u; mine = 0u;
#pragma unroll
        for (unsigned j = 0; j < 16; ++j) { const unsigned c = xb_ld(&bar[XB_XCNT(j)]); sum += c; cnt += (c > 0u) ? 1u : 0u; mine = (j == x) ? c : mine; }
        if (sum == G) break;
        __builtin_amdgcn_s_sleep(1);
        if ((++sp & 255u) == 0u) { if (xb_ld(&bar[XB_TMO])) break; if (sp > XB_SPIN_CAP) { atomicAdd(&bar[XB_TMO], 1u); break; } }
    }
    nloc = mine > 0u ? mine : 1u; nx = cnt > 0u ? cnt : 1u;
}

__device__ __forceinline__ void xcd_barrier(const XcdBarrier& b) {
    asm volatile("s_waitcnt vmcnt(0)" ::: "memory");
    __syncthreads();
    if (XB_IS_T0(b.wave0)) {
        unsigned* bar = b.bar;
        __builtin_amdgcn_s_waitcnt(0);
        unsigned nloc = b.st[0], nx = b.st[1];
        if (nloc == 0u) { xcd_barrier_complete(bar, b.x, nloc, nx); b.st[0] = nloc; b.st[1] = nx; }
        const unsigned old = xb_add(&bar[XB_XSUB(b.x)], 1u);
        const unsigned gen = old / nloc;
        if (old + 1u == (gen + 1u) * nloc) {
            __builtin_amdgcn_fence(__ATOMIC_RELEASE, "agent");
            asm volatile("s_waitcnt vmcnt(0)" ::: "memory");
            const unsigned og = xb_add(&bar[XB_TOP], 1u);
            const unsigned tg = og / nx;
            if (og + 1u == (tg + 1u) * nx) xb_add(&bar[XB_TOPGEN], 1u);
            else XB_SPIN(xb_ld(&bar[XB_TOPGEN]) == tg, bar);
            __builtin_amdgcn_fence(__ATOMIC_ACQUIRE, "agent");
            xb_add(&bar[XB_XGEN(b.x)], 1u);
            asm volatile("s_waitcnt vmcnt(0)" ::: "memory");
        } else {
            XB_SPIN(xb_ld(&bar[XB_XGEN(b.x)]) == gen, bar);
            __builtin_amdgcn_fence(__ATOMIC_ACQUIRE, "agent");
            asm volatile("s_waitcnt vmcnt(0)" ::: "memory");
        }
    }
    __syncthreads();
}


struct Frame {
    LAS unsigned char* lds;
    volatile LAS unsigned* MISC;
    int wave0;
    gu32* ctl;
    int vcu, G;
    const float* x; float* out;
    const float *norm_w, *w_in, *lb_logits, *hg_norm_w, *q_norm_w, *k_norm_w, *w_out;
    bf16 *WIN, *WOUT, *XB, *MIXED, *QI, *KT, *HI, *GH, *QN, *KN, *V, *GA;
    float *LB, *KPART, *ROWSS, *DEC;
};

__device__ __forceinline__ float wave_sum(float v) {
#pragma unroll
    for (int o = 1; o < 64; o <<= 1) v += __shfl_xor(v, o);
    return v;
}
__device__ __forceinline__ int win_dest(int oc) {
    if (oc < 2048) { const int grp = oc >> 9, hh = (oc >> 7) & 3, w = oc & 127; return 256 * (((grp >> 1) << 2) + hh) + 128 * (grp & 1) + w; }
    const int ty = (oc - 2048) >> 9, head = (oc >> 6) & 7, bj = (oc >> 5) & 1; return 256 * (8 + 2 * ty + (head >> 2)) + 128 * bj + 32 * (head & 3);
}
__device__ __forceinline__ void p0_transpose_item(const float* W, int K, int N, bf16* WT, const float* kscale, LAS float* scr, int item, int lane, bool permute) {
    const int nblk = N / 32, kb = item / nblk, nb = item % nblk, k0 = 64 * kb, n0 = 32 * nb; const int nd = permute ? win_dest(n0) : n0;
    float wv_[32];
#pragma unroll
    for (int i = 0; i < 32; ++i) wv_[i] = __builtin_nontemporal_load(W + (size_t)(k0 + 2 * i + (lane >> 5)) * N + n0 + (lane & 31));
#pragma unroll
    for (int i = 0; i < 32; ++i) { const int kk = 2 * i + (lane >> 5); const float s = kscale ? kscale[k0 + kk] : 1.0f; scr[kk * 33 + (lane & 31)] = wv_[i] * s; }
    LDS_WAIT(); asm volatile("" ::: "memory");
    const int c = lane & 7;
#pragma unroll
    for (int j = 0; j < 4; ++j) { const int n = (lane >> 3) + 8 * j; const LAS float* s = scr + (8 * c) * 33 + n;
        v4u o; o.x = pk2(s[0 * 33], s[1 * 33]); o.y = pk2(s[2 * 33], s[3 * 33]); o.z = pk2(s[4 * 33], s[5 * 33]); o.w = pk2(s[6 * 33], s[7 * 33]);
        *(GAS v4u*)(WT + (size_t)(nd + n) * K + k0 + 8 * c) = o; }
    LDS_WAIT(); asm volatile("" ::: "memory");
}
#define PHASE_IDS() int t_ = F.wave0 * 64 + lane_id_asm(); asm volatile("" : "+v"(t_)); const int tid = t_, lane = tid & 63, wave = __builtin_amdgcn_readfirstlane(tid >> 6); (void)lane; (void)wave
__device__ __forceinline__ void p0_prologue(Frame& F) {
    PHASE_IDS();
    LAS float* scr = (LAS float*)(F.lds + RING_OFF + wave * 16384);
    const int gw = F.vcu * NWAVES + wave, NGW = F.G * NWAVES;
    constexpr int I_IN = (DM / 64) * (NIN / 32), I_OUT = (DM / 64) * (DM / 32);
    constexpr int NITEMS = DEPTH * (I_IN + I_OUT);
    for (int it = gw; it < NITEMS; it += NGW) {
        int r = it;
        if (r < DEPTH * I_IN) { const int l = r / I_IN; r -= l * I_IN;
            p0_transpose_item(F.w_in + (size_t)l * DM * NIN, DM, NIN, F.WIN + (size_t)l * NIN * DM, F.norm_w + l * DM, scr, r, lane, true); continue; }
        r -= DEPTH * I_IN; { const int l = r / I_OUT; r -= l * I_OUT;
            p0_transpose_item(F.w_out + (size_t)l * DM * DM, DM, DM, F.WOUT + (size_t)l * DM * DM, nullptr, scr, r, lane, false); }
    }
    for (int m0 = gw * 4; m0 < MTOK; m0 += NGW * 4) {
        f32x4 v[4][4]; float sq[4];
#pragma unroll
        for (int r = 0; r < 4; ++r) { const GAS f32x4* xr = (const GAS f32x4*)(F.x + (size_t)(m0 + r) * DM) + lane;
#pragma unroll
            for (int j = 0; j < 4; ++j) v[r][j] = __builtin_nontemporal_load(xr + 64 * j); }
#pragma unroll
        for (int r = 0; r < 4; ++r) { float a = 0.f;
#pragma unroll
            for (int j = 0; j < 4; ++j) a += (v[r][j].x * v[r][j].x + v[r][j].y * v[r][j].y) + (v[r][j].z * v[r][j].z + v[r][j].w * v[r][j].w);
            sq[r] = a; }
#pragma unroll
        for (int o = 1; o < 64; o <<= 1) {
#pragma unroll
            for (int r = 0; r < 4; ++r) sq[r] += __shfl_xor(sq[r], o); }
#pragma unroll
        for (int r = 0; r < 4; ++r) { GAS unsigned long long* o8 = (GAS unsigned long long*)(F.XB + (size_t)(m0 + r) * DM) + lane;
#pragma unroll
            for (int j = 0; j < 4; ++j) o8[64 * j] = (unsigned long long)pk2(v[r][j].x, v[r][j].y) | ((unsigned long long)pk2(v[r][j].z, v[r][j].w) << 32);
            if (lane < 16) F.ROWSS[(size_t)(m0 + r) * 16 + lane] = (lane == 0) ? sq[r] : 0.f; }
    }
    if (blockIdx.x == 0) { const int c = tid; const float a0 = F.lb_logits[c], a1 = F.lb_logits[512 + c]; const float mx = fmaxf(a0, a1);
        const float e0 = expf(a0 - mx), e1 = expf(a1 - mx); const float p0 = e0 / (e0 + e1), p1 = e1 / (e0 + e1);
        F.LB[c] = 0.f; F.LB[512 + c] = fminf(fmaxf((p0 + p1) - p0, 0.f), 1.0f - 1e-6f); }
}

constexpr float LOG2E = 1.4426950408889634f;
constexpr float QSCALE2 = 0.125f * LOG2E;
namespace moba {
typedef short bf16x8 __attribute__((ext_vector_type(8)));
typedef short s16x4 __attribute__((ext_vector_type(4)));
typedef float f32x16 __attribute__((ext_vector_type(16)));
typedef float f32x2_t __attribute__((ext_vector_type(2))); typedef __bf16 bf16x2_t __attribute__((ext_vector_type(2)));
__device__ __forceinline__ unsigned cvtpk(float lo, float hi) { f32x2_t v = {lo, hi}; bf16x2_t b = __builtin_convertvector(v, bf16x2_t); return __builtin_bit_cast(unsigned, b); }
__device__ __forceinline__ int crow(int r, int hi) { return (r & 3) + 8 * (r >> 2) + 4 * hi; }
__device__ __forceinline__ float max3f(float a, float b, float c) { float r; asm("v_max3_f32 %0, %1, %2, %3" : "=v"(r) : "v"(a), "v"(b), "v"(c)); return r; }
constexpr int L_K = 0, L_V = 32768, L_WSF = 65536, L_KM = 67584, L_OST = 69632;
constexpr float NEG_BIG = -1e30f;
constexpr float THR = 8.0f;
__device__ __forceinline__ s16x4 vtr(const LAS unsigned char* p) { return __builtin_bit_cast(s16x4, __builtin_amdgcn_ds_read_tr16_b64_v4i16((LAS s16x4*)p)); }
}

__device__ __forceinline__ void moba_glds(unsigned voff, const void* sbase, unsigned lds_dst) { unsigned keep;
    asm volatile("s_mov_b32 %0, m0\n\ts_mov_b32 m0, %3\n\ts_nop 0\n\tglobal_load_lds_dwordx4 %1, %2\n\ts_mov_b32 m0, %0" : "=&s"(keep) : "v"(voff), "s"(sbase), "s"(lds_dst) : "memory"); }
template <bool FIXREF> __device__ __forceinline__ void moba_mfma_body(Frame& F, int l) {
    using namespace moba;
    PHASE_IDS();
    const int r32 = lane & 31, hi = lane >> 5, wid = wave;
    LAS unsigned char* L = F.lds + RING_OFF;
    LAS float* wsf = (LAS float*)(L + L_WSF) + wid * 64;
    LAS float* km = (LAS float*)(L + L_KM);
    LAS float* ost = (LAS float*)(L + L_OST) + wid * 2048;
    float gq = fabsf(F.q_norm_w[l * 64 + lane]), gk = fabsf(F.k_norm_w[l * 64 + lane]);
#pragma unroll
    for (int o = 1; o < 64; o <<= 1) { gq = fmaxf(gq, __shfl_xor(gq, o)); gk = fmaxf(gk, __shfl_xor(gk, o)); }
    gq = __builtin_bit_cast(float, __builtin_amdgcn_readfirstlane(__builtin_bit_cast(int, gq))); gk = __builtin_bit_cast(float, __builtin_amdgcn_readfirstlane(__builtin_bit_cast(int, gk)));
    const float smax2 = 8.0f * gq * gk * LOG2E * 1.02f;
    const float mhat0 = -(smax2 + 1.0f);
    gu32* qctr = F.ctl + CW_QUEUE + 64 * l;
    volatile LAS unsigned* tick = (volatile LAS unsigned*)(F.lds + EXTRA_OFF + 8192);
    if (tid == 0) tick[0] = __hip_atomic_fetch_add(qctr, 1u, RLX_AGENT);
    for (int ui = 0;; ++ui) {
        __syncthreads();
        const int it = __builtin_amdgcn_readfirstlane((int)tick[ui & 1]); if (it >= 1024) break;
        const int qb = 7 - (it >> 7), bh = it & 127;
        const int b = bh >> 3, h = bh & 7; const size_t rowbase = (size_t)b * SEQ; const int q0 = qb * 256, qrel = wid * 32 + r32, tq = q0 + qrel;
        const float sl2 = exp2f(-(float)(h + 1)) * LOG2E;
        bf16x8 qr[4];
        { const GAS bf16* Qw = (const GAS bf16*)(F.QN + (rowbase + q0 + wid * 32 + r32) * 512 + h * 64 + hi * 8);
#pragma unroll
            for (int d0 = 0; d0 < 4; ++d0) qr[d0] = *(const GAS bf16x8*)(Qw + d0 * 16); }
        LAS unsigned char* qlds = (LAS unsigned char*)ost + lane * 16;
        { int tid_u = tid; asm volatile("" : "+v"(tid_u));
          if (tid_u < qb * 64) { const GAS float* kp = (const GAS float*)(F.KPART + ((size_t)b * 8 + (tid_u >> 6)) * 1024 + h * 64 + (tid_u & 63)); km[tid_u] = (kp[0] + kp[512]) * (1.0f / 256.0f); } }
        const unsigned koff = (unsigned)(((rowbase + lane) * 512 + h * 64 + wid * 8) * 2);
        unsigned voff; { const int vr = 8 * wid + (lane >> 3), sl = lane & 7; const int ch = ((((sl >> 2) ^ ((vr >> 1) & 1)) << 2) | (sl & 3)); voff = (unsigned)((((size_t)MTOK + rowbase + vr) * 512 + h * 64 + ch * 8) * 2); }
        const unsigned lds0 = (unsigned)(uintptr_t)L;
#define MOBA_ISSUE(t_, bufi) do { moba_glds(koff, (const void*)((const char*)F.KN + (size_t)(t_) * 65536), (unsigned)__builtin_amdgcn_readfirstlane((int)(lds0 + L_K + (bufi) * 8192 + wid * 1024))); \
            moba_glds(voff, (const void*)((const char*)F.KN + (size_t)(t_) * 65536), (unsigned)__builtin_amdgcn_readfirstlane((int)(lds0 + L_V + (bufi) * 8192 + wid * 1024))); } while (0)
        const int NT = 4 * (qb + 1);
        int t0 = 0; { const float dstar = (151.0f + 2.0f * smax2) / sl2; const float x = ((float)(q0 - 63) - dstar) * (1.0f / 64.0f); if (x > 0.f) t0 = ((int)x) & ~1; if (t0 > NT - 4) t0 = NT - 4; t0 = __builtin_amdgcn_readfirstlane(t0); }
        unsigned nticket = 0u; if (tid == 0) nticket = __hip_atomic_fetch_add(qctr, 1u, RLX_AGENT);
        MOBA_ISSUE(t0, 0); MOBA_ISSUE(t0 + 1, 1); MOBA_ISSUE(t0 + 2, 2);
        __syncthreads();
        unsigned selmask = 0;
        { float gt[7]; float qf32[32];
#pragma unroll
            for (int d0 = 0; d0 < 4; ++d0)
#pragma unroll
                for (int e = 0; e < 8; ++e) qf32[d0 * 8 + e] = bf2f((unsigned short)qr[d0][e]);
#pragma unroll
            for (int i = 0; i < 32; ++i) asm volatile("" : "+v"(qf32[i]));
#pragma unroll
            for (int j = 0; j < 7; ++j) { float s = 0.f;
                if (j < qb) {
#pragma unroll
                    for (int d0 = 0; d0 < 4; ++d0)
#pragma unroll
                        for (int e = 0; e < 8; ++e) s += qf32[d0 * 8 + e] * km[j * 64 + d0 * 16 + hi * 8 + e];
                    auto rr = __builtin_amdgcn_permlane32_swap(__float_as_uint(s), __float_as_uint(s), false, false);
                    s = __uint_as_float(rr[0]) + __uint_as_float(rr[1]); }
                gt[j] = s; }
#pragma unroll
            for (int j = 0; j < 7; ++j) { int rank = 0;
#pragma unroll
                for (int i = 0; i < 7; ++i) if (i != j && i < qb) rank += (gt[i] > gt[j] || (gt[i] == gt[j] && i < j)) ? 1 : 0;
                if (j < qb && rank < 3) selmask |= 1u << j; }
            selmask |= 1u << qb; }
        if (!FIXREF) {
#pragma unroll
            for (int d0 = 0; d0 < 4; ++d0) *(LAS bf16x8*)(qlds + d0 * 1024) = qr[d0]; }
        float mhat = mhat0, l_reg = 0.f; f32x16 o[2]; o[0] = f32x16{}; o[1] = f32x16{};
        const int kbase = L_K + hi * 1024 + r32 * 16;
        const int g16 = lane >> 4, i16 = lane & 15, tq4 = i16 >> 2, tp4 = i16 & 3;
        const int vrow0 = 4 * hi + tq4;
        if (tid == 0) tick[(ui + 1) & 1] = nticket;
        asm volatile("s_waitcnt vmcnt(2)" ::: "memory");
        __syncthreads();
#define MOBA_KLOAD(KOFF) do { if (!FIXREF) { _Pragma("unroll") for (int d0 = 0; d0 < 4; ++d0) qf_[d0] = *(const LAS bf16x8*)(qlds + d0 * 1024); } \
            _Pragma("unroll") for (int d0 = 0; d0 < 4; ++d0) { \
            kfr[2 * d0] = *(const LAS bf16x8*)(L + (KOFF) + kbase + d0 * 2048); kfr[2 * d0 + 1] = *(const LAS bf16x8*)(L + (KOFF) + kbase + d0 * 2048 + 512); } } while (0)
#define MOBA_KLOADH(KOFF, H) do { _Pragma("unroll") for (int d0 = 2 * (H); d0 < 2 * (H) + 2; ++d0) { \
            kfr[2 * d0] = *(const LAS bf16x8*)(L + (KOFF) + kbase + d0 * 2048); kfr[2 * d0 + 1] = *(const LAS bf16x8*)(L + (KOFF) + kbase + d0 * 2048 + 512); } } while (0)
#define MOBA_VLOAD(VOFF) do { _Pragma("unroll") for (int dblk = 0; dblk < 2; ++dblk) _Pragma("unroll") for (int ks = 0; ks < 4; ++ks) { \
            const int rlo = 16 * ks + vrow0, rhi = rlo + 8; \
            vlo[dblk * 4 + ks] = vtr(L + L_V + (VOFF) + rlo * 128 + ((dblk ^ ((rlo >> 1) & 1)) * 64) + (16 * (g16 & 1) + 4 * tp4) * 2); \
            vhi[dblk * 4 + ks] = vtr(L + L_V + (VOFF) + rhi * 128 + ((dblk ^ ((rhi >> 1) & 1)) * 64) + (16 * (g16 & 1) + 4 * tp4) * 2); } } while (0)
#define MOBA_VLOADH(VOFF, DB) do { _Pragma("unroll") for (int ks = 0; ks < 4; ++ks) { \
            const int rlo = 16 * ks + vrow0, rhi = rlo + 8; \
            vlo[(DB) * 4 + ks] = vtr(L + L_V + (VOFF) + rlo * 128 + (((DB) ^ ((rlo >> 1) & 1)) * 64) + (16 * (g16 & 1) + 4 * tp4) * 2); \
            vhi[(DB) * 4 + ks] = vtr(L + L_V + (VOFF) + rhi * 128 + (((DB) ^ ((rhi >> 1) & 1)) * 64) + (16 * (g16 & 1) + 4 * tp4) * 2); } } while (0)
#define MOBA_QK(CANSKIP, TT, P0, P1) do { \
            const int blk_ = (TT) >> 2; \
            if (!((CANSKIP) && (blk_ == qb) && (64 * ((TT) & 3) > 32 * wid + 31))) { \
                const bool sel_ = ((selmask >> blk_) & 1u); \
                float sc0_ = sel_ ? (-mhat - sl2 * (float)(tq - 64 * (TT) - 4 * hi)) : NEG_BIG; asm volatile("" : "+v"(sc0_)); \
_Pragma("unroll") \
                for (int r = 0; r < 16; ++r) { P0[r] = __builtin_fmaf(sl2, (float)((r & 3) + 8 * (r >> 2)), sc0_); P1[r] = __builtin_fmaf(sl2, (float)(32 + (r & 3) + 8 * (r >> 2)), sc0_); } \
_Pragma("unroll") \
                for (int d0 = 0; d0 < 4; ++d0) { \
                    P0 = __builtin_amdgcn_mfma_f32_32x32x16_bf16(kfr[2 * d0], FIXREF ? qr[d0] : qf_[d0], P0, 0, 0, 0); \
                    P1 = __builtin_amdgcn_mfma_f32_32x32x16_bf16(kfr[2 * d0 + 1], FIXREF ? qr[d0] : qf_[d0], P1, 0, 0, 0); } \
            } } while (0)
#define MOBA_SM(OWNP, TT, P0, P1, HAVE_NEXT, N0, N1) do { \
            const bool own = (OWNP); const int jb = (TT) & 3; \
            if (!(own && (64 * jb > 32 * wid + 31))) { \
                if (own && (64 * jb + 63 > 32 * wid)) { \
_Pragma("unroll") \
                    for (int r = 0; r < 16; ++r) { const int kvl = 64 * jb + crow(r, hi); if (kvl > qrel) P0[r] = NEG_BIG; if (kvl + 32 > qrel) P1[r] = NEG_BIG; } } \
                if (!FIXREF) { \
                float rm = max3f(P0[0], P1[0], P0[1]), rm2 = max3f(P1[1], P0[2], P1[2]); \
_Pragma("unroll") \
                for (int r = 3; r < 15; r += 2) { rm = max3f(rm, P0[r], P1[r]); rm2 = max3f(rm2, P0[r + 1], P1[r + 1]); } \
                rm = max3f(rm, rm2, fmaxf(P0[15], P1[15])); \
                { auto rr = __builtin_amdgcn_permlane32_swap(__float_as_uint(rm), __float_as_uint(rm), false, false); rm = fmaxf(__uint_as_float(rr[0]), __uint_as_float(rr[1])); } \
                if (__any(rm > THR)) { \
                    const float dl = fmaxf(rm, 0.f); mhat += dl; \
_Pragma("unroll") \
                    for (int r = 0; r < 16; ++r) { P0[r] -= dl; P1[r] -= dl; } \
                    if (HAVE_NEXT) { \
_Pragma("unroll") \
                        for (int r = 0; r < 16; ++r) { N0[r] -= dl; N1[r] -= dl; } } \
                    const float f = __builtin_amdgcn_exp2f(-dl); l_reg *= f; \
                    if (hi == 0) wsf[r32] = f; \
_Pragma("unroll") \
                    for (int r = 0; r < 16; ++r) { const float fr = wsf[crow(r, hi)]; o[0][r] *= fr; o[1][r] *= fr; } } \
                } \
                float sacc = 0.f, sacc2 = 0.f; \
_Pragma("unroll") \
                for (int r = 0; r < 16; ++r) { P0[r] = __builtin_amdgcn_exp2f(P0[r]); P1[r] = __builtin_amdgcn_exp2f(P1[r]); sacc += P0[r]; sacc2 += P1[r]; } \
                l_reg += sacc + sacc2; \
                { v4u w; \
_Pragma("unroll") \
                    for (int ks = 0; ks < 4; ++ks) { \
_Pragma("unroll") \
                        for (int e = 0; e < 4; ++e) { const int rb = (ks & 1) * 8 + 2 * e; w[e] = (ks < 2) ? cvtpk(P0[rb], P0[rb + 1]) : cvtpk(P1[rb], P1[rb + 1]); } \
                        pa[ks] = __builtin_bit_cast(bf16x8, w); } } \
            } } while (0)
#define MOBA_PV(OWNP, TT) do { \
            if (!((OWNP) && (64 * ((TT) & 3) > 32 * wid + 31))) { \
_Pragma("unroll") \
                for (int dblk = 0; dblk < 2; ++dblk) \
_Pragma("unroll") \
                    for (int ks = 0; ks < 4; ++ks) { \
                        const s16x4 lo = vlo[dblk * 4 + ks], hh = vhi[dblk * 4 + ks]; \
                        const bf16x8 vf = __builtin_shufflevector(lo, hh, 0, 1, 2, 3, 4, 5, 6, 7); \
                        o[dblk] = __builtin_amdgcn_mfma_f32_32x32x16_bf16(pa[ks], vf, o[dblk], 0, 0, 0); } \
            } } while (0)
        f32x16 pA0, pA1, pB0, pB1; bf16x8 kfr[8], qf_[4], pa[4]; s16x4 vlo[8], vhi[8];
        MOBA_KLOAD(0); MOBA_QK(true, t0, pA0, pA1);
        int c0o = 0;
#define MOBA_ILV() do { __builtin_amdgcn_sched_group_barrier(0x002, 16, 0); \
_Pragma("unroll") \
            for (int g_ = 0; g_ < 8; ++g_) { __builtin_amdgcn_sched_group_barrier(0x008, 1, 0); __builtin_amdgcn_sched_group_barrier(0x002, 12, 0); } } while (0)
#define MOBA_STEP2(OWNP) do { \
            const int c1o = (c0o + 1) & 3, c2o = (c0o + 2) & 3, c3o = (c0o + 3) & 3; \
            if (!(OWNP) || t + 3 < NT) MOBA_ISSUE(t + 3, c3o); \
            if (FIXREF) { MOBA_KLOAD(c1o * 8192); __builtin_amdgcn_sched_barrier(0); \
                MOBA_QK(OWNP, t + 1, pB0, pB1); MOBA_SM(OWNP, t, pA0, pA1, false, pB0, pB1); if (!(OWNP)) MOBA_ILV(); __builtin_amdgcn_sched_barrier(0); \
                MOBA_VLOAD(c0o * 8192); __builtin_amdgcn_sched_barrier(0); MOBA_PV(OWNP, t); } \
            else { MOBA_KLOAD(c1o * 8192); __builtin_amdgcn_sched_barrier(0); MOBA_QK(true, t + 1, pB0, pB1); __builtin_amdgcn_sched_barrier(0); \
                MOBA_VLOAD(c0o * 8192); __builtin_amdgcn_sched_barrier(0); MOBA_SM(OWNP, t, pA0, pA1, true, pB0, pB1); MOBA_PV(OWNP, t); } \
            if (!(OWNP) || t + 3 < NT) asm volatile("s_waitcnt vmcnt(2)" ::: "memory"); else asm volatile("s_waitcnt vmcnt(0)" ::: "memory"); \
            __syncthreads(); \
            if (!(OWNP) || t + 4 < NT) MOBA_ISSUE(t + 4, c0o); \
            if (FIXREF) { if (!(OWNP) || t + 2 < NT) MOBA_KLOAD(c2o * 8192); __builtin_amdgcn_sched_barrier(0); \
                if (!(OWNP) || t + 2 < NT) MOBA_QK(OWNP, t + 2, pA0, pA1); MOBA_SM(OWNP, t + 1, pB0, pB1, false, pA0, pA1); if (!(OWNP)) MOBA_ILV(); __builtin_amdgcn_sched_barrier(0); \
                MOBA_VLOAD(c1o * 8192); __builtin_amdgcn_sched_barrier(0); MOBA_PV(OWNP, t + 1); } \
            else { if (t + 2 < NT) { MOBA_KLOAD(c2o * 8192); __builtin_amdgcn_sched_barrier(0); MOBA_QK(true, t + 2, pA0, pA1); __builtin_amdgcn_sched_barrier(0); } \
                MOBA_VLOAD(c1o * 8192); __builtin_amdgcn_sched_barrier(0); MOBA_SM(OWNP, t + 1, pB0, pB1, (t + 2 < NT), pA0, pA1); MOBA_PV(OWNP, t + 1); } \
            if (!(OWNP) || t + 4 < NT) asm volatile("s_waitcnt vmcnt(2)" ::: "memory"); else asm volatile("s_waitcnt vmcnt(0)" ::: "memory"); \
            __syncthreads(); \
            c0o = c2o; } while (0)
        int t = t0;
        for (; t < NT - 4; t += 2) MOBA_STEP2(false);
        for (; t < NT; t += 2) MOBA_STEP2(true);
#undef MOBA_STEP2
#undef MOBA_ISSUE
#undef MOBA_KLOAD
#undef MOBA_KLOADH
#undef MOBA_VLOAD
#undef MOBA_VLOADH
#undef MOBA_QK
#undef MOBA_SM
#undef MOBA_PV
        int lane_e = lane; asm volatile("" : "+v"(lane_e));
        const int r32e = lane_e & 31, hie = lane_e >> 5;
        v4u gwv[4];
#pragma unroll
        for (int i = 0; i < 4; ++i) gwv[i] = *(const GAS v4u*)(F.GA + (rowbase + q0 + wid * 32 + i * 8 + (lane_e >> 3)) * 512 + h * 64 + (lane_e & 7) * 8);
        { auto rr = __builtin_amdgcn_permlane32_swap(__float_as_uint(l_reg), __float_as_uint(l_reg), false, false); l_reg = __uint_as_float(rr[0]) + __uint_as_float(rr[1]); }
        if (hie == 0) wsf[r32e] = 1.0f / l_reg;
#pragma unroll
        for (int r = 0; r < 16; ++r) { const float rl = wsf[crow(r, hie)]; ost[crow(r, hie) * 64 + r32e] = o[0][r] * rl; ost[crow(r, hie) * 64 + 32 + r32e] = o[1][r] * rl; }
#pragma unroll
        for (int i = 0; i < 4; ++i) { const int row = i * 8 + (lane_e >> 3), ch = lane_e & 7;
            const f32x4 a = *(const LAS f32x4*)(ost + row * 64 + ch * 8), c2 = *(const LAS f32x4*)(ost + row * 64 + ch * 8 + 4);
            const size_t grow = rowbase + q0 + wid * 32 + row;
            const v4u gw = gwv[i];
            v4u ow; ow.x = pk2(a[0] * bflo(gw.x), a[1] * bfhi(gw.x)); ow.y = pk2(a[2] * bflo(gw.y), a[3] * bfhi(gw.y));
            ow.z = pk2(c2[0] * bflo(gw.z), c2[1] * bfhi(gw.z)); ow.w = pk2(c2[2] * bflo(gw.w), c2[3] * bfhi(gw.w));
            *(GAS v4u*)(F.MIXED + grow * DM + 512 + h * 64 + ch * 8) = ow; }
    }
    __syncthreads();
}


__device__ __forceinline__ void moba_mfma_phase(Frame& F, int l) {
    float gq = 0.f, gk = 0.f;
    for (int i = 0; i < 64; ++i) { gq = fmaxf(gq, fabsf(F.q_norm_w[l * 64 + i])); gk = fmaxf(gk, fabsf(F.k_norm_w[l * 64 + i])); }
    if (2.0f * (8.0f * gq * gk * LOG2E * 1.02f) + 1.0f <= 100.0f) moba_mfma_body<true>(F, l); else moba_mfma_body<false>(F, l);
}

namespace hg {
typedef short bf16x8 __attribute__((ext_vector_type(8)));
typedef short s16x4 __attribute__((ext_vector_type(4)));
typedef float f32x4 __attribute__((ext_vector_type(4)));
typedef unsigned u32x2 __attribute__((ext_vector_type(2)));
constexpr int SLOT = 33792, NSLOT = 4;
constexpr int L_SC = NSLOT * SLOT, L_NRM = L_SC + 4096;
constexpr int NSTEP = SEQ / 32;
__device__ __forceinline__ int fsw(int t) { return ((t & 7) << 2) | (((t >> 3) & 1) << 1); }
__device__ __forceinline__ int unit_off(int tok, int cg) { return 8 * (32 * tok + (cg ^ fsw(tok))); }
__device__ __forceinline__ s16x4 rd64(const LAS unsigned char* p) { return *(const LAS s16x4*)p; }
__device__ __forceinline__ s16x4 vtr(const LAS unsigned char* p) { return __builtin_bit_cast(s16x4, __builtin_amdgcn_ds_read_tr16_b64_v4i16((LAS s16x4*)p)); }
__device__ __forceinline__ bf16x8 cat(s16x4 a, s16x4 b) { return __builtin_shufflevector(a, b, 0, 1, 2, 3, 4, 5, 6, 7); }
__device__ __forceinline__ s16x4 pack4(f32x4 v) { u32x2 w; w.x = moba::cvtpk(v[0], v[1]); w.y = moba::cvtpk(v[2], v[3]); return __builtin_bit_cast(s16x4, w); }
__device__ __forceinline__ void glds16(const GAS void* gsrc, unsigned lds_dst) { unsigned keep;
    asm volatile("s_mov_b32 %0, m0\n\ts_mov_b32 m0, %2\n\ts_nop 0\n\tglobal_load_lds_dwordx4 %1, off\n\ts_mov_b32 m0, %0" : "=&s"(keep) : "v"(gsrc), "s"(lds_dst) : "memory"); }
__device__ __forceinline__ void glds16s(unsigned voff, const void* sbase, unsigned lds_dst) { unsigned keep;
    asm volatile("s_mov_b32 %0, m0\n\ts_mov_b32 m0, %3\n\ts_nop 0\n\tglobal_load_lds_dwordx4 %1, %2 nt\n\ts_mov_b32 m0, %0" : "=&s"(keep) : "v"(voff), "s"(sbase), "s"(lds_dst) : "memory"); }
#define HG_MFMA(a, b, c) __builtin_amdgcn_mfma_f32_16x16x32_bf16((a), (b), (c), 0, 0, 0)
}

__device__ __forceinline__ void hgrn_mfma_phase(Frame& F, int l) {
    using namespace hg;
    PHASE_IDS();
    const int w = wave, c16 = lane & 15, g = lane >> 4;
    LAS unsigned char* L = F.lds + RING_OFF;
    const s16x4 z4 = (s16x4){0, 0, 0, 0};
    for (int it = (int)blockIdx.x; it < 64; it += F.G) {
        const int b = it >> 2, h = it & 3; const size_t rowbase = (size_t)b * SEQ;
        const int da = w >> 1;
        unsigned dsrc[4];
#pragma unroll
        for (int i = 0; i < 4; ++i) { const int t = 16 * (w & 1) + 4 * i + (lane >> 4); const int sc = (lane & 15) ^ (fsw(t) >> 1);
            dsrc[i] = (unsigned)((((size_t)da * MTOK + rowbase + t) * 512 + h * 128 + 8 * sc) * 2); }
        const unsigned ddec = (unsigned)((((size_t)b * NSTEP) * 512 + h * 128 + 4 * lane) * 4);
        const int ddst = da * 8192 + (w & 1) * 4096;
        const unsigned lds0 = (unsigned)(uintptr_t)(F.lds + RING_OFF);
#define HG_ISSUE(step) do { const unsigned so_ = lds0 + (unsigned)(((step) & 3) * SLOT); \
            _Pragma("unroll") for (int i = 0; i < 4; ++i) \
                glds16s(dsrc[i], (const void*)((const char*)F.QI + (size_t)(step) * (32 * 512 * 2)), (unsigned)__builtin_amdgcn_readfirstlane((int)(so_ + ddst + i * 1024))); \
            if (w == 0) glds16s(ddec, (const void*)((const char*)F.DEC + (size_t)(step) * 2048), (unsigned)__builtin_amdgcn_readfirstlane((int)(so_ + 32768))); } while (0)
        f32x4 S[8]; bf16x8 Sb[4];
#pragma unroll
        for (int tk = 0; tk < 8; ++tk) S[tk] = (f32x4){0.f, 0.f, 0.f, 0.f};
#pragma unroll
        for (int ks = 0; ks < 4; ++ks) Sb[ks] = (bf16x8){0, 0, 0, 0, 0, 0, 0, 0};
        f32x4 oprev[2]; oprev[0] = (f32x4){0.f, 0.f, 0.f, 0.f}; oprev[1] = oprev[0];
        u32x2 gprev[2]; gprev[0] = (u32x2){0u, 0u}; gprev[1] = gprev[0];
        float hw[4];
#pragma unroll
        for (int r = 0; r < 4; ++r) hw[r] = F.hg_norm_w[l * 128 + 16 * w + 4 * g + r];
        asm volatile("" : "+v"(hw[0]), "+v"(hw[1]), "+v"(hw[2]), "+v"(hw[3]));
        LAS float* nrm = (LAS float*)(L + L_NRM);
        LAS unsigned char* SC = L + L_SC;
        HG_ISSUE(0); HG_ISSUE(1); HG_ISSUE(2);
        asm volatile("s_waitcnt vmcnt(8)\n\ts_barrier" ::: "memory");
        const int trq = c16 >> 2, trp = c16 & 3;
        int ro0 = 256 * c16 + 16 * (g ^ (fsw(c16) >> 1)), ko0 = 256 * (4 * g + trq) + 16 * (trp ^ (fsw(4 * g + trq) >> 1));
#define RO(ks) (ro0 ^ (64 * (ks)))
#define KO(tk) (ko0 ^ (64 * ((tk) >> 1) + 8 * ((tk) & 1)))
        const int io_ = unit_off(4 * g + trq, 4 * w + trp), go_ = unit_off(c16, 4 * w + g);
        bf16x8 qf[2][4];
#define HG_LOADQ(slotbase) do { _Pragma("unroll") for (int tt = 0; tt < 2; ++tt) _Pragma("unroll") for (int ks = 0; ks < 4; ++ks) \
            qf[tt][ks] = *(const LAS bf16x8*)((slotbase) + RO(ks) + 4096 * tt); } while (0)
#define HG_FINAL(step, P) do { _Pragma("unroll") for (int tt = 0; tt < 2; ++tt) { \
            const float ssum = ((P[tt][0] + P[tt][1]) + (P[tt][2] + P[tt][3])) + ((P[tt][4] + P[tt][5]) + (P[tt][6] + P[tt][7])); \
            const float rstd = __builtin_amdgcn_rsqf(ssum * (1.0f / 128.0f) + NORM_EPS); \
            u32x2 wv; wv.x = moba::cvtpk(oprev[tt][0] * rstd * hw[0] * bflo(gprev[tt].x), oprev[tt][1] * rstd * hw[1] * bfhi(gprev[tt].x)); \
            wv.y = moba::cvtpk(oprev[tt][2] * rstd * hw[2] * bflo(gprev[tt].y), oprev[tt][3] * rstd * hw[3] * bfhi(gprev[tt].y)); \
            *(GAS u32x2*)(F.MIXED + (rowbase + (size_t)(step) * 32 + 16 * tt + c16) * DM + h * 128 + 16 * w + 4 * g) = wv; } } while (0)
        HG_LOADQ(L);
        for (int n = 0; n < NSTEP; ++n) {
            asm volatile("" : "+v"(ro0), "+v"(ko0));
            if (n + 3 < NSTEP) HG_ISSUE(n + 3);
            const LAS unsigned char* Qs = L + (n & 3) * SLOT; const LAS unsigned char* Ks = Qs + 8192; const LAS unsigned char* Is = Qs + 16384; const LAS unsigned char* Gs = Qs + 24576;
            const LAS float* Ds = (const LAS float*)(Qs + 32768);
            LAS unsigned char* SCn = SC + (n & 1) * 1536;
            bf16x8 kf[4];
            if (w < 3) { const int st = (w == 2) ? 1 : 0;
#pragma unroll
                for (int ks = 0; ks < 4; ++ks) kf[ks] = *(const LAS bf16x8*)(Ks + RO(ks) + 4096 * st); }
            u32x2 gcur[2];
#pragma unroll
            for (int tt = 0; tt < 2; ++tt) gcur[tt] = *(const LAS u32x2*)(Gs + go_ + 4096 * tt);
            s16x4 itr[2];
#pragma unroll
            for (int st = 0; st < 2; ++st) itr[st] = vtr(Is + io_ + 4096 * st);
            const bf16x8 i01 = cat(itr[0], itr[1]);
            bf16x8 k01[4]; f32x4 dv4[4];
#pragma unroll
            for (int tk = 0; tk < 4; ++tk) { k01[tk] = cat(vtr(Ks + KO(tk)), vtr(Ks + KO(tk) + 4096)); dv4[tk] = *(const LAS f32x4*)(Ds + 16 * tk + 4 * g); }
            f32x4 o[2];
#pragma unroll
            for (int tt = 0; tt < 2; ++tt) { f32x4 a = (f32x4){0.f, 0.f, 0.f, 0.f};
#pragma unroll
                for (int ks = 0; ks < 4; ++ks) a = HG_MFMA(Sb[ks], qf[tt][ks], a);
                o[tt] = a; }
            if (w < 3) { f32x4 sc = (f32x4){0.f, 0.f, 0.f, 0.f};
                if (w == 0) {
#pragma unroll
                    for (int ks = 0; ks < 4; ++ks) sc = HG_MFMA(kf[ks], qf[0][ks], sc);
                } else {
#pragma unroll
                    for (int ks = 0; ks < 4; ++ks) sc = HG_MFMA(kf[ks], qf[1][ks], sc); }
                if (w != 1) {
#pragma unroll
                    for (int r = 0; r < 4; ++r) if (4 * g + r > c16) sc[r] = 0.f; }
                *(LAS s16x4*)(SCn + w * 512 + lane * 8) = pack4(sc); }
#pragma unroll
            for (int tk = 0; tk < 4; ++tk) S[tk] = HG_MFMA(k01[tk], i01, S[tk]);
            asm volatile("" ::: "memory");
            { bf16x8 k2[4]; f32x4 d2[4];
#pragma unroll
                for (int tk = 0; tk < 4; ++tk) { k2[tk] = cat(vtr(Ks + KO(tk + 4)), vtr(Ks + KO(tk + 4) + 4096)); d2[tk] = *(const LAS f32x4*)(Ds + 16 * (tk + 4) + 4 * g); }
#pragma unroll
                for (int tk = 0; tk < 4; ++tk) S[tk] = S[tk] * dv4[tk];
#pragma unroll
                for (int ks = 0; ks < 2; ++ks) Sb[ks] = cat(pack4(S[2 * ks]), pack4(S[2 * ks + 1]));
#pragma unroll
                for (int tk = 0; tk < 4; ++tk) S[tk + 4] = HG_MFMA(k2[tk], i01, S[tk + 4]);
#pragma unroll
                for (int tk = 0; tk < 4; ++tk) S[tk + 4] = S[tk + 4] * d2[tk];
#pragma unroll
                for (int ks = 2; ks < 4; ++ks) Sb[ks] = cat(pack4(S[2 * ks]), pack4(S[2 * ks + 1])); }
            if (n >= NSTEP - 3) asm volatile("s_waitcnt vmcnt(0) lgkmcnt(0)\n\ts_barrier" ::: "memory");
            else if (n <= 1) asm volatile("s_waitcnt vmcnt(8) lgkmcnt(0)\n\ts_barrier" ::: "memory");
            else if (n == 2) asm volatile("s_waitcnt vmcnt(10) lgkmcnt(0)\n\ts_barrier" ::: "memory");
            else asm volatile("s_waitcnt vmcnt(12) lgkmcnt(0)\n\ts_barrier" ::: "memory");
            const s16x4 sc00 = rd64(SCn + lane * 8), sc01 = rd64(SCn + 512 + lane * 8), sc11 = rd64(SCn + 1024 + lane * 8);
            float pn[2][8];
            if (n > 0) {
#pragma unroll
                for (int tt = 0; tt < 2; ++tt)
#pragma unroll
                    for (int ww = 0; ww < 8; ++ww) pn[tt][ww] = nrm[((n - 1) & 1) * 256 + ww * 32 + 16 * tt + c16]; }
            if (n + 1 < NSTEP) HG_LOADQ(L + ((n + 1) & 3) * SLOT);
            o[0] = HG_MFMA(cat(itr[0], z4), cat(sc00, z4), o[0]);
            o[1] = HG_MFMA(i01, cat(sc01, sc11), o[1]);
            { float ss0 = (o[0][0] * o[0][0] + o[0][1] * o[0][1]) + (o[0][2] * o[0][2] + o[0][3] * o[0][3]);
              float ss1 = (o[1][0] * o[1][0] + o[1][1] * o[1][1]) + (o[1][2] * o[1][2] + o[1][3] * o[1][3]);
              { auto r0 = __builtin_amdgcn_permlane16_swap(__float_as_uint(ss0), __float_as_uint(ss0), false, false); auto r1 = __builtin_amdgcn_permlane16_swap(__float_as_uint(ss1), __float_as_uint(ss1), false, false);
                ss0 = __uint_as_float(r0[0]) + __uint_as_float(r0[1]); ss1 = __uint_as_float(r1[0]) + __uint_as_float(r1[1]); }
              { auto r0 = __builtin_amdgcn_permlane32_swap(__float_as_uint(ss0), __float_as_uint(ss0), false, false); auto r1 = __builtin_amdgcn_permlane32_swap(__float_as_uint(ss1), __float_as_uint(ss1), false, false);
                ss0 = __uint_as_float(r0[0]) + __uint_as_float(r0[1]); ss1 = __uint_as_float(r1[0]) + __uint_as_float(r1[1]); }
              if (g == 0) { nrm[(n & 1) * 256 + w * 32 + c16] = ss0; nrm[(n & 1) * 256 + w * 32 + 16 + c16] = ss1; } }
            if (n > 0) HG_FINAL(n - 1, pn);
            oprev[0] = o[0]; oprev[1] = o[1]; gprev[0] = gcur[0]; gprev[1] = gcur[1];
        }
        asm volatile("s_waitcnt vmcnt(0) lgkmcnt(0)\n\ts_barrier" ::: "memory");
        { float pn[2][8];
#pragma unroll
            for (int tt = 0; tt < 2; ++tt)
#pragma unroll
                for (int ww = 0; ww < 8; ++ww) pn[tt][ww] = nrm[((NSTEP - 1) & 1) * 256 + ww * 32 + 16 * tt + c16];
            HG_FINAL(NSTEP - 1, pn); }
        asm volatile("s_waitcnt vmcnt(0) lgkmcnt(0)\n\ts_barrier" ::: "memory");
#undef RO
#undef KO
#undef HG_LOADQ
#undef HG_FINAL
#undef HG_ISSUE
    }
}

struct Args { const float* in[8]; float* out; unsigned char* ws; int ph_lo, ph_hi, li, pad; };
__global__ void __launch_bounds__(NWAVES * 64, 2) fwd(Args args) {
    extern __shared__ __attribute__((aligned(16))) unsigned char lds[];
    Frame F;
    F.lds = (LAS unsigned char*)lds;
    F.MISC = (volatile LAS unsigned*)(F.lds + MISC_OFF);
    F.G = gridDim.x; { const int bx = blockIdx.x; F.vcu = (F.G % 8 == 0) ? (bx % 8) * (F.G / 8) + bx / 8 : bx; }
    unsigned char* ws = args.ws;
    F.ctl = (gu32*)(ws + WS_CTL);
    F.x = args.in[0]; F.norm_w = args.in[1]; F.w_in = args.in[2]; F.lb_logits = args.in[3]; F.hg_norm_w = args.in[4]; F.q_norm_w = args.in[5]; F.k_norm_w = args.in[6]; F.w_out = args.in[7];
    F.out = args.out;
    F.WIN = (bf16*)(ws + WS_WIN); F.WOUT = (bf16*)(ws + WS_WOUT); F.XB = (bf16*)(ws + WS_XB); F.MIXED = (bf16*)(ws + WS_MIXED);
    F.QI = (bf16*)(ws + WS_ARR); F.KT = (bf16*)(ws + WS_ARR + ARR_BYTES); F.HI = (bf16*)(ws + WS_ARR + 2 * ARR_BYTES); F.GH = (bf16*)(ws + WS_ARR + 3 * ARR_BYTES);
    F.QN = (bf16*)(ws + WS_ARR + 4 * ARR_BYTES); F.KN = (bf16*)(ws + WS_ARR + 5 * ARR_BYTES); F.V = (bf16*)(ws + WS_ARR + 6 * ARR_BYTES); F.GA = (bf16*)(ws + WS_ARR + 7 * ARR_BYTES);
    F.LB = (float*)(ws + WS_LB); F.KPART = (float*)(ws + WS_KPART); F.ROWSS = (float*)(ws + WS_ROWSS); F.DEC = (float*)(ws + WS_DEC);
    F.wave0 = __builtin_amdgcn_readfirstlane((int)threadIdx.x >> 6);
    for (int u = F.wave0 * 64 + lane_id_asm(); u < (LDS_BYTES - LDSCTL_OFF) / 4; u += NWAVES * 64) ((LAS unsigned*)(F.lds + LDSCTL_OFF))[u] = 0u;
    __syncthreads();
    XcdBarrier bar; bar.bar = (unsigned*)(F.ctl + CW_BAR); bar.x = 0; bar.st = nullptr; bar.wave0 = F.wave0;
    if (N_LAUNCHES == 1) bar = xcd_barrier_post((unsigned*)(F.ctl + CW_BAR), F.MISC + 8, F.wave0);
#define GRID_BAR() do { if (N_LAUNCHES == 1) xcd_barrier(bar); } while (0)
    const int lo = (N_LAUNCHES == 1) ? 0 : args.ph_lo, hi = (N_LAUNCHES == 1) ? N_PHASES : args.ph_hi;
#define IN(k) (lo <= (k) && (k) < hi)
#define BOTH(k) (IN(k) && IN((k) + 1))

    if (IN(0)) { p0_prologue(F); if (BOTH(0)) GRID_BAR(); }
    for (int l = 0; l < DEPTH; ++l) {
        const int pb = 1 + 3 * l;
        if (IN(pb)) {
            pg8::Gemm g{F.XB + (size_t)l * MTOK * DM, F.WIN + (size_t)l * NIN * DM, MTOK, NIN, DM}; pg8::StaticOrder S; S.init(MTOK, NIN, F.G, (int)blockIdx.x, (int)(blockIdx.x & 7));
            pg8::EpiFused E{F.QI, F.DEC, F.KPART, F.ROWSS + (size_t)l * MTOK * 16, F.LB + l * 512, F.q_norm_w + l * 64, F.k_norm_w + l * 64, nullptr, 0};
            {
                pg8::Unit u0{0, 0}, u4{0, 0}, ut; bool two = S.next(0, u0) && S.next(4, u4);
                for (int i = 0; two && S.next(i, ut); ++i) two = (ut.pm == u0.pm || ut.pm == u4.pm);
                if (two) { LAS float* rt = (LAS float*)(F.lds + EXTRA_OFF); int t_ = F.wave0 * 64 + lane_id_asm(); asm volatile("" : "+v"(t_));
                    rt[t_] = pg8::EpiFused::rstd_global(E.rowss, ((t_ >> 8) ? u4.pm : u0.pm) * 256 + (t_ & 255));
                    E.rtab = rt; E.pm0 = u0.pm; __syncthreads(); } }
            for (int rp = 0; rp < REP_PROJ; ++rp) { if (rp) GRID_BAR(); pg8::gemm_phase<pg8::EpiFused, pg8::StaticOrder, true, true>(F.lds + RING_OFF, g, S, E, F.wave0); }
            if (BOTH(pb)) GRID_BAR();
        }
        if (IN(pb + 1)) {
            for (int rp = 0; rp < REP_HGRN; ++rp) { if (rp) GRID_BAR(); hgrn_mfma_phase(F, l); }
            for (int rp = 0; rp < REP_MOBA; ++rp) { if (rp) { GRID_BAR(); if (blockIdx.x == 0 && F.wave0 == 0 && lane_id_asm() == 0) __hip_atomic_store(F.ctl + CW_QUEUE + 64 * l, 0u, RLX_AGENT); GRID_BAR(); } moba_mfma_phase(F, l); }
            if (BOTH(pb + 1)) GRID_BAR(); }
        if (IN(pb + 2)) {
            pg8::Gemm g{F.MIXED, F.WOUT + (size_t)l * DM * DM, MTOK, DM, DM}; pg8::StaticOrder S; S.init(MTOK, DM, F.G, (int)blockIdx.x);
            pg8::EpiOut E{l == 0 ? F.XB : F.XB + (size_t)MTOK * DM, l == 0 ? nullptr : F.out, l == 0 ? F.XB + (size_t)MTOK * DM : nullptr, l == 0 ? F.ROWSS + (size_t)MTOK * 16 : nullptr};
            for (int rp = 0; rp < REP_OUT; ++rp) { if (rp) GRID_BAR(); pg8::gemm_phase<pg8::EpiOut, pg8::StaticOrder, true, true>(F.lds + RING_OFF, g, S, E, F.wave0); }
            if (pb + 2 < N_PHASES - 1 && BOTH(pb + 2)) GRID_BAR();
        }
    }
#undef IN
#undef BOTH
}

extern "C" void kernel_launch(void* const* d_in, const int* in_sizes, int n_in, void* d_out, int out_size, void* d_ws, size_t ws_size, hipStream_t stream) {
    static int grid = 0;
    if (grid == 0) {
        if (n_in != 8 || in_sizes[0] != MTOK * DM || out_size != MTOK * DM || ws_size < WS_END) { fprintf(stderr, "kernel_launch: unexpected shapes n_in %d in0 %d out %d ws %zu\n", n_in, n_in > 0 ? in_sizes[0] : -1, out_size, ws_size); grid = -1; return; }
        int dev = 0, cus = 0, per_cu = 0;
        if (hipGetDevice(&dev) != hipSuccess || hipDeviceGetAttribute(&cus, hipDeviceAttributeMultiprocessorCount, dev) != hipSuccess) { grid = -1; return; }
        if (hipFuncSetAttribute((const void*)fwd, hipFuncAttributeMaxDynamicSharedMemorySize, LDS_BYTES) != hipSuccess) { fprintf(stderr, "kernel_launch: hipFuncSetAttribute failed\n"); grid = -1; return; }
        if (hipOccupancyMaxActiveBlocksPerMultiprocessor(&per_cu, (const void*)fwd, NWAVES * 64, LDS_BYTES) != hipSuccess || per_cu < 1) fprintf(stderr, "kernel_launch: occupancy query says %d\n", per_cu);
        (void)hipGetLastError();
        if (per_cu < 1) { grid = -1; return; }
        grid = cus < 512 ? cus : 512;
    }
    if (grid < 0) return;
    if (hipMemsetAsync((char*)d_ws + WS_CTL, 0, CTL_ZERO_BYTES, stream) != hipSuccess) return;
    Args a{};
    for (int i = 0; i < 8; ++i) a.in[i] = (const float*)d_in[i];
    a.out = (float*)d_out; a.ws = (unsigned char*)d_ws;
    for (int li = 0; li < N_LAUNCHES; ++li) {
        a.ph_lo = (N_LAUNCHES == 1) ? 0 : li; a.ph_hi = (N_LAUNCHES == 1) ? N_PHASES : li + 1; a.li = li;
        hipError_t le;
        if (N_LAUNCHES == 1) { void* kargs[] = {(void*)&a}; le = hipLaunchCooperativeKernel((const void*)fwd, dim3(grid), dim3(NWAVES * 64), kargs, LDS_BYTES, stream); }
        else { hipLaunchKernelGGL(fwd, dim3(grid), dim3(NWAVES * 64), LDS_BYTES, stream, a); le = hipPeekAtLastError(); }
        if (le != hipSuccess) { fprintf(stderr, "kernel_launch: launch %d failed: %s\n", li, hipGetErrorName(le)); break; }
    }
}
```

```cpp
#include <hip/hip_runtime.h>
#include <cstdio>
#include <cstdint>
__device__ __forceinline__ int lane_id_asm() { int l; asm volatile("v_mbcnt_lo_u32_b32 %0, -1, 0\n\tv_mbcnt_hi_u32_b32 %0, -1, %0" : "=v"(l)); return l; }
namespace pg8 {
#define PG8_LAS __attribute__((address_space(3)))
typedef unsigned short bf16_t;
typedef short bf16x8 __attribute__((ext_vector_type(8)));
typedef float f32x4 __attribute__((ext_vector_type(4)));
typedef unsigned u32x4 __attribute__((ext_vector_type(4)));
typedef unsigned u32x2 __attribute__((ext_vector_type(2)));
constexpr int BM = 256, BK = 64, HALF = 128, HTB = HALF * BK * 2  , STAGE_BYTES = 8 * HTB, NXCD = 8, WGM = 8;

__host__ __device__ __forceinline__ int lds_byte(int r, int c) { const int st = (r >> 4) * 2 + (c >> 5), rr = r & 15, cc = c & 31, ob = rr * 64 + cc * 2; return st * 1024 + (ob ^ (((ob >> 9) & 1) << 5)); }
__host__ __device__ __forceinline__ void stage_rc(int b, int& R, int& C) { const int st = b / 1024, sb = b % 1024, swz = sb ^ (((sb >> 9) & 1) << 5); R = (st >> 1) * 16 + swz / 64; C = (st & 1) * 32 + (swz % 64) / 2; }
__host__ __device__ __forceinline__ int perm32(int rho) { const int n = rho >> 4, i = rho & 15; return 8 * (i >> 2) + 4 * n + (i & 3); }

struct Unit { int pm, pn; };
struct Gemm { const bf16_t* A; const bf16_t* Bt; int M, N, K; };

struct StaticOrder {
    int nM, nN, nwg, G, c, rot;
    __host__ __device__ void init(int M, int N, int G_, int c_, int rot_ = 0) { __builtin_assume(c_ >= 0 && c_ < 512);     nM = M / BM; nN = N / BM; nwg = nM * nN; G = G_; c = c_; rot = (nwg == 8 * G_) ? rot_ : 0; }
    __host__ __device__ bool next(int i, Unit& u) const {
        if ((long)i * G + c >= nwg) return false;
        const long L = (long)((i + rot) & (rot ? 7 : -1)) * G + c;
        int wgid = (int)L; { const int q = nwg / NXCD, r = nwg % NXCD, xcd = wgid % NXCD, off = wgid / NXCD; wgid = (xcd < r ? xcd * (q + 1) : r * (q + 1) + (xcd - r) * q) + off; }
        const int nig = WGM * nN, gid = wgid / nig, fm = gid * WGM, gsz = (nM - fm) < WGM ? (nM - fm) : WGM;
        u.pm = fm + ((wgid % nig) % gsz); u.pn = (wgid % nig) / gsz; return true;
    }
    __device__ __forceinline__ void a_ready(const Unit&) const {}
    __device__ __forceinline__ void done(const Unit&) const {}
};

__device__ __forceinline__ unsigned cvt_pk_bf16(float lo, float hi) { unsigned r; asm volatile("v_cvt_pk_bf16_f32 %0, %1, %2" : "=v"(r) : "v"(lo), "v"(hi)); return r; }


__device__ __forceinline__ float dpp_row_shr(float v, int n) {
    const int x = __builtin_bit_cast(int, v);
    int r;
    if (n == 1) r = __builtin_amdgcn_update_dpp(0, x, 0x111, 0xf, 0xf, false);
    else if (n == 2) r = __builtin_amdgcn_update_dpp(0, x, 0x112, 0xf, 0xf, false);
    else if (n == 4) r = __builtin_amdgcn_update_dpp(0, x, 0x114, 0xf, 0xf, false);
    else r = __builtin_amdgcn_update_dpp(0, x, 0x118, 0xf, 0xf, false);
    return __builtin_bit_cast(float, r);
}
__device__ __forceinline__ float dpp_row_shr1(float v, int n) {
    const int x = __builtin_bit_cast(int, v); const int one = 0x3f800000;
    int r;
    if (n == 1) r = __builtin_amdgcn_update_dpp(one, x, 0x111, 0xf, 0xf, false);
    else if (n == 2) r = __builtin_amdgcn_update_dpp(one, x, 0x112, 0xf, 0xf, false);
    else if (n == 4) r = __builtin_amdgcn_update_dpp(one, x, 0x114, 0xf, 0xf, false);
    else r = __builtin_amdgcn_update_dpp(one, x, 0x118, 0xf, 0xf, false);
    return __builtin_bit_cast(float, r);
}
__device__ __forceinline__ float fsig(float z) { return __builtin_amdgcn_rcpf(1.0f + __expf(-z)); }
struct EpiFused {
    static constexpr bool PERM = true, AFTER_DRAIN = false;
    bf16_t* ARR; float* DEC; float* KPART; const float* rowss; const float* lb; const float* qg; const float* kg;
    static constexpr size_t AS = (size_t)32768 * 512;
    const PG8_LAS float* rtab; int pm0;
    __device__ __forceinline__ float rstd_of(int row) const { return rtab ? rtab[(((row >> 8) == pm0) ? 0 : 256) + (row & 255)] : rstd_global(rowss, row); }
    static __device__ __forceinline__ float rstd_global(const float* rowss, int row) {
        const f32x4* rp = (const f32x4*)(rowss + (size_t)row * 16);
        const f32x4 a = rp[0], b = rp[1], c = rp[2], d = rp[3];
        const float ss = ((a[0] + a[1]) + (a[2] + a[3])) + ((b[0] + b[1]) + (b[2] + b[3])) + ((c[0] + c[1]) + (c[2] + c[3])) + ((d[0] + d[1]) + (d[2] + d[3]));
        return 1.0f / sqrtf(ss * (1.0f / 1024.0f) + 1e-6f);
    }
    static __device__ __forceinline__ u32x4 pack8(const float (&v)[8]) { u32x4 w; w.x = cvt_pk_bf16(v[0], v[1]); w.y = cvt_pk_bf16(v[2], v[3]); w.z = cvt_pk_bf16(v[4], v[5]); w.w = cvt_pk_bf16(v[6], v[7]); return w; }
    __device__ __forceinline__ void operator()(const f32x4 (&acc)[2][2][4][2], const Unit& u, int wr, int wc, int fr, int fq) const {
        const int row0 = u.pm * BM + wr * 64 + fr; const int pn = u.pn;
        if (pn < 4) {
            const int cb = pn * 128 + wc * 32 + 8 * fq;
            float lbv[8];
#pragma unroll
            for (int k = 0; k < 8; ++k) lbv[k] = lb[cb + k];
#pragma unroll
            for (int ai = 0; ai < 2; ++ai)
#pragma unroll
                for (int mp = 0; mp < 2; ++mp) { const int row1 = row0 + ai * HALF + mp * 32, row2 = row1 + 16; const float rs1 = rstd_of(row1), rs2 = rstd_of(row2);
                    float qi1[8], kt1[8], qi2[8], kt2[8], dc[8];
#pragma unroll
                    for (int k = 0; k < 8; ++k) {
                        const float zq1 = acc[ai][0][2 * mp][k >> 2][k & 3] * rs1, zf1 = acc[ai][1][2 * mp][k >> 2][k & 3] * rs1;
                        const float zq2 = acc[ai][0][2 * mp + 1][k >> 2][k & 3] * rs2, zf2 = acc[ai][1][2 * mp + 1][k >> 2][k & 3] * rs2;
                        const float f1 = lbv[k] + (1.0f - lbv[k]) * fsig(zf1), f2 = lbv[k] + (1.0f - lbv[k]) * fsig(zf2);
                        float e1 = f1, e2 = f2;
                        e1 *= dpp_row_shr1(e1, 1); e2 *= dpp_row_shr1(e2, 1); e1 *= dpp_row_shr1(e1, 2); e2 *= dpp_row_shr1(e2, 2);
                        e1 *= dpp_row_shr1(e1, 4); e2 *= dpp_row_shr1(e2, 4); e1 *= dpp_row_shr1(e1, 8); e2 *= dpp_row_shr1(e2, 8);
                        e2 *= __shfl(e1, (fq << 4) | 15);
                        qi1[k] = zq1 * fsig(zq1) * e1; kt1[k] = (1.0f - f1) * fminf(__builtin_amdgcn_rcpf(e1), 5.5406224e34f);
                        qi2[k] = zq2 * fsig(zq2) * e2; kt2[k] = (1.0f - f2) * fminf(__builtin_amdgcn_rcpf(e2), 5.5406224e34f); dc[k] = e2; }
                    { const int pc = pn * 128 + wc * 32 + 16 * (fq & 1) + 4 * (fq >> 1);
                      const u32x4 a1 = pack8(qi1), b1 = pack8(kt1), a2 = pack8(qi2), b2 = pack8(kt2);
                      bf16_t* q1 = ARR + (size_t)row1 * 512 + pc; bf16_t* q2 = ARR + (size_t)row2 * 512 + pc;
                      *(u32x2*)(q1) = (u32x2){a1.x, a1.y}; *(u32x2*)(q1 + 8) = (u32x2){a1.z, a1.w}; *(u32x2*)(q1 + AS) = (u32x2){b1.x, b1.y}; *(u32x2*)(q1 + AS + 8) = (u32x2){b1.z, b1.w};
                      *(u32x2*)(q2) = (u32x2){a2.x, a2.y}; *(u32x2*)(q2 + 8) = (u32x2){a2.z, a2.w}; *(u32x2*)(q2 + AS) = (u32x2){b2.x, b2.y}; *(u32x2*)(q2 + AS + 8) = (u32x2){b2.z, b2.w}; }
                    if (fr == 15) { float* dp = DEC + (size_t)(row1 >> 5) * 512 + cb; *(f32x4*)dp = (f32x4){dc[0], dc[1], dc[2], dc[3]}; *(f32x4*)(dp + 4) = (f32x4){dc[4], dc[5], dc[6], dc[7]}; }
                    asm volatile("" ::: "memory"); }
        } else if (pn < 8) {
            const int cb = (pn - 4) * 128 + wc * 32 + 8 * fq;
#pragma unroll
            for (int ai = 0; ai < 2; ++ai)
#pragma unroll
                for (int m = 0; m < 4; ++m) { const int row = row0 + ai * HALF + m * 16; const float rs = rstd_of(row);
                    float iv[8], gv[8];
#pragma unroll
                    for (int k = 0; k < 8; ++k) { iv[k] = acc[ai][0][m][k >> 2][k & 3] * rs; const float zg = acc[ai][1][m][k >> 2][k & 3] * rs; gv[k] = zg * fsig(zg); }
                    *(u32x4*)(ARR + 2 * AS + (size_t)row * 512 + cb) = pack8(iv); *(u32x4*)(ARR + 3 * AS + (size_t)row * 512 + cb) = pack8(gv);
                    asm volatile("" ::: "memory"); }
        } else {
            const int ty = (pn - 8) >> 1, head = 4 * ((pn - 8) & 1) + wc; const int d0 = 8 * fq;
            bf16_t* dst = ARR + (size_t)(4 + ty) * AS;
            float gain[2][8]; float csum[2][8];
#pragma unroll
            for (int bj = 0; bj < 2; ++bj)
#pragma unroll
                for (int k = 0; k < 8; ++k) { gain[bj][k] = (ty == 0) ? qg[bj * 32 + d0 + k] * (0.125f * 1.4426950408889634f) : (ty == 1) ? kg[bj * 32 + d0 + k] : 1.0f; csum[bj][k] = 0.f; }
#pragma unroll
            for (int ai = 0; ai < 2; ++ai)
#pragma unroll
                for (int m = 0; m < 4; ++m) { const int row = row0 + ai * HALF + m * 16; const float rs = rstd_of(row);
                    float v[2][8];
#pragma unroll
                    for (int bj = 0; bj < 2; ++bj)
#pragma unroll
                        for (int k = 0; k < 8; ++k) v[bj][k] = acc[ai][bj][m][k >> 2][k & 3] * rs;
                    if (ty < 2) { float ss = 0.f;
#pragma unroll
                        for (int bj = 0; bj < 2; ++bj)
#pragma unroll
                            for (int k = 0; k < 8; ++k) ss += v[bj][k] * v[bj][k];
                        ss += __shfl_xor(ss, 16); ss += __shfl_xor(ss, 32);
                        const float r2 = 1.0f / sqrtf(ss * (1.0f / 64.0f) + 1e-6f);
#pragma unroll
                        for (int bj = 0; bj < 2; ++bj)
#pragma unroll
                            for (int k = 0; k < 8; ++k) { v[bj][k] *= r2 * gain[bj][k]; csum[bj][k] += v[bj][k]; }
                    } else if (ty == 3) {
#pragma unroll
                        for (int bj = 0; bj < 2; ++bj)
#pragma unroll
                            for (int k = 0; k < 8; ++k) v[bj][k] = v[bj][k] * fsig(v[bj][k]); }
                    *(u32x4*)(dst + (size_t)row * 512 + head * 64 + d0) = pack8(v[0]); *(u32x4*)(dst + (size_t)row * 512 + head * 64 + 32 + d0) = pack8(v[1]);
                    asm volatile("" ::: "memory"); }
            if (ty == 1) {
#pragma unroll
                for (int bj = 0; bj < 2; ++bj)
#pragma unroll
                    for (int k = 0; k < 8; ++k) { float s = csum[bj][k]; s += __shfl_xor(s, 1); s += __shfl_xor(s, 2); s += __shfl_xor(s, 4); s += __shfl_xor(s, 8); csum[bj][k] = s; }
                if (fr == 0) { float* kp = KPART + ((size_t)u.pm * 2 + wr) * 512 + head * 64 + d0;
#pragma unroll
                    for (int bj = 0; bj < 2; ++bj) { *(f32x4*)(kp + bj * 32) = (f32x4){csum[bj][0], csum[bj][1], csum[bj][2], csum[bj][3]}; *(f32x4*)(kp + bj * 32 + 4) = (f32x4){csum[bj][4], csum[bj][5], csum[bj][6], csum[bj][7]}; } }
            }
        }
    }
};
struct EpiOut {
    static constexpr bool PERM = true, AFTER_DRAIN = false;
    const bf16_t* xres16; float* out; bf16_t* xb; float* rowss;
    __device__ __forceinline__ void operator()(const f32x4 (&acc)[2][2][4][2], const Unit& u, int wr, int wc, int fr, int fq) const {
        const int col0 = u.pn * BM + wc * 32 + 8 * fq;
        const size_t base = (size_t)(u.pm * BM + wr * 64 + fr) * 1024 + col0;
        u32x4 res[2][4][2];
#pragma unroll
        for (int ai = 0; ai < 2; ++ai)
#pragma unroll
            for (int m = 0; m < 4; ++m)
#pragma unroll
                for (int bj = 0; bj < 2; ++bj) res[ai][m][bj] = *(const u32x4*)(xres16 + base + (size_t)(ai * HALF + m * 16) * 1024 + bj * HALF);
#pragma unroll
        for (int ai = 0; ai < 2; ++ai)
#pragma unroll
            for (int m = 0; m < 4; ++m) {
                const int row = u.pm * BM + ai * HALF + wr * 64 + m * 16 + fr; float ss = 0.f;
#pragma unroll
                for (int bj = 0; bj < 2; ++bj) { const size_t off = (size_t)row * 1024 + col0 + bj * HALF;
                    const u32x4 r = res[ai][m][bj];
                    f32x4 v0 = (f32x4){__builtin_bit_cast(float, r.x << 16), __builtin_bit_cast(float, r.x & 0xffff0000u), __builtin_bit_cast(float, r.y << 16), __builtin_bit_cast(float, r.y & 0xffff0000u)};
                    f32x4 v1 = (f32x4){__builtin_bit_cast(float, r.z << 16), __builtin_bit_cast(float, r.z & 0xffff0000u), __builtin_bit_cast(float, r.w << 16), __builtin_bit_cast(float, r.w & 0xffff0000u)};
                    v0 = v0 + acc[ai][bj][m][0]; v1 = v1 + acc[ai][bj][m][1];
                    if (out) { *(f32x4*)(out + off) = v0; *(f32x4*)(out + off + 4) = v1; }
                    if (xb) { u32x4 w; w.x = cvt_pk_bf16(v0[0], v0[1]); w.y = cvt_pk_bf16(v0[2], v0[3]); w.z = cvt_pk_bf16(v1[0], v1[1]); w.w = cvt_pk_bf16(v1[2], v1[3]); *(u32x4*)(xb + off) = w; }
                    ss += ((v0[0] * v0[0] + v0[1] * v0[1]) + (v0[2] * v0[2] + v0[3] * v0[3])) + ((v1[0] * v1[0] + v1[1] * v1[1]) + (v1[2] * v1[2] + v1[3] * v1[3])); }
                ss += __shfl_xor(ss, 16); ss += __shfl_xor(ss, 32);
                if (fq == 0 && rowss) rowss[(size_t)row * 16 + u.pn * 4 + wc] = ss;
            }
    }
};

template <class Epi, class Sched, bool ALIGN_EPI = false, bool SP2 = false>
__device__ __forceinline__ void gemm_phase(PG8_LAS unsigned char* lds, const Gemm g, const Sched& S, const Epi& E, const int wave0) {
    int tid = wave0 * 64 + lane_id_asm(); asm volatile("" : "+v"(tid));
    const int wid = __builtin_amdgcn_readfirstlane(tid >> 6), lane = tid & 63, wr = wid >> 2, wc = wid & 3, fr = lane & 15, fq = lane >> 4;
    const int K = g.K, nt = K / BK;
    unsigned voffA[2], voffB[2];
#pragma unroll
    for (int i = 0; i < 2; ++i) { int R, C; stage_rc(tid * 16 + i * 8192, R, C); const int Rb = Epi::PERM ? ((R & ~31) + perm32(R & 31)) : R;
        voffA[i] = (unsigned)(R * K + C) * 2u; voffB[i] = (unsigned)(Rb * K + C) * 2u; }
    const size_t kstep = (size_t)(BK * 2);
    const size_t hstep = (size_t)HALF * K * 2;
    const size_t tstep = 2 * hstep;
    const unsigned ldsw = (unsigned)wid * 1024u;
    const int aoff = lds_byte(wr * 64 + fr, fq * 8), boff = lds_byte(wc * 32 + fr, fq * 8);
#define PG8_SA(b, h) (((b) * 2 + (h)) * HTB)
#define PG8_SB(b, h) ((4 + (b) * 2 + (h)) * HTB)
#define PG8_STAGE(bufoff, gbase, voff) do { _Pragma("unroll") for (int _i = 0; _i < 2; ++_i) \
        __builtin_amdgcn_global_load_lds((const unsigned*)((const char*)(gbase) + (voff)[_i]), (PG8_LAS unsigned*)(lds + (bufoff) + ldsw + _i * 8192), 16, 0, 0); } while (0)
#define PG8_LDA(dst, b, h) do { _Pragma("unroll") for (int m = 0; m < 4; ++m) _Pragma("unroll") for (int k = 0; k < 2; ++k) dst[m][k] = *(const PG8_LAS bf16x8*)(lds + PG8_SA(b, h) + aoff + m * 2048 + k * 1024); } while (0)
#define PG8_LDB(dst, b, h) do { _Pragma("unroll") for (int n = 0; n < 2; ++n) _Pragma("unroll") for (int k = 0; k < 2; ++k) dst[n][k] = *(const PG8_LAS bf16x8*)(lds + PG8_SB(b, h) + boff + n * 2048 + k * 1024); } while (0)
#define PG8_MMA(ai, bj, At, Bt) do { __builtin_amdgcn_s_setprio(1); _Pragma("unroll") for (int m = 0; m < 4; ++m) _Pragma("unroll") for (int n = 0; n < 2; ++n) _Pragma("unroll") for (int k = 0; k < 2; ++k) \
        acc[ai][bj][m][n] = __builtin_amdgcn_mfma_f32_16x16x32_bf16(Bt[n][k], At[m][k], acc[ai][bj][m][n], 0, 0, 0); __builtin_amdgcn_s_setprio(0); } while (0)
#define PG8_WAIT_V(n) asm volatile("s_waitcnt vmcnt(" #n ")" ::: "memory")
#define PG8_WAIT_L(n) asm volatile("s_waitcnt lgkmcnt(" #n ")" ::: "memory")
#define PG8_BAR __builtin_amdgcn_s_barrier()
#define PG8_SCHED __builtin_amdgcn_sched_barrier(0)
    Unit cur, nxt; int ui = 0;
    if (!S.next(0, cur)) return;
    f32x4 acc[2][2][4][2];
#pragma unroll
    for (int a = 0; a < 2; ++a)
#pragma unroll
        for (int b = 0; b < 2; ++b)
#pragma unroll
            for (int m = 0; m < 4; ++m)
#pragma unroll
                for (int n = 0; n < 2; ++n) acc[a][b][m][n] = (f32x4){0.f, 0.f, 0.f, 0.f};
    bf16x8 At[4][2], B0[2][2], B1[2][2];
    const char* cA = (const char*)g.A + (size_t)cur.pm * tstep; const char* cB = (const char*)g.Bt + (size_t)cur.pn * tstep;
    S.a_ready(cur);
    if constexpr (SP2) {
        PG8_STAGE(PG8_SB(0, 0), cB, voffB); PG8_STAGE(PG8_SB(0, 1), cB + hstep, voffB); PG8_STAGE(PG8_SA(0, 0), cA, voffA); PG8_STAGE(PG8_SA(0, 1), cA + hstep, voffA);
        if (wr == 1) PG8_BAR;
        PG8_WAIT_V(2); PG8_BAR;
        PG8_STAGE(PG8_SB(1, 0), cB + kstep, voffB); PG8_STAGE(PG8_SA(1, 0), cA + kstep, voffA); PG8_STAGE(PG8_SB(1, 1), cB + hstep + kstep, voffB);
        PG8_WAIT_V(6); PG8_BAR;
    } else {
        PG8_STAGE(PG8_SB(0, 0), cB, voffB); PG8_STAGE(PG8_SA(0, 0), cA, voffA); PG8_STAGE(PG8_SB(0, 1), cB + hstep, voffB); PG8_STAGE(PG8_SA(0, 1), cA + hstep, voffA);
        if (wr == 1) PG8_BAR;
        PG8_WAIT_V(4); PG8_BAR;
        PG8_STAGE(PG8_SB(1, 0), cB + kstep, voffB); PG8_STAGE(PG8_SA(1, 0), cA + kstep, voffA); PG8_STAGE(PG8_SB(1, 1), cB + hstep + kstep, voffB);
        PG8_WAIT_V(6); PG8_BAR;
    }
    for (;;) {
        const bool has_next = S.next(ui + 1, nxt);
        const char* nA = has_next ? (const char*)g.A + (size_t)nxt.pm * tstep : cA; const char* nB = has_next ? (const char*)g.Bt + (size_t)nxt.pn * tstep : cB;
        for (int t = 0; t < nt; t += 2) {
            const bool last = (t == nt - 2);
            const char* a1 = cA + (size_t)(t + 1) * kstep;
            const char* a2 = last ? nA : cA + (size_t)(t + 2) * kstep; const char* b2 = last ? nB : cB + (size_t)(t + 2) * kstep;
            const char* a3 = a2 + kstep; const char* b3 = b2 + kstep;
            if (last && has_next) S.a_ready(nxt);
            if constexpr (SP2) {
            PG8_LDB(B0, 0, 0); PG8_LDB(B1, 0, 1); PG8_SCHED; PG8_LDA(At, 0, 0); PG8_STAGE(PG8_SA(1, 1), a1 + hstep, voffA);
            PG8_WAIT_V(8); PG8_WAIT_L(0); PG8_BAR; PG8_MMA(0, 0, At, B0); PG8_MMA(0, 1, At, B1); PG8_BAR; PG8_SCHED;
            PG8_LDA(At, 0, 1); PG8_STAGE(PG8_SB(0, 0), b2, voffB); PG8_STAGE(PG8_SB(0, 1), b2 + hstep, voffB); PG8_STAGE(PG8_SA(0, 0), a2, voffA);
            PG8_WAIT_V(8); PG8_WAIT_L(0); PG8_BAR; PG8_MMA(1, 0, At, B0); PG8_MMA(1, 1, At, B1); PG8_BAR; PG8_SCHED;
            PG8_LDB(B0, 1, 0); PG8_LDB(B1, 1, 1); PG8_SCHED; PG8_LDA(At, 1, 0); PG8_STAGE(PG8_SA(0, 1), a2 + hstep, voffA);
            PG8_WAIT_V(8); PG8_WAIT_L(0); PG8_BAR; PG8_MMA(0, 0, At, B0); PG8_MMA(0, 1, At, B1); PG8_BAR; PG8_SCHED;
            PG8_LDA(At, 1, 1); PG8_STAGE(PG8_SB(1, 0), b3, voffB); PG8_STAGE(PG8_SB(1, 1), b3 + hstep, voffB); PG8_STAGE(PG8_SA(1, 0), a3, voffA);
            PG8_WAIT_V(8); PG8_WAIT_L(0); PG8_BAR; PG8_MMA(1, 0, At, B0); PG8_MMA(1, 1, At, B1); PG8_BAR; PG8_SCHED;
            } else {
            PG8_LDB(B0, 0, 0); PG8_SCHED; PG8_LDA(At, 0, 0); PG8_STAGE(PG8_SA(1, 1), a1 + hstep, voffA);
            PG8_WAIT_L(8); PG8_BAR; PG8_WAIT_L(0); PG8_MMA(0, 0, At, B0); PG8_BAR; PG8_SCHED;
            PG8_LDB(B1, 0, 1); PG8_STAGE(PG8_SB(0, 0), b2, voffB);
            PG8_BAR; PG8_WAIT_L(0); PG8_MMA(0, 1, At, B1); PG8_BAR;
            PG8_LDA(At, 0, 1); PG8_STAGE(PG8_SA(0, 0), a2, voffA);
            PG8_BAR; PG8_WAIT_L(0); PG8_MMA(1, 0, At, B0); PG8_BAR; PG8_SCHED;
            PG8_STAGE(PG8_SB(0, 1), b2 + hstep, voffB);
            PG8_WAIT_V(6); PG8_BAR; PG8_MMA(1, 1, At, B1); PG8_BAR;
            PG8_LDB(B0, 1, 0); PG8_SCHED; PG8_LDA(At, 1, 0); PG8_STAGE(PG8_SA(0, 1), a2 + hstep, voffA);
            PG8_WAIT_L(8); PG8_BAR; PG8_WAIT_L(0); PG8_MMA(0, 0, At, B0); PG8_BAR; PG8_SCHED;
            PG8_LDB(B1, 1, 1); PG8_STAGE(PG8_SB(1, 0), b3, voffB);
            PG8_BAR; PG8_WAIT_L(0); PG8_MMA(0, 1, At, B1); PG8_BAR;
            PG8_LDA(At, 1, 1); PG8_STAGE(PG8_SA(1, 0), a3, voffA);
            PG8_BAR; PG8_WAIT_L(0); PG8_MMA(1, 0, At, B0); PG8_BAR; PG8_SCHED;
            PG8_STAGE(PG8_SB(1, 1), b3 + hstep, voffB);
            PG8_WAIT_V(6); PG8_BAR; PG8_MMA(1, 1, At, B1); PG8_BAR;
            }
        }
        if constexpr (ALIGN_EPI) { if (wr == 0) PG8_BAR; }
        if constexpr (!Epi::AFTER_DRAIN) { E(acc, cur, wr, wc, fr, fq); S.done(cur); }
        if (!has_next) break;
#pragma unroll
        for (int a = 0; a < 2; ++a)
#pragma unroll
            for (int b = 0; b < 2; ++b)
#pragma unroll
                for (int m = 0; m < 4; ++m)
#pragma unroll
                    for (int n = 0; n < 2; ++n) acc[a][b][m][n] = (f32x4){0.f, 0.f, 0.f, 0.f};
        cur = nxt; cA = nA; cB = nB; ++ui;
        if constexpr (ALIGN_EPI) { if (wr == 1) PG8_BAR; }
    }
    PG8_WAIT_V(0);
    if constexpr (!ALIGN_EPI) { if (wr == 0) PG8_BAR; }
    PG8_BAR;
    if constexpr (Epi::AFTER_DRAIN) { E.fused(acc, cur, wr, wc, fr, fq, lds, wid, lane); S.done(cur); }
#undef PG8_SA
#undef PG8_SB
#undef PG8_STAGE
#undef PG8_LDA
#undef PG8_LDB
#undef PG8_MMA
#undef PG8_WAIT_V
#undef PG8_WAIT_L
#undef PG8_BAR
#undef PG8_SCHED
}
}


constexpr int NWAVES = 8;
#ifndef REP_PROJ
#define REP_PROJ 1
#endif
#ifndef REP_HGRN
#define REP_HGRN 1
#endif
#ifndef REP_MOBA
#define REP_MOBA 1
#endif
#ifndef REP_OUT
#define REP_OUT 1
#endif
#ifndef MK_N_LAUNCHES
#define MK_N_LAUNCHES 1
#endif
constexpr int N_PHASES = 7;
constexpr int N_LAUNCHES = MK_N_LAUNCHES;

constexpr int BATCH = 16, SEQ = 2048, DM = 1024, DEPTH = 2, MTOK = BATCH * SEQ, NIN = 4096;
constexpr int C_HQ = 0, C_HF = 512, C_HI = 1024, C_HG = 1536, C_AQ = 2048, C_AK = 2560, C_AV = 3072, C_AG = 3584;
constexpr float NORM_EPS = 1e-6f;

constexpr size_t MiB = 1u << 20;
constexpr size_t WS_CTL = 0, CTL_ZERO_BYTES = 32768;
constexpr size_t WS_WIN = 2 * MiB;
constexpr size_t WS_WOUT = 18 * MiB;
constexpr size_t WS_LB = 22 * MiB;
constexpr size_t WS_KPART = 22 * MiB + 65536;
constexpr size_t WS_ROWSS = 24 * MiB;
constexpr size_t WS_DEC = 28 * MiB;
constexpr size_t WS_XB = 32 * MiB;
constexpr size_t WS_MIXED = 160 * MiB;
constexpr size_t WS_ARR = 224 * MiB;
constexpr size_t ARR_BYTES = 32 * MiB;
constexpr size_t WS_END = 480 * MiB;
constexpr int CW_QUEUE = 1024;
constexpr int CW_BAR = 4096;

constexpr int RING_OFF = 0, RING_BYTES = 131072;
constexpr int EXTRA_OFF = RING_BYTES, EXTRA_BYTES = 16384;
constexpr int LDSCTL_OFF = EXTRA_OFF + EXTRA_BYTES, MISC_OFF = LDSCTL_OFF + 320;
constexpr int LDS_BYTES = LDSCTL_OFF + 1024;

#define GAS __attribute__((address_space(1)))
#define LAS __attribute__((address_space(3)))
typedef unsigned short bf16;
typedef unsigned v4u __attribute__((ext_vector_type(4)));
typedef float f32x4 __attribute__((ext_vector_type(4)));
typedef GAS unsigned gu32;
#define RLX_AGENT __ATOMIC_RELAXED, __HIP_MEMORY_SCOPE_AGENT
#define LDS_WAIT() asm volatile("s_waitcnt lgkmcnt(0)" ::: "memory")
#define VM_WAIT() asm volatile("s_waitcnt vmcnt(0)" ::: "memory")
__device__ __forceinline__ unsigned f2bf(float f) { unsigned u = __builtin_bit_cast(unsigned, f); return (u + 0x7fffu + ((u >> 16) & 1u)) >> 16; }
__device__ __forceinline__ unsigned pk2(float lo, float hi) { return f2bf(lo) | (f2bf(hi) << 16); }
__device__ __forceinline__ float bf2f(unsigned short b) { return __builtin_bit_cast(float, (unsigned)b << 16); }
__device__ __forceinline__ float bflo(unsigned w) { return __builtin_bit_cast(float, w << 16); }
__device__ __forceinline__ float bfhi(unsigned w) { return __builtin_bit_cast(float, w & 0xffff0000u); }
__device__ __forceinline__ float silu_f(float z) { return z / (1.0f + __expf(-z)); }
__device__ __forceinline__ float sigmoid_f(float z) { return 1.0f / (1.0f + __expf(-z)); }

#define XB_TMO      128
#define XB_XCNT(j)  (256  + 64 * (j))
#define XB_XSUB(j)  (1280 + 64 * (j))
#define XB_XGEN(j)  (2304 + 64 * (j))
#define XB_TOP      3328
#define XB_TOPGEN   3392
#define XCD_BAR_WORDS 3456
#define XB_SPIN_CAP (1u << 18)

__device__ __forceinline__ unsigned xb_ld(unsigned* p)              { return __hip_atomic_load(p, __ATOMIC_RELAXED, __HIP_MEMORY_SCOPE_AGENT); }
__device__ __forceinline__ unsigned xb_add(unsigned* p, unsigned v) { return __hip_atomic_fetch_add(p, v, __ATOMIC_RELAXED, __HIP_MEMORY_SCOPE_AGENT); }
__device__ __forceinline__ unsigned xb_xcc_id() { return (unsigned)__builtin_amdgcn_s_getreg((3 << 11) | 20) & 0xFu; }
#define XB_SPIN(cond, bar) do { unsigned _sp = 0; while (cond) { __builtin_amdgcn_s_sleep(1); \
    if ((++_sp & 255u) == 0u) { if (xb_ld(&(bar)[XB_TMO])) break; if (_sp > XB_SPIN_CAP) { atomicAdd(&(bar)[XB_TMO], 1u); break; } } } } while (0)

struct XcdBarrier {
    unsigned* bar; unsigned x; int wave0;
    volatile LAS unsigned* st;
};

#define XB_IS_T0(wv) ((wv) == 0 && lane_id_asm() == 0)
__device__ __forceinline__ XcdBarrier xcd_barrier_post(unsigned* bar, volatile LAS unsigned* st, int wave0) {
    XcdBarrier b; b.bar = bar; b.x = xb_xcc_id(); b.st = st; b.wave0 = wave0;
    if (XB_IS_T0(wave0)) (void)xb_add(&bar[XB_XCNT(b.x)], 1u);
    return b;
}
__device__ __forceinline__ void xcd_barrier_complete(unsigned* bar, unsigned x, unsigned& nloc, unsigned& nx) {
    const unsigned G = gridDim.x * gridDim.y * gridDim.z;
    unsigned sum, cnt, mine, sp = 0u;
    for (;;) {
        sum = 0u; cnt = 0u; mine = 0u;
#pragma unroll
        for (unsigned j = 0; j < 16; ++j) { const unsigned c = xb_ld(&bar[XB_XCNT(j)]); sum += c; cnt += (c > 0u) ? 1u : 0u; mine = (j == x) ? c : mine; }
        if (sum == G) break;
        __builtin_amdgcn_s_sleep(1);
        if ((++sp & 255u) == 0u) { if (xb_ld(&bar[XB_TMO])) break; if (sp > XB_SPIN_CAP) { atomicAdd(&bar[XB_TMO], 1u); break; } }
    }
    nloc = mine > 0u ? mine : 1u; nx = cnt > 0u ? cnt : 1u;
}

__device__ __forceinline__ void xcd_barrier(const XcdBarrier& b) {
    asm volatile("s_waitcnt vmcnt(0)" ::: "memory");
    __syncthreads();
    if (XB_IS_T0(b.wave0)) {
        unsigned* bar = b.bar;
        __builtin_amdgcn_s_waitcnt(0);
        unsigned nloc = b.st[0], nx = b.st[1];
        if (nloc == 0u) { xcd_barrier_complete(bar, b.x, nloc, nx); b.st[0] = nloc; b.st[1] = nx; }
        const unsigned old = xb_add(&bar[XB_XSUB(b.x)], 1u);
        const unsigned gen = old / nloc;
        if (old + 1u == (gen + 1u) * nloc) {
            __builtin_amdgcn_fence(__ATOMIC_RELEASE, "agent");
            asm volatile("s_waitcnt vmcnt(0)" ::: "memory");
            const unsigned og = xb_add(&bar[XB_TOP], 1u);
            const unsigned tg = og / nx;
            if (og + 1u == (tg + 1u) * nx) xb_add(&bar[XB_TOPGEN], 1u);
            else XB_SPIN(xb_ld(&bar[XB_TOPGEN]) == tg, bar);
            __builtin_amdgcn_fence(__ATOMIC_ACQUIRE, "agent");
            xb_add(&bar[XB_XGEN(b.x)], 1u);
            asm volatile("s_waitcnt vmcnt(0)" ::: "memory");
        } else {
            XB_SPIN(xb_ld(&bar[XB_XGEN(b.x)]) == gen, bar);
            __builtin_amdgcn_fence(__ATOMIC_ACQUIRE, "agent");
            asm volatile("s_waitcnt vmcnt(0)" ::: "memory");
        }
    }
    __syncthreads();
}


__device__ __forceinline__ void grp_barrier(unsigned* cnt, unsigned n, unsigned* tmo, int wave0) {
    asm volatile("s_waitcnt vmcnt(0)" ::: "memory");
    __syncthreads();
    if (XB_IS_T0(wave0)) {
        __builtin_amdgcn_s_waitcnt(0);
        const unsigned old = xb_add(cnt, 1u); const unsigned gen = old / n;
        if (old + 1u == (gen + 1u) * n) xb_add(cnt + 64, 1u);
        else { unsigned sp_ = 0; while (xb_ld(cnt + 64) == gen) { __builtin_amdgcn_s_sleep(1); if ((++sp_ & 255u) == 0u) { if (xb_ld(tmo)) break; if (sp_ > XB_SPIN_CAP) { atomicAdd(tmo, 1u); break; } } } }
        __builtin_amdgcn_fence(__ATOMIC_ACQUIRE, "agent");
        asm volatile("s_waitcnt vmcnt(0)" ::: "memory");
    }
    __syncthreads();
}

struct Frame {
    LAS unsigned char* lds;
    volatile LAS unsigned* MISC;
    int wave0;
    gu32* ctl;
    int vcu, G;
    const float* x; float* out;
    const float *norm_w, *w_in, *lb_logits, *hg_norm_w, *q_norm_w, *k_norm_w, *w_out;
    bf16 *WIN, *WOUT, *XB, *MIXED, *QI, *KT, *HI, *GH, *QN, *KN, *V, *GA;
    float *LB, *KPART, *ROWSS, *DEC;
};

__device__ __forceinline__ float wave_sum(float v) {
#pragma unroll
    for (int o = 1; o < 64; o <<= 1) v += __shfl_xor(v, o);
    return v;
}
__device__ __forceinline__ int win_dest(int oc) {
    if (oc < 2048) { const int grp = oc >> 9, hh = (oc >> 7) & 3, w = oc & 127; return 256 * (((grp >> 1) << 2) + hh) + 128 * (grp & 1) + w; }
    const int ty = (oc - 2048) >> 9, head = (oc >> 6) & 7, bj = (oc >> 5) & 1; return 256 * (8 + 2 * ty + (head >> 2)) + 128 * bj + 32 * (head & 3);
}
__device__ __forceinline__ void p0_transpose_item(const float* W, int K, int N, bf16* WT, const float* kscale, LAS float* scr, int item, int lane, bool permute) {
    const int nblk = N / 32, kb = item / nblk, nb = item % nblk, k0 = 64 * kb, n0 = 32 * nb; const int nd = permute ? win_dest(n0) : n0;
    float wv_[32];
#pragma unroll
    for (int i = 0; i < 32; ++i) wv_[i] = __builtin_nontemporal_load(W + (size_t)(k0 + 2 * i + (lane >> 5)) * N + n0 + (lane & 31));
#pragma unroll
    for (int i = 0; i < 32; ++i) { const int kk = 2 * i + (lane >> 5); const float s = kscale ? kscale[k0 + kk] : 1.0f; scr[kk * 33 + (lane & 31)] = wv_[i] * s; }
    LDS_WAIT(); asm volatile("" ::: "memory");
    const int c = lane & 7;
#pragma unroll
    for (int j = 0; j < 4; ++j) { const int n = (lane >> 3) + 8 * j; const LAS float* s = scr + (8 * c) * 33 + n;
        v4u o; o.x = pk2(s[0 * 33], s[1 * 33]); o.y = pk2(s[2 * 33], s[3 * 33]); o.z = pk2(s[4 * 33], s[5 * 33]); o.w = pk2(s[6 * 33], s[7 * 33]);
        *(GAS v4u*)(WT + (size_t)(nd + n) * K + k0 + 8 * c) = o; }
    LDS_WAIT(); asm volatile("" ::: "memory");
}
#define PHASE_IDS() int t_ = F.wave0 * 64 + lane_id_asm(); asm volatile("" : "+v"(t_)); const int tid = t_, lane = tid & 63, wave = __builtin_amdgcn_readfirstlane(tid >> 6); (void)lane; (void)wave
__device__ __forceinline__ void p0_prologue(Frame& F) {
    PHASE_IDS();
    LAS float* scr = (LAS float*)(F.lds + RING_OFF + wave * 16384);
    const int gw = F.vcu * NWAVES + wave, NGW = F.G * NWAVES;
    constexpr int I_IN = (DM / 64) * (NIN / 32), I_OUT = (DM / 64) * (DM / 32);
    constexpr int NITEMS = DEPTH * (I_IN + I_OUT);
    for (int it = gw; it < NITEMS; it += NGW) {
        int r = it;
        if (r < DEPTH * I_IN) { const int l = r / I_IN; r -= l * I_IN;
            p0_transpose_item(F.w_in + (size_t)l * DM * NIN, DM, NIN, F.WIN + (size_t)l * NIN * DM, F.norm_w + l * DM, scr, r, lane, true); continue; }
        r -= DEPTH * I_IN; { const int l = r / I_OUT; r -= l * I_OUT;
            p0_transpose_item(F.w_out + (size_t)l * DM * DM, DM, DM, F.WOUT + (size_t)l * DM * DM, nullptr, scr, r, lane, false); }
    }
    for (int m0 = gw * 4; m0 < MTOK; m0 += NGW * 4) {
        f32x4 v[4][4]; float sq[4];
#pragma unroll
        for (int r = 0; r < 4; ++r) { const GAS f32x4* xr = (const GAS f32x4*)(F.x + (size_t)(m0 + r) * DM) + lane;
#pragma unroll
            for (int j = 0; j < 4; ++j) v[r][j] = __builtin_nontemporal_load(xr + 64 * j); }
#pragma unroll
        for (int r = 0; r < 4; ++r) { float a = 0.f;
#pragma unroll
            for (int j = 0; j < 4; ++j) a += (v[r][j].x * v[r][j].x + v[r][j].y * v[r][j].y) + (v[r][j].z * v[r][j].z + v[r][j].w * v[r][j].w);
            sq[r] = a; }
#pragma unroll
        for (int o = 1; o < 64; o <<= 1) {
#pragma unroll
            for (int r = 0; r < 4; ++r) sq[r] += __shfl_xor(sq[r], o); }
#pragma unroll
        for (int r = 0; r < 4; ++r) { GAS unsigned long long* o8 = (GAS unsigned long long*)(F.XB + (size_t)(m0 + r) * DM) + lane;
#pragma unroll
            for (int j = 0; j < 4; ++j) o8[64 * j] = (unsigned long long)pk2(v[r][j].x, v[r][j].y) | ((unsigned long long)pk2(v[r][j].z, v[r][j].w) << 32);
            if (lane < 16) F.ROWSS[(size_t)(m0 + r) * 16 + lane] = (lane == 0) ? sq[r] : 0.f; }
    }
    if (blockIdx.x == 0) { const int c = tid; const float a0 = F.lb_logits[c], a1 = F.lb_logits[512 + c]; const float mx = fmaxf(a0, a1);
        const float e0 = expf(a0 - mx), e1 = expf(a1 - mx); const float p0 = e0 / (e0 + e1), p1 = e1 / (e0 + e1);
        F.LB[c] = 0.f; F.LB[512 + c] = fminf(fmaxf((p0 + p1) - p0, 0.f), 1.0f - 1e-6f); }
}

constexpr float LOG2E = 1.4426950408889634f;
constexpr float QSCALE2 = 0.125f * LOG2E;
namespace moba {
typedef short bf16x8 __attribute__((ext_vector_type(8)));
typedef short s16x4 __attribute__((ext_vector_type(4)));
typedef float f32x16 __attribute__((ext_vector_type(16)));
typedef float f32x2_t __attribute__((ext_vector_type(2))); typedef __bf16 bf16x2_t __attribute__((ext_vector_type(2)));
__device__ __forceinline__ unsigned cvtpk(float lo, float hi) { f32x2_t v = {lo, hi}; bf16x2_t b = __builtin_convertvector(v, bf16x2_t); return __builtin_bit_cast(unsigned, b); }
__device__ __forceinline__ int crow(int r, int hi) { return (r & 3) + 8 * (r >> 2) + 4 * hi; }
__device__ __forceinline__ float max3f(float a, float b, float c) { float r; asm("v_max3_f32 %0, %1, %2, %3" : "=v"(r) : "v"(a), "v"(b), "v"(c)); return r; }
constexpr int L_K = 0, L_V = 32768, L_WSF = 65536, L_KM = 67584, L_OST = 69632;
constexpr float NEG_BIG = -1e30f;
constexpr float THR = 8.0f;
__device__ __forceinline__ s16x4 vtr(const LAS unsigned char* p) { return __builtin_bit_cast(s16x4, __builtin_amdgcn_ds_read_tr16_b64_v4i16((LAS s16x4*)p)); }
}

__device__ __forceinline__ void moba_glds(unsigned voff, const void* sbase, unsigned lds_dst) { unsigned keep;
    asm volatile("s_mov_b32 %0, m0\n\ts_mov_b32 m0, %3\n\ts_nop 0\n\tglobal_load_lds_dwordx4 %1, %2\n\ts_mov_b32 m0, %0" : "=&s"(keep) : "v"(voff), "s"(sbase), "s"(lds_dst) : "memory"); }
template <bool FIXREF> __device__ __forceinline__ void moba_mfma_body(Frame& F, int l) {
    using namespace moba;
    PHASE_IDS();
    const int r32 = lane & 31, hi = lane >> 5, wid = wave;
    LAS unsigned char* L = F.lds + RING_OFF;
    LAS float* wsf = (LAS float*)(L + L_WSF) + wid * 64;
    LAS float* km = (LAS float*)(L + L_KM);
    LAS float* ost = (LAS float*)(L + L_OST) + wid * 2048;
    float gq = fabsf(F.q_norm_w[l * 64 + lane]), gk = fabsf(F.k_norm_w[l * 64 + lane]);
#pragma unroll
    for (int o = 1; o < 64; o <<= 1) { gq = fmaxf(gq, __shfl_xor(gq, o)); gk = fmaxf(gk, __shfl_xor(gk, o)); }
    gq = __builtin_bit_cast(float, __builtin_amdgcn_readfirstlane(__builtin_bit_cast(int, gq))); gk = __builtin_bit_cast(float, __builtin_amdgcn_readfirstlane(__builtin_bit_cast(int, gk)));
    const float smax2 = 8.0f * gq * gk * LOG2E * 1.02f;
    const float mhat0 = -(smax2 + 1.0f);
    int grp_ = (int)(blockIdx.x & 7u); asm volatile("" : "+s"(grp_));
    gu32* qctr = F.ctl + CW_QUEUE + 64 * (2 * grp_ + l);
    volatile LAS unsigned* tick = (volatile LAS unsigned*)(F.lds + EXTRA_OFF + 8192);
    if (tid == 0) tick[0] = __hip_atomic_fetch_add(qctr, 1u, RLX_AGENT);
    for (int ui = 0;; ++ui) {
        __syncthreads();
        const int it = __builtin_amdgcn_readfirstlane((int)tick[ui & 1]); if (it >= 128) break;
        const int qb = 7 - (it >> 4), bh = 16 * grp_ + (it & 15);
        const int b = bh >> 3, h = bh & 7; const size_t rowbase = (size_t)b * SEQ; const int q0 = qb * 256, qrel = wid * 32 + r32, tq = q0 + qrel;
        const float sl2 = exp2f(-(float)(h + 1)) * LOG2E;
        bf16x8 qr[4];
        { const GAS bf16* Qw = (const GAS bf16*)(F.QN + (rowbase + q0 + wid * 32 + r32) * 512 + h * 64 + hi * 8);
#pragma unroll
            for (int d0 = 0; d0 < 4; ++d0) qr[d0] = *(const GAS bf16x8*)(Qw + d0 * 16); }
        LAS unsigned char* qlds = (LAS unsigned char*)ost + lane * 16;
        { int tid_u = tid; asm volatile("" : "+v"(tid_u));
          if (tid_u < qb * 64) { const GAS float* kp = (const GAS float*)(F.KPART + ((size_t)b * 8 + (tid_u >> 6)) * 1024 + h * 64 + (tid_u & 63)); km[tid_u] = (kp[0] + kp[512]) * (1.0f / 256.0f); } }
        const unsigned koff = (unsigned)(((rowbase + lane) * 512 + h * 64 + wid * 8) * 2);
        unsigned voff; { const int vr = 8 * wid + (lane >> 3), sl = lane & 7; const int ch = ((((sl >> 2) ^ ((vr >> 1) & 1)) << 2) | (sl & 3)); voff = (unsigned)((((size_t)MTOK + rowbase + vr) * 512 + h * 64 + ch * 8) * 2); }
        const unsigned lds0 = (unsigned)(uintptr_t)L;
#define MOBA_ISSUE(t_, bufi) do { moba_glds(koff, (const void*)((const char*)F.KN + (size_t)(t_) * 65536), (unsigned)__builtin_amdgcn_readfirstlane((int)(lds0 + L_K + (bufi) * 8192 + wid * 1024))); \
            moba_glds(voff, (const void*)((const char*)F.KN + (size_t)(t_) * 65536), (unsigned)__builtin_amdgcn_readfirstlane((int)(lds0 + L_V + (bufi) * 8192 + wid * 1024))); } while (0)
        const int NT = 4 * (qb + 1);
        int t0 = 0; { const float dstar = (151.0f + 2.0f * smax2) / sl2; const float x = ((float)(q0 - 63) - dstar) * (1.0f / 64.0f); if (x > 0.f) t0 = ((int)x) & ~1; if (t0 > NT - 4) t0 = NT - 4; t0 = __builtin_amdgcn_readfirstlane(t0); }
        unsigned nticket = 0u; if (tid == 0) nticket = __hip_atomic_fetch_add(qctr, 1u, RLX_AGENT);
        MOBA_ISSUE(t0, 0); MOBA_ISSUE(t0 + 1, 1); MOBA_ISSUE(t0 + 2, 2);
        __syncthreads();
        unsigned selmask = 0;
        { float gt[7]; float qf32[32];
#pragma unroll
            for (int d0 = 0; d0 < 4; ++d0)
#pragma unroll
                for (int e = 0; e < 8; ++e) qf32[d0 * 8 + e] = bf2f((unsigned short)qr[d0][e]);
#pragma unroll
            for (int i = 0; i < 32; ++i) asm volatile("" : "+v"(qf32[i]));
#pragma unroll
            for (int j = 0; j < 7; ++j) { float s = 0.f;
                if (j < qb) {
#pragma unroll
                    for (int d0 = 0; d0 < 4; ++d0)
#pragma unroll
                        for (int e = 0; e < 8; ++e) s += qf32[d0 * 8 + e] * km[j * 64 + d0 * 16 + hi * 8 + e];
                    auto rr = __builtin_amdgcn_permlane32_swap(__float_as_uint(s), __float_as_uint(s), false, false);
                    s = __uint_as_float(rr[0]) + __uint_as_float(rr[1]); }
                gt[j] = s; }
#pragma unroll
            for (int j = 0; j < 7; ++j) { int rank = 0;
#pragma unroll
                for (int i = 0; i < 7; ++i) if (i != j && i < qb) rank += (gt[i] > gt[j] || (gt[i] == gt[j] && i < j)) ? 1 : 0;
                if (j < qb && rank < 3) selmask |= 1u << j; }
            selmask |= 1u << qb; }
        if (!FIXREF) {
#pragma unroll
            for (int d0 = 0; d0 < 4; ++d0) *(LAS bf16x8*)(qlds + d0 * 1024) = qr[d0]; }
        float mhat = mhat0, l_reg = 0.f; f32x16 o[2]; o[0] = f32x16{}; o[1] = f32x16{};
        const int kbase = L_K + hi * 1024 + r32 * 16;
        const int g16 = lane >> 4, i16 = lane & 15, tq4 = i16 >> 2, tp4 = i16 & 3;
        const int vrow0 = 4 * hi + tq4;
        if (tid == 0) tick[(ui + 1) & 1] = nticket;
        asm volatile("s_waitcnt vmcnt(2)" ::: "memory");
        __syncthreads();
#define MOBA_KLOAD(KOFF) do { if (!FIXREF) { _Pragma("unroll") for (int d0 = 0; d0 < 4; ++d0) qf_[d0] = *(const LAS bf16x8*)(qlds + d0 * 1024); } \
            _Pragma("unroll") for (int d0 = 0; d0 < 4; ++d0) { \
            kfr[2 * d0] = *(const LAS bf16x8*)(L + (KOFF) + kbase + d0 * 2048); kfr[2 * d0 + 1] = *(const LAS bf16x8*)(L + (KOFF) + kbase + d0 * 2048 + 512); } } while (0)
#define MOBA_KLOADH(KOFF, H) do { _Pragma("unroll") for (int d0 = 2 * (H); d0 < 2 * (H) + 2; ++d0) { \
            kfr[2 * d0] = *(const LAS bf16x8*)(L + (KOFF) + kbase + d0 * 2048); kfr[2 * d0 + 1] = *(const LAS bf16x8*)(L + (KOFF) + kbase + d0 * 2048 + 512); } } while (0)
#define MOBA_VLOAD(VOFF) do { _Pragma("unroll") for (int dblk = 0; dblk < 2; ++dblk) _Pragma("unroll") for (int ks = 0; ks < 4; ++ks) { \
            const int rlo = 16 * ks + vrow0, rhi = rlo + 8; \
            vlo[dblk * 4 + ks] = vtr(L + L_V + (VOFF) + rlo * 128 + ((dblk ^ ((rlo >> 1) & 1)) * 64) + (16 * (g16 & 1) + 4 * tp4) * 2); \
            vhi[dblk * 4 + ks] = vtr(L + L_V + (VOFF) + rhi * 128 + ((dblk ^ ((rhi >> 1) & 1)) * 64) + (16 * (g16 & 1) + 4 * tp4) * 2); } } while (0)
#define MOBA_VLOADH(VOFF, DB) do { _Pragma("unroll") for (int ks = 0; ks < 4; ++ks) { \
            const int rlo = 16 * ks + vrow0, rhi = rlo + 8; \
            vlo[(DB) * 4 + ks] = vtr(L + L_V + (VOFF) + rlo * 128 + (((DB) ^ ((rlo >> 1) & 1)) * 64) + (16 * (g16 & 1) + 4 * tp4) * 2); \
            vhi[(DB) * 4 + ks] = vtr(L + L_V + (VOFF) + rhi * 128 + (((DB) ^ ((rhi >> 1) & 1)) * 64) + (16 * (g16 & 1) + 4 * tp4) * 2); } } while (0)
#define MOBA_QK(CANSKIP, TT, P0, P1) do { \
            const int blk_ = (TT) >> 2; \
            if (!((CANSKIP) && (blk_ == qb) && (64 * ((TT) & 3) > 32 * wid + 31))) { \
                const bool sel_ = ((selmask >> blk_) & 1u); \
                float sc0_ = sel_ ? (-mhat - sl2 * (float)(tq - 64 * (TT) - 4 * hi)) : NEG_BIG; asm volatile("" : "+v"(sc0_)); \
_Pragma("unroll") \
                for (int r = 0; r < 16; ++r) { P0[r] = __builtin_fmaf(sl2, (float)((r & 3) + 8 * (r >> 2)), sc0_); P1[r] = __builtin_fmaf(sl2, (float)(32 + (r & 3) + 8 * (r >> 2)), sc0_); } \
_Pragma("unroll") \
                for (int d0 = 0; d0 < 4; ++d0) { \
                    P0 = __builtin_amdgcn_mfma_f32_32x32x16_bf16(kfr[2 * d0], FIXREF ? qr[d0] : qf_[d0], P0, 0, 0, 0); \
                    P1 = __builtin_amdgcn_mfma_f32_32x32x16_bf16(kfr[2 * d0 + 1], FIXREF ? qr[d0] : qf_[d0], P1, 0, 0, 0); } \
            } } while (0)
#define MOBA_SM(OWNP, TT, P0, P1, HAVE_NEXT, N0, N1) do { \
            const bool own = (OWNP); const int jb = (TT) & 3; \
            if (!(own && (64 * jb > 32 * wid + 31))) { \
                if (own && (64 * jb + 63 > 32 * wid)) { \
_Pragma("unroll") \
                    for (int r = 0; r < 16; ++r) { const int kvl = 64 * jb + crow(r, hi); if (kvl > qrel) P0[r] = NEG_BIG; if (kvl + 32 > qrel) P1[r] = NEG_BIG; } } \
                if (!FIXREF) { \
                float rm = max3f(P0[0], P1[0], P0[1]), rm2 = max3f(P1[1], P0[2], P1[2]); \
_Pragma("unroll") \
                for (int r = 3; r < 15; r += 2) { rm = max3f(rm, P0[r], P1[r]); rm2 = max3f(rm2, P0[r + 1], P1[r + 1]); } \
                rm = max3f(rm, rm2, fmaxf(P0[15], P1[15])); \
                { auto rr = __builtin_amdgcn_permlane32_swap(__float_as_uint(rm), __float_as_uint(rm), false, false); rm = fmaxf(__uint_as_float(rr[0]), __uint_as_float(rr[1])); } \
                if (__any(rm > THR)) { \
                    const float dl = fmaxf(rm, 0.f); mhat += dl; \
_Pragma("unroll") \
                    for (int r = 0; r < 16; ++r) { P0[r] -= dl; P1[r] -= dl; } \
                    if (HAVE_NEXT) { \
_Pragma("unroll") \
                        for (int r = 0; r < 16; ++r) { N0[r] -= dl; N1[r] -= dl; } } \
                    const float f = __builtin_amdgcn_exp2f(-dl); l_reg *= f; \
                    if (hi == 0) wsf[r32] = f; \
_Pragma("unroll") \
                    for (int r = 0; r < 16; ++r) { const float fr = wsf[crow(r, hi)]; o[0][r] *= fr; o[1][r] *= fr; } } \
                } \
                float sacc = 0.f, sacc2 = 0.f; \
_Pragma("unroll") \
                for (int r = 0; r < 16; ++r) { P0[r] = __builtin_amdgcn_exp2f(P0[r]); P1[r] = __builtin_amdgcn_exp2f(P1[r]); sacc += P0[r]; sacc2 += P1[r]; } \
                l_reg += sacc + sacc2; \
                { v4u w; \
_Pragma("unroll") \
                    for (int ks = 0; ks < 4; ++ks) { \
_Pragma("unroll") \
                        for (int e = 0; e < 4; ++e) { const int rb = (ks & 1) * 8 + 2 * e; w[e] = (ks < 2) ? cvtpk(P0[rb], P0[rb + 1]) : cvtpk(P1[rb], P1[rb + 1]); } \
                        pa[ks] = __builtin_bit_cast(bf16x8, w); } } \
            } } while (0)
#define MOBA_PV(OWNP, TT) do { \
            if (!((OWNP) && (64 * ((TT) & 3) > 32 * wid + 31))) { \
_Pragma("unroll") \
                for (int dblk = 0; dblk < 2; ++dblk) \
_Pragma("unroll") \
                    for (int ks = 0; ks < 4; ++ks) { \
                        const s16x4 lo = vlo[dblk * 4 + ks], hh = vhi[dblk * 4 + ks]; \
                        const bf16x8 vf = __builtin_shufflevector(lo, hh, 0, 1, 2, 3, 4, 5, 6, 7); \
                        o[dblk] = __builtin_amdgcn_mfma_f32_32x32x16_bf16(pa[ks], vf, o[dblk], 0, 0, 0); } \
            } } while (0)
        f32x16 pA0, pA1, pB0, pB1; bf16x8 kfr[8], qf_[4], pa[4]; s16x4 vlo[8], vhi[8];
        MOBA_KLOAD(0); MOBA_QK(true, t0, pA0, pA1);
        int c0o = 0;
#define MOBA_ILV() do { __builtin_amdgcn_sched_group_barrier(0x002, 16, 0); \
_Pragma("unroll") \
            for (int g_ = 0; g_ < 8; ++g_) { __builtin_amdgcn_sched_group_barrier(0x008, 1, 0); __builtin_amdgcn_sched_group_barrier(0x002, 12, 0); } } while (0)
#define MOBA_STEP2(OWNP) do { \
            const int c1o = (c0o + 1) & 3, c2o = (c0o + 2) & 3, c3o = (c0o + 3) & 3; \
            if (!(OWNP) || t + 3 < NT) MOBA_ISSUE(t + 3, c3o); \
            if (FIXREF) { MOBA_KLOAD(c1o * 8192); __builtin_amdgcn_sched_barrier(0); \
                MOBA_QK(OWNP, t + 1, pB0, pB1); MOBA_SM(OWNP, t, pA0, pA1, false, pB0, pB1); if (!(OWNP)) MOBA_ILV(); __builtin_amdgcn_sched_barrier(0); \
                MOBA_VLOAD(c0o * 8192); __builtin_amdgcn_sched_barrier(0); MOBA_PV(OWNP, t); } \
            else { MOBA_KLOAD(c1o * 8192); __builtin_amdgcn_sched_barrier(0); MOBA_QK(true, t + 1, pB0, pB1); __builtin_amdgcn_sched_barrier(0); \
                MOBA_VLOAD(c0o * 8192); __builtin_amdgcn_sched_barrier(0); MOBA_SM(OWNP, t, pA0, pA1, true, pB0, pB1); MOBA_PV(OWNP, t); } \
            if (!(OWNP) || t + 3 < NT) asm volatile("s_waitcnt vmcnt(2)" ::: "memory"); else asm volatile("s_waitcnt vmcnt(0)" ::: "memory"); \
            __syncthreads(); \
            if (!(OWNP) || t + 4 < NT) MOBA_ISSUE(t + 4, c0o); \
            if (FIXREF) { if (!(OWNP) || t + 2 < NT) MOBA_KLOAD(c2o * 8192); __builtin_amdgcn_sched_barrier(0); \
                if (!(OWNP) || t + 2 < NT) MOBA_QK(OWNP, t + 2, pA0, pA1); MOBA_SM(OWNP, t + 1, pB0, pB1, false, pA0, pA1); if (!(OWNP)) MOBA_ILV(); __builtin_amdgcn_sched_barrier(0); \
                MOBA_VLOAD(c1o * 8192); __builtin_amdgcn_sched_barrier(0); MOBA_PV(OWNP, t + 1); } \
            else { if (t + 2 < NT) { MOBA_KLOAD(c2o * 8192); __builtin_amdgcn_sched_barrier(0); MOBA_QK(true, t + 2, pA0, pA1); __builtin_amdgcn_sched_barrier(0); } \
                MOBA_VLOAD(c1o * 8192); __builtin_amdgcn_sched_barrier(0); MOBA_SM(OWNP, t + 1, pB0, pB1, (t + 2 < NT), pA0, pA1); MOBA_PV(OWNP, t + 1); } \
            if (!(OWNP) || t + 4 < NT) asm volatile("s_waitcnt vmcnt(2)" ::: "memory"); else asm volatile("s_waitcnt vmcnt(0)" ::: "memory"); \
            __syncthreads(); \
            c0o = c2o; } while (0)
        int t = t0;
        for (; t < NT - 4; t += 2) MOBA_STEP2(false);
        for (; t < NT; t += 2) MOBA_STEP2(true);
#undef MOBA_STEP2
#undef MOBA_ISSUE
#undef MOBA_KLOAD
#undef MOBA_KLOADH
#undef MOBA_VLOAD
#undef MOBA_VLOADH
#undef MOBA_QK
#undef MOBA_SM
#undef MOBA_PV
        int lane_e = lane; asm volatile("" : "+v"(lane_e));
        const int r32e = lane_e & 31, hie = lane_e >> 5;
        v4u gwv[4];
#pragma unroll
        for (int i = 0; i < 4; ++i) gwv[i] = *(const GAS v4u*)(F.GA + (rowbase + q0 + wid * 32 + i * 8 + (lane_e >> 3)) * 512 + h * 64 + (lane_e & 7) * 8);
        { auto rr = __builtin_amdgcn_permlane32_swap(__float_as_uint(l_reg), __float_as_uint(l_reg), false, false); l_reg = __uint_as_float(rr[0]) + __uint_as_float(rr[1]); }
        if (hie == 0) wsf[r32e] = 1.0f / l_reg;
#pragma unroll
        for (int r = 0; r < 16; ++r) { const float rl = wsf[crow(r, hie)]; ost[crow(r, hie) * 64 + r32e] = o[0][r] * rl; ost[crow(r, hie) * 64 + 32 + r32e] = o[1][r] * rl; }
#pragma unroll
        for (int i = 0; i < 4; ++i) { const int row = i * 8 + (lane_e >> 3), ch = lane_e & 7;
            const f32x4 a = *(const LAS f32x4*)(ost + row * 64 + ch * 8), c2 = *(const LAS f32x4*)(ost + row * 64 + ch * 8 + 4);
            const size_t grow = rowbase + q0 + wid * 32 + row;
            const v4u gw = gwv[i];
            v4u ow; ow.x = pk2(a[0] * bflo(gw.x), a[1] * bfhi(gw.x)); ow.y = pk2(a[2] * bflo(gw.y), a[3] * bfhi(gw.y));
            ow.z = pk2(c2[0] * bflo(gw.z), c2[1] * bfhi(gw.z)); ow.w = pk2(c2[2] * bflo(gw.w), c2[3] * bfhi(gw.w));
            *(GAS v4u*)(F.MIXED + grow * DM + 512 + h * 64 + ch * 8) = ow; }
    }
    __syncthreads();
}


__device__ __forceinline__ void moba_mfma_phase(Frame& F, int l) {
    float gq = 0.f, gk = 0.f;
    for (int i = 0; i < 64; ++i) { gq = fmaxf(gq, fabsf(F.q_norm_w[l * 64 + i])); gk = fmaxf(gk, fabsf(F.k_norm_w[l * 64 + i])); }
    if (2.0f * (8.0f * gq * gk * LOG2E * 1.02f) + 1.0f <= 100.0f) moba_mfma_body<true>(F, l); else moba_mfma_body<false>(F, l);
}

namespace hg {
typedef short bf16x8 __attribute__((ext_vector_type(8)));
typedef short s16x4 __attribute__((ext_vector_type(4)));
typedef float f32x4 __attribute__((ext_vector_type(4)));
typedef unsigned u32x2 __attribute__((ext_vector_type(2)));
constexpr int SLOT = 33792, NSLOT = 4;
constexpr int L_SC = NSLOT * SLOT, L_NRM = L_SC + 4096;
constexpr int NSTEP = SEQ / 32;
__device__ __forceinline__ int fsw(int t) { return ((t & 7) << 2) | (((t >> 3) & 1) << 1); }
__device__ __forceinline__ int unit_off(int tok, int cg) { return 8 * (32 * tok + (cg ^ fsw(tok))); }
__device__ __forceinline__ s16x4 rd64(const LAS unsigned char* p) { return *(const LAS s16x4*)p; }
__device__ __forceinline__ s16x4 vtr(const LAS unsigned char* p) { return __builtin_bit_cast(s16x4, __builtin_amdgcn_ds_read_tr16_b64_v4i16((LAS s16x4*)p)); }
__device__ __forceinline__ bf16x8 cat(s16x4 a, s16x4 b) { return __builtin_shufflevector(a, b, 0, 1, 2, 3, 4, 5, 6, 7); }
__device__ __forceinline__ s16x4 pack4(f32x4 v) { u32x2 w; w.x = moba::cvtpk(v[0], v[1]); w.y = moba::cvtpk(v[2], v[3]); return __builtin_bit_cast(s16x4, w); }
__device__ __forceinline__ void glds16(const GAS void* gsrc, unsigned lds_dst) { unsigned keep;
    asm volatile("s_mov_b32 %0, m0\n\ts_mov_b32 m0, %2\n\ts_nop 0\n\tglobal_load_lds_dwordx4 %1, off\n\ts_mov_b32 m0, %0" : "=&s"(keep) : "v"(gsrc), "s"(lds_dst) : "memory"); }
__device__ __forceinline__ void glds16s(unsigned voff, const void* sbase, unsigned lds_dst) { unsigned keep;
    asm volatile("s_mov_b32 %0, m0\n\ts_mov_b32 m0, %3\n\ts_nop 0\n\tglobal_load_lds_dwordx4 %1, %2 nt\n\ts_mov_b32 m0, %0" : "=&s"(keep) : "v"(voff), "s"(sbase), "s"(lds_dst) : "memory"); }
#define HG_MFMA(a, b, c) __builtin_amdgcn_mfma_f32_16x16x32_bf16((a), (b), (c), 0, 0, 0)
}

__device__ __forceinline__ void hgrn_mfma_phase(Frame& F, int l) {
    using namespace hg;
    PHASE_IDS();
    const int w = wave, c16 = lane & 15, g = lane >> 4;
    LAS unsigned char* L = F.lds + RING_OFF;
    const s16x4 z4 = (s16x4){0, 0, 0, 0};
    for (int it = (int)blockIdx.x; it < 64; it += F.G) {
        const int b = 2 * (it & 7) + (it >> 5), h = (it >> 3) & 3; const size_t rowbase = (size_t)b * SEQ;
        const int da = w >> 1;
        unsigned dsrc[4];
#pragma unroll
        for (int i = 0; i < 4; ++i) { const int t = 16 * (w & 1) + 4 * i + (lane >> 4); const int sc = (lane & 15) ^ (fsw(t) >> 1);
            dsrc[i] = (unsigned)((((size_t)da * MTOK + rowbase + t) * 512 + h * 128 + 8 * sc) * 2); }
        const unsigned ddec = (unsigned)((((size_t)b * NSTEP) * 512 + h * 128 + 4 * lane) * 4);
        const int ddst = da * 8192 + (w & 1) * 4096;
        const unsigned lds0 = (unsigned)(uintptr_t)(F.lds + RING_OFF);
#define HG_ISSUE(step) do { const unsigned so_ = lds0 + (unsigned)(((step) & 3) * SLOT); \
            _Pragma("unroll") for (int i = 0; i < 4; ++i) \
                glds16s(dsrc[i], (const void*)((const char*)F.QI + (size_t)(step) * (32 * 512 * 2)), (unsigned)__builtin_amdgcn_readfirstlane((int)(so_ + ddst + i * 1024))); \
            if (w == 0) glds16s(ddec, (const void*)((const char*)F.DEC + (size_t)(step) * 2048), (unsigned)__builtin_amdgcn_readfirstlane((int)(so_ + 32768))); } while (0)
        f32x4 S[8]; bf16x8 Sb[4];
#pragma unroll
        for (int tk = 0; tk < 8; ++tk) S[tk] = (f32x4){0.f, 0.f, 0.f, 0.f};
#pragma unroll
        for (int ks = 0; ks < 4; ++ks) Sb[ks] = (bf16x8){0, 0, 0, 0, 0, 0, 0, 0};
        f32x4 oprev[2]; oprev[0] = (f32x4){0.f, 0.f, 0.f, 0.f}; oprev[1] = oprev[0];
        u32x2 gprev[2]; gprev[0] = (u32x2){0u, 0u}; gprev[1] = gprev[0];
        float hw[4];
#pragma unroll
        for (int r = 0; r < 4; ++r) hw[r] = F.hg_norm_w[l * 128 + 16 * w + 4 * g + r];
        asm volatile("" : "+v"(hw[0]), "+v"(hw[1]), "+v"(hw[2]), "+v"(hw[3]));
        LAS float* nrm = (LAS float*)(L + L_NRM);
        LAS unsigned char* SC = L + L_SC;
        HG_ISSUE(0); HG_ISSUE(1); HG_ISSUE(2);
        asm volatile("s_waitcnt vmcnt(8)\n\ts_barrier" ::: "memory");
        const int trq = c16 >> 2, trp = c16 & 3;
        int ro0 = 256 * c16 + 16 * (g ^ (fsw(c16) >> 1)), ko0 = 256 * (4 * g + trq) + 16 * (trp ^ (fsw(4 * g + trq) >> 1));
#define RO(ks) (ro0 ^ (64 * (ks)))
#define KO(tk) (ko0 ^ (64 * ((tk) >> 1) + 8 * ((tk) & 1)))
        const int io_ = unit_off(4 * g + trq, 4 * w + trp), go_ = unit_off(c16, 4 * w + g);
        bf16x8 qf[2][4];
#define HG_LOADQ(slotbase) do { _Pragma("unroll") for (int tt = 0; tt < 2; ++tt) _Pragma("unroll") for (int ks = 0; ks < 4; ++ks) \
            qf[tt][ks] = *(const LAS bf16x8*)((slotbase) + RO(ks) + 4096 * tt); } while (0)
#define HG_FINAL(step, P) do { _Pragma("unroll") for (int tt = 0; tt < 2; ++tt) { \
            const float ssum = ((P[tt][0] + P[tt][1]) + (P[tt][2] + P[tt][3])) + ((P[tt][4] + P[tt][5]) + (P[tt][6] + P[tt][7])); \
            const float rstd = __builtin_amdgcn_rsqf(ssum * (1.0f / 128.0f) + NORM_EPS); \
            u32x2 wv; wv.x = moba::cvtpk(oprev[tt][0] * rstd * hw[0] * bflo(gprev[tt].x), oprev[tt][1] * rstd * hw[1] * bfhi(gprev[tt].x)); \
            wv.y = moba::cvtpk(oprev[tt][2] * rstd * hw[2] * bflo(gprev[tt].y), oprev[tt][3] * rstd * hw[3] * bfhi(gprev[tt].y)); \
            *(GAS u32x2*)(F.MIXED + (rowbase + (size_t)(step) * 32 + 16 * tt + c16) * DM + h * 128 + 16 * w + 4 * g) = wv; } } while (0)
        HG_LOADQ(L);
        for (int n = 0; n < NSTEP; ++n) {
            asm volatile("" : "+v"(ro0), "+v"(ko0));
            if (n + 3 < NSTEP) HG_ISSUE(n + 3);
            const LAS unsigned char* Qs = L + (n & 3) * SLOT; const LAS unsigned char* Ks = Qs + 8192; const LAS unsigned char* Is = Qs + 16384; const LAS unsigned char* Gs = Qs + 24576;
            const LAS float* Ds = (const LAS float*)(Qs + 32768);
            LAS unsigned char* SCn = SC + (n & 1) * 1536;
            bf16x8 kf[4];
            if (w < 3) { const int st = (w == 2) ? 1 : 0;
#pragma unroll
                for (int ks = 0; ks < 4; ++ks) kf[ks] = *(const LAS bf16x8*)(Ks + RO(ks) + 4096 * st); }
            u32x2 gcur[2];
#pragma unroll
            for (int tt = 0; tt < 2; ++tt) gcur[tt] = *(const LAS u32x2*)(Gs + go_ + 4096 * tt);
            s16x4 itr[2];
#pragma unroll
            for (int st = 0; st < 2; ++st) itr[st] = vtr(Is + io_ + 4096 * st);
            const bf16x8 i01 = cat(itr[0], itr[1]);
            bf16x8 k01[4]; f32x4 dv4[4];
#pragma unroll
            for (int tk = 0; tk < 4; ++tk) { k01[tk] = cat(vtr(Ks + KO(tk)), vtr(Ks + KO(tk) + 4096)); dv4[tk] = *(const LAS f32x4*)(Ds + 16 * tk + 4 * g); }
            f32x4 o[2];
#pragma unroll
            for (int tt = 0; tt < 2; ++tt) { f32x4 a = (f32x4){0.f, 0.f, 0.f, 0.f};
#pragma unroll
                for (int ks = 0; ks < 4; ++ks) a = HG_MFMA(Sb[ks], qf[tt][ks], a);
                o[tt] = a; }
            if (w < 3) { f32x4 sc = (f32x4){0.f, 0.f, 0.f, 0.f};
                if (w == 0) {
#pragma unroll
                    for (int ks = 0; ks < 4; ++ks) sc = HG_MFMA(kf[ks], qf[0][ks], sc);
                } else {
#pragma unroll
                    for (int ks = 0; ks < 4; ++ks) sc = HG_MFMA(kf[ks], qf[1][ks], sc); }
                if (w != 1) {
#pragma unroll
                    for (int r = 0; r < 4; ++r) if (4 * g + r > c16) sc[r] = 0.f; }
                *(LAS s16x4*)(SCn + w * 512 + lane * 8) = pack4(sc); }
#pragma unroll
            for (int tk = 0; tk < 4; ++tk) S[tk] = HG_MFMA(k01[tk], i01, S[tk]);
            asm volatile("" ::: "memory");
            { bf16x8 k2[4]; f32x4 d2[4];
#pragma unroll
                for (int tk = 0; tk < 4; ++tk) { k2[tk] = cat(vtr(Ks + KO(tk + 4)), vtr(Ks + KO(tk + 4) + 4096)); d2[tk] = *(const LAS f32x4*)(Ds + 16 * (tk + 4) + 4 * g); }
#pragma unroll
                for (int tk = 0; tk < 4; ++tk) S[tk] = S[tk] * dv4[tk];
#pragma unroll
                for (int ks = 0; ks < 2; ++ks) Sb[ks] = cat(pack4(S[2 * ks]), pack4(S[2 * ks + 1]));
#pragma unroll
                for (int tk = 0; tk < 4; ++tk) S[tk + 4] = HG_MFMA(k2[tk], i01, S[tk + 4]);
#pragma unroll
                for (int tk = 0; tk < 4; ++tk) S[tk + 4] = S[tk + 4] * d2[tk];
#pragma unroll
                for (int ks = 2; ks < 4; ++ks) Sb[ks] = cat(pack4(S[2 * ks]), pack4(S[2 * ks + 1])); }
            if (n >= NSTEP - 3) asm volatile("s_waitcnt vmcnt(0) lgkmcnt(0)\n\ts_barrier" ::: "memory");
            else if (n <= 1) asm volatile("s_waitcnt vmcnt(8) lgkmcnt(0)\n\ts_barrier" ::: "memory");
            else if (n == 2) asm volatile("s_waitcnt vmcnt(10) lgkmcnt(0)\n\ts_barrier" ::: "memory");
            else asm volatile("s_waitcnt vmcnt(12) lgkmcnt(0)\n\ts_barrier" ::: "memory");
            const s16x4 sc00 = rd64(SCn + lane * 8), sc01 = rd64(SCn + 512 + lane * 8), sc11 = rd64(SCn + 1024 + lane * 8);
            float pn[2][8];
            if (n > 0) {
#pragma unroll
                for (int tt = 0; tt < 2; ++tt)
#pragma unroll
                    for (int ww = 0; ww < 8; ++ww) pn[tt][ww] = nrm[((n - 1) & 1) * 256 + ww * 32 + 16 * tt + c16]; }
            if (n + 1 < NSTEP) HG_LOADQ(L + ((n + 1) & 3) * SLOT);
            o[0] = HG_MFMA(cat(itr[0], z4), cat(sc00, z4), o[0]);
            o[1] = HG_MFMA(i01, cat(sc01, sc11), o[1]);
            { float ss0 = (o[0][0] * o[0][0] + o[0][1] * o[0][1]) + (o[0][2] * o[0][2] + o[0][3] * o[0][3]);
              float ss1 = (o[1][0] * o[1][0] + o[1][1] * o[1][1]) + (o[1][2] * o[1][2] + o[1][3] * o[1][3]);
              { auto r0 = __builtin_amdgcn_permlane16_swap(__float_as_uint(ss0), __float_as_uint(ss0), false, false); auto r1 = __builtin_amdgcn_permlane16_swap(__float_as_uint(ss1), __float_as_uint(ss1), false, false);
                ss0 = __uint_as_float(r0[0]) + __uint_as_float(r0[1]); ss1 = __uint_as_float(r1[0]) + __uint_as_float(r1[1]); }
              { auto r0 = __builtin_amdgcn_permlane32_swap(__float_as_uint(ss0), __float_as_uint(ss0), false, false); auto r1 = __builtin_amdgcn_permlane32_swap(__float_as_uint(ss1), __float_as_uint(ss1), false, false);
                ss0 = __uint_as_float(r0[0]) + __uint_as_float(r0[1]); ss1 = __uint_as_float(r1[0]) + __uint_as_float(r1[1]); }
              if (g == 0) { nrm[(n & 1) * 256 + w * 32 + c16] = ss0; nrm[(n & 1) * 256 + w * 32 + 16 + c16] = ss1; } }
            if (n > 0) HG_FINAL(n - 1, pn);
            oprev[0] = o[0]; oprev[1] = o[1]; gprev[0] = gcur[0]; gprev[1] = gcur[1];
        }
        asm volatile("s_waitcnt vmcnt(0) lgkmcnt(0)\n\ts_barrier" ::: "memory");
        { float pn[2][8];
#pragma unroll
            for (int tt = 0; tt < 2; ++tt)
#pragma unroll
                for (int ww = 0; ww < 8; ++ww) pn[tt][ww] = nrm[((NSTEP - 1) & 1) * 256 + ww * 32 + 16 * tt + c16];
            HG_FINAL(NSTEP - 1, pn); }
        asm volatile("s_waitcnt vmcnt(0) lgkmcnt(0)\n\ts_barrier" ::: "memory");
#undef RO
#undef KO
#undef HG_LOADQ
#undef HG_FINAL
#undef HG_ISSUE
    }
}

struct Args { const float* in[8]; float* out; unsigned char* ws; int ph_lo, ph_hi, li, pad; };
__global__ void __launch_bounds__(NWAVES * 64, 2) fwd(Args args) {
    extern __shared__ __attribute__((aligned(16))) unsigned char lds[];
    Frame F;
    F.lds = (LAS unsigned char*)lds;
    F.MISC = (volatile LAS unsigned*)(F.lds + MISC_OFF);
    F.G = gridDim.x; { const int bx = blockIdx.x; F.vcu = (F.G % 8 == 0) ? (bx % 8) * (F.G / 8) + bx / 8 : bx; }
    unsigned char* ws = args.ws;
    F.ctl = (gu32*)(ws + WS_CTL);
    F.x = args.in[0]; F.norm_w = args.in[1]; F.w_in = args.in[2]; F.lb_logits = args.in[3]; F.hg_norm_w = args.in[4]; F.q_norm_w = args.in[5]; F.k_norm_w = args.in[6]; F.w_out = args.in[7];
    F.out = args.out;
    F.WIN = (bf16*)(ws + WS_WIN); F.WOUT = (bf16*)(ws + WS_WOUT); F.XB = (bf16*)(ws + WS_XB); F.MIXED = (bf16*)(ws + WS_MIXED);
    F.QI = (bf16*)(ws + WS_ARR); F.KT = (bf16*)(ws + WS_ARR + ARR_BYTES); F.HI = (bf16*)(ws + WS_ARR + 2 * ARR_BYTES); F.GH = (bf16*)(ws + WS_ARR + 3 * ARR_BYTES);
    F.QN = (bf16*)(ws + WS_ARR + 4 * ARR_BYTES); F.KN = (bf16*)(ws + WS_ARR + 5 * ARR_BYTES); F.V = (bf16*)(ws + WS_ARR + 6 * ARR_BYTES); F.GA = (bf16*)(ws + WS_ARR + 7 * ARR_BYTES);
    F.LB = (float*)(ws + WS_LB); F.KPART = (float*)(ws + WS_KPART); F.ROWSS = (float*)(ws + WS_ROWSS); F.DEC = (float*)(ws + WS_DEC);
    F.wave0 = __builtin_amdgcn_readfirstlane((int)threadIdx.x >> 6);
    for (int u = F.wave0 * 64 + lane_id_asm(); u < (LDS_BYTES - LDSCTL_OFF) / 4; u += NWAVES * 64) ((LAS unsigned*)(F.lds + LDSCTL_OFF))[u] = 0u;
    __syncthreads();
    XcdBarrier bar; bar.bar = (unsigned*)(F.ctl + CW_BAR); bar.x = 0; bar.st = nullptr; bar.wave0 = F.wave0;
    if (N_LAUNCHES == 1) bar = xcd_barrier_post((unsigned*)(F.ctl + CW_BAR), F.MISC + 8, F.wave0);
    if (N_LAUNCHES == 1 && XB_IS_T0(F.wave0)) __hip_atomic_fetch_or(F.ctl + 3072 + 64 * (blockIdx.x & 7u), 1u << xb_xcc_id(), __ATOMIC_RELAXED, __HIP_MEMORY_SCOPE_AGENT);
#define GRID_BAR() do { if (N_LAUNCHES == 1) xcd_barrier(bar); } while (0)
#define GRP_BAR() do { if (N_LAUNCHES == 1) { int g_ = (int)(blockIdx.x & 7u); asm volatile("" : "+s"(g_));     \
        if (__builtin_amdgcn_readfirstlane((int)F.MISC[10]) != 0) grp_barrier((unsigned*)(F.ctl + 2048 + 128 * g_), 32u, (unsigned*)(F.ctl + CW_BAR + XB_TMO), F.wave0);     \
        else xcd_barrier(bar); } } while (0)
    const int lo = (N_LAUNCHES == 1) ? 0 : args.ph_lo, hi = (N_LAUNCHES == 1) ? N_PHASES : args.ph_hi;
#define IN(k) (lo <= (k) && (k) < hi)
#define BOTH(k) (IN(k) && IN((k) + 1))

    if (IN(0)) { p0_prologue(F); if (BOTH(0)) GRID_BAR(); }
    if (N_LAUNCHES == 1) {
        if (XB_IS_T0(F.wave0)) { const unsigned m_ = xb_ld((unsigned*)(F.ctl + 3072 + 64 * (blockIdx.x & 7u))); F.MISC[10] = (gridDim.x == 256u && m_ != 0u && (m_ & (m_ - 1u)) == 0u) ? 1u : 0u; }
        __syncthreads(); }
    for (int l = 0; l < DEPTH; ++l) {
        const int pb = 1 + 3 * l;
        if (IN(pb)) {
            pg8::Gemm g{F.XB + (size_t)l * MTOK * DM, F.WIN + (size_t)l * NIN * DM, MTOK, NIN, DM}; pg8::StaticOrder S; S.init(MTOK, NIN, F.G, (int)blockIdx.x, (int)(blockIdx.x & 7));
            pg8::EpiFused E{F.QI, F.DEC, F.KPART, F.ROWSS + (size_t)l * MTOK * 16, F.LB + l * 512, F.q_norm_w + l * 64, F.k_norm_w + l * 64, nullptr, 0};
            {
                pg8::Unit u0{0, 0}, u4{0, 0}, ut; bool two = S.next(0, u0) && S.next(4, u4);
                for (int i = 0; two && S.next(i, ut); ++i) two = (ut.pm == u0.pm || ut.pm == u4.pm);
                if (two) { LAS float* rt = (LAS float*)(F.lds + EXTRA_OFF); int t_ = F.wave0 * 64 + lane_id_asm(); asm volatile("" : "+v"(t_));
                    rt[t_] = pg8::EpiFused::rstd_global(E.rowss, ((t_ >> 8) ? u4.pm : u0.pm) * 256 + (t_ & 255));
                    E.rtab = rt; E.pm0 = u0.pm; __syncthreads(); } }
            for (int rp = 0; rp < REP_PROJ; ++rp) { if (rp) GRID_BAR(); pg8::gemm_phase<pg8::EpiFused, pg8::StaticOrder, true, true>(F.lds + RING_OFF, g, S, E, F.wave0); }
            if (BOTH(pb)) GRP_BAR();
        }
        if (IN(pb + 1)) {
            for (int rp = 0; rp < REP_HGRN; ++rp) { if (rp) GRID_BAR(); hgrn_mfma_phase(F, l); }
            for (int rp = 0; rp < REP_MOBA; ++rp) { if (rp) { GRID_BAR(); if (blockIdx.x == 0 && F.wave0 == 0 && lane_id_asm() == 0) __hip_atomic_store(F.ctl + CW_QUEUE + 64 * l, 0u, RLX_AGENT); GRID_BAR(); } moba_mfma_phase(F, l); }
            if (BOTH(pb + 1)) GRP_BAR(); }
        if (IN(pb + 2)) {
            pg8::Gemm g{F.MIXED, F.WOUT + (size_t)l * DM * DM, MTOK, DM, DM}; pg8::StaticOrder S; S.init(MTOK, DM, F.G, (int)blockIdx.x);
            pg8::EpiOut E{l == 0 ? F.XB : F.XB + (size_t)MTOK * DM, l == 0 ? nullptr : F.out, l == 0 ? F.XB + (size_t)MTOK * DM : nullptr, l == 0 ? F.ROWSS + (size_t)MTOK * 16 : nullptr};
            for (int rp = 0; rp < REP_OUT; ++rp) { if (rp) GRID_BAR(); pg8::gemm_phase<pg8::EpiOut, pg8::StaticOrder, true, true>(F.lds + RING_OFF, g, S, E, F.wave0); }
            if (pb + 2 < N_PHASES - 1 && BOTH(pb + 2)) GRP_BAR();
        }
    }
#undef IN
#undef BOTH
}

extern "C" void kernel_launch(void* const* d_in, const int* in_sizes, int n_in, void* d_out, int out_size, void* d_ws, size_t ws_size, hipStream_t stream) {
    static int grid = 0;
    if (grid == 0) {
        if (n_in != 8 || in_sizes[0] != MTOK * DM || out_size != MTOK * DM || ws_size < WS_END) { fprintf(stderr, "kernel_launch: unexpected shapes n_in %d in0 %d out %d ws %zu\n", n_in, n_in > 0 ? in_sizes[0] : -1, out_size, ws_size); grid = -1; return; }
        int dev = 0, cus = 0, per_cu = 0;
        if (hipGetDevice(&dev) != hipSuccess || hipDeviceGetAttribute(&cus, hipDeviceAttributeMultiprocessorCount, dev) != hipSuccess) { grid = -1; return; }
        if (hipFuncSetAttribute((const void*)fwd, hipFuncAttributeMaxDynamicSharedMemorySize, LDS_BYTES) != hipSuccess) { fprintf(stderr, "kernel_launch: hipFuncSetAttribute failed\n"); grid = -1; return; }
        if (hipOccupancyMaxActiveBlocksPerMultiprocessor(&per_cu, (const void*)fwd, NWAVES * 64, LDS_BYTES) != hipSuccess || per_cu < 1) fprintf(stderr, "kernel_launch: occupancy query says %d\n", per_cu);
        (void)hipGetLastError();
        if (per_cu < 1) { grid = -1; return; }
        grid = cus < 512 ? cus : 512;
    }
    if (grid < 0) return;
    if (hipMemsetAsync((char*)d_ws + WS_CTL, 0, CTL_ZERO_BYTES, stream) != hipSuccess) return;
    Args a{};
    for (int i = 0; i < 8; ++i) a.in[i] = (const float*)d_in[i];
    a.out = (float*)d_out; a.ws = (unsigned char*)d_ws;
    for (int li = 0; li < N_LAUNCHES; ++li) {
        a.ph_lo = (N_LAUNCHES == 1) ? 0 : li; a.ph_hi = (N_LAUNCHES == 1) ? N_PHASES : li + 1; a.li = li;
        hipError_t le;
        if (N_LAUNCHES == 1) { void* kargs[] = {(void*)&a}; le = hipLaunchCooperativeKernel((const void*)fwd, dim3(grid), dim3(NWAVES * 64), kargs, LDS_BYTES, stream); }
        else { hipLaunchKernelGGL(fwd, dim3(grid), dim3(NWAVES * 64), LDS_BYTES, stream, a); le = hipPeekAtLastError(); }
        if (le != hipSuccess) { fprintf(stderr, "kernel_launch: launch %d failed: %s\n", li, hipGetErrorName(le)); break; }
    }
}
```

```cpp
#include <hip/hip_runtime.h>
#include <cstdio>
#include <cstdint>
__device__ __forceinline__ int lane_id_asm() { int l; asm volatile("v_mbcnt_lo_u32_b32 %0, -1, 0\n\tv_mbcnt_hi_u32_b32 %0, -1, %0" : "=v"(l)); return l; }
namespace pg8 {
#define PG8_LAS __attribute__((address_space(3)))
typedef unsigned short bf16_t;
typedef short bf16x8 __attribute__((ext_vector_type(8)));
typedef float f32x4 __attribute__((ext_vector_type(4)));
typedef unsigned u32x4 __attribute__((ext_vector_type(4)));
typedef unsigned u32x2 __attribute__((ext_vector_type(2)));
constexpr int BM = 256, BK = 64, HALF = 128, HTB = HALF * BK * 2  , STAGE_BYTES = 8 * HTB, NXCD = 8, WGM = 8;

__host__ __device__ __forceinline__ int lds_byte(int r, int c) { const int st = (r >> 4) * 2 + (c >> 5), rr = r & 15, cc = c & 31, ob = rr * 64 + cc * 2; return st * 1024 + (ob ^ (((ob >> 9) & 1) << 5)); }
__host__ __device__ __forceinline__ void stage_rc(int b, int& R, int& C) { const int st = b / 1024, sb = b % 1024, swz = sb ^ (((sb >> 9) & 1) << 5); R = (st >> 1) * 16 + swz / 64; C = (st & 1) * 32 + (swz % 64) / 2; }
__host__ __device__ __forceinline__ int perm32(int rho) { const int n = rho >> 4, i = rho & 15; return 8 * (i >> 2) + 4 * n + (i & 3); }

struct Unit { int pm, pn; };
struct Gemm { const bf16_t* A; const bf16_t* Bt; int M, N, K; };

struct StaticOrder {
    int nM, nN, nwg, G, c, rot;
    __host__ __device__ void init(int M, int N, int G_, int c_, int rot_ = 0) { __builtin_assume(c_ >= 0 && c_ < 512);     nM = M / BM; nN = N / BM; nwg = nM * nN; G = G_; c = c_; rot = (nwg == 8 * G_) ? rot_ : 0; }
    __host__ __device__ bool next(int i, Unit& u) const {
        if ((long)i * G + c >= nwg) return false;
        const long L = (long)((i + rot) & (rot ? 7 : -1)) * G + c;
        int wgid = (int)L; { const int q = nwg / NXCD, r = nwg % NXCD, xcd = wgid % NXCD, off = wgid / NXCD; wgid = (xcd < r ? xcd * (q + 1) : r * (q + 1) + (xcd - r) * q) + off; }
        const int nig = WGM * nN, gid = wgid / nig, fm = gid * WGM, gsz = (nM - fm) < WGM ? (nM - fm) : WGM;
        u.pm = fm + ((wgid % nig) % gsz); u.pn = (wgid % nig) / gsz; return true;
    }
    __device__ __forceinline__ void a_ready(const Unit&) const {}
    __device__ __forceinline__ void done(const Unit&) const {}
};

__device__ __forceinline__ unsigned cvt_pk_bf16(float lo, float hi) { unsigned r; asm volatile("v_cvt_pk_bf16_f32 %0, %1, %2" : "=v"(r) : "v"(lo), "v"(hi)); return r; }


__device__ __forceinline__ float dpp_row_shr(float v, int n) {
    const int x = __builtin_bit_cast(int, v);
    int r;
    if (n == 1) r = __builtin_amdgcn_update_dpp(0, x, 0x111, 0xf, 0xf, false);
    else if (n == 2) r = __builtin_amdgcn_update_dpp(0, x, 0x112, 0xf, 0xf, false);
    else if (n == 4) r = __builtin_amdgcn_update_dpp(0, x, 0x114, 0xf, 0xf, false);
    else r = __builtin_amdgcn_update_dpp(0, x, 0x118, 0xf, 0xf, false);
    return __builtin_bit_cast(float, r);
}
__device__ __forceinline__ float dpp_row_shr1(float v, int n) {
    const int x = __builtin_bit_cast(int, v); const int one = 0x3f800000;
    int r;
    if (n == 1) r = __builtin_amdgcn_update_dpp(one, x, 0x111, 0xf, 0xf, false);
    else if (n == 2) r = __builtin_amdgcn_update_dpp(one, x, 0x112, 0xf, 0xf, false);
    else if (n == 4) r = __builtin_amdgcn_update_dpp(one, x, 0x114, 0xf, 0xf, false);
    else r = __builtin_amdgcn_update_dpp(one, x, 0x118, 0xf, 0xf, false);
    return __builtin_bit_cast(float, r);
}
__device__ __forceinline__ float fsig(float z) { return __builtin_amdgcn_rcpf(1.0f + __expf(-z)); }
struct EpiFused {
    static constexpr bool PERM = true, AFTER_DRAIN = false;
    bf16_t* ARR; float* DEC; float* KPART; const float* rowss; const float* lb; const float* qg; const float* kg;
    static constexpr size_t AS = (size_t)32768 * 512;
    const PG8_LAS float* rtab; int pm0;
    __device__ __forceinline__ float rstd_of(int row) const { return rtab ? rtab[(((row >> 8) == pm0) ? 0 : 256) + (row & 255)] : rstd_global(rowss, row); }
    static __device__ __forceinline__ float rstd_global(const float* rowss, int row) {
        const f32x4* rp = (const f32x4*)(rowss + (size_t)row * 16);
        const f32x4 a = rp[0], b = rp[1], c = rp[2], d = rp[3];
        const float ss = ((a[0] + a[1]) + (a[2] + a[3])) + ((b[0] + b[1]) + (b[2] + b[3])) + ((c[0] + c[1]) + (c[2] + c[3])) + ((d[0] + d[1]) + (d[2] + d[3]));
        return 1.0f / sqrtf(ss * (1.0f / 1024.0f) + 1e-6f);
    }
    static __device__ __forceinline__ u32x4 pack8(const float (&v)[8]) { u32x4 w; w.x = cvt_pk_bf16(v[0], v[1]); w.y = cvt_pk_bf16(v[2], v[3]); w.z = cvt_pk_bf16(v[4], v[5]); w.w = cvt_pk_bf16(v[6], v[7]); return w; }
    __device__ __forceinline__ void operator()(const f32x4 (&acc)[2][2][4][2], const Unit& u, int wr, int wc, int fr, int fq) const {
        const int row0 = u.pm * BM + wr * 64 + fr; const int pn = u.pn;
        if (pn < 4) {
            const int cb = pn * 128 + wc * 32 + 8 * fq;
            float lbv[8];
#pragma unroll
            for (int k = 0; k < 8; ++k) lbv[k] = lb[cb + k];
#pragma unroll
            for (int ai = 0; ai < 2; ++ai)
#pragma unroll
                for (int mp = 0; mp < 2; ++mp) { const int row1 = row0 + ai * HALF + mp * 32, row2 = row1 + 16; const float rs1 = rstd_of(row1), rs2 = rstd_of(row2);
                    float qi1[8], kt1[8], qi2[8], kt2[8], dc[8];
#pragma unroll
                    for (int k = 0; k < 8; ++k) {
                        const float zq1 = acc[ai][0][2 * mp][k >> 2][k & 3] * rs1, zf1 = acc[ai][1][2 * mp][k >> 2][k & 3] * rs1;
                        const float zq2 = acc[ai][0][2 * mp + 1][k >> 2][k & 3] * rs2, zf2 = acc[ai][1][2 * mp + 1][k >> 2][k & 3] * rs2;
                        const float f1 = lbv[k] + (1.0f - lbv[k]) * fsig(zf1), f2 = lbv[k] + (1.0f - lbv[k]) * fsig(zf2);
                        float e1 = f1, e2 = f2;
                        e1 *= dpp_row_shr1(e1, 1); e2 *= dpp_row_shr1(e2, 1); e1 *= dpp_row_shr1(e1, 2); e2 *= dpp_row_shr1(e2, 2);
                        e1 *= dpp_row_shr1(e1, 4); e2 *= dpp_row_shr1(e2, 4); e1 *= dpp_row_shr1(e1, 8); e2 *= dpp_row_shr1(e2, 8);
                        e2 *= __shfl(e1, (fq << 4) | 15);
                        qi1[k] = zq1 * fsig(zq1) * e1; kt1[k] = (1.0f - f1) * fminf(__builtin_amdgcn_rcpf(e1), 5.5406224e34f);
                        qi2[k] = zq2 * fsig(zq2) * e2; kt2[k] = (1.0f - f2) * fminf(__builtin_amdgcn_rcpf(e2), 5.5406224e34f); dc[k] = e2; }
                    { const int pc = pn * 128 + wc * 32 + 16 * (fq & 1) + 4 * (fq >> 1);
                      const u32x4 a1 = pack8(qi1), b1 = pack8(kt1), a2 = pack8(qi2), b2 = pack8(kt2);
                      bf16_t* q1 = ARR + (size_t)row1 * 512 + pc; bf16_t* q2 = ARR + (size_t)row2 * 512 + pc;
                      *(u32x2*)(q1) = (u32x2){a1.x, a1.y}; *(u32x2*)(q1 + 8) = (u32x2){a1.z, a1.w}; *(u32x2*)(q1 + AS) = (u32x2){b1.x, b1.y}; *(u32x2*)(q1 + AS + 8) = (u32x2){b1.z, b1.w};
                      *(u32x2*)(q2) = (u32x2){a2.x, a2.y}; *(u32x2*)(q2 + 8) = (u32x2){a2.z, a2.w}; *(u32x2*)(q2 + AS) = (u32x2){b2.x, b2.y}; *(u32x2*)(q2 + AS + 8) = (u32x2){b2.z, b2.w}; }
                    if (fr == 15) { float* dp = DEC + (size_t)(row1 >> 5) * 512 + cb; *(f32x4*)dp = (f32x4){dc[0], dc[1], dc[2], dc[3]}; *(f32x4*)(dp + 4) = (f32x4){dc[4], dc[5], dc[6], dc[7]}; }
                    asm volatile("" ::: "memory"); }
        } else if (pn < 8) {
            const int cb = (pn - 4) * 128 + wc * 32 + 8 * fq;
#pragma unroll
            for (int ai = 0; ai < 2; ++ai)
#pragma unroll
                for (int m = 0; m < 4; ++m) { const int row = row0 + ai * HALF + m * 16; const float rs = rstd_of(row);
                    float iv[8], gv[8];
#pragma unroll
                    for (int k = 0; k < 8; ++k) { iv[k] = acc[ai][0][m][k >> 2][k & 3] * rs; const float zg = acc[ai][1][m][k >> 2][k & 3] * rs; gv[k] = zg * fsig(zg); }
                    *(u32x4*)(ARR + 2 * AS + (size_t)row * 512 + cb) = pack8(iv); *(u32x4*)(ARR + 3 * AS + (size_t)row * 512 + cb) = pack8(gv);
                    asm volatile("" ::: "memory"); }
        } else {
            const int ty = (pn - 8) >> 1, head = 4 * ((pn - 8) & 1) + wc; const int d0 = 8 * fq;
            bf16_t* dst = ARR + (size_t)(4 + ty) * AS;
            float gain[2][8]; float csum[2][8];
#pragma unroll
            for (int bj = 0; bj < 2; ++bj)
#pragma unroll
                for (int k = 0; k < 8; ++k) { gain[bj][k] = (ty == 0) ? qg[bj * 32 + d0 + k] * (0.125f * 1.4426950408889634f) : (ty == 1) ? kg[bj * 32 + d0 + k] : 1.0f; csum[bj][k] = 0.f; }
#pragma unroll
            for (int ai = 0; ai < 2; ++ai)
#pragma unroll
                for (int m = 0; m < 4; ++m) { const int row = row0 + ai * HALF + m * 16; const float rs = rstd_of(row);
                    float v[2][8];
#pragma unroll
                    for (int bj = 0; bj < 2; ++bj)
#pragma unroll
                        for (int k = 0; k < 8; ++k) v[bj][k] = acc[ai][bj][m][k >> 2][k & 3] * rs;
                    if (ty < 2) { float ss = 0.f;
#pragma unroll
                        for (int bj = 0; bj < 2; ++bj)
#pragma unroll
                            for (int k = 0; k < 8; ++k) ss += v[bj][k] * v[bj][k];
                        ss += __shfl_xor(ss, 16); ss += __shfl_xor(ss, 32);
                        const float r2 = 1.0f / sqrtf(ss * (1.0f / 64.0f) + 1e-6f);
#pragma unroll
                        for (int bj = 0; bj < 2; ++bj)
#pragma unroll
                            for (int k = 0; k < 8; ++k) { v[bj][k] *= r2 * gain[bj][k]; csum[bj][k] += v[bj][k]; }
                    } else if (ty == 3) {
#pragma unroll
                        for (int bj = 0; bj < 2; ++bj)
#pragma unroll
                            for (int k = 0; k < 8; ++k) v[bj][k] = v[bj][k] * fsig(v[bj][k]); }
                    *(u32x4*)(dst + (size_t)row * 512 + head * 64 + d0) = pack8(v[0]); *(u32x4*)(dst + (size_t)row * 512 + head * 64 + 32 + d0) = pack8(v[1]);
                    asm volatile("" ::: "memory"); }
            if (ty == 1) {
#pragma unroll
                for (int bj = 0; bj < 2; ++bj)
#pragma unroll
                    for (int k = 0; k < 8; ++k) { float s = csum[bj][k]; s += __shfl_xor(s, 1); s += __shfl_xor(s, 2); s += __shfl_xor(s, 4); s += __shfl_xor(s, 8); csum[bj][k] = s; }
                if (fr == 0) { float* kp = KPART + ((size_t)u.pm * 2 + wr) * 512 + head * 64 + d0;
#pragma unroll
                    for (int bj = 0; bj < 2; ++bj) { *(f32x4*)(kp + bj * 32) = (f32x4){csum[bj][0], csum[bj][1], csum[bj][2], csum[bj][3]}; *(f32x4*)(kp + bj * 32 + 4) = (f32x4){csum[bj][4], csum[bj][5], csum[bj][6], csum[bj][7]}; } }
            }
        }
    }
};
struct EpiOut {
    static constexpr bool PERM = true, AFTER_DRAIN = false;
    const bf16_t* xres16; float* out; bf16_t* xb; float* rowss;
    __device__ __forceinline__ void operator()(const f32x4 (&acc)[2][2][4][2], const Unit& u, int wr, int wc, int fr, int fq) const {
        const int col0 = u.pn * BM + wc * 32 + 8 * fq;
        const size_t base = (size_t)(u.pm * BM + wr * 64 + fr) * 1024 + col0;
        u32x4 res[2][4][2];
#pragma unroll
        for (int ai = 0; ai < 2; ++ai)
#pragma unroll
            for (int m = 0; m < 4; ++m)
#pragma unroll
                for (int bj = 0; bj < 2; ++bj) res[ai][m][bj] = *(const u32x4*)(xres16 + base + (size_t)(ai * HALF + m * 16) * 1024 + bj * HALF);
#pragma unroll
        for (int ai = 0; ai < 2; ++ai)
#pragma unroll
            for (int m = 0; m < 4; ++m) {
                const int row = u.pm * BM + ai * HALF + wr * 64 + m * 16 + fr; float ss = 0.f;
#pragma unroll
                for (int bj = 0; bj < 2; ++bj) { const size_t off = (size_t)row * 1024 + col0 + bj * HALF;
                    const u32x4 r = res[ai][m][bj];
                    f32x4 v0 = (f32x4){__builtin_bit_cast(float, r.x << 16), __builtin_bit_cast(float, r.x & 0xffff0000u), __builtin_bit_cast(float, r.y << 16), __builtin_bit_cast(float, r.y & 0xffff0000u)};
                    f32x4 v1 = (f32x4){__builtin_bit_cast(float, r.z << 16), __builtin_bit_cast(float, r.z & 0xffff0000u), __builtin_bit_cast(float, r.w << 16), __builtin_bit_cast(float, r.w & 0xffff0000u)};
                    v0 = v0 + acc[ai][bj][m][0]; v1 = v1 + acc[ai][bj][m][1];
                    if (out) { *(f32x4*)(out + off) = v0; *(f32x4*)(out + off + 4) = v1; }
                    if (xb) { u32x4 w; w.x = cvt_pk_bf16(v0[0], v0[1]); w.y = cvt_pk_bf16(v0[2], v0[3]); w.z = cvt_pk_bf16(v1[0], v1[1]); w.w = cvt_pk_bf16(v1[2], v1[3]); *(u32x4*)(xb + off) = w; }
                    ss += ((v0[0] * v0[0] + v0[1] * v0[1]) + (v0[2] * v0[2] + v0[3] * v0[3])) + ((v1[0] * v1[0] + v1[1] * v1[1]) + (v1[2] * v1[2] + v1[3] * v1[3])); }
                ss += __shfl_xor(ss, 16); ss += __shfl_xor(ss, 32);
                if (fq == 0 && rowss) rowss[(size_t)row * 16 + u.pn * 4 + wc] = ss;
            }
    }
};

template <class Epi, class Sched, bool ALIGN_EPI = false, bool SP2 = false>
__device__ __forceinline__ void gemm_phase(PG8_LAS unsigned char* lds, const Gemm g, const Sched& S, const Epi& E, const int wave0) {
    int tid = wave0 * 64 + lane_id_asm(); asm volatile("" : "+v"(tid));
    const int wid = __builtin_amdgcn_readfirstlane(tid >> 6), lane = tid & 63, wr = wid >> 2, wc = wid & 3, fr = lane & 15, fq = lane >> 4;
    const int K = g.K, nt = K / BK;
    unsigned voffA[2], voffB[2];
#pragma unroll
    for (int i = 0; i < 2; ++i) { int R, C; stage_rc(tid * 16 + i * 8192, R, C); const int Rb = Epi::PERM ? ((R & ~31) + perm32(R & 31)) : R;
        voffA[i] = (unsigned)(R * K + C) * 2u; voffB[i] = (unsigned)(Rb * K + C) * 2u; }
    const size_t kstep = (size_t)(BK * 2);
    const size_t hstep = (size_t)HALF * K * 2;
    const size_t tstep = 2 * hstep;
    const unsigned ldsw = (unsigned)wid * 1024u;
    const int aoff = lds_byte(wr * 64 + fr, fq * 8), boff = lds_byte(wc * 32 + fr, fq * 8);
#define PG8_SA(b, h) (((b) * 2 + (h)) * HTB)
#define PG8_SB(b, h) ((4 + (b) * 2 + (h)) * HTB)
#define PG8_STAGE(bufoff, gbase, voff) do { _Pragma("unroll") for (int _i = 0; _i < 2; ++_i) \
        __builtin_amdgcn_global_load_lds((const unsigned*)((const char*)(gbase) + (voff)[_i]), (PG8_LAS unsigned*)(lds + (bufoff) + ldsw + _i * 8192), 16, 0, 0); } while (0)
#define PG8_LDA(dst, b, h) do { _Pragma("unroll") for (int m = 0; m < 4; ++m) _Pragma("unroll") for (int k = 0; k < 2; ++k) dst[m][k] = *(const PG8_LAS bf16x8*)(lds + PG8_SA(b, h) + aoff + m * 2048 + k * 1024); } while (0)
#define PG8_LDB(dst, b, h) do { _Pragma("unroll") for (int n = 0; n < 2; ++n) _Pragma("unroll") for (int k = 0; k < 2; ++k) dst[n][k] = *(const PG8_LAS bf16x8*)(lds + PG8_SB(b, h) + boff + n * 2048 + k * 1024); } while (0)
#define PG8_MMA(ai, bj, At, Bt) do { __builtin_amdgcn_s_setprio(1); _Pragma("unroll") for (int m = 0; m < 4; ++m) _Pragma("unroll") for (int n = 0; n < 2; ++n) _Pragma("unroll") for (int k = 0; k < 2; ++k) \
        acc[ai][bj][m][n] = __builtin_amdgcn_mfma_f32_16x16x32_bf16(Bt[n][k], At[m][k], acc[ai][bj][m][n], 0, 0, 0); __builtin_amdgcn_s_setprio(0); } while (0)
#define PG8_WAIT_V(n) asm volatile("s_waitcnt vmcnt(" #n ")" ::: "memory")
#define PG8_WAIT_L(n) asm volatile("s_waitcnt lgkmcnt(" #n ")" ::: "memory")
#define PG8_BAR __builtin_amdgcn_s_barrier()
#define PG8_SCHED __builtin_amdgcn_sched_barrier(0)
    Unit cur, nxt; int ui = 0;
    if (!S.next(0, cur)) return;
    f32x4 acc[2][2][4][2];
#pragma unroll
    for (int a = 0; a < 2; ++a)
#pragma unroll
        for (int b = 0; b < 2; ++b)
#pragma unroll
            for (int m = 0; m < 4; ++m)
#pragma unroll
                for (int n = 0; n < 2; ++n) acc[a][b][m][n] = (f32x4){0.f, 0.f, 0.f, 0.f};
    bf16x8 At[4][2], B0[2][2], B1[2][2];
    const char* cA = (const char*)g.A + (size_t)cur.pm * tstep; const char* cB = (const char*)g.Bt + (size_t)cur.pn * tstep;
    S.a_ready(cur);
    if constexpr (SP2) {
        PG8_STAGE(PG8_SB(0, 0), cB, voffB); PG8_STAGE(PG8_SB(0, 1), cB + hstep, voffB); PG8_STAGE(PG8_SA(0, 0), cA, voffA); PG8_STAGE(PG8_SA(0, 1), cA + hstep, voffA);
        if (wr == 1) PG8_BAR;
        PG8_WAIT_V(2); PG8_BAR;
        PG8_STAGE(PG8_SB(1, 0), cB + kstep, voffB); PG8_STAGE(PG8_SA(1, 0), cA + kstep, voffA); PG8_STAGE(PG8_SB(1, 1), cB + hstep + kstep, voffB);
        PG8_WAIT_V(6); PG8_BAR;
    } else {
        PG8_STAGE(PG8_SB(0, 0), cB, voffB); PG8_STAGE(PG8_SA(0, 0), cA, voffA); PG8_STAGE(PG8_SB(0, 1), cB + hstep, voffB); PG8_STAGE(PG8_SA(0, 1), cA + hstep, voffA);
        if (wr == 1) PG8_BAR;
        PG8_WAIT_V(4); PG8_BAR;
        PG8_STAGE(PG8_SB(1, 0), cB + kstep, voffB); PG8_STAGE(PG8_SA(1, 0), cA + kstep, voffA); PG8_STAGE(PG8_SB(1, 1), cB + hstep + kstep, voffB);
        PG8_WAIT_V(6); PG8_BAR;
    }
    for (;;) {
        const bool has_next = S.next(ui + 1, nxt);
        const char* nA = has_next ? (const char*)g.A + (size_t)nxt.pm * tstep : cA; const char* nB = has_next ? (const char*)g.Bt + (size_t)nxt.pn * tstep : cB;
        for (int t = 0; t < nt; t += 2) {
            const bool last = (t == nt - 2);
            const char* a1 = cA + (size_t)(t + 1) * kstep;
            const char* a2 = last ? nA : cA + (size_t)(t + 2) * kstep; const char* b2 = last ? nB : cB + (size_t)(t + 2) * kstep;
            const char* a3 = a2 + kstep; const char* b3 = b2 + kstep;
            if (last && has_next) S.a_ready(nxt);
            if constexpr (SP2) {
            PG8_LDB(B0, 0, 0); PG8_LDB(B1, 0, 1); PG8_SCHED; PG8_LDA(At, 0, 0); PG8_STAGE(PG8_SA(1, 1), a1 + hstep, voffA);
            PG8_WAIT_V(8); PG8_WAIT_L(0); PG8_BAR; PG8_MMA(0, 0, At, B0); PG8_MMA(0, 1, At, B1); PG8_BAR; PG8_SCHED;
            PG8_LDA(At, 0, 1); PG8_STAGE(PG8_SB(0, 0), b2, voffB); PG8_STAGE(PG8_SB(0, 1), b2 + hstep, voffB); PG8_STAGE(PG8_SA(0, 0), a2, voffA);
            PG8_WAIT_V(8); PG8_WAIT_L(0); PG8_BAR; PG8_MMA(1, 0, At, B0); PG8_MMA(1, 1, At, B1); PG8_BAR; PG8_SCHED;
            PG8_LDB(B0, 1, 0); PG8_LDB(B1, 1, 1); PG8_SCHED; PG8_LDA(At, 1, 0); PG8_STAGE(PG8_SA(0, 1), a2 + hstep, voffA);
            PG8_WAIT_V(8); PG8_WAIT_L(0); PG8_BAR; PG8_MMA(0, 0, At, B0); PG8_MMA(0, 1, At, B1); PG8_BAR; PG8_SCHED;
            PG8_LDA(At, 1, 1); PG8_STAGE(PG8_SB(1, 0), b3, voffB); PG8_STAGE(PG8_SB(1, 1), b3 + hstep, voffB); PG8_STAGE(PG8_SA(1, 0), a3, voffA);
            PG8_WAIT_V(8); PG8_WAIT_L(0); PG8_BAR; PG8_MMA(1, 0, At, B0); PG8_MMA(1, 1, At, B1); PG8_BAR; PG8_SCHED;
            } else {
            PG8_LDB(B0, 0, 0); PG8_SCHED; PG8_LDA(At, 0, 0); PG8_STAGE(PG8_SA(1, 1), a1 + hstep, voffA);
            PG8_WAIT_L(8); PG8_BAR; PG8_WAIT_L(0); PG8_MMA(0, 0, At, B0); PG8_BAR; PG8_SCHED;
            PG8_LDB(B1, 0, 1); PG8_STAGE(PG8_SB(0, 0), b2, voffB);
            PG8_BAR; PG8_WAIT_L(0); PG8_MMA(0, 1, At, B1); PG8_BAR;
            PG8_LDA(At, 0, 1); PG8_STAGE(PG8_SA(0, 0), a2, voffA);
            PG8_BAR; PG8_WAIT_L(0); PG8_MMA(1, 0, At, B0); PG8_BAR; PG8_SCHED;
            PG8_STAGE(PG8_SB(0, 1), b2 + hstep, voffB);
            PG8_WAIT_V(6); PG8_BAR; PG8_MMA(1, 1, At, B1); PG8_BAR;
            PG8_LDB(B0, 1, 0); PG8_SCHED; PG8_LDA(At, 1, 0); PG8_STAGE(PG8_SA(0, 1), a2 + hstep, voffA);
            PG8_WAIT_L(8); PG8_BAR; PG8_WAIT_L(0); PG8_MMA(0, 0, At, B0); PG8_BAR; PG8_SCHED;
            PG8_LDB(B1, 1, 1); PG8_STAGE(PG8_SB(1, 0), b3, voffB);
            PG8_BAR; PG8_WAIT_L(0); PG8_MMA(0, 1, At, B1); PG8_BAR;
            PG8_LDA(At, 1, 1); PG8_STAGE(PG8_SA(1, 0), a3, voffA);
            PG8_BAR; PG8_WAIT_L(0); PG8_MMA(1, 0, At, B0); PG8_BAR; PG8_SCHED;
            PG8_STAGE(PG8_SB(1, 1), b3 + hstep, voffB);
            PG8_WAIT_V(6); PG8_BAR; PG8_MMA(1, 1, At, B1); PG8_BAR;
            }
        }
        if constexpr (ALIGN_EPI) { if (wr == 0) PG8_BAR; }
        if constexpr (!Epi::AFTER_DRAIN) { E(acc, cur, wr, wc, fr, fq); S.done(cur); }
        if (!has_next) break;
#pragma unroll
        for (int a = 0; a < 2; ++a)
#pragma unroll
            for (int b = 0; b < 2; ++b)
#pragma unroll
                for (int m = 0; m < 4; ++m)
#pragma unroll
                    for (int n = 0; n < 2; ++n) acc[a][b][m][n] = (f32x4){0.f, 0.f, 0.f, 0.f};
        cur = nxt; cA = nA; cB = nB; ++ui;
        if constexpr (ALIGN_EPI) { if (wr == 1) PG8_BAR; }
    }
    PG8_WAIT_V(0);
    if constexpr (!ALIGN_EPI) { if (wr == 0) PG8_BAR; }
    PG8_BAR;
    if constexpr (Epi::AFTER_DRAIN) { E.fused(acc, cur, wr, wc, fr, fq, lds, wid, lane); S.done(cur); }
#undef PG8_SA
#undef PG8_SB
#undef PG8_STAGE
#undef PG8_LDA
#undef PG8_LDB
#undef PG8_MMA
#undef PG8_WAIT_V
#undef PG8_WAIT_L
#undef PG8_BAR
#undef PG8_SCHED
}
}


constexpr int NWAVES = 8;
#ifndef REP_PROJ
#define REP_PROJ 1
#endif
#ifndef REP_HGRN
#define REP_HGRN 1
#endif
#ifndef REP_MOBA
#define REP_MOBA 1
#endif
#ifndef REP_OUT
#define REP_OUT 1
#endif
#ifndef MK_N_LAUNCHES
#define MK_N_LAUNCHES 1
#endif
constexpr int N_PHASES = 7;
constexpr int N_LAUNCHES = MK_N_LAUNCHES;

constexpr int BATCH = 16, SEQ = 2048, DM = 1024, DEPTH = 2, MTOK = BATCH * SEQ, NIN = 4096;
constexpr int C_HQ = 0, C_HF = 512, C_HI = 1024, C_HG = 1536, C_AQ = 2048, C_AK = 2560, C_AV = 3072, C_AG = 3584;
constexpr float NORM_EPS = 1e-6f;

constexpr size_t MiB = 1u << 20;
constexpr size_t WS_CTL = 0, CTL_ZERO_BYTES = 32768;
constexpr size_t WS_WIN = 2 * MiB;
constexpr size_t WS_WOUT = 18 * MiB;
constexpr size_t WS_LB = 22 * MiB;
constexpr size_t WS_KPART = 22 * MiB + 65536;
constexpr size_t WS_ROWSS = 24 * MiB;
constexpr size_t WS_DEC = 28 * MiB;
constexpr size_t WS_XB = 32 * MiB;
constexpr size_t WS_MIXED = 160 * MiB;
constexpr size_t WS_ARR = 224 * MiB;
constexpr size_t ARR_BYTES = 32 * MiB;
constexpr size_t WS_END = 480 * MiB;
constexpr int CW_QUEUE = 1024;
constexpr int CW_BAR = 4096;

constexpr int RING_OFF = 0, RING_BYTES = 131072;
constexpr int EXTRA_OFF = RING_BYTES, EXTRA_BYTES = 16384;
constexpr int LDSCTL_OFF = EXTRA_OFF + EXTRA_BYTES, MISC_OFF = LDSCTL_OFF + 320;
constexpr int LDS_BYTES = LDSCTL_OFF + 1024;

#define GAS __attribute__((address_space(1)))
#define LAS __attribute__((address_space(3)))
typedef unsigned short bf16;
typedef unsigned v4u __attribute__((ext_vector_type(4)));
typedef float f32x4 __attribute__((ext_vector_type(4)));
typedef GAS unsigned gu32;
#define RLX_AGENT __ATOMIC_RELAXED, __HIP_MEMORY_SCOPE_AGENT
#define LDS_WAIT() asm volatile("s_waitcnt lgkmcnt(0)" ::: "memory")
#define VM_WAIT() asm volatile("s_waitcnt vmcnt(0)" ::: "memory")
__device__ __forceinline__ unsigned f2bf(float f) { unsigned u = __builtin_bit_cast(unsigned, f); return (u + 0x7fffu + ((u >> 16) & 1u)) >> 16; }
__device__ __forceinline__ unsigned pk2(float lo, float hi) { return f2bf(lo) | (f2bf(hi) << 16); }
__device__ __forceinline__ float bf2f(unsigned short b) { return __builtin_bit_cast(float, (unsigned)b << 16); }
__device__ __forceinline__ float bflo(unsigned w) { return __builtin_bit_cast(float, w << 16); }
__device__ __forceinline__ float bfhi(unsigned w) { return __builtin_bit_cast(float, w & 0xffff0000u); }
__device__ __forceinline__ float silu_f(float z) { return z / (1.0f + __expf(-z)); }
__device__ __forceinline__ float sigmoid_f(float z) { return 1.0f / (1.0f + __expf(-z)); }

#define XB_TMO      128
#define XB_XCNT(j)  (256  + 64 * (j))
#define XB_XSUB(j)  (1280 + 64 * (j))
#define XB_XGEN(j)  (2304 + 64 * (j))
#define XB_TOP      3328
#define XB_TOPGEN   3392
#define XCD_BAR_WORDS 3456
#define XB_SPIN_CAP (1u << 18)

__device__ __forceinline__ unsigned xb_ld(unsigned* p)              { return __hip_atomic_load(p, __ATOMIC_RELAXED, __HIP_MEMORY_SCOPE_AGENT); }
__device__ __forceinline__ unsigned xb_add(unsigned* p, unsigned v) { return __hip_atomic_fetch_add(p, v, __ATOMIC_RELAXED, __HIP_MEMORY_SCOPE_AGENT); }
__device__ __forceinline__ unsigned xb_xcc_id() { return (unsigned)__builtin_amdgcn_s_getreg((3 << 11) | 20) & 0xFu; }
#define XB_SPIN(cond, bar) do { unsigned _sp = 0; while (cond) { __builtin_amdgcn_s_sleep(1); \
    if ((++_sp & 255u) == 0u) { if (xb_ld(&(bar)[XB_TMO])) break; if (_sp > XB_SPIN_CAP) { atomicAdd(&(bar)[XB_TMO], 1u); break; } } } } while (0)

struct XcdBarrier {
    unsigned* bar; unsigned x; int wave0;
    volatile LAS unsigned* st;
};

#define XB_IS_T0(wv) ((wv) == 0 && lane_id_asm() == 0)
__device__ __forceinline__ XcdBarrier xcd_barrier_post(unsigned* bar, volatile LAS unsigned* st, int wave0) {
    XcdBarrier b; b.bar = bar; b.x = xb_xcc_id(); b.st = st; b.wave0 = wave0;
    if (XB_IS_T0(wave0)) (void)xb_add(&bar[XB_XCNT(b.x)], 1u);
    return b;
}
__device__ __forceinline__ void xcd_barrier_complete(unsigned* bar, unsigned x, unsigned& nloc, unsigned& nx) {
    const unsigned G = gridDim.x * gridDim.y * gridDim.z;
    unsigned sum, cnt, mine, sp = 0u;
    for (;;) {
        sum = 0u; cnt = 0u; mine = 0u;
#pragma unroll
        for (unsigned j = 0; j < 16; ++j) { const unsigned c = xb_ld(&bar[XB_XCNT(j)]); sum += c; cnt += (c > 0u) ? 1u : 0u; mine = (j == x) ? c : mine; }
        if (sum == G) break;
        __builtin_amdgcn_s_sleep(1);
        if ((++sp & 255u) == 0u) { if (xb_ld(&bar[XB_TMO])) break; if (sp > XB_SPIN_CAP) { atomicAdd(&bar[XB_TMO], 1u); break; } }
    }
    nloc = mine > 0u ? mine : 1u; nx = cnt > 0u ? cnt : 1u;
}

__device__ __forceinline__ void xcd_barrier(const XcdBarrier& b) {
    asm volatile("s_waitcnt vmcnt(0)" ::: "memory");
    __syncthreads();
    if (XB_IS_T0(b.wave0)) {
        unsigned* bar = b.bar;
        __builtin_amdgcn_s_waitcnt(0);
        unsigned nloc = b.st[0], nx = b.st[1];
        if (nloc == 0u) { xcd_barrier_complete(bar, b.x, nloc, nx); b.st[0] = nloc; b.st[1] = nx; }
        const unsigned old = xb_add(&bar[XB_XSUB(b.x)], 1u);
        const unsigned gen = old / nloc;
        if (old + 1u == (gen + 1u) * nloc) {
            __builtin_amdgcn_fence(__ATOMIC_RELEASE, "agent");
            asm volatile("s_waitcnt vmcnt(0)" ::: "memory");
            const unsigned og = xb_add(&bar[XB_TOP], 1u);
            const unsigned tg = og / nx;
            if (og + 1u == (tg + 1u) * nx) xb_add(&bar[XB_TOPGEN], 1u);
            else XB_SPIN(xb_ld(&bar[XB_TOPGEN]) == tg, bar);
            __builtin_amdgcn_fence(__ATOMIC_ACQUIRE, "agent");
            xb_add(&bar[XB_XGEN(b.x)], 1u);
            asm volatile("s_waitcnt vmcnt(0)" ::: "memory");
        } else {
            XB_SPIN(xb_ld(&bar[XB_XGEN(b.x)]) == gen, bar);
            __builtin_amdgcn_fence(__ATOMIC_ACQUIRE, "agent");
            asm volatile("s_waitcnt vmcnt(0)" ::: "memory");
        }
    }
    __syncthreads();
}


__device__ __forceinline__ void grp_barrier(unsigned* cnt, unsigned n, unsigned* tmo, int wave0) {
    asm volatile("s_waitcnt vmcnt(0)" ::: "memory");
    __syncthreads();
    if (XB_IS_T0(wave0)) {
        __builtin_amdgcn_s_waitcnt(0);
        const unsigned old = xb_add(cnt, 1u); const unsigned gen = old / n;
        if (old + 1u == (gen + 1u) * n) xb_add(cnt + 64, 1u);
        else { unsigned sp_ = 0; while (xb_ld(cnt + 64) == gen) { __builtin_amdgcn_s_sleep(1); if ((++sp_ & 255u) == 0u) { if (xb_ld(tmo)) break; if (sp_ > XB_SPIN_CAP) { atomicAdd(tmo, 1u); break; } } } }
        __builtin_amdgcn_fence(__ATOMIC_ACQUIRE, "agent");
        asm volatile("s_waitcnt vmcnt(0)" ::: "memory");
    }
    __syncthreads();
}

struct Frame {
    LAS unsigned char* lds;
    volatile LAS unsigned* MISC;
    int wave0;
    gu32* ctl;
    int vcu, G;
    const float* x; float* out;
    const float *norm_w, *w_in, *lb_logits, *hg_norm_w, *q_norm_w, *k_norm_w, *w_out;
    bf16 *WIN, *WOUT, *XB, *MIXED, *QI, *KT, *HI, *GH, *QN, *KN, *V, *GA;
    float *LB, *KPART, *ROWSS, *DEC;
};

__device__ __forceinline__ float wave_sum(float v) {
#pragma unroll
    for (int o = 1; o < 64; o <<= 1) v += __shfl_xor(v, o);
    return v;
}
__device__ __forceinline__ int win_dest(int oc) {
    if (oc < 2048) { const int grp = oc >> 9, hh = (oc >> 7) & 3, w = oc & 127; return 256 * (((grp >> 1) << 2) + hh) + 128 * (grp & 1) + w; }
    const int ty = (oc - 2048) >> 9, head = (oc >> 6) & 7, bj = (oc >> 5) & 1; return 256 * (8 + 2 * ty + (head >> 2)) + 128 * bj + 32 * (head & 3);
}
__device__ __forceinline__ void p0_transpose_item(const float* W, int K, int N, bf16* WT, const float* kscale, LAS float* scr, int item, int lane, bool permute) {
    const int nblk = N / 32, kb = item / nblk, nb = item % nblk, k0 = 64 * kb, n0 = 32 * nb; const int nd = permute ? win_dest(n0) : n0;
    float wv_[32];
#pragma unroll
    for (int i = 0; i < 32; ++i) wv_[i] = __builtin_nontemporal_load(W + (size_t)(k0 + 2 * i + (lane >> 5)) * N + n0 + (lane & 31));
#pragma unroll
    for (int i = 0; i < 32; ++i) { const int kk = 2 * i + (lane >> 5); const float s = kscale ? kscale[k0 + kk] : 1.0f; scr[kk * 33 + (lane & 31)] = wv_[i] * s; }
    LDS_WAIT(); asm volatile("" ::: "memory");
    const int c = lane & 7;
#pragma unroll
    for (int j = 0; j < 4; ++j) { const int n = (lane >> 3) + 8 * j; const LAS float* s = scr + (8 * c) * 33 + n;
        v4u o; o.x = pk2(s[0 * 33], s[1 * 33]); o.y = pk2(s[2 * 33], s[3 * 33]); o.z = pk2(s[4 * 33], s[5 * 33]); o.w = pk2(s[6 * 33], s[7 * 33]);
        *(GAS v4u*)(WT + (size_t)(nd + n) * K + k0 + 8 * c) = o; }
    LDS_WAIT(); asm volatile("" ::: "memory");
}
#define PHASE_IDS() int t_ = F.wave0 * 64 + lane_id_asm(); asm volatile("" : "+v"(t_)); const int tid = t_, lane = tid & 63, wave = __builtin_amdgcn_readfirstlane(tid >> 6); (void)lane; (void)wave
__device__ __forceinline__ void p0_prologue(Frame& F) {
    PHASE_IDS();
    LAS float* scr = (LAS float*)(F.lds + RING_OFF + wave * 16384);
    const int gw = F.vcu * NWAVES + wave, NGW = F.G * NWAVES;
    constexpr int I_IN = (DM / 64) * (NIN / 32), I_OUT = (DM / 64) * (DM / 32);
    constexpr int NITEMS = DEPTH * (I_IN + I_OUT);
    for (int it = gw; it < NITEMS; it += NGW) {
        int r = it;
        if (r < DEPTH * I_IN) { const int l = r / I_IN; r -= l * I_IN;
            p0_transpose_item(F.w_in + (size_t)l * DM * NIN, DM, NIN, F.WIN + (size_t)l * NIN * DM, F.norm_w + l * DM, scr, r, lane, true); continue; }
        r -= DEPTH * I_IN; { const int l = r / I_OUT; r -= l * I_OUT;
            p0_transpose_item(F.w_out + (size_t)l * DM * DM, DM, DM, F.WOUT + (size_t)l * DM * DM, nullptr, scr, r, lane, false); }
    }
    const bool gl_ = (F.G == 256);
    for (int m0 = gl_ ? (gw >> 8) * 4096 + (gw & 255) * 4 : gw * 4; m0 < (gl_ ? ((gw >> 8) + 1) * 4096 : MTOK); m0 += gl_ ? 1024 : NGW * 4) {
        f32x4 v[4][4]; float sq[4];
#pragma unroll
        for (int r = 0; r < 4; ++r) { const GAS f32x4* xr = (const GAS f32x4*)(F.x + (size_t)(m0 + r) * DM) + lane;
#pragma unroll
            for (int j = 0; j < 4; ++j) v[r][j] = __builtin_nontemporal_load(xr + 64 * j); }
#pragma unroll
        for (int r = 0; r < 4; ++r) { float a = 0.f;
#pragma unroll
            for (int j = 0; j < 4; ++j) a += (v[r][j].x * v[r][j].x + v[r][j].y * v[r][j].y) + (v[r][j].z * v[r][j].z + v[r][j].w * v[r][j].w);
            sq[r] = a; }
#pragma unroll
        for (int o = 1; o < 64; o <<= 1) {
#pragma unroll
            for (int r = 0; r < 4; ++r) sq[r] += __shfl_xor(sq[r], o); }
#pragma unroll
        for (int r = 0; r < 4; ++r) { GAS unsigned long long* o8 = (GAS unsigned long long*)(F.XB + (size_t)(m0 + r) * DM) + lane;
#pragma unroll
            for (int j = 0; j < 4; ++j) o8[64 * j] = (unsigned long long)pk2(v[r][j].x, v[r][j].y) | ((unsigned long long)pk2(v[r][j].z, v[r][j].w) << 32);
            if (lane < 16) F.ROWSS[(size_t)(m0 + r) * 16 + lane] = (lane == 0) ? sq[r] : 0.f; }
    }
    if (blockIdx.x == 0) { const int c = tid; const float a0 = F.lb_logits[c], a1 = F.lb_logits[512 + c]; const float mx = fmaxf(a0, a1);
        const float e0 = expf(a0 - mx), e1 = expf(a1 - mx); const float p0 = e0 / (e0 + e1), p1 = e1 / (e0 + e1);
        F.LB[c] = 0.f; F.LB[512 + c] = fminf(fmaxf((p0 + p1) - p0, 0.f), 1.0f - 1e-6f); }
}

constexpr float LOG2E = 1.4426950408889634f;
constexpr float QSCALE2 = 0.125f * LOG2E;
namespace moba {
typedef short bf16x8 __attribute__((ext_vector_type(8)));
typedef short s16x4 __attribute__((ext_vector_type(4)));
typedef float f32x16 __attribute__((ext_vector_type(16)));
typedef float f32x2_t __attribute__((ext_vector_type(2))); typedef __bf16 bf16x2_t __attribute__((ext_vector_type(2)));
__device__ __forceinline__ unsigned cvtpk(float lo, float hi) { f32x2_t v = {lo, hi}; bf16x2_t b = __builtin_convertvector(v, bf16x2_t); return __builtin_bit_cast(unsigned, b); }
__device__ __forceinline__ int crow(int r, int hi) { return (r & 3) + 8 * (r >> 2) + 4 * hi; }
__device__ __forceinline__ float max3f(float a, float b, float c) { float r; asm("v_max3_f32 %0, %1, %2, %3" : "=v"(r) : "v"(a), "v"(b), "v"(c)); return r; }
constexpr int L_K = 0, L_V = 32768, L_WSF = 65536, L_KM = 67584, L_OST = 69632;
constexpr float NEG_BIG = -1e30f;
constexpr float THR = 8.0f;
__device__ __forceinline__ s16x4 vtr(const LAS unsigned char* p) { return __builtin_bit_cast(s16x4, __builtin_amdgcn_ds_read_tr16_b64_v4i16((LAS s16x4*)p)); }
}

__device__ __forceinline__ void moba_glds(unsigned voff, const void* sbase, unsigned lds_dst) { unsigned keep;
    asm volatile("s_mov_b32 %0, m0\n\ts_mov_b32 m0, %3\n\ts_nop 0\n\tglobal_load_lds_dwordx4 %1, %2\n\ts_mov_b32 m0, %0" : "=&s"(keep) : "v"(voff), "s"(sbase), "s"(lds_dst) : "memory"); }
template <bool FIXREF> __device__ __forceinline__ void moba_mfma_body(Frame& F, int l) {
    using namespace moba;
    PHASE_IDS();
    const int r32 = lane & 31, hi = lane >> 5, wid = wave;
    LAS unsigned char* L = F.lds + RING_OFF;
    LAS float* wsf = (LAS float*)(L + L_WSF) + wid * 64;
    LAS float* km = (LAS float*)(L + L_KM);
    LAS float* ost = (LAS float*)(L + L_OST) + wid * 2048;
    float gq = fabsf(F.q_norm_w[l * 64 + lane]), gk = fabsf(F.k_norm_w[l * 64 + lane]);
#pragma unroll
    for (int o = 1; o < 64; o <<= 1) { gq = fmaxf(gq, __shfl_xor(gq, o)); gk = fmaxf(gk, __shfl_xor(gk, o)); }
    gq = __builtin_bit_cast(float, __builtin_amdgcn_readfirstlane(__builtin_bit_cast(int, gq))); gk = __builtin_bit_cast(float, __builtin_amdgcn_readfirstlane(__builtin_bit_cast(int, gk)));
    const float smax2 = 8.0f * gq * gk * LOG2E * 1.02f;
    const float mhat0 = -(smax2 + 1.0f);
    int grp_ = (int)(blockIdx.x & 7u); asm volatile("" : "+s"(grp_));
    gu32* qctr = F.ctl + CW_QUEUE + 64 * (2 * grp_ + l);
    volatile LAS unsigned* tick = (volatile LAS unsigned*)(F.lds + EXTRA_OFF + 8192);
    if (tid == 0) tick[0] = __hip_atomic_fetch_add(qctr, 1u, RLX_AGENT);
    for (int ui = 0;; ++ui) {
        __syncthreads();
        const int it = __builtin_amdgcn_readfirstlane((int)tick[ui & 1]); if (it >= 128) break;
        const int qb = 7 - (it >> 4), bh = 16 * grp_ + (it & 15);
        const int b = bh >> 3, h = bh & 7; const size_t rowbase = (size_t)b * SEQ; const int q0 = qb * 256, qrel = wid * 32 + r32, tq = q0 + qrel;
        const float sl2 = exp2f(-(float)(h + 1)) * LOG2E;
        bf16x8 qr[4];
        { const GAS bf16* Qw = (const GAS bf16*)(F.QN + (rowbase + q0 + wid * 32 + r32) * 512 + h * 64 + hi * 8);
#pragma unroll
            for (int d0 = 0; d0 < 4; ++d0) qr[d0] = *(const GAS bf16x8*)(Qw + d0 * 16); }
        LAS unsigned char* qlds = (LAS unsigned char*)ost + lane * 16;
        { int tid_u = tid; asm volatile("" : "+v"(tid_u));
          if (tid_u < qb * 64) { const GAS float* kp = (const GAS float*)(F.KPART + ((size_t)b * 8 + (tid_u >> 6)) * 1024 + h * 64 + (tid_u & 63)); km[tid_u] = (kp[0] + kp[512]) * (1.0f / 256.0f); } }
        const unsigned koff = (unsigned)(((rowbase + lane) * 512 + h * 64 + wid * 8) * 2);
        unsigned voff; { const int vr = 8 * wid + (lane >> 3), sl = lane & 7; const int ch = ((((sl >> 2) ^ ((vr >> 1) & 1)) << 2) | (sl & 3)); voff = (unsigned)((((size_t)MTOK + rowbase + vr) * 512 + h * 64 + ch * 8) * 2); }
        const unsigned lds0 = (unsigned)(uintptr_t)L;
#define MOBA_ISSUE(t_, bufi) do { moba_glds(koff, (const void*)((const char*)F.KN + (size_t)(t_) * 65536), (unsigned)__builtin_amdgcn_readfirstlane((int)(lds0 + L_K + (bufi) * 8192 + wid * 1024))); \
            moba_glds(voff, (const void*)((const char*)F.KN + (size_t)(t_) * 65536), (unsigned)__builtin_amdgcn_readfirstlane((int)(lds0 + L_V + (bufi) * 8192 + wid * 1024))); } while (0)
        const int NT = 4 * (qb + 1);
        int t0 = 0; { const float dstar = (151.0f + 2.0f * smax2) / sl2; const float x = ((float)(q0 - 63) - dstar) * (1.0f / 64.0f); if (x > 0.f) t0 = ((int)x) & ~1; if (t0 > NT - 4) t0 = NT - 4; t0 = __builtin_amdgcn_readfirstlane(t0); }
        unsigned nticket = 0u; if (tid == 0) nticket = __hip_atomic_fetch_add(qctr, 1u, RLX_AGENT);
        MOBA_ISSUE(t0, 0); MOBA_ISSUE(t0 + 1, 1); MOBA_ISSUE(t0 + 2, 2);
        __syncthreads();
        unsigned selmask = 0;
        { float gt[7]; float qf32[32];
#pragma unroll
            for (int d0 = 0; d0 < 4; ++d0)
#pragma unroll
                for (int e = 0; e < 8; ++e) qf32[d0 * 8 + e] = bf2f((unsigned short)qr[d0][e]);
#pragma unroll
            for (int i = 0; i < 32; ++i) asm volatile("" : "+v"(qf32[i]));
#pragma unroll
            for (int j = 0; j < 7; ++j) { float s = 0.f;
                if (j < qb) {
#pragma unroll
                    for (int d0 = 0; d0 < 4; ++d0)
#pragma unroll
                        for (int e = 0; e < 8; ++e) s += qf32[d0 * 8 + e] * km[j * 64 + d0 * 16 + hi * 8 + e];
                    auto rr = __builtin_amdgcn_permlane32_swap(__float_as_uint(s), __float_as_uint(s), false, false);
                    s = __uint_as_float(rr[0]) + __uint_as_float(rr[1]); }
                gt[j] = s; }
#pragma unroll
            for (int j = 0; j < 7; ++j) { int rank = 0;
#pragma unroll
                for (int i = 0; i < 7; ++i) if (i != j && i < qb) rank += (gt[i] > gt[j] || (gt[i] == gt[j] && i < j)) ? 1 : 0;
                if (j < qb && rank < 3) selmask |= 1u << j; }
            selmask |= 1u << qb; }
        if (!FIXREF) {
#pragma unroll
            for (int d0 = 0; d0 < 4; ++d0) *(LAS bf16x8*)(qlds + d0 * 1024) = qr[d0]; }
        float mhat = mhat0, l_reg = 0.f; f32x16 o[2]; o[0] = f32x16{}; o[1] = f32x16{};
        const int kbase = L_K + hi * 1024 + r32 * 16;
        const int g16 = lane >> 4, i16 = lane & 15, tq4 = i16 >> 2, tp4 = i16 & 3;
        const int vrow0 = 4 * hi + tq4;
        if (tid == 0) tick[(ui + 1) & 1] = nticket;
        asm volatile("s_waitcnt vmcnt(2)" ::: "memory");
        __syncthreads();
#define MOBA_KLOAD(KOFF) do { if (!FIXREF) { _Pragma("unroll") for (int d0 = 0; d0 < 4; ++d0) qf_[d0] = *(const LAS bf16x8*)(qlds + d0 * 1024); } \
            _Pragma("unroll") for (int d0 = 0; d0 < 4; ++d0) { \
            kfr[2 * d0] = *(const LAS bf16x8*)(L + (KOFF) + kbase + d0 * 2048); kfr[2 * d0 + 1] = *(const LAS bf16x8*)(L + (KOFF) + kbase + d0 * 2048 + 512); } } while (0)
#define MOBA_KLOADH(KOFF, H) do { _Pragma("unroll") for (int d0 = 2 * (H); d0 < 2 * (H) + 2; ++d0) { \
            kfr[2 * d0] = *(const LAS bf16x8*)(L + (KOFF) + kbase + d0 * 2048); kfr[2 * d0 + 1] = *(const LAS bf16x8*)(L + (KOFF) + kbase + d0 * 2048 + 512); } } while (0)
#define MOBA_VLOAD(VOFF) do { _Pragma("unroll") for (int dblk = 0; dblk < 2; ++dblk) _Pragma("unroll") for (int ks = 0; ks < 4; ++ks) { \
            const int rlo = 16 * ks + vrow0, rhi = rlo + 8; \
            vlo[dblk * 4 + ks] = vtr(L + L_V + (VOFF) + rlo * 128 + ((dblk ^ ((rlo >> 1) & 1)) * 64) + (16 * (g16 & 1) + 4 * tp4) * 2); \
            vhi[dblk * 4 + ks] = vtr(L + L_V + (VOFF) + rhi * 128 + ((dblk ^ ((rhi >> 1) & 1)) * 64) + (16 * (g16 & 1) + 4 * tp4) * 2); } } while (0)
#define MOBA_VLOADH(VOFF, DB) do { _Pragma("unroll") for (int ks = 0; ks < 4; ++ks) { \
            const int rlo = 16 * ks + vrow0, rhi = rlo + 8; \
            vlo[(DB) * 4 + ks] = vtr(L + L_V + (VOFF) + rlo * 128 + (((DB) ^ ((rlo >> 1) & 1)) * 64) + (16 * (g16 & 1) + 4 * tp4) * 2); \
            vhi[(DB) * 4 + ks] = vtr(L + L_V + (VOFF) + rhi * 128 + (((DB) ^ ((rhi >> 1) & 1)) * 64) + (16 * (g16 & 1) + 4 * tp4) * 2); } } while (0)
#define MOBA_QK(CANSKIP, TT, P0, P1) do { \
            const int blk_ = (TT) >> 2; \
            if (!((CANSKIP) && (blk_ == qb) && (64 * ((TT) & 3) > 32 * wid + 31))) { \
                const bool sel_ = ((selmask >> blk_) & 1u); \
                float sc0_ = sel_ ? (-mhat - sl2 * (float)(tq - 64 * (TT) - 4 * hi)) : NEG_BIG; asm volatile("" : "+v"(sc0_)); \
_Pragma("unroll") \
                for (int r = 0; r < 16; ++r) { P0[r] = __builtin_fmaf(sl2, (float)((r & 3) + 8 * (r >> 2)), sc0_); P1[r] = __builtin_fmaf(sl2, (float)(32 + (r & 3) + 8 * (r >> 2)), sc0_); } \
_Pragma("unroll") \
                for (int d0 = 0; d0 < 4; ++d0) { \
                    P0 = __builtin_amdgcn_mfma_f32_32x32x16_bf16(kfr[2 * d0], FIXREF ? qr[d0] : qf_[d0], P0, 0, 0, 0); \
                    P1 = __builtin_amdgcn_mfma_f32_32x32x16_bf16(kfr[2 * d0 + 1], FIXREF ? qr[d0] : qf_[d0], P1, 0, 0, 0); } \
            } } while (0)
#define MOBA_SM(OWNP, TT, P0, P1, HAVE_NEXT, N0, N1) do { \
            const bool own = (OWNP); const int jb = (TT) & 3; \
            if (!(own && (64 * jb > 32 * wid + 31))) { \
                if (own && (64 * jb + 63 > 32 * wid)) { \
_Pragma("unroll") \
                    for (int r = 0; r < 16; ++r) { const int kvl = 64 * jb + crow(r, hi); if (kvl > qrel) P0[r] = NEG_BIG; if (kvl + 32 > qrel) P1[r] = NEG_BIG; } } \
                if (!FIXREF) { \
                float rm = max3f(P0[0], P1[0], P0[1]), rm2 = max3f(P1[1], P0[2], P1[2]); \
_Pragma("unroll") \
                for (int r = 3; r < 15; r += 2) { rm = max3f(rm, P0[r], P1[r]); rm2 = max3f(rm2, P0[r + 1], P1[r + 1]); } \
                rm = max3f(rm, rm2, fmaxf(P0[15], P1[15])); \
                { auto rr = __builtin_amdgcn_permlane32_swap(__float_as_uint(rm), __float_as_uint(rm), false, false); rm = fmaxf(__uint_as_float(rr[0]), __uint_as_float(rr[1])); } \
                if (__any(rm > THR)) { \
                    const float dl = fmaxf(rm, 0.f); mhat += dl; \
_Pragma("unroll") \
                    for (int r = 0; r < 16; ++r) { P0[r] -= dl; P1[r] -= dl; } \
                    if (HAVE_NEXT) { \
_Pragma("unroll") \
                        for (int r = 0; r < 16; ++r) { N0[r] -= dl; N1[r] -= dl; } } \
                    const float f = __builtin_amdgcn_exp2f(-dl); l_reg *= f; \
                    if (hi == 0) wsf[r32] = f; \
_Pragma("unroll") \
                    for (int r = 0; r < 16; ++r) { const float fr = wsf[crow(r, hi)]; o[0][r] *= fr; o[1][r] *= fr; } } \
                } \
                float sacc = 0.f, sacc2 = 0.f; \
_Pragma("unroll") \
                for (int r = 0; r < 16; ++r) { P0[r] = __builtin_amdgcn_exp2f(P0[r]); P1[r] = __builtin_amdgcn_exp2f(P1[r]); sacc += P0[r]; sacc2 += P1[r]; } \
                l_reg += sacc + sacc2; \
                { v4u w; \
_Pragma("unroll") \
                    for (int ks = 0; ks < 4; ++ks) { \
_Pragma("unroll") \
                        for (int e = 0; e < 4; ++e) { const int rb = (ks & 1) * 8 + 2 * e; w[e] = (ks < 2) ? cvtpk(P0[rb], P0[rb + 1]) : cvtpk(P1[rb], P1[rb + 1]); } \
                        pa[ks] = __builtin_bit_cast(bf16x8, w); } } \
            } } while (0)
#define MOBA_PV(OWNP, TT) do { \
            if (!((OWNP) && (64 * ((TT) & 3) > 32 * wid + 31))) { \
_Pragma("unroll") \
                for (int dblk = 0; dblk < 2; ++dblk) \
_Pragma("unroll") \
                    for (int ks = 0; ks < 4; ++ks) { \
                        const s16x4 lo = vlo[dblk * 4 + ks], hh = vhi[dblk * 4 + ks]; \
                        const bf16x8 vf = __builtin_shufflevector(lo, hh, 0, 1, 2, 3, 4, 5, 6, 7); \
                        o[dblk] = __builtin_amdgcn_mfma_f32_32x32x16_bf16(pa[ks], vf, o[dblk], 0, 0, 0); } \
            } } while (0)
        f32x16 pA0, pA1, pB0, pB1; bf16x8 kfr[8], qf_[4], pa[4]; s16x4 vlo[8], vhi[8];
        MOBA_KLOAD(0); MOBA_QK(true, t0, pA0, pA1);
        int c0o = 0;
#define MOBA_ILV() do { __builtin_amdgcn_sched_group_barrier(0x002, 16, 0); \
_Pragma("unroll") \
            for (int g_ = 0; g_ < 8; ++g_) { __builtin_amdgcn_sched_group_barrier(0x008, 1, 0); __builtin_amdgcn_sched_group_barrier(0x002, 12, 0); } } while (0)
#define MOBA_STEP2(OWNP) do { \
            const int c1o = (c0o + 1) & 3, c2o = (c0o + 2) & 3, c3o = (c0o + 3) & 3; \
            if (!(OWNP) || t + 3 < NT) MOBA_ISSUE(t + 3, c3o); \
            if (FIXREF) { MOBA_KLOAD(c1o * 8192); __builtin_amdgcn_sched_barrier(0); \
                MOBA_QK(OWNP, t + 1, pB0, pB1); MOBA_SM(OWNP, t, pA0, pA1, false, pB0, pB1); if (!(OWNP)) MOBA_ILV(); __builtin_amdgcn_sched_barrier(0); \
                MOBA_VLOAD(c0o * 8192); __builtin_amdgcn_sched_barrier(0); MOBA_PV(OWNP, t); } \
            else { MOBA_KLOAD(c1o * 8192); __builtin_amdgcn_sched_barrier(0); MOBA_QK(true, t + 1, pB0, pB1); __builtin_amdgcn_sched_barrier(0); \
                MOBA_VLOAD(c0o * 8192); __builtin_amdgcn_sched_barrier(0); MOBA_SM(OWNP, t, pA0, pA1, true, pB0, pB1); MOBA_PV(OWNP, t); } \
            if (!(OWNP) || t + 3 < NT) asm volatile("s_waitcnt vmcnt(2)" ::: "memory"); else asm volatile("s_waitcnt vmcnt(0)" ::: "memory"); \
            __syncthreads(); \
            if (!(OWNP) || t + 4 < NT) MOBA_ISSUE(t + 4, c0o); \
            if (FIXREF) { if (!(OWNP) || t + 2 < NT) MOBA_KLOAD(c2o * 8192); __builtin_amdgcn_sched_barrier(0); \
                if (!(OWNP) || t + 2 < NT) MOBA_QK(OWNP, t + 2, pA0, pA1); MOBA_SM(OWNP, t + 1, pB0, pB1, false, pA0, pA1); if (!(OWNP)) MOBA_ILV(); __builtin_amdgcn_sched_barrier(0); \
                MOBA_VLOAD(c1o * 8192); __builtin_amdgcn_sched_barrier(0); MOBA_PV(OWNP, t + 1); } \
            else { if (t + 2 < NT) { MOBA_KLOAD(c2o * 8192); __builtin_amdgcn_sched_barrier(0); MOBA_QK(true, t + 2, pA0, pA1); __builtin_amdgcn_sched_barrier(0); } \
                MOBA_VLOAD(c1o * 8192); __builtin_amdgcn_sched_barrier(0); MOBA_SM(OWNP, t + 1, pB0, pB1, (t + 2 < NT), pA0, pA1); MOBA_PV(OWNP, t + 1); } \
            if (!(OWNP) || t + 4 < NT) asm volatile("s_waitcnt vmcnt(2)" ::: "memory"); else asm volatile("s_waitcnt vmcnt(0)" ::: "memory"); \
            __syncthreads(); \
            c0o = c2o; } while (0)
        int t = t0;
        for (; t < NT - 4; t += 2) MOBA_STEP2(false);
        for (; t < NT; t += 2) MOBA_STEP2(true);
#undef MOBA_STEP2
#undef MOBA_ISSUE
#undef MOBA_KLOAD
#undef MOBA_KLOADH
#undef MOBA_VLOAD
#undef MOBA_VLOADH
#undef MOBA_QK
#undef MOBA_SM
#undef MOBA_PV
        int lane_e = lane; asm volatile("" : "+v"(lane_e));
        const int r32e = lane_e & 31, hie = lane_e >> 5;
        v4u gwv[4];
#pragma unroll
        for (int i = 0; i < 4; ++i) gwv[i] = *(const GAS v4u*)(F.GA + (rowbase + q0 + wid * 32 + i * 8 + (lane_e >> 3)) * 512 + h * 64 + (lane_e & 7) * 8);
        { auto rr = __builtin_amdgcn_permlane32_swap(__float_as_uint(l_reg), __float_as_uint(l_reg), false, false); l_reg = __uint_as_float(rr[0]) + __uint_as_float(rr[1]); }
        if (hie == 0) wsf[r32e] = 1.0f / l_reg;
#pragma unroll
        for (int r = 0; r < 16; ++r) { const float rl = wsf[crow(r, hie)]; ost[crow(r, hie) * 64 + r32e] = o[0][r] * rl; ost[crow(r, hie) * 64 + 32 + r32e] = o[1][r] * rl; }
#pragma unroll
        for (int i = 0; i < 4; ++i) { const int row = i * 8 + (lane_e >> 3), ch = lane_e & 7;
            const f32x4 a = *(const LAS f32x4*)(ost + row * 64 + ch * 8), c2 = *(const LAS f32x4*)(ost + row * 64 + ch * 8 + 4);
            const size_t grow = rowbase + q0 + wid * 32 + row;
            const v4u gw = gwv[i];
            v4u ow; ow.x = pk2(a[0] * bflo(gw.x), a[1] * bfhi(gw.x)); ow.y = pk2(a[2] * bflo(gw.y), a[3] * bfhi(gw.y));
            ow.z = pk2(c2[0] * bflo(gw.z), c2[1] * bfhi(gw.z)); ow.w = pk2(c2[2] * bflo(gw.w), c2[3] * bfhi(gw.w));
            *(GAS v4u*)(F.MIXED + grow * DM + 512 + h * 64 + ch * 8) = ow; }
    }
    __syncthreads();
}


__device__ __forceinline__ void moba_mfma_phase(Frame& F, int l) {
    float gq = 0.f, gk = 0.f;
    for (int i = 0; i < 64; ++i) { gq = fmaxf(gq, fabsf(F.q_norm_w[l * 64 + i])); gk = fmaxf(gk, fabsf(F.k_norm_w[l * 64 + i])); }
    if (2.0f * (8.0f * gq * gk * LOG2E * 1.02f) + 1.0f <= 100.0f) moba_mfma_body<true>(F, l); else moba_mfma_body<false>(F, l);
}

namespace hg {
typedef short bf16x8 __attribute__((ext_vector_type(8)));
typedef short s16x4 __attribute__((ext_vector_type(4)));
typedef float f32x4 __attribute__((ext_vector_type(4)));
typedef unsigned u32x2 __attribute__((ext_vector_type(2)));
constexpr int SLOT = 33792, NSLOT = 4;
constexpr int L_SC = NSLOT * SLOT, L_NRM = L_SC + 4096;
constexpr int NSTEP = SEQ / 32;
__device__ __forceinline__ int fsw(int t) { return ((t & 7) << 2) | (((t >> 3) & 1) << 1); }
__device__ __forceinline__ int unit_off(int tok, int cg) { return 8 * (32 * tok + (cg ^ fsw(tok))); }
__device__ __forceinline__ s16x4 rd64(const LAS unsigned char* p) { return *(const LAS s16x4*)p; }
__device__ __forceinline__ s16x4 vtr(const LAS unsigned char* p) { return __builtin_bit_cast(s16x4, __builtin_amdgcn_ds_read_tr16_b64_v4i16((LAS s16x4*)p)); }
__device__ __forceinline__ bf16x8 cat(s16x4 a, s16x4 b) { return __builtin_shufflevector(a, b, 0, 1, 2, 3, 4, 5, 6, 7); }
__device__ __forceinline__ s16x4 pack4(f32x4 v) { u32x2 w; w.x = moba::cvtpk(v[0], v[1]); w.y = moba::cvtpk(v[2], v[3]); return __builtin_bit_cast(s16x4, w); }
__device__ __forceinline__ void glds16(const GAS void* gsrc, unsigned lds_dst) { unsigned keep;
    asm volatile("s_mov_b32 %0, m0\n\ts_mov_b32 m0, %2\n\ts_nop 0\n\tglobal_load_lds_dwordx4 %1, off\n\ts_mov_b32 m0, %0" : "=&s"(keep) : "v"(gsrc), "s"(lds_dst) : "memory"); }
__device__ __forceinline__ void glds16s(unsigned voff, const void* sbase, unsigned lds_dst) { unsigned keep;
    asm volatile("s_mov_b32 %0, m0\n\ts_mov_b32 m0, %3\n\ts_nop 0\n\tglobal_load_lds_dwordx4 %1, %2 nt\n\ts_mov_b32 m0, %0" : "=&s"(keep) : "v"(voff), "s"(sbase), "s"(lds_dst) : "memory"); }
#define HG_MFMA(a, b, c) __builtin_amdgcn_mfma_f32_16x16x32_bf16((a), (b), (c), 0, 0, 0)
}

__device__ __forceinline__ void hgrn_mfma_phase(Frame& F, int l) {
    using namespace hg;
    PHASE_IDS();
    const int w = wave, c16 = lane & 15, g = lane >> 4;
    LAS unsigned char* L = F.lds + RING_OFF;
    const s16x4 z4 = (s16x4){0, 0, 0, 0};
    for (int it = (int)blockIdx.x; it < 64; it += F.G) {
        const int b = 2 * (it & 7) + (it >> 5), h = (it >> 3) & 3; const size_t rowbase = (size_t)b * SEQ;
        const int da = w >> 1;
        unsigned dsrc[4];
#pragma unroll
        for (int i = 0; i < 4; ++i) { const int t = 16 * (w & 1) + 4 * i + (lane >> 4); const int sc = (lane & 15) ^ (fsw(t) >> 1);
            dsrc[i] = (unsigned)((((size_t)da * MTOK + rowbase + t) * 512 + h * 128 + 8 * sc) * 2); }
        const unsigned ddec = (unsigned)((((size_t)b * NSTEP) * 512 + h * 128 + 4 * lane) * 4);
        const int ddst = da * 8192 + (w & 1) * 4096;
        const unsigned lds0 = (unsigned)(uintptr_t)(F.lds + RING_OFF);
#define HG_ISSUE(step) do { const unsigned so_ = lds0 + (unsigned)(((step) & 3) * SLOT); \
            _Pragma("unroll") for (int i = 0; i < 4; ++i) \
                glds16s(dsrc[i], (const void*)((const char*)F.QI + (size_t)(step) * (32 * 512 * 2)), (unsigned)__builtin_amdgcn_readfirstlane((int)(so_ + ddst + i * 1024))); \
            if (w == 0) glds16s(ddec, (const void*)((const char*)F.DEC + (size_t)(step) * 2048), (unsigned)__builtin_amdgcn_readfirstlane((int)(so_ + 32768))); } while (0)
        f32x4 S[8]; bf16x8 Sb[4];
#pragma unroll
        for (int tk = 0; tk < 8; ++tk) S[tk] = (f32x4){0.f, 0.f, 0.f, 0.f};
#pragma unroll
        for (int ks = 0; ks < 4; ++ks) Sb[ks] = (bf16x8){0, 0, 0, 0, 0, 0, 0, 0};
        f32x4 oprev[2]; oprev[0] = (f32x4){0.f, 0.f, 0.f, 0.f}; oprev[1] = oprev[0];
        u32x2 gprev[2]; gprev[0] = (u32x2){0u, 0u}; gprev[1] = gprev[0];
        float hw[4];
#pragma unroll
        for (int r = 0; r < 4; ++r) hw[r] = F.hg_norm_w[l * 128 + 16 * w + 4 * g + r];
        asm volatile("" : "+v"(hw[0]), "+v"(hw[1]), "+v"(hw[2]), "+v"(hw[3]));
        LAS float* nrm = (LAS float*)(L + L_NRM);
        LAS unsigned char* SC = L + L_SC;
        HG_ISSUE(0); HG_ISSUE(1); HG_ISSUE(2);
        asm volatile("s_waitcnt vmcnt(8)\n\ts_barrier" ::: "memory");
        const int trq = c16 >> 2, trp = c16 & 3;
        int ro0 = 256 * c16 + 16 * (g ^ (fsw(c16) >> 1)), ko0 = 256 * (4 * g + trq) + 16 * (trp ^ (fsw(4 * g + trq) >> 1));
#define RO(ks) (ro0 ^ (64 * (ks)))
#define KO(tk) (ko0 ^ (64 * ((tk) >> 1) + 8 * ((tk) & 1)))
        const int io_ = unit_off(4 * g + trq, 4 * w + trp), go_ = unit_off(c16, 4 * w + g);
        bf16x8 qf[2][4];
#define HG_LOADQ(slotbase) do { _Pragma("unroll") for (int tt = 0; tt < 2; ++tt) _Pragma("unroll") for (int ks = 0; ks < 4; ++ks) \
            qf[tt][ks] = *(const LAS bf16x8*)((slotbase) + RO(ks) + 4096 * tt); } while (0)
#define HG_FINAL(step, P) do { _Pragma("unroll") for (int tt = 0; tt < 2; ++tt) { \
            const float ssum = ((P[tt][0] + P[tt][1]) + (P[tt][2] + P[tt][3])) + ((P[tt][4] + P[tt][5]) + (P[tt][6] + P[tt][7])); \
            const float rstd = __builtin_amdgcn_rsqf(ssum * (1.0f / 128.0f) + NORM_EPS); \
            u32x2 wv; wv.x = moba::cvtpk(oprev[tt][0] * rstd * hw[0] * bflo(gprev[tt].x), oprev[tt][1] * rstd * hw[1] * bfhi(gprev[tt].x)); \
            wv.y = moba::cvtpk(oprev[tt][2] * rstd * hw[2] * bflo(gprev[tt].y), oprev[tt][3] * rstd * hw[3] * bfhi(gprev[tt].y)); \
            *(GAS u32x2*)(F.MIXED + (rowbase + (size_t)(step) * 32 + 16 * tt + c16) * DM + h * 128 + 16 * w + 4 * g) = wv; } } while (0)
        HG_LOADQ(L);
        for (int n = 0; n < NSTEP; ++n) {
            asm volatile("" : "+v"(ro0), "+v"(ko0));
            if (n + 3 < NSTEP) HG_ISSUE(n + 3);
            const LAS unsigned char* Qs = L + (n & 3) * SLOT; const LAS unsigned char* Ks = Qs + 8192; const LAS unsigned char* Is = Qs + 16384; const LAS unsigned char* Gs = Qs + 24576;
            const LAS float* Ds = (const LAS float*)(Qs + 32768);
            LAS unsigned char* SCn = SC + (n & 1) * 1536;
            bf16x8 kf[4];
            if (w < 3) { const int st = (w == 2) ? 1 : 0;
#pragma unroll
                for (int ks = 0; ks < 4; ++ks) kf[ks] = *(const LAS bf16x8*)(Ks + RO(ks) + 4096 * st); }
            u32x2 gcur[2];
#pragma unroll
            for (int tt = 0; tt < 2; ++tt) gcur[tt] = *(const LAS u32x2*)(Gs + go_ + 4096 * tt);
            s16x4 itr[2];
#pragma unroll
            for (int st = 0; st < 2; ++st) itr[st] = vtr(Is + io_ + 4096 * st);
            const bf16x8 i01 = cat(itr[0], itr[1]);
            bf16x8 k01[4]; f32x4 dv4[4];
#pragma unroll
            for (int tk = 0; tk < 4; ++tk) { k01[tk] = cat(vtr(Ks + KO(tk)), vtr(Ks + KO(tk) + 4096)); dv4[tk] = *(const LAS f32x4*)(Ds + 16 * tk + 4 * g); }
            f32x4 o[2];
#pragma unroll
            for (int tt = 0; tt < 2; ++tt) { f32x4 a = (f32x4){0.f, 0.f, 0.f, 0.f};
#pragma unroll
                for (int ks = 0; ks < 4; ++ks) a = HG_MFMA(Sb[ks], qf[tt][ks], a);
                o[tt] = a; }
            if (w < 3) { f32x4 sc = (f32x4){0.f, 0.f, 0.f, 0.f};
                if (w == 0) {
#pragma unroll
                    for (int ks = 0; ks < 4; ++ks) sc = HG_MFMA(kf[ks], qf[0][ks], sc);
                } else {
#pragma unroll
                    for (int ks = 0; ks < 4; ++ks) sc = HG_MFMA(kf[ks], qf[1][ks], sc); }
                if (w != 1) {
#pragma unroll
                    for (int r = 0; r < 4; ++r) if (4 * g + r > c16) sc[r] = 0.f; }
                *(LAS s16x4*)(SCn + w * 512 + lane * 8) = pack4(sc); }
#pragma unroll
            for (int tk = 0; tk < 4; ++tk) S[tk] = HG_MFMA(k01[tk], i01, S[tk]);
            asm volatile("" ::: "memory");
            { bf16x8 k2[4]; f32x4 d2[4];
#pragma unroll
                for (int tk = 0; tk < 4; ++tk) { k2[tk] = cat(vtr(Ks + KO(tk + 4)), vtr(Ks + KO(tk + 4) + 4096)); d2[tk] = *(const LAS f32x4*)(Ds + 16 * (tk + 4) + 4 * g); }
#pragma unroll
                for (int tk = 0; tk < 4; ++tk) S[tk] = S[tk] * dv4[tk];
#pragma unroll
                for (int ks = 0; ks < 2; ++ks) Sb[ks] = cat(pack4(S[2 * ks]), pack4(S[2 * ks + 1]));
#pragma unroll
                for (int tk = 0; tk < 4; ++tk) S[tk + 4] = HG_MFMA(k2[tk], i01, S[tk + 4]);
#pragma unroll
                for (int tk = 0; tk < 4; ++tk) S[tk + 4] = S[tk + 4] * d2[tk];
#pragma unroll
                for (int ks = 2; ks < 4; ++ks) Sb[ks] = cat(pack4(S[2 * ks]), pack4(S[2 * ks + 1])); }
            if (n >= NSTEP - 3) asm volatile("s_waitcnt vmcnt(0) lgkmcnt(0)\n\ts_barrier" ::: "memory");
            else if (n <= 1) asm volatile("s_waitcnt vmcnt(8) lgkmcnt(0)\n\ts_barrier" ::: "memory");
            else if (n == 2) asm volatile("s_waitcnt vmcnt(10) lgkmcnt(0)\n\ts_barrier" ::: "memory");
            else asm volatile("s_waitcnt vmcnt(12) lgkmcnt(0)\n\ts_barrier" ::: "memory");
            const s16x4 sc00 = rd64(SCn + lane * 8), sc01 = rd64(SCn + 512 + lane * 8), sc11 = rd64(SCn + 1024 + lane * 8);
            float pn[2][8];
            if (n > 0) {
#pragma unroll
                for (int tt = 0; tt < 2; ++tt)
#pragma unroll
                    for (int ww = 0; ww < 8; ++ww) pn[tt][ww] = nrm[((n - 1) & 1) * 256 + ww * 32 + 16 * tt + c16]; }
            if (n + 1 < NSTEP) HG_LOADQ(L + ((n + 1) & 3) * SLOT);
            o[0] = HG_MFMA(cat(itr[0], z4), cat(sc00, z4), o[0]);
            o[1] = HG_MFMA(i01, cat(sc01, sc11), o[1]);
            { float ss0 = (o[0][0] * o[0][0] + o[0][1] * o[0][1]) + (o[0][2] * o[0][2] + o[0][3] * o[0][3]);
              float ss1 = (o[1][0] * o[1][0] + o[1][1] * o[1][1]) + (o[1][2] * o[1][2] + o[1][3] * o[1][3]);
              { auto r0 = __builtin_amdgcn_permlane16_swap(__float_as_uint(ss0), __float_as_uint(ss0), false, false); auto r1 = __builtin_amdgcn_permlane16_swap(__float_as_uint(ss1), __float_as_uint(ss1), false, false);
                ss0 = __uint_as_float(r0[0]) + __uint_as_float(r0[1]); ss1 = __uint_as_float(r1[0]) + __uint_as_float(r1[1]); }
              { auto r0 = __builtin_amdgcn_permlane32_swap(__float_as_uint(ss0), __float_as_uint(ss0), false, false); auto r1 = __builtin_amdgcn_permlane32_swap(__float_as_uint(ss1), __float_as_uint(ss1), false, false);
                ss0 = __uint_as_float(r0[0]) + __uint_as_float(r0[1]); ss1 = __uint_as_float(r1[0]) + __uint_as_float(r1[1]); }
              if (g == 0) { nrm[(n & 1) * 256 + w * 32 + c16] = ss0; nrm[(n & 1) * 256 + w * 32 + 16 + c16] = ss1; } }
            if (n > 0) HG_FINAL(n - 1, pn);
            oprev[0] = o[0]; oprev[1] = o[1]; gprev[0] = gcur[0]; gprev[1] = gcur[1];
        }
        asm volatile("s_waitcnt vmcnt(0) lgkmcnt(0)\n\ts_barrier" ::: "memory");
        { float pn[2][8];
#pragma unroll
            for (int tt = 0; tt < 2; ++tt)
#pragma unroll
                for (int ww = 0; ww < 8; ++ww) pn[tt][ww] = nrm[((NSTEP - 1) & 1) * 256 + ww * 32 + 16 * tt + c16];
            HG_FINAL(NSTEP - 1, pn); }
        asm volatile("s_waitcnt vmcnt(0) lgkmcnt(0)\n\ts_barrier" ::: "memory");
#undef RO
#undef KO
#undef HG_LOADQ
#undef HG_FINAL
#undef HG_ISSUE
    }
}

struct Args { const float* in[8]; float* out; unsigned char* ws; int ph_lo, ph_hi, li, pad; };
__global__ void __launch_bounds__(NWAVES * 64, 2) fwd(Args args) {
    extern __shared__ __attribute__((aligned(16))) unsigned char lds[];
    Frame F;
    F.lds = (LAS unsigned char*)lds;
    F.MISC = (volatile LAS unsigned*)(F.lds + MISC_OFF);
    F.G = gridDim.x; { const int bx = blockIdx.x; F.vcu = (F.G % 8 == 0) ? (bx % 8) * (F.G / 8) + bx / 8 : bx; }
    unsigned char* ws = args.ws;
    F.ctl = (gu32*)(ws + WS_CTL);
    F.x = args.in[0]; F.norm_w = args.in[1]; F.w_in = args.in[2]; F.lb_logits = args.in[3]; F.hg_norm_w = args.in[4]; F.q_norm_w = args.in[5]; F.k_norm_w = args.in[6]; F.w_out = args.in[7];
    F.out = args.out;
    F.WIN = (bf16*)(ws + WS_WIN); F.WOUT = (bf16*)(ws + WS_WOUT); F.XB = (bf16*)(ws + WS_XB); F.MIXED = (bf16*)(ws + WS_MIXED);
    F.QI = (bf16*)(ws + WS_ARR); F.KT = (bf16*)(ws + WS_ARR + ARR_BYTES); F.HI = (bf16*)(ws + WS_ARR + 2 * ARR_BYTES); F.GH = (bf16*)(ws + WS_ARR + 3 * ARR_BYTES);
    F.QN = (bf16*)(ws + WS_ARR + 4 * ARR_BYTES); F.KN = (bf16*)(ws + WS_ARR + 5 * ARR_BYTES); F.V = (bf16*)(ws + WS_ARR + 6 * ARR_BYTES); F.GA = (bf16*)(ws + WS_ARR + 7 * ARR_BYTES);
    F.LB = (float*)(ws + WS_LB); F.KPART = (float*)(ws + WS_KPART); F.ROWSS = (float*)(ws + WS_ROWSS); F.DEC = (float*)(ws + WS_DEC);
    F.wave0 = __builtin_amdgcn_readfirstlane((int)threadIdx.x >> 6);
    for (int u = F.wave0 * 64 + lane_id_asm(); u < (LDS_BYTES - LDSCTL_OFF) / 4; u += NWAVES * 64) ((LAS unsigned*)(F.lds + LDSCTL_OFF))[u] = 0u;
    __syncthreads();
    XcdBarrier bar; bar.bar = (unsigned*)(F.ctl + CW_BAR); bar.x = 0; bar.st = nullptr; bar.wave0 = F.wave0;
    if (N_LAUNCHES == 1) bar = xcd_barrier_post((unsigned*)(F.ctl + CW_BAR), F.MISC + 8, F.wave0);
    if (N_LAUNCHES == 1 && XB_IS_T0(F.wave0)) __hip_atomic_fetch_or(F.ctl + 3072 + 64 * (blockIdx.x & 7u), 1u << xb_xcc_id(), __ATOMIC_RELAXED, __HIP_MEMORY_SCOPE_AGENT);
#define GRID_BAR() do { if (N_LAUNCHES == 1) xcd_barrier(bar); } while (0)
#define GRP_BAR() do { if (N_LAUNCHES == 1) { int g_ = (int)(blockIdx.x & 7u); asm volatile("" : "+s"(g_));     \
        if (__builtin_amdgcn_readfirstlane((int)F.MISC[10]) != 0) grp_barrier((unsigned*)(F.ctl + 2048 + 128 * g_), 32u, (unsigned*)(F.ctl + CW_BAR + XB_TMO), F.wave0);     \
        else xcd_barrier(bar); } } while (0)
    const int lo = (N_LAUNCHES == 1) ? 0 : args.ph_lo, hi = (N_LAUNCHES == 1) ? N_PHASES : args.ph_hi;
#define IN(k) (lo <= (k) && (k) < hi)
#define BOTH(k) (IN(k) && IN((k) + 1))

    if (IN(0)) { p0_prologue(F); if (BOTH(0)) GRID_BAR(); }
    if (N_LAUNCHES == 1) {
        if (XB_IS_T0(F.wave0)) { const unsigned m_ = xb_ld((unsigned*)(F.ctl + 3072 + 64 * (blockIdx.x & 7u))); F.MISC[10] = (gridDim.x == 256u && m_ != 0u && (m_ & (m_ - 1u)) == 0u) ? 1u : 0u; }
        __syncthreads(); }
    for (int l = 0; l < DEPTH; ++l) {
        const int pb = 1 + 3 * l;
        if (IN(pb)) {
            pg8::Gemm g{F.XB + (size_t)l * MTOK * DM, F.WIN + (size_t)l * NIN * DM, MTOK, NIN, DM}; pg8::StaticOrder S; S.init(MTOK, NIN, F.G, (int)blockIdx.x, (int)(blockIdx.x & 7));
            pg8::EpiFused E{F.QI, F.DEC, F.KPART, F.ROWSS + (size_t)l * MTOK * 16, F.LB + l * 512, F.q_norm_w + l * 64, F.k_norm_w + l * 64, nullptr, 0};
            {
                pg8::Unit u0{0, 0}, u4{0, 0}, ut; bool two = S.next(0, u0) && S.next(4, u4);
                for (int i = 0; two && S.next(i, ut); ++i) two = (ut.pm == u0.pm || ut.pm == u4.pm);
                if (two) { LAS float* rt = (LAS float*)(F.lds + EXTRA_OFF); int t_ = F.wave0 * 64 + lane_id_asm(); asm volatile("" : "+v"(t_));
                    rt[t_] = pg8::EpiFused::rstd_global(E.rowss, ((t_ >> 8) ? u4.pm : u0.pm) * 256 + (t_ & 255));
                    E.rtab = rt; E.pm0 = u0.pm; __syncthreads(); } }
            for (int rp = 0; rp < REP_PROJ; ++rp) { if (rp) GRID_BAR(); pg8::gemm_phase<pg8::EpiFused, pg8::StaticOrder, true, true>(F.lds + RING_OFF, g, S, E, F.wave0); }
            if (BOTH(pb)) GRP_BAR();
        }
        if (IN(pb + 1)) {
            for (int rp = 0; rp < REP_HGRN; ++rp) { if (rp) GRID_BAR(); hgrn_mfma_phase(F, l); }
            for (int rp = 0; rp < REP_MOBA; ++rp) { if (rp) { GRID_BAR(); if (blockIdx.x == 0 && F.wave0 == 0 && lane_id_asm() == 0) __hip_atomic_store(F.ctl + CW_QUEUE + 64 * l, 0u, RLX_AGENT); GRID_BAR(); } moba_mfma_phase(F, l); }
            if (BOTH(pb + 1)) GRP_BAR(); }
        if (IN(pb + 2)) {
            pg8::Gemm g{F.MIXED, F.WOUT + (size_t)l * DM * DM, MTOK, DM, DM}; pg8::StaticOrder S; S.init(MTOK, DM, F.G, (int)blockIdx.x);
            pg8::EpiOut E{l == 0 ? F.XB : F.XB + (size_t)MTOK * DM, l == 0 ? nullptr : F.out, l == 0 ? F.XB + (size_t)MTOK * DM : nullptr, l == 0 ? F.ROWSS + (size_t)MTOK * 16 : nullptr};
            for (int rp = 0; rp < REP_OUT; ++rp) { if (rp) GRID_BAR(); pg8::gemm_phase<pg8::EpiOut, pg8::StaticOrder, true, true>(F.lds + RING_OFF, g, S, E, F.wave0); }
            if (pb + 2 < N_PHASES - 1 && BOTH(pb + 2)) GRP_BAR();
        }
    }
#undef IN
#undef BOTH
}

extern "C" void kernel_launch(void* const* d_in, const int* in_sizes, int n_in, void* d_out, int out_size, void* d_ws, size_t ws_size, hipStream_t stream) {
    static int grid = 0;
    if (grid == 0) {
        if (n_in != 8 || in_sizes[0] != MTOK * DM || out_size != MTOK * DM || ws_size < WS_END) { fprintf(stderr, "kernel_launch: unexpected shapes n_in %d in0 %d out %d ws %zu\n", n_in, n_in > 0 ? in_sizes[0] : -1, out_size, ws_size); grid = -1; return; }
        int dev = 0, cus = 0, per_cu = 0;
        if (hipGetDevice(&dev) != hipSuccess || hipDeviceGetAttribute(&cus, hipDeviceAttributeMultiprocessorCount, dev) != hipSuccess) { grid = -1; return; }
        if (hipFuncSetAttribute((const void*)fwd, hipFuncAttributeMaxDynamicSharedMemorySize, LDS_BYTES) != hipSuccess) { fprintf(stderr, "kernel_launch: hipFuncSetAttribute failed\n"); grid = -1; return; }
        if (hipOccupancyMaxActiveBlocksPerMultiprocessor(&per_cu, (const void*)fwd, NWAVES * 64, LDS_BYTES) != hipSuccess || per_cu < 1) fprintf(stderr, "kernel_launch: occupancy query says %d\n", per_cu);
        (void)hipGetLastError();
        if (per_cu < 1) { grid = -1; return; }
        grid = cus < 512 ? cus : 512;
    }
    if (grid < 0) return;
    if (hipMemsetAsync((char*)d_ws + WS_CTL, 0, CTL_ZERO_BYTES, stream) != hipSuccess) return;
    Args a{};
    for (int i = 0; i < 8; ++i) a.in[i] = (const float*)d_in[i];
    a.out = (float*)d_out; a.ws = (unsigned char*)d_ws;
    for (int li = 0; li < N_LAUNCHES; ++li) {
        a.ph_lo = (N_LAUNCHES == 1) ? 0 : li; a.ph_hi = (N_LAUNCHES == 1) ? N_PHASES : li + 1; a.li = li;
        hipError_t le;
        if (N_LAUNCHES == 1) { void* kargs[] = {(void*)&a}; le = hipLaunchCooperativeKernel((const void*)fwd, dim3(grid), dim3(NWAVES * 64), kargs, LDS_BYTES, stream); }
        else { hipLaunchKernelGGL(fwd, dim3(grid), dim3(NWAVES * 64), LDS_BYTES, stream, a); le = hipPeekAtLastError(); }
        if (le != hipSuccess) { fprintf(stderr, "kernel_launch: launch %d failed: %s\n", li, hipGetErrorName(le)); break; }
    }
}
```

```cpp
#include <hip/hip_runtime.h>
#include <cstdio>
#include <cstdint>
__device__ __forceinline__ int lane_id_asm() { int l; asm volatile("v_mbcnt_lo_u32_b32 %0, -1, 0\n\tv_mbcnt_hi_u32_b32 %0, -1, %0" : "=v"(l)); return l; }
namespace pg8 {
#define PG8_LAS __attribute__((address_space(3)))
typedef unsigned short bf16_t;
typedef short bf16x8 __attribute__((ext_vector_type(8)));
typedef float f32x4 __attribute__((ext_vector_type(4)));
typedef unsigned u32x4 __attribute__((ext_vector_type(4)));
typedef unsigned u32x2 __attribute__((ext_vector_type(2)));
constexpr int BM = 256, BK = 64, HALF = 128, HTB = HALF * BK * 2  , STAGE_BYTES = 8 * HTB, NXCD = 8, WGM = 8;

__host__ __device__ __forceinline__ int lds_byte(int r, int c) { const int st = (r >> 4) * 2 + (c >> 5), rr = r & 15, cc = c & 31, ob = rr * 64 + cc * 2; return st * 1024 + (ob ^ (((ob >> 9) & 1) << 5)); }
__host__ __device__ __forceinline__ void stage_rc(int b, int& R, int& C) { const int st = b / 1024, sb = b % 1024, swz = sb ^ (((sb >> 9) & 1) << 5); R = (st >> 1) * 16 + swz / 64; C = (st & 1) * 32 + (swz % 64) / 2; }
__host__ __device__ __forceinline__ int perm32(int rho) { const int n = rho >> 4, i = rho & 15; return 8 * (i >> 2) + 4 * n + (i & 3); }

struct Unit { int pm, pn; };
struct Gemm { const bf16_t* A; const bf16_t* Bt; int M, N, K; };

struct StaticOrder {
    int nM, nN, nwg, G, c, rot;
    __host__ __device__ void init(int M, int N, int G_, int c_, int rot_ = 0) { __builtin_assume(c_ >= 0 && c_ < 512);     nM = M / BM; nN = N / BM; nwg = nM * nN; G = G_; c = c_; rot = (nwg == 8 * G_) ? rot_ : 0; }
    __host__ __device__ bool next(int i, Unit& u) const {
        if ((long)i * G + c >= nwg) return false;
        const long L = (long)((i + rot) & (rot ? 7 : -1)) * G + c;
        int wgid = (int)L; { const int q = nwg / NXCD, r = nwg % NXCD, xcd = wgid % NXCD, off = wgid / NXCD; wgid = (xcd < r ? xcd * (q + 1) : r * (q + 1) + (xcd - r) * q) + off; }
        const int nig = WGM * nN, gid = wgid / nig, fm = gid * WGM, gsz = (nM - fm) < WGM ? (nM - fm) : WGM;
        u.pm = fm + ((wgid % nig) % gsz); u.pn = (wgid % nig) / gsz; return true;
    }
    __device__ __forceinline__ void a_ready(const Unit&) const {}
    __device__ __forceinline__ void done(const Unit&) const {}
};

__device__ __forceinline__ unsigned cvt_pk_bf16(float lo, float hi) { unsigned r; asm volatile("v_cvt_pk_bf16_f32 %0, %1, %2" : "=v"(r) : "v"(lo), "v"(hi)); return r; }


__device__ __forceinline__ float dpp_row_shr(float v, int n) {
    const int x = __builtin_bit_cast(int, v);
    int r;
    if (n == 1) r = __builtin_amdgcn_update_dpp(0, x, 0x111, 0xf, 0xf, false);
    else if (n == 2) r = __builtin_amdgcn_update_dpp(0, x, 0x112, 0xf, 0xf, false);
    else if (n == 4) r = __builtin_amdgcn_update_dpp(0, x, 0x114, 0xf, 0xf, false);
    else r = __builtin_amdgcn_update_dpp(0, x, 0x118, 0xf, 0xf, false);
    return __builtin_bit_cast(float, r);
}
__device__ __forceinline__ float dpp_row_shr1(float v, int n) {
    const int x = __builtin_bit_cast(int, v); const int one = 0x3f800000;
    int r;
    if (n == 1) r = __builtin_amdgcn_update_dpp(one, x, 0x111, 0xf, 0xf, false);
    else if (n == 2) r = __builtin_amdgcn_update_dpp(one, x, 0x112, 0xf, 0xf, false);
    else if (n == 4) r = __builtin_amdgcn_update_dpp(one, x, 0x114, 0xf, 0xf, false);
    else r = __builtin_amdgcn_update_dpp(one, x, 0x118, 0xf, 0xf, false);
    return __builtin_bit_cast(float, r);
}
__device__ __forceinline__ float fsig(float z) { return __builtin_amdgcn_rcpf(1.0f + __expf(-z)); }
struct EpiFused {
    static constexpr bool PERM = true, AFTER_DRAIN = false;
    bf16_t* ARR; float* DEC; float* KPART; const float* rowss; const float* lb; const float* qg; const float* kg;
    static constexpr size_t AS = (size_t)32768 * 512;
    const PG8_LAS float* rtab; int pm0;
    __device__ __forceinline__ float rstd_of(int row) const { return rtab ? rtab[(((row >> 8) == pm0) ? 0 : 256) + (row & 255)] : rstd_global(rowss, row); }
    static __device__ __forceinline__ float rstd_global(const float* rowss, int row) {
        const f32x4* rp = (const f32x4*)(rowss + (size_t)row * 16);
        const f32x4 a = rp[0], b = rp[1], c = rp[2], d = rp[3];
        const float ss = ((a[0] + a[1]) + (a[2] + a[3])) + ((b[0] + b[1]) + (b[2] + b[3])) + ((c[0] + c[1]) + (c[2] + c[3])) + ((d[0] + d[1]) + (d[2] + d[3]));
        return 1.0f / sqrtf(ss * (1.0f / 1024.0f) + 1e-6f);
    }
    static __device__ __forceinline__ u32x4 pack8(const float (&v)[8]) { u32x4 w; w.x = cvt_pk_bf16(v[0], v[1]); w.y = cvt_pk_bf16(v[2], v[3]); w.z = cvt_pk_bf16(v[4], v[5]); w.w = cvt_pk_bf16(v[6], v[7]); return w; }
    __device__ __forceinline__ void operator()(const f32x4 (&acc)[2][2][4][2], const Unit& u, int wr, int wc, int fr, int fq) const {
        const int row0 = u.pm * BM + wr * 64 + fr; const int pn = u.pn;
        if (pn < 4) {
            const int cb = pn * 128 + wc * 32 + 8 * fq;
            float lbv[8];
#pragma unroll
            for (int k = 0; k < 8; ++k) lbv[k] = lb[cb + k];
#pragma unroll
            for (int ai = 0; ai < 2; ++ai)
#pragma unroll
                for (int mp = 0; mp < 2; ++mp) { const int row1 = row0 + ai * HALF + mp * 32, row2 = row1 + 16; const float rs1 = rstd_of(row1), rs2 = rstd_of(row2);
                    float qi1[8], kt1[8], qi2[8], kt2[8], dc[8];
#pragma unroll
                    for (int k = 0; k < 8; ++k) {
                        const float zq1 = acc[ai][0][2 * mp][k >> 2][k & 3] * rs1, zf1 = acc[ai][1][2 * mp][k >> 2][k & 3] * rs1;
                        const float zq2 = acc[ai][0][2 * mp + 1][k >> 2][k & 3] * rs2, zf2 = acc[ai][1][2 * mp + 1][k >> 2][k & 3] * rs2;
                        const float f1 = lbv[k] + (1.0f - lbv[k]) * fsig(zf1), f2 = lbv[k] + (1.0f - lbv[k]) * fsig(zf2);
                        float e1 = f1, e2 = f2;
                        e1 *= dpp_row_shr1(e1, 1); e2 *= dpp_row_shr1(e2, 1); e1 *= dpp_row_shr1(e1, 2); e2 *= dpp_row_shr1(e2, 2);
                        e1 *= dpp_row_shr1(e1, 4); e2 *= dpp_row_shr1(e2, 4); e1 *= dpp_row_shr1(e1, 8); e2 *= dpp_row_shr1(e2, 8);
                        e2 *= __shfl(e1, (fq << 4) | 15);
                        qi1[k] = zq1 * fsig(zq1) * e1; kt1[k] = (1.0f - f1) * fminf(__builtin_amdgcn_rcpf(e1), 5.5406224e34f);
                        qi2[k] = zq2 * fsig(zq2) * e2; kt2[k] = (1.0f - f2) * fminf(__builtin_amdgcn_rcpf(e2), 5.5406224e34f); dc[k] = e2; }
                    { const int pc = pn * 128 + wc * 32 + 16 * (fq & 1) + 4 * (fq >> 1);
                      const u32x4 a1 = pack8(qi1), b1 = pack8(kt1), a2 = pack8(qi2), b2 = pack8(kt2);
                      bf16_t* q1 = ARR + (size_t)row1 * 512 + pc; bf16_t* q2 = ARR + (size_t)row2 * 512 + pc;
                      *(u32x2*)(q1) = (u32x2){a1.x, a1.y}; *(u32x2*)(q1 + 8) = (u32x2){a1.z, a1.w}; *(u32x2*)(q1 + AS) = (u32x2){b1.x, b1.y}; *(u32x2*)(q1 + AS + 8) = (u32x2){b1.z, b1.w};
                      *(u32x2*)(q2) = (u32x2){a2.x, a2.y}; *(u32x2*)(q2 + 8) = (u32x2){a2.z, a2.w}; *(u32x2*)(q2 + AS) = (u32x2){b2.x, b2.y}; *(u32x2*)(q2 + AS + 8) = (u32x2){b2.z, b2.w}; }
                    if (fr == 15) { float* dp = DEC + (size_t)(row1 >> 5) * 512 + cb; *(f32x4*)dp = (f32x4){dc[0], dc[1], dc[2], dc[3]}; *(f32x4*)(dp + 4) = (f32x4){dc[4], dc[5], dc[6], dc[7]}; }
                    asm volatile("" ::: "memory"); }
        } else if (pn < 8) {
            const int cb = (pn - 4) * 128 + wc * 32 + 8 * fq;
#pragma unroll
            for (int ai = 0; ai < 2; ++ai)
#pragma unroll
                for (int m = 0; m < 4; ++m) { const int row = row0 + ai * HALF + m * 16; const float rs = rstd_of(row);
                    float iv[8], gv[8];
#pragma unroll
                    for (int k = 0; k < 8; ++k) { iv[k] = acc[ai][0][m][k >> 2][k & 3] * rs; const float zg = acc[ai][1][m][k >> 2][k & 3] * rs; gv[k] = zg * fsig(zg); }
                    *(u32x4*)(ARR + 2 * AS + (size_t)row * 512 + cb) = pack8(iv); *(u32x4*)(ARR + 3 * AS + (size_t)row * 512 + cb) = pack8(gv);
                    asm volatile("" ::: "memory"); }
        } else {
            const int ty = (pn - 8) >> 1, head = 4 * ((pn - 8) & 1) + wc; const int d0 = 8 * fq;
            bf16_t* dst = ARR + (size_t)(4 + ty) * AS;
            float gain[2][8]; float csum[2][8];
#pragma unroll
            for (int bj = 0; bj < 2; ++bj)
#pragma unroll
                for (int k = 0; k < 8; ++k) { gain[bj][k] = (ty == 0) ? qg[bj * 32 + d0 + k] * (0.125f * 1.4426950408889634f) : (ty == 1) ? kg[bj * 32 + d0 + k] : 1.0f; csum[bj][k] = 0.f; }
#pragma unroll
            for (int ai = 0; ai < 2; ++ai)
#pragma unroll
                for (int m = 0; m < 4; ++m) { const int row = row0 + ai * HALF + m * 16; const float rs = rstd_of(row);
                    float v[2][8];
#pragma unroll
                    for (int bj = 0; bj < 2; ++bj)
#pragma unroll
                        for (int k = 0; k < 8; ++k) v[bj][k] = acc[ai][bj][m][k >> 2][k & 3] * rs;
                    if (ty < 2) { float ss = 0.f;
#pragma unroll
                        for (int bj = 0; bj < 2; ++bj)
#pragma unroll
                            for (int k = 0; k < 8; ++k) ss += v[bj][k] * v[bj][k];
                        ss += __shfl_xor(ss, 16); ss += __shfl_xor(ss, 32);
                        const float r2 = 1.0f / sqrtf(ss * (1.0f / 64.0f) + 1e-6f);
#pragma unroll
                        for (int bj = 0; bj < 2; ++bj)
#pragma unroll
                            for (int k = 0; k < 8; ++k) { v[bj][k] *= r2 * gain[bj][k]; csum[bj][k] += v[bj][k]; }
                    } else if (ty == 3) {
#pragma unroll
                        for (int bj = 0; bj < 2; ++bj)
#pragma unroll
                            for (int k = 0; k < 8; ++k) v[bj][k] = v[bj][k] * fsig(v[bj][k]); }
                    *(u32x4*)(dst + (size_t)row * 512 + head * 64 + d0) = pack8(v[0]); *(u32x4*)(dst + (size_t)row * 512 + head * 64 + 32 + d0) = pack8(v[1]);
                    asm volatile("" ::: "memory"); }
            if (ty == 1) {
#pragma unroll
                for (int bj = 0; bj < 2; ++bj)
#pragma unroll
                    for (int k = 0; k < 8; ++k) { float s = csum[bj][k]; s += __shfl_xor(s, 1); s += __shfl_xor(s, 2); s += __shfl_xor(s, 4); s += __shfl_xor(s, 8); csum[bj][k] = s; }
                if (fr == 0) { float* kp = KPART + ((size_t)u.pm * 2 + wr) * 512 + head * 64 + d0;
#pragma unroll
                    for (int bj = 0; bj < 2; ++bj) { *(f32x4*)(kp + bj * 32) = (f32x4){csum[bj][0], csum[bj][1], csum[bj][2], csum[bj][3]}; *(f32x4*)(kp + bj * 32 + 4) = (f32x4){csum[bj][4], csum[bj][5], csum[bj][6], csum[bj][7]}; } }
            }
        }
    }
};
struct EpiOut {
    static constexpr bool PERM = true, AFTER_DRAIN = false;
    const bf16_t* xres16; float* out; bf16_t* xb; float* rowss;
    __device__ __forceinline__ void operator()(const f32x4 (&acc)[2][2][4][2], const Unit& u, int wr, int wc, int fr, int fq) const {
        const int col0 = u.pn * BM + wc * 32 + 8 * fq;
        const size_t base = (size_t)(u.pm * BM + wr * 64 + fr) * 1024 + col0;
        u32x4 res[2][4][2];
#pragma unroll
        for (int ai = 0; ai < 2; ++ai)
#pragma unroll
            for (int m = 0; m < 4; ++m)
#pragma unroll
                for (int bj = 0; bj < 2; ++bj) res[ai][m][bj] = *(const u32x4*)(xres16 + base + (size_t)(ai * HALF + m * 16) * 1024 + bj * HALF);
#pragma unroll
        for (int ai = 0; ai < 2; ++ai)
#pragma unroll
            for (int m = 0; m < 4; ++m) {
                const int row = u.pm * BM + ai * HALF + wr * 64 + m * 16 + fr; float ss = 0.f;
#pragma unroll
                for (int bj = 0; bj < 2; ++bj) { const size_t off = (size_t)row * 1024 + col0 + bj * HALF;
                    const u32x4 r = res[ai][m][bj];
                    f32x4 v0 = (f32x4){__builtin_bit_cast(float, r.x << 16), __builtin_bit_cast(float, r.x & 0xffff0000u), __builtin_bit_cast(float, r.y << 16), __builtin_bit_cast(float, r.y & 0xffff0000u)};
                    f32x4 v1 = (f32x4){__builtin_bit_cast(float, r.z << 16), __builtin_bit_cast(float, r.z & 0xffff0000u), __builtin_bit_cast(float, r.w << 16), __builtin_bit_cast(float, r.w & 0xffff0000u)};
                    v0 = v0 + acc[ai][bj][m][0]; v1 = v1 + acc[ai][bj][m][1];
                    if (out) { *(f32x4*)(out + off) = v0; *(f32x4*)(out + off + 4) = v1; }
                    if (xb) { u32x4 w; w.x = cvt_pk_bf16(v0[0], v0[1]); w.y = cvt_pk_bf16(v0[2], v0[3]); w.z = cvt_pk_bf16(v1[0], v1[1]); w.w = cvt_pk_bf16(v1[2], v1[3]); *(u32x4*)(xb + off) = w; }
                    if (rowss) ss += ((v0[0] * v0[0] + v0[1] * v0[1]) + (v0[2] * v0[2] + v0[3] * v0[3])) + ((v1[0] * v1[0] + v1[1] * v1[1]) + (v1[2] * v1[2] + v1[3] * v1[3])); }
                if (rowss) { ss += __shfl_xor(ss, 16); ss += __shfl_xor(ss, 32); }
                if (fq == 0 && rowss) rowss[(size_t)row * 16 + u.pn * 4 + wc] = ss;
            }
    }
};

template <class Epi, class Sched, bool ALIGN_EPI = false, bool SP2 = false>
__device__ __forceinline__ void gemm_phase(PG8_LAS unsigned char* lds, const Gemm g, const Sched& S, const Epi& E, const int wave0) {
    int tid = wave0 * 64 + lane_id_asm(); asm volatile("" : "+v"(tid));
    const int wid = __builtin_amdgcn_readfirstlane(tid >> 6), lane = tid & 63, wr = wid >> 2, wc = wid & 3, fr = lane & 15, fq = lane >> 4;
    const int K = g.K, nt = K / BK;
    unsigned voffA[2], voffB[2];
#pragma unroll
    for (int i = 0; i < 2; ++i) { int R, C; stage_rc(tid * 16 + i * 8192, R, C); const int Rb = Epi::PERM ? ((R & ~31) + perm32(R & 31)) : R;
        voffA[i] = (unsigned)(R * K + C) * 2u; voffB[i] = (unsigned)(Rb * K + C) * 2u; }
    const size_t kstep = (size_t)(BK * 2);
    const size_t hstep = (size_t)HALF * K * 2;
    const size_t tstep = 2 * hstep;
    const unsigned ldsw = (unsigned)wid * 1024u;
    const int aoff = lds_byte(wr * 64 + fr, fq * 8), boff = lds_byte(wc * 32 + fr, fq * 8);
#define PG8_SA(b, h) (((b) * 2 + (h)) * HTB)
#define PG8_SB(b, h) ((4 + (b) * 2 + (h)) * HTB)
#define PG8_STAGE(bufoff, gbase, voff) do { _Pragma("unroll") for (int _i = 0; _i < 2; ++_i) \
        __builtin_amdgcn_global_load_lds((const unsigned*)((const char*)(gbase) + (voff)[_i]), (PG8_LAS unsigned*)(lds + (bufoff) + ldsw + _i * 8192), 16, 0, 0); } while (0)
#define PG8_LDA(dst, b, h) do { _Pragma("unroll") for (int m = 0; m < 4; ++m) _Pragma("unroll") for (int k = 0; k < 2; ++k) dst[m][k] = *(const PG8_LAS bf16x8*)(lds + PG8_SA(b, h) + aoff + m * 2048 + k * 1024); } while (0)
#define PG8_LDB(dst, b, h) do { _Pragma("unroll") for (int n = 0; n < 2; ++n) _Pragma("unroll") for (int k = 0; k < 2; ++k) dst[n][k] = *(const PG8_LAS bf16x8*)(lds + PG8_SB(b, h) + boff + n * 2048 + k * 1024); } while (0)
#define PG8_MMA(ai, bj, At, Bt) do { __builtin_amdgcn_s_setprio(1); _Pragma("unroll") for (int m = 0; m < 4; ++m) _Pragma("unroll") for (int n = 0; n < 2; ++n) _Pragma("unroll") for (int k = 0; k < 2; ++k) \
        acc[ai][bj][m][n] = __builtin_amdgcn_mfma_f32_16x16x32_bf16(Bt[n][k], At[m][k], acc[ai][bj][m][n], 0, 0, 0); __builtin_amdgcn_s_setprio(0); } while (0)
#define PG8_WAIT_V(n) asm volatile("s_waitcnt vmcnt(" #n ")" ::: "memory")
#define PG8_WAIT_L(n) asm volatile("s_waitcnt lgkmcnt(" #n ")" ::: "memory")
#define PG8_BAR __builtin_amdgcn_s_barrier()
#define PG8_SCHED __builtin_amdgcn_sched_barrier(0)
    Unit cur, nxt; int ui = 0;
    if (!S.next(0, cur)) return;
    f32x4 acc[2][2][4][2];
#pragma unroll
    for (int a = 0; a < 2; ++a)
#pragma unroll
        for (int b = 0; b < 2; ++b)
#pragma unroll
            for (int m = 0; m < 4; ++m)
#pragma unroll
                for (int n = 0; n < 2; ++n) acc[a][b][m][n] = (f32x4){0.f, 0.f, 0.f, 0.f};
    bf16x8 At[4][2], B0[2][2], B1[2][2];
    const char* cA = (const char*)g.A + (size_t)cur.pm * tstep; const char* cB = (const char*)g.Bt + (size_t)cur.pn * tstep;
    S.a_ready(cur);
    if constexpr (SP2) {
        PG8_STAGE(PG8_SB(0, 0), cB, voffB); PG8_STAGE(PG8_SB(0, 1), cB + hstep, voffB); PG8_STAGE(PG8_SA(0, 0), cA, voffA); PG8_STAGE(PG8_SA(0, 1), cA + hstep, voffA);
        if (wr == 1) PG8_BAR;
        PG8_WAIT_V(2); PG8_BAR;
        PG8_STAGE(PG8_SB(1, 0), cB + kstep, voffB); PG8_STAGE(PG8_SA(1, 0), cA + kstep, voffA); PG8_STAGE(PG8_SB(1, 1), cB + hstep + kstep, voffB);
        PG8_WAIT_V(6); PG8_BAR;
    } else {
        PG8_STAGE(PG8_SB(0, 0), cB, voffB); PG8_STAGE(PG8_SA(0, 0), cA, voffA); PG8_STAGE(PG8_SB(0, 1), cB + hstep, voffB); PG8_STAGE(PG8_SA(0, 1), cA + hstep, voffA);
        if (wr == 1) PG8_BAR;
        PG8_WAIT_V(4); PG8_BAR;
        PG8_STAGE(PG8_SB(1, 0), cB + kstep, voffB); PG8_STAGE(PG8_SA(1, 0), cA + kstep, voffA); PG8_STAGE(PG8_SB(1, 1), cB + hstep + kstep, voffB);
        PG8_WAIT_V(6); PG8_BAR;
    }
    for (;;) {
        const bool has_next = S.next(ui + 1, nxt);
        const char* nA = has_next ? (const char*)g.A + (size_t)nxt.pm * tstep : cA; const char* nB = has_next ? (const char*)g.Bt + (size_t)nxt.pn * tstep : cB;
        for (int t = 0; t < nt; t += 2) {
            const bool last = (t == nt - 2);
            const char* a1 = cA + (size_t)(t + 1) * kstep;
            const char* a2 = last ? nA : cA + (size_t)(t + 2) * kstep; const char* b2 = last ? nB : cB + (size_t)(t + 2) * kstep;
            const char* a3 = a2 + kstep; const char* b3 = b2 + kstep;
            if (last && has_next) S.a_ready(nxt);
            if constexpr (SP2) {
            PG8_LDB(B0, 0, 0); PG8_LDB(B1, 0, 1); PG8_SCHED; PG8_LDA(At, 0, 0); PG8_STAGE(PG8_SA(1, 1), a1 + hstep, voffA);
            PG8_WAIT_V(8); PG8_WAIT_L(0); PG8_BAR; PG8_MMA(0, 0, At, B0); PG8_MMA(0, 1, At, B1); PG8_BAR; PG8_SCHED;
            PG8_LDA(At, 0, 1); PG8_STAGE(PG8_SB(0, 0), b2, voffB); PG8_STAGE(PG8_SB(0, 1), b2 + hstep, voffB); PG8_STAGE(PG8_SA(0, 0), a2, voffA);
            PG8_WAIT_V(8); PG8_WAIT_L(0); PG8_BAR; PG8_MMA(1, 0, At, B0); PG8_MMA(1, 1, At, B1); PG8_BAR; PG8_SCHED;
            PG8_LDB(B0, 1, 0); PG8_LDB(B1, 1, 1); PG8_SCHED; PG8_LDA(At, 1, 0); PG8_STAGE(PG8_SA(0, 1), a2 + hstep, voffA);
            PG8_WAIT_V(8); PG8_WAIT_L(0); PG8_BAR; PG8_MMA(0, 0, At, B0); PG8_MMA(0, 1, At, B1); PG8_BAR; PG8_SCHED;
            PG8_LDA(At, 1, 1); PG8_STAGE(PG8_SB(1, 0), b3, voffB); PG8_STAGE(PG8_SB(1, 1), b3 + hstep, voffB); PG8_STAGE(PG8_SA(1, 0), a3, voffA);
            PG8_WAIT_V(8); PG8_WAIT_L(0); PG8_BAR; PG8_MMA(1, 0, At, B0); PG8_MMA(1, 1, At, B1); PG8_BAR; PG8_SCHED;
            } else {
            PG8_LDB(B0, 0, 0); PG8_SCHED; PG8_LDA(At, 0, 0); PG8_STAGE(PG8_SA(1, 1), a1 + hstep, voffA);
            PG8_WAIT_L(8); PG8_BAR; PG8_WAIT_L(0); PG8_MMA(0, 0, At, B0); PG8_BAR; PG8_SCHED;
            PG8_LDB(B1, 0, 1); PG8_STAGE(PG8_SB(0, 0), b2, voffB);
            PG8_BAR; PG8_WAIT_L(0); PG8_MMA(0, 1, At, B1); PG8_BAR;
            PG8_LDA(At, 0, 1); PG8_STAGE(PG8_SA(0, 0), a2, voffA);
            PG8_BAR; PG8_WAIT_L(0); PG8_MMA(1, 0, At, B0); PG8_BAR; PG8_SCHED;
            PG8_STAGE(PG8_SB(0, 1), b2 + hstep, voffB);
            PG8_WAIT_V(6); PG8_BAR; PG8_MMA(1, 1, At, B1); PG8_BAR;
            PG8_LDB(B0, 1, 0); PG8_SCHED; PG8_LDA(At, 1, 0); PG8_STAGE(PG8_SA(0, 1), a2 + hstep, voffA);
            PG8_WAIT_L(8); PG8_BAR; PG8_WAIT_L(0); PG8_MMA(0, 0, At, B0); PG8_BAR; PG8_SCHED;
            PG8_LDB(B1, 1, 1); PG8_STAGE(PG8_SB(1, 0), b3, voffB);
            PG8_BAR; PG8_WAIT_L(0); PG8_MMA(0, 1, At, B1); PG8_BAR;
            PG8_LDA(At, 1, 1); PG8_STAGE(PG8_SA(1, 0), a3, voffA);
            PG8_BAR; PG8_WAIT_L(0); PG8_MMA(1, 0, At, B0); PG8_BAR; PG8_SCHED;
            PG8_STAGE(PG8_SB(1, 1), b3 + hstep, voffB);
            PG8_WAIT_V(6); PG8_BAR; PG8_MMA(1, 1, At, B1); PG8_BAR;
            }
        }
        if constexpr (ALIGN_EPI) { if (wr == 0) PG8_BAR; }
        if constexpr (!Epi::AFTER_DRAIN) { E(acc, cur, wr, wc, fr, fq); S.done(cur); }
        if (!has_next) break;
#pragma unroll
        for (int a = 0; a < 2; ++a)
#pragma unroll
            for (int b = 0; b < 2; ++b)
#pragma unroll
                for (int m = 0; m < 4; ++m)
#pragma unroll
                    for (int n = 0; n < 2; ++n) acc[a][b][m][n] = (f32x4){0.f, 0.f, 0.f, 0.f};
        cur = nxt; cA = nA; cB = nB; ++ui;
        if constexpr (ALIGN_EPI) { if (wr == 1) PG8_BAR; }
    }
    PG8_WAIT_V(0);
    if constexpr (!ALIGN_EPI) { if (wr == 0) PG8_BAR; }
    PG8_BAR;
    if constexpr (Epi::AFTER_DRAIN) { E.fused(acc, cur, wr, wc, fr, fq, lds, wid, lane); S.done(cur); }
#undef PG8_SA
#undef PG8_SB
#undef PG8_STAGE
#undef PG8_LDA
#undef PG8_LDB
#undef PG8_MMA
#undef PG8_WAIT_V
#undef PG8_WAIT_L
#undef PG8_BAR
#undef PG8_SCHED
}
}


constexpr int NWAVES = 8;
#ifndef REP_PROJ
#define REP_PROJ 1
#endif
#ifndef REP_HGRN
#define REP_HGRN 1
#endif
#ifndef REP_MOBA
#define REP_MOBA 1
#endif
#ifndef REP_OUT
#define REP_OUT 1
#endif
#ifndef MK_N_LAUNCHES
#define MK_N_LAUNCHES 1
#endif
constexpr int N_PHASES = 7;
constexpr int N_LAUNCHES = MK_N_LAUNCHES;

constexpr int BATCH = 16, SEQ = 2048, DM = 1024, DEPTH = 2, MTOK = BATCH * SEQ, NIN = 4096;
constexpr int C_HQ = 0, C_HF = 512, C_HI = 1024, C_HG = 1536, C_AQ = 2048, C_AK = 2560, C_AV = 3072, C_AG = 3584;
constexpr float NORM_EPS = 1e-6f;

constexpr size_t MiB = 1u << 20;
constexpr size_t WS_CTL = 0, CTL_ZERO_BYTES = 32768;
constexpr size_t WS_WIN = 2 * MiB;
constexpr size_t WS_WOUT = 18 * MiB;
constexpr size_t WS_LB = 22 * MiB;
constexpr size_t WS_KPART = 22 * MiB + 65536;
constexpr size_t WS_ROWSS = 24 * MiB;
constexpr size_t WS_DEC = 28 * MiB;
constexpr size_t WS_XB = 32 * MiB;
constexpr size_t WS_MIXED = 160 * MiB;
constexpr size_t WS_ARR = 224 * MiB;
constexpr size_t ARR_BYTES = 32 * MiB;
constexpr size_t WS_END = 480 * MiB;
constexpr int CW_QUEUE = 1024;
constexpr int CW_BAR = 4096;

constexpr int RING_OFF = 0, RING_BYTES = 131072;
constexpr int EXTRA_OFF = RING_BYTES, EXTRA_BYTES = 16384;
constexpr int LDSCTL_OFF = EXTRA_OFF + EXTRA_BYTES, MISC_OFF = LDSCTL_OFF + 320;
constexpr int LDS_BYTES = LDSCTL_OFF + 1024;

#define GAS __attribute__((address_space(1)))
#define LAS __attribute__((address_space(3)))
typedef unsigned short bf16;
typedef unsigned v4u __attribute__((ext_vector_type(4)));
typedef float f32x4 __attribute__((ext_vector_type(4)));
typedef GAS unsigned gu32;
#define RLX_AGENT __ATOMIC_RELAXED, __HIP_MEMORY_SCOPE_AGENT
#define LDS_WAIT() asm volatile("s_waitcnt lgkmcnt(0)" ::: "memory")
#define VM_WAIT() asm volatile("s_waitcnt vmcnt(0)" ::: "memory")
__device__ __forceinline__ unsigned f2bf(float f) { unsigned u = __builtin_bit_cast(unsigned, f); return (u + 0x7fffu + ((u >> 16) & 1u)) >> 16; }
__device__ __forceinline__ unsigned pk2(float lo, float hi) { return f2bf(lo) | (f2bf(hi) << 16); }
__device__ __forceinline__ float bf2f(unsigned short b) { return __builtin_bit_cast(float, (unsigned)b << 16); }
__device__ __forceinline__ float bflo(unsigned w) { return __builtin_bit_cast(float, w << 16); }
__device__ __forceinline__ float bfhi(unsigned w) { return __builtin_bit_cast(float, w & 0xffff0000u); }
__device__ __forceinline__ float silu_f(float z) { return z / (1.0f + __expf(-z)); }
__device__ __forceinline__ float sigmoid_f(float z) { return 1.0f / (1.0f + __expf(-z)); }

#define XB_TMO      128
#define XB_XCNT(j)  (256  + 64 * (j))
#define XB_XSUB(j)  (1280 + 64 * (j))
#define XB_XGEN(j)  (2304 + 64 * (j))
#define XB_TOP      3328
#define XB_TOPGEN   3392
#define XCD_BAR_WORDS 3456
#define XB_SPIN_CAP (1u << 18)

__device__ __forceinline__ unsigned xb_ld(unsigned* p)              { return __hip_atomic_load(p, __ATOMIC_RELAXED, __HIP_MEMORY_SCOPE_AGENT); }
__device__ __forceinline__ unsigned xb_add(unsigned* p, unsigned v) { return __hip_atomic_fetch_add(p, v, __ATOMIC_RELAXED, __HIP_MEMORY_SCOPE_AGENT); }
__device__ __forceinline__ unsigned xb_xcc_id() { return (unsigned)__builtin_amdgcn_s_getreg((3 << 11) | 20) & 0xFu; }
#define XB_SPIN(cond, bar) do { unsigned _sp = 0; while (cond) { __builtin_amdgcn_s_sleep(1); \
    if ((++_sp & 255u) == 0u) { if (xb_ld(&(bar)[XB_TMO])) break; if (_sp > XB_SPIN_CAP) { atomicAdd(&(bar)[XB_TMO], 1u); break; } } } } while (0)

struct XcdBarrier {
    unsigned* bar; unsigned x; int wave0;
    volatile LAS unsigned* st;
};

#define XB_IS_T0(wv) ((wv) == 0 && lane_id_asm() == 0)
__device__ __forceinline__ XcdBarrier xcd_barrier_post(unsigned* bar, volatile LAS unsigned* st, int wave0) {
    XcdBarrier b; b.bar = bar; b.x = xb_xcc_id(); b.st = st; b.wave0 = wave0;
    if (XB_IS_T0(wave0)) (void)xb_add(&bar[XB_XCNT(b.x)], 1u);
    return b;
}
__device__ __forceinline__ void xcd_barrier_complete(unsigned* bar, unsigned x, unsigned& nloc, unsigned& nx) {
    const unsigned G = gridDim.x * gridDim.y * gridDim.z;
    unsigned sum, cnt, mine, sp = 0u;
    for (;;) {
        sum = 0u; cnt = 0u; mine = 0u;
#pragma unroll
        for (unsigned j = 0; j < 16; ++j) { const unsigned c = xb_ld(&bar[XB_XCNT(j)]); sum += c; cnt += (c > 0u) ? 1u : 0u; mine = (j == x) ? c : mine; }
        if (sum == G) break;
        __builtin_amdgcn_s_sleep(1);
        if ((++sp & 255u) == 0u) { if (xb_ld(&bar[XB_TMO])) break; if (sp > XB_SPIN_CAP) { atomicAdd(&bar[XB_TMO], 1u); break; } }
    }
    nloc = mine > 0u ? mine : 1u; nx = cnt > 0u ? cnt : 1u;
}

__device__ __forceinline__ void xcd_barrier(const XcdBarrier& b) {
    asm volatile("s_waitcnt vmcnt(0)" ::: "memory");
    __syncthreads();
    if (XB_IS_T0(b.wave0)) {
        unsigned* bar = b.bar;
        __builtin_amdgcn_s_waitcnt(0);
        unsigned nloc = b.st[0], nx = b.st[1];
        if (nloc == 0u) { xcd_barrier_complete(bar, b.x, nloc, nx); b.st[0] = nloc; b.st[1] = nx; }
        const unsigned old = xb_add(&bar[XB_XSUB(b.x)], 1u);
        const unsigned gen = old / nloc;
        if (old + 1u == (gen + 1u) * nloc) {
            __builtin_amdgcn_fence(__ATOMIC_RELEASE, "agent");
            asm volatile("s_waitcnt vmcnt(0)" ::: "memory");
            const unsigned og = xb_add(&bar[XB_TOP], 1u);
            const unsigned tg = og / nx;
            if (og + 1u == (tg + 1u) * nx) xb_add(&bar[XB_TOPGEN], 1u);
            else XB_SPIN(xb_ld(&bar[XB_TOPGEN]) == tg, bar);
            __builtin_amdgcn_fence(__ATOMIC_ACQUIRE, "agent");
            xb_add(&bar[XB_XGEN(b.x)], 1u);
            asm volatile("s_waitcnt vmcnt(0)" ::: "memory");
        } else {
            XB_SPIN(xb_ld(&bar[XB_XGEN(b.x)]) == gen, bar);
            __builtin_amdgcn_fence(__ATOMIC_ACQUIRE, "agent");
            asm volatile("s_waitcnt vmcnt(0)" ::: "memory");
        }
    }
    __syncthreads();
}


__device__ __forceinline__ void grp_barrier(unsigned* cnt, unsigned n, unsigned* tmo, int wave0) {
    asm volatile("s_waitcnt vmcnt(0)" ::: "memory");
    __syncthreads();
    if (XB_IS_T0(wave0)) {
        __builtin_amdgcn_s_waitcnt(0);
        const unsigned old = xb_add(cnt, 1u); const unsigned gen = old / n;
        if (old + 1u == (gen + 1u) * n) xb_add(cnt + 64, 1u);
        else { unsigned sp_ = 0; while (xb_ld(cnt + 64) == gen) { __builtin_amdgcn_s_sleep(1); if ((++sp_ & 255u) == 0u) { if (xb_ld(tmo)) break; if (sp_ > XB_SPIN_CAP) { atomicAdd(tmo, 1u); break; } } } }
        __builtin_amdgcn_fence(__ATOMIC_ACQUIRE, "agent");
        asm volatile("s_waitcnt vmcnt(0)" ::: "memory");
    }
    __syncthreads();
}

struct Frame {
    LAS unsigned char* lds;
    volatile LAS unsigned* MISC;
    int wave0;
    gu32* ctl;
    int vcu, G;
    const float* x; float* out;
    const float *norm_w, *w_in, *lb_logits, *hg_norm_w, *q_norm_w, *k_norm_w, *w_out;
    bf16 *WIN, *WOUT, *XB, *MIXED, *QI, *KT, *HI, *GH, *QN, *KN, *V, *GA;
    float *LB, *KPART, *ROWSS, *DEC;
};

__device__ __forceinline__ float wave_sum(float v) {
#pragma unroll
    for (int o = 1; o < 64; o <<= 1) v += __shfl_xor(v, o);
    return v;
}
__device__ __forceinline__ int win_dest(int oc) {
    if (oc < 2048) { const int grp = oc >> 9, hh = (oc >> 7) & 3, w = oc & 127; return 256 * (((grp >> 1) << 2) + hh) + 128 * (grp & 1) + w; }
    const int ty = (oc - 2048) >> 9, head = (oc >> 6) & 7, bj = (oc >> 5) & 1; return 256 * (8 + 2 * ty + (head >> 2)) + 128 * bj + 32 * (head & 3);
}
__device__ __forceinline__ void p0_transpose_item(const float* W, int K, int N, bf16* WT, const float* kscale, LAS float* scr, int item, int lane, bool permute) {
    const int nblk = N / 32, kb = item / nblk, nb = item % nblk, k0 = 64 * kb, n0 = 32 * nb; const int nd = permute ? win_dest(n0) : n0;
    float wv_[32];
#pragma unroll
    for (int i = 0; i < 32; ++i) wv_[i] = __builtin_nontemporal_load(W + (size_t)(k0 + 2 * i + (lane >> 5)) * N + n0 + (lane & 31));
#pragma unroll
    for (int i = 0; i < 32; ++i) { const int kk = 2 * i + (lane >> 5); const float s = kscale ? kscale[k0 + kk] : 1.0f; scr[kk * 33 + (lane & 31)] = wv_[i] * s; }
    LDS_WAIT(); asm volatile("" ::: "memory");
    const int c = lane & 7;
#pragma unroll
    for (int j = 0; j < 4; ++j) { const int n = (lane >> 3) + 8 * j; const LAS float* s = scr + (8 * c) * 33 + n;
        v4u o; o.x = pk2(s[0 * 33], s[1 * 33]); o.y = pk2(s[2 * 33], s[3 * 33]); o.z = pk2(s[4 * 33], s[5 * 33]); o.w = pk2(s[6 * 33], s[7 * 33]);
        *(GAS v4u*)(WT + (size_t)(nd + n) * K + k0 + 8 * c) = o; }
    LDS_WAIT(); asm volatile("" ::: "memory");
}
#define PHASE_IDS() int t_ = F.wave0 * 64 + lane_id_asm(); asm volatile("" : "+v"(t_)); const int tid = t_, lane = tid & 63, wave = __builtin_amdgcn_readfirstlane(tid >> 6); (void)lane; (void)wave
__device__ __forceinline__ void p0_prologue(Frame& F) {
    PHASE_IDS();
    LAS float* scr = (LAS float*)(F.lds + RING_OFF + wave * 16384);
    const int gw = F.vcu * NWAVES + wave, NGW = F.G * NWAVES;
    constexpr int I_IN = (DM / 64) * (NIN / 32), I_OUT = (DM / 64) * (DM / 32);
    constexpr int NITEMS = DEPTH * (I_IN + I_OUT);
    for (int it = gw; it < NITEMS; it += NGW) {
        int r = it;
        if (r < DEPTH * I_IN) { const int l = r / I_IN; r -= l * I_IN;
            p0_transpose_item(F.w_in + (size_t)l * DM * NIN, DM, NIN, F.WIN + (size_t)l * NIN * DM, F.norm_w + l * DM, scr, r, lane, true); continue; }
        r -= DEPTH * I_IN; { const int l = r / I_OUT; r -= l * I_OUT;
            p0_transpose_item(F.w_out + (size_t)l * DM * DM, DM, DM, F.WOUT + (size_t)l * DM * DM, nullptr, scr, r, lane, false); }
    }
    const bool gl_ = (F.G == 256);
    for (int m0 = gl_ ? (gw >> 8) * 4096 + (gw & 255) * 4 : gw * 4; m0 < (gl_ ? ((gw >> 8) + 1) * 4096 : MTOK); m0 += gl_ ? 1024 : NGW * 4) {
        f32x4 v[4][4]; float sq[4];
#pragma unroll
        for (int r = 0; r < 4; ++r) { const GAS f32x4* xr = (const GAS f32x4*)(F.x + (size_t)(m0 + r) * DM) + lane;
#pragma unroll
            for (int j = 0; j < 4; ++j) v[r][j] = __builtin_nontemporal_load(xr + 64 * j); }
#pragma unroll
        for (int r = 0; r < 4; ++r) { float a = 0.f;
#pragma unroll
            for (int j = 0; j < 4; ++j) a += (v[r][j].x * v[r][j].x + v[r][j].y * v[r][j].y) + (v[r][j].z * v[r][j].z + v[r][j].w * v[r][j].w);
            sq[r] = a; }
#pragma unroll
        for (int o = 1; o < 64; o <<= 1) {
#pragma unroll
            for (int r = 0; r < 4; ++r) sq[r] += __shfl_xor(sq[r], o); }
#pragma unroll
        for (int r = 0; r < 4; ++r) { GAS unsigned long long* o8 = (GAS unsigned long long*)(F.XB + (size_t)(m0 + r) * DM) + lane;
#pragma unroll
            for (int j = 0; j < 4; ++j) o8[64 * j] = (unsigned long long)pk2(v[r][j].x, v[r][j].y) | ((unsigned long long)pk2(v[r][j].z, v[r][j].w) << 32);
            if (lane < 16) F.ROWSS[(size_t)(m0 + r) * 16 + lane] = (lane == 0) ? sq[r] : 0.f; }
    }
    if (blockIdx.x == 0) { const int c = tid; const float a0 = F.lb_logits[c], a1 = F.lb_logits[512 + c]; const float mx = fmaxf(a0, a1);
        const float e0 = expf(a0 - mx), e1 = expf(a1 - mx); const float p0 = e0 / (e0 + e1), p1 = e1 / (e0 + e1);
        F.LB[c] = 0.f; F.LB[512 + c] = fminf(fmaxf((p0 + p1) - p0, 0.f), 1.0f - 1e-6f); }
}

constexpr float LOG2E = 1.4426950408889634f;
constexpr float QSCALE2 = 0.125f * LOG2E;
namespace moba {
typedef short bf16x8 __attribute__((ext_vector_type(8)));
typedef short s16x4 __attribute__((ext_vector_type(4)));
typedef float f32x16 __attribute__((ext_vector_type(16)));
typedef float f32x2_t __attribute__((ext_vector_type(2))); typedef __bf16 bf16x2_t __attribute__((ext_vector_type(2)));
__device__ __forceinline__ unsigned cvtpk(float lo, float hi) { f32x2_t v = {lo, hi}; bf16x2_t b = __builtin_convertvector(v, bf16x2_t); return __builtin_bit_cast(unsigned, b); }
__device__ __forceinline__ int crow(int r, int hi) { return (r & 3) + 8 * (r >> 2) + 4 * hi; }
__device__ __forceinline__ float max3f(float a, float b, float c) { float r; asm("v_max3_f32 %0, %1, %2, %3" : "=v"(r) : "v"(a), "v"(b), "v"(c)); return r; }
constexpr int L_K = 0, L_V = 32768, L_WSF = 65536, L_KM = 67584, L_OST = 69632;
constexpr float NEG_BIG = -1e30f;
constexpr float THR = 8.0f;
__device__ __forceinline__ s16x4 vtr(const LAS unsigned char* p) { return __builtin_bit_cast(s16x4, __builtin_amdgcn_ds_read_tr16_b64_v4i16((LAS s16x4*)p)); }
}

__device__ __forceinline__ void moba_glds(unsigned voff, const void* sbase, unsigned lds_dst) { unsigned keep;
    asm volatile("s_mov_b32 %0, m0\n\ts_mov_b32 m0, %3\n\ts_nop 0\n\tglobal_load_lds_dwordx4 %1, %2\n\ts_mov_b32 m0, %0" : "=&s"(keep) : "v"(voff), "s"(sbase), "s"(lds_dst) : "memory"); }
template <bool FIXREF> __device__ __forceinline__ void moba_mfma_body(Frame& F, int l, const float gq, const float gk) {
    using namespace moba;
    PHASE_IDS();
    const int r32 = lane & 31, hi = lane >> 5, wid = wave;
    LAS unsigned char* L = F.lds + RING_OFF;
    LAS float* wsf = (LAS float*)(L + L_WSF) + wid * 64;
    LAS float* km = (LAS float*)(L + L_KM);
    LAS float* ost = (LAS float*)(L + L_OST) + wid * 2048;
    const float smax2 = 8.0f * gq * gk * LOG2E * 1.02f;
    const float mhat0 = -(smax2 + 1.0f);
    int grp_ = (int)(blockIdx.x & 7u); asm volatile("" : "+s"(grp_));
    gu32* qctr = F.ctl + CW_QUEUE + 64 * (2 * grp_ + l);
    volatile LAS unsigned* tick = (volatile LAS unsigned*)(F.lds + EXTRA_OFF + 8192);
    for (int ui = 0;; ++ui) {
        __syncthreads();
        const int it = __builtin_amdgcn_readfirstlane((int)tick[ui & 1]); if (it >= 128) break;
        const int qb = 7 - (it >> 4), bh = 16 * grp_ + (it & 15);
        const int b = bh >> 3, h = bh & 7; const size_t rowbase = (size_t)b * SEQ; const int q0 = qb * 256, qrel = wid * 32 + r32, tq = q0 + qrel;
        const float sl2 = exp2f(-(float)(h + 1)) * LOG2E;
        bf16x8 qr[4];
        { const GAS bf16* Qw = (const GAS bf16*)(F.QN + (rowbase + q0 + wid * 32 + r32) * 512 + h * 64 + hi * 8);
#pragma unroll
            for (int d0 = 0; d0 < 4; ++d0) qr[d0] = *(const GAS bf16x8*)(Qw + d0 * 16); }
        LAS unsigned char* qlds = (LAS unsigned char*)ost + lane * 16;
        float kml0 = 0.f, kml1 = 0.f;
        { int tid_u = tid; asm volatile("" : "+v"(tid_u));
          if (qb > 3 && tid_u < qb * 64) { const GAS float* kp = (const GAS float*)(F.KPART + ((size_t)b * 8 + (tid_u >> 6)) * 1024 + h * 64 + (tid_u & 63)); kml0 = kp[0]; kml1 = kp[512]; } }
        const unsigned koff = (unsigned)(((rowbase + lane) * 512 + h * 64 + wid * 8) * 2);
        unsigned voff; { const int vr = 8 * wid + (lane >> 3), sl = lane & 7; const int ch = ((((sl >> 2) ^ ((vr >> 1) & 1)) << 2) | (sl & 3)); voff = (unsigned)((((size_t)MTOK + rowbase + vr) * 512 + h * 64 + ch * 8) * 2); }
        const unsigned lds0 = (unsigned)(uintptr_t)L;
#define MOBA_ISSUE(t_, bufi) do { moba_glds(koff, (const void*)((const char*)F.KN + (size_t)(t_) * 65536), (unsigned)__builtin_amdgcn_readfirstlane((int)(lds0 + L_K + (bufi) * 8192 + wid * 1024))); \
            moba_glds(voff, (const void*)((const char*)F.KN + (size_t)(t_) * 65536), (unsigned)__builtin_amdgcn_readfirstlane((int)(lds0 + L_V + (bufi) * 8192 + wid * 1024))); } while (0)
        const int NT = 4 * (qb + 1);
        int t0 = 0; { const float dstar = (151.0f + 2.0f * smax2) / sl2; const float x = ((float)(q0 - 63) - dstar) * (1.0f / 64.0f); if (x > 0.f) t0 = ((int)x) & ~1; if (t0 > NT - 4) t0 = NT - 4; t0 = __builtin_amdgcn_readfirstlane(t0); }
        unsigned nticket = 0u; if (tid == 0) nticket = __hip_atomic_fetch_add(qctr, 1u, RLX_AGENT);
        MOBA_ISSUE(t0, 0); MOBA_ISSUE(t0 + 1, 1); MOBA_ISSUE(t0 + 2, 2);
        { int tid_u = tid; asm volatile("" : "+v"(tid_u)); if (qb > 3 && tid_u < qb * 64) km[tid_u] = (kml0 + kml1) * (1.0f / 256.0f); }
        if (qb > 3) __syncthreads();
        unsigned selmask = 0;
        if (qb <= 3) selmask = (1u << (qb + 1)) - 1u;
        else { float gt[7]; float qf32[32];
#pragma unroll
            for (int d0 = 0; d0 < 4; ++d0)
#pragma unroll
                for (int e = 0; e < 8; ++e) qf32[d0 * 8 + e] = bf2f((unsigned short)qr[d0][e]);
#pragma unroll
            for (int i = 0; i < 32; ++i) asm volatile("" : "+v"(qf32[i]));
#pragma unroll
            for (int j = 0; j < 7; ++j) { float s = 0.f;
                if (j < qb) {
#pragma unroll
                    for (int d0 = 0; d0 < 4; ++d0)
#pragma unroll
                        for (int e = 0; e < 8; ++e) s += qf32[d0 * 8 + e] * km[j * 64 + d0 * 16 + hi * 8 + e];
                    auto rr = __builtin_amdgcn_permlane32_swap(__float_as_uint(s), __float_as_uint(s), false, false);
                    s = __uint_as_float(rr[0]) + __uint_as_float(rr[1]); }
                gt[j] = s; }
#pragma unroll
            for (int j = 0; j < 7; ++j) { int rank = 0;
#pragma unroll
                for (int i = 0; i < 7; ++i) if (i != j && i < qb) rank += (gt[i] > gt[j] || (gt[i] == gt[j] && i < j)) ? 1 : 0;
                if (j < qb && rank < 3) selmask |= 1u << j; }
            selmask |= 1u << qb; }
        if (!FIXREF) {
#pragma unroll
            for (int d0 = 0; d0 < 4; ++d0) *(LAS bf16x8*)(qlds + d0 * 1024) = qr[d0]; }
        float mhat = mhat0, l_reg = 0.f; f32x16 o[2]; o[0] = f32x16{}; o[1] = f32x16{};
        const int kbase = L_K + hi * 1024 + r32 * 16;
        const int g16 = lane >> 4, i16 = lane & 15, tq4 = i16 >> 2, tp4 = i16 & 3;
        const int vrow0 = 4 * hi + tq4;
        if (tid == 0) tick[(ui + 1) & 1] = nticket;
        asm volatile("s_waitcnt vmcnt(2)" ::: "memory");
        __syncthreads();
#define MOBA_KLOAD(KOFF) do { if (!FIXREF) { _Pragma("unroll") for (int d0 = 0; d0 < 4; ++d0) qf_[d0] = *(const LAS bf16x8*)(qlds + d0 * 1024); } \
            _Pragma("unroll") for (int d0 = 0; d0 < 4; ++d0) { \
            kfr[2 * d0] = *(const LAS bf16x8*)(L + (KOFF) + kbase + d0 * 2048); kfr[2 * d0 + 1] = *(const LAS bf16x8*)(L + (KOFF) + kbase + d0 * 2048 + 512); } } while (0)
#define MOBA_KLOADH(KOFF, H) do { _Pragma("unroll") for (int d0 = 2 * (H); d0 < 2 * (H) + 2; ++d0) { \
            kfr[2 * d0] = *(const LAS bf16x8*)(L + (KOFF) + kbase + d0 * 2048); kfr[2 * d0 + 1] = *(const LAS bf16x8*)(L + (KOFF) + kbase + d0 * 2048 + 512); } } while (0)
#define MOBA_VLOAD(VOFF) do { _Pragma("unroll") for (int dblk = 0; dblk < 2; ++dblk) _Pragma("unroll") for (int ks = 0; ks < 4; ++ks) { \
            const int rlo = 16 * ks + vrow0, rhi = rlo + 8; \
            vlo[dblk * 4 + ks] = vtr(L + L_V + (VOFF) + rlo * 128 + ((dblk ^ ((rlo >> 1) & 1)) * 64) + (16 * (g16 & 1) + 4 * tp4) * 2); \
            vhi[dblk * 4 + ks] = vtr(L + L_V + (VOFF) + rhi * 128 + ((dblk ^ ((rhi >> 1) & 1)) * 64) + (16 * (g16 & 1) + 4 * tp4) * 2); } } while (0)
#define MOBA_VLOADH(VOFF, DB) do { _Pragma("unroll") for (int ks = 0; ks < 4; ++ks) { \
            const int rlo = 16 * ks + vrow0, rhi = rlo + 8; \
            vlo[(DB) * 4 + ks] = vtr(L + L_V + (VOFF) + rlo * 128 + (((DB) ^ ((rlo >> 1) & 1)) * 64) + (16 * (g16 & 1) + 4 * tp4) * 2); \
            vhi[(DB) * 4 + ks] = vtr(L + L_V + (VOFF) + rhi * 128 + (((DB) ^ ((rhi >> 1) & 1)) * 64) + (16 * (g16 & 1) + 4 * tp4) * 2); } } while (0)
#define MOBA_QK(CANSKIP, TT, P0, P1) do { \
            const int blk_ = (TT) >> 2; \
            if (!((CANSKIP) && (blk_ == qb) && (64 * ((TT) & 3) > 32 * wid + 31))) { \
                const bool sel_ = ((selmask >> blk_) & 1u); \
                float sc0_ = sel_ ? (-mhat - sl2 * (float)(tq - 64 * (TT) - 4 * hi)) : NEG_BIG; asm volatile("" : "+v"(sc0_)); \
_Pragma("unroll") \
                for (int r = 0; r < 16; ++r) { P0[r] = __builtin_fmaf(sl2, (float)((r & 3) + 8 * (r >> 2)), sc0_); P1[r] = __builtin_fmaf(sl2, (float)(32 + (r & 3) + 8 * (r >> 2)), sc0_); } \
_Pragma("unroll") \
                for (int d0 = 0; d0 < 4; ++d0) { \
                    P0 = __builtin_amdgcn_mfma_f32_32x32x16_bf16(kfr[2 * d0], FIXREF ? qr[d0] : qf_[d0], P0, 0, 0, 0); \
                    P1 = __builtin_amdgcn_mfma_f32_32x32x16_bf16(kfr[2 * d0 + 1], FIXREF ? qr[d0] : qf_[d0], P1, 0, 0, 0); } \
            } } while (0)
#define MOBA_SM(OWNP, TT, P0, P1, HAVE_NEXT, N0, N1) do { \
            const bool own = (OWNP); const int jb = (TT) & 3; \
            if (!(own && (64 * jb > 32 * wid + 31))) { \
                if (own && (64 * jb + 63 > 32 * wid)) { \
_Pragma("unroll") \
                    for (int r = 0; r < 16; ++r) { const int kvl = 64 * jb + crow(r, hi); if (kvl > qrel) P0[r] = NEG_BIG; if (kvl + 32 > qrel) P1[r] = NEG_BIG; } } \
                if (!FIXREF) { \
                float rm = max3f(P0[0], P1[0], P0[1]), rm2 = max3f(P1[1], P0[2], P1[2]); \
_Pragma("unroll") \
                for (int r = 3; r < 15; r += 2) { rm = max3f(rm, P0[r], P1[r]); rm2 = max3f(rm2, P0[r + 1], P1[r + 1]); } \
                rm = max3f(rm, rm2, fmaxf(P0[15], P1[15])); \
                { auto rr = __builtin_amdgcn_permlane32_swap(__float_as_uint(rm), __float_as_uint(rm), false, false); rm = fmaxf(__uint_as_float(rr[0]), __uint_as_float(rr[1])); } \
                if (__any(rm > THR)) { \
                    const float dl = fmaxf(rm, 0.f); mhat += dl; \
_Pragma("unroll") \
                    for (int r = 0; r < 16; ++r) { P0[r] -= dl; P1[r] -= dl; } \
                    if (HAVE_NEXT) { \
_Pragma("unroll") \
                        for (int r = 0; r < 16; ++r) { N0[r] -= dl; N1[r] -= dl; } } \
                    const float f = __builtin_amdgcn_exp2f(-dl); l_reg *= f; \
                    if (hi == 0) wsf[r32] = f; \
_Pragma("unroll") \
                    for (int r = 0; r < 16; ++r) { const float fr = wsf[crow(r, hi)]; o[0][r] *= fr; o[1][r] *= fr; } } \
                } \
                float sacc = 0.f, sacc2 = 0.f; \
_Pragma("unroll") \
                for (int r = 0; r < 16; ++r) { P0[r] = __builtin_amdgcn_exp2f(P0[r]); P1[r] = __builtin_amdgcn_exp2f(P1[r]); sacc += P0[r]; sacc2 += P1[r]; } \
                l_reg += sacc + sacc2; \
                { v4u w; \
_Pragma("unroll") \
                    for (int ks = 0; ks < 4; ++ks) { \
_Pragma("unroll") \
                        for (int e = 0; e < 4; ++e) { const int rb = (ks & 1) * 8 + 2 * e; w[e] = (ks < 2) ? cvtpk(P0[rb], P0[rb + 1]) : cvtpk(P1[rb], P1[rb + 1]); } \
                        pa[ks] = __builtin_bit_cast(bf16x8, w); } } \
            } } while (0)
#define MOBA_PV(OWNP, TT) do { \
            if (!((OWNP) && (64 * ((TT) & 3) > 32 * wid + 31))) { \
_Pragma("unroll") \
                for (int dblk = 0; dblk < 2; ++dblk) \
_Pragma("unroll") \
                    for (int ks = 0; ks < 4; ++ks) { \
                        const s16x4 lo = vlo[dblk * 4 + ks], hh = vhi[dblk * 4 + ks]; \
                        const bf16x8 vf = __builtin_shufflevector(lo, hh, 0, 1, 2, 3, 4, 5, 6, 7); \
                        o[dblk] = __builtin_amdgcn_mfma_f32_32x32x16_bf16(pa[ks], vf, o[dblk], 0, 0, 0); } \
            } } while (0)
        f32x16 pA0, pA1, pB0, pB1; bf16x8 kfr[8], qf_[4], pa[4]; s16x4 vlo[8], vhi[8];
        MOBA_KLOAD(0); MOBA_QK(true, t0, pA0, pA1);
        int c0o = 0;
#define MOBA_ILV() do { __builtin_amdgcn_sched_group_barrier(0x002, 16, 0); \
_Pragma("unroll") \
            for (int g_ = 0; g_ < 8; ++g_) { __builtin_amdgcn_sched_group_barrier(0x008, 1, 0); __builtin_amdgcn_sched_group_barrier(0x002, 12, 0); } } while (0)
#define MOBA_STEP2(OWNP) do { \
            const int c1o = (c0o + 1) & 3, c2o = (c0o + 2) & 3, c3o = (c0o + 3) & 3; \
            if (!(OWNP) || t + 3 < NT) MOBA_ISSUE(t + 3, c3o); \
            if (FIXREF) { MOBA_KLOAD(c1o * 8192); __builtin_amdgcn_sched_barrier(0); \
                MOBA_QK(OWNP, t + 1, pB0, pB1); MOBA_SM(OWNP, t, pA0, pA1, false, pB0, pB1); if (!(OWNP)) MOBA_ILV(); __builtin_amdgcn_sched_barrier(0); \
                MOBA_VLOAD(c0o * 8192); __builtin_amdgcn_sched_barrier(0); MOBA_PV(OWNP, t); } \
            else { MOBA_KLOAD(c1o * 8192); __builtin_amdgcn_sched_barrier(0); MOBA_QK(true, t + 1, pB0, pB1); __builtin_amdgcn_sched_barrier(0); \
                MOBA_VLOAD(c0o * 8192); __builtin_amdgcn_sched_barrier(0); MOBA_SM(OWNP, t, pA0, pA1, true, pB0, pB1); MOBA_PV(OWNP, t); } \
            if (!(OWNP) || t + 3 < NT) asm volatile("s_waitcnt vmcnt(2)" ::: "memory"); else asm volatile("s_waitcnt vmcnt(0)" ::: "memory"); \
            __syncthreads(); \
            if (!(OWNP) || t + 4 < NT) MOBA_ISSUE(t + 4, c0o); \
            if (FIXREF) { if (!(OWNP) || t + 2 < NT) MOBA_KLOAD(c2o * 8192); __builtin_amdgcn_sched_barrier(0); \
                if (!(OWNP) || t + 2 < NT) MOBA_QK(OWNP, t + 2, pA0, pA1); MOBA_SM(OWNP, t + 1, pB0, pB1, false, pA0, pA1); if (!(OWNP)) MOBA_ILV(); __builtin_amdgcn_sched_barrier(0); \
                MOBA_VLOAD(c1o * 8192); __builtin_amdgcn_sched_barrier(0); MOBA_PV(OWNP, t + 1); } \
            else { if (t + 2 < NT) { MOBA_KLOAD(c2o * 8192); __builtin_amdgcn_sched_barrier(0); MOBA_QK(true, t + 2, pA0, pA1); __builtin_amdgcn_sched_barrier(0); } \
                MOBA_VLOAD(c1o * 8192); __builtin_amdgcn_sched_barrier(0); MOBA_SM(OWNP, t + 1, pB0, pB1, (t + 2 < NT), pA0, pA1); MOBA_PV(OWNP, t + 1); } \
            if (!(OWNP) || t + 4 < NT) asm volatile("s_waitcnt vmcnt(2)" ::: "memory"); else asm volatile("s_waitcnt vmcnt(0)" ::: "memory"); \
            __syncthreads(); \
            c0o = c2o; } while (0)
        int t = t0;
        for (; t < NT - 4; t += 2) MOBA_STEP2(false);
        for (; t < NT; t += 2) MOBA_STEP2(true);
#undef MOBA_STEP2
#undef MOBA_ISSUE
#undef MOBA_KLOAD
#undef MOBA_KLOADH
#undef MOBA_VLOAD
#undef MOBA_VLOADH
#undef MOBA_QK
#undef MOBA_SM
#undef MOBA_PV
        int lane_e = lane; asm volatile("" : "+v"(lane_e));
        const int r32e = lane_e & 31, hie = lane_e >> 5;
        v4u gwv[4];
#pragma unroll
        for (int i = 0; i < 4; ++i) gwv[i] = *(const GAS v4u*)(F.GA + (rowbase + q0 + wid * 32 + i * 8 + (lane_e >> 3)) * 512 + h * 64 + (lane_e & 7) * 8);
        { auto rr = __builtin_amdgcn_permlane32_swap(__float_as_uint(l_reg), __float_as_uint(l_reg), false, false); l_reg = __uint_as_float(rr[0]) + __uint_as_float(rr[1]); }
        if (hie == 0) wsf[r32e] = 1.0f / l_reg;
#pragma unroll
        for (int r = 0; r < 16; ++r) { const float rl = wsf[crow(r, hie)]; ost[crow(r, hie) * 64 + r32e] = o[0][r] * rl; ost[crow(r, hie) * 64 + 32 + r32e] = o[1][r] * rl; }
#pragma unroll
        for (int i = 0; i < 4; ++i) { const int row = i * 8 + (lane_e >> 3), ch = lane_e & 7;
            const f32x4 a = *(const LAS f32x4*)(ost + row * 64 + ch * 8), c2 = *(const LAS f32x4*)(ost + row * 64 + ch * 8 + 4);
            const size_t grow = rowbase + q0 + wid * 32 + row;
            const v4u gw = gwv[i];
            v4u ow; ow.x = pk2(a[0] * bflo(gw.x), a[1] * bfhi(gw.x)); ow.y = pk2(a[2] * bflo(gw.y), a[3] * bfhi(gw.y));
            ow.z = pk2(c2[0] * bflo(gw.z), c2[1] * bfhi(gw.z)); ow.w = pk2(c2[2] * bflo(gw.w), c2[3] * bfhi(gw.w));
            *(GAS v4u*)(F.MIXED + grow * DM + 512 + h * 64 + ch * 8) = ow; }
    }
    __syncthreads();
}


__device__ __forceinline__ void moba_mfma_phase(Frame& F, int l) {
    unsigned tk0_ = 0u; const bool t0_ = (F.wave0 == 0) && (lane_id_asm() == 0);
    if (t0_) tk0_ = __hip_atomic_fetch_add(F.ctl + CW_QUEUE + 64 * (2 * (int)(blockIdx.x & 7u) + l), 1u, RLX_AGENT);
    float gq = 0.f, gk = 0.f;
    for (int i = 0; i < 64; ++i) { gq = fmaxf(gq, fabsf(F.q_norm_w[l * 64 + i])); gk = fmaxf(gk, fabsf(F.k_norm_w[l * 64 + i])); }
    if (t0_) ((volatile LAS unsigned*)(F.lds + EXTRA_OFF + 8192))[0] = tk0_;
    if (F.wave0 < 4) __builtin_amdgcn_s_setprio(1);
    if (2.0f * (8.0f * gq * gk * LOG2E * 1.02f) + 1.0f <= 100.0f) moba_mfma_body<true>(F, l, gq, gk); else moba_mfma_body<false>(F, l, gq, gk);
    __builtin_amdgcn_s_setprio(0);
}

namespace hg {
typedef short bf16x8 __attribute__((ext_vector_type(8)));
typedef short s16x4 __attribute__((ext_vector_type(4)));
typedef float f32x4 __attribute__((ext_vector_type(4)));
typedef unsigned u32x2 __attribute__((ext_vector_type(2)));
constexpr int SLOT = 33792, NSLOT = 4;
constexpr int L_SC = NSLOT * SLOT, L_NRM = L_SC + 4096;
constexpr int NSTEP = SEQ / 32;
__device__ __forceinline__ int fsw(int t) { return ((t & 7) << 2) | (((t >> 3) & 1) << 1); }
__device__ __forceinline__ int unit_off(int tok, int cg) { return 8 * (32 * tok + (cg ^ fsw(tok))); }
__device__ __forceinline__ s16x4 rd64(const LAS unsigned char* p) { return *(const LAS s16x4*)p; }
__device__ __forceinline__ s16x4 vtr(const LAS unsigned char* p) { return __builtin_bit_cast(s16x4, __builtin_amdgcn_ds_read_tr16_b64_v4i16((LAS s16x4*)p)); }
__device__ __forceinline__ bf16x8 cat(s16x4 a, s16x4 b) { return __builtin_shufflevector(a, b, 0, 1, 2, 3, 4, 5, 6, 7); }
__device__ __forceinline__ s16x4 pack4(f32x4 v) { u32x2 w; w.x = moba::cvtpk(v[0], v[1]); w.y = moba::cvtpk(v[2], v[3]); return __builtin_bit_cast(s16x4, w); }
__device__ __forceinline__ void glds16(const GAS void* gsrc, unsigned lds_dst) { unsigned keep;
    asm volatile("s_mov_b32 %0, m0\n\ts_mov_b32 m0, %2\n\ts_nop 0\n\tglobal_load_lds_dwordx4 %1, off\n\ts_mov_b32 m0, %0" : "=&s"(keep) : "v"(gsrc), "s"(lds_dst) : "memory"); }
__device__ __forceinline__ void glds16s(unsigned voff, const void* sbase, unsigned lds_dst) { unsigned keep;
    asm volatile("s_mov_b32 %0, m0\n\ts_mov_b32 m0, %3\n\ts_nop 0\n\tglobal_load_lds_dwordx4 %1, %2 nt\n\ts_mov_b32 m0, %0" : "=&s"(keep) : "v"(voff), "s"(sbase), "s"(lds_dst) : "memory"); }
#define HG_MFMA(a, b, c) __builtin_amdgcn_mfma_f32_16x16x32_bf16((a), (b), (c), 0, 0, 0)
}

__device__ __forceinline__ void hgrn_mfma_phase(Frame& F, int l) {
    using namespace hg;
    PHASE_IDS();
    const int w = wave, c16 = lane & 15, g = lane >> 4;
    LAS unsigned char* L = F.lds + RING_OFF;
    const s16x4 z4 = (s16x4){0, 0, 0, 0};
    for (int it = (int)blockIdx.x; it < 64; it += F.G) {
        const int b = 2 * (it & 7) + (it >> 5), h = (it >> 3) & 3; const size_t rowbase = (size_t)b * SEQ;
        const int da = w >> 1;
        unsigned dsrc[4];
#pragma unroll
        for (int i = 0; i < 4; ++i) { const int t = 16 * (w & 1) + 4 * i + (lane >> 4); const int sc = (lane & 15) ^ (fsw(t) >> 1);
            dsrc[i] = (unsigned)((((size_t)da * MTOK + rowbase + t) * 512 + h * 128 + 8 * sc) * 2); }
        const unsigned ddec = (unsigned)((((size_t)b * NSTEP) * 512 + h * 128 + 4 * lane) * 4);
        const int ddst = da * 8192 + (w & 1) * 4096;
        const unsigned lds0 = (unsigned)(uintptr_t)(F.lds + RING_OFF);
#define HG_ISSUE(step) do { const unsigned so_ = lds0 + (unsigned)(((step) & 3) * SLOT); \
            _Pragma("unroll") for (int i = 0; i < 4; ++i) \
                glds16s(dsrc[i], (const void*)((const char*)F.QI + (size_t)(step) * (32 * 512 * 2)), (unsigned)__builtin_amdgcn_readfirstlane((int)(so_ + ddst + i * 1024))); \
            if (w == 0) glds16s(ddec, (const void*)((const char*)F.DEC + (size_t)(step) * 2048), (unsigned)__builtin_amdgcn_readfirstlane((int)(so_ + 32768))); } while (0)
        f32x4 S[8]; bf16x8 Sb[4];
#pragma unroll
        for (int tk = 0; tk < 8; ++tk) S[tk] = (f32x4){0.f, 0.f, 0.f, 0.f};
#pragma unroll
        for (int ks = 0; ks < 4; ++ks) Sb[ks] = (bf16x8){0, 0, 0, 0, 0, 0, 0, 0};
        f32x4 oprev[2]; oprev[0] = (f32x4){0.f, 0.f, 0.f, 0.f}; oprev[1] = oprev[0];
        u32x2 gprev[2]; gprev[0] = (u32x2){0u, 0u}; gprev[1] = gprev[0];
        float hw[4];
#pragma unroll
        for (int r = 0; r < 4; ++r) hw[r] = F.hg_norm_w[l * 128 + 16 * w + 4 * g + r];
        asm volatile("" : "+v"(hw[0]), "+v"(hw[1]), "+v"(hw[2]), "+v"(hw[3]));
        LAS float* nrm = (LAS float*)(L + L_NRM);
        LAS unsigned char* SC = L + L_SC;
        HG_ISSUE(0); HG_ISSUE(1); HG_ISSUE(2);
        asm volatile("s_waitcnt vmcnt(8)\n\ts_barrier" ::: "memory");
        const int trq = c16 >> 2, trp = c16 & 3;
        int ro0 = 256 * c16 + 16 * (g ^ (fsw(c16) >> 1)), ko0 = 256 * (4 * g + trq) + 16 * (trp ^ (fsw(4 * g + trq) >> 1));
#define RO(ks) (ro0 ^ (64 * (ks)))
#define KO(tk) (ko0 ^ (64 * ((tk) >> 1) + 8 * ((tk) & 1)))
        const int io_ = unit_off(4 * g + trq, 4 * w + trp), go_ = unit_off(c16, 4 * w + g);
        bf16x8 qf[2][4];
#define HG_LOADQ(slotbase) do { _Pragma("unroll") for (int tt = 0; tt < 2; ++tt) _Pragma("unroll") for (int ks = 0; ks < 4; ++ks) \
            qf[tt][ks] = *(const LAS bf16x8*)((slotbase) + RO(ks) + 4096 * tt); } while (0)
#define HG_FINAL(step, P) do { _Pragma("unroll") for (int tt = 0; tt < 2; ++tt) { \
            const float ssum = ((P[tt][0] + P[tt][1]) + (P[tt][2] + P[tt][3])) + ((P[tt][4] + P[tt][5]) + (P[tt][6] + P[tt][7])); \
            const float rstd = __builtin_amdgcn_rsqf(ssum * (1.0f / 128.0f) + NORM_EPS); \
            u32x2 wv; wv.x = moba::cvtpk(oprev[tt][0] * rstd * hw[0] * bflo(gprev[tt].x), oprev[tt][1] * rstd * hw[1] * bfhi(gprev[tt].x)); \
            wv.y = moba::cvtpk(oprev[tt][2] * rstd * hw[2] * bflo(gprev[tt].y), oprev[tt][3] * rstd * hw[3] * bfhi(gprev[tt].y)); \
            *(GAS u32x2*)(F.MIXED + (rowbase + (size_t)(step) * 32 + 16 * tt + c16) * DM + h * 128 + 16 * w + 4 * g) = wv; } } while (0)
        HG_LOADQ(L);
        for (int n = 0; n < NSTEP; ++n) {
            asm volatile("" : "+v"(ro0), "+v"(ko0));
            if (n + 3 < NSTEP) HG_ISSUE(n + 3);
            const LAS unsigned char* Qs = L + (n & 3) * SLOT; const LAS unsigned char* Ks = Qs + 8192; const LAS unsigned char* Is = Qs + 16384; const LAS unsigned char* Gs = Qs + 24576;
            const LAS float* Ds = (const LAS float*)(Qs + 32768);
            LAS unsigned char* SCn = SC + (n & 1) * 1536;
            bf16x8 kf[4];
            if (w < 3) { const int st = (w == 2) ? 1 : 0;
#pragma unroll
                for (int ks = 0; ks < 4; ++ks) kf[ks] = *(const LAS bf16x8*)(Ks + RO(ks) + 4096 * st); }
            u32x2 gcur[2];
#pragma unroll
            for (int tt = 0; tt < 2; ++tt) gcur[tt] = *(const LAS u32x2*)(Gs + go_ + 4096 * tt);
            s16x4 itr[2];
#pragma unroll
            for (int st = 0; st < 2; ++st) itr[st] = vtr(Is + io_ + 4096 * st);
            const bf16x8 i01 = cat(itr[0], itr[1]);
            bf16x8 k01[4]; f32x4 dv4[4];
#pragma unroll
            for (int tk = 0; tk < 4; ++tk) { k01[tk] = cat(vtr(Ks + KO(tk)), vtr(Ks + KO(tk) + 4096)); dv4[tk] = *(const LAS f32x4*)(Ds + 16 * tk + 4 * g); }
            f32x4 o[2];
#pragma unroll
            for (int tt = 0; tt < 2; ++tt) { f32x4 a = (f32x4){0.f, 0.f, 0.f, 0.f};
#pragma unroll
                for (int ks = 0; ks < 4; ++ks) a = HG_MFMA(Sb[ks], qf[tt][ks], a);
                o[tt] = a; }
            if (w < 3) { f32x4 sc = (f32x4){0.f, 0.f, 0.f, 0.f};
                if (w == 0) {
#pragma unroll
                    for (int ks = 0; ks < 4; ++ks) sc = HG_MFMA(kf[ks], qf[0][ks], sc);
                } else {
#pragma unroll
                    for (int ks = 0; ks < 4; ++ks) sc = HG_MFMA(kf[ks], qf[1][ks], sc); }
                if (w != 1) {
#pragma unroll
                    for (int r = 0; r < 4; ++r) if (4 * g + r > c16) sc[r] = 0.f; }
                *(LAS s16x4*)(SCn + w * 512 + lane * 8) = pack4(sc); }
#pragma unroll
            for (int tk = 0; tk < 4; ++tk) S[tk] = HG_MFMA(k01[tk], i01, S[tk]);
            asm volatile("" ::: "memory");
            { bf16x8 k2[4]; f32x4 d2[4];
#pragma unroll
                for (int tk = 0; tk < 4; ++tk) { k2[tk] = cat(vtr(Ks + KO(tk + 4)), vtr(Ks + KO(tk + 4) + 4096)); d2[tk] = *(const LAS f32x4*)(Ds + 16 * (tk + 4) + 4 * g); }
#pragma unroll
                for (int tk = 0; tk < 4; ++tk) S[tk] = S[tk] * dv4[tk];
#pragma unroll
                for (int ks = 0; ks < 2; ++ks) Sb[ks] = cat(pack4(S[2 * ks]), pack4(S[2 * ks + 1]));
#pragma unroll
                for (int tk = 0; tk < 4; ++tk) S[tk + 4] = HG_MFMA(k2[tk], i01, S[tk + 4]);
#pragma unroll
                for (int tk = 0; tk < 4; ++tk) S[tk + 4] = S[tk + 4] * d2[tk];
#pragma unroll
                for (int ks = 2; ks < 4; ++ks) Sb[ks] = cat(pack4(S[2 * ks]), pack4(S[2 * ks + 1])); }
            if (n >= NSTEP - 3) asm volatile("s_waitcnt vmcnt(0) lgkmcnt(0)\n\ts_barrier" ::: "memory");
            else if (n <= 1) asm volatile("s_waitcnt vmcnt(8) lgkmcnt(0)\n\ts_barrier" ::: "memory");
            else if (n == 2) asm volatile("s_waitcnt vmcnt(10) lgkmcnt(0)\n\ts_barrier" ::: "memory");
            else asm volatile("s_waitcnt vmcnt(12) lgkmcnt(0)\n\ts_barrier" ::: "memory");
            const s16x4 sc00 = rd64(SCn + lane * 8), sc01 = rd64(SCn + 512 + lane * 8), sc11 = rd64(SCn + 1024 + lane * 8);
            float pn[2][8];
            if (n > 0) {
#pragma unroll
                for (int tt = 0; tt < 2; ++tt)
#pragma unroll
                    for (int ww = 0; ww < 8; ++ww) pn[tt][ww] = nrm[((n - 1) & 1) * 256 + ww * 32 + 16 * tt + c16]; }
            if (n + 1 < NSTEP) HG_LOADQ(L + ((n + 1) & 3) * SLOT);
            o[0] = HG_MFMA(cat(itr[0], z4), cat(sc00, z4), o[0]);
            o[1] = HG_MFMA(i01, cat(sc01, sc11), o[1]);
            { float ss0 = (o[0][0] * o[0][0] + o[0][1] * o[0][1]) + (o[0][2] * o[0][2] + o[0][3] * o[0][3]);
              float ss1 = (o[1][0] * o[1][0] + o[1][1] * o[1][1]) + (o[1][2] * o[1][2] + o[1][3] * o[1][3]);
              { auto r0 = __builtin_amdgcn_permlane16_swap(__float_as_uint(ss0), __float_as_uint(ss0), false, false); auto r1 = __builtin_amdgcn_permlane16_swap(__float_as_uint(ss1), __float_as_uint(ss1), false, false);
                ss0 = __uint_as_float(r0[0]) + __uint_as_float(r0[1]); ss1 = __uint_as_float(r1[0]) + __uint_as_float(r1[1]); }
              { auto r0 = __builtin_amdgcn_permlane32_swap(__float_as_uint(ss0), __float_as_uint(ss0), false, false); auto r1 = __builtin_amdgcn_permlane32_swap(__float_as_uint(ss1), __float_as_uint(ss1), false, false);
                ss0 = __uint_as_float(r0[0]) + __uint_as_float(r0[1]); ss1 = __uint_as_float(r1[0]) + __uint_as_float(r1[1]); }
              if (g == 0) { nrm[(n & 1) * 256 + w * 32 + c16] = ss0; nrm[(n & 1) * 256 + w * 32 + 16 + c16] = ss1; } }
            if (n > 0) HG_FINAL(n - 1, pn);
            oprev[0] = o[0]; oprev[1] = o[1]; gprev[0] = gcur[0]; gprev[1] = gcur[1];
        }
        asm volatile("s_waitcnt vmcnt(0) lgkmcnt(0)\n\ts_barrier" ::: "memory");
        { float pn[2][8];
#pragma unroll
            for (int tt = 0; tt < 2; ++tt)
#pragma unroll
                for (int ww = 0; ww < 8; ++ww) pn[tt][ww] = nrm[((NSTEP - 1) & 1) * 256 + ww * 32 + 16 * tt + c16];
            HG_FINAL(NSTEP - 1, pn); }
        asm volatile("s_waitcnt vmcnt(0) lgkmcnt(0)\n\ts_barrier" ::: "memory");
#undef RO
#undef KO
#undef HG_LOADQ
#undef HG_FINAL
#undef HG_ISSUE
    }
}

struct Args { const float* in[8]; float* out; unsigned char* ws; int ph_lo, ph_hi, li, pad; };
__global__ void __launch_bounds__(NWAVES * 64, 2) fwd(Args args) {
    extern __shared__ __attribute__((aligned(16))) unsigned char lds[];
    Frame F;
    F.lds = (LAS unsigned char*)lds;
    F.MISC = (volatile LAS unsigned*)(F.lds + MISC_OFF);
    F.G = gridDim.x; { const int bx = blockIdx.x; F.vcu = (F.G % 8 == 0) ? (bx % 8) * (F.G / 8) + bx / 8 : bx; }
    unsigned char* ws = args.ws;
    F.ctl = (gu32*)(ws + WS_CTL);
    F.x = args.in[0]; F.norm_w = args.in[1]; F.w_in = args.in[2]; F.lb_logits = args.in[3]; F.hg_norm_w = args.in[4]; F.q_norm_w = args.in[5]; F.k_norm_w = args.in[6]; F.w_out = args.in[7];
    F.out = args.out;
    F.WIN = (bf16*)(ws + WS_WIN); F.WOUT = (bf16*)(ws + WS_WOUT); F.XB = (bf16*)(ws + WS_XB); F.MIXED = (bf16*)(ws + WS_MIXED);
    F.QI = (bf16*)(ws + WS_ARR); F.KT = (bf16*)(ws + WS_ARR + ARR_BYTES); F.HI = (bf16*)(ws + WS_ARR + 2 * ARR_BYTES); F.GH = (bf16*)(ws + WS_ARR + 3 * ARR_BYTES);
    F.QN = (bf16*)(ws + WS_ARR + 4 * ARR_BYTES); F.KN = (bf16*)(ws + WS_ARR + 5 * ARR_BYTES); F.V = (bf16*)(ws + WS_ARR + 6 * ARR_BYTES); F.GA = (bf16*)(ws + WS_ARR + 7 * ARR_BYTES);
    F.LB = (float*)(ws + WS_LB); F.KPART = (float*)(ws + WS_KPART); F.ROWSS = (float*)(ws + WS_ROWSS); F.DEC = (float*)(ws + WS_DEC);
    F.wave0 = __builtin_amdgcn_readfirstlane((int)threadIdx.x >> 6);
    for (int u = F.wave0 * 64 + lane_id_asm(); u < (LDS_BYTES - LDSCTL_OFF) / 4; u += NWAVES * 64) ((LAS unsigned*)(F.lds + LDSCTL_OFF))[u] = 0u;
    __syncthreads();
    XcdBarrier bar; bar.bar = (unsigned*)(F.ctl + CW_BAR); bar.x = 0; bar.st = nullptr; bar.wave0 = F.wave0;
    if (N_LAUNCHES == 1) bar = xcd_barrier_post((unsigned*)(F.ctl + CW_BAR), F.MISC + 8, F.wave0);
    if (N_LAUNCHES == 1 && XB_IS_T0(F.wave0)) __hip_atomic_fetch_or(F.ctl + 3072 + 64 * (blockIdx.x & 7u), 1u << xb_xcc_id(), __ATOMIC_RELAXED, __HIP_MEMORY_SCOPE_AGENT);
#define GRID_BAR() do { if (N_LAUNCHES == 1) xcd_barrier(bar); } while (0)
#define GRP_BAR() do { if (N_LAUNCHES == 1) { int g_ = (int)(blockIdx.x & 7u); asm volatile("" : "+s"(g_));     \
        if (__builtin_amdgcn_readfirstlane((int)F.MISC[10]) != 0) grp_barrier((unsigned*)(F.ctl + 2048 + 128 * g_), 32u, (unsigned*)(F.ctl + CW_BAR + XB_TMO), F.wave0);     \
        else xcd_barrier(bar); } } while (0)
    const int lo = (N_LAUNCHES == 1) ? 0 : args.ph_lo, hi = (N_LAUNCHES == 1) ? N_PHASES : args.ph_hi;
#define IN(k) (lo <= (k) && (k) < hi)
#define BOTH(k) (IN(k) && IN((k) + 1))

    if (IN(0)) { p0_prologue(F); if (BOTH(0)) GRID_BAR(); }
    if (N_LAUNCHES == 1) {
        if (XB_IS_T0(F.wave0)) { const unsigned m_ = xb_ld((unsigned*)(F.ctl + 3072 + 64 * (blockIdx.x & 7u))); F.MISC[10] = (gridDim.x == 256u && m_ != 0u && (m_ & (m_ - 1u)) == 0u) ? 1u : 0u; }
        __syncthreads(); }
    for (int l = 0; l < DEPTH; ++l) {
        const int pb = 1 + 3 * l;
        if (IN(pb)) {
            pg8::Gemm g{F.XB + (size_t)l * MTOK * DM, F.WIN + (size_t)l * NIN * DM, MTOK, NIN, DM}; pg8::StaticOrder S; S.init(MTOK, NIN, F.G, (int)blockIdx.x, (int)(((blockIdx.x & 1u) << 2) | (blockIdx.x & 2u) | ((blockIdx.x >> 2) & 1u)));
            pg8::EpiFused E{F.QI, F.DEC, F.KPART, F.ROWSS + (size_t)l * MTOK * 16, F.LB + l * 512, F.q_norm_w + l * 64, F.k_norm_w + l * 64, nullptr, 0};
            {
                pg8::Unit u0{0, 0}, u4{0, 0}, ut; bool two = S.next(0, u0) && S.next(4, u4);
                for (int i = 0; two && S.next(i, ut); ++i) two = (ut.pm == u0.pm || ut.pm == u4.pm);
                if (two) { LAS float* rt = (LAS float*)(F.lds + EXTRA_OFF); int t_ = F.wave0 * 64 + lane_id_asm(); asm volatile("" : "+v"(t_));
                    rt[t_] = pg8::EpiFused::rstd_global(E.rowss, ((t_ >> 8) ? u4.pm : u0.pm) * 256 + (t_ & 255));
                    E.rtab = rt; E.pm0 = u0.pm; __syncthreads(); } }
            for (int rp = 0; rp < REP_PROJ; ++rp) { if (rp) GRID_BAR(); pg8::gemm_phase<pg8::EpiFused, pg8::StaticOrder, true, true>(F.lds + RING_OFF, g, S, E, F.wave0); }
            if (BOTH(pb)) GRP_BAR();
        }
        if (IN(pb + 1)) {
            for (int rp = 0; rp < REP_HGRN; ++rp) { if (rp) GRID_BAR(); hgrn_mfma_phase(F, l); }
            for (int rp = 0; rp < REP_MOBA; ++rp) { if (rp) { GRID_BAR(); if (blockIdx.x == 0 && F.wave0 == 0 && lane_id_asm() == 0) __hip_atomic_store(F.ctl + CW_QUEUE + 64 * l, 0u, RLX_AGENT); GRID_BAR(); } moba_mfma_phase(F, l); }
            if (BOTH(pb + 1)) GRP_BAR(); }
        if (IN(pb + 2)) {
            pg8::Gemm g{F.MIXED, F.WOUT + (size_t)l * DM * DM, MTOK, DM, DM}; pg8::StaticOrder S; S.init(MTOK, DM, F.G, (int)blockIdx.x);
            pg8::EpiOut E{l == 0 ? F.XB : F.XB + (size_t)MTOK * DM, l == 0 ? nullptr : F.out, l == 0 ? F.XB + (size_t)MTOK * DM : nullptr, l == 0 ? F.ROWSS + (size_t)MTOK * 16 : nullptr};
            for (int rp = 0; rp < REP_OUT; ++rp) { if (rp) GRID_BAR(); pg8::gemm_phase<pg8::EpiOut, pg8::StaticOrder, true, true>(F.lds + RING_OFF, g, S, E, F.wave0); }
            if (pb + 2 < N_PHASES - 1 && BOTH(pb + 2)) GRP_BAR();
        }
    }
#undef IN
#undef BOTH
}

extern "C" void kernel_launch(void* const* d_in, const int* in_sizes, int n_in, void* d_out, int out_size, void* d_ws, size_t ws_size, hipStream_t stream) {
    static int grid = 0;
    if (grid == 0) {
        if (n_in != 8 || in_sizes[0] != MTOK * DM || out_size != MTOK * DM || ws_size < WS_END) { fprintf(stderr, "kernel_launch: unexpected shapes n_in %d in0 %d out %d ws %zu\n", n_in, n_in > 0 ? in_sizes[0] : -1, out_size, ws_size); grid = -1; return; }
        int dev = 0, cus = 0, per_cu = 0;
        if (hipGetDevice(&dev) != hipSuccess || hipDeviceGetAttribute(&cus, hipDeviceAttributeMultiprocessorCount, dev) != hipSuccess) { grid = -1; return; }
        if (hipFuncSetAttribute((const void*)fwd, hipFuncAttributeMaxDynamicSharedMemorySize, LDS_BYTES) != hipSuccess) { fprintf(stderr, "kernel_launch: hipFuncSetAttribute failed\n"); grid = -1; return; }
        if (hipOccupancyMaxActiveBlocksPerMultiprocessor(&per_cu, (const void*)fwd, NWAVES * 64, LDS_BYTES) != hipSuccess || per_cu < 1) fprintf(stderr, "kernel_launch: occupancy query says %d\n", per_cu);
        (void)hipGetLastError();
        if (per_cu < 1) { grid = -1; return; }
        grid = cus < 512 ? cus : 512;
    }
    if (grid < 0) return;
    if (hipMemsetAsync((char*)d_ws + WS_CTL, 0, CTL_ZERO_BYTES, stream) != hipSuccess) return;
    Args a{};
    for (int i = 0; i < 8; ++i) a.in[i] = (const float*)d_in[i];
    a.out = (float*)d_out; a.ws = (unsigned char*)d_ws;
    for (int li = 0; li < N_LAUNCHES; ++li) {
        a.ph_lo = (N_LAUNCHES == 1) ? 0 : li; a.ph_hi = (N_LAUNCHES == 1) ? N_PHASES : li + 1; a.li = li;
        hipError_t le;
        if (N_LAUNCHES == 1) { void* kargs[] = {(void*)&a}; le = hipLaunchCooperativeKernel((const void*)fwd, dim3(grid), dim3(NWAVES * 64), kargs, LDS_BYTES, stream); }
        else { hipLaunchKernelGGL(fwd, dim3(grid), dim3(NWAVES * 64), LDS_BYTES, stream, a); le = hipPeekAtLastError(); }
        if (le != hipSuccess) { fprintf(stderr, "kernel_launch: launch %d failed: %s\n", li, hipGetErrorName(le)); break; }
    }
}
```
